# Optimizing an MI355X kernel written in HIP

```python
import math
import jax, jax.numpy as jnp
from jax import lax
import numpy as np

D_MODEL = 1024
BATCH = 8
SEQ = 2048
DEPTH = 1
DEC_BATCH = 128
DEC_SEQ = 4
PAST_LEN = 2048
PAGE_SIZE = 128

HEAD_DIM = 64
ATTN_GROUPS = ((128, 1), (512, 4), (2048, 16))
HEADS_PER_GROUP = 4
N_ATTN_HEADS = HEADS_PER_GROUP * len(ATTN_GROUPS)
ATTN_WIDTH = N_ATTN_HEADS * HEAD_DIM
SSM_WIDTH = D_MODEL - ATTN_WIDTH
SSM_GROUP = 16
SSM_GROUPS = SSM_WIDTH // SSM_GROUP
SSM_STATE = 64
IN_WIDTH = 3 * ATTN_WIDTH + SSM_WIDTH
ROT_DIM = HEAD_DIM // 4
ROPE_THETA = 500000.0
N_MEM = 256
X_HEADS = 4
X_HEAD_DIM = D_MODEL // X_HEADS
D_FF = 2816
CONV_W = 3
EPS = 1e-6

kernel_name = "hymba_s5_longnet_convffn_step"


def rmsnorm(x, g):
    xf = x.astype(jnp.float32)
    y = xf * lax.rsqrt(jnp.mean(xf * xf, axis=-1, keepdims=True) + EPS)
    return (y * g.astype(jnp.float32)).astype(x.dtype)


def rope_partial(x, pos):
    half = ROT_DIM // 2
    inv = jnp.power(jnp.float32(ROPE_THETA), -jnp.arange(half, dtype=jnp.float32) * 2.0 / ROT_DIM)
    ang = pos.astype(jnp.float32)[:, None] * inv[None, :]
    cos = jnp.cos(ang)[None, :, None, :]
    sin = jnp.sin(ang)[None, :, None, :]
    xr = x[..., :ROT_DIM].astype(jnp.float32)
    x1, x2 = xr[..., :half], xr[..., half:]
    rot = jnp.concatenate([x1 * cos - x2 * sin, x2 * cos + x1 * sin], axis=-1)
    return jnp.concatenate([rot.astype(x.dtype), x[..., ROT_DIM:]], axis=-1)


def dilated_attn_prompt(q, k, v, window, dil):
    B, L, H, E = q.shape
    S = L // dil
    blk = window // dil
    nb = -(-S // blk)
    Sp = nb * blk

    def to_blocks(t):
        t = t.reshape(B, S, dil, H, E)
        t = jnp.pad(t, ((0, 0), (0, Sp - S), (0, 0), (0, 0), (0, 0)))
        return t.reshape(B, nb, blk, dil, H, E)

    def band(t):
        tp = jnp.pad(t, ((0, 0), (1, 0), (0, 0), (0, 0), (0, 0), (0, 0)))
        return jnp.concatenate([tp[:, :-1], tp[:, 1:]], axis=2)

    qb = to_blocks(q)
    kb = band(to_blocks(k))
    vb = band(to_blocks(v))
    s = jnp.einsum('bnqrhe,bnkrhe->bnrhqk', qb, kb, preferred_element_type=jnp.float32)
    qi = jnp.arange(nb)[:, None, None] * blk + jnp.arange(blk)[None, :, None]
    ki = (jnp.arange(nb)[:, None, None] - 1) * blk + jnp.arange(2 * blk)[None, None, :]
    delta = qi - ki
    mask = (delta >= 0) & (delta <= blk) & (ki >= 0)
    s = jnp.where(mask[None, :, None, None], s, -jnp.inf)
    lse = jax.nn.logsumexp(s, axis=-1)
    p = jnp.exp(s - lse[..., None])
    o = jnp.einsum('bnrhqk,bnkrhe->bnqrhe', p.astype(v.dtype), vb)
    o = o.reshape(B, Sp, dil, H, E)[:, :S].reshape(B, L, H, E)
    lse = jnp.transpose(lse, (0, 1, 4, 2, 3)).reshape(B, Sp, dil, H)[:, :S].reshape(B, L, H)
    return o, lse


def dilated_attn_sample(q, k_all, v_all, window, dil, n_buf):
    T = q.shape[1]
    n_keys = window // dil + 1
    idx = n_buf + jnp.arange(T)[:, None] - dil * jnp.arange(n_keys)[None, :]
    valid = idx >= 0
    idx = jnp.maximum(idx, 0)
    kg = k_all[:, idx]
    vg = v_all[:, idx]
    s = jnp.einsum('bthe,btjhe->bthj', q, kg, preferred_element_type=jnp.float32)
    s = jnp.where(valid[None, :, None, :], s, -jnp.inf)
    lse = jax.nn.logsumexp(s, axis=-1)
    p = jnp.exp(s - lse[..., None])
    o = jnp.einsum('bthj,btjhe->bthe', p.astype(vg.dtype), vg)
    return o, lse


def s5_scan(u, s0_re, s0_im, p):
    uf = u.astype(jnp.float32)
    lam_re = p['ssm_lam_re'].astype(jnp.float32)
    lam_im = p['ssm_lam_im'].astype(jnp.float32)
    dt = jnp.exp(p['ssm_log_dt'].astype(jnp.float32))[:, None]
    mag = jnp.exp(lam_re * dt)
    a_re = mag * jnp.cos(lam_im * dt)
    a_im = mag * jnp.sin(lam_im * dt)
    den = lam_re * lam_re + lam_im * lam_im
    nr, ni = a_re - 1.0, a_im
    c_re = (nr * lam_re + ni * lam_im) / den
    c_im = (ni * lam_re - nr * lam_im) / den
    bu_re = jnp.einsum('blgh,gph->blgp', uf, p['ssm_b_re'].astype(jnp.float32))
    bu_im = jnp.einsum('blgh,gph->blgp', uf, p['ssm_b_im'].astype(jnp.float32))
    b_re = c_re * bu_re - c_im * bu_im
    b_im = c_re * bu_im + c_im * bu_re
    s0r = s0_re.astype(jnp.float32)
    s0i = s0_im.astype(jnp.float32)
    b_re = b_re.at[:, 0].add(a_re * s0r - a_im * s0i)
    b_im = b_im.at[:, 0].add(a_re * s0i + a_im * s0r)
    ar = jnp.broadcast_to(a_re, b_re.shape)
    ai = jnp.broadcast_to(a_im, b_im.shape)

    def combine(e1, e2):
        a1r, a1i, b1r, b1i = e1
        a2r, a2i, b2r, b2i = e2
        return (a2r * a1r - a2i * a1i, a2r * a1i + a2i * a1r,
                a2r * b1r - a2i * b1i + b2r, a2r * b1i + a2i * b1r + b2i)

    _, _, h_re, h_im = lax.associative_scan(combine, (ar, ai, b_re, b_im), axis=1)
    y = (jnp.einsum('blgp,ghp->blgh', h_re, p['ssm_c_re'].astype(jnp.float32))
         - jnp.einsum('blgp,ghp->blgh', h_im, p['ssm_c_im'].astype(jnp.float32))
         + p['ssm_d'].astype(jnp.float32) * uf)
    return y.astype(u.dtype), h_re[:, -1], h_im[:, -1]


def parallel_mixer(xn, pos, past_kv, s0_re, s0_im, p):
    B, L, _ = xn.shape
    z = xn @ p['w_in']
    q = z[..., :ATTN_WIDTH].reshape(B, L, N_ATTN_HEADS, HEAD_DIM)
    k = z[..., ATTN_WIDTH:2 * ATTN_WIDTH].reshape(B, L, N_ATTN_HEADS, HEAD_DIM)
    v = z[..., 2 * ATTN_WIDTH:3 * ATTN_WIDTH].reshape(B, L, N_ATTN_HEADS, HEAD_DIM)
    u = z[..., 3 * ATTN_WIDTH:].reshape(B, L, SSM_GROUPS, SSM_GROUP)
    q = rope_partial(rmsnorm(q, p['q_norm']), pos) * (HEAD_DIM ** -0.5)
    k = rope_partial(rmsnorm(k, p['k_norm']), pos)
    outs, lses, new_kv = [], [], []
    for g, (win, dil) in enumerate(ATTN_GROUPS):
        hs = slice(g * HEADS_PER_GROUP, (g + 1) * HEADS_PER_GROUP)
        qg, kg, vg = q[:, :, hs], k[:, :, hs], v[:, :, hs]
        if past_kv is None:
            o, lse = dilated_attn_prompt(qg, kg, vg, win, dil)
            keep = min(win, L)
            new_kv.append(jnp.stack([kg[:, L - keep:], vg[:, L - keep:]], axis=2))
        else:
            buf = past_kv[g]
            k_all = jnp.concatenate([buf[:, :, 0], kg], axis=1)
            v_all = jnp.concatenate([buf[:, :, 1], vg], axis=1)
            o, lse = dilated_attn_sample(qg, k_all, v_all, win, dil, buf.shape[1])
            new_kv.append(jnp.stack([kg, vg], axis=2))
        outs.append(o)
        lses.append(lse)
    alpha = jax.nn.softmax(jnp.stack(lses, axis=2), axis=2)
    attn = (jnp.stack(outs, axis=2) * alpha[..., None].astype(xn.dtype)).reshape(B, L, ATTN_WIDTH)
    y, h_re, h_im = s5_scan(u, s0_re, s0_im, p)
    zs = jax.nn.gelu(y.reshape(B, L, SSM_WIDTH))
    ssm_out = zs * jax.nn.sigmoid(zs @ p['w_glu'] + p['b_glu'])
    mixed = jnp.concatenate([rmsnorm(attn, p['attn_out_norm']), rmsnorm(ssm_out, p['ssm_out_norm'])], axis=-1)
    return mixed @ p['w_out'], new_kv, h_re, h_im


def memory_kv(mem, p):
    B = mem.shape[0]
    kv = (rmsnorm(mem, p['norm_mem']) @ p['w_xkv']).reshape(B, N_MEM, 2, X_HEADS, X_HEAD_DIM)
    return jnp.stack([rmsnorm(kv[:, :, 0], p['xk_norm']), kv[:, :, 1]], axis=2)


def cross_attention(hn, mkv, p):
    B, L, _ = hn.shape
    q = rmsnorm((hn @ p['w_xq']).reshape(B, L, X_HEADS, X_HEAD_DIM), p['xq_norm']) * (X_HEAD_DIM ** -0.5)
    s = jnp.einsum('blhe,bmhe->bhlm', q, mkv[:, :, 0], preferred_element_type=jnp.float32)
    pr = jax.nn.softmax(s, axis=-1)
    o = jnp.einsum('bhlm,bmhe->blhe', pr.astype(hn.dtype), mkv[:, :, 1]).reshape(B, L, D_MODEL)
    return o @ p['w_xo']


def conv_ffn(hn, conv_buf, p):
    up = hn @ p['w_up']
    L = up.shape[1]
    padded = jnp.concatenate([conv_buf.astype(up.dtype), up], axis=1)
    cw = p['conv_w']
    c = p['conv_b'] + sum(cw[i] * padded[:, i:i + L] for i in range(CONV_W))
    gate, val = jnp.split(c, 2, axis=-1)
    return (jax.nn.silu(gate) * val) @ p['w_down'], padded[:, -(CONV_W - 1):]


def decoder_layer(x, pos, past_kv, s0_re, s0_im, conv_buf, mkv, p):
    mix, new_kv, h_re, h_im = parallel_mixer(rmsnorm(x, p['norm_mix']), pos, past_kv, s0_re, s0_im, p)
    h = x + mix
    h = h + cross_attention(rmsnorm(h, p['norm_x']), mkv, p)
    f, new_conv = conv_ffn(rmsnorm(h, p['norm_ffn']), conv_buf, p)
    return h + f, new_kv, h_re, h_im, new_conv


def setup_inputs(seed: int = 0) -> dict:
    key = jax.random.key(seed)
    ks = iter(jax.random.split(key, 64))
    f32 = jnp.float32

    def nrm(shape, scale):
        return scale * jax.random.normal(next(ks), shape, f32)

    def gain(shape):
        return 1.0 + 0.02 * jax.random.normal(next(ks), shape, f32)

    bufs = [min(w, PAST_LEN) for w, _ in ATTN_GROUPS]
    G, P, H = SSM_GROUPS, SSM_STATE, SSM_GROUP
    lam_im = jnp.pi * jnp.broadcast_to(jnp.arange(P, dtype=f32), (DEPTH, G, P))
    return {
        'x_prompt': nrm((BATCH, SEQ, D_MODEL), 1.0),
        'x_sample': nrm((DEC_BATCH, DEC_SEQ, D_MODEL), 1.0),
        'mem_prompt': nrm((BATCH, N_MEM, D_MODEL), 1.0),
        'cache_kv_dil1': nrm((DEPTH, DEC_BATCH, bufs[0], 2, HEADS_PER_GROUP, HEAD_DIM), 1.0),
        'cache_kv_dil4': nrm((DEPTH, DEC_BATCH, bufs[1], 2, HEADS_PER_GROUP, HEAD_DIM), 1.0),
        'cache_kv_dil16': nrm((DEPTH, DEC_BATCH, bufs[2], 2, HEADS_PER_GROUP, HEAD_DIM), 1.0),
        'state_ssm_re': nrm((DEPTH, DEC_BATCH, G, P), 0.5),
        'state_ssm_im': nrm((DEPTH, DEC_BATCH, G, P), 0.5),
        'state_ffn_conv': nrm((DEPTH, DEC_BATCH, CONV_W - 1, 2 * D_FF), 1.0),
        'cache_mem_kv': nrm((DEPTH, DEC_BATCH, N_MEM, 2, X_HEADS, X_HEAD_DIM), 1.0),
        'norm_mix': gain((DEPTH, D_MODEL)),
        'w_in': nrm((DEPTH, D_MODEL, IN_WIDTH), D_MODEL ** -0.5),
        'q_norm': gain((DEPTH, HEAD_DIM)),
        'k_norm': gain((DEPTH, HEAD_DIM)),
        'ssm_lam_re': -0.5 + nrm((DEPTH, G, P), 0.01),
        'ssm_lam_im': lam_im + nrm((DEPTH, G, P), 0.01),
        'ssm_log_dt': jax.random.uniform(next(ks), (DEPTH, G), f32, math.log(1e-3), math.log(1e-1)),
        'ssm_b_re': nrm((DEPTH, G, P, H), (2 * H) ** -0.5),
        'ssm_b_im': nrm((DEPTH, G, P, H), (2 * H) ** -0.5),
        'ssm_c_re': nrm((DEPTH, G, H, P), P ** -0.5),
        'ssm_c_im': nrm((DEPTH, G, H, P), P ** -0.5),
        'ssm_d': nrm((DEPTH, G, H), 1.0),
        'w_glu': nrm((DEPTH, SSM_WIDTH, SSM_WIDTH), SSM_WIDTH ** -0.5),
        'b_glu': nrm((DEPTH, SSM_WIDTH), 0.01),
        'attn_out_norm': gain((DEPTH, ATTN_WIDTH)),
        'ssm_out_norm': gain((DEPTH, SSM_WIDTH)),
        'w_out': nrm((DEPTH, D_MODEL, D_MODEL), D_MODEL ** -0.5),
        'norm_x': gain((DEPTH, D_MODEL)),
        'norm_mem': gain((DEPTH, D_MODEL)),
        'w_xq': nrm((DEPTH, D_MODEL, D_MODEL), D_MODEL ** -0.5),
        'w_xkv': nrm((DEPTH, D_MODEL, 2 * D_MODEL), D_MODEL ** -0.5),
        'xq_norm': gain((DEPTH, X_HEAD_DIM)),
        'xk_norm': gain((DEPTH, X_HEAD_DIM)),
        'w_xo': nrm((DEPTH, D_MODEL, D_MODEL), D_MODEL ** -0.5),
        'norm_ffn': gain((DEPTH, D_MODEL)),
        'w_up': nrm((DEPTH, D_MODEL, 2 * D_FF), D_MODEL ** -0.5),
        'conv_w': nrm((DEPTH, CONV_W, 2 * D_FF), CONV_W ** -0.5),
        'conv_b': nrm((DEPTH, 2 * D_FF), 0.01),
        'w_down': nrm((DEPTH, D_FF, D_MODEL), D_FF ** -0.5),
    }


def reference(x_prompt, x_sample, mem_prompt, cache_kv_dil1, cache_kv_dil4, cache_kv_dil16,
              state_ssm_re, state_ssm_im, state_ffn_conv, cache_mem_kv,
              norm_mix, w_in, q_norm, k_norm, ssm_lam_re, ssm_lam_im, ssm_log_dt,
              ssm_b_re, ssm_b_im, ssm_c_re, ssm_c_im, ssm_d, w_glu, b_glu,
              attn_out_norm, ssm_out_norm, w_out, norm_x, norm_mem, w_xq, w_xkv,
              xq_norm, xk_norm, w_xo, norm_ffn, w_up, conv_w, conv_b, w_down):
    Bp, Lp = x_prompt.shape[0], x_prompt.shape[1]
    pos_p = jnp.arange(Lp)
    pos_s = PAST_LEN + jnp.arange(x_sample.shape[1])
    yp, ys = x_prompt, x_sample
    n_g = len(ATTN_GROUPS)
    kv_p = [[] for _ in range(n_g)]
    kv_s = [[] for _ in range(n_g)]
    re_p, im_p, conv_p, mem_p = [], [], [], []
    re_s, im_s, conv_s = [], [], []
    for l in range(DEPTH):
        p = dict(norm_mix=norm_mix[l], w_in=w_in[l], q_norm=q_norm[l], k_norm=k_norm[l],
                 ssm_lam_re=ssm_lam_re[l], ssm_lam_im=ssm_lam_im[l], ssm_log_dt=ssm_log_dt[l],
                 ssm_b_re=ssm_b_re[l], ssm_b_im=ssm_b_im[l], ssm_c_re=ssm_c_re[l], ssm_c_im=ssm_c_im[l],
                 ssm_d=ssm_d[l], w_glu=w_glu[l], b_glu=b_glu[l], attn_out_norm=attn_out_norm[l],
                 ssm_out_norm=ssm_out_norm[l], w_out=w_out[l], norm_x=norm_x[l], norm_mem=norm_mem[l],
                 w_xq=w_xq[l], w_xkv=w_xkv[l], xq_norm=xq_norm[l], xk_norm=xk_norm[l], w_xo=w_xo[l],
                 norm_ffn=norm_ffn[l], w_up=w_up[l], conv_w=conv_w[l], conv_b=conv_b[l], w_down=w_down[l])
        mkv_p = memory_kv(mem_prompt, p)
        s0 = jnp.zeros((Bp, SSM_GROUPS, SSM_STATE), jnp.float32)
        cb0 = jnp.zeros((Bp, CONV_W - 1, 2 * D_FF), yp.dtype)
        yp, nkv, hr, hi, nc = decoder_layer(yp, pos_p, None, s0, s0, cb0, mkv_p, p)
        for g in range(n_g):
            kv_p[g].append(nkv[g])
        re_p.append(hr)
        im_p.append(hi)
        conv_p.append(nc)
        mem_p.append(mkv_p)
        past = (cache_kv_dil1[l], cache_kv_dil4[l], cache_kv_dil16[l])
        ys, nkv, hr, hi, nc = decoder_layer(ys, pos_s, past, state_ssm_re[l], state_ssm_im[l],
                                            state_ffn_conv[l], cache_mem_kv[l], p)
        for g in range(n_g):
            kv_s[g].append(nkv[g])
        re_s.append(hr)
        im_s.append(hi)
        conv_s.append(nc)
    kvp = [jnp.stack(a) for a in kv_p]
    kvs = [jnp.stack(a) for a in kv_s]
    return (yp, ys,
            kvp[0], kvp[1], kvp[2], jnp.stack(re_p), jnp.stack(im_p), jnp.stack(conv_p), jnp.stack(mem_p),
            kvs[0], kvs[1], kvs[2], jnp.stack(re_s), jnp.stack(im_s), jnp.stack(conv_s))
```

```cpp
#include <hip/hip_runtime.h>
#include <cstdio>
#include <cstdint>

#define GAS __attribute__((address_space(1)))
#define LAS __attribute__((address_space(3)))
#define PG8_LAS __attribute__((address_space(3)))
typedef unsigned short bf16;
typedef short bf16x8 __attribute__((ext_vector_type(8)));
typedef float f32x4 __attribute__((ext_vector_type(4)));
typedef float f32x2 __attribute__((ext_vector_type(2)));
typedef float f32x16 __attribute__((ext_vector_type(16)));
typedef unsigned u32x4 __attribute__((ext_vector_type(4)));
typedef unsigned u32x2 __attribute__((ext_vector_type(2)));
typedef GAS unsigned gu32;
#define RLX_AGENT __ATOMIC_RELAXED, __HIP_MEMORY_SCOPE_AGENT
#define LDS_WAIT() asm volatile("s_waitcnt lgkmcnt(0)" ::: "memory")
#define VM_WAIT() asm volatile("s_waitcnt vmcnt(0)" ::: "memory")

constexpr int D = 1024, BP = 8, LP = 2048, MP = BP * LP, BS = 128, TS = 4, MS = BS * TS, MT = MP + MS;
constexpr int INW = 2560, AW = 768, SW = 256, NMEM = 256, MM = BP * NMEM, FF = 2816, FF2 = 5632;
constexpr float EPS = 1e-6f;
constexpr float LOG2E = 1.4426950408889634f, LN2 = 0.6931471805599453f;
constexpr int NWAVES = 8;

constexpr size_t MiB = 1u << 20;
constexpr size_t WS_CTL = 0, CTL_ZERO_BYTES = 1 * MiB;
constexpr size_t WS_ROPE = 1 * MiB;
constexpr size_t WS_SSMC = 1 * MiB + 512 * 1024;
constexpr size_t WS_WIN = 2 * MiB, WS_WOUT = 7 * MiB, WS_WXQ = 9 * MiB, WS_WXKV = 11 * MiB, WS_WXO = 15 * MiB, WS_WUP = 17 * MiB, WS_WDOWN = 28 * MiB, WS_WGLU = 34 * MiB;
constexpr size_t WS_XN = 35 * MiB, WS_MEMN = 68 * MiB, WS_Q = 72 * MiB, WS_K = 97 * MiB, WS_VT = 122 * MiB, WS_U = 146 * MiB, WS_AO = 163 * MiB, WS_LSE = 188 * MiB;
constexpr size_t WS_SSMF = 189 * MiB, WS_MIXED = 191 * MiB, WS_H1B = 224 * MiB, WS_SS1 = 257 * MiB, WS_QX = 259 * MiB, WS_QSS = 292 * MiB, WS_MSS = 294 * MiB, WS_MEMK = 295 * MiB, WS_MVT = 299 * MiB;
constexpr size_t WS_OX = 303 * MiB, WS_H2B = 336 * MiB, WS_SS2 = 369 * MiB, WS_UP = 371 * MiB, WS_ACT = 553 * MiB, WS_END = 644 * MiB;
constexpr size_t WS_EDGE = 371 * MiB;
constexpr size_t WS_SS1S = 258 * MiB + 512 * 1024, WS_QSSS = 293 * MiB + 512 * 1024, WS_SS2S = 370 * MiB + 512 * 1024;
constexpr size_t CTL_RS1 = 128 * 1024, CTL_RS2 = 256 * 1024, CTL_QS = 384 * 1024;
constexpr int CW_BAR = 4096;

constexpr int RING_BYTES = 131072;
constexpr int MISC_OFF = 135168;
constexpr int LDS_BYTES = 147456;

__device__ __forceinline__ unsigned f2bf(float f) { unsigned u = __builtin_bit_cast(unsigned, f); return (u + 0x7fffu + ((u >> 16) & 1u)) >> 16; }
__device__ __forceinline__ unsigned pk2(float lo, float hi) { return f2bf(lo) | (f2bf(hi) << 16); }
__device__ __forceinline__ float bf2f(unsigned h) { return __builtin_bit_cast(float, h << 16); }
typedef __bf16 bf16v2_t __attribute__((ext_vector_type(2)));
__device__ __forceinline__ unsigned cvt_pk_bf16(float lo, float hi) { const f32x2 v = {lo, hi}; return __builtin_bit_cast(unsigned, __builtin_convertvector(v, bf16v2_t)); }
__device__ __forceinline__ bf16x8 pack8(float a0, float a1, float a2, float a3, float a4, float a5, float a6, float a7) {
    u32x4 w; w.x = cvt_pk_bf16(a0, a1); w.y = cvt_pk_bf16(a2, a3); w.z = cvt_pk_bf16(a4, a5); w.w = cvt_pk_bf16(a6, a7); return __builtin_bit_cast(bf16x8, w); }
__device__ __forceinline__ float wave_sum(float v) {
#pragma unroll
    for (int o = 1; o < 64; o <<= 1) v += __shfl_xor(v, o);
    return v;
}
__device__ __forceinline__ float fexp2(float x) { return __builtin_amdgcn_exp2f(x); }
__device__ __forceinline__ float flog2(float x) { return __builtin_amdgcn_logf(x); }
__device__ __forceinline__ float frcp(float x) { return __builtin_amdgcn_rcpf(x); }
__device__ __forceinline__ float frsq(float x) { return __builtin_amdgcn_rsqf(x); }
__device__ __forceinline__ void sincos_d(double x, double& s, double& c) {
    const double k = __builtin_rint(x * 0.63661977236758134308);
    double r = __builtin_fma(-k, 1.57079632679489655800e+00, x); r = __builtin_fma(-k, 6.12323399573676603587e-17, r);
    const long long q = (long long)k; const double r2 = r * r;
    double sp = 1.0 / 6227020800.0; sp = sp * r2 - 1.0 / 39916800.0; sp = sp * r2 + 1.0 / 362880.0; sp = sp * r2 - 1.0 / 5040.0; sp = sp * r2 + 1.0 / 120.0; sp = sp * r2 - 1.0 / 6.0; sp = sp * r2 + 1.0; sp = sp * r;
    double cp = -1.0 / 87178291200.0; cp = cp * r2 + 1.0 / 479001600.0; cp = cp * r2 - 1.0 / 3628800.0; cp = cp * r2 + 1.0 / 40320.0; cp = cp * r2 - 1.0 / 720.0; cp = cp * r2 + 1.0 / 24.0; cp = cp * r2 - 0.5; cp = cp * r2 + 1.0;
    const int qq = (int)(q & 3);
    s = (qq == 0) ? sp : (qq == 1) ? cp : (qq == 2) ? -sp : -cp;
    c = (qq == 0) ? cp : (qq == 1) ? -sp : (qq == 2) ? -cp : sp;
}
__device__ __forceinline__ double exp_d(double x) {
    const double k = __builtin_rint(x * 1.44269504088896340736);
    double r = __builtin_fma(-k, 6.93147180369123816490e-01, x); r = __builtin_fma(-k, 1.90821492927058770002e-10, r);
    double p = 1.0 / 6227020800.0;
    p = p * r + 1.0 / 479001600.0; p = p * r + 1.0 / 39916800.0; p = p * r + 1.0 / 3628800.0; p = p * r + 1.0 / 362880.0; p = p * r + 1.0 / 40320.0; p = p * r + 1.0 / 5040.0;
    p = p * r + 1.0 / 720.0; p = p * r + 1.0 / 120.0; p = p * r + 1.0 / 24.0; p = p * r + 1.0 / 6.0; p = p * r + 0.5; p = p * r + 1.0; p = p * r + 1.0;
    const int ki = (int)k;
    return __builtin_ldexp(p, ki);
}
__device__ __forceinline__ float dot4(f32x4 a) { return (a[0] * a[0] + a[1] * a[1]) + (a[2] * a[2] + a[3] * a[3]); }
__device__ __forceinline__ u32x4 pk8(f32x4 a, f32x4 b) { u32x4 w; w.x = cvt_pk_bf16(a[0], a[1]); w.y = cvt_pk_bf16(a[2], a[3]); w.z = cvt_pk_bf16(b[0], b[1]); w.w = cvt_pk_bf16(b[2], b[3]); return w; }
__device__ __forceinline__ f32x4 shx16(f32x4 a) { f32x4 r; r[0] = __shfl_xor(a[0], 16); r[1] = __shfl_xor(a[1], 16); r[2] = __shfl_xor(a[2], 16); r[3] = __shfl_xor(a[3], 16); return r; }
constexpr size_t O_KV1P_ = (size_t)MT * D, O_KV4P_ = O_KV1P_ + (size_t)BP * 128 * 512, O_KV16P_ = O_KV4P_ + (size_t)BP * 512 * 512;
constexpr size_t O_KV1S_ = O_KV16P_ + (size_t)BP * 2048 * 512 + 2 * BP * 1024 + (size_t)BP * 2 * FF2 + (size_t)MM * 2048, O_KV4S_ = O_KV1S_ + (size_t)MS * 512, O_KV16S_ = O_KV4S_ + (size_t)MS * 512;
typedef short s16x4 __attribute__((ext_vector_type(4)));
__device__ __forceinline__ s16x4 lds_tr4(LAS unsigned char* p) { return __builtin_bit_cast(s16x4, __builtin_amdgcn_ds_read_tr16_b64_v4i16((LAS s16x4*)p)); }
__device__ __forceinline__ bf16x8 cat44(s16x4 a, s16x4 b) { return (bf16x8){a[0], a[1], a[2], a[3], b[0], b[1], b[2], b[3]}; }
__device__ __forceinline__ void atomic_addf(float* p, float v) { (void)__hip_atomic_fetch_add(p, v, __ATOMIC_RELAXED, __HIP_MEMORY_SCOPE_AGENT); }

namespace pg8 {
#define PG8_LAS __attribute__((address_space(3)))
typedef unsigned short bf16_t;
typedef short bf16x8 __attribute__((ext_vector_type(8)));
typedef float f32x4 __attribute__((ext_vector_type(4)));
typedef unsigned u32x4 __attribute__((ext_vector_type(4)));
constexpr int BM = 256, BK = 64, HALF = 128, HTB = HALF * BK * 2  , STAGE_BYTES = 8 * HTB, NXCD = 8, WGM = 8;

__host__ __device__ __forceinline__ int lds_byte(int r, int c) { const int st = (r >> 4) * 2 + (c >> 5), rr = r & 15, cc = c & 31, ob = rr * 64 + cc * 2; return st * 1024 + (ob ^ (((ob >> 9) & 1) << 5)); }
__host__ __device__ __forceinline__ void stage_rc(int b, int& R, int& C) { const int st = b / 1024, sb = b % 1024, swz = sb ^ (((sb >> 9) & 1) << 5); R = (st >> 1) * 16 + swz / 64; C = (st & 1) * 32 + (swz % 64) / 2; }
__host__ __device__ __forceinline__ int perm32(int rho) { const int n = rho >> 4, i = rho & 15; return 8 * (i >> 2) + 4 * n + (i & 3); }

struct Unit { int pm, pn; };
struct Gemm { const bf16_t* A; const bf16_t* Bt; int M, N, K; };

struct StaticOrder {
    int nM, nN, nwg, G, c;
    __host__ __device__ void init(int M, int N, int G_, int c_) { nM = M / BM; nN = N / BM; nwg = nM * nN; G = G_; c = c_; }
    __host__ __device__ bool next(int i, Unit& u) const {
        const long L = (long)i * G + c; if (L >= nwg) return false;
        int wgid = (int)L; { const int q = nwg / NXCD, r = nwg % NXCD, xcd = wgid % NXCD, off = wgid / NXCD; wgid = (xcd < r ? xcd * (q + 1) : r * (q + 1) + (xcd - r) * q) + off; }
        const int nig = WGM * nN, gid = wgid / nig, fm = gid * WGM, gsz = (nM - fm) < WGM ? (nM - fm) : WGM;
        u.pm = fm + ((wgid % nig) % gsz); u.pn = (wgid % nig) / gsz; return true;
    }
    __device__ __forceinline__ void a_ready(const Unit&) const {}
    __device__ __forceinline__ void done(const Unit&) const {}
};


struct RotOrder {
    int nM, nN, nwg, G, c;
    __host__ __device__ void init(int M, int N, int G_, int blk, int base) { nM = M / BM; nN = N / BM; nwg = nM * nN; G = G_; const int rot = base % G_; c = blk - rot; if (c < 0) c += G_; }
    __host__ __device__ __forceinline__ bool next(int i, Unit& u) const {
        const long L = (long)i * G + c; if (L >= nwg) return false;
        int wgid = (int)L; { const int q = nwg / NXCD, r = nwg % NXCD, xcd = wgid % NXCD, off = wgid / NXCD; wgid = (xcd < r ? xcd * (q + 1) : r * (q + 1) + (xcd - r) * q) + off; }
        const int nig = WGM * nN, gid = wgid / nig, fm = gid * WGM, gsz = (nM - fm) < WGM ? (nM - fm) : WGM;
        u.pm = fm + ((wgid % nig) % gsz); u.pn = (wgid % nig) / gsz; return true;
    }
    __device__ __forceinline__ void a_ready(const Unit&) const {}
    __device__ __forceinline__ void done(const Unit&) const {}
};


struct EpiZ {
    static constexpr bool PERM = true, AFTER_DRAIN = false, BMAP = false, AMAP = false;
    bf16_t* Q; bf16_t* Kb; bf16_t* VN; float* U; const float* rope; const float* qg; const float* kg;
    float* outp;
    __device__ __forceinline__ int bmap(int r) const { return r; }
    __device__ __forceinline__ void operator()(const f32x4 (&acc)[2][2][4][2], const Unit& u, int wr, int wc, int fr, int fq) const {
        const int pn = u.pn; const bool sample = u.pm >= 64;
        const int rbase = u.pm * BM + wr * 64 + fr;
        if (pn == 9) {
#pragma unroll
            for (int ai = 0; ai < 2; ++ai)
#pragma unroll
                for (int m = 0; m < 4; ++m) { const int R = rbase + ai * HALF + m * 16; float* p = U + (size_t)R * 256 + wc * 64 + 8 * fq;
#pragma unroll
                    for (int bj = 0; bj < 2; ++bj) { *(f32x4*)(p + 32 * bj) = acc[ai][bj][m][0]; *(f32x4*)(p + 32 * bj + 4) = acc[ai][bj][m][1]; } }
            return;
        }
        const int kind = pn / 3, g = pn - 3 * kind;
        const int keep = g == 0 ? 128 : (g == 1 ? 512 : 2048);
        float* kvp = outp + (g == 0 ? O_KV1P_ : (g == 1 ? O_KV4P_ : O_KV16P_)); float* kvs = outp + (g == 0 ? O_KV1S_ : (g == 1 ? O_KV4S_ : O_KV16S_));
        if (kind == 2) {
#pragma unroll
            for (int ai = 0; ai < 2; ++ai)
#pragma unroll
                for (int m = 0; m < 4; ++m) { const int R = rbase + ai * HALF + m * 16; float* dst = nullptr;
                    if (sample) dst = kvs + ((size_t)(R - MP) * 2 + 1) * 256;
                    else { const int b = R >> 11, t = R & 2047; if (t >= 2048 - keep) dst = kvp + ((size_t)(b * keep + t - (2048 - keep)) * 2 + 1) * 256; }
                    if (dst) { dst += wc * 64 + 8 * fq;
#pragma unroll
                        for (int bj = 0; bj < 2; ++bj) { *(f32x4*)(dst + 32 * bj) = acc[ai][bj][m][0]; *(f32x4*)(dst + 32 * bj + 4) = acc[ai][bj][m][1]; } }
                    if (!sample) { bf16_t* vp = VN + (size_t)R * AW + g * 256 + wc * 64 + 8 * fq;
                        *(u32x4*)vp = pk8(acc[ai][0][m][0], acc[ai][0][m][1]); *(u32x4*)(vp + 32) = pk8(acc[ai][1][m][0], acc[ai][1][m][1]); } }
            return;
        }
        const float* gp = (kind == 0 ? qg : kg) + 8 * fq;
        const f32x4 g00 = *(const f32x4*)(gp), g01 = *(const f32x4*)(gp + 4), g10 = *(const f32x4*)(gp + 32), g11 = *(const f32x4*)(gp + 36);
        const float sgn = fq == 0 ? -1.f : 1.f;
        const float qs = kind == 0 ? 0.125f * LOG2E : 1.f;
        bf16_t* ob = kind == 0 ? Q : Kb;
        f32x4 rc0, rc1, rs0, rs1;
        { const int R = rbase; const int pos = sample ? 2048 + (R & 3) : (R & 2047); const float* rp = rope + (size_t)pos * 16; rc0 = *(const f32x4*)rp; rc1 = *(const f32x4*)(rp + 4); rs0 = *(const f32x4*)(rp + 8); rs1 = *(const f32x4*)(rp + 12); }
#pragma unroll
        for (int ai = 0; ai < 2; ++ai)
#pragma unroll
            for (int m = 0; m < 4; ++m) { const int R = rbase + ai * HALF + m * 16;
                const f32x4 c0 = rc0, c1 = rc1, s0 = rs0, s1 = rs1;
                if (ai * 4 + m < 7) { const int Rn = rbase + ((ai * 4 + m + 1) >> 2) * HALF + ((ai * 4 + m + 1) & 3) * 16; const int pos = sample ? 2048 + (Rn & 3) : (Rn & 2047); const float* rp = rope + (size_t)pos * 16;
                    rc0 = *(const f32x4*)rp; rc1 = *(const f32x4*)(rp + 4); rs0 = *(const f32x4*)(rp + 8); rs1 = *(const f32x4*)(rp + 12); }
                float ss = (dot4(acc[ai][0][m][0]) + dot4(acc[ai][0][m][1])) + (dot4(acc[ai][1][m][0]) + dot4(acc[ai][1][m][1])); ss += __shfl_xor(ss, 16); ss += __shfl_xor(ss, 32);
                const float rs = frsq(ss * (1.0f / 64.0f) + EPS);
                float* dst = nullptr;
                if (kind == 1) { if (sample) dst = kvs + ((size_t)(R - MP) * 2) * 256; else { const int b = R >> 11, t = R & 2047; if (t >= 2048 - keep) dst = kvp + ((size_t)(b * keep + t - (2048 - keep)) * 2) * 256; }
                    if (dst) dst += wc * 64 + 8 * fq; }
                bf16_t* op = ob + (size_t)R * AW + g * 256 + wc * 64 + 8 * fq;
                f32x4 xa = acc[ai][0][m][0] * rs * g00, xb = acc[ai][0][m][1] * rs * g01;
                { const f32x4 oa = shx16(xa), ob2 = shx16(xb);
                  if (fq < 2) { xa = xa * c0 + (oa * s0) * sgn; xb = xb * c1 + (ob2 * s1) * sgn; } }
                if (dst) { *(f32x4*)(dst) = xa; *(f32x4*)(dst + 4) = xb; }
                *(u32x4*)(op) = pk8(xa * qs, xb * qs);
                xa = acc[ai][1][m][0] * rs * g10; xb = acc[ai][1][m][1] * rs * g11;
                if (dst) { *(f32x4*)(dst + 32) = xa; *(f32x4*)(dst + 36) = xb; }
                *(u32x4*)(op + 32) = pk8(xa * qs, xb * qs);
            }
    }
};

struct EpiVt {
    static constexpr bool PERM = true, AFTER_DRAIN = false, BMAP = true, AMAP = false;
    bf16_t* VT; int g;
    __device__ __forceinline__ int bmap(int r) const { return g == 0 ? r : (g == 1 ? ((r & 63) * 4 + (r >> 6)) : ((r & 15) * 16 + (r >> 4))); }
    __device__ __forceinline__ void operator()(const f32x4 (&acc)[2][2][4][2], const Unit& u, int wr, int wc, int fr, int fq) const {
        const int b = u.pn >> 3, t0 = (u.pn & 7) * 256, sh = 2 * g, S = 2048 >> sh, Wl = 8 - sh;
#pragma unroll
        for (int ai = 0; ai < 2; ++ai)
#pragma unroll
            for (int m = 0; m < 4; ++m) { const int hh = 2 * wr + (m >> 1), d = 32 * ai + 16 * (m & 1) + fr;
#pragma unroll
                for (int bj = 0; bj < 2; ++bj) { const int c8 = 128 * bj + 32 * wc + 8 * fq, res = c8 >> Wl, ds = c8 & ((1 << Wl) - 1), pos = res * S + (t0 >> sh) + ds;
                    bf16_t* p = VT + ((((size_t)((g * 4 + hh) * 8 + b) * 64 + (pos >> 5)) * 64 + d) * 32 + (pos & 31));
                    *(u32x4*)p = pk8(acc[ai][bj][m][0], acc[ai][bj][m][1]); } }
    }
};

struct EpiMem {
    static constexpr bool PERM = true, AFTER_DRAIN = false, BMAP = false, AMAP = false;
    float* out; float* mss; bf16_t* MVN;
    __device__ __forceinline__ int bmap(int r) const { return r; }
    __device__ __forceinline__ void operator()(const f32x4 (&acc)[2][2][4][2], const Unit& u, int wr, int wc, int fr, int fq) const {
        const int kv = u.pn >> 2, h = u.pn & 3;
#pragma unroll
        for (int ai = 0; ai < 2; ++ai)
#pragma unroll
            for (int m = 0; m < 4; ++m) { const int R = u.pm * BM + ai * HALF + wr * 64 + m * 16 + fr; float* dst = out + ((size_t)R * 2 + kv) * 1024 + h * 256 + 32 * wc + 8 * fq; float ss = 0.f;
#pragma unroll
                for (int bj = 0; bj < 2; ++bj) { const f32x4 a = acc[ai][bj][m][0], c = acc[ai][bj][m][1]; *(f32x4*)(dst + 128 * bj) = a; *(f32x4*)(dst + 128 * bj + 4) = c; ss += dot4(a) + dot4(c);
                    if (kv) *(u32x4*)(MVN + (size_t)R * 1024 + h * 256 + 32 * wc + 8 * fq + 128 * bj) = pk8(a, c); }
                if (kv == 0) { ss += __shfl_xor(ss, 16); ss += __shfl_xor(ss, 32); if (fq == 0) mss[(size_t)R * 16 + h * 4 + wc] = ss; } }
    }
};
struct EpiMemVt {
    static constexpr bool PERM = true, AFTER_DRAIN = false, BMAP = false, AMAP = false;
    bf16_t* MVT;
    __device__ __forceinline__ int bmap(int r) const { return r; }
    __device__ __forceinline__ void operator()(const f32x4 (&acc)[2][2][4][2], const Unit& u, int wr, int wc, int fr, int fq) const {
        const int h = u.pm, b = u.pn;
#pragma unroll
        for (int ai = 0; ai < 2; ++ai)
#pragma unroll
            for (int m = 0; m < 4; ++m) { const int d = ai * HALF + wr * 64 + m * 16 + fr;
#pragma unroll
                for (int bj = 0; bj < 2; ++bj) { const int c8 = 128 * bj + 32 * wc + 8 * fq;
                    bf16_t* p = MVT + ((((size_t)(h * 8 + b) * 8 + (c8 >> 5)) * 256 + d) * 32 + (c8 & 31));
                    *(u32x4*)p = pk8(acc[ai][bj][m][0], acc[ai][bj][m][1]); } }
    }
};
template <bool BASE_BF16, bool OUT_F32> struct EpiRes {
    static constexpr bool PERM = true, AFTER_DRAIN = false, BMAP = false, AMAP = false;
    const void* base; float* out; bf16_t* hb; float* ssq;
    __device__ __forceinline__ int bmap(int r) const { return r; }
    __device__ __forceinline__ void operator()(const f32x4 (&acc)[2][2][4][2], const Unit& u, int wr, int wc, int fr, int fq) const {
        const int c0 = u.pn * BM + 32 * wc + 8 * fq;
#pragma unroll
        for (int ai = 0; ai < 2; ++ai) {
            f32x4 b0[4][2], b1[4][2];
#pragma unroll
            for (int m = 0; m < 4; ++m)
#pragma unroll
                for (int bj = 0; bj < 2; ++bj) { const size_t off = (size_t)(u.pm * BM + ai * HALF + wr * 64 + m * 16 + fr) * D + c0 + 128 * bj;
                    if (BASE_BF16) { const u32x4 w = *(const u32x4*)((const bf16_t*)base + off); b0[m][bj] = (f32x4){bf2f(w.x & 0xffffu), bf2f(w.x >> 16), bf2f(w.y & 0xffffu), bf2f(w.y >> 16)}; b1[m][bj] = (f32x4){bf2f(w.z & 0xffffu), bf2f(w.z >> 16), bf2f(w.w & 0xffffu), bf2f(w.w >> 16)}; }
                    else { b0[m][bj] = *(const f32x4*)((const float*)base + off); b1[m][bj] = *(const f32x4*)((const float*)base + off + 4); } }
            asm volatile("" ::: "memory");
#pragma unroll
            for (int m = 0; m < 4; ++m) { const int R = u.pm * BM + ai * HALF + wr * 64 + m * 16 + fr; float ss = 0.f;
#pragma unroll
                for (int bj = 0; bj < 2; ++bj) { const size_t off = (size_t)R * D + c0 + 128 * bj;
                    const f32x4 o0 = b0[m][bj] + acc[ai][bj][m][0], o1 = b1[m][bj] + acc[ai][bj][m][1];
                    if (OUT_F32) { *(f32x4*)(out + off) = o0; *(f32x4*)(out + off + 4) = o1; }
                    if (hb) *(u32x4*)(hb + off) = pk8(o0, o1);
                    ss += dot4(o0) + dot4(o1); }
                if (ssq) { ss += __shfl_xor(ss, 16); ss += __shfl_xor(ss, 32); if (fq == 0) atomic_addf(ssq + R, ss); } }
        }
    }
};
struct EpiQx {
    static constexpr bool PERM = true, AFTER_DRAIN = false, BMAP = false, AMAP = false;
    bf16_t* QX; float* qss;
    __device__ __forceinline__ int bmap(int r) const { return r; }
    __device__ __forceinline__ void operator()(const f32x4 (&acc)[2][2][4][2], const Unit& u, int wr, int wc, int fr, int fq) const {
        const int c0 = u.pn * BM + 32 * wc + 8 * fq;
#pragma unroll
        for (int ai = 0; ai < 2; ++ai)
#pragma unroll
            for (int m = 0; m < 4; ++m) { const int R = u.pm * BM + ai * HALF + wr * 64 + m * 16 + fr; float ss = 0.f;
#pragma unroll
                for (int bj = 0; bj < 2; ++bj) { const f32x4 a = acc[ai][bj][m][0], c = acc[ai][bj][m][1]; *(u32x4*)(QX + (size_t)R * D + c0 + 128 * bj) = pk8(a, c); ss += dot4(a) + dot4(c); }
                ss += __shfl_xor(ss, 16); ss += __shfl_xor(ss, 32); if (fq == 0) atomic_addf(qss + (size_t)R * 4 + u.pn, ss); }
    }
};
template <int CTRL> __device__ __forceinline__ float dppf(float old, float src) { return __builtin_bit_cast(float, __builtin_amdgcn_update_dpp(__builtin_bit_cast(int, old), __builtin_bit_cast(int, src), CTRL, 0xf, 0xf, false)); }
__device__ __forceinline__ f32x4 prev_rows1(f32x4 pg, f32x4 cur) { f32x4 r;
#pragma unroll
    for (int e = 0; e < 4; ++e) r[e] = dppf<0x111>(dppf<0x121>(0.f, pg[e]), cur[e]);
    return r; }
__device__ __forceinline__ f32x4 prev_rows2(f32x4 pg, f32x4 cur) { f32x4 r;
#pragma unroll
    for (int e = 0; e < 4; ++e) r[e] = dppf<0x112>(dppf<0x122>(0.f, pg[e]), cur[e]);
    return r; }
__device__ __forceinline__ float silu_(float x) { return x * frcp(1.0f + fexp2(-x * LOG2E)); }
constexpr int HALO_OFF = 135680;
struct EpiUpConv {
    static constexpr bool PERM = true, AFTER_DRAIN = false, BMAP = false, AMAP = true;
    bf16_t* ACT; float* EDGE; const float* rs2; const float* cw; const float* cb; const float* sconv; float* convp; float* convs; PG8_LAS unsigned char* lds;
    __device__ __forceinline__ int bmap(int r) const { return r; }
    __device__ __forceinline__ int amap(int r) const { return (r & 64) + 4 * (r & 15) + ((r >> 4) & 3); }
    __device__ __forceinline__ void operator()(f32x4 (&acc)[2][2][4][2], const Unit& u, int wr, int wc, int fr, int fq) const {
        const bool smp = u.pm >= 64;
        const int j8 = u.pn * 128 + 32 * wc + 8 * fq;
        f32x4 cwv[8];
#define UPC_LOADW(n_) do { const int j4_ = j8 + 4 * (n_); cwv[0] = *(const f32x4*)(cw + j4_); cwv[1] = *(const f32x4*)(cw + FF2 + j4_); cwv[2] = *(const f32x4*)(cw + 2 * FF2 + j4_); cwv[3] = *(const f32x4*)(cb + j4_); \
        cwv[4] = *(const f32x4*)(cw + FF + j4_); cwv[5] = *(const f32x4*)(cw + FF2 + FF + j4_); cwv[6] = *(const f32x4*)(cw + 2 * FF2 + FF + j4_); cwv[7] = *(const f32x4*)(cb + FF + j4_); } while (0)
        UPC_LOADW(0);
        const int tok0 = u.pm * BM + wr * 64 + 4 * fr;
        { float tot[2][4];
#pragma unroll
          for (int ai = 0; ai < 2; ++ai)
#pragma unroll
              for (int m = 0; m < 4; ++m) tot[ai][m] = rs2[tok0 + ai * HALF + m];
#pragma unroll
          for (int ai = 0; ai < 2; ++ai)
#pragma unroll
              for (int m = 0; m < 4; ++m) { const float rstd = frsq(tot[ai][m] * (1.0f / 1024.0f) + EPS);
#pragma unroll
                  for (int bj = 0; bj < 2; ++bj) { acc[ai][bj][m][0] = acc[ai][bj][m][0] * rstd; acc[ai][bj][m][1] = acc[ai][bj][m][1] * rstd; } } }
        PG8_LAS float* halo = (PG8_LAS float*)(lds + HALO_OFF);
        if (!smp && fr == 15) {
#pragma unroll
            for (int ai = 0; ai < 2; ++ai)
#pragma unroll
                for (int mm = 2; mm < 4; ++mm) { PG8_LAS float* hp = halo + ((((2 * ai + wr + 1) * 2 + (mm - 2)) * 4 + wc) * 4 + fq) * 16;
                    *(PG8_LAS f32x4*)(hp) = acc[ai][0][mm][0]; *(PG8_LAS f32x4*)(hp + 4) = acc[ai][0][mm][1]; *(PG8_LAS f32x4*)(hp + 8) = acc[ai][1][mm][0]; *(PG8_LAS f32x4*)(hp + 12) = acc[ai][1][mm][1]; }
        }
        asm volatile("s_waitcnt lgkmcnt(0)\n\ts_barrier" ::: "memory");
#pragma unroll
        for (int n = 0; n < 2; ++n) {
            const int j4 = j8 + 4 * n;
            if (n == 1) UPC_LOADW(1);
            const f32x4 wg0 = cwv[0], wg1 = cwv[1], wg2 = cwv[2], bgv = cwv[3], wv0 = cwv[4], wv1 = cwv[5], wv2 = cwv[6], bvv = cwv[7];
#pragma unroll
            for (int ai = 0; ai < 2; ++ai) {
                const int blk = 2 * ai + wr, tokb = tok0 + ai * HALF;
                f32x4 gm1, gm2, vm1, vm2;
                if (smp) { const float* sb = sconv + (size_t)((tokb - MP) >> 2) * 2 * FF2;
                    gm2 = *(const f32x4*)(sb + j4); vm2 = *(const f32x4*)(sb + FF + j4); gm1 = *(const f32x4*)(sb + FF2 + j4); vm1 = *(const f32x4*)(sb + FF2 + FF + j4); }
                else { f32x4 h2g = {0.f, 0.f, 0.f, 0.f}, h3g = h2g, h2v = h2g, h3v = h2g;
                    if (blk > 0 && fr == 0) { const PG8_LAS float* hp = halo + (((blk * 2) * 4 + wc) * 4 + fq) * 16; h2g = *(const PG8_LAS f32x4*)(hp + 4 * n); h2v = *(const PG8_LAS f32x4*)(hp + 8 + 4 * n);
                        h3g = *(const PG8_LAS f32x4*)(hp + 256 + 4 * n); h3v = *(const PG8_LAS f32x4*)(hp + 256 + 8 + 4 * n); }
#pragma unroll
                    for (int e = 0; e < 4; ++e) { gm1[e] = dppf<0x111>(h3g[e], acc[ai][0][3][n][e]); gm2[e] = dppf<0x111>(h2g[e], acc[ai][0][2][n][e]); vm1[e] = dppf<0x111>(h3v[e], acc[ai][1][3][n][e]); vm2[e] = dppf<0x111>(h2v[e], acc[ai][1][2][n][e]); } }
#pragma unroll
                for (int m = 0; m < 4; ++m) { const int R = tokb + m;
                    const f32x4 g = acc[ai][0][m][n], v = acc[ai][1][m][n];
                    const f32x4 g1 = m == 0 ? gm1 : acc[ai][0][m > 0 ? m - 1 : 0][n], v1 = m == 0 ? vm1 : acc[ai][1][m > 0 ? m - 1 : 0][n];
                    const f32x4 g2 = m == 0 ? gm2 : (m == 1 ? gm1 : acc[ai][0][m > 1 ? m - 2 : 0][n]), v2 = m == 0 ? vm2 : (m == 1 ? vm1 : acc[ai][1][m > 1 ? m - 2 : 0][n]);
                    if (smp) { if (m >= 2) { float* cd = convs + ((size_t)((R - MP) >> 2) * 2 + (m - 2)) * FF2; *(f32x4*)(cd + j4) = g; *(f32x4*)(cd + FF + j4) = v; } }
                    else if ((ai == 0 && m < 2) || (ai == 1 && m >= 2)) {
                        const int t = R & 2047;
                        if (t >= 2046) { float* cd = convp + ((size_t)(R >> 11) * 2 + (t - 2046)) * FF2; *(f32x4*)(cd + j4) = g; *(f32x4*)(cd + FF + j4) = v; }
                        const int rt = R & 255;
                        if (rt < 2 || rt >= 254) { float* ed = EDGE + ((size_t)u.pm * 4 + (rt < 2 ? rt : rt - 252)) * FF2; *(f32x4*)(ed + j4) = g; *(f32x4*)(ed + FF + j4) = v; }
                    }
                    const f32x4 cg = bgv + wg0 * g2 + wg1 * g1 + wg2 * g, cv = bvv + wv0 * v2 + wv1 * v1 + wv2 * v;
                    u32x2 w; w.x = cvt_pk_bf16(silu_(cg[0]) * cv[0], silu_(cg[1]) * cv[1]); w.y = cvt_pk_bf16(silu_(cg[2]) * cv[2], silu_(cg[3]) * cv[3]);
                    *(u32x2*)(ACT + (size_t)R * FF + j4) = w;
                }
            }
        }
    }
};
#undef UPC_LOADW

template <class Epi, class Sched, bool ALIGN_EPI = false, bool SP2 = false>
__device__ __forceinline__ void gemm_phase(PG8_LAS unsigned char* lds, const Gemm g, const Sched& S, const Epi& E) {
    int tid_ = threadIdx.x; asm volatile("" : "+v"(tid_));
    const int tid = tid_, wid = __builtin_amdgcn_readfirstlane(tid >> 6), lane = tid & 63, wr = wid >> 2, wc = wid & 3, fr = lane & 15, fq = lane >> 4;
    const int K = g.K, nt = K / BK;
    unsigned voffA[2], voffB[2], voffB1[2];
#pragma unroll
    for (int i = 0; i < 2; ++i) { int R, C; stage_rc(tid * 16 + i * 8192, R, C); const int Rb = Epi::PERM ? ((R & ~31) + perm32(R & 31)) : R;
        int Ra = R; if constexpr (Epi::AMAP) Ra = E.amap(R); voffA[i] = (unsigned)(Ra * K + C) * 2u;     voffB[i] = (unsigned)(E.bmap(Rb) * K + C) * 2u; if constexpr (Epi::BMAP) voffB1[i] = (unsigned)(E.bmap(HALF + Rb) * K + C) * 2u; else voffB1[i] = 0u; }
    const size_t kstep = (size_t)(BK * 2);
    const size_t hstep = (size_t)HALF * K * 2;
    const unsigned* vB1 = Epi::BMAP ? voffB1 : voffB; const size_t h1step = Epi::BMAP ? (size_t)0 : hstep;
    const size_t tstep = 2 * hstep;
    const unsigned ldsw = (unsigned)wid * 1024u;
    const int aoff = lds_byte(wr * 64 + fr, fq * 8), boff = lds_byte(wc * 32 + fr, fq * 8);
#define PG8_SA(b, h) (((b) * 2 + (h)) * HTB)
#define PG8_SB(b, h) ((4 + (b) * 2 + (h)) * HTB)
#define PG8_STAGE(bufoff, gbase, voff) do { _Pragma("unroll") for (int _i = 0; _i < 2; ++_i) \
        __builtin_amdgcn_global_load_lds((const unsigned*)((const char*)(gbase) + (voff)[_i]), (PG8_LAS unsigned*)(lds + (bufoff) + ldsw + _i * 8192), 16, 0, 0); } while (0)
#define PG8_LDA(dst, b, h) do { _Pragma("unroll") for (int m = 0; m < 4; ++m) _Pragma("unroll") for (int k = 0; k < 2; ++k) dst[m][k] = *(const PG8_LAS bf16x8*)(lds + PG8_SA(b, h) + aoff + m * 2048 + k * 1024); } while (0)
#define PG8_LDB(dst, b, h) do { _Pragma("unroll") for (int n = 0; n < 2; ++n) _Pragma("unroll") for (int k = 0; k < 2; ++k) dst[n][k] = *(const PG8_LAS bf16x8*)(lds + PG8_SB(b, h) + boff + n * 2048 + k * 1024); } while (0)
#define PG8_MMA(ai, bj, At, Bt) do { __builtin_amdgcn_s_setprio(1); _Pragma("unroll") for (int m = 0; m < 4; ++m) _Pragma("unroll") for (int n = 0; n < 2; ++n) _Pragma("unroll") for (int k = 0; k < 2; ++k) \
        acc[ai][bj][m][n] = __builtin_amdgcn_mfma_f32_16x16x32_bf16(Bt[n][k], At[m][k], acc[ai][bj][m][n], 0, 0, 0); __builtin_amdgcn_s_setprio(0); } while (0)
#define PG8_WAIT_V(n) asm volatile("s_waitcnt vmcnt(" #n ")" ::: "memory")
#define PG8_WAIT_L(n) asm volatile("s_waitcnt lgkmcnt(" #n ")" ::: "memory")
#define PG8_BAR __builtin_amdgcn_s_barrier()
#define PG8_SCHED __builtin_amdgcn_sched_barrier(0)
    Unit cur, nxt; int ui = 0;
    if (!S.next(0, cur)) return;
    f32x4 acc[2][2][4][2];
#pragma unroll
    for (int a = 0; a < 2; ++a)
#pragma unroll
        for (int b = 0; b < 2; ++b)
#pragma unroll
            for (int m = 0; m < 4; ++m)
#pragma unroll
                for (int n = 0; n < 2; ++n) acc[a][b][m][n] = (f32x4){0.f, 0.f, 0.f, 0.f};
    bf16x8 At[4][2], B0[2][2], B1[2][2];
    const char* cA = (const char*)g.A + (size_t)cur.pm * tstep; const char* cB = (const char*)g.Bt + (size_t)cur.pn * tstep;
    S.a_ready(cur);
    if constexpr (SP2) {
        PG8_STAGE(PG8_SB(0, 0), cB, voffB); PG8_STAGE(PG8_SB(0, 1), cB + h1step, vB1); PG8_STAGE(PG8_SA(0, 0), cA, voffA); PG8_STAGE(PG8_SA(0, 1), cA + hstep, voffA);
        if (wr == 1) PG8_BAR;
        PG8_WAIT_V(2); PG8_BAR;
        PG8_STAGE(PG8_SB(1, 0), cB + kstep, voffB); PG8_STAGE(PG8_SA(1, 0), cA + kstep, voffA); PG8_STAGE(PG8_SB(1, 1), cB + h1step + kstep, vB1);
        PG8_WAIT_V(6); PG8_BAR;
    } else {
        PG8_STAGE(PG8_SB(0, 0), cB, voffB); PG8_STAGE(PG8_SA(0, 0), cA, voffA); PG8_STAGE(PG8_SB(0, 1), cB + h1step, vB1); PG8_STAGE(PG8_SA(0, 1), cA + hstep, voffA);
        if (wr == 1) PG8_BAR;
        PG8_WAIT_V(4); PG8_BAR;
        PG8_STAGE(PG8_SB(1, 0), cB + kstep, voffB); PG8_STAGE(PG8_SA(1, 0), cA + kstep, voffA); PG8_STAGE(PG8_SB(1, 1), cB + h1step + kstep, vB1);
        PG8_WAIT_V(6); PG8_BAR;
    }
    for (;;) {
        const bool has_next = S.next(ui + 1, nxt);
        const char* nA = has_next ? (const char*)g.A + (size_t)nxt.pm * tstep : cA; const char* nB = has_next ? (const char*)g.Bt + (size_t)nxt.pn * tstep : cB;
        for (int t = 0; t < nt; t += 2) {
            const bool last = (t == nt - 2);
            const char* a1 = cA + (size_t)(t + 1) * kstep;
            const char* a2 = last ? nA : cA + (size_t)(t + 2) * kstep; const char* b2 = last ? nB : cB + (size_t)(t + 2) * kstep;
            const char* a3 = a2 + kstep; const char* b3 = b2 + kstep;
            if (last && has_next) S.a_ready(nxt);
            if constexpr (SP2) {
            PG8_LDB(B0, 0, 0); PG8_LDB(B1, 0, 1); PG8_SCHED; PG8_LDA(At, 0, 0); PG8_STAGE(PG8_SA(1, 1), a1 + hstep, voffA);
            PG8_WAIT_V(8); PG8_WAIT_L(0); PG8_BAR; PG8_MMA(0, 0, At, B0); PG8_MMA(0, 1, At, B1); PG8_BAR; PG8_SCHED;
            PG8_LDA(At, 0, 1); PG8_STAGE(PG8_SB(0, 0), b2, voffB); PG8_STAGE(PG8_SB(0, 1), b2 + h1step, vB1); PG8_STAGE(PG8_SA(0, 0), a2, voffA);
            PG8_WAIT_V(8); PG8_WAIT_L(0); PG8_BAR; PG8_MMA(1, 0, At, B0); PG8_MMA(1, 1, At, B1); PG8_BAR; PG8_SCHED;
            PG8_LDB(B0, 1, 0); PG8_LDB(B1, 1, 1); PG8_SCHED; PG8_LDA(At, 1, 0); PG8_STAGE(PG8_SA(0, 1), a2 + hstep, voffA);
            PG8_WAIT_V(8); PG8_WAIT_L(0); PG8_BAR; PG8_MMA(0, 0, At, B0); PG8_MMA(0, 1, At, B1); PG8_BAR; PG8_SCHED;
            PG8_LDA(At, 1, 1); PG8_STAGE(PG8_SB(1, 0), b3, voffB); PG8_STAGE(PG8_SB(1, 1), b3 + h1step, vB1); PG8_STAGE(PG8_SA(1, 0), a3, voffA);
            PG8_WAIT_V(8); PG8_WAIT_L(0); PG8_BAR; PG8_MMA(1, 0, At, B0); PG8_MMA(1, 1, At, B1); PG8_BAR; PG8_SCHED;
            } else {
            PG8_LDB(B0, 0, 0); PG8_SCHED; PG8_LDA(At, 0, 0); PG8_STAGE(PG8_SA(1, 1), a1 + hstep, voffA);
            PG8_WAIT_L(8); PG8_BAR; PG8_WAIT_L(0); PG8_MMA(0, 0, At, B0); PG8_BAR; PG8_SCHED;
            PG8_LDB(B1, 0, 1); PG8_STAGE(PG8_SB(0, 0), b2, voffB);
            PG8_BAR; PG8_WAIT_L(0); PG8_MMA(0, 1, At, B1); PG8_BAR;
            PG8_LDA(At, 0, 1); PG8_STAGE(PG8_SA(0, 0), a2, voffA);
            PG8_BAR; PG8_WAIT_L(0); PG8_MMA(1, 0, At, B0); PG8_BAR; PG8_SCHED;
            PG8_STAGE(PG8_SB(0, 1), b2 + h1step, vB1);
            PG8_WAIT_V(6); PG8_BAR; PG8_MMA(1, 1, At, B1); PG8_BAR;
            PG8_LDB(B0, 1, 0); PG8_SCHED; PG8_LDA(At, 1, 0); PG8_STAGE(PG8_SA(0, 1), a2 + hstep, voffA);
            PG8_WAIT_L(8); PG8_BAR; PG8_WAIT_L(0); PG8_MMA(0, 0, At, B0); PG8_BAR; PG8_SCHED;
            PG8_LDB(B1, 1, 1); PG8_STAGE(PG8_SB(1, 0), b3, voffB);
            PG8_BAR; PG8_WAIT_L(0); PG8_MMA(0, 1, At, B1); PG8_BAR;
            PG8_LDA(At, 1, 1); PG8_STAGE(PG8_SA(1, 0), a3, voffA);
            PG8_BAR; PG8_WAIT_L(0); PG8_MMA(1, 0, At, B0); PG8_BAR; PG8_SCHED;
            PG8_STAGE(PG8_SB(1, 1), b3 + h1step, vB1);
            PG8_WAIT_V(6); PG8_BAR; PG8_MMA(1, 1, At, B1); PG8_BAR;
            }
        }
        if constexpr (ALIGN_EPI) { if (wr == 0) PG8_BAR; }
        if constexpr (!Epi::AFTER_DRAIN) { E(acc, cur, wr, wc, fr, fq); S.done(cur); }
        if (!has_next) break;
#pragma unroll
        for (int a = 0; a < 2; ++a)
#pragma unroll
            for (int b = 0; b < 2; ++b)
#pragma unroll
                for (int m = 0; m < 4; ++m)
#pragma unroll
                    for (int n = 0; n < 2; ++n) acc[a][b][m][n] = (f32x4){0.f, 0.f, 0.f, 0.f};
        cur = nxt; cA = nA; cB = nB; ++ui;
        if constexpr (ALIGN_EPI) { if (wr == 1) PG8_BAR; }
    }
    PG8_WAIT_V(0);
    if constexpr (!ALIGN_EPI) { if (wr == 0) PG8_BAR; }
    PG8_BAR;
    if constexpr (Epi::AFTER_DRAIN) { E.fused(acc, cur, wr, wc, fr, fq, lds, wid, lane); S.done(cur); }
#undef PG8_SA
#undef PG8_SB
#undef PG8_STAGE
#undef PG8_LDA
#undef PG8_LDB
#undef PG8_MMA
#undef PG8_WAIT_V
#undef PG8_WAIT_L
#undef PG8_BAR
#undef PG8_SCHED
}
}

#define XB_TMO      128
#define XB_XCNT(j)  (256  + 64 * (j))
#define XB_XSUB(j)  (1280 + 64 * (j))
#define XB_XGEN(j)  (2304 + 64 * (j))
#define XB_TOP      3328
#define XB_TOPGEN   3392
#define XCD_BAR_WORDS 3456
#define XB_SPIN_CAP (1u << 18)

__device__ __forceinline__ unsigned xb_ld(unsigned* p)              { return __hip_atomic_load(p, __ATOMIC_RELAXED, __HIP_MEMORY_SCOPE_AGENT); }
__device__ __forceinline__ unsigned xb_add(unsigned* p, unsigned v) { return __hip_atomic_fetch_add(p, v, __ATOMIC_RELAXED, __HIP_MEMORY_SCOPE_AGENT); }
__device__ __forceinline__ unsigned xb_xcc_id() { return (unsigned)__builtin_amdgcn_s_getreg((3 << 11) | 20) & 0xFu; }
#define XB_SPIN(cond, bar) do { unsigned _sp = 0; while (cond) { __builtin_amdgcn_s_sleep(1); \
    if ((++_sp & 255u) == 0u) { if (xb_ld(&(bar)[XB_TMO])) break; if (_sp > XB_SPIN_CAP) { atomicAdd(&(bar)[XB_TMO], 1u); break; } } } } while (0)

struct XcdBarrier {
    unsigned* bar; unsigned x;
    volatile LAS unsigned* st;
};

__device__ __forceinline__ XcdBarrier xcd_barrier_post(unsigned* bar, volatile LAS unsigned* st) {
    XcdBarrier b; b.bar = bar; b.x = xb_xcc_id(); b.st = st;
    if (threadIdx.x == 0) (void)xb_add(&bar[XB_XCNT(b.x)], 1u);
    return b;
}
__device__ __forceinline__ void xcd_barrier_complete(unsigned* bar, unsigned x, unsigned& nloc, unsigned& nx) {
    const unsigned G = gridDim.x * gridDim.y * gridDim.z;
    unsigned sum, cnt, mine, sp = 0u;
    for (;;) {
        sum = 0u; cnt = 0u; mine = 0u;
#pragma unroll
        for (unsigned j = 0; j < 16; ++j) { const unsigned c = xb_ld(&bar[XB_XCNT(j)]); sum += c; cnt += (c > 0u) ? 1u : 0u; mine = (j == x) ? c : mine; }
        if (sum == G) break;
        __builtin_amdgcn_s_sleep(1);
        if ((++sp & 255u) == 0u) { if (xb_ld(&bar[XB_TMO])) break; if (sp > XB_SPIN_CAP) { atomicAdd(&bar[XB_TMO], 1u); break; } }
    }
    nloc = mine > 0u ? mine : 1u; nx = cnt > 0u ? cnt : 1u;
}

__device__ __forceinline__ void xcd_barrier(const XcdBarrier& b) {
    asm volatile("s_waitcnt vmcnt(0)" ::: "memory");
    __syncthreads();
    if (threadIdx.x == 0) {
        unsigned* bar = b.bar;
        __builtin_amdgcn_s_waitcnt(0);
        unsigned nloc = b.st[0], nx = b.st[1];
        if (nloc == 0u) { xcd_barrier_complete(bar, b.x, nloc, nx); b.st[0] = nloc; b.st[1] = nx; }
        const unsigned old = xb_add(&bar[XB_XSUB(b.x)], 1u);
        const unsigned gen = old / nloc;
        if (old + 1u == (gen + 1u) * nloc) {
            __builtin_amdgcn_fence(__ATOMIC_RELEASE, "agent");
            asm volatile("s_waitcnt vmcnt(0)" ::: "memory");
            const unsigned og = xb_add(&bar[XB_TOP], 1u);
            const unsigned tg = og / nx;
            if (og + 1u == (tg + 1u) * nx) xb_add(&bar[XB_TOPGEN], 1u);
            else XB_SPIN(xb_ld(&bar[XB_TOPGEN]) == tg, bar);
            __builtin_amdgcn_fence(__ATOMIC_ACQUIRE, "agent");
            xb_add(&bar[XB_XGEN(b.x)], 1u);
            asm volatile("s_waitcnt vmcnt(0)" ::: "memory");
        } else {
            XB_SPIN(xb_ld(&bar[XB_XGEN(b.x)]) == gen, bar);
            __builtin_amdgcn_fence(__ATOMIC_ACQUIRE, "agent");
            asm volatile("s_waitcnt vmcnt(0)" ::: "memory");
        }
    }
    __syncthreads();
}

struct Args { const float* in[39]; float* out; unsigned char* ws; int ph_lo, ph_hi, li, pad; };
enum { I_XP = 0, I_XS, I_MEM, I_C1, I_C4, I_C16, I_SRE, I_SIM, I_SCONV, I_CMEM, I_NMIX, I_WIN, I_QN, I_KN, I_LRE, I_LIM, I_LDT, I_BRE, I_BIM, I_CRE, I_CIM, I_SD, I_WGLU, I_BGLU,
       I_AON, I_SON, I_WOUT, I_NX, I_NMEM, I_WXQ, I_WXKV, I_XQN, I_XKN, I_WXO, I_NFFN, I_WUP, I_CONVW, I_CONVB, I_WDOWN };
constexpr size_t O_YP = 0, O_YS = O_YP + (size_t)MP * D, O_KV1P = O_YS + (size_t)MS * D, O_KV4P = O_KV1P + (size_t)BP * 128 * 512, O_KV16P = O_KV4P + (size_t)BP * 512 * 512,
    O_SREP = O_KV16P + (size_t)BP * 2048 * 512, O_SIMP = O_SREP + BP * 1024, O_CONVP = O_SIMP + BP * 1024, O_MEMKV = O_CONVP + (size_t)BP * 2 * FF2, O_KV1S = O_MEMKV + (size_t)MM * 2048,
    O_KV4S = O_KV1S + (size_t)MS * 512, O_KV16S = O_KV4S + (size_t)MS * 512, O_SRES = O_KV16S + (size_t)MS * 512, O_SIMS = O_SRES + BS * 1024, O_CONVS = O_SIMS + BS * 1024, O_END = O_CONVS + (size_t)BS * 2 * FF2;
static_assert(O_END == 35102720 && O_KV1P == O_KV1P_ && O_KV4P == O_KV4P_ && O_KV16P == O_KV16P_ && O_KV1S == O_KV1S_ && O_KV4S == O_KV4S_ && O_KV16S == O_KV16S_, "output map");

template <int MODE> __device__ __forceinline__ int rowmap(int n) {
    if (MODE == 1) return (n & ~255) + 128 * ((n >> 5) & 1) + 32 * ((n >> 6) & 3) + (n & 31);
    if (MODE == 2) { return n < FF ? 256 * (n >> 7) + (n & 127) : 256 * ((n - FF) >> 7) + 128 + ((n - FF) & 127); }
    return n;
}
template <int MODE> __device__ __forceinline__ void p0_transpose_item(const float* W, int K, int N, bf16* WT, const float* gk, LAS float* scr, int item, int lane) {
    const int nblk = N / 32, kb = item / nblk, nb = item % nblk, k0 = 64 * kb, n0 = 32 * nb;
    float wv[32];
#pragma unroll
    for (int i = 0; i < 32; ++i) wv[i] = W[(size_t)(k0 + 2 * i + (lane >> 5)) * N + n0 + (lane & 31)];
    if (gk) {
#pragma unroll
        for (int i = 0; i < 32; ++i) wv[i] *= gk[k0 + 2 * i + (lane >> 5)]; }
#pragma unroll
    for (int i = 0; i < 32; ++i) scr[(2 * i + (lane >> 5)) * 33 + (lane & 31)] = wv[i];
    LDS_WAIT(); asm volatile("" ::: "memory");
    const int c = lane & 7;
#pragma unroll
    for (int j = 0; j < 4; ++j) { const int n = (lane >> 3) + 8 * j; const LAS float* s = scr + (8 * c) * 33 + n;
        u32x4 o; o.x = pk2(s[0 * 33], s[1 * 33]); o.y = pk2(s[2 * 33], s[3 * 33]); o.z = pk2(s[4 * 33], s[5 * 33]); o.w = pk2(s[6 * 33], s[7 * 33]);
        *(GAS u32x4*)(WT + (size_t)rowmap<MODE>(n0 + n) * K + k0 + 8 * c) = o; }
    LDS_WAIT(); asm volatile("" ::: "memory");
}
__device__ __forceinline__ void rms_rows2_to_bf16(const float* xrow0, const float* xrow1, const f32x4 (&gg)[4], bf16* orow0, bf16* orow1, int lane) {
    const f32x4* xr0 = (const f32x4*)xrow0 + lane; const f32x4* xr1 = (const f32x4*)xrow1 + lane;
    f32x4 v0[4], v1[4]; float s0 = 0.f, s1 = 0.f;
#pragma unroll
    for (int j = 0; j < 4; ++j) { v0[j] = xr0[64 * j]; v1[j] = xr1[64 * j]; }
#pragma unroll
    for (int j = 0; j < 4; ++j) { s0 += dot4(v0[j]); s1 += dot4(v1[j]); }
#pragma unroll
    for (int o = 1; o < 64; o <<= 1) { s0 += __shfl_xor(s0, o); s1 += __shfl_xor(s1, o); }
    const float r0 = frsq(s0 * (1.0f / D) + EPS), r1 = frsq(s1 * (1.0f / D) + EPS);
    u32x2* o0 = (u32x2*)orow0 + lane; u32x2* o1 = (u32x2*)orow1 + lane;
#pragma unroll
    for (int j = 0; j < 4; ++j) { const f32x4 a = v0[j] * r0 * gg[j], c = v1[j] * r1 * gg[j];
        u32x2 w; w.x = cvt_pk_bf16(a[0], a[1]); w.y = cvt_pk_bf16(a[2], a[3]); o0[64 * j] = w;
        u32x2 z; z.x = cvt_pk_bf16(c[0], c[1]); z.y = cvt_pk_bf16(c[2], c[3]); o1[64 * j] = z; }
}

__device__ __forceinline__ int pi23(int m) { return (m & ~12) | ((m & 4) << 1) | ((m & 8) >> 1); }
__device__ __forceinline__ void memk_fix_item(float* memkv, const float* mss, const float* xkn, const float* xqn, bf16* MEMK, int Rm, int lane) {
    const f32x4 gk = *(const f32x4*)(xkn + 4 * lane), gq = *(const f32x4*)(xqn + 4 * lane);
    f32x4 v[4], s[4];
#pragma unroll
    for (int h = 0; h < 4; ++h) { v[h] = *(const f32x4*)(memkv + (size_t)Rm * 2048 + h * 256 + 4 * lane); s[h] = *(const f32x4*)(mss + (size_t)Rm * 16 + 4 * h); }
#pragma unroll
    for (int h = 0; h < 4; ++h) {
        const float rs = frsq(((s[h][0] + s[h][1]) + (s[h][2] + s[h][3])) * (1.0f / 256.0f) + EPS);
        const f32x4 kn = v[h] * rs * gk; *(f32x4*)(memkv + (size_t)Rm * 2048 + h * 256 + 4 * lane) = kn; const f32x4 kq = kn * gq;
        u32x2 w; w.x = cvt_pk_bf16(kq[0], kq[1]); w.y = cvt_pk_bf16(kq[2], kq[3]); *(u32x2*)(MEMK + (size_t)Rm * 1024 + h * 256 + 4 * lane) = w;
    }
}
__device__ __forceinline__ void ssm_bfrags(const Args& a, const float* ssmc, int g, int lane, bf16x8 (&bb)[4]) {
    const int n = lane & 31, hi = lane >> 5;
#pragma unroll
    for (int s2 = 0; s2 < 2; ++s2) { const int st = g * 64 + 32 * s2 + n; const f32x4 c0 = *(const f32x4*)(ssmc + (size_t)st * 8); const float cr = c0[2], ci = c0[3];
        const f32x4 r0 = *(const f32x4*)(a.in[I_BRE] + (size_t)st * 16 + 8 * hi), r1 = *(const f32x4*)(a.in[I_BRE] + (size_t)st * 16 + 8 * hi + 4);
        const f32x4 i0 = *(const f32x4*)(a.in[I_BIM] + (size_t)st * 16 + 8 * hi), i1 = *(const f32x4*)(a.in[I_BIM] + (size_t)st * 16 + 8 * hi + 4);
        const f32x4 pr0 = r0 * cr - i0 * ci, pr1 = r1 * cr - i1 * ci, pi0 = i0 * cr + r0 * ci, pi1 = i1 * cr + r1 * ci;
        bb[s2] = pack8(pr0[0], pr0[1], pr0[2], pr0[3], pr1[0], pr1[1], pr1[2], pr1[3]); bb[2 + s2] = pack8(pi0[0], pi0[1], pi0[2], pi0[3], pi1[0], pi1[1], pi1[2], pi1[3]); }
}
__device__ __forceinline__ bf16x8 ssm_loadu(const float* U, int row0, int nrows, int g, int lane) {
    const int m = lane & 31, hi = lane >> 5; const int row = row0 + (m < nrows ? m : (m & (nrows - 1)));
    const f32x4 u0 = *(const f32x4*)(U + (size_t)row * 256 + g * 16 + 8 * hi), u1 = *(const f32x4*)(U + (size_t)row * 256 + g * 16 + 8 * hi + 4);
    return pack8(u0[0], u0[1], u0[2], u0[3], u1[0], u1[1], u1[2], u1[3]);
}
__device__ __forceinline__ void ssm_xcompute(bf16x8 ua, const bf16x8 (&bb)[4], f32x16 (&xr)[2], f32x16 (&xi)[2]) {
    const f32x16 z = {0.f, 0.f, 0.f, 0.f, 0.f, 0.f, 0.f, 0.f, 0.f, 0.f, 0.f, 0.f, 0.f, 0.f, 0.f, 0.f};
    f32x16 t0 = __builtin_amdgcn_mfma_f32_32x32x16_bf16(ua, bb[0], z, 0, 0, 0), t1 = __builtin_amdgcn_mfma_f32_32x32x16_bf16(ua, bb[1], z, 0, 0, 0);
    f32x16 t2 = __builtin_amdgcn_mfma_f32_32x32x16_bf16(ua, bb[2], z, 0, 0, 0), t3 = __builtin_amdgcn_mfma_f32_32x32x16_bf16(ua, bb[3], z, 0, 0, 0);
#pragma unroll
    for (int r = 0; r < 16; ++r) {
        const float a0 = t0[r], a1 = t1[r], a2 = t2[r], a3 = t3[r];
        const auto sr = __builtin_amdgcn_permlane32_swap(__float_as_uint(a0), __float_as_uint(a1), false, false);
        const unsigned s0 = sr[0], s1 = sr[1];
        xr[0][r] = __uint_as_float(s0); xr[1][r] = __uint_as_float(s1);
        const auto si = __builtin_amdgcn_permlane32_swap(__float_as_uint(a2), __float_as_uint(a3), false, false);
        const unsigned s2 = si[0], s3 = si[1];
        xi[0][r] = __uint_as_float(s2); xi[1][r] = __uint_as_float(s3); }
}
#define SSM_XR(t) xr[((t) >> 2) & 1][((t) & 3) + 4 * ((t) >> 3)]
#define SSM_XI(t) xi[((t) >> 2) & 1][((t) & 3) + 4 * ((t) >> 3)]
__device__ __forceinline__ void ssm_a_item(const Args& a, const float* U, const float* ssmc, float* SSMF, LAS float* uL, int it, int lane) {
    const int g = it & 15, bc = it >> 4, b = bc / 31, c = bc - b * 31;
    const f32x4 c0 = *(const f32x4*)(ssmc + (size_t)(g * 64 + lane) * 8);
    const float ar = c0[0], ai = c0[1];
    bf16x8 bb[4]; ssm_bfrags(a, ssmc, g, lane, bb);
    float hr = 0.f, hi = 0.f;
    bf16x8 ua2[2]; ua2[0] = ssm_loadu(U, b * 2048 + c * 64, 32, g, lane); ua2[1] = ssm_loadu(U, b * 2048 + c * 64 + 32, 32, g, lane);
#pragma unroll
    for (int blk = 0; blk < 2; ++blk) {
        f32x16 xr[2], xi[2]; ssm_xcompute(ua2[blk], bb, xr, xi);
#pragma unroll
        for (int t = 0; t < 32; ++t) { const float nr = fmaf(ar, hr, fmaf(-ai, hi, SSM_XR(t))), ni = fmaf(ar, hi, fmaf(ai, hr, SSM_XI(t))); hr = nr; hi = ni; }
    }
    *(f32x2*)(SSMF + ((size_t)((b * 32 + c) * 16 + g) * 64 + lane) * 2) = (f32x2){hr, hi};
    (void)uL;
}
constexpr int SAB = 4;
struct SaBatch { f32x4 k[SAB], v[SAB]; };
__device__ __forceinline__ void sa_load(SaBatch& B, const float* cb, unsigned loff, int t, int dil, int nvalid, int i0) {
#pragma unroll
    for (int j = 0; j < SAB; ++j) { const int i = i0 + j, idx = i < nvalid ? t + i * dil : t; const char* rp = (const char*)(cb + (size_t)idx * 512);
        B.k[j] = __builtin_nontemporal_load((const f32x4*)(rp + loff)); B.v[j] = __builtin_nontemporal_load((const f32x4*)(rp + 1024 + loff)); }
}
__device__ __forceinline__ void sa_compute(const SaBatch& B, f32x4 q, int nvalid, int i0, float& m, float& l, f32x4& o) {
    float s[SAB]; float mb = m;
#pragma unroll
    for (int j = 0; j < SAB; ++j) { float d = (q[0] * B.k[j][0] + q[1] * B.k[j][1]) + (q[2] * B.k[j][2] + q[3] * B.k[j][3]);
        d += __shfl_xor(d, 1); d += __shfl_xor(d, 2); d += __shfl_xor(d, 4); d += __shfl_xor(d, 8);
        s[j] = (i0 + j) < nvalid ? d : -1e30f; mb = fmaxf(mb, s[j]); }
    const float sc = fexp2(m - mb); l *= sc; o = o * sc; m = mb;
#pragma unroll
    for (int j = 0; j < SAB; ++j) { const float p = fexp2(s[j] - mb); l += p; o = o + B.v[j] * p; }
}
__device__ __forceinline__ void sattn_item(const Args& a, const bf16* Q, bf16* AO, float* LSE, int it, int lane) {
    const int g = it >> 9, rem = it & 511, b = rem >> 2, t = rem & 3;
    const int dil = 1 << (2 * g), nbuf = 128 << (2 * g);
    const int R = MP + 4 * b + t, hh = lane >> 4, dq = (lane & 15) * 4;
    const u32x2 qw = *(const u32x2*)(Q + (size_t)R * AW + g * 256 + hh * 64 + dq);
    const f32x4 q = {bf2f(qw.x & 0xffffu), bf2f(qw.x >> 16), bf2f(qw.y & 0xffffu), bf2f(qw.y >> 16)};
    const float* cb = a.in[I_C1 + g] + (size_t)b * nbuf * 512; const unsigned loff = 4u * (unsigned)(hh * 64 + dq);
    const float* nb = a.out + (g == 0 ? O_KV1S : (g == 1 ? O_KV4S : O_KV16S)) + (size_t)(4 * b) * 512 + hh * 64 + dq;
    const int nvalid = g == 0 ? 128 - t : 128;
    float m = -1e30f, l = 0.f; f32x4 o = {0.f, 0.f, 0.f, 0.f};
    SaBatch A, B; sa_load(A, cb, loff, t, dil, nvalid, 0);
#pragma unroll 1
    for (int i0 = 0; i0 < 128; i0 += 2 * SAB) {
        sa_load(B, cb, loff, t, dil, nvalid, i0 + SAB);
        sa_compute(A, q, nvalid, i0, m, l, o);
        if (i0 + 2 * SAB < 128) sa_load(A, cb, loff, t, dil, nvalid, i0 + 2 * SAB);
        sa_compute(B, q, nvalid, i0 + SAB, m, l, o);
    }
    {
        f32x4 kk[4], vv[4]; float s[4]; float mb = m;
#pragma unroll
        for (int j = 0; j < 4; ++j) { const float* rp = nb + (size_t)j * 512; kk[j] = *(const f32x4*)rp; vv[j] = *(const f32x4*)(rp + 256); }
#pragma unroll
        for (int j = 0; j < 4; ++j) { float d = (q[0] * kk[j][0] + q[1] * kk[j][1]) + (q[2] * kk[j][2] + q[3] * kk[j][3]);
            d += __shfl_xor(d, 1); d += __shfl_xor(d, 2); d += __shfl_xor(d, 4); d += __shfl_xor(d, 8);
            const bool ok = g == 0 ? (j <= t) : (j == t); s[j] = ok ? d : -1e30f; mb = fmaxf(mb, s[j]); }
        const float sc = fexp2(m - mb); l *= sc; o = o * sc; m = mb;
#pragma unroll
        for (int j = 0; j < 4; ++j) { const float p = fexp2(s[j] - mb); l += p; o = o + vv[j] * p; }
    }
    const float il = frcp(l); o = o * il;
    u32x2 w; w.x = cvt_pk_bf16(o[0], o[1]); w.y = cvt_pk_bf16(o[2], o[3]); *(u32x2*)(AO + (size_t)R * AW + g * 256 + hh * 64 + dq) = w;
    if ((lane & 15) == 0) LSE[(size_t)R * 12 + g * 4 + hh] = (m + flog2(l)) * LN2;
}
__device__ __forceinline__ void pattn_item(const bf16* Q, const bf16* Kb, const bf16* VT, bf16* AO, float* LSE, int it, int lane) {
    const int g = it >> 11; int rem = it & 2047;
    const int sh = 2 * g, dil = 1 << sh, S = 2048 >> sh, nql = 6 - sh;
    const int qt = rem & ((1 << nql) - 1); rem >>= nql; const int res = rem & (dil - 1); rem >>= sh; const int hh = rem & 3, b = rem >> 2;
    const int n = lane & 31, hi = lane >> 5;
    const int s_q = 32 * qt + n, qrow = b * 2048 + s_q * dil + res;
    const int coff = g * 256 + hh * 64 + 32 * hi;
    bf16x8 qf[4];
    { const bf16* qp = Q + (size_t)qrow * AW + coff;
#pragma unroll
      for (int d0 = 0; d0 < 4; ++d0) qf[d0] = *(const bf16x8*)(qp + 8 * d0); }
    f32x16 sc[5];
    const int pm = pi23(n);
#pragma unroll
    for (int kt = 0; kt < 5; ++kt) {
        const int sb = 32 * qt - 128 + 32 * kt; int sk = sb + pm; sk = sk < 0 ? 0 : sk;
        const bf16* kp = Kb + (size_t)(b * 2048 + sk * dil + res) * AW + coff;
        bf16x8 kf[4];
#pragma unroll
        for (int d0 = 0; d0 < 4; ++d0) kf[d0] = *(const bf16x8*)(kp + 8 * d0);
        f32x16 acc = {0.f, 0.f, 0.f, 0.f, 0.f, 0.f, 0.f, 0.f, 0.f, 0.f, 0.f, 0.f, 0.f, 0.f, 0.f, 0.f};
#pragma unroll
        for (int d0 = 0; d0 < 4; ++d0) acc = __builtin_amdgcn_mfma_f32_32x32x16_bf16(kf[d0], qf[d0], acc, 0, 0, 0);
        sc[kt] = acc;
    }
    float mx = -1e30f;
#pragma unroll
    for (int kt = 0; kt < 5; ++kt) { const int sb = 32 * qt - 128 + 32 * kt;
#pragma unroll
        for (int r = 0; r < 16; ++r) { const int sk = sb + 16 * (r >> 3) + 8 * hi + (r & 7); const int dl = s_q - sk; const bool ok = (sk >= 0) && (dl >= 0) && (dl <= 128);
            const float v = ok ? sc[kt][r] : -1e30f; sc[kt][r] = v; mx = fmaxf(mx, v); } }
    mx = fmaxf(mx, __shfl_xor(mx, 32));
    float l = 0.f;
#pragma unroll
    for (int kt = 0; kt < 5; ++kt)
#pragma unroll
        for (int r = 0; r < 16; ++r) { const float p = fexp2(sc[kt][r] - mx); sc[kt][r] = p; l += p; }
    l += __shfl_xor(l, 32);
    f32x16 o[2];
#pragma unroll
    for (int dt = 0; dt < 2; ++dt) o[dt] = (f32x16){0.f, 0.f, 0.f, 0.f, 0.f, 0.f, 0.f, 0.f, 0.f, 0.f, 0.f, 0.f, 0.f, 0.f, 0.f, 0.f};
    const bf16* vbase = VT + (size_t)((g * 4 + hh) * 8 + b) * 64 * 2048;
#pragma unroll
    for (int kt = 0; kt < 5; ++kt) {
        int sb = 32 * qt - 128 + 32 * kt; sb = sb < 0 ? 0 : sb;
        const bf16* vp = vbase + (size_t)((res * S + sb) >> 5) * 2048 + n * 32 + 8 * hi;
#pragma unroll
        for (int jj = 0; jj < 2; ++jj) {
            const bf16x8 pb = pack8(sc[kt][8 * jj + 0], sc[kt][8 * jj + 1], sc[kt][8 * jj + 2], sc[kt][8 * jj + 3], sc[kt][8 * jj + 4], sc[kt][8 * jj + 5], sc[kt][8 * jj + 6], sc[kt][8 * jj + 7]);
#pragma unroll
            for (int dt = 0; dt < 2; ++dt) { const bf16x8 vf = *(const bf16x8*)(vp + dt * 1024 + 16 * jj); o[dt] = __builtin_amdgcn_mfma_f32_32x32x16_bf16(vf, pb, o[dt], 0, 0, 0); }
        }
    }
    const float il = frcp(l);
    bf16* op = AO + (size_t)qrow * AW + g * 256 + hh * 64 + 4 * hi;
#pragma unroll
    for (int dt = 0; dt < 2; ++dt)
#pragma unroll
        for (int r4 = 0; r4 < 4; ++r4) { u32x2 w; w.x = cvt_pk_bf16(o[dt][4 * r4] * il, o[dt][4 * r4 + 1] * il); w.y = cvt_pk_bf16(o[dt][4 * r4 + 2] * il, o[dt][4 * r4 + 3] * il);
            *(u32x2*)(op + 32 * dt + 8 * r4) = w; }
    if (hi == 0) LSE[(size_t)qrow * 12 + g * 4 + hh] = (mx + flog2(l)) * LN2;
}

constexpr int PK_ROW = 144, PK_SLOT = 32 * PK_ROW, PV_OFF = 12 * PK_SLOT;
__device__ __forceinline__ void pattn_wg_item(const bf16* Q, const bf16* Kb, const bf16* VT, bf16* AO, float* LSE, LAS unsigned char* lds, int item, int wave, int lane, int tid) {
    const int g = item >> 8, r = item & 255, hh = (r >> 3) & 3, b = r >> 5;
    const int sh = 2 * g, dil = 1 << sh, S = 2048 >> sh;
    const int qblk = g == 0 ? (r & 7) : (r & 1), resb = g == 0 ? 0 : (g == 1 ? ((r >> 1) & 3) : 2 * (r & 7));
    const int pc = tid & 255;
    u32x4 kreg[6], vreg[6];
#pragma unroll
    for (int i = 0; i < 6; ++i) { const int T = (tid >> 8) + 2 * i;
        int sb, rs; bool ok;
        if (g < 2) { sb = 256 * qblk - 128 + 32 * T; rs = resb; ok = sb >= 0; } else { sb = 32 * (T & 3); rs = resb + (T >> 2); ok = T < 8; }
        if (ok) { const int t = (sb + (pc >> 3)) * dil + rs;
            kreg[i] = *(const u32x4*)(Kb + (size_t)(b * 2048 + t) * AW + g * 256 + hh * 64 + 8 * (pc & 7));
            vreg[i] = *(const u32x4*)(VT + (size_t)(b * 2048 + t) * AW + g * 256 + hh * 64 + 8 * (pc & 7)); }
        else { kreg[i] = (u32x4){0u, 0u, 0u, 0u}; vreg[i] = kreg[i]; } }
    const int n = lane & 31, hi = lane >> 5;
    const int qt = g < 2 ? 8 * qblk + wave : (wave & 3), resw = g < 2 ? resb : resb + (wave >> 2);
    const int slot_base = g < 2 ? wave : 4 * (wave >> 2) + (wave & 3) - 4;
    const int s_q = 32 * qt + n, qrow = b * 2048 + s_q * dil + resw;
    bf16x8 qf[4];
    { const bf16* qp = Q + (size_t)qrow * AW + g * 256 + hh * 64 + 32 * hi;
#pragma unroll
      for (int d0 = 0; d0 < 4; ++d0) qf[d0] = *(const bf16x8*)(qp + 8 * d0); }
#pragma unroll
    for (int i = 0; i < 6; ++i) { const int T = (tid >> 8) + 2 * i;
        *(LAS u32x4*)(lds + T * PK_SLOT + (pc >> 3) * PK_ROW + (pc & 7) * 16) = kreg[i];
        *(LAS u32x4*)(lds + PV_OFF + T * PK_SLOT + (pc >> 3) * PK_ROW + (pc & 7) * 16) = vreg[i]; }
    __syncthreads();
    f32x16 sc[5];
    const int pm = pi23(n);
#pragma unroll
    for (int kt = 0; kt < 5; ++kt) {
        const int slot = slot_base + kt, sb = 32 * qt - 128 + 32 * kt;
        f32x16 acc = {0.f, 0.f, 0.f, 0.f, 0.f, 0.f, 0.f, 0.f, 0.f, 0.f, 0.f, 0.f, 0.f, 0.f, 0.f, 0.f};
        if (sb >= 0) {
            const LAS unsigned char* kp = lds + slot * PK_SLOT + pm * PK_ROW + 64 * hi;
            bf16x8 kf[4];
#pragma unroll
            for (int d0 = 0; d0 < 4; ++d0) kf[d0] = *(const LAS bf16x8*)(kp + 16 * d0);
#pragma unroll
            for (int d0 = 0; d0 < 4; ++d0) acc = __builtin_amdgcn_mfma_f32_32x32x16_bf16(kf[d0], qf[d0], acc, 0, 0, 0);
        }
        sc[kt] = acc;
    }
    float mx = -1e30f;
#pragma unroll
    for (int kt = 0; kt < 5; ++kt) { const int sb = 32 * qt - 128 + 32 * kt;
#pragma unroll
        for (int rr = 0; rr < 16; ++rr) { const int sk = sb + 16 * (rr >> 3) + 8 * hi + (rr & 7); const int dl = s_q - sk; const bool ok = (sk >= 0) && (dl >= 0) && (dl <= 128);
            const float v = ok ? sc[kt][rr] : -1e30f; sc[kt][rr] = v; mx = fmaxf(mx, v); } }
    mx = fmaxf(mx, __shfl_xor(mx, 32));
    float l = 0.f;
#pragma unroll
    for (int kt = 0; kt < 5; ++kt)
#pragma unroll
        for (int rr = 0; rr < 16; ++rr) { const float p = fexp2(sc[kt][rr] - mx); sc[kt][rr] = p; l += p; }
    l += __shfl_xor(l, 32);
    f32x16 o[2];
#pragma unroll
    for (int dt = 0; dt < 2; ++dt) o[dt] = (f32x16){0.f, 0.f, 0.f, 0.f, 0.f, 0.f, 0.f, 0.f, 0.f, 0.f, 0.f, 0.f, 0.f, 0.f, 0.f, 0.f};
#pragma unroll
    for (int kt = 0; kt < 5; ++kt) {
        const int slot = slot_base + kt, sb = 32 * qt - 128 + 32 * kt;
        if (sb >= 0) {
            LAS unsigned char* vp = lds + PV_OFF + slot * PK_SLOT + (8 * hi + ((lane >> 2) & 3)) * PK_ROW + (16 * ((lane >> 4) & 1) + 4 * (lane & 3)) * 2;
            bf16x8 vf[2][2];
#pragma unroll
            for (int jj = 0; jj < 2; ++jj)
#pragma unroll
                for (int dt = 0; dt < 2; ++dt) vf[jj][dt] = cat44(lds_tr4(vp + (16 * jj) * PK_ROW + 64 * dt), lds_tr4(vp + (16 * jj + 4) * PK_ROW + 64 * dt));
#pragma unroll
            for (int jj = 0; jj < 2; ++jj) {
                const bf16x8 pb = pack8(sc[kt][8 * jj + 0], sc[kt][8 * jj + 1], sc[kt][8 * jj + 2], sc[kt][8 * jj + 3], sc[kt][8 * jj + 4], sc[kt][8 * jj + 5], sc[kt][8 * jj + 6], sc[kt][8 * jj + 7]);
#pragma unroll
                for (int dt = 0; dt < 2; ++dt) o[dt] = __builtin_amdgcn_mfma_f32_32x32x16_bf16(vf[jj][dt], pb, o[dt], 0, 0, 0);
            }
        }
    }
    const float il = frcp(l);
    bf16* op = AO + (size_t)qrow * AW + g * 256 + hh * 64 + 4 * hi;
#pragma unroll
    for (int dt = 0; dt < 2; ++dt)
#pragma unroll
        for (int r4 = 0; r4 < 4; ++r4) { u32x2 w; w.x = cvt_pk_bf16(o[dt][4 * r4] * il, o[dt][4 * r4 + 1] * il); w.y = cvt_pk_bf16(o[dt][4 * r4 + 2] * il, o[dt][4 * r4 + 3] * il);
            *(u32x2*)(op + 32 * dt + 8 * r4) = w; }
    if (hi == 0) LSE[(size_t)qrow * 12 + g * 4 + hh] = (mx + flog2(l)) * LN2;
    __syncthreads();
}

template <int NB> __device__ __forceinline__ void combine_rows(const bf16* AO, const float* LSE, const float* aon, bf16* MIXED, int R0, int lane) {
    const int hh = lane >> 4; float ls[NB][3]; u32x2 ow[NB][3];
#pragma unroll
    for (int i = 0; i < NB; ++i)
#pragma unroll
        for (int g = 0; g < 3; ++g) { ow[i][g] = *(const u32x2*)(AO + (size_t)(R0 + i) * AW + g * 256 + 4 * lane); ls[i][g] = LSE[(size_t)(R0 + i) * 12 + g * 4 + hh]; }
    f32x4 gn[3];
#pragma unroll
    for (int g = 0; g < 3; ++g) gn[g] = *(const f32x4*)(aon + g * 256 + 4 * lane);
#pragma unroll
    for (int i = 0; i < NB; ++i) {
        const float mx = fmaxf(fmaxf(ls[i][0], ls[i][1]), ls[i][2]);
        float e[3]; e[0] = fexp2((ls[i][0] - mx) * LOG2E); e[1] = fexp2((ls[i][1] - mx) * LOG2E); e[2] = fexp2((ls[i][2] - mx) * LOG2E);
        const float inv = frcp(e[0] + e[1] + e[2]);
        f32x4 v[3]; float ss = 0.f;
#pragma unroll
        for (int g = 0; g < 3; ++g) { const float al = e[g] * inv; v[g] = (f32x4){bf2f(ow[i][g].x & 0xffffu), bf2f(ow[i][g].x >> 16), bf2f(ow[i][g].y & 0xffffu), bf2f(ow[i][g].y >> 16)} * al; ss += dot4(v[g]); }
        const float rs = frsq(wave_sum(ss) * (1.0f / 768.0f) + EPS);
#pragma unroll
        for (int g = 0; g < 3; ++g) { const f32x4 y = v[g] * rs * gn[g];
            u32x2 w; w.x = cvt_pk_bf16(y[0], y[1]); w.y = cvt_pk_bf16(y[2], y[3]); *(u32x2*)(MIXED + (size_t)(R0 + i) * D + g * 256 + 4 * lane) = w; }
    }
}
__device__ __forceinline__ float gelu_tanh(float x) { const float u2 = 1.5957691216057308f * (x + 0.044715f * x * x * x); return x * frcp(1.0f + fexp2(-u2 * LOG2E)); }
__device__ __forceinline__ float sigmoidf_(float z) { return frcp(1.0f + fexp2(-z * LOG2E)); }
__device__ __forceinline__ void ssm_c_item(const Args& a, const float* U, const float* ssmc, const float* SSMF, const bf16* WGLU, bf16* MIXED, LAS unsigned char* lds, int item, int wave, int lane) {
    const bool hs = item < 32;
    const int b = item >> 5, c = item & 31;
    const int R0 = item * 64, RS0 = MP + item * 16;
    LAS unsigned* HL = (LAS unsigned*)(lds + wave * 4352);
    LAS float* ZS = (LAS float*)(lds + 34816);
    const int t16 = lane & 15, q4 = lane >> 4;
    for (int gi = 0; gi < 2; ++gi) {
        const int g = 2 * wave + gi;
        const f32x4* cp = (const f32x4*)(ssmc + (size_t)(g * 64 + lane) * 8); const f32x4 c0 = cp[0], c1 = cp[1];
        const float ar = c0[0], ai = c0[1], a64r = c1[0], a64i = c1[1];
        bf16x8 bb[4]; ssm_bfrags(a, ssmc, g, lane, bb);
        bf16x8 cf[4];
#pragma unroll
        for (int s4 = 0; s4 < 4; ++s4) { const int p0 = 16 * s4 + 4 * q4; const f32x4 x = *(const f32x4*)(a.in[I_CRE] + (size_t)(g * 16 + t16) * 64 + p0), y = *(const f32x4*)(a.in[I_CIM] + (size_t)(g * 16 + t16) * 64 + p0);
            cf[s4] = pack8(x[0], -y[0], x[1], -y[1], x[2], -y[2], x[3], -y[3]); }
        const f32x4 dv = *(const f32x4*)(a.in[I_SD] + g * 16 + 4 * q4);
        float hr = 0.f, hi = 0.f;
        {
            const int nb16 = (c + 15) >> 4; int cc0 = c - 16 * nb16;
            for (int i16 = 0; i16 < nb16; ++i16, cc0 += 16) { f32x2 f[16];
#pragma unroll
                for (int j = 0; j < 16; ++j) { const int cc = cc0 + j; f[j] = cc >= 0 ? *(const f32x2*)(SSMF + ((size_t)((b * 32 + cc) * 16 + g) * 64 + lane) * 2) : (f32x2){0.f, 0.f}; }
#pragma unroll
                for (int j = 0; j < 16; ++j) { const float nr = fmaf(a64r, hr, fmaf(-a64i, hi, f[j][0])), ni = fmaf(a64r, hi, fmaf(a64i, hr, f[j][1])); hr = nr; hi = ni; } }
        }
        bf16x8 ua2[2]; f32x4 uv4[4];
        ua2[0] = ssm_loadu(U, R0, 32, g, lane); ua2[1] = ssm_loadu(U, R0 + 32, 32, g, lane);
#pragma unroll
        for (int j = 0; j < 4; ++j) uv4[j] = *(const f32x4*)(U + (size_t)(R0 + 16 * j + t16) * 256 + g * 16 + 4 * q4);
#pragma unroll
        for (int blk = 0; blk < 2; ++blk) {
            f32x16 xr[2], xi[2]; ssm_xcompute(ua2[blk], bb, xr, xi);
#pragma unroll
            for (int s2 = 0; s2 < 2; ++s2) {
                const int trow = 32 * blk + 16 * s2 + t16;
                const f32x4 uv = uv4[2 * blk + s2];
#pragma unroll
                for (int tt = 0; tt < 16; ++tt) { const int t = 16 * s2 + tt;
                    const float nr = fmaf(ar, hr, fmaf(-ai, hi, SSM_XR(t))), ni = fmaf(ar, hi, fmaf(ai, hr, SSM_XI(t))); hr = nr; hi = ni;
                    HL[tt * 68 + lane] = cvt_pk_bf16(hr, hi);
                }
                LDS_WAIT(); asm volatile("" ::: "memory");
                f32x4 y = {0.f, 0.f, 0.f, 0.f};
#pragma unroll
                for (int s4 = 0; s4 < 4; ++s4) { const bf16x8 hf = *(const LAS bf16x8*)((LAS unsigned short*)HL + t16 * 136 + 32 * s4 + 8 * q4); y = __builtin_amdgcn_mfma_f32_16x16x32_bf16(cf[s4], hf, y, 0, 0, 0); }
                f32x4 z;
#pragma unroll
                for (int e = 0; e < 4; ++e) z[e] = gelu_tanh(y[e] + dv[e] * uv[e]);
                *(LAS f32x4*)(ZS + trow * 260 + g * 16 + 4 * q4) = z;
                LDS_WAIT(); asm volatile("" ::: "memory");
            }
        }
        if (c == 31) { a.out[O_SREP + (size_t)(b * 16 + g) * 64 + lane] = hr; a.out[O_SIMP + (size_t)(b * 16 + g) * 64 + lane] = hi; }
        if (hs) {
            float sre[4], sim[4];
#pragma unroll
            for (int j = 0; j < 4; ++j) { const size_t o = (size_t)((4 * item + j) * 16 + g) * 64 + lane; sre[j] = a.in[I_SRE][o]; sim[j] = a.in[I_SIM][o]; }
            const bf16x8 ua = ssm_loadu(U, RS0, 16, g, lane);
            const f32x4 uv = *(const f32x4*)(U + (size_t)(RS0 + t16) * 256 + g * 16 + 4 * q4);
            f32x16 xr[2], xi[2]; ssm_xcompute(ua, bb, xr, xi);
#pragma unroll
            for (int tt = 0; tt < 16; ++tt) {
                if ((tt & 3) == 0) { hr = sre[tt >> 2]; hi = sim[tt >> 2]; }
                const float nr = fmaf(ar, hr, fmaf(-ai, hi, SSM_XR(tt))), ni = fmaf(ar, hi, fmaf(ai, hr, SSM_XI(tt))); hr = nr; hi = ni;
                HL[tt * 68 + lane] = cvt_pk_bf16(hr, hi);
                if ((tt & 3) == 3) { const size_t o = (size_t)((4 * item + (tt >> 2)) * 16 + g) * 64 + lane; a.out[O_SRES + o] = hr; a.out[O_SIMS + o] = hi; }
            }
            LDS_WAIT(); asm volatile("" ::: "memory");
            f32x4 y = {0.f, 0.f, 0.f, 0.f};
#pragma unroll
            for (int s4 = 0; s4 < 4; ++s4) { const bf16x8 hf = *(const LAS bf16x8*)((LAS unsigned short*)HL + t16 * 136 + 32 * s4 + 8 * q4); y = __builtin_amdgcn_mfma_f32_16x16x32_bf16(cf[s4], hf, y, 0, 0, 0); }
            f32x4 z;
#pragma unroll
            for (int e = 0; e < 4; ++e) z[e] = gelu_tanh(y[e] + dv[e] * uv[e]);
            *(LAS f32x4*)(ZS + (64 + t16) * 260 + g * 16 + 4 * q4) = z;
            LDS_WAIT(); asm volatile("" ::: "memory");
        }
    }
    const int n = lane & 31, hi5 = lane >> 5, n0 = 32 * wave, nmt = hs ? 3 : 2;
    bf16x8 bfr[16];
#pragma unroll
    for (int st = 0; st < 16; ++st) bfr[st] = *(const bf16x8*)(WGLU + (size_t)(n0 + n) * 256 + 16 * st + 8 * hi5);
    const float bias = a.in[I_BGLU][n0 + n];
    const f32x4 gn = *(const f32x4*)(a.in[I_SON] + 4 * lane);
    __syncthreads();
    f32x16 acc[3];
#pragma unroll
    for (int mt = 0; mt < 3; ++mt) acc[mt] = (f32x16){0.f, 0.f, 0.f, 0.f, 0.f, 0.f, 0.f, 0.f, 0.f, 0.f, 0.f, 0.f, 0.f, 0.f, 0.f, 0.f};
#pragma unroll
    for (int st = 0; st < 16; ++st) {
        const bf16x8 bf = bfr[st];
#pragma unroll
        for (int mt = 0; mt < 3; ++mt) { if (mt < nmt) { const LAS float* zp = ZS + (32 * mt + n) * 260 + 16 * st + 8 * hi5; const f32x4 x = *(const LAS f32x4*)zp, y = *(const LAS f32x4*)(zp + 4);
            acc[mt] = __builtin_amdgcn_mfma_f32_32x32x16_bf16(pack8(x[0], x[1], x[2], x[3], y[0], y[1], y[2], y[3]), bf, acc[mt], 0, 0, 0); } }
    }
    float so[3][16];
#pragma unroll
    for (int mt = 0; mt < 3; ++mt) { if (mt < nmt) {
#pragma unroll
        for (int r = 0; r < 16; ++r) { const int t = 32 * mt + (r & 3) + 8 * (r >> 2) + 4 * hi5; so[mt][r] = ZS[t * 260 + n0 + n] * sigmoidf_(acc[mt][r] + bias); } } }
    __syncthreads();
#pragma unroll
    for (int mt = 0; mt < 3; ++mt) { if (mt < nmt) {
#pragma unroll
        for (int r = 0; r < 16; ++r) { const int t = 32 * mt + (r & 3) + 8 * (r >> 2) + 4 * hi5; ZS[t * 260 + n0 + n] = so[mt][r]; } } }
    __syncthreads();
#pragma unroll
    for (int i = 0; i < 10; ++i) { if (i >= 8 && !hs) break;
        const int row = i < 8 ? 8 * wave + i : 64 + 2 * wave + (i - 8); const f32x4 v = *(const LAS f32x4*)(ZS + row * 260 + 4 * lane);
        const float rs = frsq(wave_sum(dot4(v)) * (1.0f / 256.0f) + EPS); const f32x4 y = v * rs * gn;
        const size_t orow = i < 8 ? (size_t)(R0 + row) : (size_t)(RS0 + row - 64);
        u32x2 w; w.x = cvt_pk_bf16(y[0], y[1]); w.y = cvt_pk_bf16(y[2], y[3]); *(u32x2*)(MIXED + orow * D + 768 + 4 * lane) = w; }
    __syncthreads();
}

__device__ __forceinline__ float xq_sigma(const float* RS1, const float* QS, int R, int h) {
    const float rstd = frsq(RS1[R] * (1.0f / 1024.0f) + EPS), msq = QS[(size_t)R * 4 + h] * (1.0f / 256.0f);
    return rstd / sqrtf(rstd * rstd * msq + EPS) * (0.0625f * LOG2E);
}
template <int MODE, bool BASE_BF16 = false> __device__ __forceinline__ void sample_gemm_tile(const bf16* A, const bf16* Bt, int K, const void* base, float* outp, bf16* hb, float* ssq, LAS unsigned char* lds, int tile, int wave, int lane, int tid) {
    const int tm = tile >> 5, tn = tile & 31, n = lane & 31, hi = lane >> 5, kw = K >> 3;
    const bf16* ap = A + (size_t)(64 * tm + n) * K + wave * kw + 8 * hi;
    const bf16* bp = Bt + (size_t)(32 * tn + n) * K + wave * kw + 8 * hi;
    f32x16 acc0 = {0.f, 0.f, 0.f, 0.f, 0.f, 0.f, 0.f, 0.f, 0.f, 0.f, 0.f, 0.f, 0.f, 0.f, 0.f, 0.f}, acc1 = acc0;
    const int row = tid >> 3, c4 = (tid & 7) * 4, rs = 64 * tm + row, col = 32 * tn + c4;
    f32x4 bs = {0.f, 0.f, 0.f, 0.f};
    if (MODE == 0) {
        if (BASE_BF16) { const u32x2 w = *(const u32x2*)((const bf16*)base + (size_t)rs * D + col); bs = (f32x4){bf2f(w.x & 0xffffu), bf2f(w.x >> 16), bf2f(w.y & 0xffffu), bf2f(w.y >> 16)}; }
        else bs = *(const f32x4*)((const float*)base + (size_t)rs * D + col); }
#pragma unroll 8
    for (int s = 0; s < kw; s += 16) { const bf16x8 a0 = *(const bf16x8*)(ap + s), a1 = *(const bf16x8*)(ap + (size_t)32 * K + s), bb = *(const bf16x8*)(bp + s);
        acc0 = __builtin_amdgcn_mfma_f32_32x32x16_bf16(a0, bb, acc0, 0, 0, 0); acc1 = __builtin_amdgcn_mfma_f32_32x32x16_bf16(a1, bb, acc1, 0, 0, 0); }
    LAS float* P = (LAS float*)lds;
#pragma unroll
    for (int r = 0; r < 16; ++r) { const int row = (r & 3) + 8 * (r >> 2) + 4 * hi; P[(wave * 64 + row) * 32 + n] = acc0[r]; P[(wave * 64 + 32 + row) * 32 + n] = acc1[r]; }
    __syncthreads();
    f32x4 v = {0.f, 0.f, 0.f, 0.f};
#pragma unroll
    for (int w = 0; w < 8; ++w) v = v + *(const LAS f32x4*)(P + (w * 64 + row) * 32 + c4);
    float s;
    if (MODE == 0) {
        const f32x4 o = bs + v; if (outp) *(f32x4*)(outp + (size_t)rs * D + col) = o;
        if (hb) { u32x2 w; w.x = cvt_pk_bf16(o[0], o[1]); w.y = cvt_pk_bf16(o[2], o[3]); *(u32x2*)(hb + (size_t)rs * D + col) = w; }
        s = dot4(o); }
    else { u32x2 w; w.x = cvt_pk_bf16(v[0], v[1]); w.y = cvt_pk_bf16(v[2], v[3]); *(u32x2*)(hb + (size_t)rs * D + col) = w; s = dot4(v); }
    if (ssq) { s += __shfl_xor(s, 1); s += __shfl_xor(s, 2); s += __shfl_xor(s, 4); if ((tid & 7) == 0) atomic_addf(MODE == 0 ? ssq + rs : ssq + (size_t)rs * 4 + (tn >> 3), s); }
    __syncthreads();
}
constexpr int XK_ROW = 272, XK_BUF = 32 * XK_ROW, XV_BUF = XK_BUF, XV_OFF = 2 * XK_BUF;
__device__ __forceinline__ void xattn_wg_item(const bf16* QX, const float* SS1, const float* QSS, const bf16* MEMK, const bf16* MVT, bf16* OX, LAS unsigned char* lds, int it, int wave, int lane, int tid) {
    const int qb = it & 7, h = (it >> 3) & 3, b = it >> 5;
    const int n = lane & 31, hi = lane >> 5, R = b * 2048 + 256 * qb + 32 * wave + n;
    const float sigma = xq_sigma(SS1, QSS, R, h);
    const bf16* kg = MEMK + (size_t)(b * 256 + (tid >> 4)) * 1024 + h * 256 + 128 * ((tid >> 3) & 1) + 8 * (tid & 7);
    const bf16* vg = MVT + (size_t)(b * 256 + (tid >> 4)) * 1024 + h * 256 + 8 * (tid & 15);
    LAS unsigned char* kl = lds + (tid >> 4) * XK_ROW + (tid & 15) * 16;
    LAS unsigned char* vl = lds + XV_OFF + (tid >> 4) * XK_ROW + (tid & 15) * 16;
#define XSRC(t) ((t) < 16 ? (const u32x4*)(kg + (size_t)((t) & 7) * 32 * 1024 + ((t) >> 3) * 64) : (const u32x4*)(vg + (size_t)(((t) - 16) & 7) * 32 * 1024 + (((t) - 16) >> 3) * 128))
#define XPUT(t, w_) do { if ((t) < 16) *(LAS u32x4*)(kl + ((t) & 1) * XK_BUF) = (w_); else *(LAS u32x4*)(vl + ((t) & 1) * XV_BUF) = (w_); } while (0)
    u32x4 ring[3]; ring[0] = *XSRC(0); ring[1] = *XSRC(1); ring[2] = *XSRC(2);
    f32x16 sc[8];
#pragma unroll
    for (int kt = 0; kt < 8; ++kt) sc[kt] = (f32x16){0.f, 0.f, 0.f, 0.f, 0.f, 0.f, 0.f, 0.f, 0.f, 0.f, 0.f, 0.f, 0.f, 0.f, 0.f, 0.f};
    XPUT(0, ring[0]);
    __syncthreads();
    const LAS unsigned char* kr = lds + pi23(n) * XK_ROW + 128 * hi;
#pragma unroll
    for (int dh = 0; dh < 2; ++dh) {
        bf16x8 qf[8];
        { const bf16* qp = QX + (size_t)R * D + h * 256 + 128 * hi + 64 * dh;
#pragma unroll
          for (int st = 0; st < 8; ++st) qf[st] = *(const bf16x8*)(qp + 8 * st); }
#pragma unroll
        for (int kt = 0; kt < 8; ++kt) {
            const int s = dh * 8 + kt;
            ring[s % 3] = *XSRC(s + 3);
            const LAS unsigned char* kp = kr + (s & 1) * XK_BUF;
            bf16x8 kf[8];
#pragma unroll
            for (int st = 0; st < 8; ++st) kf[st] = *(const LAS bf16x8*)(kp + 16 * st);
            __builtin_amdgcn_sched_barrier(0);
#pragma unroll
            for (int st = 0; st < 8; ++st) sc[kt] = __builtin_amdgcn_mfma_f32_32x32x16_bf16(kf[st], qf[st], sc[kt], 0, 0, 0);
            XPUT(s + 1, ring[(s + 1) % 3]);
            asm volatile("s_waitcnt lgkmcnt(0)\n\ts_barrier" ::: "memory");
        }
    }
    float mx = -1e30f;
#pragma unroll
    for (int kt = 0; kt < 8; ++kt)
#pragma unroll
        for (int r = 0; r < 16; ++r) { sc[kt][r] *= sigma; mx = fmaxf(mx, sc[kt][r]); }
    mx = fmaxf(mx, __shfl_xor(mx, 32));
    float l = 0.f;
#pragma unroll
    for (int kt = 0; kt < 8; ++kt)
#pragma unroll
        for (int r = 0; r < 16; ++r) { const float p = fexp2(sc[kt][r] - mx); sc[kt][r] = p; l += p; }
    l += __shfl_xor(l, 32);
    const float il = frcp(l);
    bf16x8 pb[8][2];
#pragma unroll
    for (int kt = 0; kt < 8; ++kt)
#pragma unroll
        for (int jj = 0; jj < 2; ++jj) pb[kt][jj] = pack8(sc[kt][8 * jj + 0], sc[kt][8 * jj + 1], sc[kt][8 * jj + 2], sc[kt][8 * jj + 3], sc[kt][8 * jj + 4], sc[kt][8 * jj + 5], sc[kt][8 * jj + 6], sc[kt][8 * jj + 7]);
    LAS unsigned char* vr = lds + XV_OFF + (8 * hi + ((lane >> 2) & 3)) * XK_ROW + (16 * ((lane >> 4) & 1) + 4 * (lane & 3)) * 2;
    bf16* op = OX + (size_t)R * D + h * 256 + 4 * hi;
#pragma unroll
    for (int dh = 0; dh < 2; ++dh) {
        f32x16 o[4];
#pragma unroll
        for (int dt = 0; dt < 4; ++dt) o[dt] = (f32x16){0.f, 0.f, 0.f, 0.f, 0.f, 0.f, 0.f, 0.f, 0.f, 0.f, 0.f, 0.f, 0.f, 0.f, 0.f, 0.f};
#pragma unroll
        for (int kt = 0; kt < 8; ++kt) {
            const int s = 16 + dh * 8 + kt;
            if (s + 3 < 32) ring[s % 3] = *XSRC(s + 3);
            LAS unsigned char* vp = vr + (s & 1) * XV_BUF;
            bf16x8 vf[4][2];
#pragma unroll
            for (int dt = 0; dt < 4; ++dt)
#pragma unroll
                for (int jj = 0; jj < 2; ++jj) vf[dt][jj] = cat44(lds_tr4(vp + (16 * jj) * XK_ROW + 64 * dt), lds_tr4(vp + (16 * jj + 4) * XK_ROW + 64 * dt));
            __builtin_amdgcn_sched_barrier(0);
#pragma unroll
            for (int jj = 0; jj < 2; ++jj)
#pragma unroll
                for (int dt = 0; dt < 4; ++dt) o[dt] = __builtin_amdgcn_mfma_f32_32x32x16_bf16(vf[dt][jj], pb[kt][jj], o[dt], 0, 0, 0);
            if (s + 1 < 32) XPUT(s + 1, ring[(s + 1) % 3]);
            asm volatile("s_waitcnt lgkmcnt(0)\n\ts_barrier" ::: "memory");
        }
#pragma unroll
        for (int dt = 0; dt < 4; ++dt)
#pragma unroll
            for (int r4 = 0; r4 < 4; ++r4) { u32x2 w; w.x = cvt_pk_bf16(o[dt][4 * r4] * il, o[dt][4 * r4 + 1] * il); w.y = cvt_pk_bf16(o[dt][4 * r4 + 2] * il, o[dt][4 * r4 + 3] * il);
                *(u32x2*)(op + 128 * dh + 32 * dt + 8 * r4) = w; }
    }
}
#undef XSRC
#undef XPUT
constexpr int SXB = 4;
struct SxBatch { f32x4 k[SXB], v[SXB]; };
__device__ __forceinline__ void sx_load(SxBatch& B, const float* kb, unsigned loff, int j0) {
#pragma unroll
    for (int j = 0; j < SXB; ++j) { const char* p = (const char*)(kb + (size_t)(j0 + j) * 2048); B.k[j] = __builtin_nontemporal_load((const f32x4*)(p + loff)); B.v[j] = __builtin_nontemporal_load((const f32x4*)(p + 4096 + loff)); }
}
__device__ __forceinline__ float rdl(float v, int l) { return __builtin_bit_cast(float, __builtin_amdgcn_readlane(__builtin_bit_cast(int, v), l)); }
__device__ __forceinline__ void sx_compute(const SxBatch& B, const f32x4 (&q)[4], bool b5, bool b4, float& m, float& l, f32x4 (&o)[4]) {
    float s[SXB]; float mb = m;
#pragma unroll
    for (int j = 0; j < SXB; ++j) {
        float d[4];
#pragma unroll
        for (int t = 0; t < 4; ++t) d[t] = (q[t][0] * B.k[j][0] + q[t][1] * B.k[j][1]) + (q[t][2] * B.k[j][2] + q[t][3] * B.k[j][3]);
        const float x0 = b5 ? d[0] : d[2], x1 = b5 ? d[1] : d[3], k0 = b5 ? d[2] : d[0], k1 = b5 ? d[3] : d[1];
        const float r0 = k0 + __shfl_xor(x0, 32), r1 = k1 + __shfl_xor(x1, 32);
        const float xs = b4 ? r0 : r1, ks = b4 ? r1 : r0;
        float r = ks + __shfl_xor(xs, 16);
        r += __shfl_xor(r, 8); r += __shfl_xor(r, 4); r += __shfl_xor(r, 2); r += __shfl_xor(r, 1);
        s[j] = r; mb = fmaxf(mb, r);
    }
    const float sc = fexp2(m - mb); m = mb; l *= sc;
#pragma unroll
    for (int t = 0; t < 4; ++t) o[t] = o[t] * rdl(sc, 16 * t);
#pragma unroll
    for (int j = 0; j < SXB; ++j) { const float p = fexp2(s[j] - mb); l += p;
#pragma unroll
        for (int t = 0; t < 4; ++t) o[t] = o[t] + B.v[j] * rdl(p, 16 * t); }
}
template <int NSW> __device__ __forceinline__ void sxattn_stream(const Args& a, const bf16* QX, const float* SS1S, const float* QSSS, bf16* OX, LAS unsigned char* lds, LAS unsigned* cnt, int pair, int slot, int sw, int lane) {
    const int b = pair >> 2, h = pair & 3;
    LAS float* OL = (LAS float*)lds + (size_t)slot * (NSW * 1024); LAS float* ML = (LAS float*)(lds + 65536) + slot * 32; LAS float* LL = (LAS float*)(lds + 65536 + 256) + slot * 32;
    const f32x4 gq = *(const f32x4*)(a.in[I_XQN] + 4 * lane);
    f32x4 q[4];
    const float sgc = xq_sigma(SS1S, QSSS, MP + 4 * b + (lane >> 4), h);
#pragma unroll
    for (int t = 0; t < 4; ++t) { const int R = MP + 4 * b + t; const float sg = rdl(sgc, 16 * t); const u32x2 w = *(const u32x2*)(QX + (size_t)R * D + h * 256 + 4 * lane);
        q[t] = (f32x4){bf2f(w.x & 0xffffu), bf2f(w.x >> 16), bf2f(w.y & 0xffffu), bf2f(w.y >> 16)} * gq * sg; }
    constexpr int NK = 256 / NSW;
    const float* kb = a.in[I_CMEM] + ((size_t)(b * 256 + NK * sw) * 2) * 1024 + h * 256; const unsigned loff = 16u * (unsigned)lane;
    const bool b5 = (lane & 32) != 0, b4 = (lane & 16) != 0;
    float m = -1e30f, l = 0.f;
    f32x4 o[4];
#pragma unroll
    for (int t = 0; t < 4; ++t) o[t] = (f32x4){0.f, 0.f, 0.f, 0.f};
    SxBatch A, B; sx_load(A, kb, loff, 0);
#pragma unroll 1
    for (int j0 = 0; j0 < NK; j0 += 2 * SXB) {
        sx_load(B, kb, loff, j0 + SXB);
        sx_compute(A, q, b5, b4, m, l, o);
        if (j0 + 2 * SXB < NK) sx_load(A, kb, loff, j0 + 2 * SXB);
        sx_compute(B, q, b5, b4, m, l, o);
    }
#pragma unroll
    for (int t = 0; t < 4; ++t) *(LAS f32x4*)(OL + (sw * 4 + t) * 256 + 4 * lane) = o[t];
    if ((lane & 15) == 0) { ML[sw * 4 + (lane >> 4)] = m; LL[sw * 4 + (lane >> 4)] = l; }
    asm volatile("s_waitcnt lgkmcnt(0)" ::: "memory");
    unsigned old = 0u; if (lane == 0) old = __hip_atomic_fetch_add(cnt, 1u, __ATOMIC_ACQ_REL, __HIP_MEMORY_SCOPE_WORKGROUP);
    old = __builtin_amdgcn_readfirstlane(old);
    if (old == (unsigned)(NSW - 1)) {
        asm volatile("s_waitcnt lgkmcnt(0)" ::: "memory");
#pragma unroll
        for (int t = 0; t < 4; ++t) {
            float M = -1e30f;
#pragma unroll
            for (int w = 0; w < NSW; ++w) M = fmaxf(M, ML[w * 4 + t]);
            float L = 0.f; f32x4 acc = {0.f, 0.f, 0.f, 0.f};
#pragma unroll
            for (int w = 0; w < NSW; ++w) { const float f = fexp2(ML[w * 4 + t] - M); L += LL[w * 4 + t] * f; acc = acc + *(const LAS f32x4*)(OL + (w * 4 + t) * 256 + 4 * lane) * f; }
            const float il = frcp(L); u32x2 wv; wv.x = cvt_pk_bf16(acc[0] * il, acc[1] * il); wv.y = cvt_pk_bf16(acc[2] * il, acc[3] * il);
            *(u32x2*)(OX + (size_t)(MP + 4 * b + t) * D + h * 256 + 4 * lane) = wv;
        }
    }
}

__device__ __forceinline__ void up8(const bf16* p, float (&v)[8]) { const u32x4 w = *(const u32x4*)p;
    v[0] = bf2f(w.x & 0xffffu); v[1] = bf2f(w.x >> 16); v[2] = bf2f(w.y & 0xffffu); v[3] = bf2f(w.y >> 16); v[4] = bf2f(w.z & 0xffffu); v[5] = bf2f(w.z >> 16); v[6] = bf2f(w.w & 0xffffu); v[7] = bf2f(w.w >> 16); }
__device__ __forceinline__ void ld8(const float* p, float (&v)[8]) { const f32x4 a = *(const f32x4*)p, b = *(const f32x4*)(p + 4); v[0] = a[0]; v[1] = a[1]; v[2] = a[2]; v[3] = a[3]; v[4] = b[0]; v[5] = b[1]; v[6] = b[2]; v[7] = b[3]; }
__device__ __forceinline__ void conv_item(const Args& a, const bf16* UP, bf16* ACT, int it) {
    const int cgp = it % 352, rc = it / 352, j0 = cgp * 8, R0 = rc * 32;
    const float* cw = a.in[I_CONVW]; const float* cbp = a.in[I_CONVB];
    float wg[3][8], wv[3][8], bg[8], bv[8];
#pragma unroll
    for (int i = 0; i < 3; ++i) { ld8(cw + (size_t)i * FF2 + j0, wg[i]); ld8(cw + (size_t)i * FF2 + FF + j0, wv[i]); }
    ld8(cbp + j0, bg); ld8(cbp + FF + j0, bv);
    float g2[8], g1[8], v2[8], v1[8];
    const bool sample = R0 >= MP;
    if (!sample && (R0 & 2047) != 0) { up8(UP + (size_t)(R0 - 2) * FF2 + j0, g2); up8(UP + (size_t)(R0 - 1) * FF2 + j0, g1); up8(UP + (size_t)(R0 - 2) * FF2 + FF + j0, v2); up8(UP + (size_t)(R0 - 1) * FF2 + FF + j0, v1); }
    else {
#pragma unroll
        for (int e = 0; e < 8; ++e) { g2[e] = 0.f; g1[e] = 0.f; v2[e] = 0.f; v1[e] = 0.f; } }
    for (int r = 0; r < 32; ++r) { const int R = R0 + r;
        if (sample && (r & 3) == 0) { const float* sb = a.in[I_SCONV] + (size_t)((R - MP) >> 2) * 2 * FF2; ld8(sb + j0, g2); ld8(sb + FF2 + j0, g1); ld8(sb + FF + j0, v2); ld8(sb + FF2 + FF + j0, v1); }
        float gc[8], vc[8]; up8(UP + (size_t)R * FF2 + j0, gc); up8(UP + (size_t)R * FF2 + FF + j0, vc);
        float o[8];
#pragma unroll
        for (int e = 0; e < 8; ++e) { const float cgv = bg[e] + wg[0][e] * g2[e] + wg[1][e] * g1[e] + wg[2][e] * gc[e]; const float cvv = bv[e] + wv[0][e] * v2[e] + wv[1][e] * v1[e] + wv[2][e] * vc[e];
            o[e] = cgv * sigmoidf_(cgv) * cvv; g2[e] = g1[e]; g1[e] = gc[e]; v2[e] = v1[e]; v1[e] = vc[e]; }
        u32x4 w; w.x = cvt_pk_bf16(o[0], o[1]); w.y = cvt_pk_bf16(o[2], o[3]); w.z = cvt_pk_bf16(o[4], o[5]); w.w = cvt_pk_bf16(o[6], o[7]);
        *(u32x4*)(ACT + (size_t)R * FF + j0) = w;
    }
}

__device__ __forceinline__ void conv_fix_item(const Args& a, const float* EDGE, bf16* ACT, int it) {
    const int cgp = it % 352, rr = it / 352, r = rr & 1, ti = rr >> 1;
    const int pm = 8 * (ti / 7) + 1 + ti % 7, j0 = cgp * 8;
    const float* cw = a.in[I_CONVW]; const float* cbp = a.in[I_CONVB];
    const float* e_prev = EDGE + (size_t)(pm - 1) * 4 * FF2; const float* e_cur = EDGE + (size_t)pm * 4 * FF2;
    const float* r2 = r == 0 ? e_prev + 2 * FF2 : e_prev + 3 * FF2; const float* r1 = r == 0 ? e_prev + 3 * FF2 : e_cur; const float* r0 = r == 0 ? e_cur : e_cur + FF2;
    float o[8];
#pragma unroll
    for (int hf = 0; hf < 2; ++hf) { const int j4 = j0 + 4 * hf;
        const f32x4 cg = *(const f32x4*)(cbp + j4) + *(const f32x4*)(cw + j4) * *(const f32x4*)(r2 + j4) + *(const f32x4*)(cw + FF2 + j4) * *(const f32x4*)(r1 + j4) + *(const f32x4*)(cw + 2 * FF2 + j4) * *(const f32x4*)(r0 + j4);
        const f32x4 cv = *(const f32x4*)(cbp + FF + j4) + *(const f32x4*)(cw + FF + j4) * *(const f32x4*)(r2 + FF + j4) + *(const f32x4*)(cw + FF2 + FF + j4) * *(const f32x4*)(r1 + FF + j4) + *(const f32x4*)(cw + 2 * FF2 + FF + j4) * *(const f32x4*)(r0 + FF + j4);
#pragma unroll
        for (int e = 0; e < 4; ++e) o[4 * hf + e] = cg[e] * sigmoidf_(cg[e]) * cv[e]; }
    u32x4 w; w.x = cvt_pk_bf16(o[0], o[1]); w.y = cvt_pk_bf16(o[2], o[3]); w.z = cvt_pk_bf16(o[4], o[5]); w.w = cvt_pk_bf16(o[6], o[7]);
    *(u32x4*)(ACT + (size_t)(pm * 256 + r) * FF + j0) = w;
}

__device__ __forceinline__ void conv_fix_tile(const Args& a, const float* EDGE, bf16* ACT, int pm, int tid) {
    const float* cw = a.in[I_CONVW]; const float* cbp = a.in[I_CONVB];
    const float* e_prev = EDGE + (size_t)(pm - 1) * 4 * FF2; const float* e_cur = EDGE + (size_t)pm * 4 * FF2;
    for (int it = tid; it < 2 * 352; it += NWAVES * 64) { const int r = it / 352, j0 = (it - r * 352) * 8;
        const float* r2 = r == 0 ? e_prev + 2 * FF2 : e_prev + 3 * FF2; const float* r1 = r == 0 ? e_prev + 3 * FF2 : e_cur; const float* r0 = r == 0 ? e_cur : e_cur + FF2;
        float o[8];
#pragma unroll
        for (int hf = 0; hf < 2; ++hf) { const int j4 = j0 + 4 * hf;
            const f32x4 cg = *(const f32x4*)(cbp + j4) + *(const f32x4*)(cw + j4) * *(const f32x4*)(r2 + j4) + *(const f32x4*)(cw + FF2 + j4) * *(const f32x4*)(r1 + j4) + *(const f32x4*)(cw + 2 * FF2 + j4) * *(const f32x4*)(r0 + j4);
            const f32x4 cv = *(const f32x4*)(cbp + FF + j4) + *(const f32x4*)(cw + FF + j4) * *(const f32x4*)(r2 + FF + j4) + *(const f32x4*)(cw + FF2 + FF + j4) * *(const f32x4*)(r1 + FF + j4) + *(const f32x4*)(cw + 2 * FF2 + FF + j4) * *(const f32x4*)(r0 + FF + j4);
#pragma unroll
            for (int e = 0; e < 4; ++e) o[4 * hf + e] = cg[e] * sigmoidf_(cg[e]) * cv[e]; }
        u32x4 w; w.x = cvt_pk_bf16(o[0], o[1]); w.y = cvt_pk_bf16(o[2], o[3]); w.z = cvt_pk_bf16(o[4], o[5]); w.w = cvt_pk_bf16(o[6], o[7]);
        *(u32x4*)(ACT + (size_t)(pm * 256 + r) * FF + j0) = w; }
}

#ifndef MK_N_LAUNCHES
#define MK_N_LAUNCHES 1
#endif
constexpr int N_PHASES = 11;
#ifndef DUP_PHASE
#define DUP_PHASE -1
#endif
#define NREP(k) ((DUP_PHASE) == (k) ? 2 : 1)
constexpr int N_LAUNCHES = MK_N_LAUNCHES;
static_assert(N_LAUNCHES == 1 || N_LAUNCHES == N_PHASES, "MK_N_LAUNCHES is 1 or 11");

__global__ void __launch_bounds__(NWAVES * 64, 2) fwd_kernel(Args args) {
    extern __shared__ __attribute__((aligned(16))) unsigned char lds_raw[];
    LAS unsigned char* lds = (LAS unsigned char*)lds_raw;
    volatile LAS unsigned* MISC = (volatile LAS unsigned*)(lds + MISC_OFF);
    const int tid0 = threadIdx.x, wave0 = __builtin_amdgcn_readfirstlane(tid0 >> 6);
    const int G = gridDim.x; const int bx = blockIdx.x; const int vcu = (G % 8 == 0) ? (bx % 8) * (G / 8) + bx / 8 : bx;
    const int NGW = G * NWAVES;
    unsigned char* ws = args.ws;
    gu32* ctl = (gu32*)(ws + WS_CTL);
    for (int u = tid0; u < 128; u += NWAVES * 64) ((LAS unsigned*)(lds + MISC_OFF))[u] = 0u;
    __syncthreads();
    XcdBarrier bar; bar.bar = (unsigned*)(ctl + CW_BAR); bar.x = 0; bar.st = nullptr;
    if (N_LAUNCHES == 1) bar = xcd_barrier_post((unsigned*)(ctl + CW_BAR) + args.li * XCD_BAR_WORDS, MISC + 8);
#ifdef DOUBLE_BAR
#define GRID_BAR() do { if (N_LAUNCHES == 1) { xcd_barrier(bar); xcd_barrier(bar); } } while (0)
#else
#define GRID_BAR() do { if (N_LAUNCHES == 1) xcd_barrier(bar); } while (0)
#endif
    const int lo = args.ph_lo, hi = args.ph_hi;
#define IN(k) (lo <= (k) && (k) < hi)
#define WSBASE() GAS unsigned char* wsl = (GAS unsigned char*)ws; asm volatile("" : "+s"(wsl));     int tid = threadIdx.x; asm volatile("" : "+v"(tid)); const int lane = tid & 63, wave = __builtin_amdgcn_readfirstlane(tid >> 6), gw = vcu * NWAVES + wave; (void)lane; (void)gw
#define ROPE_ ((float*)(wsl + WS_ROPE))
#define SSMC_ ((float*)(wsl + WS_SSMC))
#define WIN ((bf16*)(wsl + WS_WIN))
#define WOUT ((bf16*)(wsl + WS_WOUT))
#define WXQ ((bf16*)(wsl + WS_WXQ))
#define WXKV ((bf16*)(wsl + WS_WXKV))
#define WXO ((bf16*)(wsl + WS_WXO))
#define WUP ((bf16*)(wsl + WS_WUP))
#define WDOWN ((bf16*)(wsl + WS_WDOWN))
#define WGLU ((bf16*)(wsl + WS_WGLU))
#define XN ((bf16*)(wsl + WS_XN))
#define MEMN ((bf16*)(wsl + WS_MEMN))
#define Qb ((bf16*)(wsl + WS_Q))
#define Kb ((bf16*)(wsl + WS_K))
#define VT ((bf16*)(wsl + WS_VT))
#define U_ ((float*)(wsl + WS_U))
#define AO ((bf16*)(wsl + WS_AO))
#define LSE ((float*)(wsl + WS_LSE))
#define SSMF ((float*)(wsl + WS_SSMF))
#define MIXED ((bf16*)(wsl + WS_MIXED))
#define H1B ((bf16*)(wsl + WS_H1B))
#define SS1 ((float*)(wsl + WS_CTL + CTL_RS1))
#define QX ((bf16*)(wsl + WS_QX))
#define QSS ((float*)(wsl + WS_CTL + CTL_QS))
#define MSS ((float*)(wsl + WS_MSS))
#define MEMK ((bf16*)(wsl + WS_MEMK))
#define MVT ((bf16*)(wsl + WS_MVT))
#define OX ((bf16*)(wsl + WS_OX))
#define H2B ((bf16*)(wsl + WS_H2B))
#define SS2 ((float*)(wsl + WS_CTL + CTL_RS2))
#define UP ((bf16*)(wsl + WS_UP))
#define ACT ((bf16*)(wsl + WS_ACT))
#define SS1S (SS1 + MP)
#define QSSS (QSS + (size_t)MP * 4)
#define SS2S (SS2 + MP)
    float* out = args.out;

    if (IN(0)) for (int rep_ = 0; rep_ < NREP(0); ++rep_) { WSBASE();
        LAS float* scr = (LAS float*)(lds + wave * 16384);
        constexpr int I_IN = 16 * (INW / 32), I_SQ = 16 * (D / 32), I_KV = 16 * (2048 / 32), I_UP = 16 * (FF2 / 32), I_DN = (FF / 64) * (D / 32), I_GL = 4 * 8;
        constexpr int NIT = I_IN + 3 * I_SQ + I_KV + I_UP + I_DN + I_GL;
        for (int it = gw; it < NIT; it += NGW) {
            int r = it;
            if (r < I_IN) { p0_transpose_item<1>(args.in[I_WIN], D, INW, WIN, nullptr, scr, r, lane); continue; } r -= I_IN;
            if (r < I_SQ) { p0_transpose_item<0>(args.in[I_WOUT], D, D, WOUT, nullptr, scr, r, lane); continue; } r -= I_SQ;
            if (r < I_SQ) { p0_transpose_item<0>(args.in[I_WXQ], D, D, WXQ, args.in[I_NX], scr, r, lane); continue; } r -= I_SQ;
            if (r < I_SQ) { p0_transpose_item<0>(args.in[I_WXO], D, D, WXO, nullptr, scr, r, lane); continue; } r -= I_SQ;
            if (r < I_KV) { p0_transpose_item<0>(args.in[I_WXKV], D, 2048, WXKV, nullptr, scr, r, lane); continue; } r -= I_KV;
            if (r < I_UP) { p0_transpose_item<2>(args.in[I_WUP], D, FF2, WUP, args.in[I_NFFN], scr, r, lane); continue; } r -= I_UP;
            if (r < I_DN) { p0_transpose_item<0>(args.in[I_WDOWN], FF, D, WDOWN, nullptr, scr, r, lane); continue; } r -= I_DN;
            p0_transpose_item<0>(args.in[I_WGLU], 256, 256, WGLU, nullptr, scr, r, lane);
        }
        { f32x4 gg[4];
#pragma unroll
          for (int j = 0; j < 4; ++j) gg[j] = ((const f32x4*)args.in[I_NMIX])[lane + 64 * j];
          for (int m = 2 * gw; m < MT; m += 2 * NGW) { const float* x0 = m < MP ? args.in[I_XP] + (size_t)m * D : args.in[I_XS] + (size_t)(m - MP) * D;
              rms_rows2_to_bf16(x0, x0 + D, gg, XN + (size_t)m * D, XN + (size_t)(m + 1) * D, lane); }
#pragma unroll
          for (int j = 0; j < 4; ++j) gg[j] = ((const f32x4*)args.in[I_NMEM])[lane + 64 * j];
          for (int m = 2 * gw; m < MM; m += 2 * NGW) rms_rows2_to_bf16(args.in[I_MEM] + (size_t)m * D, args.in[I_MEM] + (size_t)(m + 1) * D, gg, MEMN + (size_t)m * D, MEMN + (size_t)(m + 1) * D, lane); }
        {
            const int gt = vcu * (NWAVES * 64) + tid;
            if (gt < 2052 * 8) { const int pos = gt >> 3, i = gt & 7; const float iv = i == 0 ? 1.0f : i == 1 ? 0.1939227432012558f : i == 2 ? 0.03760603070259094f : i == 3 ? 0.007292664609849453f : i == 4 ? 0.0014142135623842478f : i == 5 ? 0.00027424818836152554f : i == 6 ? 5.3182957344688475e-05f : 1.0313385246263351e-05f;
                const float ang = (float)pos * iv; double s, c; sincos_d((double)ang, s, c); ROPE_[pos * 16 + i] = (float)c; ROPE_[pos * 16 + 8 + i] = (float)s; }
            const int st = gt - 2052 * 8;
            if (st >= 0 && st < 1024) {
                const int g = st >> 6; const double dt = exp_d((double)args.in[I_LDT][g]); const double lr = (double)args.in[I_LRE][st], li = (double)args.in[I_LIM][st];
                const double mag = exp_d(lr * dt); double s, c; sincos_d(li * dt, s, c); const double are = mag * c, aim = mag * s;
                const double den = lr * lr + li * li, nr = are - 1.0, ni = aim; const double cre = (nr * lr + ni * li) / den, cim = (ni * lr - nr * li) / den;
                const double mag64 = exp_d(64.0 * lr * dt); double s64, c64; sincos_d(64.0 * li * dt, s64, c64);
                float* o = SSMC_ + (size_t)st * 8; o[0] = (float)are; o[1] = (float)aim; o[2] = (float)cre; o[3] = (float)cim; o[4] = (float)(mag64 * c64); o[5] = (float)(mag64 * s64); o[6] = 0.f; o[7] = 0.f; }
        }
        GRID_BAR();
    }

    if (IN(1)) for (int rep_ = 0; rep_ < NREP(1); ++rep_) { WSBASE();
        int base = 0;
        { pg8::Gemm g{XN, WIN, MT, INW, D}; pg8::RotOrder S; S.init(MT, INW, G, bx, base); base += S.nwg;
          pg8::EpiZ E{Qb, Kb, VT, U_, ROPE_, args.in[I_QN], args.in[I_KN], out};
          pg8::gemm_phase<pg8::EpiZ, pg8::RotOrder, true, true>(lds, g, S, E); }
        { pg8::Gemm g{MEMN, WXKV, MM, 2048, D}; pg8::RotOrder S; S.init(MM, 2048, G, bx, base); base += S.nwg;
          pg8::EpiMem E{out + O_MEMKV, MSS, MVT}; pg8::gemm_phase<pg8::EpiMem, pg8::RotOrder, true, true>(lds, g, S, E); }
        GRID_BAR();
    }

    if (IN(2)) for (int rep_ = 0; rep_ < NREP(2); ++rep_) { WSBASE();
        if (rep_ == 0) for (int it = gw; it < MM; it += NGW) memk_fix_item(out + O_MEMKV, MSS, args.in[I_XKN], args.in[I_XQN], MEMK, it, lane);
        for (int r2_ = 0; r2_ < ((DUP_PHASE) == 21 ? 2 : 1); ++r2_)
        for (int it = vcu; it < 3 * 256; it += G) pattn_wg_item(Qb, Kb, VT, AO, LSE, lds, it, wave, lane, tid);
        LAS float* uL = (LAS float*)(lds + wave * 4096);
        if (wave < 6) { for (int it = vcu * 6 + wave; it < 3 * 512; it += G * 6) sattn_item(args, Qb, AO, LSE, it, lane); }
        else { for (int it = vcu * 2 + (wave - 6); it < 8 * 31 * 16; it += G * 2) ssm_a_item(args, U_, SSMC_, SSMF, uL, it, lane); }
        GRID_BAR();
    }

    if (IN(3)) for (int rep_ = 0; rep_ < NREP(3); ++rep_) { WSBASE();
        for (int r1_ = 0; r1_ < ((DUP_PHASE) == 31 ? 2 : 1); ++r1_)
        if (G > 64) {
            if (vcu >= 32) { const int ncw = (G - 32) * NWAVES; for (int R = ((vcu - 32) * NWAVES + wave) * 8; R < MT; R += ncw * 8) combine_rows<8>(AO, LSE, args.in[I_AON], MIXED, R, lane); }
        } else { for (int R = gw * 4; R < MT; R += NGW * 4) combine_rows<4>(AO, LSE, args.in[I_AON], MIXED, R, lane); }
        for (int r2_ = 0; r2_ < ((DUP_PHASE) == 32 ? 2 : 1); ++r2_)
        for (int it = vcu; it < 256; it += G) ssm_c_item(args, U_, SSMC_, SSMF, WGLU, MIXED, lds, it, wave, lane);
        GRID_BAR();
    }

    if (IN(4)) for (int rep_ = 0; rep_ < NREP(4); ++rep_) { WSBASE();
        pg8::Gemm g{MIXED, WOUT, MP, D, D}; pg8::RotOrder S; S.init(MP, D, G, bx, 0);
        pg8::EpiRes<false, false> E{args.in[I_XP], nullptr, H1B, SS1}; pg8::gemm_phase<pg8::EpiRes<false, false>, pg8::RotOrder, true, true>(lds, g, S, E);
        for (int tile = bx; tile < 256; tile += G)
            sample_gemm_tile<0, false>(MIXED + (size_t)MP * D, WOUT, D, args.in[I_XS], nullptr, H1B + (size_t)MP * D, SS1S, lds, tile, wave, lane, tid);
        GRID_BAR();
    }
    if (IN(5)) for (int rep_ = 0; rep_ < NREP(5); ++rep_) { WSBASE();
        pg8::Gemm g{H1B, WXQ, MP, D, D}; pg8::RotOrder S; S.init(MP, D, G, bx, 0);
        pg8::EpiQx E{QX, QSS}; pg8::gemm_phase<pg8::EpiQx, pg8::RotOrder, true, true>(lds, g, S, E);
        for (int tile = bx; tile < 256; tile += G)
            sample_gemm_tile<1>(H1B + (size_t)MP * D, WXQ, D, nullptr, nullptr, QX + (size_t)MP * D, QSSS, lds, tile, wave, lane, tid);
        GRID_BAR();
    }
    if (IN(6)) for (int rep_ = 0; rep_ < NREP(6); ++rep_) { WSBASE();
        if (tid < 8) ((LAS unsigned*)(lds + MISC_OFF))[16 + tid] = 0u;
        __syncthreads();
        for (int r2_ = 0; r2_ < ((DUP_PHASE) == 61 ? 2 : 1); ++r2_) {
            int slot = 0;
            for (int pair = vcu; pair < BS * 4; pair += G, ++slot) sxattn_stream<8>(args, QX, SS1, QSS, OX, lds, (LAS unsigned*)(lds + MISC_OFF) + 16 + (slot & 7), pair, slot & 1, wave, lane);
        }
        __syncthreads();
        { int tid2 = threadIdx.x; asm volatile("" : "+v"(tid2)); const int lane2 = tid2 & 63, wave2 = __builtin_amdgcn_readfirstlane(tid2 >> 6);
          GAS unsigned char* wsl2 = (GAS unsigned char*)ws; asm volatile("" : "+s"(wsl2));
        for (int r2_ = 0; r2_ < ((DUP_PHASE) == 62 ? 2 : 1); ++r2_)
        for (int it = vcu; it < 8 * 4 * 8; it += G) xattn_wg_item((bf16*)(wsl2 + WS_QX), (float*)(wsl2 + WS_CTL + CTL_RS1), (float*)(wsl2 + WS_CTL + CTL_QS), (bf16*)(wsl2 + WS_MEMK), (bf16*)(wsl2 + WS_MVT), (bf16*)(wsl2 + WS_OX), lds, it, wave2, lane2, tid2); }
        GRID_BAR();
    }
    if (IN(7)) for (int rep_ = 0; rep_ < NREP(7); ++rep_) { WSBASE();
        pg8::Gemm g{OX, WXO, MP, D, D}; pg8::RotOrder S; S.init(MP, D, G, bx, 0);
        pg8::EpiRes<true, false> E{H1B, nullptr, H2B, SS2}; pg8::gemm_phase<pg8::EpiRes<true, false>, pg8::RotOrder, true, true>(lds, g, S, E);
        for (int tile = bx; tile < 256; tile += G)
            sample_gemm_tile<0, true>(OX + (size_t)MP * D, WXO, D, H1B + (size_t)MP * D, nullptr, H2B + (size_t)MP * D, SS2S, lds, tile, wave, lane, tid);
        GRID_BAR();
    }
    if (IN(8)) for (int rep_ = 0; rep_ < NREP(8); ++rep_) { WSBASE();
        pg8::Gemm g{H2B, WUP, MT, FF2, D}; pg8::RotOrder S; S.init(MT, FF2, G, bx, 0);
        pg8::EpiUpConv E{ACT, (float*)(wsl + WS_EDGE), SS2, args.in[I_CONVW], args.in[I_CONVB], args.in[I_SCONV], out + O_CONVP, out + O_CONVS, lds}; pg8::gemm_phase<pg8::EpiUpConv, pg8::RotOrder, true, true>(lds, g, S, E);
        GRID_BAR();
    }
    if (IN(10)) for (int rep_ = 0; rep_ < NREP(10); ++rep_) { WSBASE();
        pg8::Gemm g{ACT, WDOWN, MP, D, FF}; pg8::RotOrder S; S.init(MP, D, G, bx, 0);
        { pg8::Unit uu; for (int i = 0; S.next(i, uu); ++i) if ((uu.pm & 7) != 0) conv_fix_tile(args, (const float*)(wsl + WS_EDGE), ACT, uu.pm, tid);
          VM_WAIT(); __syncthreads(); }
        pg8::EpiRes<true, true> E{H2B, out, nullptr, nullptr}; pg8::gemm_phase<pg8::EpiRes<true, true>, pg8::RotOrder, true, true>(lds, g, S, E);
        for (int tile = bx; tile < 256; tile += G)
            sample_gemm_tile<0, true>(ACT + (size_t)MP * FF, WDOWN, FF, H2B + (size_t)MP * D, out + (size_t)MP * D, nullptr, nullptr, lds, tile, wave, lane, tid);
    }
#if defined(DBG_SCALE_MASK)
    if (hi == N_PHASES) { GRID_BAR();
        const size_t offs[16] = {O_YP, O_YS, O_KV1P, O_KV4P, O_KV16P, O_SREP, O_SIMP, O_CONVP, O_MEMKV, O_KV1S, O_KV4S, O_KV16S, O_SRES, O_SIMS, O_CONVS, O_END};
        const size_t gt = (size_t)vcu * (NWAVES * 64) + tid, NT = (size_t)G * NWAVES * 64;
#pragma unroll
        for (int o = 0; o < 15; ++o) if ((DBG_SCALE_MASK >> o) & 1) { for (size_t i = offs[o] + gt; i < offs[o + 1]; i += NT) out[i] *= 3.0f; }
    }
#endif
#undef IN
#undef GRID_BAR
}

extern "C" void kernel_launch(void* const* d_in, const int* in_sizes, int n_in, void* d_out, int out_size, void* d_ws, size_t ws_size, hipStream_t stream) {
    static int grid = 0;
    if (grid == 0) {
        if (n_in != 39 || (size_t)out_size != O_END || ws_size < WS_END) { fprintf(stderr, "kernel_launch: unexpected problem shape (n_in %d, out %d, ws %zu); nothing launched\n", n_in, out_size, ws_size); grid = -1; return; }
        int dev = 0, cus = 0, per_cu = 0;
        if (hipGetDevice(&dev) != hipSuccess || hipDeviceGetAttribute(&cus, hipDeviceAttributeMultiprocessorCount, dev) != hipSuccess) { grid = -1; return; }
        if (hipFuncSetAttribute((const void*)fwd_kernel, hipFuncAttributeMaxDynamicSharedMemorySize, LDS_BYTES) != hipSuccess) { fprintf(stderr, "kernel_launch: hipFuncSetAttribute failed\n"); grid = -1; return; }
        if (hipOccupancyMaxActiveBlocksPerMultiprocessor(&per_cu, (const void*)fwd_kernel, NWAVES * 64, LDS_BYTES) != hipSuccess || per_cu < 1) { fprintf(stderr, "kernel_launch: occupancy query says %d workgroups per CU\n", per_cu); (void)hipGetLastError(); grid = -1; return; }
        grid = cus;
    }
    if (grid < 0) return;
    (void)hipMemsetAsync((char*)d_ws + WS_CTL, 0, CTL_ZERO_BYTES, stream);
    Args a{};
    for (int i = 0; i < 39; ++i) a.in[i] = (const float*)d_in[i];
    a.out = (float*)d_out; a.ws = (unsigned char*)d_ws;
#if defined(PROBE_PRE_HI)
    a.ph_lo = 0; a.ph_hi = PROBE_PRE_HI; a.li = 1; a.pad = 0;
    hipLaunchKernelGGL(fwd_kernel, dim3(grid), dim3(NWAVES * 64), LDS_BYTES, stream, a);
    (void)hipMemsetAsync((char*)d_ws + WS_CTL, 0, CTL_ZERO_BYTES, stream);
#endif
    for (int li = 0; li < N_LAUNCHES; ++li) {
        a.li = 0; a.pad = 0;
        a.ph_lo = (N_LAUNCHES == 1) ? 0 : li; a.ph_hi = (N_LAUNCHES == 1) ? N_PHASES : li + 1;
        hipLaunchKernelGGL(fwd_kernel, dim3(grid), dim3(NWAVES * 64), LDS_BYTES, stream, a);
        const hipError_t le = hipPeekAtLastError();
        if (le != hipSuccess) { fprintf(stderr, "kernel_launch: launch %d failed: %s\n", li, hipGetErrorName(le)); break; }
    }
}
```

```cpp
#include <hip/hip_runtime.h>
#include <cstdio>
#include <cstdint>

#define GAS __attribute__((address_space(1)))
#define LAS __attribute__((address_space(3)))
#define PG8_LAS __attribute__((address_space(3)))
typedef unsigned short bf16;
typedef short bf16x8 __attribute__((ext_vector_type(8)));
typedef float f32x4 __attribute__((ext_vector_type(4)));
typedef float f32x2 __attribute__((ext_vector_type(2)));
typedef float f32x16 __attribute__((ext_vector_type(16)));
typedef unsigned u32x4 __attribute__((ext_vector_type(4)));
typedef unsigned u32x2 __attribute__((ext_vector_type(2)));
typedef GAS unsigned gu32;
#define RLX_AGENT __ATOMIC_RELAXED, __HIP_MEMORY_SCOPE_AGENT
#define LDS_WAIT() asm volatile("s_waitcnt lgkmcnt(0)" ::: "memory")
#define VM_WAIT() asm volatile("s_waitcnt vmcnt(0)" ::: "memory")

constexpr int D = 1024, BP = 8, LP = 2048, MP = BP * LP, BS = 128, TS = 4, MS = BS * TS, MT = MP + MS;
constexpr int INW = 2560, AW = 768, SW = 256, NMEM = 256, MM = BP * NMEM, FF = 2816, FF2 = 5632;
constexpr float EPS = 1e-6f;
constexpr float LOG2E = 1.4426950408889634f, LN2 = 0.6931471805599453f;
constexpr int NWAVES = 8;

constexpr size_t MiB = 1u << 20;
constexpr size_t WS_CTL = 0, CTL_ZERO_BYTES = 1 * MiB;
constexpr size_t WS_ROPE = 1 * MiB;
constexpr size_t WS_SSMC = 1 * MiB + 512 * 1024;
constexpr size_t WS_WIN = 2 * MiB, WS_WOUT = 7 * MiB, WS_WXQ = 9 * MiB, WS_WXKV = 11 * MiB, WS_WXO = 15 * MiB, WS_WUP = 17 * MiB, WS_WDOWN = 28 * MiB, WS_WGLU = 34 * MiB;
constexpr size_t WS_XN = 35 * MiB, WS_MEMN = 68 * MiB, WS_Q = 72 * MiB, WS_K = 97 * MiB, WS_VT = 122 * MiB, WS_U = 146 * MiB, WS_AO = 163 * MiB, WS_LSE = 188 * MiB;
constexpr size_t WS_SSMF = 189 * MiB, WS_MIXED = 191 * MiB, WS_H1B = 224 * MiB, WS_SS1 = 257 * MiB, WS_QX = 259 * MiB, WS_QSS = 292 * MiB, WS_MSS = 294 * MiB, WS_MEMK = 295 * MiB, WS_MVT = 299 * MiB;
constexpr size_t WS_OX = 303 * MiB, WS_H2B = 336 * MiB, WS_SS2 = 369 * MiB, WS_UP = 371 * MiB, WS_ACT = 553 * MiB, WS_END = 644 * MiB;
constexpr size_t WS_EDGE = 371 * MiB;
constexpr size_t WS_SS1S = 258 * MiB + 512 * 1024, WS_QSSS = 293 * MiB + 512 * 1024, WS_SS2S = 370 * MiB + 512 * 1024;
constexpr size_t CTL_RS1 = 128 * 1024, CTL_RS2 = 256 * 1024, CTL_QS = 384 * 1024;
constexpr int CW_BAR = 4096;

constexpr int RING_BYTES = 131072;
constexpr int MISC_OFF = 135168;
constexpr int LDS_BYTES = 147456;

__device__ __forceinline__ unsigned f2bf(float f) { unsigned u = __builtin_bit_cast(unsigned, f); return (u + 0x7fffu + ((u >> 16) & 1u)) >> 16; }
__device__ __forceinline__ unsigned pk2(float lo, float hi) { return f2bf(lo) | (f2bf(hi) << 16); }
__device__ __forceinline__ float bf2f(unsigned h) { return __builtin_bit_cast(float, h << 16); }
typedef __bf16 bf16v2_t __attribute__((ext_vector_type(2)));
__device__ __forceinline__ unsigned cvt_pk_bf16(float lo, float hi) { const f32x2 v = {lo, hi}; return __builtin_bit_cast(unsigned, __builtin_convertvector(v, bf16v2_t)); }
__device__ __forceinline__ bf16x8 pack8(float a0, float a1, float a2, float a3, float a4, float a5, float a6, float a7) {
    u32x4 w; w.x = cvt_pk_bf16(a0, a1); w.y = cvt_pk_bf16(a2, a3); w.z = cvt_pk_bf16(a4, a5); w.w = cvt_pk_bf16(a6, a7); return __builtin_bit_cast(bf16x8, w); }
__device__ __forceinline__ float wave_sum(float v) {
#pragma unroll
    for (int o = 1; o < 64; o <<= 1) v += __shfl_xor(v, o);
    return v;
}
__device__ __forceinline__ float fexp2(float x) { return __builtin_amdgcn_exp2f(x); }
__device__ __forceinline__ float flog2(float x) { return __builtin_amdgcn_logf(x); }
__device__ __forceinline__ float frcp(float x) { return __builtin_amdgcn_rcpf(x); }
__device__ __forceinline__ float frsq(float x) { return __builtin_amdgcn_rsqf(x); }
__device__ __forceinline__ void sincos_d(double x, double& s, double& c) {
    const double k = __builtin_rint(x * 0.63661977236758134308);
    double r = __builtin_fma(-k, 1.57079632679489655800e+00, x); r = __builtin_fma(-k, 6.12323399573676603587e-17, r);
    const long long q = (long long)k; const double r2 = r * r;
    double sp = 1.0 / 6227020800.0; sp = sp * r2 - 1.0 / 39916800.0; sp = sp * r2 + 1.0 / 362880.0; sp = sp * r2 - 1.0 / 5040.0; sp = sp * r2 + 1.0 / 120.0; sp = sp * r2 - 1.0 / 6.0; sp = sp * r2 + 1.0; sp = sp * r;
    double cp = -1.0 / 87178291200.0; cp = cp * r2 + 1.0 / 479001600.0; cp = cp * r2 - 1.0 / 3628800.0; cp = cp * r2 + 1.0 / 40320.0; cp = cp * r2 - 1.0 / 720.0; cp = cp * r2 + 1.0 / 24.0; cp = cp * r2 - 0.5; cp = cp * r2 + 1.0;
    const int qq = (int)(q & 3);
    s = (qq == 0) ? sp : (qq == 1) ? cp : (qq == 2) ? -sp : -cp;
    c = (qq == 0) ? cp : (qq == 1) ? -sp : (qq == 2) ? -cp : sp;
}
__device__ __forceinline__ double exp_d(double x) {
    const double k = __builtin_rint(x * 1.44269504088896340736);
    double r = __builtin_fma(-k, 6.93147180369123816490e-01, x); r = __builtin_fma(-k, 1.90821492927058770002e-10, r);
    double p = 1.0 / 6227020800.0;
    p = p * r + 1.0 / 479001600.0; p = p * r + 1.0 / 39916800.0; p = p * r + 1.0 / 3628800.0; p = p * r + 1.0 / 362880.0; p = p * r + 1.0 / 40320.0; p = p * r + 1.0 / 5040.0;
    p = p * r + 1.0 / 720.0; p = p * r + 1.0 / 120.0; p = p * r + 1.0 / 24.0; p = p * r + 1.0 / 6.0; p = p * r + 0.5; p = p * r + 1.0; p = p * r + 1.0;
    const int ki = (int)k;
    return __builtin_ldexp(p, ki);
}
__device__ __forceinline__ float dot4(f32x4 a) { return (a[0] * a[0] + a[1] * a[1]) + (a[2] * a[2] + a[3] * a[3]); }
__device__ __forceinline__ u32x4 pk8(f32x4 a, f32x4 b) { u32x4 w; w.x = cvt_pk_bf16(a[0], a[1]); w.y = cvt_pk_bf16(a[2], a[3]); w.z = cvt_pk_bf16(b[0], b[1]); w.w = cvt_pk_bf16(b[2], b[3]); return w; }
__device__ __forceinline__ f32x4 shx16(f32x4 a) { f32x4 r; r[0] = __shfl_xor(a[0], 16); r[1] = __shfl_xor(a[1], 16); r[2] = __shfl_xor(a[2], 16); r[3] = __shfl_xor(a[3], 16); return r; }
constexpr size_t O_KV1P_ = (size_t)MT * D, O_KV4P_ = O_KV1P_ + (size_t)BP * 128 * 512, O_KV16P_ = O_KV4P_ + (size_t)BP * 512 * 512;
constexpr size_t O_KV1S_ = O_KV16P_ + (size_t)BP * 2048 * 512 + 2 * BP * 1024 + (size_t)BP * 2 * FF2 + (size_t)MM * 2048, O_KV4S_ = O_KV1S_ + (size_t)MS * 512, O_KV16S_ = O_KV4S_ + (size_t)MS * 512;
typedef short s16x4 __attribute__((ext_vector_type(4)));
__device__ __forceinline__ s16x4 lds_tr4(LAS unsigned char* p) { return __builtin_bit_cast(s16x4, __builtin_amdgcn_ds_read_tr16_b64_v4i16((LAS s16x4*)p)); }
__device__ __forceinline__ bf16x8 cat44(s16x4 a, s16x4 b) { return (bf16x8){a[0], a[1], a[2], a[3], b[0], b[1], b[2], b[3]}; }
__device__ __forceinline__ void atomic_addf(float* p, float v) { (void)__hip_atomic_fetch_add(p, v, __ATOMIC_RELAXED, __HIP_MEMORY_SCOPE_AGENT); }

namespace pg8 {
#define PG8_LAS __attribute__((address_space(3)))
typedef unsigned short bf16_t;
typedef short bf16x8 __attribute__((ext_vector_type(8)));
typedef float f32x4 __attribute__((ext_vector_type(4)));
typedef unsigned u32x4 __attribute__((ext_vector_type(4)));
constexpr int BM = 256, BK = 64, HALF = 128, HTB = HALF * BK * 2  , STAGE_BYTES = 8 * HTB, NXCD = 8, WGM = 8;

__host__ __device__ __forceinline__ int lds_byte(int r, int c) { const int st = (r >> 4) * 2 + (c >> 5), rr = r & 15, cc = c & 31, ob = rr * 64 + cc * 2; return st * 1024 + (ob ^ (((ob >> 9) & 1) << 5)); }
__host__ __device__ __forceinline__ void stage_rc(int b, int& R, int& C) { const int st = b / 1024, sb = b % 1024, swz = sb ^ (((sb >> 9) & 1) << 5); R = (st >> 1) * 16 + swz / 64; C = (st & 1) * 32 + (swz % 64) / 2; }
__host__ __device__ __forceinline__ int perm32(int rho) { const int n = rho >> 4, i = rho & 15; return 8 * (i >> 2) + 4 * n + (i & 3); }

struct Unit { int pm, pn; };
struct Gemm { const bf16_t* A; const bf16_t* Bt; int M, N, K; };

struct StaticOrder {
    int nM, nN, nwg, G, c;
    __host__ __device__ void init(int M, int N, int G_, int c_) { nM = M / BM; nN = N / BM; nwg = nM * nN; G = G_; c = c_; }
    __host__ __device__ bool next(int i, Unit& u) const {
        const long L = (long)i * G + c; if (L >= nwg) return false;
        int wgid = (int)L; { const int q = nwg / NXCD, r = nwg % NXCD, xcd = wgid % NXCD, off = wgid / NXCD; wgid = (xcd < r ? xcd * (q + 1) : r * (q + 1) + (xcd - r) * q) + off; }
        const int nig = WGM * nN, gid = wgid / nig, fm = gid * WGM, gsz = (nM - fm) < WGM ? (nM - fm) : WGM;
        u.pm = fm + ((wgid % nig) % gsz); u.pn = (wgid % nig) / gsz; return true;
    }
    __device__ __forceinline__ void a_ready(const Unit&) const {}
    __device__ __forceinline__ void done(const Unit&) const {}
};


struct RotOrder {
    int nM, nN, nwg, G, c;
    __host__ __device__ void init(int M, int N, int G_, int blk, int base) { nM = M / BM; nN = N / BM; nwg = nM * nN; G = G_; const int rot = base % G_; c = blk - rot; if (c < 0) c += G_; }
    __host__ __device__ __forceinline__ bool next(int i, Unit& u) const {
        const long L = (long)i * G + c; if (L >= nwg) return false;
        int wgid = (int)L; { const int q = nwg / NXCD, r = nwg % NXCD, xcd = wgid % NXCD, off = wgid / NXCD; wgid = (xcd < r ? xcd * (q + 1) : r * (q + 1) + (xcd - r) * q) + off; }
        const int nig = WGM * nN, gid = wgid / nig, fm = gid * WGM, gsz = (nM - fm) < WGM ? (nM - fm) : WGM;
        u.pm = fm + ((wgid % nig) % gsz); u.pn = (wgid % nig) / gsz; return true;
    }
    __device__ __forceinline__ void a_ready(const Unit&) const {}
    __device__ __forceinline__ void done(const Unit&) const {}
};


struct EpiZ {
    static constexpr bool PERM = true, AFTER_DRAIN = false, BMAP = false, AMAP = false;
    bf16_t* Q; bf16_t* Kb; bf16_t* VN; float* U; const float* rope; const float* qg; const float* kg;
    float* outp;
    __device__ __forceinline__ int bmap(int r) const { return r; }
    __device__ __forceinline__ void operator()(const f32x4 (&acc)[2][2][4][2], const Unit& u, int wr, int wc, int fr, int fq) const {
        const int pn = u.pn; const bool sample = u.pm >= 64;
        const int rbase = u.pm * BM + wr * 64 + fr;
        if (pn == 9) {
#pragma unroll
            for (int ai = 0; ai < 2; ++ai)
#pragma unroll
                for (int m = 0; m < 4; ++m) { const int R = rbase + ai * HALF + m * 16; float* p = U + (size_t)R * 256 + wc * 64 + 8 * fq;
#pragma unroll
                    for (int bj = 0; bj < 2; ++bj) { *(f32x4*)(p + 32 * bj) = acc[ai][bj][m][0]; *(f32x4*)(p + 32 * bj + 4) = acc[ai][bj][m][1]; } }
            return;
        }
        const int kind = pn / 3, g = pn - 3 * kind;
        const int keep = g == 0 ? 128 : (g == 1 ? 512 : 2048);
        float* kvp = outp + (g == 0 ? O_KV1P_ : (g == 1 ? O_KV4P_ : O_KV16P_)); float* kvs = outp + (g == 0 ? O_KV1S_ : (g == 1 ? O_KV4S_ : O_KV16S_));
        if (kind == 2) {
#pragma unroll
            for (int ai = 0; ai < 2; ++ai)
#pragma unroll
                for (int m = 0; m < 4; ++m) { const int R = rbase + ai * HALF + m * 16; float* dst = nullptr;
                    if (sample) dst = kvs + ((size_t)(R - MP) * 2 + 1) * 256;
                    else { const int b = R >> 11, t = R & 2047; if (t >= 2048 - keep) dst = kvp + ((size_t)(b * keep + t - (2048 - keep)) * 2 + 1) * 256; }
                    if (dst) { dst += wc * 64 + 8 * fq;
#pragma unroll
                        for (int bj = 0; bj < 2; ++bj) { *(f32x4*)(dst + 32 * bj) = acc[ai][bj][m][0]; *(f32x4*)(dst + 32 * bj + 4) = acc[ai][bj][m][1]; } }
                    if (!sample) { bf16_t* vp = VN + (size_t)R * AW + g * 256 + wc * 64 + 8 * fq;
                        *(u32x4*)vp = pk8(acc[ai][0][m][0], acc[ai][0][m][1]); *(u32x4*)(vp + 32) = pk8(acc[ai][1][m][0], acc[ai][1][m][1]); } }
            return;
        }
        const float* gp = (kind == 0 ? qg : kg) + 8 * fq;
        const f32x4 g00 = *(const f32x4*)(gp), g01 = *(const f32x4*)(gp + 4), g10 = *(const f32x4*)(gp + 32), g11 = *(const f32x4*)(gp + 36);
        const float sgn = fq == 0 ? -1.f : 1.f;
        const float qs = kind == 0 ? 0.125f * LOG2E : 1.f;
        bf16_t* ob = kind == 0 ? Q : Kb;
        f32x4 rc0, rc1, rs0, rs1;
        { const int R = rbase; const int pos = sample ? 2048 + (R & 3) : (R & 2047); const float* rp = rope + (size_t)pos * 16; rc0 = *(const f32x4*)rp; rc1 = *(const f32x4*)(rp + 4); rs0 = *(const f32x4*)(rp + 8); rs1 = *(const f32x4*)(rp + 12); }
#pragma unroll
        for (int ai = 0; ai < 2; ++ai)
#pragma unroll
            for (int m = 0; m < 4; ++m) { const int R = rbase + ai * HALF + m * 16;
                const f32x4 c0 = rc0, c1 = rc1, s0 = rs0, s1 = rs1;
                if (ai * 4 + m < 7) { const int Rn = rbase + ((ai * 4 + m + 1) >> 2) * HALF + ((ai * 4 + m + 1) & 3) * 16; const int pos = sample ? 2048 + (Rn & 3) : (Rn & 2047); const float* rp = rope + (size_t)pos * 16;
                    rc0 = *(const f32x4*)rp; rc1 = *(const f32x4*)(rp + 4); rs0 = *(const f32x4*)(rp + 8); rs1 = *(const f32x4*)(rp + 12); }
                float ss = (dot4(acc[ai][0][m][0]) + dot4(acc[ai][0][m][1])) + (dot4(acc[ai][1][m][0]) + dot4(acc[ai][1][m][1])); ss += __shfl_xor(ss, 16); ss += __shfl_xor(ss, 32);
                const float rs = frsq(ss * (1.0f / 64.0f) + EPS);
                float* dst = nullptr;
                if (kind == 1) { if (sample) dst = kvs + ((size_t)(R - MP) * 2) * 256; else { const int b = R >> 11, t = R & 2047; if (t >= 2048 - keep) dst = kvp + ((size_t)(b * keep + t - (2048 - keep)) * 2) * 256; }
                    if (dst) dst += wc * 64 + 8 * fq; }
                bf16_t* op = ob + (size_t)R * AW + g * 256 + wc * 64 + 8 * fq;
                f32x4 xa = acc[ai][0][m][0] * rs * g00, xb = acc[ai][0][m][1] * rs * g01;
                { const f32x4 oa = shx16(xa), ob2 = shx16(xb);
                  if (fq < 2) { xa = xa * c0 + (oa * s0) * sgn; xb = xb * c1 + (ob2 * s1) * sgn; } }
                if (dst) { *(f32x4*)(dst) = xa; *(f32x4*)(dst + 4) = xb; }
                *(u32x4*)(op) = pk8(xa * qs, xb * qs);
                xa = acc[ai][1][m][0] * rs * g10; xb = acc[ai][1][m][1] * rs * g11;
                if (dst) { *(f32x4*)(dst + 32) = xa; *(f32x4*)(dst + 36) = xb; }
                *(u32x4*)(op + 32) = pk8(xa * qs, xb * qs);
            }
    }
};

struct EpiVt {
    static constexpr bool PERM = true, AFTER_DRAIN = false, BMAP = true, AMAP = false;
    bf16_t* VT; int g;
    __device__ __forceinline__ int bmap(int r) const { return g == 0 ? r : (g == 1 ? ((r & 63) * 4 + (r >> 6)) : ((r & 15) * 16 + (r >> 4))); }
    __device__ __forceinline__ void operator()(const f32x4 (&acc)[2][2][4][2], const Unit& u, int wr, int wc, int fr, int fq) const {
        const int b = u.pn >> 3, t0 = (u.pn & 7) * 256, sh = 2 * g, S = 2048 >> sh, Wl = 8 - sh;
#pragma unroll
        for (int ai = 0; ai < 2; ++ai)
#pragma unroll
            for (int m = 0; m < 4; ++m) { const int hh = 2 * wr + (m >> 1), d = 32 * ai + 16 * (m & 1) + fr;
#pragma unroll
                for (int bj = 0; bj < 2; ++bj) { const int c8 = 128 * bj + 32 * wc + 8 * fq, res = c8 >> Wl, ds = c8 & ((1 << Wl) - 1), pos = res * S + (t0 >> sh) + ds;
                    bf16_t* p = VT + ((((size_t)((g * 4 + hh) * 8 + b) * 64 + (pos >> 5)) * 64 + d) * 32 + (pos & 31));
                    *(u32x4*)p = pk8(acc[ai][bj][m][0], acc[ai][bj][m][1]); } }
    }
};

struct EpiMem {
    static constexpr bool PERM = true, AFTER_DRAIN = false, BMAP = false, AMAP = false;
    float* out; float* mss; bf16_t* MVN;
    __device__ __forceinline__ int bmap(int r) const { return r; }
    __device__ __forceinline__ void operator()(const f32x4 (&acc)[2][2][4][2], const Unit& u, int wr, int wc, int fr, int fq) const {
        const int kv = u.pn >> 2, h = u.pn & 3;
#pragma unroll
        for (int ai = 0; ai < 2; ++ai)
#pragma unroll
            for (int m = 0; m < 4; ++m) { const int R = u.pm * BM + ai * HALF + wr * 64 + m * 16 + fr; float* dst = out + ((size_t)R * 2 + kv) * 1024 + h * 256 + 32 * wc + 8 * fq; float ss = 0.f;
#pragma unroll
                for (int bj = 0; bj < 2; ++bj) { const f32x4 a = acc[ai][bj][m][0], c = acc[ai][bj][m][1]; *(f32x4*)(dst + 128 * bj) = a; *(f32x4*)(dst + 128 * bj + 4) = c; ss += dot4(a) + dot4(c);
                    if (kv) *(u32x4*)(MVN + (size_t)R * 1024 + h * 256 + 32 * wc + 8 * fq + 128 * bj) = pk8(a, c); }
                if (kv == 0) { ss += __shfl_xor(ss, 16); ss += __shfl_xor(ss, 32); if (fq == 0) mss[(size_t)R * 16 + h * 4 + wc] = ss; } }
    }
};
struct EpiMemVt {
    static constexpr bool PERM = true, AFTER_DRAIN = false, BMAP = false, AMAP = false;
    bf16_t* MVT;
    __device__ __forceinline__ int bmap(int r) const { return r; }
    __device__ __forceinline__ void operator()(const f32x4 (&acc)[2][2][4][2], const Unit& u, int wr, int wc, int fr, int fq) const {
        const int h = u.pm, b = u.pn;
#pragma unroll
        for (int ai = 0; ai < 2; ++ai)
#pragma unroll
            for (int m = 0; m < 4; ++m) { const int d = ai * HALF + wr * 64 + m * 16 + fr;
#pragma unroll
                for (int bj = 0; bj < 2; ++bj) { const int c8 = 128 * bj + 32 * wc + 8 * fq;
                    bf16_t* p = MVT + ((((size_t)(h * 8 + b) * 8 + (c8 >> 5)) * 256 + d) * 32 + (c8 & 31));
                    *(u32x4*)p = pk8(acc[ai][bj][m][0], acc[ai][bj][m][1]); } }
    }
};
template <bool BASE_BF16, bool OUT_F32> struct EpiRes {
    static constexpr bool PERM = true, AFTER_DRAIN = false, BMAP = false, AMAP = false;
    const void* base; float* out; bf16_t* hb; float* ssq;
    __device__ __forceinline__ int bmap(int r) const { return r; }
    __device__ __forceinline__ void operator()(const f32x4 (&acc)[2][2][4][2], const Unit& u, int wr, int wc, int fr, int fq) const {
        const int c0 = u.pn * BM + 32 * wc + 8 * fq;
#pragma unroll
        for (int ai = 0; ai < 2; ++ai) {
            f32x4 b0[4][2], b1[4][2];
#pragma unroll
            for (int m = 0; m < 4; ++m)
#pragma unroll
                for (int bj = 0; bj < 2; ++bj) { const size_t off = (size_t)(u.pm * BM + ai * HALF + wr * 64 + m * 16 + fr) * D + c0 + 128 * bj;
                    if (BASE_BF16) { const u32x4 w = *(const u32x4*)((const bf16_t*)base + off); b0[m][bj] = (f32x4){bf2f(w.x & 0xffffu), bf2f(w.x >> 16), bf2f(w.y & 0xffffu), bf2f(w.y >> 16)}; b1[m][bj] = (f32x4){bf2f(w.z & 0xffffu), bf2f(w.z >> 16), bf2f(w.w & 0xffffu), bf2f(w.w >> 16)}; }
                    else { b0[m][bj] = *(const f32x4*)((const float*)base + off); b1[m][bj] = *(const f32x4*)((const float*)base + off + 4); } }
            asm volatile("" ::: "memory");
#pragma unroll
            for (int m = 0; m < 4; ++m) { const int R = u.pm * BM + ai * HALF + wr * 64 + m * 16 + fr; float ss = 0.f;
#pragma unroll
                for (int bj = 0; bj < 2; ++bj) { const size_t off = (size_t)R * D + c0 + 128 * bj;
                    const f32x4 o0 = b0[m][bj] + acc[ai][bj][m][0], o1 = b1[m][bj] + acc[ai][bj][m][1];
                    if (OUT_F32) { *(f32x4*)(out + off) = o0; *(f32x4*)(out + off + 4) = o1; }
                    if (hb) *(u32x4*)(hb + off) = pk8(o0, o1);
                    ss += dot4(o0) + dot4(o1); }
                if (ssq) { ss += __shfl_xor(ss, 16); ss += __shfl_xor(ss, 32); if (fq == 0) atomic_addf(ssq + R, ss); } }
        }
    }
};
struct EpiQx {
    static constexpr bool PERM = true, AFTER_DRAIN = false, BMAP = false, AMAP = false;
    bf16_t* QX; float* qss;
    __device__ __forceinline__ int bmap(int r) const { return r; }
    __device__ __forceinline__ void operator()(const f32x4 (&acc)[2][2][4][2], const Unit& u, int wr, int wc, int fr, int fq) const {
        const int c0 = u.pn * BM + 32 * wc + 8 * fq;
#pragma unroll
        for (int ai = 0; ai < 2; ++ai)
#pragma unroll
            for (int m = 0; m < 4; ++m) { const int R = u.pm * BM + ai * HALF + wr * 64 + m * 16 + fr; float ss = 0.f;
#pragma unroll
                for (int bj = 0; bj < 2; ++bj) { const f32x4 a = acc[ai][bj][m][0], c = acc[ai][bj][m][1]; *(u32x4*)(QX + (size_t)R * D + c0 + 128 * bj) = pk8(a, c); ss += dot4(a) + dot4(c); }
                ss += __shfl_xor(ss, 16); ss += __shfl_xor(ss, 32); if (fq == 0) atomic_addf(qss + (size_t)R * 4 + u.pn, ss); }
    }
};
template <int CTRL> __device__ __forceinline__ float dppf(float old, float src) { return __builtin_bit_cast(float, __builtin_amdgcn_update_dpp(__builtin_bit_cast(int, old), __builtin_bit_cast(int, src), CTRL, 0xf, 0xf, false)); }
__device__ __forceinline__ f32x4 prev_rows1(f32x4 pg, f32x4 cur) { f32x4 r;
#pragma unroll
    for (int e = 0; e < 4; ++e) r[e] = dppf<0x111>(dppf<0x121>(0.f, pg[e]), cur[e]);
    return r; }
__device__ __forceinline__ f32x4 prev_rows2(f32x4 pg, f32x4 cur) { f32x4 r;
#pragma unroll
    for (int e = 0; e < 4; ++e) r[e] = dppf<0x112>(dppf<0x122>(0.f, pg[e]), cur[e]);
    return r; }
__device__ __forceinline__ float silu_(float x) { return x * frcp(1.0f + fexp2(-x * LOG2E)); }
constexpr int HALO_OFF = 135680;
struct EpiUpConv {
    static constexpr bool PERM = true, AFTER_DRAIN = false, BMAP = false, AMAP = true;
    bf16_t* ACT; float* EDGE; const float* rs2; const float* cw; const float* cb; const float* sconv; float* convp; float* convs; PG8_LAS unsigned char* lds;
    __device__ __forceinline__ int bmap(int r) const { return r; }
    __device__ __forceinline__ int amap(int r) const { return (r & 64) + 4 * (r & 15) + ((r >> 4) & 3); }
    __device__ __forceinline__ void operator()(f32x4 (&acc)[2][2][4][2], const Unit& u, int wr, int wc, int fr, int fq) const {
        const bool smp = u.pm >= 64;
        const int j8 = u.pn * 128 + 32 * wc + 8 * fq;
        f32x4 cwv[8];
#define UPC_LOADW(n_) do { const int j4_ = j8 + 4 * (n_); cwv[0] = *(const f32x4*)(cw + j4_); cwv[1] = *(const f32x4*)(cw + FF2 + j4_); cwv[2] = *(const f32x4*)(cw + 2 * FF2 + j4_); cwv[3] = *(const f32x4*)(cb + j4_); \
        cwv[4] = *(const f32x4*)(cw + FF + j4_); cwv[5] = *(const f32x4*)(cw + FF2 + FF + j4_); cwv[6] = *(const f32x4*)(cw + 2 * FF2 + FF + j4_); cwv[7] = *(const f32x4*)(cb + FF + j4_); } while (0)
        UPC_LOADW(0);
        const int tok0 = u.pm * BM + wr * 64 + 4 * fr;
        { float tot[2][4];
#pragma unroll
          for (int ai = 0; ai < 2; ++ai)
#pragma unroll
              for (int m = 0; m < 4; ++m) tot[ai][m] = rs2[tok0 + ai * HALF + m];
#pragma unroll
          for (int ai = 0; ai < 2; ++ai)
#pragma unroll
              for (int m = 0; m < 4; ++m) { const float rstd = frsq(tot[ai][m] * (1.0f / 1024.0f) + EPS);
#pragma unroll
                  for (int bj = 0; bj < 2; ++bj) { acc[ai][bj][m][0] = acc[ai][bj][m][0] * rstd; acc[ai][bj][m][1] = acc[ai][bj][m][1] * rstd; } } }
        PG8_LAS float* halo = (PG8_LAS float*)(lds + HALO_OFF);
        if (!smp && fr == 15) {
#pragma unroll
            for (int ai = 0; ai < 2; ++ai)
#pragma unroll
                for (int mm = 2; mm < 4; ++mm) { PG8_LAS float* hp = halo + ((((2 * ai + wr + 1) * 2 + (mm - 2)) * 4 + wc) * 4 + fq) * 16;
                    *(PG8_LAS f32x4*)(hp) = acc[ai][0][mm][0]; *(PG8_LAS f32x4*)(hp + 4) = acc[ai][0][mm][1]; *(PG8_LAS f32x4*)(hp + 8) = acc[ai][1][mm][0]; *(PG8_LAS f32x4*)(hp + 12) = acc[ai][1][mm][1]; }
        }
        asm volatile("s_waitcnt lgkmcnt(0)\n\ts_barrier" ::: "memory");
#pragma unroll
        for (int n = 0; n < 2; ++n) {
            const int j4 = j8 + 4 * n;
            if (n == 1) UPC_LOADW(1);
            const f32x4 wg0 = cwv[0], wg1 = cwv[1], wg2 = cwv[2], bgv = cwv[3], wv0 = cwv[4], wv1 = cwv[5], wv2 = cwv[6], bvv = cwv[7];
#pragma unroll
            for (int ai = 0; ai < 2; ++ai) {
                const int blk = 2 * ai + wr, tokb = tok0 + ai * HALF;
                f32x4 gm1, gm2, vm1, vm2;
                if (smp) { const float* sb = sconv + (size_t)((tokb - MP) >> 2) * 2 * FF2;
                    gm2 = *(const f32x4*)(sb + j4); vm2 = *(const f32x4*)(sb + FF + j4); gm1 = *(const f32x4*)(sb + FF2 + j4); vm1 = *(const f32x4*)(sb + FF2 + FF + j4); }
                else { f32x4 h2g = {0.f, 0.f, 0.f, 0.f}, h3g = h2g, h2v = h2g, h3v = h2g;
                    if (blk > 0 && fr == 0) { const PG8_LAS float* hp = halo + (((blk * 2) * 4 + wc) * 4 + fq) * 16; h2g = *(const PG8_LAS f32x4*)(hp + 4 * n); h2v = *(const PG8_LAS f32x4*)(hp + 8 + 4 * n);
                        h3g = *(const PG8_LAS f32x4*)(hp + 256 + 4 * n); h3v = *(const PG8_LAS f32x4*)(hp + 256 + 8 + 4 * n); }
#pragma unroll
                    for (int e = 0; e < 4; ++e) { gm1[e] = dppf<0x111>(h3g[e], acc[ai][0][3][n][e]); gm2[e] = dppf<0x111>(h2g[e], acc[ai][0][2][n][e]); vm1[e] = dppf<0x111>(h3v[e], acc[ai][1][3][n][e]); vm2[e] = dppf<0x111>(h2v[e], acc[ai][1][2][n][e]); } }
#pragma unroll
                for (int m = 0; m < 4; ++m) { const int R = tokb + m;
                    const f32x4 g = acc[ai][0][m][n], v = acc[ai][1][m][n];
                    const f32x4 g1 = m == 0 ? gm1 : acc[ai][0][m > 0 ? m - 1 : 0][n], v1 = m == 0 ? vm1 : acc[ai][1][m > 0 ? m - 1 : 0][n];
                    const f32x4 g2 = m == 0 ? gm2 : (m == 1 ? gm1 : acc[ai][0][m > 1 ? m - 2 : 0][n]), v2 = m == 0 ? vm2 : (m == 1 ? vm1 : acc[ai][1][m > 1 ? m - 2 : 0][n]);
                    if (smp) { if (m >= 2) { float* cd = convs + ((size_t)((R - MP) >> 2) * 2 + (m - 2)) * FF2; *(f32x4*)(cd + j4) = g; *(f32x4*)(cd + FF + j4) = v; } }
                    else if ((ai == 0 && m < 2) || (ai == 1 && m >= 2)) {
                        const int t = R & 2047;
                        if (t >= 2046) { float* cd = convp + ((size_t)(R >> 11) * 2 + (t - 2046)) * FF2; *(f32x4*)(cd + j4) = g; *(f32x4*)(cd + FF + j4) = v; }
                        const int rt = R & 255;
                        if (rt < 2 || rt >= 254) { float* ed = EDGE + ((size_t)u.pm * 4 + (rt < 2 ? rt : rt - 252)) * FF2; *(f32x4*)(ed + j4) = g; *(f32x4*)(ed + FF + j4) = v; }
                    }
                    const f32x4 cg = bgv + wg0 * g2 + wg1 * g1 + wg2 * g, cv = bvv + wv0 * v2 + wv1 * v1 + wv2 * v;
                    u32x2 w; w.x = cvt_pk_bf16(silu_(cg[0]) * cv[0], silu_(cg[1]) * cv[1]); w.y = cvt_pk_bf16(silu_(cg[2]) * cv[2], silu_(cg[3]) * cv[3]);
                    *(u32x2*)(ACT + (size_t)R * FF + j4) = w;
                }
            }
        }
    }
};
#undef UPC_LOADW

template <class Epi, class Sched, bool ALIGN_EPI = false, bool SP2 = false>
__device__ __forceinline__ void gemm_phase(PG8_LAS unsigned char* lds, const Gemm g, const Sched& S, const Epi& E) {
    int tid_ = threadIdx.x; asm volatile("" : "+v"(tid_));
    const int tid = tid_, wid = __builtin_amdgcn_readfirstlane(tid >> 6), lane = tid & 63, wr = wid >> 2, wc = wid & 3, fr = lane & 15, fq = lane >> 4;
    const int K = g.K, nt = K / BK;
    unsigned voffA[2], voffB[2], voffB1[2];
#pragma unroll
    for (int i = 0; i < 2; ++i) { int R, C; stage_rc(tid * 16 + i * 8192, R, C); const int Rb = Epi::PERM ? ((R & ~31) + perm32(R & 31)) : R;
        int Ra = R; if constexpr (Epi::AMAP) Ra = E.amap(R); voffA[i] = (unsigned)(Ra * K + C) * 2u;     voffB[i] = (unsigned)(E.bmap(Rb) * K + C) * 2u; if constexpr (Epi::BMAP) voffB1[i] = (unsigned)(E.bmap(HALF + Rb) * K + C) * 2u; else voffB1[i] = 0u; }
    const size_t kstep = (size_t)(BK * 2);
    const size_t hstep = (size_t)HALF * K * 2;
    const unsigned* vB1 = Epi::BMAP ? voffB1 : voffB; const size_t h1step = Epi::BMAP ? (size_t)0 : hstep;
    const size_t tstep = 2 * hstep;
    const unsigned ldsw = (unsigned)wid * 1024u;
    const int aoff = lds_byte(wr * 64 + fr, fq * 8), boff = lds_byte(wc * 32 + fr, fq * 8);
#define PG8_SA(b, h) (((b) * 2 + (h)) * HTB)
#define PG8_SB(b, h) ((4 + (b) * 2 + (h)) * HTB)
#define PG8_STAGE(bufoff, gbase, voff) do { _Pragma("unroll") for (int _i = 0; _i < 2; ++_i) \
        __builtin_amdgcn_global_load_lds((const unsigned*)((const char*)(gbase) + (voff)[_i]), (PG8_LAS unsigned*)(lds + (bufoff) + ldsw + _i * 8192), 16, 0, 0); } while (0)
#define PG8_LDA(dst, b, h) do { _Pragma("unroll") for (int m = 0; m < 4; ++m) _Pragma("unroll") for (int k = 0; k < 2; ++k) dst[m][k] = *(const PG8_LAS bf16x8*)(lds + PG8_SA(b, h) + aoff + m * 2048 + k * 1024); } while (0)
#define PG8_LDB(dst, b, h) do { _Pragma("unroll") for (int n = 0; n < 2; ++n) _Pragma("unroll") for (int k = 0; k < 2; ++k) dst[n][k] = *(const PG8_LAS bf16x8*)(lds + PG8_SB(b, h) + boff + n * 2048 + k * 1024); } while (0)
#define PG8_MMA(ai, bj, At, Bt) do { __builtin_amdgcn_s_setprio(1); _Pragma("unroll") for (int m = 0; m < 4; ++m) _Pragma("unroll") for (int n = 0; n < 2; ++n) _Pragma("unroll") for (int k = 0; k < 2; ++k) \
        acc[ai][bj][m][n] = __builtin_amdgcn_mfma_f32_16x16x32_bf16(Bt[n][k], At[m][k], acc[ai][bj][m][n], 0, 0, 0); __builtin_amdgcn_s_setprio(0); } while (0)
#define PG8_WAIT_V(n) asm volatile("s_waitcnt vmcnt(" #n ")" ::: "memory")
#define PG8_WAIT_L(n) asm volatile("s_waitcnt lgkmcnt(" #n ")" ::: "memory")
#define PG8_BAR __builtin_amdgcn_s_barrier()
#define PG8_SCHED __builtin_amdgcn_sched_barrier(0)
    Unit cur, nxt; int ui = 0;
    if (!S.next(0, cur)) return;
    f32x4 acc[2][2][4][2];
#pragma unroll
    for (int a = 0; a < 2; ++a)
#pragma unroll
        for (int b = 0; b < 2; ++b)
#pragma unroll
            for (int m = 0; m < 4; ++m)
#pragma unroll
                for (int n = 0; n < 2; ++n) acc[a][b][m][n] = (f32x4){0.f, 0.f, 0.f, 0.f};
    bf16x8 At[4][2], B0[2][2], B1[2][2];
    const char* cA = (const char*)g.A + (size_t)cur.pm * tstep; const char* cB = (const char*)g.Bt + (size_t)cur.pn * tstep;
    S.a_ready(cur);
    if constexpr (SP2) {
        PG8_STAGE(PG8_SB(0, 0), cB, voffB); PG8_STAGE(PG8_SB(0, 1), cB + h1step, vB1); PG8_STAGE(PG8_SA(0, 0), cA, voffA); PG8_STAGE(PG8_SA(0, 1), cA + hstep, voffA);
        if (wr == 1) PG8_BAR;
        PG8_WAIT_V(2); PG8_BAR;
        PG8_STAGE(PG8_SB(1, 0), cB + kstep, voffB); PG8_STAGE(PG8_SA(1, 0), cA + kstep, voffA); PG8_STAGE(PG8_SB(1, 1), cB + h1step + kstep, vB1);
        PG8_WAIT_V(6); PG8_BAR;
    } else {
        PG8_STAGE(PG8_SB(0, 0), cB, voffB); PG8_STAGE(PG8_SA(0, 0), cA, voffA); PG8_STAGE(PG8_SB(0, 1), cB + h1step, vB1); PG8_STAGE(PG8_SA(0, 1), cA + hstep, voffA);
        if (wr == 1) PG8_BAR;
        PG8_WAIT_V(4); PG8_BAR;
        PG8_STAGE(PG8_SB(1, 0), cB + kstep, voffB); PG8_STAGE(PG8_SA(1, 0), cA + kstep, voffA); PG8_STAGE(PG8_SB(1, 1), cB + h1step + kstep, vB1);
        PG8_WAIT_V(6); PG8_BAR;
    }
    for (;;) {
        const bool has_next = S.next(ui + 1, nxt);
        const char* nA = has_next ? (const char*)g.A + (size_t)nxt.pm * tstep : cA; const char* nB = has_next ? (const char*)g.Bt + (size_t)nxt.pn * tstep : cB;
        for (int t = 0; t < nt; t += 2) {
            const bool last = (t == nt - 2);
            const char* a1 = cA + (size_t)(t + 1) * kstep;
            const char* a2 = last ? nA : cA + (size_t)(t + 2) * kstep; const char* b2 = last ? nB : cB + (size_t)(t + 2) * kstep;
            const char* a3 = a2 + kstep; const char* b3 = b2 + kstep;
            if (last && has_next) S.a_ready(nxt);
            if constexpr (SP2) {
            PG8_LDB(B0, 0, 0); PG8_LDB(B1, 0, 1); PG8_SCHED; PG8_LDA(At, 0, 0); PG8_STAGE(PG8_SA(1, 1), a1 + hstep, voffA);
            PG8_WAIT_V(8); PG8_WAIT_L(0); PG8_BAR; PG8_MMA(0, 0, At, B0); PG8_MMA(0, 1, At, B1); PG8_BAR; PG8_SCHED;
            PG8_LDA(At, 0, 1); PG8_STAGE(PG8_SB(0, 0), b2, voffB); PG8_STAGE(PG8_SB(0, 1), b2 + h1step, vB1); PG8_STAGE(PG8_SA(0, 0), a2, voffA);
            PG8_WAIT_V(8); PG8_WAIT_L(0); PG8_BAR; PG8_MMA(1, 0, At, B0); PG8_MMA(1, 1, At, B1); PG8_BAR; PG8_SCHED;
            PG8_LDB(B0, 1, 0); PG8_LDB(B1, 1, 1); PG8_SCHED; PG8_LDA(At, 1, 0); PG8_STAGE(PG8_SA(0, 1), a2 + hstep, voffA);
            PG8_WAIT_V(8); PG8_WAIT_L(0); PG8_BAR; PG8_MMA(0, 0, At, B0); PG8_MMA(0, 1, At, B1); PG8_BAR; PG8_SCHED;
            PG8_LDA(At, 1, 1); PG8_STAGE(PG8_SB(1, 0), b3, voffB); PG8_STAGE(PG8_SB(1, 1), b3 + h1step, vB1); PG8_STAGE(PG8_SA(1, 0), a3, voffA);
            PG8_WAIT_V(8); PG8_WAIT_L(0); PG8_BAR; PG8_MMA(1, 0, At, B0); PG8_MMA(1, 1, At, B1); PG8_BAR; PG8_SCHED;
            } else {
            PG8_LDB(B0, 0, 0); PG8_SCHED; PG8_LDA(At, 0, 0); PG8_STAGE(PG8_SA(1, 1), a1 + hstep, voffA);
            PG8_WAIT_L(8); PG8_BAR; PG8_WAIT_L(0); PG8_MMA(0, 0, At, B0); PG8_BAR; PG8_SCHED;
            PG8_LDB(B1, 0, 1); PG8_STAGE(PG8_SB(0, 0), b2, voffB);
            PG8_BAR; PG8_WAIT_L(0); PG8_MMA(0, 1, At, B1); PG8_BAR;
            PG8_LDA(At, 0, 1); PG8_STAGE(PG8_SA(0, 0), a2, voffA);
            PG8_BAR; PG8_WAIT_L(0); PG8_MMA(1, 0, At, B0); PG8_BAR; PG8_SCHED;
            PG8_STAGE(PG8_SB(0, 1), b2 + h1step, vB1);
            PG8_WAIT_V(6); PG8_BAR; PG8_MMA(1, 1, At, B1); PG8_BAR;
            PG8_LDB(B0, 1, 0); PG8_SCHED; PG8_LDA(At, 1, 0); PG8_STAGE(PG8_SA(0, 1), a2 + hstep, voffA);
            PG8_WAIT_L(8); PG8_BAR; PG8_WAIT_L(0); PG8_MMA(0, 0, At, B0); PG8_BAR; PG8_SCHED;
            PG8_LDB(B1, 1, 1); PG8_STAGE(PG8_SB(1, 0), b3, voffB);
            PG8_BAR; PG8_WAIT_L(0); PG8_MMA(0, 1, At, B1); PG8_BAR;
            PG8_LDA(At, 1, 1); PG8_STAGE(PG8_SA(1, 0), a3, voffA);
            PG8_BAR; PG8_WAIT_L(0); PG8_MMA(1, 0, At, B0); PG8_BAR; PG8_SCHED;
            PG8_STAGE(PG8_SB(1, 1), b3 + h1step, vB1);
            PG8_WAIT_V(6); PG8_BAR; PG8_MMA(1, 1, At, B1); PG8_BAR;
            }
        }
        if constexpr (ALIGN_EPI) { if (wr == 0) PG8_BAR; }
        if constexpr (!Epi::AFTER_DRAIN) { E(acc, cur, wr, wc, fr, fq); S.done(cur); }
        if (!has_next) break;
#pragma unroll
        for (int a = 0; a < 2; ++a)
#pragma unroll
            for (int b = 0; b < 2; ++b)
#pragma unroll
                for (int m = 0; m < 4; ++m)
#pragma unroll
                    for (int n = 0; n < 2; ++n) acc[a][b][m][n] = (f32x4){0.f, 0.f, 0.f, 0.f};
        cur = nxt; cA = nA; cB = nB; ++ui;
        if constexpr (ALIGN_EPI) { if (wr == 1) PG8_BAR; }
    }
    PG8_WAIT_V(0);
    if constexpr (!ALIGN_EPI) { if (wr == 0) PG8_BAR; }
    PG8_BAR;
    if constexpr (Epi::AFTER_DRAIN) { E.fused(acc, cur, wr, wc, fr, fq, lds, wid, lane); S.done(cur); }
#undef PG8_SA
#undef PG8_SB
#undef PG8_STAGE
#undef PG8_LDA
#undef PG8_LDB
#undef PG8_MMA
#undef PG8_WAIT_V
#undef PG8_WAIT_L
#undef PG8_BAR
#undef PG8_SCHED
}
}

#define XB_TMO      128
#define XB_XCNT(j)  (256  + 64 * (j))
#define XB_XSUB(j)  (1280 + 64 * (j))
#define XB_XGEN(j)  (2304 + 64 * (j))
#define XB_TOP      3328
#define XB_TOPGEN   3392
#define XCD_BAR_WORDS 3456
#define XB_SPIN_CAP (1u << 18)

__device__ __forceinline__ unsigned xb_ld(unsigned* p)              { return __hip_atomic_load(p, __ATOMIC_RELAXED, __HIP_MEMORY_SCOPE_AGENT); }
__device__ __forceinline__ unsigned xb_add(unsigned* p, unsigned v) { return __hip_atomic_fetch_add(p, v, __ATOMIC_RELAXED, __HIP_MEMORY_SCOPE_AGENT); }
__device__ __forceinline__ unsigned xb_xcc_id() { return (unsigned)__builtin_amdgcn_s_getreg((3 << 11) | 20) & 0xFu; }
#define XB_SPIN(cond, bar) do { unsigned _sp = 0; while (cond) { __builtin_amdgcn_s_sleep(1); \
    if ((++_sp & 255u) == 0u) { if (xb_ld(&(bar)[XB_TMO])) break; if (_sp > XB_SPIN_CAP) { atomicAdd(&(bar)[XB_TMO], 1u); break; } } } } while (0)

struct XcdBarrier {
    unsigned* bar; unsigned x;
    volatile LAS unsigned* st;
};

__device__ __forceinline__ XcdBarrier xcd_barrier_post(unsigned* bar, volatile LAS unsigned* st) {
    XcdBarrier b; b.bar = bar; b.x = xb_xcc_id(); b.st = st;
    if (threadIdx.x == 0) (void)xb_add(&bar[XB_XCNT(b.x)], 1u);
    return b;
}
__device__ __forceinline__ void xcd_barrier_complete(unsigned* bar, unsigned x, unsigned& nloc, unsigned& nx) {
    const unsigned G = gridDim.x * gridDim.y * gridDim.z;
    unsigned sum, cnt, mine, sp = 0u;
    for (;;) {
        sum = 0u; cnt = 0u; mine = 0u;
#pragma unroll
        for (unsigned j = 0; j < 16; ++j) { const unsigned c = xb_ld(&bar[XB_XCNT(j)]); sum += c; cnt += (c > 0u) ? 1u : 0u; mine = (j == x) ? c : mine; }
        if (sum == G) break;
        __builtin_amdgcn_s_sleep(1);
        if ((++sp & 255u) == 0u) { if (xb_ld(&bar[XB_TMO])) break; if (sp > XB_SPIN_CAP) { atomicAdd(&bar[XB_TMO], 1u); break; } }
    }
    nloc = mine > 0u ? mine : 1u; nx = cnt > 0u ? cnt : 1u;
}

__device__ __forceinline__ void xcd_barrier(const XcdBarrier& b) {
    asm volatile("s_waitcnt vmcnt(0)" ::: "memory");
    __syncthreads();
    if (threadIdx.x == 0) {
        unsigned* bar = b.bar;
        __builtin_amdgcn_s_waitcnt(0);
        unsigned nloc = b.st[0], nx = b.st[1];
        if (nloc == 0u) { xcd_barrier_complete(bar, b.x, nloc, nx); b.st[0] = nloc; b.st[1] = nx; }
        const unsigned old = xb_add(&bar[XB_XSUB(b.x)], 1u);
        const unsigned gen = old / nloc;
        if (old + 1u == (gen + 1u) * nloc) {
            __builtin_amdgcn_fence(__ATOMIC_RELEASE, "agent");
            asm volatile("s_waitcnt vmcnt(0)" ::: "memory");
            const unsigned og = xb_add(&bar[XB_TOP], 1u);
            const unsigned tg = og / nx;
            if (og + 1u == (tg + 1u) * nx) xb_add(&bar[XB_TOPGEN], 1u);
            else XB_SPIN(xb_ld(&bar[XB_TOPGEN]) == tg, bar);
            __builtin_amdgcn_fence(__ATOMIC_ACQUIRE, "agent");
            xb_add(&bar[XB_XGEN(b.x)], 1u);
            asm volatile("s_waitcnt vmcnt(0)" ::: "memory");
        } else {
            XB_SPIN(xb_ld(&bar[XB_XGEN(b.x)]) == gen, bar);
            __builtin_amdgcn_fence(__ATOMIC_ACQUIRE, "agent");
            asm volatile("s_waitcnt vmcnt(0)" ::: "memory");
        }
    }
    __syncthreads();
}

struct Args { const float* in[39]; float* out; unsigned char* ws; int ph_lo, ph_hi, li, pad; };
enum { I_XP = 0, I_XS, I_MEM, I_C1, I_C4, I_C16, I_SRE, I_SIM, I_SCONV, I_CMEM, I_NMIX, I_WIN, I_QN, I_KN, I_LRE, I_LIM, I_LDT, I_BRE, I_BIM, I_CRE, I_CIM, I_SD, I_WGLU, I_BGLU,
       I_AON, I_SON, I_WOUT, I_NX, I_NMEM, I_WXQ, I_WXKV, I_XQN, I_XKN, I_WXO, I_NFFN, I_WUP, I_CONVW, I_CONVB, I_WDOWN };
constexpr size_t O_YP = 0, O_YS = O_YP + (size_t)MP * D, O_KV1P = O_YS + (size_t)MS * D, O_KV4P = O_KV1P + (size_t)BP * 128 * 512, O_KV16P = O_KV4P + (size_t)BP * 512 * 512,
    O_SREP = O_KV16P + (size_t)BP * 2048 * 512, O_SIMP = O_SREP + BP * 1024, O_CONVP = O_SIMP + BP * 1024, O_MEMKV = O_CONVP + (size_t)BP * 2 * FF2, O_KV1S = O_MEMKV + (size_t)MM * 2048,
    O_KV4S = O_KV1S + (size_t)MS * 512, O_KV16S = O_KV4S + (size_t)MS * 512, O_SRES = O_KV16S + (size_t)MS * 512, O_SIMS = O_SRES + BS * 1024, O_CONVS = O_SIMS + BS * 1024, O_END = O_CONVS + (size_t)BS * 2 * FF2;
static_assert(O_END == 35102720 && O_KV1P == O_KV1P_ && O_KV4P == O_KV4P_ && O_KV16P == O_KV16P_ && O_KV1S == O_KV1S_ && O_KV4S == O_KV4S_ && O_KV16S == O_KV16S_, "output map");

template <int MODE> __device__ __forceinline__ int rowmap(int n) {
    if (MODE == 1) return (n & ~255) + 128 * ((n >> 5) & 1) + 32 * ((n >> 6) & 3) + (n & 31);
    if (MODE == 2) { return n < FF ? 256 * (n >> 7) + (n & 127) : 256 * ((n - FF) >> 7) + 128 + ((n - FF) & 127); }
    return n;
}
template <int MODE> __device__ __forceinline__ void p0_transpose_item(const float* W, int K, int N, bf16* WT, const float* gk, LAS float* scr, int item, int lane) {
    const int nblk = N / 32, kb = item / nblk, nb = item % nblk, k0 = 64 * kb, n0 = 32 * nb;
    float wv[32];
#pragma unroll
    for (int i = 0; i < 32; ++i) wv[i] = W[(size_t)(k0 + 2 * i + (lane >> 5)) * N + n0 + (lane & 31)];
    if (gk) {
#pragma unroll
        for (int i = 0; i < 32; ++i) wv[i] *= gk[k0 + 2 * i + (lane >> 5)]; }
#pragma unroll
    for (int i = 0; i < 32; ++i) scr[(2 * i + (lane >> 5)) * 33 + (lane & 31)] = wv[i];
    LDS_WAIT(); asm volatile("" ::: "memory");
    const int c = lane & 7;
#pragma unroll
    for (int j = 0; j < 4; ++j) { const int n = (lane >> 3) + 8 * j; const LAS float* s = scr + (8 * c) * 33 + n;
        u32x4 o; o.x = pk2(s[0 * 33], s[1 * 33]); o.y = pk2(s[2 * 33], s[3 * 33]); o.z = pk2(s[4 * 33], s[5 * 33]); o.w = pk2(s[6 * 33], s[7 * 33]);
        *(GAS u32x4*)(WT + (size_t)rowmap<MODE>(n0 + n) * K + k0 + 8 * c) = o; }
    LDS_WAIT(); asm volatile("" ::: "memory");
}
__device__ __forceinline__ void rms_rows2_to_bf16(const float* xrow0, const float* xrow1, const f32x4 (&gg)[4], bf16* orow0, bf16* orow1, int lane) {
    const f32x4* xr0 = (const f32x4*)xrow0 + lane; const f32x4* xr1 = (const f32x4*)xrow1 + lane;
    f32x4 v0[4], v1[4]; float s0 = 0.f, s1 = 0.f;
#pragma unroll
    for (int j = 0; j < 4; ++j) { v0[j] = xr0[64 * j]; v1[j] = xr1[64 * j]; }
#pragma unroll
    for (int j = 0; j < 4; ++j) { s0 += dot4(v0[j]); s1 += dot4(v1[j]); }
#pragma unroll
    for (int o = 1; o < 64; o <<= 1) { s0 += __shfl_xor(s0, o); s1 += __shfl_xor(s1, o); }
    const float r0 = frsq(s0 * (1.0f / D) + EPS), r1 = frsq(s1 * (1.0f / D) + EPS);
    u32x2* o0 = (u32x2*)orow0 + lane; u32x2* o1 = (u32x2*)orow1 + lane;
#pragma unroll
    for (int j = 0; j < 4; ++j) { const f32x4 a = v0[j] * r0 * gg[j], c = v1[j] * r1 * gg[j];
        u32x2 w; w.x = cvt_pk_bf16(a[0], a[1]); w.y = cvt_pk_bf16(a[2], a[3]); o0[64 * j] = w;
        u32x2 z; z.x = cvt_pk_bf16(c[0], c[1]); z.y = cvt_pk_bf16(c[2], c[3]); o1[64 * j] = z; }
}

__device__ __forceinline__ int pi23(int m) { return (m & ~12) | ((m & 4) << 1) | ((m & 8) >> 1); }
__device__ __forceinline__ void memk_fix_item(float* memkv, const float* mss, const float* xkn, const float* xqn, bf16* MEMK, int Rm, int lane) {
    const f32x4 gk = *(const f32x4*)(xkn + 4 * lane), gq = *(const f32x4*)(xqn + 4 * lane);
    f32x4 v[4], s[4];
#pragma unroll
    for (int h = 0; h < 4; ++h) { v[h] = *(const f32x4*)(memkv + (size_t)Rm * 2048 + h * 256 + 4 * lane); s[h] = *(const f32x4*)(mss + (size_t)Rm * 16 + 4 * h); }
#pragma unroll
    for (int h = 0; h < 4; ++h) {
        const float rs = frsq(((s[h][0] + s[h][1]) + (s[h][2] + s[h][3])) * (1.0f / 256.0f) + EPS);
        const f32x4 kn = v[h] * rs * gk; *(f32x4*)(memkv + (size_t)Rm * 2048 + h * 256 + 4 * lane) = kn; const f32x4 kq = kn * gq;
        u32x2 w; w.x = cvt_pk_bf16(kq[0], kq[1]); w.y = cvt_pk_bf16(kq[2], kq[3]); *(u32x2*)(MEMK + (size_t)Rm * 1024 + h * 256 + 4 * lane) = w;
    }
}
__device__ __forceinline__ void ssm_bfrags(const Args& a, const float* ssmc, int g, int lane, bf16x8 (&bb)[4]) {
    const int n = lane & 31, hi = lane >> 5;
#pragma unroll
    for (int s2 = 0; s2 < 2; ++s2) { const int st = g * 64 + 32 * s2 + n; const f32x4 c0 = *(const f32x4*)(ssmc + (size_t)st * 8); const float cr = c0[2], ci = c0[3];
        const f32x4 r0 = *(const f32x4*)(a.in[I_BRE] + (size_t)st * 16 + 8 * hi), r1 = *(const f32x4*)(a.in[I_BRE] + (size_t)st * 16 + 8 * hi + 4);
        const f32x4 i0 = *(const f32x4*)(a.in[I_BIM] + (size_t)st * 16 + 8 * hi), i1 = *(const f32x4*)(a.in[I_BIM] + (size_t)st * 16 + 8 * hi + 4);
        const f32x4 pr0 = r0 * cr - i0 * ci, pr1 = r1 * cr - i1 * ci, pi0 = i0 * cr + r0 * ci, pi1 = i1 * cr + r1 * ci;
        bb[s2] = pack8(pr0[0], pr0[1], pr0[2], pr0[3], pr1[0], pr1[1], pr1[2], pr1[3]); bb[2 + s2] = pack8(pi0[0], pi0[1], pi0[2], pi0[3], pi1[0], pi1[1], pi1[2], pi1[3]); }
}
__device__ __forceinline__ bf16x8 ssm_loadu(const float* U, int row0, int nrows, int g, int lane) {
    const int m = lane & 31, hi = lane >> 5; const int row = row0 + (m < nrows ? m : (m & (nrows - 1)));
    const f32x4 u0 = *(const f32x4*)(U + (size_t)row * 256 + g * 16 + 8 * hi), u1 = *(const f32x4*)(U + (size_t)row * 256 + g * 16 + 8 * hi + 4);
    return pack8(u0[0], u0[1], u0[2], u0[3], u1[0], u1[1], u1[2], u1[3]);
}
__device__ __forceinline__ void ssm_xcompute(bf16x8 ua, const bf16x8 (&bb)[4], f32x16 (&xr)[2], f32x16 (&xi)[2]) {
    const f32x16 z = {0.f, 0.f, 0.f, 0.f, 0.f, 0.f, 0.f, 0.f, 0.f, 0.f, 0.f, 0.f, 0.f, 0.f, 0.f, 0.f};
    f32x16 t0 = __builtin_amdgcn_mfma_f32_32x32x16_bf16(ua, bb[0], z, 0, 0, 0), t1 = __builtin_amdgcn_mfma_f32_32x32x16_bf16(ua, bb[1], z, 0, 0, 0);
    f32x16 t2 = __builtin_amdgcn_mfma_f32_32x32x16_bf16(ua, bb[2], z, 0, 0, 0), t3 = __builtin_amdgcn_mfma_f32_32x32x16_bf16(ua, bb[3], z, 0, 0, 0);
#pragma unroll
    for (int r = 0; r < 16; ++r) {
        const float a0 = t0[r], a1 = t1[r], a2 = t2[r], a3 = t3[r];
        const auto sr = __builtin_amdgcn_permlane32_swap(__float_as_uint(a0), __float_as_uint(a1), false, false);
        const unsigned s0 = sr[0], s1 = sr[1];
        xr[0][r] = __uint_as_float(s0); xr[1][r] = __uint_as_float(s1);
        const auto si = __builtin_amdgcn_permlane32_swap(__float_as_uint(a2), __float_as_uint(a3), false, false);
        const unsigned s2 = si[0], s3 = si[1];
        xi[0][r] = __uint_as_float(s2); xi[1][r] = __uint_as_float(s3); }
    __builtin_amdgcn_sched_barrier(0); asm volatile("s_nop 7" ::: "memory"); __builtin_amdgcn_sched_barrier(0);
}
#define SSM_XR(t) xr[((t) >> 2) & 1][((t) & 3) + 4 * ((t) >> 3)]
#define SSM_XI(t) xi[((t) >> 2) & 1][((t) & 3) + 4 * ((t) >> 3)]
__device__ __forceinline__ void ssm_a_item(const Args& a, const float* U, const float* ssmc, float* SSMF, LAS float* uL, int it, int lane) {
    const int g = it & 15, bc = it >> 4, b = bc / 31, c = bc - b * 31;
    const f32x4 c0 = *(const f32x4*)(ssmc + (size_t)(g * 64 + lane) * 8);
    const float ar = c0[0], ai = c0[1];
    bf16x8 bb[4]; ssm_bfrags(a, ssmc, g, lane, bb);
    float hr = 0.f, hi = 0.f;
    bf16x8 ua2[2]; ua2[0] = ssm_loadu(U, b * 2048 + c * 64, 32, g, lane); ua2[1] = ssm_loadu(U, b * 2048 + c * 64 + 32, 32, g, lane);
#pragma unroll
    for (int blk = 0; blk < 2; ++blk) {
        f32x16 xr[2], xi[2]; ssm_xcompute(ua2[blk], bb, xr, xi);
#pragma unroll
        for (int t = 0; t < 32; ++t) { const float nr = fmaf(ar, hr, fmaf(-ai, hi, SSM_XR(t))), ni = fmaf(ar, hi, fmaf(ai, hr, SSM_XI(t))); hr = nr; hi = ni; }
    }
    *(f32x2*)(SSMF + ((size_t)((b * 32 + c) * 16 + g) * 64 + lane) * 2) = (f32x2){hr, hi};
    (void)uL;
}
constexpr int SAB = 4;
struct SaBatch { f32x4 k[SAB], v[SAB]; };
__device__ __forceinline__ void sa_load(SaBatch& B, const float* cb, unsigned loff, int t, int dil, int nvalid, int i0) {
#pragma unroll
    for (int j = 0; j < SAB; ++j) { const int i = i0 + j, idx = i < nvalid ? t + i * dil : t; const char* rp = (const char*)(cb + (size_t)idx * 512);
        B.k[j] = __builtin_nontemporal_load((const f32x4*)(rp + loff)); B.v[j] = __builtin_nontemporal_load((const f32x4*)(rp + 1024 + loff)); }
}
__device__ __forceinline__ void sa_compute(const SaBatch& B, f32x4 q, int nvalid, int i0, float& m, float& l, f32x4& o) {
    float s[SAB]; float mb = m;
#pragma unroll
    for (int j = 0; j < SAB; ++j) { float d = (q[0] * B.k[j][0] + q[1] * B.k[j][1]) + (q[2] * B.k[j][2] + q[3] * B.k[j][3]);
        d += __shfl_xor(d, 1); d += __shfl_xor(d, 2); d += __shfl_xor(d, 4); d += __shfl_xor(d, 8);
        s[j] = (i0 + j) < nvalid ? d : -1e30f; mb = fmaxf(mb, s[j]); }
    const float sc = fexp2(m - mb); l *= sc; o = o * sc; m = mb;
#pragma unroll
    for (int j = 0; j < SAB; ++j) { const float p = fexp2(s[j] - mb); l += p; o = o + B.v[j] * p; }
}
__device__ __forceinline__ void sattn_item(const Args& a, const bf16* Q, bf16* AO, float* LSE, int it, int lane) {
    const int g = it >> 9, rem = it & 511, b = rem >> 2, t = rem & 3;
    const int dil = 1 << (2 * g), nbuf = 128 << (2 * g);
    const int R = MP + 4 * b + t, hh = lane >> 4, dq = (lane & 15) * 4;
    const u32x2 qw = *(const u32x2*)(Q + (size_t)R * AW + g * 256 + hh * 64 + dq);
    const f32x4 q = {bf2f(qw.x & 0xffffu), bf2f(qw.x >> 16), bf2f(qw.y & 0xffffu), bf2f(qw.y >> 16)};
    const float* cb = a.in[I_C1 + g] + (size_t)b * nbuf * 512; const unsigned loff = 4u * (unsigned)(hh * 64 + dq);
    const float* nb = a.out + (g == 0 ? O_KV1S : (g == 1 ? O_KV4S : O_KV16S)) + (size_t)(4 * b) * 512 + hh * 64 + dq;
    const int nvalid = g == 0 ? 128 - t : 128;
    float m = -1e30f, l = 0.f; f32x4 o = {0.f, 0.f, 0.f, 0.f};
    SaBatch A, B; sa_load(A, cb, loff, t, dil, nvalid, 0);
#pragma unroll 1
    for (int i0 = 0; i0 < 128; i0 += 2 * SAB) {
        sa_load(B, cb, loff, t, dil, nvalid, i0 + SAB);
        sa_compute(A, q, nvalid, i0, m, l, o);
        if (i0 + 2 * SAB < 128) sa_load(A, cb, loff, t, dil, nvalid, i0 + 2 * SAB);
        sa_compute(B, q, nvalid, i0 + SAB, m, l, o);
    }
    {
        f32x4 kk[4], vv[4]; float s[4]; float mb = m;
#pragma unroll
        for (int j = 0; j < 4; ++j) { const float* rp = nb + (size_t)j * 512; kk[j] = *(const f32x4*)rp; vv[j] = *(const f32x4*)(rp + 256); }
#pragma unroll
        for (int j = 0; j < 4; ++j) { float d = (q[0] * kk[j][0] + q[1] * kk[j][1]) + (q[2] * kk[j][2] + q[3] * kk[j][3]);
            d += __shfl_xor(d, 1); d += __shfl_xor(d, 2); d += __shfl_xor(d, 4); d += __shfl_xor(d, 8);
            const bool ok = g == 0 ? (j <= t) : (j == t); s[j] = ok ? d : -1e30f; mb = fmaxf(mb, s[j]); }
        const float sc = fexp2(m - mb); l *= sc; o = o * sc; m = mb;
#pragma unroll
        for (int j = 0; j < 4; ++j) { const float p = fexp2(s[j] - mb); l += p; o = o + vv[j] * p; }
    }
    const float il = frcp(l); o = o * il;
    u32x2 w; w.x = cvt_pk_bf16(o[0], o[1]); w.y = cvt_pk_bf16(o[2], o[3]); *(u32x2*)(AO + (size_t)R * AW + g * 256 + hh * 64 + dq) = w;
    if ((lane & 15) == 0) LSE[(size_t)R * 12 + g * 4 + hh] = (m + flog2(l)) * LN2;
}
__device__ __forceinline__ void pattn_item(const bf16* Q, const bf16* Kb, const bf16* VT, bf16* AO, float* LSE, int it, int lane) {
    const int g = it >> 11; int rem = it & 2047;
    const int sh = 2 * g, dil = 1 << sh, S = 2048 >> sh, nql = 6 - sh;
    const int qt = rem & ((1 << nql) - 1); rem >>= nql; const int res = rem & (dil - 1); rem >>= sh; const int hh = rem & 3, b = rem >> 2;
    const int n = lane & 31, hi = lane >> 5;
    const int s_q = 32 * qt + n, qrow = b * 2048 + s_q * dil + res;
    const int coff = g * 256 + hh * 64 + 32 * hi;
    bf16x8 qf[4];
    { const bf16* qp = Q + (size_t)qrow * AW + coff;
#pragma unroll
      for (int d0 = 0; d0 < 4; ++d0) qf[d0] = *(const bf16x8*)(qp + 8 * d0); }
    f32x16 sc[5];
    const int pm = pi23(n);
#pragma unroll
    for (int kt = 0; kt < 5; ++kt) {
        const int sb = 32 * qt - 128 + 32 * kt; int sk = sb + pm; sk = sk < 0 ? 0 : sk;
        const bf16* kp = Kb + (size_t)(b * 2048 + sk * dil + res) * AW + coff;
        bf16x8 kf[4];
#pragma unroll
        for (int d0 = 0; d0 < 4; ++d0) kf[d0] = *(const bf16x8*)(kp + 8 * d0);
        f32x16 acc = {0.f, 0.f, 0.f, 0.f, 0.f, 0.f, 0.f, 0.f, 0.f, 0.f, 0.f, 0.f, 0.f, 0.f, 0.f, 0.f};
#pragma unroll
        for (int d0 = 0; d0 < 4; ++d0) acc = __builtin_amdgcn_mfma_f32_32x32x16_bf16(kf[d0], qf[d0], acc, 0, 0, 0);
        sc[kt] = acc;
    }
    float mx = -1e30f;
#pragma unroll
    for (int kt = 0; kt < 5; ++kt) { const int sb = 32 * qt - 128 + 32 * kt;
#pragma unroll
        for (int r = 0; r < 16; ++r) { const int sk = sb + 16 * (r >> 3) + 8 * hi + (r & 7); const int dl = s_q - sk; const bool ok = (sk >= 0) && (dl >= 0) && (dl <= 128);
            const float v = ok ? sc[kt][r] : -1e30f; sc[kt][r] = v; mx = fmaxf(mx, v); } }
    mx = fmaxf(mx, __shfl_xor(mx, 32));
    float l = 0.f;
#pragma unroll
    for (int kt = 0; kt < 5; ++kt)
#pragma unroll
        for (int r = 0; r < 16; ++r) { const float p = fexp2(sc[kt][r] - mx); sc[kt][r] = p; l += p; }
    l += __shfl_xor(l, 32);
    f32x16 o[2];
#pragma unroll
    for (int dt = 0; dt < 2; ++dt) o[dt] = (f32x16){0.f, 0.f, 0.f, 0.f, 0.f, 0.f, 0.f, 0.f, 0.f, 0.f, 0.f, 0.f, 0.f, 0.f, 0.f, 0.f};
    const bf16* vbase = VT + (size_t)((g * 4 + hh) * 8 + b) * 64 * 2048;
#pragma unroll
    for (int kt = 0; kt < 5; ++kt) {
        int sb = 32 * qt - 128 + 32 * kt; sb = sb < 0 ? 0 : sb;
        const bf16* vp = vbase + (size_t)((res * S + sb) >> 5) * 2048 + n * 32 + 8 * hi;
#pragma unroll
        for (int jj = 0; jj < 2; ++jj) {
            const bf16x8 pb = pack8(sc[kt][8 * jj + 0], sc[kt][8 * jj + 1], sc[kt][8 * jj + 2], sc[kt][8 * jj + 3], sc[kt][8 * jj + 4], sc[kt][8 * jj + 5], sc[kt][8 * jj + 6], sc[kt][8 * jj + 7]);
#pragma unroll
            for (int dt = 0; dt < 2; ++dt) { const bf16x8 vf = *(const bf16x8*)(vp + dt * 1024 + 16 * jj); o[dt] = __builtin_amdgcn_mfma_f32_32x32x16_bf16(vf, pb, o[dt], 0, 0, 0); }
        }
    }
    const float il = frcp(l);
    bf16* op = AO + (size_t)qrow * AW + g * 256 + hh * 64 + 4 * hi;
#pragma unroll
    for (int dt = 0; dt < 2; ++dt)
#pragma unroll
        for (int r4 = 0; r4 < 4; ++r4) { u32x2 w; w.x = cvt_pk_bf16(o[dt][4 * r4] * il, o[dt][4 * r4 + 1] * il); w.y = cvt_pk_bf16(o[dt][4 * r4 + 2] * il, o[dt][4 * r4 + 3] * il);
            *(u32x2*)(op + 32 * dt + 8 * r4) = w; }
    if (hi == 0) LSE[(size_t)qrow * 12 + g * 4 + hh] = (mx + flog2(l)) * LN2;
}

constexpr int PK_ROW = 144, PK_SLOT = 32 * PK_ROW, PV_OFF = 12 * PK_SLOT;
__device__ __forceinline__ void pattn_wg_item(const bf16* Q, const bf16* Kb, const bf16* VT, bf16* AO, float* LSE, LAS unsigned char* lds, int item, int wave, int lane, int tid) {
    const int g = item >> 8, r = item & 255, hh = (r >> 3) & 3, b = r >> 5;
    const int sh = 2 * g, dil = 1 << sh, S = 2048 >> sh;
    const int qblk = g == 0 ? (r & 7) : (r & 1), resb = g == 0 ? 0 : (g == 1 ? ((r >> 1) & 3) : 2 * (r & 7));
    const int pc = tid & 255;
    u32x4 kreg[6], vreg[6];
#pragma unroll
    for (int i = 0; i < 6; ++i) { const int T = (tid >> 8) + 2 * i;
        int sb, rs; bool ok;
        if (g < 2) { sb = 256 * qblk - 128 + 32 * T; rs = resb; ok = sb >= 0; } else { sb = 32 * (T & 3); rs = resb + (T >> 2); ok = T < 8; }
        if (ok) { const int t = (sb + (pc >> 3)) * dil + rs;
            kreg[i] = *(const u32x4*)(Kb + (size_t)(b * 2048 + t) * AW + g * 256 + hh * 64 + 8 * (pc & 7));
            vreg[i] = *(const u32x4*)(VT + (size_t)(b * 2048 + t) * AW + g * 256 + hh * 64 + 8 * (pc & 7)); }
        else { kreg[i] = (u32x4){0u, 0u, 0u, 0u}; vreg[i] = kreg[i]; } }
    const int n = lane & 31, hi = lane >> 5;
    const int qt = g < 2 ? 8 * qblk + wave : (wave & 3), resw = g < 2 ? resb : resb + (wave >> 2);
    const int slot_base = g < 2 ? wave : 4 * (wave >> 2) + (wave & 3) - 4;
    const int s_q = 32 * qt + n, qrow = b * 2048 + s_q * dil + resw;
    bf16x8 qf[4];
    { const bf16* qp = Q + (size_t)qrow * AW + g * 256 + hh * 64 + 32 * hi;
#pragma unroll
      for (int d0 = 0; d0 < 4; ++d0) qf[d0] = *(const bf16x8*)(qp + 8 * d0); }
#pragma unroll
    for (int i = 0; i < 6; ++i) { const int T = (tid >> 8) + 2 * i;
        *(LAS u32x4*)(lds + T * PK_SLOT + (pc >> 3) * PK_ROW + (pc & 7) * 16) = kreg[i];
        *(LAS u32x4*)(lds + PV_OFF + T * PK_SLOT + (pc >> 3) * PK_ROW + (pc & 7) * 16) = vreg[i]; }
    __syncthreads();
    f32x16 sc[5];
    const int pm = pi23(n);
#pragma unroll
    for (int kt = 0; kt < 5; ++kt) {
        const int slot = slot_base + kt, sb = 32 * qt - 128 + 32 * kt;
        f32x16 acc = {0.f, 0.f, 0.f, 0.f, 0.f, 0.f, 0.f, 0.f, 0.f, 0.f, 0.f, 0.f, 0.f, 0.f, 0.f, 0.f};
        if (sb >= 0) {
            const LAS unsigned char* kp = lds + slot * PK_SLOT + pm * PK_ROW + 64 * hi;
            bf16x8 kf[4];
#pragma unroll
            for (int d0 = 0; d0 < 4; ++d0) kf[d0] = *(const LAS bf16x8*)(kp + 16 * d0);
#pragma unroll
            for (int d0 = 0; d0 < 4; ++d0) acc = __builtin_amdgcn_mfma_f32_32x32x16_bf16(kf[d0], qf[d0], acc, 0, 0, 0);
        }
        sc[kt] = acc;
    }
    float mx = -1e30f;
#pragma unroll
    for (int kt = 0; kt < 5; ++kt) { const int sb = 32 * qt - 128 + 32 * kt;
#pragma unroll
        for (int rr = 0; rr < 16; ++rr) { const int sk = sb + 16 * (rr >> 3) + 8 * hi + (rr & 7); const int dl = s_q - sk; const bool ok = (sk >= 0) && (dl >= 0) && (dl <= 128);
            const float v = ok ? sc[kt][rr] : -1e30f; sc[kt][rr] = v; mx = fmaxf(mx, v); } }
    mx = fmaxf(mx, __shfl_xor(mx, 32));
    float l = 0.f;
#pragma unroll
    for (int kt = 0; kt < 5; ++kt)
#pragma unroll
        for (int rr = 0; rr < 16; ++rr) { const float p = fexp2(sc[kt][rr] - mx); sc[kt][rr] = p; l += p; }
    l += __shfl_xor(l, 32);
    f32x16 o[2];
#pragma unroll
    for (int dt = 0; dt < 2; ++dt) o[dt] = (f32x16){0.f, 0.f, 0.f, 0.f, 0.f, 0.f, 0.f, 0.f, 0.f, 0.f, 0.f, 0.f, 0.f, 0.f, 0.f, 0.f};
#pragma unroll
    for (int kt = 0; kt < 5; ++kt) {
        const int slot = slot_base + kt, sb = 32 * qt - 128 + 32 * kt;
        if (sb >= 0) {
            LAS unsigned char* vp = lds + PV_OFF + slot * PK_SLOT + (8 * hi + ((lane >> 2) & 3)) * PK_ROW + (16 * ((lane >> 4) & 1) + 4 * (lane & 3)) * 2;
            bf16x8 vf[2][2];
#pragma unroll
            for (int jj = 0; jj < 2; ++jj)
#pragma unroll
                for (int dt = 0; dt < 2; ++dt) vf[jj][dt] = cat44(lds_tr4(vp + (16 * jj) * PK_ROW + 64 * dt), lds_tr4(vp + (16 * jj + 4) * PK_ROW + 64 * dt));
#pragma unroll
            for (int jj = 0; jj < 2; ++jj) {
                const bf16x8 pb = pack8(sc[kt][8 * jj + 0], sc[kt][8 * jj + 1], sc[kt][8 * jj + 2], sc[kt][8 * jj + 3], sc[kt][8 * jj + 4], sc[kt][8 * jj + 5], sc[kt][8 * jj + 6], sc[kt][8 * jj + 7]);
#pragma unroll
                for (int dt = 0; dt < 2; ++dt) o[dt] = __builtin_amdgcn_mfma_f32_32x32x16_bf16(vf[jj][dt], pb, o[dt], 0, 0, 0);
            }
        }
    }
    const float il = frcp(l);
    bf16* op = AO + (size_t)qrow * AW + g * 256 + hh * 64 + 4 * hi;
#pragma unroll
    for (int dt = 0; dt < 2; ++dt)
#pragma unroll
        for (int r4 = 0; r4 < 4; ++r4) { u32x2 w; w.x = cvt_pk_bf16(o[dt][4 * r4] * il, o[dt][4 * r4 + 1] * il); w.y = cvt_pk_bf16(o[dt][4 * r4 + 2] * il, o[dt][4 * r4 + 3] * il);
            *(u32x2*)(op + 32 * dt + 8 * r4) = w; }
    if (hi == 0) LSE[(size_t)qrow * 12 + g * 4 + hh] = (mx + flog2(l)) * LN2;
    __syncthreads();
}

template <int NB> __device__ __forceinline__ void combine_rows(const bf16* AO, const float* LSE, const float* aon, bf16* MIXED, int R0, int lane) {
    const int hh = lane >> 4; float ls[NB][3]; u32x2 ow[NB][3];
#pragma unroll
    for (int i = 0; i < NB; ++i)
#pragma unroll
        for (int g = 0; g < 3; ++g) { ow[i][g] = *(const u32x2*)(AO + (size_t)(R0 + i) * AW + g * 256 + 4 * lane); ls[i][g] = LSE[(size_t)(R0 + i) * 12 + g * 4 + hh]; }
    f32x4 gn[3];
#pragma unroll
    for (int g = 0; g < 3; ++g) gn[g] = *(const f32x4*)(aon + g * 256 + 4 * lane);
#pragma unroll
    for (int i = 0; i < NB; ++i) {
        const float mx = fmaxf(fmaxf(ls[i][0], ls[i][1]), ls[i][2]);
        float e[3]; e[0] = fexp2((ls[i][0] - mx) * LOG2E); e[1] = fexp2((ls[i][1] - mx) * LOG2E); e[2] = fexp2((ls[i][2] - mx) * LOG2E);
        const float inv = frcp(e[0] + e[1] + e[2]);
        f32x4 v[3]; float ss = 0.f;
#pragma unroll
        for (int g = 0; g < 3; ++g) { const float al = e[g] * inv; v[g] = (f32x4){bf2f(ow[i][g].x & 0xffffu), bf2f(ow[i][g].x >> 16), bf2f(ow[i][g].y & 0xffffu), bf2f(ow[i][g].y >> 16)} * al; ss += dot4(v[g]); }
        const float rs = frsq(wave_sum(ss) * (1.0f / 768.0f) + EPS);
#pragma unroll
        for (int g = 0; g < 3; ++g) { const f32x4 y = v[g] * rs * gn[g];
            u32x2 w; w.x = cvt_pk_bf16(y[0], y[1]); w.y = cvt_pk_bf16(y[2], y[3]); *(u32x2*)(MIXED + (size_t)(R0 + i) * D + g * 256 + 4 * lane) = w; }
    }
}
__device__ __forceinline__ float gelu_tanh(float x) { const float u2 = 1.5957691216057308f * (x + 0.044715f * x * x * x); return x * frcp(1.0f + fexp2(-u2 * LOG2E)); }
__device__ __forceinline__ float sigmoidf_(float z) { return frcp(1.0f + fexp2(-z * LOG2E)); }
__device__ __forceinline__ void ssm_c_item(const Args& a, const float* U, const float* ssmc, const float* SSMF, const bf16* WGLU, bf16* MIXED, LAS unsigned char* lds, int item, int wave, int lane) {
    const bool hs = item < 32;
    const int b = item >> 5, c = item & 31;
    const int R0 = item * 64, RS0 = MP + item * 16;
    LAS unsigned* HL = (LAS unsigned*)(lds + wave * 4352);
    LAS float* ZS = (LAS float*)(lds + 34816);
    const int t16 = lane & 15, q4 = lane >> 4;
    for (int gi = 0; gi < 2; ++gi) {
        const int g = 2 * wave + gi;
        const f32x4* cp = (const f32x4*)(ssmc + (size_t)(g * 64 + lane) * 8); const f32x4 c0 = cp[0], c1 = cp[1];
        const float ar = c0[0], ai = c0[1], a64r = c1[0], a64i = c1[1];
        bf16x8 bb[4]; ssm_bfrags(a, ssmc, g, lane, bb);
        bf16x8 cf[4];
#pragma unroll
        for (int s4 = 0; s4 < 4; ++s4) { const int p0 = 16 * s4 + 4 * q4; const f32x4 x = *(const f32x4*)(a.in[I_CRE] + (size_t)(g * 16 + t16) * 64 + p0), y = *(const f32x4*)(a.in[I_CIM] + (size_t)(g * 16 + t16) * 64 + p0);
            cf[s4] = pack8(x[0], -y[0], x[1], -y[1], x[2], -y[2], x[3], -y[3]); }
        const f32x4 dv = *(const f32x4*)(a.in[I_SD] + g * 16 + 4 * q4);
        float hr = 0.f, hi = 0.f;
        {
            const int nb16 = (c + 15) >> 4; int cc0 = c - 16 * nb16;
            for (int i16 = 0; i16 < nb16; ++i16, cc0 += 16) { f32x2 f[16];
#pragma unroll
                for (int j = 0; j < 16; ++j) { const int cc = cc0 + j; f[j] = cc >= 0 ? *(const f32x2*)(SSMF + ((size_t)((b * 32 + cc) * 16 + g) * 64 + lane) * 2) : (f32x2){0.f, 0.f}; }
#pragma unroll
                for (int j = 0; j < 16; ++j) { const float nr = fmaf(a64r, hr, fmaf(-a64i, hi, f[j][0])), ni = fmaf(a64r, hi, fmaf(a64i, hr, f[j][1])); hr = nr; hi = ni; } }
        }
#if defined(PROBE_DUMP)
        { float* dmp = (float*)((unsigned char*)MIXED - WS_MIXED + 741 * MiB) + ((size_t)(item * 16 + g) * 64 + lane) * 2; dmp[0] = hr; dmp[1] = hi; }
#endif
        bf16x8 ua2[2]; f32x4 uv4[4];
        ua2[0] = ssm_loadu(U, R0, 32, g, lane); ua2[1] = ssm_loadu(U, R0 + 32, 32, g, lane);
#pragma unroll
        for (int j = 0; j < 4; ++j) uv4[j] = *(const f32x4*)(U + (size_t)(R0 + 16 * j + t16) * 256 + g * 16 + 4 * q4);
#if defined(PROBE_DUMP)
        { u32x4* dmp = (u32x4*)((unsigned char*)MIXED - WS_MIXED + 724 * MiB) + ((size_t)(item * 16 + g) * 2) * 64 + lane; dmp[0] = __builtin_bit_cast(u32x4, ua2[0]); dmp[64] = __builtin_bit_cast(u32x4, ua2[1]); }
#endif
#pragma unroll
        for (int blk = 0; blk < 2; ++blk) {
            f32x16 xr[2], xi[2]; ssm_xcompute(ua2[blk], bb, xr, xi);
#pragma unroll
            for (int s2 = 0; s2 < 2; ++s2) {
                const int trow = 32 * blk + 16 * s2 + t16;
                const f32x4 uv = uv4[2 * blk + s2];
#pragma unroll
                for (int tt = 0; tt < 16; ++tt) { const int t = 16 * s2 + tt;
                    const float nr = fmaf(ar, hr, fmaf(-ai, hi, SSM_XR(t))), ni = fmaf(ar, hi, fmaf(ai, hr, SSM_XI(t))); hr = nr; hi = ni;
                    HL[tt * 68 + lane] = cvt_pk_bf16(hr, hi);
                }
                LDS_WAIT(); asm volatile("" ::: "memory");
                f32x4 y = {0.f, 0.f, 0.f, 0.f};
#pragma unroll
                for (int s4 = 0; s4 < 4; ++s4) { const bf16x8 hf = *(const LAS bf16x8*)((LAS unsigned short*)HL + t16 * 136 + 32 * s4 + 8 * q4); y = __builtin_amdgcn_mfma_f32_16x16x32_bf16(cf[s4], hf, y, 0, 0, 0); }
                f32x4 z;
#pragma unroll
                for (int e = 0; e < 4; ++e) z[e] = gelu_tanh(y[e] + dv[e] * uv[e]);
                *(LAS f32x4*)(ZS + trow * 260 + g * 16 + 4 * q4) = z;
                LDS_WAIT(); asm volatile("" ::: "memory");
            }
        }
        if (c == 31) { a.out[O_SREP + (size_t)(b * 16 + g) * 64 + lane] = hr; a.out[O_SIMP + (size_t)(b * 16 + g) * 64 + lane] = hi; }
        if (hs) {
            float sre[4], sim[4];
#pragma unroll
            for (int j = 0; j < 4; ++j) { const size_t o = (size_t)((4 * item + j) * 16 + g) * 64 + lane; sre[j] = a.in[I_SRE][o]; sim[j] = a.in[I_SIM][o]; }
            const bf16x8 ua = ssm_loadu(U, RS0, 16, g, lane);
            const f32x4 uv = *(const f32x4*)(U + (size_t)(RS0 + t16) * 256 + g * 16 + 4 * q4);
            f32x16 xr[2], xi[2]; ssm_xcompute(ua, bb, xr, xi);
#pragma unroll
            for (int tt = 0; tt < 16; ++tt) {
                if ((tt & 3) == 0) { hr = sre[tt >> 2]; hi = sim[tt >> 2]; }
                const float nr = fmaf(ar, hr, fmaf(-ai, hi, SSM_XR(tt))), ni = fmaf(ar, hi, fmaf(ai, hr, SSM_XI(tt))); hr = nr; hi = ni;
                HL[tt * 68 + lane] = cvt_pk_bf16(hr, hi);
                if ((tt & 3) == 3) { const size_t o = (size_t)((4 * item + (tt >> 2)) * 16 + g) * 64 + lane; a.out[O_SRES + o] = hr; a.out[O_SIMS + o] = hi; }
            }
            LDS_WAIT(); asm volatile("" ::: "memory");
            f32x4 y = {0.f, 0.f, 0.f, 0.f};
#pragma unroll
            for (int s4 = 0; s4 < 4; ++s4) { const bf16x8 hf = *(const LAS bf16x8*)((LAS unsigned short*)HL + t16 * 136 + 32 * s4 + 8 * q4); y = __builtin_amdgcn_mfma_f32_16x16x32_bf16(cf[s4], hf, y, 0, 0, 0); }
            f32x4 z;
#pragma unroll
            for (int e = 0; e < 4; ++e) z[e] = gelu_tanh(y[e] + dv[e] * uv[e]);
            *(LAS f32x4*)(ZS + (64 + t16) * 260 + g * 16 + 4 * q4) = z;
            LDS_WAIT(); asm volatile("" ::: "memory");
        }
    }
    const int n = lane & 31, hi5 = lane >> 5, n0 = 32 * wave, nmt = hs ? 3 : 2;
    bf16x8 bfr[16];
#pragma unroll
    for (int st = 0; st < 16; ++st) bfr[st] = *(const bf16x8*)(WGLU + (size_t)(n0 + n) * 256 + 16 * st + 8 * hi5);
    const float bias = a.in[I_BGLU][n0 + n];
    const f32x4 gn = *(const f32x4*)(a.in[I_SON] + 4 * lane);
    __syncthreads();
    f32x16 acc[3];
#pragma unroll
    for (int mt = 0; mt < 3; ++mt) acc[mt] = (f32x16){0.f, 0.f, 0.f, 0.f, 0.f, 0.f, 0.f, 0.f, 0.f, 0.f, 0.f, 0.f, 0.f, 0.f, 0.f, 0.f};
#pragma unroll
    for (int st = 0; st < 16; ++st) {
        const bf16x8 bf = bfr[st];
#pragma unroll
        for (int mt = 0; mt < 3; ++mt) { if (mt < nmt) { const LAS float* zp = ZS + (32 * mt + n) * 260 + 16 * st + 8 * hi5; const f32x4 x = *(const LAS f32x4*)zp, y = *(const LAS f32x4*)(zp + 4);
            acc[mt] = __builtin_amdgcn_mfma_f32_32x32x16_bf16(pack8(x[0], x[1], x[2], x[3], y[0], y[1], y[2], y[3]), bf, acc[mt], 0, 0, 0); } }
    }
    float so[3][16];
#pragma unroll
    for (int mt = 0; mt < 3; ++mt) { if (mt < nmt) {
#pragma unroll
        for (int r = 0; r < 16; ++r) { const int t = 32 * mt + (r & 3) + 8 * (r >> 2) + 4 * hi5; so[mt][r] = ZS[t * 260 + n0 + n] * sigmoidf_(acc[mt][r] + bias); } } }
    __syncthreads();
#pragma unroll
    for (int mt = 0; mt < 3; ++mt) { if (mt < nmt) {
#pragma unroll
        for (int r = 0; r < 16; ++r) { const int t = 32 * mt + (r & 3) + 8 * (r >> 2) + 4 * hi5; ZS[t * 260 + n0 + n] = so[mt][r]; } } }
    __syncthreads();
#pragma unroll
    for (int i = 0; i < 10; ++i) { if (i >= 8 && !hs) break;
        const int row = i < 8 ? 8 * wave + i : 64 + 2 * wave + (i - 8); const f32x4 v = *(const LAS f32x4*)(ZS + row * 260 + 4 * lane);
        const float rs = frsq(wave_sum(dot4(v)) * (1.0f / 256.0f) + EPS); const f32x4 y = v * rs * gn;
        const size_t orow = i < 8 ? (size_t)(R0 + row) : (size_t)(RS0 + row - 64);
        u32x2 w; w.x = cvt_pk_bf16(y[0], y[1]); w.y = cvt_pk_bf16(y[2], y[3]); *(u32x2*)(MIXED + orow * D + 768 + 4 * lane) = w; }
    __syncthreads();
}

__device__ __forceinline__ float xq_sigma(const float* RS1, const float* QS, int R, int h) {
    const float rstd = frsq(RS1[R] * (1.0f / 1024.0f) + EPS), msq = QS[(size_t)R * 4 + h] * (1.0f / 256.0f);
    return rstd / sqrtf(rstd * rstd * msq + EPS) * (0.0625f * LOG2E);
}
template <int MODE, bool BASE_BF16 = false> __device__ __forceinline__ void sample_gemm_tile(const bf16* A, const bf16* Bt, int K, const void* base, float* outp, bf16* hb, float* ssq, LAS unsigned char* lds, int tile, int wave, int lane, int tid) {
    const int tm = tile >> 5, tn = tile & 31, n = lane & 31, hi = lane >> 5, kw = K >> 3;
    const bf16* ap = A + (size_t)(64 * tm + n) * K + wave * kw + 8 * hi;
    const bf16* bp = Bt + (size_t)(32 * tn + n) * K + wave * kw + 8 * hi;
    f32x16 acc0 = {0.f, 0.f, 0.f, 0.f, 0.f, 0.f, 0.f, 0.f, 0.f, 0.f, 0.f, 0.f, 0.f, 0.f, 0.f, 0.f}, acc1 = acc0;
    const int row = tid >> 3, c4 = (tid & 7) * 4, rs = 64 * tm + row, col = 32 * tn + c4;
    f32x4 bs = {0.f, 0.f, 0.f, 0.f};
    if (MODE == 0) {
        if (BASE_BF16) { const u32x2 w = *(const u32x2*)((const bf16*)base + (size_t)rs * D + col); bs = (f32x4){bf2f(w.x & 0xffffu), bf2f(w.x >> 16), bf2f(w.y & 0xffffu), bf2f(w.y >> 16)}; }
        else bs = *(const f32x4*)((const float*)base + (size_t)rs * D + col); }
#pragma unroll 8
    for (int s = 0; s < kw; s += 16) { const bf16x8 a0 = *(const bf16x8*)(ap + s), a1 = *(const bf16x8*)(ap + (size_t)32 * K + s), bb = *(const bf16x8*)(bp + s);
        acc0 = __builtin_amdgcn_mfma_f32_32x32x16_bf16(a0, bb, acc0, 0, 0, 0); acc1 = __builtin_amdgcn_mfma_f32_32x32x16_bf16(a1, bb, acc1, 0, 0, 0); }
    LAS float* P = (LAS float*)lds;
#pragma unroll
    for (int r = 0; r < 16; ++r) { const int row = (r & 3) + 8 * (r >> 2) + 4 * hi; P[(wave * 64 + row) * 32 + n] = acc0[r]; P[(wave * 64 + 32 + row) * 32 + n] = acc1[r]; }
    __syncthreads();
    f32x4 v = {0.f, 0.f, 0.f, 0.f};
#pragma unroll
    for (int w = 0; w < 8; ++w) v = v + *(const LAS f32x4*)(P + (w * 64 + row) * 32 + c4);
    float s;
    if (MODE == 0) {
        const f32x4 o = bs + v; if (outp) *(f32x4*)(outp + (size_t)rs * D + col) = o;
        if (hb) { u32x2 w; w.x = cvt_pk_bf16(o[0], o[1]); w.y = cvt_pk_bf16(o[2], o[3]); *(u32x2*)(hb + (size_t)rs * D + col) = w; }
        s = dot4(o); }
    else { u32x2 w; w.x = cvt_pk_bf16(v[0], v[1]); w.y = cvt_pk_bf16(v[2], v[3]); *(u32x2*)(hb + (size_t)rs * D + col) = w; s = dot4(v); }
    if (ssq) { s += __shfl_xor(s, 1); s += __shfl_xor(s, 2); s += __shfl_xor(s, 4); if ((tid & 7) == 0) atomic_addf(MODE == 0 ? ssq + rs : ssq + (size_t)rs * 4 + (tn >> 3), s); }
    __syncthreads();
}
constexpr int XK_ROW = 272, XK_BUF = 32 * XK_ROW, XV_BUF = XK_BUF, XV_OFF = 2 * XK_BUF;
__device__ __forceinline__ void xattn_wg_item(const bf16* QX, const float* SS1, const float* QSS, const bf16* MEMK, const bf16* MVT, bf16* OX, LAS unsigned char* lds, int it, int wave, int lane, int tid) {
    const int qb = it & 7, h = (it >> 3) & 3, b = it >> 5;
    const int n = lane & 31, hi = lane >> 5, R = b * 2048 + 256 * qb + 32 * wave + n;
    const float sigma = xq_sigma(SS1, QSS, R, h);
    const bf16* kg = MEMK + (size_t)(b * 256 + (tid >> 4)) * 1024 + h * 256 + 128 * ((tid >> 3) & 1) + 8 * (tid & 7);
    const bf16* vg = MVT + (size_t)(b * 256 + (tid >> 4)) * 1024 + h * 256 + 8 * (tid & 15);
    LAS unsigned char* kl = lds + (tid >> 4) * XK_ROW + (tid & 15) * 16;
    LAS unsigned char* vl = lds + XV_OFF + (tid >> 4) * XK_ROW + (tid & 15) * 16;
#define XSRC(t) ((t) < 16 ? (const u32x4*)(kg + (size_t)((t) & 7) * 32 * 1024 + ((t) >> 3) * 64) : (const u32x4*)(vg + (size_t)(((t) - 16) & 7) * 32 * 1024 + (((t) - 16) >> 3) * 128))
#define XPUT(t, w_) do { if ((t) < 16) *(LAS u32x4*)(kl + ((t) & 1) * XK_BUF) = (w_); else *(LAS u32x4*)(vl + ((t) & 1) * XV_BUF) = (w_); } while (0)
    u32x4 ring[3]; ring[0] = *XSRC(0); ring[1] = *XSRC(1); ring[2] = *XSRC(2);
    f32x16 sc[8];
#pragma unroll
    for (int kt = 0; kt < 8; ++kt) sc[kt] = (f32x16){0.f, 0.f, 0.f, 0.f, 0.f, 0.f, 0.f, 0.f, 0.f, 0.f, 0.f, 0.f, 0.f, 0.f, 0.f, 0.f};
    XPUT(0, ring[0]);
    __syncthreads();
    const LAS unsigned char* kr = lds + pi23(n) * XK_ROW + 128 * hi;
#pragma unroll
    for (int dh = 0; dh < 2; ++dh) {
        bf16x8 qf[8];
        { const bf16* qp = QX + (size_t)R * D + h * 256 + 128 * hi + 64 * dh;
#pragma unroll
          for (int st = 0; st < 8; ++st) qf[st] = *(const bf16x8*)(qp + 8 * st); }
#pragma unroll
        for (int kt = 0; kt < 8; ++kt) {
            const int s = dh * 8 + kt;
            ring[s % 3] = *XSRC(s + 3);
            const LAS unsigned char* kp = kr + (s & 1) * XK_BUF;
            bf16x8 kf[8];
#pragma unroll
            for (int st = 0; st < 8; ++st) kf[st] = *(const LAS bf16x8*)(kp + 16 * st);
            __builtin_amdgcn_sched_barrier(0);
#pragma unroll
            for (int st = 0; st < 8; ++st) sc[kt] = __builtin_amdgcn_mfma_f32_32x32x16_bf16(kf[st], qf[st], sc[kt], 0, 0, 0);
            XPUT(s + 1, ring[(s + 1) % 3]);
            asm volatile("s_waitcnt lgkmcnt(0)\n\ts_barrier" ::: "memory");
        }
    }
    float mx = -1e30f;
#pragma unroll
    for (int kt = 0; kt < 8; ++kt)
#pragma unroll
        for (int r = 0; r < 16; ++r) { sc[kt][r] *= sigma; mx = fmaxf(mx, sc[kt][r]); }
    mx = fmaxf(mx, __shfl_xor(mx, 32));
    float l = 0.f;
#pragma unroll
    for (int kt = 0; kt < 8; ++kt)
#pragma unroll
        for (int r = 0; r < 16; ++r) { const float p = fexp2(sc[kt][r] - mx); sc[kt][r] = p; l += p; }
    l += __shfl_xor(l, 32);
    const float il = frcp(l);
    bf16x8 pb[8][2];
#pragma unroll
    for (int kt = 0; kt < 8; ++kt)
#pragma unroll
        for (int jj = 0; jj < 2; ++jj) pb[kt][jj] = pack8(sc[kt][8 * jj + 0], sc[kt][8 * jj + 1], sc[kt][8 * jj + 2], sc[kt][8 * jj + 3], sc[kt][8 * jj + 4], sc[kt][8 * jj + 5], sc[kt][8 * jj + 6], sc[kt][8 * jj + 7]);
    LAS unsigned char* vr = lds + XV_OFF + (8 * hi + ((lane >> 2) & 3)) * XK_ROW + (16 * ((lane >> 4) & 1) + 4 * (lane & 3)) * 2;
    bf16* op = OX + (size_t)R * D + h * 256 + 4 * hi;
#pragma unroll
    for (int dh = 0; dh < 2; ++dh) {
        f32x16 o[4];
#pragma unroll
        for (int dt = 0; dt < 4; ++dt) o[dt] = (f32x16){0.f, 0.f, 0.f, 0.f, 0.f, 0.f, 0.f, 0.f, 0.f, 0.f, 0.f, 0.f, 0.f, 0.f, 0.f, 0.f};
#pragma unroll
        for (int kt = 0; kt < 8; ++kt) {
            const int s = 16 + dh * 8 + kt;
            if (s + 3 < 32) ring[s % 3] = *XSRC(s + 3);
            LAS unsigned char* vp = vr + (s & 1) * XV_BUF;
            bf16x8 vf[4][2];
#pragma unroll
            for (int dt = 0; dt < 4; ++dt)
#pragma unroll
                for (int jj = 0; jj < 2; ++jj) vf[dt][jj] = cat44(lds_tr4(vp + (16 * jj) * XK_ROW + 64 * dt), lds_tr4(vp + (16 * jj + 4) * XK_ROW + 64 * dt));
            __builtin_amdgcn_sched_barrier(0);
#pragma unroll
            for (int jj = 0; jj < 2; ++jj)
#pragma unroll
                for (int dt = 0; dt < 4; ++dt) o[dt] = __builtin_amdgcn_mfma_f32_32x32x16_bf16(vf[dt][jj], pb[kt][jj], o[dt], 0, 0, 0);
            if (s + 1 < 32) XPUT(s + 1, ring[(s + 1) % 3]);
            asm volatile("s_waitcnt lgkmcnt(0)\n\ts_barrier" ::: "memory");
        }
#pragma unroll
        for (int dt = 0; dt < 4; ++dt)
#pragma unroll
            for (int r4 = 0; r4 < 4; ++r4) { u32x2 w; w.x = cvt_pk_bf16(o[dt][4 * r4] * il, o[dt][4 * r4 + 1] * il); w.y = cvt_pk_bf16(o[dt][4 * r4 + 2] * il, o[dt][4 * r4 + 3] * il);
                *(u32x2*)(op + 128 * dh + 32 * dt + 8 * r4) = w; }
    }
}
#undef XSRC
#undef XPUT
constexpr int SXB = 4;
struct SxBatch { f32x4 k[SXB], v[SXB]; };
__device__ __forceinline__ void sx_load(SxBatch& B, const float* kb, unsigned loff, int j0) {
#pragma unroll
    for (int j = 0; j < SXB; ++j) { const char* p = (const char*)(kb + (size_t)(j0 + j) * 2048); B.k[j] = __builtin_nontemporal_load((const f32x4*)(p + loff)); B.v[j] = __builtin_nontemporal_load((const f32x4*)(p + 4096 + loff)); }
}
__device__ __forceinline__ float rdl(float v, int l) { return __builtin_bit_cast(float, __builtin_amdgcn_readlane(__builtin_bit_cast(int, v), l)); }
__device__ __forceinline__ void sx_compute(const SxBatch& B, const f32x4 (&q)[4], bool b5, bool b4, float& m, float& l, f32x4 (&o)[4]) {
    float s[SXB]; float mb = m;
#pragma unroll
    for (int j = 0; j < SXB; ++j) {
        float d[4];
#pragma unroll
        for (int t = 0; t < 4; ++t) d[t] = (q[t][0] * B.k[j][0] + q[t][1] * B.k[j][1]) + (q[t][2] * B.k[j][2] + q[t][3] * B.k[j][3]);
        const float x0 = b5 ? d[0] : d[2], x1 = b5 ? d[1] : d[3], k0 = b5 ? d[2] : d[0], k1 = b5 ? d[3] : d[1];
        const float r0 = k0 + __shfl_xor(x0, 32), r1 = k1 + __shfl_xor(x1, 32);
        const float xs = b4 ? r0 : r1, ks = b4 ? r1 : r0;
        float r = ks + __shfl_xor(xs, 16);
        r += __shfl_xor(r, 8); r += __shfl_xor(r, 4); r += __shfl_xor(r, 2); r += __shfl_xor(r, 1);
        s[j] = r; mb = fmaxf(mb, r);
    }
    const float sc = fexp2(m - mb); m = mb; l *= sc;
#pragma unroll
    for (int t = 0; t < 4; ++t) o[t] = o[t] * rdl(sc, 16 * t);
#pragma unroll
    for (int j = 0; j < SXB; ++j) { const float p = fexp2(s[j] - mb); l += p;
#pragma unroll
        for (int t = 0; t < 4; ++t) o[t] = o[t] + B.v[j] * rdl(p, 16 * t); }
}
template <int NSW> __device__ __forceinline__ void sxattn_stream(const Args& a, const bf16* QX, const float* SS1S, const float* QSSS, bf16* OX, LAS unsigned char* lds, LAS unsigned* cnt, int pair, int slot, int sw, int lane) {
    const int b = pair >> 2, h = pair & 3;
    LAS float* OL = (LAS float*)lds + (size_t)slot * (NSW * 1024); LAS float* ML = (LAS float*)(lds + 65536) + slot * 32; LAS float* LL = (LAS float*)(lds + 65536 + 256) + slot * 32;
    const f32x4 gq = *(const f32x4*)(a.in[I_XQN] + 4 * lane);
    f32x4 q[4];
    const float sgc = xq_sigma(SS1S, QSSS, MP + 4 * b + (lane >> 4), h);
#pragma unroll
    for (int t = 0; t < 4; ++t) { const int R = MP + 4 * b + t; const float sg = rdl(sgc, 16 * t); const u32x2 w = *(const u32x2*)(QX + (size_t)R * D + h * 256 + 4 * lane);
        q[t] = (f32x4){bf2f(w.x & 0xffffu), bf2f(w.x >> 16), bf2f(w.y & 0xffffu), bf2f(w.y >> 16)} * gq * sg; }
    constexpr int NK = 256 / NSW;
    const float* kb = a.in[I_CMEM] + ((size_t)(b * 256 + NK * sw) * 2) * 1024 + h * 256; const unsigned loff = 16u * (unsigned)lane;
    const bool b5 = (lane & 32) != 0, b4 = (lane & 16) != 0;
    float m = -1e30f, l = 0.f;
    f32x4 o[4];
#pragma unroll
    for (int t = 0; t < 4; ++t) o[t] = (f32x4){0.f, 0.f, 0.f, 0.f};
    SxBatch A, B; sx_load(A, kb, loff, 0);
#pragma unroll 1
    for (int j0 = 0; j0 < NK; j0 += 2 * SXB) {
        sx_load(B, kb, loff, j0 + SXB);
        sx_compute(A, q, b5, b4, m, l, o);
        if (j0 + 2 * SXB < NK) sx_load(A, kb, loff, j0 + 2 * SXB);
        sx_compute(B, q, b5, b4, m, l, o);
    }
#pragma unroll
    for (int t = 0; t < 4; ++t) *(LAS f32x4*)(OL + (sw * 4 + t) * 256 + 4 * lane) = o[t];
    if ((lane & 15) == 0) { ML[sw * 4 + (lane >> 4)] = m; LL[sw * 4 + (lane >> 4)] = l; }
    asm volatile("s_waitcnt lgkmcnt(0)" ::: "memory");
    unsigned old = 0u; if (lane == 0) old = __hip_atomic_fetch_add(cnt, 1u, __ATOMIC_ACQ_REL, __HIP_MEMORY_SCOPE_WORKGROUP);
    old = __builtin_amdgcn_readfirstlane(old);
    if (old == (unsigned)(NSW - 1)) {
        asm volatile("s_waitcnt lgkmcnt(0)" ::: "memory");
#pragma unroll
        for (int t = 0; t < 4; ++t) {
            float M = -1e30f;
#pragma unroll
            for (int w = 0; w < NSW; ++w) M = fmaxf(M, ML[w * 4 + t]);
            float L = 0.f; f32x4 acc = {0.f, 0.f, 0.f, 0.f};
#pragma unroll
            for (int w = 0; w < NSW; ++w) { const float f = fexp2(ML[w * 4 + t] - M); L += LL[w * 4 + t] * f; acc = acc + *(const LAS f32x4*)(OL + (w * 4 + t) * 256 + 4 * lane) * f; }
            const float il = frcp(L); u32x2 wv; wv.x = cvt_pk_bf16(acc[0] * il, acc[1] * il); wv.y = cvt_pk_bf16(acc[2] * il, acc[3] * il);
            *(u32x2*)(OX + (size_t)(MP + 4 * b + t) * D + h * 256 + 4 * lane) = wv;
        }
    }
}

__device__ __forceinline__ void up8(const bf16* p, float (&v)[8]) { const u32x4 w = *(const u32x4*)p;
    v[0] = bf2f(w.x & 0xffffu); v[1] = bf2f(w.x >> 16); v[2] = bf2f(w.y & 0xffffu); v[3] = bf2f(w.y >> 16); v[4] = bf2f(w.z & 0xffffu); v[5] = bf2f(w.z >> 16); v[6] = bf2f(w.w & 0xffffu); v[7] = bf2f(w.w >> 16); }
__device__ __forceinline__ void ld8(const float* p, float (&v)[8]) { const f32x4 a = *(const f32x4*)p, b = *(const f32x4*)(p + 4); v[0] = a[0]; v[1] = a[1]; v[2] = a[2]; v[3] = a[3]; v[4] = b[0]; v[5] = b[1]; v[6] = b[2]; v[7] = b[3]; }
__device__ __forceinline__ void conv_item(const Args& a, const bf16* UP, bf16* ACT, int it) {
    const int cgp = it % 352, rc = it / 352, j0 = cgp * 8, R0 = rc * 32;
    const float* cw = a.in[I_CONVW]; const float* cbp = a.in[I_CONVB];
    float wg[3][8], wv[3][8], bg[8], bv[8];
#pragma unroll
    for (int i = 0; i < 3; ++i) { ld8(cw + (size_t)i * FF2 + j0, wg[i]); ld8(cw + (size_t)i * FF2 + FF + j0, wv[i]); }
    ld8(cbp + j0, bg); ld8(cbp + FF + j0, bv);
    float g2[8], g1[8], v2[8], v1[8];
    const bool sample = R0 >= MP;
    if (!sample && (R0 & 2047) != 0) { up8(UP + (size_t)(R0 - 2) * FF2 + j0, g2); up8(UP + (size_t)(R0 - 1) * FF2 + j0, g1); up8(UP + (size_t)(R0 - 2) * FF2 + FF + j0, v2); up8(UP + (size_t)(R0 - 1) * FF2 + FF + j0, v1); }
    else {
#pragma unroll
        for (int e = 0; e < 8; ++e) { g2[e] = 0.f; g1[e] = 0.f; v2[e] = 0.f; v1[e] = 0.f; } }
    for (int r = 0; r < 32; ++r) { const int R = R0 + r;
        if (sample && (r & 3) == 0) { const float* sb = a.in[I_SCONV] + (size_t)((R - MP) >> 2) * 2 * FF2; ld8(sb + j0, g2); ld8(sb + FF2 + j0, g1); ld8(sb + FF + j0, v2); ld8(sb + FF2 + FF + j0, v1); }
        float gc[8], vc[8]; up8(UP + (size_t)R * FF2 + j0, gc); up8(UP + (size_t)R * FF2 + FF + j0, vc);
        float o[8];
#pragma unroll
        for (int e = 0; e < 8; ++e) { const float cgv = bg[e] + wg[0][e] * g2[e] + wg[1][e] * g1[e] + wg[2][e] * gc[e]; const float cvv = bv[e] + wv[0][e] * v2[e] + wv[1][e] * v1[e] + wv[2][e] * vc[e];
            o[e] = cgv * sigmoidf_(cgv) * cvv; g2[e] = g1[e]; g1[e] = gc[e]; v2[e] = v1[e]; v1[e] = vc[e]; }
        u32x4 w; w.x = cvt_pk_bf16(o[0], o[1]); w.y = cvt_pk_bf16(o[2], o[3]); w.z = cvt_pk_bf16(o[4], o[5]); w.w = cvt_pk_bf16(o[6], o[7]);
        *(u32x4*)(ACT + (size_t)R * FF + j0) = w;
    }
}

__device__ __forceinline__ void conv_fix_item(const Args& a, const float* EDGE, bf16* ACT, int it) {
    const int cgp = it % 352, rr = it / 352, r = rr & 1, ti = rr >> 1;
    const int pm = 8 * (ti / 7) + 1 + ti % 7, j0 = cgp * 8;
    const float* cw = a.in[I_CONVW]; const float* cbp = a.in[I_CONVB];
    const float* e_prev = EDGE + (size_t)(pm - 1) * 4 * FF2; const float* e_cur = EDGE + (size_t)pm * 4 * FF2;
    const float* r2 = r == 0 ? e_prev + 2 * FF2 : e_prev + 3 * FF2; const float* r1 = r == 0 ? e_prev + 3 * FF2 : e_cur; const float* r0 = r == 0 ? e_cur : e_cur + FF2;
    float o[8];
#pragma unroll
    for (int hf = 0; hf < 2; ++hf) { const int j4 = j0 + 4 * hf;
        const f32x4 cg = *(const f32x4*)(cbp + j4) + *(const f32x4*)(cw + j4) * *(const f32x4*)(r2 + j4) + *(const f32x4*)(cw + FF2 + j4) * *(const f32x4*)(r1 + j4) + *(const f32x4*)(cw + 2 * FF2 + j4) * *(const f32x4*)(r0 + j4);
        const f32x4 cv = *(const f32x4*)(cbp + FF + j4) + *(const f32x4*)(cw + FF + j4) * *(const f32x4*)(r2 + FF + j4) + *(const f32x4*)(cw + FF2 + FF + j4) * *(const f32x4*)(r1 + FF + j4) + *(const f32x4*)(cw + 2 * FF2 + FF + j4) * *(const f32x4*)(r0 + FF + j4);
#pragma unroll
        for (int e = 0; e < 4; ++e) o[4 * hf + e] = cg[e] * sigmoidf_(cg[e]) * cv[e]; }
    u32x4 w; w.x = cvt_pk_bf16(o[0], o[1]); w.y = cvt_pk_bf16(o[2], o[3]); w.z = cvt_pk_bf16(o[4], o[5]); w.w = cvt_pk_bf16(o[6], o[7]);
    *(u32x4*)(ACT + (size_t)(pm * 256 + r) * FF + j0) = w;
}

__device__ __forceinline__ void conv_fix_tile(const Args& a, const float* EDGE, bf16* ACT, int pm, int tid) {
    const float* cw = a.in[I_CONVW]; const float* cbp = a.in[I_CONVB];
    const float* e_prev = EDGE + (size_t)(pm - 1) * 4 * FF2; const float* e_cur = EDGE + (size_t)pm * 4 * FF2;
    for (int it = tid; it < 2 * 352; it += NWAVES * 64) { const int r = it / 352, j0 = (it - r * 352) * 8;
        const float* r2 = r == 0 ? e_prev + 2 * FF2 : e_prev + 3 * FF2; const float* r1 = r == 0 ? e_prev + 3 * FF2 : e_cur; const float* r0 = r == 0 ? e_cur : e_cur + FF2;
        float o[8];
#pragma unroll
        for (int hf = 0; hf < 2; ++hf) { const int j4 = j0 + 4 * hf;
            const f32x4 cg = *(const f32x4*)(cbp + j4) + *(const f32x4*)(cw + j4) * *(const f32x4*)(r2 + j4) + *(const f32x4*)(cw + FF2 + j4) * *(const f32x4*)(r1 + j4) + *(const f32x4*)(cw + 2 * FF2 + j4) * *(const f32x4*)(r0 + j4);
            const f32x4 cv = *(const f32x4*)(cbp + FF + j4) + *(const f32x4*)(cw + FF + j4) * *(const f32x4*)(r2 + FF + j4) + *(const f32x4*)(cw + FF2 + FF + j4) * *(const f32x4*)(r1 + FF + j4) + *(const f32x4*)(cw + 2 * FF2 + FF + j4) * *(const f32x4*)(r0 + FF + j4);
#pragma unroll
            for (int e = 0; e < 4; ++e) o[4 * hf + e] = cg[e] * sigmoidf_(cg[e]) * cv[e]; }
        u32x4 w; w.x = cvt_pk_bf16(o[0], o[1]); w.y = cvt_pk_bf16(o[2], o[3]); w.z = cvt_pk_bf16(o[4], o[5]); w.w = cvt_pk_bf16(o[6], o[7]);
        *(u32x4*)(ACT + (size_t)(pm * 256 + r) * FF + j0) = w; }
}

#ifndef MK_N_LAUNCHES
#define MK_N_LAUNCHES 1
#endif
constexpr int N_PHASES = 11;
#ifndef DUP_PHASE
#define DUP_PHASE -1
#endif
#define NREP(k) ((DUP_PHASE) == (k) ? 2 : 1)
constexpr int N_LAUNCHES = MK_N_LAUNCHES;
static_assert(N_LAUNCHES == 1 || N_LAUNCHES == N_PHASES, "MK_N_LAUNCHES is 1 or 11");

__global__ void __launch_bounds__(NWAVES * 64, 2) fwd_kernel(Args args) {
    extern __shared__ __attribute__((aligned(16))) unsigned char lds_raw[];
    LAS unsigned char* lds = (LAS unsigned char*)lds_raw;
    volatile LAS unsigned* MISC = (volatile LAS unsigned*)(lds + MISC_OFF);
    const int tid0 = threadIdx.x, wave0 = __builtin_amdgcn_readfirstlane(tid0 >> 6);
    const int G = gridDim.x; const int bx = blockIdx.x; const int vcu = (G % 8 == 0) ? (bx % 8) * (G / 8) + bx / 8 : bx;
    const int NGW = G * NWAVES;
    unsigned char* ws = args.ws;
    gu32* ctl = (gu32*)(ws + WS_CTL);
    for (int u = tid0; u < 128; u += NWAVES * 64) ((LAS unsigned*)(lds + MISC_OFF))[u] = 0u;
    __syncthreads();
    XcdBarrier bar; bar.bar = (unsigned*)(ctl + CW_BAR); bar.x = 0; bar.st = nullptr;
    if (N_LAUNCHES == 1) bar = xcd_barrier_post((unsigned*)(ctl + CW_BAR) + args.li * XCD_BAR_WORDS, MISC + 8);
#ifdef DOUBLE_BAR
#define GRID_BAR() do { if (N_LAUNCHES == 1) { xcd_barrier(bar); xcd_barrier(bar); } } while (0)
#else
#define GRID_BAR() do { if (N_LAUNCHES == 1) xcd_barrier(bar); } while (0)
#endif
    const int lo = args.ph_lo, hi = args.ph_hi;
#define IN(k) (lo <= (k) && (k) < hi)
#define WSBASE() GAS unsigned char* wsl = (GAS unsigned char*)ws; asm volatile("" : "+s"(wsl));     int tid = threadIdx.x; asm volatile("" : "+v"(tid)); const int lane = tid & 63, wave = __builtin_amdgcn_readfirstlane(tid >> 6), gw = vcu * NWAVES + wave; (void)lane; (void)gw
#define ROPE_ ((float*)(wsl + WS_ROPE))
#define SSMC_ ((float*)(wsl + WS_SSMC))
#define WIN ((bf16*)(wsl + WS_WIN))
#define WOUT ((bf16*)(wsl + WS_WOUT))
#define WXQ ((bf16*)(wsl + WS_WXQ))
#define WXKV ((bf16*)(wsl + WS_WXKV))
#define WXO ((bf16*)(wsl + WS_WXO))
#define WUP ((bf16*)(wsl + WS_WUP))
#define WDOWN ((bf16*)(wsl + WS_WDOWN))
#define WGLU ((bf16*)(wsl + WS_WGLU))
#define XN ((bf16*)(wsl + WS_XN))
#define MEMN ((bf16*)(wsl + WS_MEMN))
#define Qb ((bf16*)(wsl + WS_Q))
#define Kb ((bf16*)(wsl + WS_K))
#define VT ((bf16*)(wsl + WS_VT))
#define U_ ((float*)(wsl + WS_U))
#define AO ((bf16*)(wsl + WS_AO))
#define LSE ((float*)(wsl + WS_LSE))
#define SSMF ((float*)(wsl + WS_SSMF))
#define MIXED ((bf16*)(wsl + WS_MIXED))
#define H1B ((bf16*)(wsl + WS_H1B))
#define SS1 ((float*)(wsl + WS_CTL + CTL_RS1))
#define QX ((bf16*)(wsl + WS_QX))
#define QSS ((float*)(wsl + WS_CTL + CTL_QS))
#define MSS ((float*)(wsl + WS_MSS))
#define MEMK ((bf16*)(wsl + WS_MEMK))
#define MVT ((bf16*)(wsl + WS_MVT))
#define OX ((bf16*)(wsl + WS_OX))
#define H2B ((bf16*)(wsl + WS_H2B))
#define SS2 ((float*)(wsl + WS_CTL + CTL_RS2))
#define UP ((bf16*)(wsl + WS_UP))
#define ACT ((bf16*)(wsl + WS_ACT))
#define SS1S (SS1 + MP)
#define QSSS (QSS + (size_t)MP * 4)
#define SS2S (SS2 + MP)
    float* out = args.out;

    if (IN(0)) for (int rep_ = 0; rep_ < NREP(0); ++rep_) { WSBASE();
        LAS float* scr = (LAS float*)(lds + wave * 16384);
        constexpr int I_IN = 16 * (INW / 32), I_SQ = 16 * (D / 32), I_KV = 16 * (2048 / 32), I_UP = 16 * (FF2 / 32), I_DN = (FF / 64) * (D / 32), I_GL = 4 * 8;
        constexpr int NIT = I_IN + 3 * I_SQ + I_KV + I_UP + I_DN + I_GL;
        for (int it = gw; it < NIT; it += NGW) {
            int r = it;
            if (r < I_IN) { p0_transpose_item<1>(args.in[I_WIN], D, INW, WIN, nullptr, scr, r, lane); continue; } r -= I_IN;
            if (r < I_SQ) { p0_transpose_item<0>(args.in[I_WOUT], D, D, WOUT, nullptr, scr, r, lane); continue; } r -= I_SQ;
            if (r < I_SQ) { p0_transpose_item<0>(args.in[I_WXQ], D, D, WXQ, args.in[I_NX], scr, r, lane); continue; } r -= I_SQ;
            if (r < I_SQ) { p0_transpose_item<0>(args.in[I_WXO], D, D, WXO, nullptr, scr, r, lane); continue; } r -= I_SQ;
            if (r < I_KV) { p0_transpose_item<0>(args.in[I_WXKV], D, 2048, WXKV, nullptr, scr, r, lane); continue; } r -= I_KV;
            if (r < I_UP) { p0_transpose_item<2>(args.in[I_WUP], D, FF2, WUP, args.in[I_NFFN], scr, r, lane); continue; } r -= I_UP;
            if (r < I_DN) { p0_transpose_item<0>(args.in[I_WDOWN], FF, D, WDOWN, nullptr, scr, r, lane); continue; } r -= I_DN;
            p0_transpose_item<0>(args.in[I_WGLU], 256, 256, WGLU, nullptr, scr, r, lane);
        }
        { f32x4 gg[4];
#pragma unroll
          for (int j = 0; j < 4; ++j) gg[j] = ((const f32x4*)args.in[I_NMIX])[lane + 64 * j];
          for (int m = 2 * gw; m < MT; m += 2 * NGW) { const float* x0 = m < MP ? args.in[I_XP] + (size_t)m * D : args.in[I_XS] + (size_t)(m - MP) * D;
              rms_rows2_to_bf16(x0, x0 + D, gg, XN + (size_t)m * D, XN + (size_t)(m + 1) * D, lane); }
#pragma unroll
          for (int j = 0; j < 4; ++j) gg[j] = ((const f32x4*)args.in[I_NMEM])[lane + 64 * j];
          for (int m = 2 * gw; m < MM; m += 2 * NGW) rms_rows2_to_bf16(args.in[I_MEM] + (size_t)m * D, args.in[I_MEM] + (size_t)(m + 1) * D, gg, MEMN + (size_t)m * D, MEMN + (size_t)(m + 1) * D, lane); }
        {
            const int gt = vcu * (NWAVES * 64) + tid;
            if (gt < 2052 * 8) { const int pos = gt >> 3, i = gt & 7; const float iv = i == 0 ? 1.0f : i == 1 ? 0.1939227432012558f : i == 2 ? 0.03760603070259094f : i == 3 ? 0.007292664609849453f : i == 4 ? 0.0014142135623842478f : i == 5 ? 0.00027424818836152554f : i == 6 ? 5.3182957344688475e-05f : 1.0313385246263351e-05f;
                const float ang = (float)pos * iv; double s, c; sincos_d((double)ang, s, c); ROPE_[pos * 16 + i] = (float)c; ROPE_[pos * 16 + 8 + i] = (float)s; }
            const int st = gt - 2052 * 8;
            if (st >= 0 && st < 1024) {
                const int g = st >> 6; const double dt = exp_d((double)args.in[I_LDT][g]); const double lr = (double)args.in[I_LRE][st], li = (double)args.in[I_LIM][st];
                const double mag = exp_d(lr * dt); double s, c; sincos_d(li * dt, s, c); const double are = mag * c, aim = mag * s;
                const double den = lr * lr + li * li, nr = are - 1.0, ni = aim; const double cre = (nr * lr + ni * li) / den, cim = (ni * lr - nr * li) / den;
                const double mag64 = exp_d(64.0 * lr * dt); double s64, c64; sincos_d(64.0 * li * dt, s64, c64);
                float* o = SSMC_ + (size_t)st * 8; o[0] = (float)are; o[1] = (float)aim; o[2] = (float)cre; o[3] = (float)cim; o[4] = (float)(mag64 * c64); o[5] = (float)(mag64 * s64); o[6] = 0.f; o[7] = 0.f; }
        }
        GRID_BAR();
    }

    if (IN(1)) for (int rep_ = 0; rep_ < NREP(1); ++rep_) { WSBASE();
        int base = 0;
        { pg8::Gemm g{XN, WIN, MT, INW, D}; pg8::RotOrder S; S.init(MT, INW, G, bx, base); base += S.nwg;
          pg8::EpiZ E{Qb, Kb, VT, U_, ROPE_, args.in[I_QN], args.in[I_KN], out};
          pg8::gemm_phase<pg8::EpiZ, pg8::RotOrder, true, true>(lds, g, S, E); }
        { pg8::Gemm g{MEMN, WXKV, MM, 2048, D}; pg8::RotOrder S; S.init(MM, 2048, G, bx, base); base += S.nwg;
          pg8::EpiMem E{out + O_MEMKV, MSS, MVT}; pg8::gemm_phase<pg8::EpiMem, pg8::RotOrder, true, true>(lds, g, S, E); }
        GRID_BAR();
    }

    if (IN(2)) for (int rep_ = 0; rep_ < NREP(2); ++rep_) { WSBASE();
        for (int r2_ = 0; r2_ < ((DUP_PHASE) == 21 ? 2 : 1); ++r2_)
        for (int it = vcu; it < 3 * 256; it += G) pattn_wg_item(Qb, Kb, VT, AO, LSE, lds, it, wave, lane, tid);
        LAS float* uL = (LAS float*)(lds + wave * 4096);
        if (wave < 6) { for (int it = vcu * 6 + wave; it < 3 * 512; it += G * 6) sattn_item(args, Qb, AO, LSE, it, lane); }
        else { if (rep_ == 0) for (int it = vcu * 2 + (wave - 6); it < MM; it += G * 2) memk_fix_item(out + O_MEMKV, MSS, args.in[I_XKN], args.in[I_XQN], MEMK, it, lane);
               for (int it = vcu * 2 + (wave - 6); it < 8 * 31 * 16; it += G * 2) ssm_a_item(args, U_, SSMC_, SSMF, uL, it, lane); }
        GRID_BAR();
    }

    if (IN(3)) for (int rep_ = 0; rep_ < NREP(3); ++rep_) { WSBASE();
#if defined(PROBE_LDS_FILL)
        for (int u_ = tid; u_ < 134656 / 4; u_ += NWAVES * 64) ((LAS unsigned*)lds)[u_] = PROBE_LDS_FILL;
        __syncthreads();
#endif
#if defined(PROBE_DELAY_P3)
        for (int i_ = 0; i_ < 10; ++i_) __builtin_amdgcn_s_sleep(127);
        __builtin_amdgcn_fence(__ATOMIC_ACQUIRE, "agent"); asm volatile("s_waitcnt vmcnt(0)" ::: "memory"); __syncthreads();
#endif
        for (int r1_ = 0; r1_ < ((DUP_PHASE) == 31 ? 2 : 1); ++r1_)
        if (G > 64) {
            if (vcu >= 32) { const int ncw = (G - 32) * NWAVES; for (int R = ((vcu - 32) * NWAVES + wave) * 8; R < MT; R += ncw * 8) combine_rows<8>(AO, LSE, args.in[I_AON], MIXED, R, lane); }
        } else { for (int R = gw * 4; R < MT; R += NGW * 4) combine_rows<4>(AO, LSE, args.in[I_AON], MIXED, R, lane); }
#if defined(PROBE_P3_TWICE)
        for (int it = vcu; it < 256; it += G) ssm_c_item(args, U_, SSMC_, SSMF, WGLU, (bf16*)(wsl + 644 * MiB), lds, it, wave, lane);
#endif
        for (int r2_ = 0; r2_ < ((DUP_PHASE) == 32 ? 2 : 1); ++r2_)
        for (int it = vcu; it < 256; it += G) ssm_c_item(args, U_, SSMC_, SSMF, WGLU, MIXED, lds, it, wave, lane);
        GRID_BAR();
    }

    if (IN(4)) for (int rep_ = 0; rep_ < NREP(4); ++rep_) { WSBASE();
        pg8::Gemm g{MIXED, WOUT, MP, D, D}; pg8::RotOrder S; S.init(MP, D, G, bx, 0);
        pg8::EpiRes<false, false> E{args.in[I_XP], nullptr, H1B, SS1}; pg8::gemm_phase<pg8::EpiRes<false, false>, pg8::RotOrder, true, true>(lds, g, S, E);
        for (int tile = bx; tile < 256; tile += G)
            sample_gemm_tile<0, false>(MIXED + (size_t)MP * D, WOUT, D, args.in[I_XS], nullptr, H1B + (size_t)MP * D, SS1S, lds, tile, wave, lane, tid);
        GRID_BAR();
    }
    if (IN(5)) for (int rep_ = 0; rep_ < NREP(5); ++rep_) { WSBASE();
        pg8::Gemm g{H1B, WXQ, MP, D, D}; pg8::RotOrder S; S.init(MP, D, G, bx, 0);
        pg8::EpiQx E{QX, QSS}; pg8::gemm_phase<pg8::EpiQx, pg8::RotOrder, true, true>(lds, g, S, E);
        for (int tile = bx; tile < 256; tile += G)
            sample_gemm_tile<1>(H1B + (size_t)MP * D, WXQ, D, nullptr, nullptr, QX + (size_t)MP * D, QSSS, lds, tile, wave, lane, tid);
        GRID_BAR();
    }
    if (IN(6)) for (int rep_ = 0; rep_ < NREP(6); ++rep_) { WSBASE();
        if (tid < 8) ((LAS unsigned*)(lds + MISC_OFF))[16 + tid] = 0u;
        __syncthreads();
        for (int r2_ = 0; r2_ < ((DUP_PHASE) == 61 ? 2 : 1); ++r2_) {
            int slot = 0;
            for (int pair = vcu; pair < BS * 4; pair += G, ++slot) sxattn_stream<8>(args, QX, SS1, QSS, OX, lds, (LAS unsigned*)(lds + MISC_OFF) + 16 + (slot & 7), pair, slot & 1, wave, lane);
        }
        __syncthreads();
        { int tid2 = threadIdx.x; asm volatile("" : "+v"(tid2)); const int lane2 = tid2 & 63, wave2 = __builtin_amdgcn_readfirstlane(tid2 >> 6);
          GAS unsigned char* wsl2 = (GAS unsigned char*)ws; asm volatile("" : "+s"(wsl2));
        for (int r2_ = 0; r2_ < ((DUP_PHASE) == 62 ? 2 : 1); ++r2_)
        for (int it = vcu; it < 8 * 4 * 8; it += G) xattn_wg_item((bf16*)(wsl2 + WS_QX), (float*)(wsl2 + WS_CTL + CTL_RS1), (float*)(wsl2 + WS_CTL + CTL_QS), (bf16*)(wsl2 + WS_MEMK), (bf16*)(wsl2 + WS_MVT), (bf16*)(wsl2 + WS_OX), lds, it, wave2, lane2, tid2); }
        GRID_BAR();
    }
    if (IN(7)) for (int rep_ = 0; rep_ < NREP(7); ++rep_) { WSBASE();
        pg8::Gemm g{OX, WXO, MP, D, D}; pg8::RotOrder S; S.init(MP, D, G, bx, 0);
        pg8::EpiRes<true, false> E{H1B, nullptr, H2B, SS2}; pg8::gemm_phase<pg8::EpiRes<true, false>, pg8::RotOrder, true, true>(lds, g, S, E);
        for (int tile = bx; tile < 256; tile += G)
            sample_gemm_tile<0, true>(OX + (size_t)MP * D, WXO, D, H1B + (size_t)MP * D, nullptr, H2B + (size_t)MP * D, SS2S, lds, tile, wave, lane, tid);
        GRID_BAR();
    }
    if (IN(8)) for (int rep_ = 0; rep_ < NREP(8); ++rep_) { WSBASE();
        pg8::Gemm g{H2B, WUP, MT, FF2, D}; pg8::RotOrder S; S.init(MT, FF2, G, bx, 0);
        pg8::EpiUpConv E{ACT, (float*)(wsl + WS_EDGE), SS2, args.in[I_CONVW], args.in[I_CONVB], args.in[I_SCONV], out + O_CONVP, out + O_CONVS, lds}; pg8::gemm_phase<pg8::EpiUpConv, pg8::RotOrder, true, true>(lds, g, S, E);
        GRID_BAR();
    }
    if (IN(10)) for (int rep_ = 0; rep_ < NREP(10); ++rep_) { WSBASE();
        pg8::Gemm g{ACT, WDOWN, MP, D, FF}; pg8::RotOrder S; S.init(MP, D, G, bx, 0);
        { pg8::Unit uu; for (int i = 0; S.next(i, uu); ++i) if ((uu.pm & 7) != 0) conv_fix_tile(args, (const float*)(wsl + WS_EDGE), ACT, uu.pm, tid);
          VM_WAIT(); __syncthreads(); }
        pg8::EpiRes<true, true> E{H2B, out, nullptr, nullptr}; pg8::gemm_phase<pg8::EpiRes<true, true>, pg8::RotOrder, true, true>(lds, g, S, E);
        for (int tile = bx; tile < 256; tile += G)
            sample_gemm_tile<0, true>(ACT + (size_t)MP * FF, WDOWN, FF, H2B + (size_t)MP * D, out + (size_t)MP * D, nullptr, nullptr, lds, tile, wave, lane, tid);
    }
#if defined(DBG_SCALE_MASK)
    if (hi == N_PHASES) { GRID_BAR();
        const size_t offs[16] = {O_YP, O_YS, O_KV1P, O_KV4P, O_KV16P, O_SREP, O_SIMP, O_CONVP, O_MEMKV, O_KV1S, O_KV4S, O_KV16S, O_SRES, O_SIMS, O_CONVS, O_END};
        const size_t gt = (size_t)vcu * (NWAVES * 64) + tid, NT = (size_t)G * NWAVES * 64;
#pragma unroll
        for (int o = 0; o < 15; ++o) if ((DBG_SCALE_MASK >> o) & 1) { for (size_t i = offs[o] + gt; i < offs[o + 1]; i += NT) out[i] *= 3.0f; }
    }
#endif
#undef IN
#undef GRID_BAR
}


#if defined(PROBE_DET) || defined(PROBE_P3_TWICE)
__global__ void det_cmp_kernel(const unsigned* a, const unsigned* b, size_t nwords, unsigned* counter, int tol, int rw, int lo, int hi) {
    unsigned c = 0;
    for (size_t i = (size_t)blockIdx.x * blockDim.x + threadIdx.x; i < nwords; i += (size_t)gridDim.x * blockDim.x) {
        if (rw > 0) { const int cw = (int)(i % (size_t)rw); if (cw < lo || cw >= hi) continue; }
        const unsigned x = a[i], y = b[i];
        if (tol) { const float fx = __uint_as_float(x), fy = __uint_as_float(y); if (!(fabsf(fx - fy) <= 0.02f)) ++c; } else if (x != y) { ++c; atomicMin(counter + 32, (unsigned)i); atomicMax(counter + 48, (unsigned)i); } }
    if (c) atomicAdd(counter, c);
}
__global__ void det_mark_kernel(const unsigned* counters, int nreg, float* y, size_t n, int forced) {
    int r = -1; for (int i = nreg - 1; i >= 0; --i) if (counters[i] != 0u) r = i;
#if defined(PROBE_DET_COUNT)
    { const unsigned c = counters[PROBE_DET_COUNT], fw = counters[32 + PROBE_DET_COUNT], lw = counters[48 + PROBE_DET_COUNT]; const int fitem = (int)(fw / 512u) / 64, litem = (int)(lw / 512u) / 64;
      r = -1;
      if (c) { switch (PROBE_DET_MODE) { case 1: r = (int)(c >> 10); break; case 2: r = fitem >> 4; break; case 3: r = fitem & 15; break; case 4: r = litem - fitem; break; case 5: r = (int)((fw / 512u) & 63) >> 2; break; case 6: r = (int)(fw & 511u) >> 5; break; default: r = 0; } if (r > 21) r = 21; } }
#endif
    if (forced >= 0) r = forced;
#if defined(PROBE_CAL)
    r = (int)((wall_clock64() >> 12) & 1) ? 19 : -1;
#endif
    if (r < 0) return;
    const float f = 1.0f + 0.1f * (float)(r + 1);
    for (size_t i = (size_t)blockIdx.x * blockDim.x + threadIdx.x; i < n; i += (size_t)gridDim.x * blockDim.x) y[i] *= f;
}
#endif

extern "C" void kernel_launch(void* const* d_in, const int* in_sizes, int n_in, void* d_out, int out_size, void* d_ws, size_t ws_size, hipStream_t stream) {
    static int grid = 0;
    if (grid == 0) {
        if (n_in != 39 || (size_t)out_size != O_END || ws_size < WS_END) { fprintf(stderr, "kernel_launch: unexpected problem shape (n_in %d, out %d, ws %zu); nothing launched\n", n_in, out_size, ws_size); grid = -1; return; }
        int dev = 0, cus = 0, per_cu = 0;
        if (hipGetDevice(&dev) != hipSuccess || hipDeviceGetAttribute(&cus, hipDeviceAttributeMultiprocessorCount, dev) != hipSuccess) { grid = -1; return; }
        if (hipFuncSetAttribute((const void*)fwd_kernel, hipFuncAttributeMaxDynamicSharedMemorySize, LDS_BYTES) != hipSuccess) { fprintf(stderr, "kernel_launch: hipFuncSetAttribute failed\n"); grid = -1; return; }
        if (hipOccupancyMaxActiveBlocksPerMultiprocessor(&per_cu, (const void*)fwd_kernel, NWAVES * 64, LDS_BYTES) != hipSuccess || per_cu < 1) { fprintf(stderr, "kernel_launch: occupancy query says %d workgroups per CU\n", per_cu); (void)hipGetLastError(); grid = -1; return; }
        grid = cus;
    }
    if (grid < 0) return;
    (void)hipMemsetAsync((char*)d_ws + WS_CTL, 0, CTL_ZERO_BYTES, stream);
    Args a{};
    for (int i = 0; i < 39; ++i) a.in[i] = (const float*)d_in[i];
    a.out = (float*)d_out; a.ws = (unsigned char*)d_ws;
#if defined(PROBE_PRE_HI)
    a.ph_lo = 0; a.ph_hi = PROBE_PRE_HI; a.li = 1; a.pad = 0;
    hipLaunchKernelGGL(fwd_kernel, dim3(grid), dim3(NWAVES * 64), LDS_BYTES, stream, a);
    (void)hipMemsetAsync((char*)d_ws + WS_CTL, 0, CTL_ZERO_BYTES, stream);
#endif
#if defined(PROBE_DET)
    {
        const size_t SP = 644 * MiB, need = 1005 * MiB;
        char* w = (char*)d_ws; float* o = (float*)d_out;
        if (ws_size >= need) {
            a.ph_lo = 0; a.ph_hi = N_PHASES; a.li = 0; a.pad = 0;
            hipLaunchKernelGGL(fwd_kernel, dim3(grid), dim3(NWAVES * 64), LDS_BYTES, stream, a);
#if defined(PROBE_DUMP)
            (void)hipMemcpyAsync(w + SP + 190 * MiB, w + 191 * MiB, 33 * MiB, hipMemcpyDeviceToDevice, stream);
            (void)hipMemcpyAsync(w + 760 * MiB, w + 724 * MiB, 34 * MiB, hipMemcpyDeviceToDevice, stream);
#else
            (void)hipMemcpyAsync(w + SP, w + 1 * MiB, 223 * MiB, hipMemcpyDeviceToDevice, stream);
            (void)hipMemcpyAsync(w + SP + 223 * MiB, w + 295 * MiB, 4 * MiB, hipMemcpyDeviceToDevice, stream);
            (void)hipMemcpyAsync(w + SP + 227 * MiB, d_out, O_END * 4, hipMemcpyDeviceToDevice, stream);
#endif
#if defined(PROBE_DET_POISON)
            (void)hipMemsetAsync(w + PROBE_DET_POISON_LO * MiB, 0xAA, (size_t)(PROBE_DET_POISON_HI - PROBE_DET_POISON_LO) * MiB, stream);
#endif
            (void)hipMemsetAsync(w + WS_CTL, 0, CTL_ZERO_BYTES, stream);
        }
    }
#endif
    for (int li = 0; li < N_LAUNCHES; ++li) {
        a.li = 0; a.pad = 0;
        a.ph_lo = (N_LAUNCHES == 1) ? 0 : li; a.ph_hi = (N_LAUNCHES == 1) ? N_PHASES : li + 1;
        hipLaunchKernelGGL(fwd_kernel, dim3(grid), dim3(NWAVES * 64), LDS_BYTES, stream, a);
        const hipError_t le = hipPeekAtLastError();
        if (le != hipSuccess) { fprintf(stderr, "kernel_launch: launch %d failed: %s\n", li, hipGetErrorName(le)); break; }
    }
#if defined(PROBE_P3_TWICE)
    {   char* w = (char*)d_ws; float* o = (float*)d_out; unsigned* cnt = (unsigned*)(w + 643 * MiB + 900 * 1024);
        (void)hipMemsetAsync(cnt, 0, 256, stream); (void)hipMemsetAsync(cnt + 32, 0xFF, 64, stream);
        hipLaunchKernelGGL(det_cmp_kernel, dim3(2048), dim3(256), 0, stream, (const unsigned*)(w + WS_MIXED), (const unsigned*)(w + 644 * MiB), (size_t)MP * D * 2 / 4, cnt + PROBE_DET_COUNT, 0, 512, 384, 512);
        hipLaunchKernelGGL(det_mark_kernel, dim3(32), dim3(256), 0, stream, cnt, 1, o + O_SREP, (size_t)BP * 1024, -1);
    }
#endif
#if defined(PROBE_DET)
    {
        const size_t SP = 644 * MiB, need = 1005 * MiB;
        char* w = (char*)d_ws; float* o = (float*)d_out; unsigned* cnt = (unsigned*)(w + 640 * MiB);
        cnt = (unsigned*)(w + 643 * MiB + 900 * 1024);
        if (ws_size < need) { hipLaunchKernelGGL(det_mark_kernel, dim3(1024), dim3(256), 0, stream, cnt, 0, o, (size_t)MP * D, 19); }
        else {
            (void)hipMemsetAsync(cnt, 0, 256, stream); (void)hipMemsetAsync(cnt + 32, 0xFF, 64, stream);
            const char* c0 = w + SP - 1 * MiB;
            const float* oc = (const float*)(w + SP + 227 * MiB);
            struct Reg { const void* a; const void* b; size_t bytes; int tol; };
            struct Reg2 { const void* a; const void* b; size_t bytes; int rw, lo, hi; };
#if defined(PROBE_DUMP)
            const Reg2 regs[5] = {
                {w + 724 * MiB, w + 760 * MiB, (size_t)8 * MiB, 0, 0, 0}, {w + 741 * MiB, w + 777 * MiB, (size_t)2 * MiB, 0, 0, 0},
                {w + WS_MIXED, c0 + WS_MIXED, (size_t)MP * D * 2, 512, 384, 512}, {w + WS_MIXED, c0 + WS_MIXED, (size_t)MP * D * 2, 512, 384, 512}, {w + WS_MIXED, c0 + WS_MIXED, (size_t)MP * D * 2, 512, 384, 512} };
#else
            const Reg2 regs[14] = {
                {w + WS_U, c0 + WS_U, (size_t)MT * 256 * 4, 0, 0, 0}, {w + WS_Q, c0 + WS_Q, (size_t)MT * 768 * 2, 0, 0, 0}, {w + WS_K, c0 + WS_K, (size_t)MT * 768 * 2, 0, 0, 0}, {w + WS_VT, c0 + WS_VT, (size_t)MP * 768 * 2, 0, 0, 0},
                {o + O_KV1P, oc + O_KV1P, (O_SREP - O_KV1P) * 4, 0, 0, 0}, {o + O_MEMKV, oc + O_MEMKV, (O_KV1S - O_MEMKV) * 4, 0, 0, 0}, {o + O_KV1S, oc + O_KV1S, (O_SRES - O_KV1S) * 4, 0, 0, 0},
                {w + WS_SSMF, c0 + WS_SSMF, 2 * MiB, 0, 0, 0}, {w + WS_AO, c0 + WS_AO, (size_t)MT * 768 * 2, 0, 0, 0}, {w + WS_LSE, c0 + WS_LSE, (size_t)MT * 12 * 4, 0, 0, 0}, {w + WS_MEMK, w + SP + 223 * MiB, 4 * MiB, 0, 0, 0},
                {o + O_SREP, oc + O_SREP, (O_CONVP - O_SREP) * 4, 0, 0, 0}, {o + O_SRES, oc + O_SRES, (O_CONVS - O_SRES) * 4, 0, 0, 0}, {w + WS_MIXED, c0 + WS_MIXED, (size_t)MT * D * 2, 0, 0, 0} };
#endif
            for (int r = 0; r < (int)(sizeof(regs) / sizeof(regs[0])); ++r) hipLaunchKernelGGL(det_cmp_kernel, dim3(2048), dim3(256), 0, stream, (const unsigned*)regs[r].a, (const unsigned*)regs[r].b, regs[r].bytes / 4, cnt + r, 0, regs[r].rw, regs[r].lo, regs[r].hi);
            hipLaunchKernelGGL(det_mark_kernel, dim3(32), dim3(256), 0, stream, cnt, 14, o + O_SREP, (size_t)BP * 1024, -1);
        }
    }
#endif
}
```

```cpp
#include <hip/hip_runtime.h>
#include <cstdio>
#include <cstdint>

#define GAS __attribute__((address_space(1)))
#define LAS __attribute__((address_space(3)))
#define PG8_LAS __attribute__((address_space(3)))
typedef unsigned short bf16;
typedef short bf16x8 __attribute__((ext_vector_type(8)));
typedef float f32x4 __attribute__((ext_vector_type(4)));
typedef float f32x2 __attribute__((ext_vector_type(2)));
typedef float f32x16 __attribute__((ext_vector_type(16)));
typedef unsigned u32x4 __attribute__((ext_vector_type(4)));
typedef unsigned u32x2 __attribute__((ext_vector_type(2)));
typedef GAS unsigned gu32;
#define RLX_AGENT __ATOMIC_RELAXED, __HIP_MEMORY_SCOPE_AGENT
#define LDS_WAIT() asm volatile("s_waitcnt lgkmcnt(0)" ::: "memory")
#define VM_WAIT() asm volatile("s_waitcnt vmcnt(0)" ::: "memory")

constexpr int D = 1024, BP = 8, LP = 2048, MP = BP * LP, BS = 128, TS = 4, MS = BS * TS, MT = MP + MS;
constexpr int INW = 2560, AW = 768, SW = 256, NMEM = 256, MM = BP * NMEM, FF = 2816, FF2 = 5632;
constexpr float EPS = 1e-6f;
constexpr float LOG2E = 1.4426950408889634f, LN2 = 0.6931471805599453f;
constexpr int NWAVES = 8;

constexpr size_t MiB = 1u << 20;
constexpr size_t WS_CTL = 0, CTL_ZERO_BYTES = 1 * MiB;
constexpr size_t WS_ROPE = 1 * MiB;
constexpr size_t WS_SSMC = 1 * MiB + 512 * 1024;
constexpr size_t WS_WIN = 2 * MiB, WS_WOUT = 7 * MiB, WS_WXQ = 9 * MiB, WS_WXKV = 11 * MiB, WS_WXO = 15 * MiB, WS_WUP = 17 * MiB, WS_WDOWN = 28 * MiB, WS_WGLU = 34 * MiB;
constexpr size_t WS_XN = 35 * MiB, WS_MEMN = 68 * MiB, WS_Q = 72 * MiB, WS_K = 97 * MiB, WS_VT = 122 * MiB, WS_U = 146 * MiB, WS_AO = 163 * MiB, WS_LSE = 188 * MiB;
constexpr size_t WS_SSMF = 189 * MiB, WS_MIXED = 191 * MiB, WS_H1B = 224 * MiB, WS_SS1 = 257 * MiB, WS_QX = 259 * MiB, WS_QSS = 292 * MiB, WS_MSS = 294 * MiB, WS_MEMK = 295 * MiB, WS_MVT = 299 * MiB;
constexpr size_t WS_OX = 303 * MiB, WS_H2B = 336 * MiB, WS_SS2 = 369 * MiB, WS_UP = 371 * MiB, WS_ACT = 553 * MiB, WS_END = 644 * MiB;
constexpr size_t WS_EDGE = 371 * MiB;
constexpr size_t WS_SS1S = 258 * MiB + 512 * 1024, WS_QSSS = 293 * MiB + 512 * 1024, WS_SS2S = 370 * MiB + 512 * 1024;
constexpr size_t CTL_RS1 = 128 * 1024, CTL_RS2 = 256 * 1024, CTL_QS = 384 * 1024;
constexpr int CW_BAR = 4096;

constexpr int RING_BYTES = 131072;
constexpr int MISC_OFF = 135168;
constexpr int LDS_BYTES = 147456;

__device__ __forceinline__ unsigned f2bf(float f) { unsigned u = __builtin_bit_cast(unsigned, f); return (u + 0x7fffu + ((u >> 16) & 1u)) >> 16; }
__device__ __forceinline__ unsigned pk2(float lo, float hi) { return f2bf(lo) | (f2bf(hi) << 16); }
__device__ __forceinline__ float bf2f(unsigned h) { return __builtin_bit_cast(float, h << 16); }
typedef __bf16 bf16v2_t __attribute__((ext_vector_type(2)));
__device__ __forceinline__ unsigned cvt_pk_bf16(float lo, float hi) { const f32x2 v = {lo, hi}; return __builtin_bit_cast(unsigned, __builtin_convertvector(v, bf16v2_t)); }
__device__ __forceinline__ bf16x8 pack8(float a0, float a1, float a2, float a3, float a4, float a5, float a6, float a7) {
    u32x4 w; w.x = cvt_pk_bf16(a0, a1); w.y = cvt_pk_bf16(a2, a3); w.z = cvt_pk_bf16(a4, a5); w.w = cvt_pk_bf16(a6, a7); return __builtin_bit_cast(bf16x8, w); }
__device__ __forceinline__ float wave_sum(float v) {
#pragma unroll
    for (int o = 1; o < 64; o <<= 1) v += __shfl_xor(v, o);
    return v;
}
__device__ __forceinline__ float fexp2(float x) { return __builtin_amdgcn_exp2f(x); }
__device__ __forceinline__ float flog2(float x) { return __builtin_amdgcn_logf(x); }
__device__ __forceinline__ float frcp(float x) { return __builtin_amdgcn_rcpf(x); }
__device__ __forceinline__ float frsq(float x) { return __builtin_amdgcn_rsqf(x); }
__device__ __forceinline__ void sincos_d(double x, double& s, double& c) {
    const double k = __builtin_rint(x * 0.63661977236758134308);
    double r = __builtin_fma(-k, 1.57079632679489655800e+00, x); r = __builtin_fma(-k, 6.12323399573676603587e-17, r);
    const long long q = (long long)k; const double r2 = r * r;
    double sp = 1.0 / 6227020800.0; sp = sp * r2 - 1.0 / 39916800.0; sp = sp * r2 + 1.0 / 362880.0; sp = sp * r2 - 1.0 / 5040.0; sp = sp * r2 + 1.0 / 120.0; sp = sp * r2 - 1.0 / 6.0; sp = sp * r2 + 1.0; sp = sp * r;
    double cp = -1.0 / 87178291200.0; cp = cp * r2 + 1.0 / 479001600.0; cp = cp * r2 - 1.0 / 3628800.0; cp = cp * r2 + 1.0 / 40320.0; cp = cp * r2 - 1.0 / 720.0; cp = cp * r2 + 1.0 / 24.0; cp = cp * r2 - 0.5; cp = cp * r2 + 1.0;
    const int qq = (int)(q & 3);
    s = (qq == 0) ? sp : (qq == 1) ? cp : (qq == 2) ? -sp : -cp;
    c = (qq == 0) ? cp : (qq == 1) ? -sp : (qq == 2) ? -cp : sp;
}
__device__ __forceinline__ double exp_d(double x) {
    const double k = __builtin_rint(x * 1.44269504088896340736);
    double r = __builtin_fma(-k, 6.93147180369123816490e-01, x); r = __builtin_fma(-k, 1.90821492927058770002e-10, r);
    double p = 1.0 / 6227020800.0;
    p = p * r + 1.0 / 479001600.0; p = p * r + 1.0 / 39916800.0; p = p * r + 1.0 / 3628800.0; p = p * r + 1.0 / 362880.0; p = p * r + 1.0 / 40320.0; p = p * r + 1.0 / 5040.0;
    p = p * r + 1.0 / 720.0; p = p * r + 1.0 / 120.0; p = p * r + 1.0 / 24.0; p = p * r + 1.0 / 6.0; p = p * r + 0.5; p = p * r + 1.0; p = p * r + 1.0;
    const int ki = (int)k;
    return __builtin_ldexp(p, ki);
}
__device__ __forceinline__ float dot4(f32x4 a) { return (a[0] * a[0] + a[1] * a[1]) + (a[2] * a[2] + a[3] * a[3]); }
__device__ __forceinline__ u32x4 pk8(f32x4 a, f32x4 b) { u32x4 w; w.x = cvt_pk_bf16(a[0], a[1]); w.y = cvt_pk_bf16(a[2], a[3]); w.z = cvt_pk_bf16(b[0], b[1]); w.w = cvt_pk_bf16(b[2], b[3]); return w; }
__device__ __forceinline__ f32x4 shx16(f32x4 a) { f32x4 r; r[0] = __shfl_xor(a[0], 16); r[1] = __shfl_xor(a[1], 16); r[2] = __shfl_xor(a[2], 16); r[3] = __shfl_xor(a[3], 16); return r; }
constexpr size_t O_KV1P_ = (size_t)MT * D, O_KV4P_ = O_KV1P_ + (size_t)BP * 128 * 512, O_KV16P_ = O_KV4P_ + (size_t)BP * 512 * 512;
constexpr size_t O_KV1S_ = O_KV16P_ + (size_t)BP * 2048 * 512 + 2 * BP * 1024 + (size_t)BP * 2 * FF2 + (size_t)MM * 2048, O_KV4S_ = O_KV1S_ + (size_t)MS * 512, O_KV16S_ = O_KV4S_ + (size_t)MS * 512;
typedef short s16x4 __attribute__((ext_vector_type(4)));
__device__ __forceinline__ s16x4 lds_tr4(LAS unsigned char* p) { return __builtin_bit_cast(s16x4, __builtin_amdgcn_ds_read_tr16_b64_v4i16((LAS s16x4*)p)); }
__device__ __forceinline__ bf16x8 cat44(s16x4 a, s16x4 b) { return (bf16x8){a[0], a[1], a[2], a[3], b[0], b[1], b[2], b[3]}; }
__device__ __forceinline__ void atomic_addf(float* p, float v) { (void)__hip_atomic_fetch_add(p, v, __ATOMIC_RELAXED, __HIP_MEMORY_SCOPE_AGENT); }

namespace pg8 {
#define PG8_LAS __attribute__((address_space(3)))
typedef unsigned short bf16_t;
typedef short bf16x8 __attribute__((ext_vector_type(8)));
typedef float f32x4 __attribute__((ext_vector_type(4)));
typedef unsigned u32x4 __attribute__((ext_vector_type(4)));
constexpr int BM = 256, BK = 64, HALF = 128, HTB = HALF * BK * 2  , STAGE_BYTES = 8 * HTB, NXCD = 8, WGM = 8;

__host__ __device__ __forceinline__ int lds_byte(int r, int c) { const int st = (r >> 4) * 2 + (c >> 5), rr = r & 15, cc = c & 31, ob = rr * 64 + cc * 2; return st * 1024 + (ob ^ (((ob >> 9) & 1) << 5)); }
__host__ __device__ __forceinline__ void stage_rc(int b, int& R, int& C) { const int st = b / 1024, sb = b % 1024, swz = sb ^ (((sb >> 9) & 1) << 5); R = (st >> 1) * 16 + swz / 64; C = (st & 1) * 32 + (swz % 64) / 2; }
__host__ __device__ __forceinline__ int perm32(int rho) { const int n = rho >> 4, i = rho & 15; return 8 * (i >> 2) + 4 * n + (i & 3); }

struct Unit { int pm, pn; };
struct Gemm { const bf16_t* A; const bf16_t* Bt; int M, N, K; };

struct StaticOrder {
    int nM, nN, nwg, G, c;
    __host__ __device__ void init(int M, int N, int G_, int c_) { nM = M / BM; nN = N / BM; nwg = nM * nN; G = G_; c = c_; }
    __host__ __device__ bool next(int i, Unit& u) const {
        const long L = (long)i * G + c; if (L >= nwg) return false;
        int wgid = (int)L; { const int q = nwg / NXCD, r = nwg % NXCD, xcd = wgid % NXCD, off = wgid / NXCD; wgid = (xcd < r ? xcd * (q + 1) : r * (q + 1) + (xcd - r) * q) + off; }
        const int nig = WGM * nN, gid = wgid / nig, fm = gid * WGM, gsz = (nM - fm) < WGM ? (nM - fm) : WGM;
        u.pm = fm + ((wgid % nig) % gsz); u.pn = (wgid % nig) / gsz; return true;
    }
    __device__ __forceinline__ void a_ready(const Unit&) const {}
    __device__ __forceinline__ void done(const Unit&) const {}
};


struct RotOrder {
    int nM, nN, nwg, G, c;
    __host__ __device__ void init(int M, int N, int G_, int blk, int base) { nM = M / BM; nN = N / BM; nwg = nM * nN; G = G_; const int rot = base % G_; c = blk - rot; if (c < 0) c += G_; }
    __host__ __device__ __forceinline__ bool next(int i, Unit& u) const {
        const long L = (long)i * G + c; if (L >= nwg) return false;
        int wgid = (int)L; { const int q = nwg / NXCD, r = nwg % NXCD, xcd = wgid % NXCD, off = wgid / NXCD; wgid = (xcd < r ? xcd * (q + 1) : r * (q + 1) + (xcd - r) * q) + off; }
        const int nig = WGM * nN, gid = wgid / nig, fm = gid * WGM, gsz = (nM - fm) < WGM ? (nM - fm) : WGM;
        u.pm = fm + ((wgid % nig) % gsz); u.pn = (wgid % nig) / gsz; return true;
    }
    __device__ __forceinline__ void a_ready(const Unit&) const {}
    __device__ __forceinline__ void done(const Unit&) const {}
};


struct EpiZ {
    static constexpr bool PERM = true, AFTER_DRAIN = false, BMAP = false, AMAP = false;
    bf16_t* Q; bf16_t* Kb; bf16_t* VN; float* U; const float* rope; const float* qg; const float* kg;
    float* outp;
    __device__ __forceinline__ int bmap(int r) const { return r; }
    __device__ __forceinline__ void operator()(const f32x4 (&acc)[2][2][4][2], const Unit& u, int wr, int wc, int fr, int fq) const {
        const int pn = u.pn; const bool sample = u.pm >= 64;
        const int rbase = u.pm * BM + wr * 64 + fr;
        if (pn == 9) {
#pragma unroll
            for (int ai = 0; ai < 2; ++ai)
#pragma unroll
                for (int m = 0; m < 4; ++m) { const int R = rbase + ai * HALF + m * 16; float* p = U + (size_t)R * 256 + wc * 64 + 8 * fq;
#pragma unroll
                    for (int bj = 0; bj < 2; ++bj) { *(f32x4*)(p + 32 * bj) = acc[ai][bj][m][0]; *(f32x4*)(p + 32 * bj + 4) = acc[ai][bj][m][1]; } }
            return;
        }
        const int kind = pn / 3, g = pn - 3 * kind;
        const int keep = g == 0 ? 128 : (g == 1 ? 512 : 2048);
        float* kvp = outp + (g == 0 ? O_KV1P_ : (g == 1 ? O_KV4P_ : O_KV16P_)); float* kvs = outp + (g == 0 ? O_KV1S_ : (g == 1 ? O_KV4S_ : O_KV16S_));
        if (kind == 2) {
#pragma unroll
            for (int ai = 0; ai < 2; ++ai)
#pragma unroll
                for (int m = 0; m < 4; ++m) { const int R = rbase + ai * HALF + m * 16; float* dst = nullptr;
                    if (sample) dst = kvs + ((size_t)(R - MP) * 2 + 1) * 256;
                    else { const int b = R >> 11, t = R & 2047; if (t >= 2048 - keep) dst = kvp + ((size_t)(b * keep + t - (2048 - keep)) * 2 + 1) * 256; }
                    if (dst) { dst += wc * 64 + 8 * fq;
#pragma unroll
                        for (int bj = 0; bj < 2; ++bj) { *(f32x4*)(dst + 32 * bj) = acc[ai][bj][m][0]; *(f32x4*)(dst + 32 * bj + 4) = acc[ai][bj][m][1]; } }
                    if (!sample) { bf16_t* vp = VN + (size_t)R * AW + g * 256 + wc * 64 + 8 * fq;
                        *(u32x4*)vp = pk8(acc[ai][0][m][0], acc[ai][0][m][1]); *(u32x4*)(vp + 32) = pk8(acc[ai][1][m][0], acc[ai][1][m][1]); } }
            return;
        }
        const float* gp = (kind == 0 ? qg : kg) + 8 * fq;
        const f32x4 g00 = *(const f32x4*)(gp), g01 = *(const f32x4*)(gp + 4), g10 = *(const f32x4*)(gp + 32), g11 = *(const f32x4*)(gp + 36);
        const float sgn = fq == 0 ? -1.f : 1.f;
        const float qs = kind == 0 ? 0.125f * LOG2E : 1.f;
        bf16_t* ob = kind == 0 ? Q : Kb;
        f32x4 rc0, rc1, rs0, rs1;
        { const int R = rbase; const int pos = sample ? 2048 + (R & 3) : (R & 2047); const float* rp = rope + (size_t)pos * 16; rc0 = *(const f32x4*)rp; rc1 = *(const f32x4*)(rp + 4); rs0 = *(const f32x4*)(rp + 8); rs1 = *(const f32x4*)(rp + 12); }
#pragma unroll
        for (int ai = 0; ai < 2; ++ai)
#pragma unroll
            for (int m = 0; m < 4; ++m) { const int R = rbase + ai * HALF + m * 16;
                const f32x4 c0 = rc0, c1 = rc1, s0 = rs0, s1 = rs1;
                if (ai * 4 + m < 7) { const int Rn = rbase + ((ai * 4 + m + 1) >> 2) * HALF + ((ai * 4 + m + 1) & 3) * 16; const int pos = sample ? 2048 + (Rn & 3) : (Rn & 2047); const float* rp = rope + (size_t)pos * 16;
                    rc0 = *(const f32x4*)rp; rc1 = *(const f32x4*)(rp + 4); rs0 = *(const f32x4*)(rp + 8); rs1 = *(const f32x4*)(rp + 12); }
                float ss = (dot4(acc[ai][0][m][0]) + dot4(acc[ai][0][m][1])) + (dot4(acc[ai][1][m][0]) + dot4(acc[ai][1][m][1])); ss += __shfl_xor(ss, 16); ss += __shfl_xor(ss, 32);
                const float rs = frsq(ss * (1.0f / 64.0f) + EPS);
                float* dst = nullptr;
                if (kind == 1) { if (sample) dst = kvs + ((size_t)(R - MP) * 2) * 256; else { const int b = R >> 11, t = R & 2047; if (t >= 2048 - keep) dst = kvp + ((size_t)(b * keep + t - (2048 - keep)) * 2) * 256; }
                    if (dst) dst += wc * 64 + 8 * fq; }
                bf16_t* op = ob + (size_t)R * AW + g * 256 + wc * 64 + 8 * fq;
                f32x4 xa = acc[ai][0][m][0] * rs * g00, xb = acc[ai][0][m][1] * rs * g01;
                { const f32x4 oa = shx16(xa), ob2 = shx16(xb);
                  if (fq < 2) { xa = xa * c0 + (oa * s0) * sgn; xb = xb * c1 + (ob2 * s1) * sgn; } }
                if (dst) { *(f32x4*)(dst) = xa; *(f32x4*)(dst + 4) = xb; }
                *(u32x4*)(op) = pk8(xa * qs, xb * qs);
                xa = acc[ai][1][m][0] * rs * g10; xb = acc[ai][1][m][1] * rs * g11;
                if (dst) { *(f32x4*)(dst + 32) = xa; *(f32x4*)(dst + 36) = xb; }
                *(u32x4*)(op + 32) = pk8(xa * qs, xb * qs);
            }
    }
};

struct EpiVt {
    static constexpr bool PERM = true, AFTER_DRAIN = false, BMAP = true, AMAP = false;
    bf16_t* VT; int g;
    __device__ __forceinline__ int bmap(int r) const { return g == 0 ? r : (g == 1 ? ((r & 63) * 4 + (r >> 6)) : ((r & 15) * 16 + (r >> 4))); }
    __device__ __forceinline__ void operator()(const f32x4 (&acc)[2][2][4][2], const Unit& u, int wr, int wc, int fr, int fq) const {
        const int b = u.pn >> 3, t0 = (u.pn & 7) * 256, sh = 2 * g, S = 2048 >> sh, Wl = 8 - sh;
#pragma unroll
        for (int ai = 0; ai < 2; ++ai)
#pragma unroll
            for (int m = 0; m < 4; ++m) { const int hh = 2 * wr + (m >> 1), d = 32 * ai + 16 * (m & 1) + fr;
#pragma unroll
                for (int bj = 0; bj < 2; ++bj) { const int c8 = 128 * bj + 32 * wc + 8 * fq, res = c8 >> Wl, ds = c8 & ((1 << Wl) - 1), pos = res * S + (t0 >> sh) + ds;
                    bf16_t* p = VT + ((((size_t)((g * 4 + hh) * 8 + b) * 64 + (pos >> 5)) * 64 + d) * 32 + (pos & 31));
                    *(u32x4*)p = pk8(acc[ai][bj][m][0], acc[ai][bj][m][1]); } }
    }
};

struct EpiMem {
    static constexpr bool PERM = true, AFTER_DRAIN = false, BMAP = false, AMAP = false;
    float* out; float* mss; bf16_t* MVN;
    __device__ __forceinline__ int bmap(int r) const { return r; }
    __device__ __forceinline__ void operator()(const f32x4 (&acc)[2][2][4][2], const Unit& u, int wr, int wc, int fr, int fq) const {
        const int kv = u.pn >> 2, h = u.pn & 3;
#pragma unroll
        for (int ai = 0; ai < 2; ++ai)
#pragma unroll
            for (int m = 0; m < 4; ++m) { const int R = u.pm * BM + ai * HALF + wr * 64 + m * 16 + fr; float* dst = out + ((size_t)R * 2 + kv) * 1024 + h * 256 + 32 * wc + 8 * fq; float ss = 0.f;
#pragma unroll
                for (int bj = 0; bj < 2; ++bj) { const f32x4 a = acc[ai][bj][m][0], c = acc[ai][bj][m][1]; *(f32x4*)(dst + 128 * bj) = a; *(f32x4*)(dst + 128 * bj + 4) = c; ss += dot4(a) + dot4(c);
                    if (kv) *(u32x4*)(MVN + (size_t)R * 1024 + h * 256 + 32 * wc + 8 * fq + 128 * bj) = pk8(a, c); }
                if (kv == 0) { ss += __shfl_xor(ss, 16); ss += __shfl_xor(ss, 32); if (fq == 0) mss[(size_t)R * 16 + h * 4 + wc] = ss; } }
    }
};
struct EpiMemVt {
    static constexpr bool PERM = true, AFTER_DRAIN = false, BMAP = false, AMAP = false;
    bf16_t* MVT;
    __device__ __forceinline__ int bmap(int r) const { return r; }
    __device__ __forceinline__ void operator()(const f32x4 (&acc)[2][2][4][2], const Unit& u, int wr, int wc, int fr, int fq) const {
        const int h = u.pm, b = u.pn;
#pragma unroll
        for (int ai = 0; ai < 2; ++ai)
#pragma unroll
            for (int m = 0; m < 4; ++m) { const int d = ai * HALF + wr * 64 + m * 16 + fr;
#pragma unroll
                for (int bj = 0; bj < 2; ++bj) { const int c8 = 128 * bj + 32 * wc + 8 * fq;
                    bf16_t* p = MVT + ((((size_t)(h * 8 + b) * 8 + (c8 >> 5)) * 256 + d) * 32 + (c8 & 31));
                    *(u32x4*)p = pk8(acc[ai][bj][m][0], acc[ai][bj][m][1]); } }
    }
};
template <bool BASE_BF16, bool OUT_F32> struct EpiRes {
    static constexpr bool PERM = true, AFTER_DRAIN = false, BMAP = false, AMAP = false;
    const void* base; float* out; bf16_t* hb; float* ssq;
    __device__ __forceinline__ int bmap(int r) const { return r; }
    __device__ __forceinline__ void operator()(const f32x4 (&acc)[2][2][4][2], const Unit& u, int wr, int wc, int fr, int fq) const {
        const int c0 = u.pn * BM + 32 * wc + 8 * fq;
#pragma unroll
        for (int ai = 0; ai < 2; ++ai) {
            f32x4 b0[4][2], b1[4][2];
#pragma unroll
            for (int m = 0; m < 4; ++m)
#pragma unroll
                for (int bj = 0; bj < 2; ++bj) { const size_t off = (size_t)(u.pm * BM + ai * HALF + wr * 64 + m * 16 + fr) * D + c0 + 128 * bj;
                    if (BASE_BF16) { const u32x4 w = *(const u32x4*)((const bf16_t*)base + off); b0[m][bj] = (f32x4){bf2f(w.x & 0xffffu), bf2f(w.x >> 16), bf2f(w.y & 0xffffu), bf2f(w.y >> 16)}; b1[m][bj] = (f32x4){bf2f(w.z & 0xffffu), bf2f(w.z >> 16), bf2f(w.w & 0xffffu), bf2f(w.w >> 16)}; }
                    else { b0[m][bj] = *(const f32x4*)((const float*)base + off); b1[m][bj] = *(const f32x4*)((const float*)base + off + 4); } }
            asm volatile("" ::: "memory");
#pragma unroll
            for (int m = 0; m < 4; ++m) { const int R = u.pm * BM + ai * HALF + wr * 64 + m * 16 + fr; float ss = 0.f;
#pragma unroll
                for (int bj = 0; bj < 2; ++bj) { const size_t off = (size_t)R * D + c0 + 128 * bj;
                    const f32x4 o0 = b0[m][bj] + acc[ai][bj][m][0], o1 = b1[m][bj] + acc[ai][bj][m][1];
                    if (OUT_F32) { *(f32x4*)(out + off) = o0; *(f32x4*)(out + off + 4) = o1; }
                    if (hb) *(u32x4*)(hb + off) = pk8(o0, o1);
                    ss += dot4(o0) + dot4(o1); }
                if (ssq) { ss += __shfl_xor(ss, 16); ss += __shfl_xor(ss, 32); if (fq == 0) atomic_addf(ssq + R, ss); } }
        }
    }
};
struct EpiQx {
    static constexpr bool PERM = true, AFTER_DRAIN = false, BMAP = false, AMAP = false;
    bf16_t* QX; float* qss;
    __device__ __forceinline__ int bmap(int r) const { return r; }
    __device__ __forceinline__ void operator()(const f32x4 (&acc)[2][2][4][2], const Unit& u, int wr, int wc, int fr, int fq) const {
        const int c0 = u.pn * BM + 32 * wc + 8 * fq;
#pragma unroll
        for (int ai = 0; ai < 2; ++ai)
#pragma unroll
            for (int m = 0; m < 4; ++m) { const int R = u.pm * BM + ai * HALF + wr * 64 + m * 16 + fr; float ss = 0.f;
#pragma unroll
                for (int bj = 0; bj < 2; ++bj) { const f32x4 a = acc[ai][bj][m][0], c = acc[ai][bj][m][1]; *(u32x4*)(QX + (size_t)R * D + c0 + 128 * bj) = pk8(a, c); ss += dot4(a) + dot4(c); }
                ss += __shfl_xor(ss, 16); ss += __shfl_xor(ss, 32); if (fq == 0) atomic_addf(qss + (size_t)R * 4 + u.pn, ss); }
    }
};
template <int CTRL> __device__ __forceinline__ float dppf(float old, float src) { return __builtin_bit_cast(float, __builtin_amdgcn_update_dpp(__builtin_bit_cast(int, old), __builtin_bit_cast(int, src), CTRL, 0xf, 0xf, false)); }
__device__ __forceinline__ f32x4 prev_rows1(f32x4 pg, f32x4 cur) { f32x4 r;
#pragma unroll
    for (int e = 0; e < 4; ++e) r[e] = dppf<0x111>(dppf<0x121>(0.f, pg[e]), cur[e]);
    return r; }
__device__ __forceinline__ f32x4 prev_rows2(f32x4 pg, f32x4 cur) { f32x4 r;
#pragma unroll
    for (int e = 0; e < 4; ++e) r[e] = dppf<0x112>(dppf<0x122>(0.f, pg[e]), cur[e]);
    return r; }
__device__ __forceinline__ float silu_(float x) { return x * frcp(1.0f + fexp2(-x * LOG2E)); }
constexpr int HALO_OFF = 135680;
struct EpiUpConv {
    static constexpr bool PERM = true, AFTER_DRAIN = false, BMAP = false, AMAP = true;
    bf16_t* ACT; float* EDGE; const float* rs2; const float* cw; const float* cb; const float* sconv; float* convp; float* convs; PG8_LAS unsigned char* lds;
    __device__ __forceinline__ int bmap(int r) const { return r; }
    __device__ __forceinline__ int amap(int r) const { return (r & 64) + 4 * (r & 15) + ((r >> 4) & 3); }
    __device__ __forceinline__ void operator()(f32x4 (&acc)[2][2][4][2], const Unit& u, int wr, int wc, int fr, int fq) const {
        const bool smp = u.pm >= 64;
        const int j8 = u.pn * 128 + 32 * wc + 8 * fq;
        f32x4 cwv[8];
#define UPC_LOADW(n_) do { const int j4_ = j8 + 4 * (n_); cwv[0] = *(const f32x4*)(cw + j4_); cwv[1] = *(const f32x4*)(cw + FF2 + j4_); cwv[2] = *(const f32x4*)(cw + 2 * FF2 + j4_); cwv[3] = *(const f32x4*)(cb + j4_); \
        cwv[4] = *(const f32x4*)(cw + FF + j4_); cwv[5] = *(const f32x4*)(cw + FF2 + FF + j4_); cwv[6] = *(const f32x4*)(cw + 2 * FF2 + FF + j4_); cwv[7] = *(const f32x4*)(cb + FF + j4_); } while (0)
        UPC_LOADW(0);
        const int tok0 = u.pm * BM + wr * 64 + 4 * fr;
        { float tot[2][4];
#pragma unroll
          for (int ai = 0; ai < 2; ++ai)
#pragma unroll
              for (int m = 0; m < 4; ++m) tot[ai][m] = rs2[tok0 + ai * HALF + m];
#pragma unroll
          for (int ai = 0; ai < 2; ++ai)
#pragma unroll
              for (int m = 0; m < 4; ++m) { const float rstd = frsq(tot[ai][m] * (1.0f / 1024.0f) + EPS);
#pragma unroll
                  for (int bj = 0; bj < 2; ++bj) { acc[ai][bj][m][0] = acc[ai][bj][m][0] * rstd; acc[ai][bj][m][1] = acc[ai][bj][m][1] * rstd; } } }
        PG8_LAS float* halo = (PG8_LAS float*)(lds + HALO_OFF);
        if (!smp && fr == 15) {
#pragma unroll
            for (int ai = 0; ai < 2; ++ai)
#pragma unroll
                for (int mm = 2; mm < 4; ++mm) { PG8_LAS float* hp = halo + ((((2 * ai + wr + 1) * 2 + (mm - 2)) * 4 + wc) * 4 + fq) * 16;
                    *(PG8_LAS f32x4*)(hp) = acc[ai][0][mm][0]; *(PG8_LAS f32x4*)(hp + 4) = acc[ai][0][mm][1]; *(PG8_LAS f32x4*)(hp + 8) = acc[ai][1][mm][0]; *(PG8_LAS f32x4*)(hp + 12) = acc[ai][1][mm][1]; }
        }
        asm volatile("s_waitcnt lgkmcnt(0)\n\ts_barrier" ::: "memory");
#pragma unroll
        for (int n = 0; n < 2; ++n) {
            const int j4 = j8 + 4 * n;
            if (n == 1) UPC_LOADW(1);
            const f32x4 wg0 = cwv[0], wg1 = cwv[1], wg2 = cwv[2], bgv = cwv[3], wv0 = cwv[4], wv1 = cwv[5], wv2 = cwv[6], bvv = cwv[7];
#pragma unroll
            for (int ai = 0; ai < 2; ++ai) {
                const int blk = 2 * ai + wr, tokb = tok0 + ai * HALF;
                f32x4 gm1, gm2, vm1, vm2;
                if (smp) { const float* sb = sconv + (size_t)((tokb - MP) >> 2) * 2 * FF2;
                    gm2 = *(const f32x4*)(sb + j4); vm2 = *(const f32x4*)(sb + FF + j4); gm1 = *(const f32x4*)(sb + FF2 + j4); vm1 = *(const f32x4*)(sb + FF2 + FF + j4); }
                else { f32x4 h2g = {0.f, 0.f, 0.f, 0.f}, h3g = h2g, h2v = h2g, h3v = h2g;
                    if (blk > 0 && fr == 0) { const PG8_LAS float* hp = halo + (((blk * 2) * 4 + wc) * 4 + fq) * 16; h2g = *(const PG8_LAS f32x4*)(hp + 4 * n); h2v = *(const PG8_LAS f32x4*)(hp + 8 + 4 * n);
                        h3g = *(const PG8_LAS f32x4*)(hp + 256 + 4 * n); h3v = *(const PG8_LAS f32x4*)(hp + 256 + 8 + 4 * n); }
#pragma unroll
                    for (int e = 0; e < 4; ++e) { gm1[e] = dppf<0x111>(h3g[e], acc[ai][0][3][n][e]); gm2[e] = dppf<0x111>(h2g[e], acc[ai][0][2][n][e]); vm1[e] = dppf<0x111>(h3v[e], acc[ai][1][3][n][e]); vm2[e] = dppf<0x111>(h2v[e], acc[ai][1][2][n][e]); } }
#pragma unroll
                for (int m = 0; m < 4; ++m) { const int R = tokb + m;
                    const f32x4 g = acc[ai][0][m][n], v = acc[ai][1][m][n];
                    const f32x4 g1 = m == 0 ? gm1 : acc[ai][0][m > 0 ? m - 1 : 0][n], v1 = m == 0 ? vm1 : acc[ai][1][m > 0 ? m - 1 : 0][n];
                    const f32x4 g2 = m == 0 ? gm2 : (m == 1 ? gm1 : acc[ai][0][m > 1 ? m - 2 : 0][n]), v2 = m == 0 ? vm2 : (m == 1 ? vm1 : acc[ai][1][m > 1 ? m - 2 : 0][n]);
                    if (smp) { if (m >= 2) { float* cd = convs + ((size_t)((R - MP) >> 2) * 2 + (m - 2)) * FF2; *(f32x4*)(cd + j4) = g; *(f32x4*)(cd + FF + j4) = v; } }
                    else if ((ai == 0 && m < 2) || (ai == 1 && m >= 2)) {
                        const int t = R & 2047;
                        if (t >= 2046) { float* cd = convp + ((size_t)(R >> 11) * 2 + (t - 2046)) * FF2; *(f32x4*)(cd + j4) = g; *(f32x4*)(cd + FF + j4) = v; }
                        const int rt = R & 255;
                        if (rt < 2 || rt >= 254) { float* ed = EDGE + ((size_t)u.pm * 4 + (rt < 2 ? rt : rt - 252)) * FF2; *(f32x4*)(ed + j4) = g; *(f32x4*)(ed + FF + j4) = v; }
                    }
                    const f32x4 cg = bgv + wg0 * g2 + wg1 * g1 + wg2 * g, cv = bvv + wv0 * v2 + wv1 * v1 + wv2 * v;
                    u32x2 w; w.x = cvt_pk_bf16(silu_(cg[0]) * cv[0], silu_(cg[1]) * cv[1]); w.y = cvt_pk_bf16(silu_(cg[2]) * cv[2], silu_(cg[3]) * cv[3]);
                    *(u32x2*)(ACT + (size_t)R * FF + j4) = w;
                }
            }
        }
    }
};
#undef UPC_LOADW

template <class Epi, class Sched, bool ALIGN_EPI = false, bool SP2 = false>
__device__ __forceinline__ void gemm_phase(PG8_LAS unsigned char* lds, const Gemm g, const Sched& S, const Epi& E) {
    int tid_ = threadIdx.x; asm volatile("" : "+v"(tid_));
    const int tid = tid_, wid = __builtin_amdgcn_readfirstlane(tid >> 6), lane = tid & 63, wr = wid >> 2, wc = wid & 3, fr = lane & 15, fq = lane >> 4;
    const int K = g.K, nt = K / BK;
    unsigned voffA[2], voffB[2], voffB1[2];
#pragma unroll
    for (int i = 0; i < 2; ++i) { int R, C; stage_rc(tid * 16 + i * 8192, R, C); const int Rb = Epi::PERM ? ((R & ~31) + perm32(R & 31)) : R;
        int Ra = R; if constexpr (Epi::AMAP) Ra = E.amap(R); voffA[i] = (unsigned)(Ra * K + C) * 2u;     voffB[i] = (unsigned)(E.bmap(Rb) * K + C) * 2u; if constexpr (Epi::BMAP) voffB1[i] = (unsigned)(E.bmap(HALF + Rb) * K + C) * 2u; else voffB1[i] = 0u; }
    const size_t kstep = (size_t)(BK * 2);
    const size_t hstep = (size_t)HALF * K * 2;
    const unsigned* vB1 = Epi::BMAP ? voffB1 : voffB; const size_t h1step = Epi::BMAP ? (size_t)0 : hstep;
    const size_t tstep = 2 * hstep;
    const unsigned ldsw = (unsigned)wid * 1024u;
    const int aoff = lds_byte(wr * 64 + fr, fq * 8), boff = lds_byte(wc * 32 + fr, fq * 8);
#define PG8_SA(b, h) (((b) * 2 + (h)) * HTB)
#define PG8_SB(b, h) ((4 + (b) * 2 + (h)) * HTB)
#define PG8_STAGE(bufoff, gbase, voff) do { _Pragma("unroll") for (int _i = 0; _i < 2; ++_i) \
        __builtin_amdgcn_global_load_lds((const unsigned*)((const char*)(gbase) + (voff)[_i]), (PG8_LAS unsigned*)(lds + (bufoff) + ldsw + _i * 8192), 16, 0, 0); } while (0)
#define PG8_LDA(dst, b, h) do { _Pragma("unroll") for (int m = 0; m < 4; ++m) _Pragma("unroll") for (int k = 0; k < 2; ++k) dst[m][k] = *(const PG8_LAS bf16x8*)(lds + PG8_SA(b, h) + aoff + m * 2048 + k * 1024); } while (0)
#define PG8_LDB(dst, b, h) do { _Pragma("unroll") for (int n = 0; n < 2; ++n) _Pragma("unroll") for (int k = 0; k < 2; ++k) dst[n][k] = *(const PG8_LAS bf16x8*)(lds + PG8_SB(b, h) + boff + n * 2048 + k * 1024); } while (0)
#define PG8_MMA(ai, bj, At, Bt) do { __builtin_amdgcn_s_setprio(1); _Pragma("unroll") for (int m = 0; m < 4; ++m) _Pragma("unroll") for (int n = 0; n < 2; ++n) _Pragma("unroll") for (int k = 0; k < 2; ++k) \
        acc[ai][bj][m][n] = __builtin_amdgcn_mfma_f32_16x16x32_bf16(Bt[n][k], At[m][k], acc[ai][bj][m][n], 0, 0, 0); __builtin_amdgcn_s_setprio(0); } while (0)
#define PG8_WAIT_V(n) asm volatile("s_waitcnt vmcnt(" #n ")" ::: "memory")
#define PG8_WAIT_L(n) asm volatile("s_waitcnt lgkmcnt(" #n ")" ::: "memory")
#define PG8_BAR __builtin_amdgcn_s_barrier()
#define PG8_SCHED __builtin_amdgcn_sched_barrier(0)
    Unit cur, nxt; int ui = 0;
    if (!S.next(0, cur)) return;
    f32x4 acc[2][2][4][2];
#pragma unroll
    for (int a = 0; a < 2; ++a)
#pragma unroll
        for (int b = 0; b < 2; ++b)
#pragma unroll
            for (int m = 0; m < 4; ++m)
#pragma unroll
                for (int n = 0; n < 2; ++n) acc[a][b][m][n] = (f32x4){0.f, 0.f, 0.f, 0.f};
    bf16x8 At[4][2], B0[2][2], B1[2][2];
    const char* cA = (const char*)g.A + (size_t)cur.pm * tstep; const char* cB = (const char*)g.Bt + (size_t)cur.pn * tstep;
    S.a_ready(cur);
    if constexpr (SP2) {
        PG8_STAGE(PG8_SB(0, 0), cB, voffB); PG8_STAGE(PG8_SB(0, 1), cB + h1step, vB1); PG8_STAGE(PG8_SA(0, 0), cA, voffA); PG8_STAGE(PG8_SA(0, 1), cA + hstep, voffA);
        if (wr == 1) PG8_BAR;
        PG8_WAIT_V(2); PG8_BAR;
        PG8_STAGE(PG8_SB(1, 0), cB + kstep, voffB); PG8_STAGE(PG8_SA(1, 0), cA + kstep, voffA); PG8_STAGE(PG8_SB(1, 1), cB + h1step + kstep, vB1);
        PG8_WAIT_V(6); PG8_BAR;
    } else {
        PG8_STAGE(PG8_SB(0, 0), cB, voffB); PG8_STAGE(PG8_SA(0, 0), cA, voffA); PG8_STAGE(PG8_SB(0, 1), cB + h1step, vB1); PG8_STAGE(PG8_SA(0, 1), cA + hstep, voffA);
        if (wr == 1) PG8_BAR;
        PG8_WAIT_V(4); PG8_BAR;
        PG8_STAGE(PG8_SB(1, 0), cB + kstep, voffB); PG8_STAGE(PG8_SA(1, 0), cA + kstep, voffA); PG8_STAGE(PG8_SB(1, 1), cB + h1step + kstep, vB1);
        PG8_WAIT_V(6); PG8_BAR;
    }
    for (;;) {
        const bool has_next = S.next(ui + 1, nxt);
        const char* nA = has_next ? (const char*)g.A + (size_t)nxt.pm * tstep : cA; const char* nB = has_next ? (const char*)g.Bt + (size_t)nxt.pn * tstep : cB;
        for (int t = 0; t < nt; t += 2) {
            const bool last = (t == nt - 2);
            const char* a1 = cA + (size_t)(t + 1) * kstep;
            const char* a2 = last ? nA : cA + (size_t)(t + 2) * kstep; const char* b2 = last ? nB : cB + (size_t)(t + 2) * kstep;
            const char* a3 = a2 + kstep; const char* b3 = b2 + kstep;
            if (last && has_next) S.a_ready(nxt);
            if constexpr (SP2) {
            PG8_LDB(B0, 0, 0); PG8_LDB(B1, 0, 1); PG8_SCHED; PG8_LDA(At, 0, 0); PG8_STAGE(PG8_SA(1, 1), a1 + hstep, voffA);
            PG8_WAIT_V(8); PG8_WAIT_L(0); PG8_BAR; PG8_MMA(0, 0, At, B0); PG8_MMA(0, 1, At, B1); PG8_BAR; PG8_SCHED;
            PG8_LDA(At, 0, 1); PG8_STAGE(PG8_SB(0, 0), b2, voffB); PG8_STAGE(PG8_SB(0, 1), b2 + h1step, vB1); PG8_STAGE(PG8_SA(0, 0), a2, voffA);
            PG8_WAIT_V(8); PG8_WAIT_L(0); PG8_BAR; PG8_MMA(1, 0, At, B0); PG8_MMA(1, 1, At, B1); PG8_BAR; PG8_SCHED;
            PG8_LDB(B0, 1, 0); PG8_LDB(B1, 1, 1); PG8_SCHED; PG8_LDA(At, 1, 0); PG8_STAGE(PG8_SA(0, 1), a2 + hstep, voffA);
            PG8_WAIT_V(8); PG8_WAIT_L(0); PG8_BAR; PG8_MMA(0, 0, At, B0); PG8_MMA(0, 1, At, B1); PG8_BAR; PG8_SCHED;
            PG8_LDA(At, 1, 1); PG8_STAGE(PG8_SB(1, 0), b3, voffB); PG8_STAGE(PG8_SB(1, 1), b3 + h1step, vB1); PG8_STAGE(PG8_SA(1, 0), a3, voffA);
            PG8_WAIT_V(8); PG8_WAIT_L(0); PG8_BAR; PG8_MMA(1, 0, At, B0); PG8_MMA(1, 1, At, B1); PG8_BAR; PG8_SCHED;
            } else {
            PG8_LDB(B0, 0, 0); PG8_SCHED; PG8_LDA(At, 0, 0); PG8_STAGE(PG8_SA(1, 1), a1 + hstep, voffA);
            PG8_WAIT_L(8); PG8_BAR; PG8_WAIT_L(0); PG8_MMA(0, 0, At, B0); PG8_BAR; PG8_SCHED;
            PG8_LDB(B1, 0, 1); PG8_STAGE(PG8_SB(0, 0), b2, voffB);
            PG8_BAR; PG8_WAIT_L(0); PG8_MMA(0, 1, At, B1); PG8_BAR;
            PG8_LDA(At, 0, 1); PG8_STAGE(PG8_SA(0, 0), a2, voffA);
            PG8_BAR; PG8_WAIT_L(0); PG8_MMA(1, 0, At, B0); PG8_BAR; PG8_SCHED;
            PG8_STAGE(PG8_SB(0, 1), b2 + h1step, vB1);
            PG8_WAIT_V(6); PG8_BAR; PG8_MMA(1, 1, At, B1); PG8_BAR;
            PG8_LDB(B0, 1, 0); PG8_SCHED; PG8_LDA(At, 1, 0); PG8_STAGE(PG8_SA(0, 1), a2 + hstep, voffA);
            PG8_WAIT_L(8); PG8_BAR; PG8_WAIT_L(0); PG8_MMA(0, 0, At, B0); PG8_BAR; PG8_SCHED;
            PG8_LDB(B1, 1, 1); PG8_STAGE(PG8_SB(1, 0), b3, voffB);
            PG8_BAR; PG8_WAIT_L(0); PG8_MMA(0, 1, At, B1); PG8_BAR;
            PG8_LDA(At, 1, 1); PG8_STAGE(PG8_SA(1, 0), a3, voffA);
            PG8_BAR; PG8_WAIT_L(0); PG8_MMA(1, 0, At, B0); PG8_BAR; PG8_SCHED;
            PG8_STAGE(PG8_SB(1, 1), b3 + h1step, vB1);
            PG8_WAIT_V(6); PG8_BAR; PG8_MMA(1, 1, At, B1); PG8_BAR;
            }
        }
        if constexpr (ALIGN_EPI) { if (wr == 0) PG8_BAR; }
        if constexpr (!Epi::AFTER_DRAIN) { E(acc, cur, wr, wc, fr, fq); S.done(cur); }
        if (!has_next) break;
#pragma unroll
        for (int a = 0; a < 2; ++a)
#pragma unroll
            for (int b = 0; b < 2; ++b)
#pragma unroll
                for (int m = 0; m < 4; ++m)
#pragma unroll
                    for (int n = 0; n < 2; ++n) acc[a][b][m][n] = (f32x4){0.f, 0.f, 0.f, 0.f};
        cur = nxt; cA = nA; cB = nB; ++ui;
        if constexpr (ALIGN_EPI) { if (wr == 1) PG8_BAR; }
    }
    PG8_WAIT_V(0);
    if constexpr (!ALIGN_EPI) { if (wr == 0) PG8_BAR; }
    PG8_BAR;
    if constexpr (Epi::AFTER_DRAIN) { E.fused(acc, cur, wr, wc, fr, fq, lds, wid, lane); S.done(cur); }
#undef PG8_SA
#undef PG8_SB
#undef PG8_STAGE
#undef PG8_LDA
#undef PG8_LDB
#undef PG8_MMA
#undef PG8_WAIT_V
#undef PG8_WAIT_L
#undef PG8_BAR
#undef PG8_SCHED
}
}

#define XB_TMO      128
#define XB_XCNT(j)  (256  + 64 * (j))
#define XB_XSUB(j)  (1280 + 64 * (j))
#define XB_XGEN(j)  (2304 + 64 * (j))
#define XB_TOP      3328
#define XB_TOPGEN   3392
#define XCD_BAR_WORDS 3456
#define XB_SPIN_CAP (1u << 18)

__device__ __forceinline__ unsigned xb_ld(unsigned* p)              { return __hip_atomic_load(p, __ATOMIC_RELAXED, __HIP_MEMORY_SCOPE_AGENT); }
__device__ __forceinline__ unsigned xb_add(unsigned* p, unsigned v) { return __hip_atomic_fetch_add(p, v, __ATOMIC_RELAXED, __HIP_MEMORY_SCOPE_AGENT); }
__device__ __forceinline__ unsigned xb_xcc_id() { return (unsigned)__builtin_amdgcn_s_getreg((3 << 11) | 20) & 0xFu; }
#define XB_SPIN(cond, bar) do { unsigned _sp = 0; while (cond) { __builtin_amdgcn_s_sleep(1); \
    if ((++_sp & 255u) == 0u) { if (xb_ld(&(bar)[XB_TMO])) break; if (_sp > XB_SPIN_CAP) { atomicAdd(&(bar)[XB_TMO], 1u); break; } } } } while (0)

struct XcdBarrier {
    unsigned* bar; unsigned x;
    volatile LAS unsigned* st;
};

__device__ __forceinline__ XcdBarrier xcd_barrier_post(unsigned* bar, volatile LAS unsigned* st) {
    XcdBarrier b; b.bar = bar; b.x = xb_xcc_id(); b.st = st;
    if (threadIdx.x == 0) (void)xb_add(&bar[XB_XCNT(b.x)], 1u);
    return b;
}
__device__ __forceinline__ void xcd_barrier_complete(unsigned* bar, unsigned x, unsigned& nloc, unsigned& nx) {
    const unsigned G = gridDim.x * gridDim.y * gridDim.z;
    unsigned sum, cnt, mine, sp = 0u;
    for (;;) {
        sum = 0u; cnt = 0u; mine = 0u;
#pragma unroll
        for (unsigned j = 0; j < 16; ++j) { const unsigned c = xb_ld(&bar[XB_XCNT(j)]); sum += c; cnt += (c > 0u) ? 1u : 0u; mine = (j == x) ? c : mine; }
        if (sum == G) break;
        __builtin_amdgcn_s_sleep(1);
        if ((++sp & 255u) == 0u) { if (xb_ld(&bar[XB_TMO])) break; if (sp > XB_SPIN_CAP) { atomicAdd(&bar[XB_TMO], 1u); break; } }
    }
    nloc = mine > 0u ? mine : 1u; nx = cnt > 0u ? cnt : 1u;
}

__device__ __forceinline__ void xcd_barrier(const XcdBarrier& b) {
    asm volatile("s_waitcnt vmcnt(0)" ::: "memory");
    __syncthreads();
    if (threadIdx.x == 0) {
        unsigned* bar = b.bar;
        __builtin_amdgcn_s_waitcnt(0);
        unsigned nloc = b.st[0], nx = b.st[1];
        if (nloc == 0u) { xcd_barrier_complete(bar, b.x, nloc, nx); b.st[0] = nloc; b.st[1] = nx; }
        const unsigned old = xb_add(&bar[XB_XSUB(b.x)], 1u);
        const unsigned gen = old / nloc;
        if (old + 1u == (gen + 1u) * nloc) {
            __builtin_amdgcn_fence(__ATOMIC_RELEASE, "agent");
            asm volatile("s_waitcnt vmcnt(0)" ::: "memory");
            const unsigned og = xb_add(&bar[XB_TOP], 1u);
            const unsigned tg = og / nx;
            if (og + 1u == (tg + 1u) * nx) xb_add(&bar[XB_TOPGEN], 1u);
            else XB_SPIN(xb_ld(&bar[XB_TOPGEN]) == tg, bar);
            __builtin_amdgcn_fence(__ATOMIC_ACQUIRE, "agent");
            xb_add(&bar[XB_XGEN(b.x)], 1u);
            asm volatile("s_waitcnt vmcnt(0)" ::: "memory");
        } else {
            XB_SPIN(xb_ld(&bar[XB_XGEN(b.x)]) == gen, bar);
            __builtin_amdgcn_fence(__ATOMIC_ACQUIRE, "agent");
            asm volatile("s_waitcnt vmcnt(0)" ::: "memory");
        }
    }
    __syncthreads();
}

struct Args { const float* in[39]; float* out; unsigned char* ws; int ph_lo, ph_hi, li, pad; };
enum { I_XP = 0, I_XS, I_MEM, I_C1, I_C4, I_C16, I_SRE, I_SIM, I_SCONV, I_CMEM, I_NMIX, I_WIN, I_QN, I_KN, I_LRE, I_LIM, I_LDT, I_BRE, I_BIM, I_CRE, I_CIM, I_SD, I_WGLU, I_BGLU,
       I_AON, I_SON, I_WOUT, I_NX, I_NMEM, I_WXQ, I_WXKV, I_XQN, I_XKN, I_WXO, I_NFFN, I_WUP, I_CONVW, I_CONVB, I_WDOWN };
constexpr size_t O_YP = 0, O_YS = O_YP + (size_t)MP * D, O_KV1P = O_YS + (size_t)MS * D, O_KV4P = O_KV1P + (size_t)BP * 128 * 512, O_KV16P = O_KV4P + (size_t)BP * 512 * 512,
    O_SREP = O_KV16P + (size_t)BP * 2048 * 512, O_SIMP = O_SREP + BP * 1024, O_CONVP = O_SIMP + BP * 1024, O_MEMKV = O_CONVP + (size_t)BP * 2 * FF2, O_KV1S = O_MEMKV + (size_t)MM * 2048,
    O_KV4S = O_KV1S + (size_t)MS * 512, O_KV16S = O_KV4S + (size_t)MS * 512, O_SRES = O_KV16S + (size_t)MS * 512, O_SIMS = O_SRES + BS * 1024, O_CONVS = O_SIMS + BS * 1024, O_END = O_CONVS + (size_t)BS * 2 * FF2;
static_assert(O_END == 35102720 && O_KV1P == O_KV1P_ && O_KV4P == O_KV4P_ && O_KV16P == O_KV16P_ && O_KV1S == O_KV1S_ && O_KV4S == O_KV4S_ && O_KV16S == O_KV16S_, "output map");

template <int MODE> __device__ __forceinline__ int rowmap(int n) {
    if (MODE == 1) return (n & ~255) + 128 * ((n >> 5) & 1) + 32 * ((n >> 6) & 3) + (n & 31);
    if (MODE == 2) { return n < FF ? 256 * (n >> 7) + (n & 127) : 256 * ((n - FF) >> 7) + 128 + ((n - FF) & 127); }
    return n;
}
template <int MODE> __device__ __forceinline__ void p0_transpose_item(const float* W, int K, int N, bf16* WT, const float* gk, LAS float* scr, int item, int lane) {
    const int nblk = N / 32, kb = item / nblk, nb = item % nblk, k0 = 64 * kb, n0 = 32 * nb;
    float wv[32];
#pragma unroll
    for (int i = 0; i < 32; ++i) wv[i] = W[(size_t)(k0 + 2 * i + (lane >> 5)) * N + n0 + (lane & 31)];
    if (gk) {
#pragma unroll
        for (int i = 0; i < 32; ++i) wv[i] *= gk[k0 + 2 * i + (lane >> 5)]; }
#pragma unroll
    for (int i = 0; i < 32; ++i) scr[(2 * i + (lane >> 5)) * 33 + (lane & 31)] = wv[i];
    LDS_WAIT(); asm volatile("" ::: "memory");
    const int c = lane & 7;
#pragma unroll
    for (int j = 0; j < 4; ++j) { const int n = (lane >> 3) + 8 * j; const LAS float* s = scr + (8 * c) * 33 + n;
        u32x4 o; o.x = pk2(s[0 * 33], s[1 * 33]); o.y = pk2(s[2 * 33], s[3 * 33]); o.z = pk2(s[4 * 33], s[5 * 33]); o.w = pk2(s[6 * 33], s[7 * 33]);
        *(GAS u32x4*)(WT + (size_t)rowmap<MODE>(n0 + n) * K + k0 + 8 * c) = o; }
    LDS_WAIT(); asm volatile("" ::: "memory");
}
__device__ __forceinline__ void rms_rows2_to_bf16(const float* xrow0, const float* xrow1, const f32x4 (&gg)[4], bf16* orow0, bf16* orow1, int lane) {
    const f32x4* xr0 = (const f32x4*)xrow0 + lane; const f32x4* xr1 = (const f32x4*)xrow1 + lane;
    f32x4 v0[4], v1[4]; float s0 = 0.f, s1 = 0.f;
#pragma unroll
    for (int j = 0; j < 4; ++j) { v0[j] = xr0[64 * j]; v1[j] = xr1[64 * j]; }
#pragma unroll
    for (int j = 0; j < 4; ++j) { s0 += dot4(v0[j]); s1 += dot4(v1[j]); }
#pragma unroll
    for (int o = 1; o < 64; o <<= 1) { s0 += __shfl_xor(s0, o); s1 += __shfl_xor(s1, o); }
    const float r0 = frsq(s0 * (1.0f / D) + EPS), r1 = frsq(s1 * (1.0f / D) + EPS);
    u32x2* o0 = (u32x2*)orow0 + lane; u32x2* o1 = (u32x2*)orow1 + lane;
#pragma unroll
    for (int j = 0; j < 4; ++j) { const f32x4 a = v0[j] * r0 * gg[j], c = v1[j] * r1 * gg[j];
        u32x2 w; w.x = cvt_pk_bf16(a[0], a[1]); w.y = cvt_pk_bf16(a[2], a[3]); o0[64 * j] = w;
        u32x2 z; z.x = cvt_pk_bf16(c[0], c[1]); z.y = cvt_pk_bf16(c[2], c[3]); o1[64 * j] = z; }
}

__device__ __forceinline__ int pi23(int m) { return (m & ~12) | ((m & 4) << 1) | ((m & 8) >> 1); }
__device__ __forceinline__ void memk_fix_item(float* memkv, const float* mss, const float* xkn, const float* xqn, bf16* MEMK, int Rm, int lane) {
    const f32x4 gk = *(const f32x4*)(xkn + 4 * lane), gq = *(const f32x4*)(xqn + 4 * lane);
    f32x4 v[4], s[4];
#pragma unroll
    for (int h = 0; h < 4; ++h) { v[h] = *(const f32x4*)(memkv + (size_t)Rm * 2048 + h * 256 + 4 * lane); s[h] = *(const f32x4*)(mss + (size_t)Rm * 16 + 4 * h); }
#pragma unroll
    for (int h = 0; h < 4; ++h) {
        const float rs = frsq(((s[h][0] + s[h][1]) + (s[h][2] + s[h][3])) * (1.0f / 256.0f) + EPS);
        const f32x4 kn = v[h] * rs * gk; *(f32x4*)(memkv + (size_t)Rm * 2048 + h * 256 + 4 * lane) = kn; const f32x4 kq = kn * gq;
        u32x2 w; w.x = cvt_pk_bf16(kq[0], kq[1]); w.y = cvt_pk_bf16(kq[2], kq[3]); *(u32x2*)(MEMK + (size_t)Rm * 1024 + h * 256 + 4 * lane) = w;
    }
}
__device__ __forceinline__ void ssm_bfrags(const Args& a, const float* ssmc, int g, int lane, bf16x8 (&bb)[4]) {
    const int n = lane & 31, hi = lane >> 5;
#pragma unroll
    for (int s2 = 0; s2 < 2; ++s2) { const int st = g * 64 + 32 * s2 + n; const f32x4 c0 = *(const f32x4*)(ssmc + (size_t)st * 8); const float cr = c0[2], ci = c0[3];
        const f32x4 r0 = *(const f32x4*)(a.in[I_BRE] + (size_t)st * 16 + 8 * hi), r1 = *(const f32x4*)(a.in[I_BRE] + (size_t)st * 16 + 8 * hi + 4);
        const f32x4 i0 = *(const f32x4*)(a.in[I_BIM] + (size_t)st * 16 + 8 * hi), i1 = *(const f32x4*)(a.in[I_BIM] + (size_t)st * 16 + 8 * hi + 4);
        const f32x4 pr0 = r0 * cr - i0 * ci, pr1 = r1 * cr - i1 * ci, pi0 = i0 * cr + r0 * ci, pi1 = i1 * cr + r1 * ci;
        bb[s2] = pack8(pr0[0], pr0[1], pr0[2], pr0[3], pr1[0], pr1[1], pr1[2], pr1[3]); bb[2 + s2] = pack8(pi0[0], pi0[1], pi0[2], pi0[3], pi1[0], pi1[1], pi1[2], pi1[3]); }
}
__device__ __forceinline__ bf16x8 ssm_loadu(const float* U, int row0, int nrows, int g, int lane) {
    const int m = lane & 31, hi = lane >> 5; const int row = row0 + (m < nrows ? m : (m & (nrows - 1)));
    const f32x4 u0 = *(const f32x4*)(U + (size_t)row * 256 + g * 16 + 8 * hi), u1 = *(const f32x4*)(U + (size_t)row * 256 + g * 16 + 8 * hi + 4);
    return pack8(u0[0], u0[1], u0[2], u0[3], u1[0], u1[1], u1[2], u1[3]);
}
__device__ __forceinline__ void ssm_xcompute(bf16x8 ua, const bf16x8 (&bb)[4], f32x16 (&xr)[2], f32x16 (&xi)[2]) {
    const f32x16 z = {0.f, 0.f, 0.f, 0.f, 0.f, 0.f, 0.f, 0.f, 0.f, 0.f, 0.f, 0.f, 0.f, 0.f, 0.f, 0.f};
    f32x16 t0 = __builtin_amdgcn_mfma_f32_32x32x16_bf16(ua, bb[0], z, 0, 0, 0), t1 = __builtin_amdgcn_mfma_f32_32x32x16_bf16(ua, bb[1], z, 0, 0, 0);
    f32x16 t2 = __builtin_amdgcn_mfma_f32_32x32x16_bf16(ua, bb[2], z, 0, 0, 0), t3 = __builtin_amdgcn_mfma_f32_32x32x16_bf16(ua, bb[3], z, 0, 0, 0);
#pragma unroll
    for (int r = 0; r < 16; ++r) {
        const float a0 = t0[r], a1 = t1[r], a2 = t2[r], a3 = t3[r];
        const auto sr = __builtin_amdgcn_permlane32_swap(__float_as_uint(a0), __float_as_uint(a1), false, false);
        const unsigned s0 = sr[0], s1 = sr[1];
        xr[0][r] = __uint_as_float(s0); xr[1][r] = __uint_as_float(s1);
        const auto si = __builtin_amdgcn_permlane32_swap(__float_as_uint(a2), __float_as_uint(a3), false, false);
        const unsigned s2 = si[0], s3 = si[1];
        xi[0][r] = __uint_as_float(s2); xi[1][r] = __uint_as_float(s3); }
    __builtin_amdgcn_sched_barrier(0); asm volatile("s_nop 7" ::: "memory"); __builtin_amdgcn_sched_barrier(0);
}
#define SSM_XR(t) xr[((t) >> 2) & 1][((t) & 3) + 4 * ((t) >> 3)]
#define SSM_XI(t) xi[((t) >> 2) & 1][((t) & 3) + 4 * ((t) >> 3)]
__device__ __forceinline__ void ssm_a_item(const Args& a, const float* U, const float* ssmc, float* SSMF, LAS float* uL, int it, int lane) {
    const int g = it & 15, bc = it >> 4, b = bc / 31, c = bc - b * 31;
    const f32x4 c0 = *(const f32x4*)(ssmc + (size_t)(g * 64 + lane) * 8);
    const float ar = c0[0], ai = c0[1];
    bf16x8 bb[4]; ssm_bfrags(a, ssmc, g, lane, bb);
    float hr = 0.f, hi = 0.f;
    bf16x8 ua2[2]; ua2[0] = ssm_loadu(U, b * 2048 + c * 64, 32, g, lane); ua2[1] = ssm_loadu(U, b * 2048 + c * 64 + 32, 32, g, lane);
#pragma unroll
    for (int blk = 0; blk < 2; ++blk) {
        f32x16 xr[2], xi[2]; ssm_xcompute(ua2[blk], bb, xr, xi);
#pragma unroll
        for (int t = 0; t < 32; ++t) { const float nr = fmaf(ar, hr, fmaf(-ai, hi, SSM_XR(t))), ni = fmaf(ar, hi, fmaf(ai, hr, SSM_XI(t))); hr = nr; hi = ni; }
    }
    *(f32x2*)(SSMF + ((size_t)((b * 32 + c) * 16 + g) * 64 + lane) * 2) = (f32x2){hr, hi};
    (void)uL;
}
constexpr int SAB = 4;
struct SaBatch { f32x4 k[SAB], v[SAB]; };
__device__ __forceinline__ void sa_load(SaBatch& B, const float* cb, unsigned loff, int t, int dil, int nvalid, int i0) {
#pragma unroll
    for (int j = 0; j < SAB; ++j) { const int i = i0 + j, idx = i < nvalid ? t + i * dil : t; const char* rp = (const char*)(cb + (size_t)idx * 512);
        B.k[j] = __builtin_nontemporal_load((const f32x4*)(rp + loff)); B.v[j] = __builtin_nontemporal_load((const f32x4*)(rp + 1024 + loff)); }
}
__device__ __forceinline__ void sa_compute(const SaBatch& B, f32x4 q, int nvalid, int i0, float& m, float& l, f32x4& o) {
    float s[SAB]; float mb = m;
#pragma unroll
    for (int j = 0; j < SAB; ++j) { float d = (q[0] * B.k[j][0] + q[1] * B.k[j][1]) + (q[2] * B.k[j][2] + q[3] * B.k[j][3]);
        d += __shfl_xor(d, 1); d += __shfl_xor(d, 2); d += __shfl_xor(d, 4); d += __shfl_xor(d, 8);
        s[j] = (i0 + j) < nvalid ? d : -1e30f; mb = fmaxf(mb, s[j]); }
    const float sc = fexp2(m - mb); l *= sc; o = o * sc; m = mb;
#pragma unroll
    for (int j = 0; j < SAB; ++j) { const float p = fexp2(s[j] - mb); l += p; o = o + B.v[j] * p; }
}
__device__ __forceinline__ void sattn_item(const Args& a, const bf16* Q, bf16* AO, float* LSE, int it, int lane) {
    const int g = it >> 9, rem = it & 511, b = rem >> 2, t = rem & 3;
    const int dil = 1 << (2 * g), nbuf = 128 << (2 * g);
    const int R = MP + 4 * b + t, hh = lane >> 4, dq = (lane & 15) * 4;
    const u32x2 qw = *(const u32x2*)(Q + (size_t)R * AW + g * 256 + hh * 64 + dq);
    const f32x4 q = {bf2f(qw.x & 0xffffu), bf2f(qw.x >> 16), bf2f(qw.y & 0xffffu), bf2f(qw.y >> 16)};
    const float* cb = a.in[I_C1 + g] + (size_t)b * nbuf * 512; const unsigned loff = 4u * (unsigned)(hh * 64 + dq);
    const float* nb = a.out + (g == 0 ? O_KV1S : (g == 1 ? O_KV4S : O_KV16S)) + (size_t)(4 * b) * 512 + hh * 64 + dq;
    const int nvalid = g == 0 ? 128 - t : 128;
    float m = -1e30f, l = 0.f; f32x4 o = {0.f, 0.f, 0.f, 0.f};
    SaBatch A, B; sa_load(A, cb, loff, t, dil, nvalid, 0);
#pragma unroll 1
    for (int i0 = 0; i0 < 128; i0 += 2 * SAB) {
        sa_load(B, cb, loff, t, dil, nvalid, i0 + SAB);
        sa_compute(A, q, nvalid, i0, m, l, o);
        if (i0 + 2 * SAB < 128) sa_load(A, cb, loff, t, dil, nvalid, i0 + 2 * SAB);
        sa_compute(B, q, nvalid, i0 + SAB, m, l, o);
    }
    {
        f32x4 kk[4], vv[4]; float s[4]; float mb = m;
#pragma unroll
        for (int j = 0; j < 4; ++j) { const float* rp = nb + (size_t)j * 512; kk[j] = *(const f32x4*)rp; vv[j] = *(const f32x4*)(rp + 256); }
#pragma unroll
        for (int j = 0; j < 4; ++j) { float d = (q[0] * kk[j][0] + q[1] * kk[j][1]) + (q[2] * kk[j][2] + q[3] * kk[j][3]);
            d += __shfl_xor(d, 1); d += __shfl_xor(d, 2); d += __shfl_xor(d, 4); d += __shfl_xor(d, 8);
            const bool ok = g == 0 ? (j <= t) : (j == t); s[j] = ok ? d : -1e30f; mb = fmaxf(mb, s[j]); }
        const float sc = fexp2(m - mb); l *= sc; o = o * sc; m = mb;
#pragma unroll
        for (int j = 0; j < 4; ++j) { const float p = fexp2(s[j] - mb); l += p; o = o + vv[j] * p; }
    }
    const float il = frcp(l); o = o * il;
    u32x2 w; w.x = cvt_pk_bf16(o[0], o[1]); w.y = cvt_pk_bf16(o[2], o[3]); *(u32x2*)(AO + (size_t)R * AW + g * 256 + hh * 64 + dq) = w;
    if ((lane & 15) == 0) LSE[(size_t)R * 12 + g * 4 + hh] = (m + flog2(l)) * LN2;
}
__device__ __forceinline__ void pattn_item(const bf16* Q, const bf16* Kb, const bf16* VT, bf16* AO, float* LSE, int it, int lane) {
    const int g = it >> 11; int rem = it & 2047;
    const int sh = 2 * g, dil = 1 << sh, S = 2048 >> sh, nql = 6 - sh;
    const int qt = rem & ((1 << nql) - 1); rem >>= nql; const int res = rem & (dil - 1); rem >>= sh; const int hh = rem & 3, b = rem >> 2;
    const int n = lane & 31, hi = lane >> 5;
    const int s_q = 32 * qt + n, qrow = b * 2048 + s_q * dil + res;
    const int coff = g * 256 + hh * 64 + 32 * hi;
    bf16x8 qf[4];
    { const bf16* qp = Q + (size_t)qrow * AW + coff;
#pragma unroll
      for (int d0 = 0; d0 < 4; ++d0) qf[d0] = *(const bf16x8*)(qp + 8 * d0); }
    f32x16 sc[5];
    const int pm = pi23(n);
#pragma unroll
    for (int kt = 0; kt < 5; ++kt) {
        const int sb = 32 * qt - 128 + 32 * kt; int sk = sb + pm; sk = sk < 0 ? 0 : sk;
        const bf16* kp = Kb + (size_t)(b * 2048 + sk * dil + res) * AW + coff;
        bf16x8 kf[4];
#pragma unroll
        for (int d0 = 0; d0 < 4; ++d0) kf[d0] = *(const bf16x8*)(kp + 8 * d0);
        f32x16 acc = {0.f, 0.f, 0.f, 0.f, 0.f, 0.f, 0.f, 0.f, 0.f, 0.f, 0.f, 0.f, 0.f, 0.f, 0.f, 0.f};
#pragma unroll
        for (int d0 = 0; d0 < 4; ++d0) acc = __builtin_amdgcn_mfma_f32_32x32x16_bf16(kf[d0], qf[d0], acc, 0, 0, 0);
        sc[kt] = acc;
    }
    float mx = -1e30f;
#pragma unroll
    for (int kt = 0; kt < 5; ++kt) { const int sb = 32 * qt - 128 + 32 * kt;
#pragma unroll
        for (int r = 0; r < 16; ++r) { const int sk = sb + 16 * (r >> 3) + 8 * hi + (r & 7); const int dl = s_q - sk; const bool ok = (sk >= 0) && (dl >= 0) && (dl <= 128);
            const float v = ok ? sc[kt][r] : -1e30f; sc[kt][r] = v; mx = fmaxf(mx, v); } }
    mx = fmaxf(mx, __shfl_xor(mx, 32));
    float l = 0.f;
#pragma unroll
    for (int kt = 0; kt < 5; ++kt)
#pragma unroll
        for (int r = 0; r < 16; ++r) { const float p = fexp2(sc[kt][r] - mx); sc[kt][r] = p; l += p; }
    l += __shfl_xor(l, 32);
    f32x16 o[2];
#pragma unroll
    for (int dt = 0; dt < 2; ++dt) o[dt] = (f32x16){0.f, 0.f, 0.f, 0.f, 0.f, 0.f, 0.f, 0.f, 0.f, 0.f, 0.f, 0.f, 0.f, 0.f, 0.f, 0.f};
    const bf16* vbase = VT + (size_t)((g * 4 + hh) * 8 + b) * 64 * 2048;
#pragma unroll
    for (int kt = 0; kt < 5; ++kt) {
        int sb = 32 * qt - 128 + 32 * kt; sb = sb < 0 ? 0 : sb;
        const bf16* vp = vbase + (size_t)((res * S + sb) >> 5) * 2048 + n * 32 + 8 * hi;
#pragma unroll
        for (int jj = 0; jj < 2; ++jj) {
            const bf16x8 pb = pack8(sc[kt][8 * jj + 0], sc[kt][8 * jj + 1], sc[kt][8 * jj + 2], sc[kt][8 * jj + 3], sc[kt][8 * jj + 4], sc[kt][8 * jj + 5], sc[kt][8 * jj + 6], sc[kt][8 * jj + 7]);
#pragma unroll
            for (int dt = 0; dt < 2; ++dt) { const bf16x8 vf = *(const bf16x8*)(vp + dt * 1024 + 16 * jj); o[dt] = __builtin_amdgcn_mfma_f32_32x32x16_bf16(vf, pb, o[dt], 0, 0, 0); }
        }
    }
    const float il = frcp(l);
    bf16* op = AO + (size_t)qrow * AW + g * 256 + hh * 64 + 4 * hi;
#pragma unroll
    for (int dt = 0; dt < 2; ++dt)
#pragma unroll
        for (int r4 = 0; r4 < 4; ++r4) { u32x2 w; w.x = cvt_pk_bf16(o[dt][4 * r4] * il, o[dt][4 * r4 + 1] * il); w.y = cvt_pk_bf16(o[dt][4 * r4 + 2] * il, o[dt][4 * r4 + 3] * il);
            *(u32x2*)(op + 32 * dt + 8 * r4) = w; }
    if (hi == 0) LSE[(size_t)qrow * 12 + g * 4 + hh] = (mx + flog2(l)) * LN2;
}

constexpr int PK_ROW = 144, PK_SLOT = 32 * PK_ROW, PV_OFF = 12 * PK_SLOT;
__device__ __forceinline__ void pattn_wg_item(const bf16* Q, const bf16* Kb, const bf16* VT, bf16* AO, float* LSE, LAS unsigned char* lds, int item, int wave, int lane, int tid) {
    const int g = item >> 8, r = item & 255, hh = (r >> 3) & 3, b = r >> 5;
    const int sh = 2 * g, dil = 1 << sh, S = 2048 >> sh;
    const int qblk = g == 0 ? (r & 7) : (r & 1), resb = g == 0 ? 0 : (g == 1 ? ((r >> 1) & 3) : 2 * (r & 7));
    const int pc = tid & 255;
    u32x4 kreg[6], vreg[6];
#pragma unroll
    for (int i = 0; i < 6; ++i) { const int T = (tid >> 8) + 2 * i;
        int sb, rs; bool ok;
        if (g < 2) { sb = 256 * qblk - 128 + 32 * T; rs = resb; ok = sb >= 0; } else { sb = 32 * (T & 3); rs = resb + (T >> 2); ok = T < 8; }
        if (ok) { const int t = (sb + (pc >> 3)) * dil + rs;
            kreg[i] = *(const u32x4*)(Kb + (size_t)(b * 2048 + t) * AW + g * 256 + hh * 64 + 8 * (pc & 7));
            vreg[i] = *(const u32x4*)(VT + (size_t)(b * 2048 + t) * AW + g * 256 + hh * 64 + 8 * (pc & 7)); }
        else { kreg[i] = (u32x4){0u, 0u, 0u, 0u}; vreg[i] = kreg[i]; } }
    const int n = lane & 31, hi = lane >> 5;
    const int qt = g < 2 ? 8 * qblk + wave : (wave & 3), resw = g < 2 ? resb : resb + (wave >> 2);
    const int slot_base = g < 2 ? wave : 4 * (wave >> 2) + (wave & 3) - 4;
    const int s_q = 32 * qt + n, qrow = b * 2048 + s_q * dil + resw;
    bf16x8 qf[4];
    { const bf16* qp = Q + (size_t)qrow * AW + g * 256 + hh * 64 + 32 * hi;
#pragma unroll
      for (int d0 = 0; d0 < 4; ++d0) qf[d0] = *(const bf16x8*)(qp + 8 * d0); }
#pragma unroll
    for (int i = 0; i < 6; ++i) { const int T = (tid >> 8) + 2 * i;
        *(LAS u32x4*)(lds + T * PK_SLOT + (pc >> 3) * PK_ROW + (pc & 7) * 16) = kreg[i];
        *(LAS u32x4*)(lds + PV_OFF + T * PK_SLOT + (pc >> 3) * PK_ROW + (pc & 7) * 16) = vreg[i]; }
    __syncthreads();
    f32x16 sc[5];
    const int pm = pi23(n);
#pragma unroll
    for (int kt = 0; kt < 5; ++kt) {
        const int slot = slot_base + kt, sb = 32 * qt - 128 + 32 * kt;
        f32x16 acc = {0.f, 0.f, 0.f, 0.f, 0.f, 0.f, 0.f, 0.f, 0.f, 0.f, 0.f, 0.f, 0.f, 0.f, 0.f, 0.f};
        if (sb >= 0) {
            const LAS unsigned char* kp = lds + slot * PK_SLOT + pm * PK_ROW + 64 * hi;
            bf16x8 kf[4];
#pragma unroll
            for (int d0 = 0; d0 < 4; ++d0) kf[d0] = *(const LAS bf16x8*)(kp + 16 * d0);
#pragma unroll
            for (int d0 = 0; d0 < 4; ++d0) acc = __builtin_amdgcn_mfma_f32_32x32x16_bf16(kf[d0], qf[d0], acc, 0, 0, 0);
        }
        sc[kt] = acc;
    }
    float mx = -1e30f;
#pragma unroll
    for (int kt = 0; kt < 5; ++kt) { const int sb = 32 * qt - 128 + 32 * kt;
#pragma unroll
        for (int rr = 0; rr < 16; ++rr) { const int sk = sb + 16 * (rr >> 3) + 8 * hi + (rr & 7); const int dl = s_q - sk; const bool ok = (sk >= 0) && (dl >= 0) && (dl <= 128);
            const float v = ok ? sc[kt][rr] : -1e30f; sc[kt][rr] = v; mx = fmaxf(mx, v); } }
    mx = fmaxf(mx, __shfl_xor(mx, 32));
    float l = 0.f;
#pragma unroll
    for (int kt = 0; kt < 5; ++kt)
#pragma unroll
        for (int rr = 0; rr < 16; ++rr) { const float p = fexp2(sc[kt][rr] - mx); sc[kt][rr] = p; l += p; }
    l += __shfl_xor(l, 32);
    f32x16 o[2];
#pragma unroll
    for (int dt = 0; dt < 2; ++dt) o[dt] = (f32x16){0.f, 0.f, 0.f, 0.f, 0.f, 0.f, 0.f, 0.f, 0.f, 0.f, 0.f, 0.f, 0.f, 0.f, 0.f, 0.f};
#pragma unroll
    for (int kt = 0; kt < 5; ++kt) {
        const int slot = slot_base + kt, sb = 32 * qt - 128 + 32 * kt;
        if (sb >= 0) {
            LAS unsigned char* vp = lds + PV_OFF + slot * PK_SLOT + (8 * hi + ((lane >> 2) & 3)) * PK_ROW + (16 * ((lane >> 4) & 1) + 4 * (lane & 3)) * 2;
            bf16x8 vf[2][2];
#pragma unroll
            for (int jj = 0; jj < 2; ++jj)
#pragma unroll
                for (int dt = 0; dt < 2; ++dt) vf[jj][dt] = cat44(lds_tr4(vp + (16 * jj) * PK_ROW + 64 * dt), lds_tr4(vp + (16 * jj + 4) * PK_ROW + 64 * dt));
#pragma unroll
            for (int jj = 0; jj < 2; ++jj) {
                const bf16x8 pb = pack8(sc[kt][8 * jj + 0], sc[kt][8 * jj + 1], sc[kt][8 * jj + 2], sc[kt][8 * jj + 3], sc[kt][8 * jj + 4], sc[kt][8 * jj + 5], sc[kt][8 * jj + 6], sc[kt][8 * jj + 7]);
#pragma unroll
                for (int dt = 0; dt < 2; ++dt) o[dt] = __builtin_amdgcn_mfma_f32_32x32x16_bf16(vf[jj][dt], pb, o[dt], 0, 0, 0);
            }
        }
    }
    const float il = frcp(l);
    bf16* op = AO + (size_t)qrow * AW + g * 256 + hh * 64 + 4 * hi;
#pragma unroll
    for (int dt = 0; dt < 2; ++dt)
#pragma unroll
        for (int r4 = 0; r4 < 4; ++r4) { u32x2 w; w.x = cvt_pk_bf16(o[dt][4 * r4] * il, o[dt][4 * r4 + 1] * il); w.y = cvt_pk_bf16(o[dt][4 * r4 + 2] * il, o[dt][4 * r4 + 3] * il);
            *(u32x2*)(op + 32 * dt + 8 * r4) = w; }
    if (hi == 0) LSE[(size_t)qrow * 12 + g * 4 + hh] = (mx + flog2(l)) * LN2;
    __syncthreads();
}

template <int NB> __device__ __forceinline__ void combine_rows(const bf16* AO, const float* LSE, const float* aon, bf16* MIXED, int R0, int lane) {
    const int hh = lane >> 4; float ls[NB][3]; u32x2 ow[NB][3];
#pragma unroll
    for (int i = 0; i < NB; ++i)
#pragma unroll
        for (int g = 0; g < 3; ++g) { ow[i][g] = *(const u32x2*)(AO + (size_t)(R0 + i) * AW + g * 256 + 4 * lane); ls[i][g] = LSE[(size_t)(R0 + i) * 12 + g * 4 + hh]; }
    f32x4 gn[3];
#pragma unroll
    for (int g = 0; g < 3; ++g) gn[g] = *(const f32x4*)(aon + g * 256 + 4 * lane);
#pragma unroll
    for (int i = 0; i < NB; ++i) {
        const float mx = fmaxf(fmaxf(ls[i][0], ls[i][1]), ls[i][2]);
        float e[3]; e[0] = fexp2((ls[i][0] - mx) * LOG2E); e[1] = fexp2((ls[i][1] - mx) * LOG2E); e[2] = fexp2((ls[i][2] - mx) * LOG2E);
        const float inv = frcp(e[0] + e[1] + e[2]);
        f32x4 v[3]; float ss = 0.f;
#pragma unroll
        for (int g = 0; g < 3; ++g) { const float al = e[g] * inv; v[g] = (f32x4){bf2f(ow[i][g].x & 0xffffu), bf2f(ow[i][g].x >> 16), bf2f(ow[i][g].y & 0xffffu), bf2f(ow[i][g].y >> 16)} * al; ss += dot4(v[g]); }
        const float rs = frsq(wave_sum(ss) * (1.0f / 768.0f) + EPS);
#pragma unroll
        for (int g = 0; g < 3; ++g) { const f32x4 y = v[g] * rs * gn[g];
            u32x2 w; w.x = cvt_pk_bf16(y[0], y[1]); w.y = cvt_pk_bf16(y[2], y[3]); *(u32x2*)(MIXED + (size_t)(R0 + i) * D + g * 256 + 4 * lane) = w; }
    }
}
__device__ __forceinline__ float gelu_tanh(float x) { const float u2 = 1.5957691216057308f * (x + 0.044715f * x * x * x); return x * frcp(1.0f + fexp2(-u2 * LOG2E)); }
__device__ __forceinline__ float sigmoidf_(float z) { return frcp(1.0f + fexp2(-z * LOG2E)); }
__device__ __forceinline__ void ssm_c_item(const Args& a, const float* U, const float* ssmc, const float* SSMF, const bf16* WGLU, bf16* MIXED, LAS unsigned char* lds, int item, int wave, int lane) {
    const bool hs = item < 32;
    const int b = item >> 5, c = item & 31;
    const int R0 = item * 64, RS0 = MP + item * 16;
    LAS unsigned* HL = (LAS unsigned*)(lds + wave * 4352);
    LAS float* ZS = (LAS float*)(lds + 34816);
    const int t16 = lane & 15, q4 = lane >> 4;
    for (int gi = 0; gi < 2; ++gi) {
        const int g = 2 * wave + gi;
        const f32x4* cp = (const f32x4*)(ssmc + (size_t)(g * 64 + lane) * 8); const f32x4 c0 = cp[0], c1 = cp[1];
        const float ar = c0[0], ai = c0[1], a64r = c1[0], a64i = c1[1];
        bf16x8 bb[4]; ssm_bfrags(a, ssmc, g, lane, bb);
        bf16x8 cf[4];
#pragma unroll
        for (int s4 = 0; s4 < 4; ++s4) { const int p0 = 16 * s4 + 4 * q4; const f32x4 x = *(const f32x4*)(a.in[I_CRE] + (size_t)(g * 16 + t16) * 64 + p0), y = *(const f32x4*)(a.in[I_CIM] + (size_t)(g * 16 + t16) * 64 + p0);
            cf[s4] = pack8(x[0], -y[0], x[1], -y[1], x[2], -y[2], x[3], -y[3]); }
        const f32x4 dv = *(const f32x4*)(a.in[I_SD] + g * 16 + 4 * q4);
        float hr = 0.f, hi = 0.f;
        {
            const int nb16 = (c + 15) >> 4; int cc0 = c - 16 * nb16;
            for (int i16 = 0; i16 < nb16; ++i16, cc0 += 16) { f32x2 f[16];
#pragma unroll
                for (int j = 0; j < 16; ++j) { const int cc = cc0 + j; f[j] = cc >= 0 ? *(const f32x2*)(SSMF + ((size_t)((b * 32 + cc) * 16 + g) * 64 + lane) * 2) : (f32x2){0.f, 0.f}; }
#pragma unroll
                for (int j = 0; j < 16; ++j) { const float nr = fmaf(a64r, hr, fmaf(-a64i, hi, f[j][0])), ni = fmaf(a64r, hi, fmaf(a64i, hr, f[j][1])); hr = nr; hi = ni; } }
        }
#if defined(PROBE_DUMP)
        { float* dmp = (float*)((unsigned char*)MIXED - WS_MIXED + 741 * MiB) + ((size_t)(item * 16 + g) * 64 + lane) * 2; dmp[0] = hr; dmp[1] = hi; }
#endif
        bf16x8 ua2[2]; f32x4 uv4[4];
        ua2[0] = ssm_loadu(U, R0, 32, g, lane); ua2[1] = ssm_loadu(U, R0 + 32, 32, g, lane);
#pragma unroll
        for (int j = 0; j < 4; ++j) uv4[j] = *(const f32x4*)(U + (size_t)(R0 + 16 * j + t16) * 256 + g * 16 + 4 * q4);
#if defined(PROBE_DUMP)
        { u32x4* dmp = (u32x4*)((unsigned char*)MIXED - WS_MIXED + 724 * MiB) + ((size_t)(item * 16 + g) * 2) * 64 + lane; dmp[0] = __builtin_bit_cast(u32x4, ua2[0]); dmp[64] = __builtin_bit_cast(u32x4, ua2[1]); }
#endif
#pragma unroll
        for (int blk = 0; blk < 2; ++blk) {
            f32x16 xr[2], xi[2]; ssm_xcompute(ua2[blk], bb, xr, xi);
#pragma unroll
            for (int s2 = 0; s2 < 2; ++s2) {
                const int trow = 32 * blk + 16 * s2 + t16;
                const f32x4 uv = uv4[2 * blk + s2];
#pragma unroll
                for (int tt = 0; tt < 16; ++tt) { const int t = 16 * s2 + tt;
                    const float nr = fmaf(ar, hr, fmaf(-ai, hi, SSM_XR(t))), ni = fmaf(ar, hi, fmaf(ai, hr, SSM_XI(t))); hr = nr; hi = ni;
                    HL[tt * 68 + lane] = cvt_pk_bf16(hr, hi);
                }
                LDS_WAIT(); asm volatile("" ::: "memory");
                f32x4 y = {0.f, 0.f, 0.f, 0.f};
#pragma unroll
                for (int s4 = 0; s4 < 4; ++s4) { const bf16x8 hf = *(const LAS bf16x8*)((LAS unsigned short*)HL + t16 * 136 + 32 * s4 + 8 * q4); y = __builtin_amdgcn_mfma_f32_16x16x32_bf16(cf[s4], hf, y, 0, 0, 0); }
                f32x4 z;
#pragma unroll
                for (int e = 0; e < 4; ++e) z[e] = gelu_tanh(y[e] + dv[e] * uv[e]);
                *(LAS f32x4*)(ZS + trow * 260 + g * 16 + 4 * q4) = z;
                LDS_WAIT(); asm volatile("" ::: "memory");
            }
        }
        if (c == 31) { a.out[O_SREP + (size_t)(b * 16 + g) * 64 + lane] = hr; a.out[O_SIMP + (size_t)(b * 16 + g) * 64 + lane] = hi; }
        if (hs) {
            float sre[4], sim[4];
#pragma unroll
            for (int j = 0; j < 4; ++j) { const size_t o = (size_t)((4 * item + j) * 16 + g) * 64 + lane; sre[j] = a.in[I_SRE][o]; sim[j] = a.in[I_SIM][o]; }
            const bf16x8 ua = ssm_loadu(U, RS0, 16, g, lane);
            const f32x4 uv = *(const f32x4*)(U + (size_t)(RS0 + t16) * 256 + g * 16 + 4 * q4);
            f32x16 xr[2], xi[2]; ssm_xcompute(ua, bb, xr, xi);
#pragma unroll
            for (int tt = 0; tt < 16; ++tt) {
                if ((tt & 3) == 0) { hr = sre[tt >> 2]; hi = sim[tt >> 2]; }
                const float nr = fmaf(ar, hr, fmaf(-ai, hi, SSM_XR(tt))), ni = fmaf(ar, hi, fmaf(ai, hr, SSM_XI(tt))); hr = nr; hi = ni;
                HL[tt * 68 + lane] = cvt_pk_bf16(hr, hi);
                if ((tt & 3) == 3) { const size_t o = (size_t)((4 * item + (tt >> 2)) * 16 + g) * 64 + lane; a.out[O_SRES + o] = hr; a.out[O_SIMS + o] = hi; }
            }
            LDS_WAIT(); asm volatile("" ::: "memory");
            f32x4 y = {0.f, 0.f, 0.f, 0.f};
#pragma unroll
            for (int s4 = 0; s4 < 4; ++s4) { const bf16x8 hf = *(const LAS bf16x8*)((LAS unsigned short*)HL + t16 * 136 + 32 * s4 + 8 * q4); y = __builtin_amdgcn_mfma_f32_16x16x32_bf16(cf[s4], hf, y, 0, 0, 0); }
            f32x4 z;
#pragma unroll
            for (int e = 0; e < 4; ++e) z[e] = gelu_tanh(y[e] + dv[e] * uv[e]);
            *(LAS f32x4*)(ZS + (64 + t16) * 260 + g * 16 + 4 * q4) = z;
            LDS_WAIT(); asm volatile("" ::: "memory");
        }
    }
    const int n = lane & 31, hi5 = lane >> 5, n0 = 32 * wave, nmt = hs ? 3 : 2;
    bf16x8 bfr[16];
#pragma unroll
    for (int st = 0; st < 16; ++st) bfr[st] = *(const bf16x8*)(WGLU + (size_t)(n0 + n) * 256 + 16 * st + 8 * hi5);
    const float bias = a.in[I_BGLU][n0 + n];
    const f32x4 gn = *(const f32x4*)(a.in[I_SON] + 4 * lane);
    __syncthreads();
    f32x16 acc[3];
#pragma unroll
    for (int mt = 0; mt < 3; ++mt) acc[mt] = (f32x16){0.f, 0.f, 0.f, 0.f, 0.f, 0.f, 0.f, 0.f, 0.f, 0.f, 0.f, 0.f, 0.f, 0.f, 0.f, 0.f};
#pragma unroll
    for (int st = 0; st < 16; ++st) {
        const bf16x8 bf = bfr[st];
#pragma unroll
        for (int mt = 0; mt < 3; ++mt) { if (mt < nmt) { const LAS float* zp = ZS + (32 * mt + n) * 260 + 16 * st + 8 * hi5; const f32x4 x = *(const LAS f32x4*)zp, y = *(const LAS f32x4*)(zp + 4);
            acc[mt] = __builtin_amdgcn_mfma_f32_32x32x16_bf16(pack8(x[0], x[1], x[2], x[3], y[0], y[1], y[2], y[3]), bf, acc[mt], 0, 0, 0); } }
    }
    float so[3][16];
#pragma unroll
    for (int mt = 0; mt < 3; ++mt) { if (mt < nmt) {
#pragma unroll
        for (int r = 0; r < 16; ++r) { const int t = 32 * mt + (r & 3) + 8 * (r >> 2) + 4 * hi5; so[mt][r] = ZS[t * 260 + n0 + n] * sigmoidf_(acc[mt][r] + bias); } } }
    __syncthreads();
#pragma unroll
    for (int mt = 0; mt < 3; ++mt) { if (mt < nmt) {
#pragma unroll
        for (int r = 0; r < 16; ++r) { const int t = 32 * mt + (r & 3) + 8 * (r >> 2) + 4 * hi5; ZS[t * 260 + n0 + n] = so[mt][r]; } } }
    __syncthreads();
#pragma unroll
    for (int i = 0; i < 10; ++i) { if (i >= 8 && !hs) break;
        const int row = i < 8 ? 8 * wave + i : 64 + 2 * wave + (i - 8); const f32x4 v = *(const LAS f32x4*)(ZS + row * 260 + 4 * lane);
        const float rs = frsq(wave_sum(dot4(v)) * (1.0f / 256.0f) + EPS); const f32x4 y = v * rs * gn;
        const size_t orow = i < 8 ? (size_t)(R0 + row) : (size_t)(RS0 + row - 64);
        u32x2 w; w.x = cvt_pk_bf16(y[0], y[1]); w.y = cvt_pk_bf16(y[2], y[3]); *(u32x2*)(MIXED + orow * D + 768 + 4 * lane) = w; }
    __syncthreads();
}

__device__ __forceinline__ float xq_sigma(const float* RS1, const float* QS, int R, int h) {
    const float rstd = frsq(RS1[R] * (1.0f / 1024.0f) + EPS), msq = QS[(size_t)R * 4 + h] * (1.0f / 256.0f);
    return rstd / sqrtf(rstd * rstd * msq + EPS) * (0.0625f * LOG2E);
}
template <int MODE, bool BASE_BF16 = false> __device__ __forceinline__ void sample_gemm_tile(const bf16* A, const bf16* Bt, int K, const void* base, float* outp, bf16* hb, float* ssq, LAS unsigned char* lds, int tile, int wave, int lane, int tid) {
    const int tm = tile >> 5, tn = tile & 31, n = lane & 31, hi = lane >> 5, kw = K >> 3;
    const bf16* ap = A + (size_t)(64 * tm + n) * K + wave * kw + 8 * hi;
    const bf16* bp = Bt + (size_t)(32 * tn + n) * K + wave * kw + 8 * hi;
    f32x16 acc0 = {0.f, 0.f, 0.f, 0.f, 0.f, 0.f, 0.f, 0.f, 0.f, 0.f, 0.f, 0.f, 0.f, 0.f, 0.f, 0.f}, acc1 = acc0;
    const int row = tid >> 3, c4 = (tid & 7) * 4, rs = 64 * tm + row, col = 32 * tn + c4;
    f32x4 bs = {0.f, 0.f, 0.f, 0.f};
    if (MODE == 0) {
        if (BASE_BF16) { const u32x2 w = *(const u32x2*)((const bf16*)base + (size_t)rs * D + col); bs = (f32x4){bf2f(w.x & 0xffffu), bf2f(w.x >> 16), bf2f(w.y & 0xffffu), bf2f(w.y >> 16)}; }
        else bs = *(const f32x4*)((const float*)base + (size_t)rs * D + col); }
#pragma unroll 8
    for (int s = 0; s < kw; s += 16) { const bf16x8 a0 = *(const bf16x8*)(ap + s), a1 = *(const bf16x8*)(ap + (size_t)32 * K + s), bb = *(const bf16x8*)(bp + s);
        acc0 = __builtin_amdgcn_mfma_f32_32x32x16_bf16(a0, bb, acc0, 0, 0, 0); acc1 = __builtin_amdgcn_mfma_f32_32x32x16_bf16(a1, bb, acc1, 0, 0, 0); }
    LAS float* P = (LAS float*)lds;
#pragma unroll
    for (int r = 0; r < 16; ++r) { const int row = (r & 3) + 8 * (r >> 2) + 4 * hi; P[(wave * 64 + row) * 32 + n] = acc0[r]; P[(wave * 64 + 32 + row) * 32 + n] = acc1[r]; }
    __syncthreads();
    f32x4 v = {0.f, 0.f, 0.f, 0.f};
#pragma unroll
    for (int w = 0; w < 8; ++w) v = v + *(const LAS f32x4*)(P + (w * 64 + row) * 32 + c4);
    float s;
    if (MODE == 0) {
        const f32x4 o = bs + v; if (outp) *(f32x4*)(outp + (size_t)rs * D + col) = o;
        if (hb) { u32x2 w; w.x = cvt_pk_bf16(o[0], o[1]); w.y = cvt_pk_bf16(o[2], o[3]); *(u32x2*)(hb + (size_t)rs * D + col) = w; }
        s = dot4(o); }
    else { u32x2 w; w.x = cvt_pk_bf16(v[0], v[1]); w.y = cvt_pk_bf16(v[2], v[3]); *(u32x2*)(hb + (size_t)rs * D + col) = w; s = dot4(v); }
    if (ssq) { s += __shfl_xor(s, 1); s += __shfl_xor(s, 2); s += __shfl_xor(s, 4); if ((tid & 7) == 0) atomic_addf(MODE == 0 ? ssq + rs : ssq + (size_t)rs * 4 + (tn >> 3), s); }
    __syncthreads();
}
constexpr int XK_ROW = 272, XK_BUF = 32 * XK_ROW, XV_BUF = XK_BUF, XV_OFF = 2 * XK_BUF;
__device__ __forceinline__ void xattn_wg_item(const bf16* QX, const float* SS1, const float* QSS, const bf16* MEMK, const bf16* MVT, bf16* OX, LAS unsigned char* lds, int it, int wave, int lane, int tid) {
    const int qb = it & 7, h = (it >> 3) & 3, b = it >> 5;
    const int n = lane & 31, hi = lane >> 5, R = b * 2048 + 256 * qb + 32 * wave + n;
    const float sigma = xq_sigma(SS1, QSS, R, h);
    const bf16* kg = MEMK + (size_t)(b * 256 + (tid >> 4)) * 1024 + h * 256 + 128 * ((tid >> 3) & 1) + 8 * (tid & 7);
    const bf16* vg = MVT + (size_t)(b * 256 + (tid >> 4)) * 1024 + h * 256 + 8 * (tid & 15);
    LAS unsigned char* kl = lds + (tid >> 4) * XK_ROW + (tid & 15) * 16;
    LAS unsigned char* vl = lds + XV_OFF + (tid >> 4) * XK_ROW + (tid & 15) * 16;
#define XSRC(t) ((t) < 16 ? (const u32x4*)(kg + (size_t)((t) & 7) * 32 * 1024 + ((t) >> 3) * 64) : (const u32x4*)(vg + (size_t)(((t) - 16) & 7) * 32 * 1024 + (((t) - 16) >> 3) * 128))
#define XPUT(t, w_) do { if ((t) < 16) *(LAS u32x4*)(kl + ((t) & 1) * XK_BUF) = (w_); else *(LAS u32x4*)(vl + ((t) & 1) * XV_BUF) = (w_); } while (0)
    u32x4 ring[3]; ring[0] = *XSRC(0); ring[1] = *XSRC(1); ring[2] = *XSRC(2);
    f32x16 sc[8];
#pragma unroll
    for (int kt = 0; kt < 8; ++kt) sc[kt] = (f32x16){0.f, 0.f, 0.f, 0.f, 0.f, 0.f, 0.f, 0.f, 0.f, 0.f, 0.f, 0.f, 0.f, 0.f, 0.f, 0.f};
    XPUT(0, ring[0]);
    __syncthreads();
    const LAS unsigned char* kr = lds + pi23(n) * XK_ROW + 128 * hi;
#pragma unroll
    for (int dh = 0; dh < 2; ++dh) {
        bf16x8 qf[8];
        { const bf16* qp = QX + (size_t)R * D + h * 256 + 128 * hi + 64 * dh;
#pragma unroll
          for (int st = 0; st < 8; ++st) qf[st] = *(const bf16x8*)(qp + 8 * st); }
#pragma unroll
        for (int kt = 0; kt < 8; ++kt) {
            const int s = dh * 8 + kt;
            ring[s % 3] = *XSRC(s + 3);
            const LAS unsigned char* kp = kr + (s & 1) * XK_BUF;
            bf16x8 kf[8];
#pragma unroll
            for (int st = 0; st < 8; ++st) kf[st] = *(const LAS bf16x8*)(kp + 16 * st);
            __builtin_amdgcn_sched_barrier(0);
#pragma unroll
            for (int st = 0; st < 8; ++st) sc[kt] = __builtin_amdgcn_mfma_f32_32x32x16_bf16(kf[st], qf[st], sc[kt], 0, 0, 0);
            XPUT(s + 1, ring[(s + 1) % 3]);
            asm volatile("s_waitcnt lgkmcnt(0)\n\ts_barrier" ::: "memory");
        }
    }
    float mx = -1e30f;
#pragma unroll
    for (int kt = 0; kt < 8; ++kt)
#pragma unroll
        for (int r = 0; r < 16; ++r) { sc[kt][r] *= sigma; mx = fmaxf(mx, sc[kt][r]); }
    mx = fmaxf(mx, __shfl_xor(mx, 32));
    float l = 0.f;
#pragma unroll
    for (int kt = 0; kt < 8; ++kt)
#pragma unroll
        for (int r = 0; r < 16; ++r) { const float p = fexp2(sc[kt][r] - mx); sc[kt][r] = p; l += p; }
    l += __shfl_xor(l, 32);
    const float il = frcp(l);
    bf16x8 pb[8][2];
#pragma unroll
    for (int kt = 0; kt < 8; ++kt)
#pragma unroll
        for (int jj = 0; jj < 2; ++jj) pb[kt][jj] = pack8(sc[kt][8 * jj + 0], sc[kt][8 * jj + 1], sc[kt][8 * jj + 2], sc[kt][8 * jj + 3], sc[kt][8 * jj + 4], sc[kt][8 * jj + 5], sc[kt][8 * jj + 6], sc[kt][8 * jj + 7]);
    LAS unsigned char* vr = lds + XV_OFF + (8 * hi + ((lane >> 2) & 3)) * XK_ROW + (16 * ((lane >> 4) & 1) + 4 * (lane & 3)) * 2;
    bf16* op = OX + (size_t)R * D + h * 256 + 4 * hi;
#pragma unroll
    for (int dh = 0; dh < 2; ++dh) {
        f32x16 o[4];
#pragma unroll
        for (int dt = 0; dt < 4; ++dt) o[dt] = (f32x16){0.f, 0.f, 0.f, 0.f, 0.f, 0.f, 0.f, 0.f, 0.f, 0.f, 0.f, 0.f, 0.f, 0.f, 0.f, 0.f};
#pragma unroll
        for (int kt = 0; kt < 8; ++kt) {
            const int s = 16 + dh * 8 + kt;
            if (s + 3 < 32) ring[s % 3] = *XSRC(s + 3);
            LAS unsigned char* vp = vr + (s & 1) * XV_BUF;
            bf16x8 vf[4][2];
#pragma unroll
            for (int dt = 0; dt < 4; ++dt)
#pragma unroll
                for (int jj = 0; jj < 2; ++jj) vf[dt][jj] = cat44(lds_tr4(vp + (16 * jj) * XK_ROW + 64 * dt), lds_tr4(vp + (16 * jj + 4) * XK_ROW + 64 * dt));
            __builtin_amdgcn_sched_barrier(0);
#pragma unroll
            for (int jj = 0; jj < 2; ++jj)
#pragma unroll
                for (int dt = 0; dt < 4; ++dt) o[dt] = __builtin_amdgcn_mfma_f32_32x32x16_bf16(vf[dt][jj], pb[kt][jj], o[dt], 0, 0, 0);
            if (s + 1 < 32) XPUT(s + 1, ring[(s + 1) % 3]);
            asm volatile("s_waitcnt lgkmcnt(0)\n\ts_barrier" ::: "memory");
        }
#pragma unroll
        for (int dt = 0; dt < 4; ++dt)
#pragma unroll
            for (int r4 = 0; r4 < 4; ++r4) { u32x2 w; w.x = cvt_pk_bf16(o[dt][4 * r4] * il, o[dt][4 * r4 + 1] * il); w.y = cvt_pk_bf16(o[dt][4 * r4 + 2] * il, o[dt][4 * r4 + 3] * il);
                *(u32x2*)(op + 128 * dh + 32 * dt + 8 * r4) = w; }
    }
}
#undef XSRC
#undef XPUT
constexpr int SXB = 4;
struct SxBatch { f32x4 k[SXB], v[SXB]; };
__device__ __forceinline__ void sx_load(SxBatch& B, const float* kb, unsigned loff, int j0) {
#pragma unroll
    for (int j = 0; j < SXB; ++j) { const char* p = (const char*)(kb + (size_t)(j0 + j) * 2048); B.k[j] = __builtin_nontemporal_load((const f32x4*)(p + loff)); B.v[j] = __builtin_nontemporal_load((const f32x4*)(p + 4096 + loff)); }
}
__device__ __forceinline__ float rdl(float v, int l) { return __builtin_bit_cast(float, __builtin_amdgcn_readlane(__builtin_bit_cast(int, v), l)); }
__device__ __forceinline__ void sx_compute(const SxBatch& B, const f32x4 (&q)[4], bool b5, bool b4, float& m, float& l, f32x4 (&o)[4]) {
    float s[SXB]; float mb = m;
#pragma unroll
    for (int j = 0; j < SXB; ++j) {
        float d[4];
#pragma unroll
        for (int t = 0; t < 4; ++t) d[t] = (q[t][0] * B.k[j][0] + q[t][1] * B.k[j][1]) + (q[t][2] * B.k[j][2] + q[t][3] * B.k[j][3]);
        const float x0 = b5 ? d[0] : d[2], x1 = b5 ? d[1] : d[3], k0 = b5 ? d[2] : d[0], k1 = b5 ? d[3] : d[1];
        const float r0 = k0 + __shfl_xor(x0, 32), r1 = k1 + __shfl_xor(x1, 32);
        const float xs = b4 ? r0 : r1, ks = b4 ? r1 : r0;
        float r = ks + __shfl_xor(xs, 16);
        r += __shfl_xor(r, 8); r += __shfl_xor(r, 4); r += __shfl_xor(r, 2); r += __shfl_xor(r, 1);
        s[j] = r; mb = fmaxf(mb, r);
    }
    const float sc = fexp2(m - mb); m = mb; l *= sc;
#pragma unroll
    for (int t = 0; t < 4; ++t) o[t] = o[t] * rdl(sc, 16 * t);
#pragma unroll
    for (int j = 0; j < SXB; ++j) { const float p = fexp2(s[j] - mb); l += p;
#pragma unroll
        for (int t = 0; t < 4; ++t) o[t] = o[t] + B.v[j] * rdl(p, 16 * t); }
}
template <int NSW> __device__ __forceinline__ void sxattn_stream(const Args& a, const bf16* QX, const float* SS1S, const float* QSSS, bf16* OX, LAS unsigned char* lds, LAS unsigned* cnt, int pair, int slot, int sw, int lane) {
    const int b = pair >> 2, h = pair & 3;
    LAS float* OL = (LAS float*)lds + (size_t)slot * (NSW * 1024); LAS float* ML = (LAS float*)(lds + 65536) + slot * 32; LAS float* LL = (LAS float*)(lds + 65536 + 256) + slot * 32;
    const f32x4 gq = *(const f32x4*)(a.in[I_XQN] + 4 * lane);
    f32x4 q[4];
    const float sgc = xq_sigma(SS1S, QSSS, MP + 4 * b + (lane >> 4), h);
#pragma unroll
    for (int t = 0; t < 4; ++t) { const int R = MP + 4 * b + t; const float sg = rdl(sgc, 16 * t); const u32x2 w = *(const u32x2*)(QX + (size_t)R * D + h * 256 + 4 * lane);
        q[t] = (f32x4){bf2f(w.x & 0xffffu), bf2f(w.x >> 16), bf2f(w.y & 0xffffu), bf2f(w.y >> 16)} * gq * sg; }
    constexpr int NK = 256 / NSW;
    const float* kb = a.in[I_CMEM] + ((size_t)(b * 256 + NK * sw) * 2) * 1024 + h * 256; const unsigned loff = 16u * (unsigned)lane;
    const bool b5 = (lane & 32) != 0, b4 = (lane & 16) != 0;
    float m = -1e30f, l = 0.f;
    f32x4 o[4];
#pragma unroll
    for (int t = 0; t < 4; ++t) o[t] = (f32x4){0.f, 0.f, 0.f, 0.f};
    SxBatch A, B; sx_load(A, kb, loff, 0);
#pragma unroll 1
    for (int j0 = 0; j0 < NK; j0 += 2 * SXB) {
        sx_load(B, kb, loff, j0 + SXB);
        sx_compute(A, q, b5, b4, m, l, o);
        if (j0 + 2 * SXB < NK) sx_load(A, kb, loff, j0 + 2 * SXB);
        sx_compute(B, q, b5, b4, m, l, o);
    }
#pragma unroll
    for (int t = 0; t < 4; ++t) *(LAS f32x4*)(OL + (sw * 4 + t) * 256 + 4 * lane) = o[t];
    if ((lane & 15) == 0) { ML[sw * 4 + (lane >> 4)] = m; LL[sw * 4 + (lane >> 4)] = l; }
    asm volatile("s_waitcnt lgkmcnt(0)" ::: "memory");
    unsigned old = 0u; if (lane == 0) old = __hip_atomic_fetch_add(cnt, 1u, __ATOMIC_ACQ_REL, __HIP_MEMORY_SCOPE_WORKGROUP);
    old = __builtin_amdgcn_readfirstlane(old);
    if (old == (unsigned)(NSW - 1)) {
        asm volatile("s_waitcnt lgkmcnt(0)" ::: "memory");
#pragma unroll
        for (int t = 0; t < 4; ++t) {
            float M = -1e30f;
#pragma unroll
            for (int w = 0; w < NSW; ++w) M = fmaxf(M, ML[w * 4 + t]);
            float L = 0.f; f32x4 acc = {0.f, 0.f, 0.f, 0.f};
#pragma unroll
            for (int w = 0; w < NSW; ++w) { const float f = fexp2(ML[w * 4 + t] - M); L += LL[w * 4 + t] * f; acc = acc + *(const LAS f32x4*)(OL + (w * 4 + t) * 256 + 4 * lane) * f; }
            const float il = frcp(L); u32x2 wv; wv.x = cvt_pk_bf16(acc[0] * il, acc[1] * il); wv.y = cvt_pk_bf16(acc[2] * il, acc[3] * il);
            *(u32x2*)(OX + (size_t)(MP + 4 * b + t) * D + h * 256 + 4 * lane) = wv;
        }
    }
}

__device__ __forceinline__ void up8(const bf16* p, float (&v)[8]) { const u32x4 w = *(const u32x4*)p;
    v[0] = bf2f(w.x & 0xffffu); v[1] = bf2f(w.x >> 16); v[2] = bf2f(w.y & 0xffffu); v[3] = bf2f(w.y >> 16); v[4] = bf2f(w.z & 0xffffu); v[5] = bf2f(w.z >> 16); v[6] = bf2f(w.w & 0xffffu); v[7] = bf2f(w.w >> 16); }
__device__ __forceinline__ void ld8(const float* p, float (&v)[8]) { const f32x4 a = *(const f32x4*)p, b = *(const f32x4*)(p + 4); v[0] = a[0]; v[1] = a[1]; v[2] = a[2]; v[3] = a[3]; v[4] = b[0]; v[5] = b[1]; v[6] = b[2]; v[7] = b[3]; }
__device__ __forceinline__ void conv_item(const Args& a, const bf16* UP, bf16* ACT, int it) {
    const int cgp = it % 352, rc = it / 352, j0 = cgp * 8, R0 = rc * 32;
    const float* cw = a.in[I_CONVW]; const float* cbp = a.in[I_CONVB];
    float wg[3][8], wv[3][8], bg[8], bv[8];
#pragma unroll
    for (int i = 0; i < 3; ++i) { ld8(cw + (size_t)i * FF2 + j0, wg[i]); ld8(cw + (size_t)i * FF2 + FF + j0, wv[i]); }
    ld8(cbp + j0, bg); ld8(cbp + FF + j0, bv);
    float g2[8], g1[8], v2[8], v1[8];
    const bool sample = R0 >= MP;
    if (!sample && (R0 & 2047) != 0) { up8(UP + (size_t)(R0 - 2) * FF2 + j0, g2); up8(UP + (size_t)(R0 - 1) * FF2 + j0, g1); up8(UP + (size_t)(R0 - 2) * FF2 + FF + j0, v2); up8(UP + (size_t)(R0 - 1) * FF2 + FF + j0, v1); }
    else {
#pragma unroll
        for (int e = 0; e < 8; ++e) { g2[e] = 0.f; g1[e] = 0.f; v2[e] = 0.f; v1[e] = 0.f; } }
    for (int r = 0; r < 32; ++r) { const int R = R0 + r;
        if (sample && (r & 3) == 0) { const float* sb = a.in[I_SCONV] + (size_t)((R - MP) >> 2) * 2 * FF2; ld8(sb + j0, g2); ld8(sb + FF2 + j0, g1); ld8(sb + FF + j0, v2); ld8(sb + FF2 + FF + j0, v1); }
        float gc[8], vc[8]; up8(UP + (size_t)R * FF2 + j0, gc); up8(UP + (size_t)R * FF2 + FF + j0, vc);
        float o[8];
#pragma unroll
        for (int e = 0; e < 8; ++e) { const float cgv = bg[e] + wg[0][e] * g2[e] + wg[1][e] * g1[e] + wg[2][e] * gc[e]; const float cvv = bv[e] + wv[0][e] * v2[e] + wv[1][e] * v1[e] + wv[2][e] * vc[e];
            o[e] = cgv * sigmoidf_(cgv) * cvv; g2[e] = g1[e]; g1[e] = gc[e]; v2[e] = v1[e]; v1[e] = vc[e]; }
        u32x4 w; w.x = cvt_pk_bf16(o[0], o[1]); w.y = cvt_pk_bf16(o[2], o[3]); w.z = cvt_pk_bf16(o[4], o[5]); w.w = cvt_pk_bf16(o[6], o[7]);
        *(u32x4*)(ACT + (size_t)R * FF + j0) = w;
    }
}

__device__ __forceinline__ void conv_fix_item(const Args& a, const float* EDGE, bf16* ACT, int it) {
    const int cgp = it % 352, rr = it / 352, r = rr & 1, ti = rr >> 1;
    const int pm = 8 * (ti / 7) + 1 + ti % 7, j0 = cgp * 8;
    const float* cw = a.in[I_CONVW]; const float* cbp = a.in[I_CONVB];
    const float* e_prev = EDGE + (size_t)(pm - 1) * 4 * FF2; const float* e_cur = EDGE + (size_t)pm * 4 * FF2;
    const float* r2 = r == 0 ? e_prev + 2 * FF2 : e_prev + 3 * FF2; const float* r1 = r == 0 ? e_prev + 3 * FF2 : e_cur; const float* r0 = r == 0 ? e_cur : e_cur + FF2;
    float o[8];
#pragma unroll
    for (int hf = 0; hf < 2; ++hf) { const int j4 = j0 + 4 * hf;
        const f32x4 cg = *(const f32x4*)(cbp + j4) + *(const f32x4*)(cw + j4) * *(const f32x4*)(r2 + j4) + *(const f32x4*)(cw + FF2 + j4) * *(const f32x4*)(r1 + j4) + *(const f32x4*)(cw + 2 * FF2 + j4) * *(const f32x4*)(r0 + j4);
        const f32x4 cv = *(const f32x4*)(cbp + FF + j4) + *(const f32x4*)(cw + FF + j4) * *(const f32x4*)(r2 + FF + j4) + *(const f32x4*)(cw + FF2 + FF + j4) * *(const f32x4*)(r1 + FF + j4) + *(const f32x4*)(cw + 2 * FF2 + FF + j4) * *(const f32x4*)(r0 + FF + j4);
#pragma unroll
        for (int e = 0; e < 4; ++e) o[4 * hf + e] = cg[e] * sigmoidf_(cg[e]) * cv[e]; }
    u32x4 w; w.x = cvt_pk_bf16(o[0], o[1]); w.y = cvt_pk_bf16(o[2], o[3]); w.z = cvt_pk_bf16(o[4], o[5]); w.w = cvt_pk_bf16(o[6], o[7]);
    *(u32x4*)(ACT + (size_t)(pm * 256 + r) * FF + j0) = w;
}

__device__ __forceinline__ void conv_fix_tile(const Args& a, const float* EDGE, bf16* ACT, int pm, int tid) {
    const float* cw = a.in[I_CONVW]; const float* cbp = a.in[I_CONVB];
    const float* e_prev = EDGE + (size_t)(pm - 1) * 4 * FF2; const float* e_cur = EDGE + (size_t)pm * 4 * FF2;
    for (int it = tid; it < 2 * 352; it += NWAVES * 64) { const int r = it / 352, j0 = (it - r * 352) * 8;
        const float* r2 = r == 0 ? e_prev + 2 * FF2 : e_prev + 3 * FF2; const float* r1 = r == 0 ? e_prev + 3 * FF2 : e_cur; const float* r0 = r == 0 ? e_cur : e_cur + FF2;
        float o[8];
#pragma unroll
        for (int hf = 0; hf < 2; ++hf) { const int j4 = j0 + 4 * hf;
            const f32x4 cg = *(const f32x4*)(cbp + j4) + *(const f32x4*)(cw + j4) * *(const f32x4*)(r2 + j4) + *(const f32x4*)(cw + FF2 + j4) * *(const f32x4*)(r1 + j4) + *(const f32x4*)(cw + 2 * FF2 + j4) * *(const f32x4*)(r0 + j4);
            const f32x4 cv = *(const f32x4*)(cbp + FF + j4) + *(const f32x4*)(cw + FF + j4) * *(const f32x4*)(r2 + FF + j4) + *(const f32x4*)(cw + FF2 + FF + j4) * *(const f32x4*)(r1 + FF + j4) + *(const f32x4*)(cw + 2 * FF2 + FF + j4) * *(const f32x4*)(r0 + FF + j4);
#pragma unroll
            for (int e = 0; e < 4; ++e) o[4 * hf + e] = cg[e] * sigmoidf_(cg[e]) * cv[e]; }
        u32x4 w; w.x = cvt_pk_bf16(o[0], o[1]); w.y = cvt_pk_bf16(o[2], o[3]); w.z = cvt_pk_bf16(o[4], o[5]); w.w = cvt_pk_bf16(o[6], o[7]);
        *(u32x4*)(ACT + (size_t)(pm * 256 + r) * FF + j0) = w; }
}

#ifndef MK_N_LAUNCHES
#define MK_N_LAUNCHES 1
#endif
constexpr int N_PHASES = 11;
#ifndef DUP_PHASE
#define DUP_PHASE -1
#endif
#define NREP(k) ((DUP_PHASE) == (k) ? 2 : 1)
constexpr int N_LAUNCHES = MK_N_LAUNCHES;
static_assert(N_LAUNCHES == 1 || N_LAUNCHES == N_PHASES, "MK_N_LAUNCHES is 1 or 11");

__global__ void __launch_bounds__(NWAVES * 64, 2) fwd_kernel(Args args) {
    extern __shared__ __attribute__((aligned(16))) unsigned char lds_raw[];
    LAS unsigned char* lds = (LAS unsigned char*)lds_raw;
    volatile LAS unsigned* MISC = (volatile LAS unsigned*)(lds + MISC_OFF);
    const int tid0 = threadIdx.x, wave0 = __builtin_amdgcn_readfirstlane(tid0 >> 6);
    const int G = gridDim.x; const int bx = blockIdx.x; const int vcu = (G % 8 == 0) ? (bx % 8) * (G / 8) + bx / 8 : bx;
    const int NGW = G * NWAVES;
    unsigned char* ws = args.ws;
    gu32* ctl = (gu32*)(ws + WS_CTL);
    for (int u = tid0; u < 128; u += NWAVES * 64) ((LAS unsigned*)(lds + MISC_OFF))[u] = 0u;
    __syncthreads();
    XcdBarrier bar; bar.bar = (unsigned*)(ctl + CW_BAR); bar.x = 0; bar.st = nullptr;
    if (N_LAUNCHES == 1) bar = xcd_barrier_post((unsigned*)(ctl + CW_BAR) + args.li * XCD_BAR_WORDS, MISC + 8);
#ifdef DOUBLE_BAR
#define GRID_BAR() do { if (N_LAUNCHES == 1) { xcd_barrier(bar); xcd_barrier(bar); } } while (0)
#else
#define GRID_BAR() do { if (N_LAUNCHES == 1) xcd_barrier(bar); } while (0)
#endif
    const int lo = args.ph_lo, hi = args.ph_hi;
#define IN(k) (lo <= (k) && (k) < hi)
#define WSBASE() GAS unsigned char* wsl = (GAS unsigned char*)ws; asm volatile("" : "+s"(wsl));     int tid = threadIdx.x; asm volatile("" : "+v"(tid)); const int lane = tid & 63, wave = __builtin_amdgcn_readfirstlane(tid >> 6), gw = vcu * NWAVES + wave; (void)lane; (void)gw
#define ROPE_ ((float*)(wsl + WS_ROPE))
#define SSMC_ ((float*)(wsl + WS_SSMC))
#define WIN ((bf16*)(wsl + WS_WIN))
#define WOUT ((bf16*)(wsl + WS_WOUT))
#define WXQ ((bf16*)(wsl + WS_WXQ))
#define WXKV ((bf16*)(wsl + WS_WXKV))
#define WXO ((bf16*)(wsl + WS_WXO))
#define WUP ((bf16*)(wsl + WS_WUP))
#define WDOWN ((bf16*)(wsl + WS_WDOWN))
#define WGLU ((bf16*)(wsl + WS_WGLU))
#define XN ((bf16*)(wsl + WS_XN))
#define MEMN ((bf16*)(wsl + WS_MEMN))
#define Qb ((bf16*)(wsl + WS_Q))
#define Kb ((bf16*)(wsl + WS_K))
#define VT ((bf16*)(wsl + WS_VT))
#define U_ ((float*)(wsl + WS_U))
#define AO ((bf16*)(wsl + WS_AO))
#define LSE ((float*)(wsl + WS_LSE))
#define SSMF ((float*)(wsl + WS_SSMF))
#define MIXED ((bf16*)(wsl + WS_MIXED))
#define H1B ((bf16*)(wsl + WS_H1B))
#define SS1 ((float*)(wsl + WS_CTL + CTL_RS1))
#define QX ((bf16*)(wsl + WS_QX))
#define QSS ((float*)(wsl + WS_CTL + CTL_QS))
#define MSS ((float*)(wsl + WS_MSS))
#define MEMK ((bf16*)(wsl + WS_MEMK))
#define MVT ((bf16*)(wsl + WS_MVT))
#define OX ((bf16*)(wsl + WS_OX))
#define H2B ((bf16*)(wsl + WS_H2B))
#define SS2 ((float*)(wsl + WS_CTL + CTL_RS2))
#define UP ((bf16*)(wsl + WS_UP))
#define ACT ((bf16*)(wsl + WS_ACT))
#define SS1S (SS1 + MP)
#define QSSS (QSS + (size_t)MP * 4)
#define SS2S (SS2 + MP)
    float* out = args.out;

    if (IN(0)) for (int rep_ = 0; rep_ < NREP(0); ++rep_) { WSBASE();
        LAS float* scr = (LAS float*)(lds + wave * 16384);
        constexpr int I_IN = 16 * (INW / 32), I_SQ = 16 * (D / 32), I_KV = 16 * (2048 / 32), I_UP = 16 * (FF2 / 32), I_DN = (FF / 64) * (D / 32), I_GL = 4 * 8;
        constexpr int NIT = I_IN + 3 * I_SQ + I_KV + I_UP + I_DN + I_GL;
        for (int it = gw; it < NIT; it += NGW) {
            int r = it;
            if (r < I_IN) { p0_transpose_item<1>(args.in[I_WIN], D, INW, WIN, nullptr, scr, r, lane); continue; } r -= I_IN;
            if (r < I_SQ) { p0_transpose_item<0>(args.in[I_WOUT], D, D, WOUT, nullptr, scr, r, lane); continue; } r -= I_SQ;
            if (r < I_SQ) { p0_transpose_item<0>(args.in[I_WXQ], D, D, WXQ, args.in[I_NX], scr, r, lane); continue; } r -= I_SQ;
            if (r < I_SQ) { p0_transpose_item<0>(args.in[I_WXO], D, D, WXO, nullptr, scr, r, lane); continue; } r -= I_SQ;
            if (r < I_KV) { p0_transpose_item<0>(args.in[I_WXKV], D, 2048, WXKV, nullptr, scr, r, lane); continue; } r -= I_KV;
            if (r < I_UP) { p0_transpose_item<2>(args.in[I_WUP], D, FF2, WUP, args.in[I_NFFN], scr, r, lane); continue; } r -= I_UP;
            if (r < I_DN) { p0_transpose_item<0>(args.in[I_WDOWN], FF, D, WDOWN, nullptr, scr, r, lane); continue; } r -= I_DN;
            p0_transpose_item<0>(args.in[I_WGLU], 256, 256, WGLU, nullptr, scr, r, lane);
        }
        { f32x4 gg[4];
#pragma unroll
          for (int j = 0; j < 4; ++j) gg[j] = ((const f32x4*)args.in[I_NMIX])[lane + 64 * j];
          for (int m = 2 * gw; m < MT; m += 2 * NGW) { const float* x0 = m < MP ? args.in[I_XP] + (size_t)m * D : args.in[I_XS] + (size_t)(m - MP) * D;
              rms_rows2_to_bf16(x0, x0 + D, gg, XN + (size_t)m * D, XN + (size_t)(m + 1) * D, lane); }
#pragma unroll
          for (int j = 0; j < 4; ++j) gg[j] = ((const f32x4*)args.in[I_NMEM])[lane + 64 * j];
          for (int m = 2 * gw; m < MM; m += 2 * NGW) rms_rows2_to_bf16(args.in[I_MEM] + (size_t)m * D, args.in[I_MEM] + (size_t)(m + 1) * D, gg, MEMN + (size_t)m * D, MEMN + (size_t)(m + 1) * D, lane); }
        {
            const int gt = vcu * (NWAVES * 64) + tid;
            if (gt < 2052 * 8) { const int pos = gt >> 3, i = gt & 7; const float iv = i == 0 ? 1.0f : i == 1 ? 0.1939227432012558f : i == 2 ? 0.03760603070259094f : i == 3 ? 0.007292664609849453f : i == 4 ? 0.0014142135623842478f : i == 5 ? 0.00027424818836152554f : i == 6 ? 5.3182957344688475e-05f : 1.0313385246263351e-05f;
                const float ang = (float)pos * iv; double s, c; sincos_d((double)ang, s, c); ROPE_[pos * 16 + i] = (float)c; ROPE_[pos * 16 + 8 + i] = (float)s; }
            const int st = gt - 2052 * 8;
            if (st >= 0 && st < 1024) {
                const int g = st >> 6; const double dt = exp_d((double)args.in[I_LDT][g]); const double lr = (double)args.in[I_LRE][st], li = (double)args.in[I_LIM][st];
                const double mag = exp_d(lr * dt); double s, c; sincos_d(li * dt, s, c); const double are = mag * c, aim = mag * s;
                const double den = lr * lr + li * li, nr = are - 1.0, ni = aim; const double cre = (nr * lr + ni * li) / den, cim = (ni * lr - nr * li) / den;
                const double mag64 = exp_d(64.0 * lr * dt); double s64, c64; sincos_d(64.0 * li * dt, s64, c64);
                float* o = SSMC_ + (size_t)st * 8; o[0] = (float)are; o[1] = (float)aim; o[2] = (float)cre; o[3] = (float)cim; o[4] = (float)(mag64 * c64); o[5] = (float)(mag64 * s64); o[6] = 0.f; o[7] = 0.f; }
        }
        GRID_BAR();
    }

    if (IN(1)) for (int rep_ = 0; rep_ < NREP(1); ++rep_) { WSBASE();
        int base = 0;
        { pg8::Gemm g{XN, WIN, MT, INW, D}; pg8::RotOrder S; S.init(MT, INW, G, bx, base); base += S.nwg;
          pg8::EpiZ E{Qb, Kb, VT, U_, ROPE_, args.in[I_QN], args.in[I_KN], out};
          pg8::gemm_phase<pg8::EpiZ, pg8::RotOrder, true, true>(lds, g, S, E); }
        { pg8::Gemm g{MEMN, WXKV, MM, 2048, D}; pg8::RotOrder S; S.init(MM, 2048, G, bx, base); base += S.nwg;
          pg8::EpiMem E{out + O_MEMKV, MSS, MVT}; pg8::gemm_phase<pg8::EpiMem, pg8::RotOrder, true, true>(lds, g, S, E); }
        GRID_BAR();
    }

    if (IN(2)) for (int rep_ = 0; rep_ < NREP(2); ++rep_) { WSBASE();
        LAS float* uL = (LAS float*)(lds + wave * 4096);
        const int swapo = (bx >> 3) & 1;
#pragma unroll 1
        for (int pass = 0; pass < 2; ++pass) {
            if (pass == swapo) {
                for (int it = vcu; it < 3 * 256; it += G) pattn_wg_item(Qb, Kb, VT, AO, LSE, lds, it, wave, lane, tid);
            } else {
                if (wave < 6) { for (int it = vcu * 6 + wave; it < 3 * 512; it += G * 6) sattn_item(args, Qb, AO, LSE, it, lane); }
                else { if (rep_ == 0) for (int it = vcu * 2 + (wave - 6); it < MM; it += G * 2) memk_fix_item(out + O_MEMKV, MSS, args.in[I_XKN], args.in[I_XQN], MEMK, it, lane);
                       for (int it = vcu * 2 + (wave - 6); it < 8 * 31 * 16; it += G * 2) ssm_a_item(args, U_, SSMC_, SSMF, uL, it, lane); }
            }
            __syncthreads();
        }
        GRID_BAR();
    }

    if (IN(3)) for (int rep_ = 0; rep_ < NREP(3); ++rep_) { WSBASE();
#if defined(PROBE_LDS_FILL)
        for (int u_ = tid; u_ < 134656 / 4; u_ += NWAVES * 64) ((LAS unsigned*)lds)[u_] = PROBE_LDS_FILL;
        __syncthreads();
#endif
#if defined(PROBE_DELAY_P3)
        for (int i_ = 0; i_ < 10; ++i_) __builtin_amdgcn_s_sleep(127);
        __builtin_amdgcn_fence(__ATOMIC_ACQUIRE, "agent"); asm volatile("s_waitcnt vmcnt(0)" ::: "memory"); __syncthreads();
#endif
        for (int r1_ = 0; r1_ < ((DUP_PHASE) == 31 ? 2 : 1); ++r1_)
        if (G > 64) {
            if (vcu >= 32) { const int ncw = (G - 32) * NWAVES; for (int R = ((vcu - 32) * NWAVES + wave) * 8; R < MT; R += ncw * 8) combine_rows<8>(AO, LSE, args.in[I_AON], MIXED, R, lane); }
        } else { for (int R = gw * 4; R < MT; R += NGW * 4) combine_rows<4>(AO, LSE, args.in[I_AON], MIXED, R, lane); }
#if defined(PROBE_P3_TWICE)
        for (int it = vcu; it < 256; it += G) ssm_c_item(args, U_, SSMC_, SSMF, WGLU, (bf16*)(wsl + 644 * MiB), lds, it, wave, lane);
#endif
        for (int r2_ = 0; r2_ < ((DUP_PHASE) == 32 ? 2 : 1); ++r2_)
        for (int it = vcu; it < 256; it += G) ssm_c_item(args, U_, SSMC_, SSMF, WGLU, MIXED, lds, it, wave, lane);
        GRID_BAR();
    }

    if (IN(4)) for (int rep_ = 0; rep_ < NREP(4); ++rep_) { WSBASE();
        pg8::Gemm g{MIXED, WOUT, MP, D, D}; pg8::RotOrder S; S.init(MP, D, G, bx, 0);
        pg8::EpiRes<false, false> E{args.in[I_XP], nullptr, H1B, SS1}; pg8::gemm_phase<pg8::EpiRes<false, false>, pg8::RotOrder, true, true>(lds, g, S, E);
        for (int tile = bx; tile < 256; tile += G)
            sample_gemm_tile<0, false>(MIXED + (size_t)MP * D, WOUT, D, args.in[I_XS], nullptr, H1B + (size_t)MP * D, SS1S, lds, tile, wave, lane, tid);
        GRID_BAR();
    }
    if (IN(5)) for (int rep_ = 0; rep_ < NREP(5); ++rep_) { WSBASE();
        pg8::Gemm g{H1B, WXQ, MP, D, D}; pg8::RotOrder S; S.init(MP, D, G, bx, 0);
        pg8::EpiQx E{QX, QSS}; pg8::gemm_phase<pg8::EpiQx, pg8::RotOrder, true, true>(lds, g, S, E);
        for (int tile = bx; tile < 256; tile += G)
            sample_gemm_tile<1>(H1B + (size_t)MP * D, WXQ, D, nullptr, nullptr, QX + (size_t)MP * D, QSSS, lds, tile, wave, lane, tid);
        GRID_BAR();
    }
    if (IN(6)) for (int rep_ = 0; rep_ < NREP(6); ++rep_) { WSBASE();
        if (tid < 8) ((LAS unsigned*)(lds + MISC_OFF))[16 + tid] = 0u;
        __syncthreads();
        for (int r2_ = 0; r2_ < ((DUP_PHASE) == 61 ? 2 : 1); ++r2_) {
            int slot = 0;
            for (int pair = vcu; pair < BS * 4; pair += G, ++slot) sxattn_stream<8>(args, QX, SS1, QSS, OX, lds, (LAS unsigned*)(lds + MISC_OFF) + 16 + (slot & 7), pair, slot & 1, wave, lane);
        }
        __syncthreads();
        { int tid2 = threadIdx.x; asm volatile("" : "+v"(tid2)); const int lane2 = tid2 & 63, wave2 = __builtin_amdgcn_readfirstlane(tid2 >> 6);
          GAS unsigned char* wsl2 = (GAS unsigned char*)ws; asm volatile("" : "+s"(wsl2));
        for (int r2_ = 0; r2_ < ((DUP_PHASE) == 62 ? 2 : 1); ++r2_)
        for (int it = vcu; it < 8 * 4 * 8; it += G) xattn_wg_item((bf16*)(wsl2 + WS_QX), (float*)(wsl2 + WS_CTL + CTL_RS1), (float*)(wsl2 + WS_CTL + CTL_QS), (bf16*)(wsl2 + WS_MEMK), (bf16*)(wsl2 + WS_MVT), (bf16*)(wsl2 + WS_OX), lds, it, wave2, lane2, tid2); }
        GRID_BAR();
    }
    if (IN(7)) for (int rep_ = 0; rep_ < NREP(7); ++rep_) { WSBASE();
        pg8::Gemm g{OX, WXO, MP, D, D}; pg8::RotOrder S; S.init(MP, D, G, bx, 0);
        pg8::EpiRes<true, false> E{H1B, nullptr, H2B, SS2}; pg8::gemm_phase<pg8::EpiRes<true, false>, pg8::RotOrder, true, true>(lds, g, S, E);
        for (int tile = bx; tile < 256; tile += G)
            sample_gemm_tile<0, true>(OX + (size_t)MP * D, WXO, D, H1B + (size_t)MP * D, nullptr, H2B + (size_t)MP * D, SS2S, lds, tile, wave, lane, tid);
        GRID_BAR();
    }
    if (IN(8)) for (int rep_ = 0; rep_ < NREP(8); ++rep_) { WSBASE();
        pg8::Gemm g{H2B, WUP, MT, FF2, D}; pg8::RotOrder S; S.init(MT, FF2, G, bx, 0);
        pg8::EpiUpConv E{ACT, (float*)(wsl + WS_EDGE), SS2, args.in[I_CONVW], args.in[I_CONVB], args.in[I_SCONV], out + O_CONVP, out + O_CONVS, lds}; pg8::gemm_phase<pg8::EpiUpConv, pg8::RotOrder, true, true>(lds, g, S, E);
        GRID_BAR();
    }
    if (IN(10)) for (int rep_ = 0; rep_ < NREP(10); ++rep_) { WSBASE();
        pg8::Gemm g{ACT, WDOWN, MP, D, FF}; pg8::RotOrder S; S.init(MP, D, G, bx, 0);
        { pg8::Unit uu; for (int i = 0; S.next(i, uu); ++i) if ((uu.pm & 7) != 0) conv_fix_tile(args, (const float*)(wsl + WS_EDGE), ACT, uu.pm, tid);
          VM_WAIT(); __syncthreads(); }
        pg8::EpiRes<true, true> E{H2B, out, nullptr, nullptr}; pg8::gemm_phase<pg8::EpiRes<true, true>, pg8::RotOrder, true, true>(lds, g, S, E);
        for (int tile = bx; tile < 256; tile += G)
            sample_gemm_tile<0, true>(ACT + (size_t)MP * FF, WDOWN, FF, H2B + (size_t)MP * D, out + (size_t)MP * D, nullptr, nullptr, lds, tile, wave, lane, tid);
    }
#if defined(DBG_SCALE_MASK)
    if (hi == N_PHASES) { GRID_BAR();
        const size_t offs[16] = {O_YP, O_YS, O_KV1P, O_KV4P, O_KV16P, O_SREP, O_SIMP, O_CONVP, O_MEMKV, O_KV1S, O_KV4S, O_KV16S, O_SRES, O_SIMS, O_CONVS, O_END};
        const size_t gt = (size_t)vcu * (NWAVES * 64) + tid, NT = (size_t)G * NWAVES * 64;
#pragma unroll
        for (int o = 0; o < 15; ++o) if ((DBG_SCALE_MASK >> o) & 1) { for (size_t i = offs[o] + gt; i < offs[o + 1]; i += NT) out[i] *= 3.0f; }
    }
#endif
#undef IN
#undef GRID_BAR
}


#if defined(PROBE_DET) || defined(PROBE_P3_TWICE)
__global__ void det_cmp_kernel(const unsigned* a, const unsigned* b, size_t nwords, unsigned* counter, int tol, int rw, int lo, int hi) {
    unsigned c = 0;
    for (size_t i = (size_t)blockIdx.x * blockDim.x + threadIdx.x; i < nwords; i += (size_t)gridDim.x * blockDim.x) {
        if (rw > 0) { const int cw = (int)(i % (size_t)rw); if (cw < lo || cw >= hi) continue; }
        const unsigned x = a[i], y = b[i];
        if (tol) { const float fx = __uint_as_float(x), fy = __uint_as_float(y); if (!(fabsf(fx - fy) <= 0.02f)) ++c; } else if (x != y) { ++c; atomicMin(counter + 32, (unsigned)i); atomicMax(counter + 48, (unsigned)i); } }
    if (c) atomicAdd(counter, c);
}
__global__ void det_mark_kernel(const unsigned* counters, int nreg, float* y, size_t n, int forced) {
    int r = -1; for (int i = nreg - 1; i >= 0; --i) if (counters[i] != 0u) r = i;
#if defined(PROBE_DET_COUNT)
    { const unsigned c = counters[PROBE_DET_COUNT], fw = counters[32 + PROBE_DET_COUNT], lw = counters[48 + PROBE_DET_COUNT]; const int fitem = (int)(fw / 512u) / 64, litem = (int)(lw / 512u) / 64;
      r = -1;
      if (c) { switch (PROBE_DET_MODE) { case 1: r = (int)(c >> 10); break; case 2: r = fitem >> 4; break; case 3: r = fitem & 15; break; case 4: r = litem - fitem; break; case 5: r = (int)((fw / 512u) & 63) >> 2; break; case 6: r = (int)(fw & 511u) >> 5; break; default: r = 0; } if (r > 21) r = 21; } }
#endif
    if (forced >= 0) r = forced;
#if defined(PROBE_CAL)
    r = (int)((wall_clock64() >> 12) & 1) ? 19 : -1;
#endif
    if (r < 0) return;
    const float f = 1.0f + 0.1f * (float)(r + 1);
    for (size_t i = (size_t)blockIdx.x * blockDim.x + threadIdx.x; i < n; i += (size_t)gridDim.x * blockDim.x) y[i] *= f;
}
#endif

extern "C" void kernel_launch(void* const* d_in, const int* in_sizes, int n_in, void* d_out, int out_size, void* d_ws, size_t ws_size, hipStream_t stream) {
    static int grid = 0;
    if (grid == 0) {
        if (n_in != 39 || (size_t)out_size != O_END || ws_size < WS_END) { fprintf(stderr, "kernel_launch: unexpected problem shape (n_in %d, out %d, ws %zu); nothing launched\n", n_in, out_size, ws_size); grid = -1; return; }
        int dev = 0, cus = 0, per_cu = 0;
        if (hipGetDevice(&dev) != hipSuccess || hipDeviceGetAttribute(&cus, hipDeviceAttributeMultiprocessorCount, dev) != hipSuccess) { grid = -1; return; }
        if (hipFuncSetAttribute((const void*)fwd_kernel, hipFuncAttributeMaxDynamicSharedMemorySize, LDS_BYTES) != hipSuccess) { fprintf(stderr, "kernel_launch: hipFuncSetAttribute failed\n"); grid = -1; return; }
        if (hipOccupancyMaxActiveBlocksPerMultiprocessor(&per_cu, (const void*)fwd_kernel, NWAVES * 64, LDS_BYTES) != hipSuccess || per_cu < 1) { fprintf(stderr, "kernel_launch: occupancy query says %d workgroups per CU\n", per_cu); (void)hipGetLastError(); grid = -1; return; }
        grid = cus;
    }
    if (grid < 0) return;
    (void)hipMemsetAsync((char*)d_ws + WS_CTL, 0, CTL_ZERO_BYTES, stream);
    Args a{};
    for (int i = 0; i < 39; ++i) a.in[i] = (const float*)d_in[i];
    a.out = (float*)d_out; a.ws = (unsigned char*)d_ws;
#if defined(PROBE_PRE_HI)
    a.ph_lo = 0; a.ph_hi = PROBE_PRE_HI; a.li = 1; a.pad = 0;
    hipLaunchKernelGGL(fwd_kernel, dim3(grid), dim3(NWAVES * 64), LDS_BYTES, stream, a);
    (void)hipMemsetAsync((char*)d_ws + WS_CTL, 0, CTL_ZERO_BYTES, stream);
#endif
#if defined(PROBE_DET)
    {
        const size_t SP = 644 * MiB, need = 1005 * MiB;
        char* w = (char*)d_ws; float* o = (float*)d_out;
        if (ws_size >= need) {
            a.ph_lo = 0; a.ph_hi = N_PHASES; a.li = 0; a.pad = 0;
            hipLaunchKernelGGL(fwd_kernel, dim3(grid), dim3(NWAVES * 64), LDS_BYTES, stream, a);
#if defined(PROBE_DUMP)
            (void)hipMemcpyAsync(w + SP + 190 * MiB, w + 191 * MiB, 33 * MiB, hipMemcpyDeviceToDevice, stream);
            (void)hipMemcpyAsync(w + 760 * MiB, w + 724 * MiB, 34 * MiB, hipMemcpyDeviceToDevice, stream);
#else
            (void)hipMemcpyAsync(w + SP, w + 1 * MiB, 223 * MiB, hipMemcpyDeviceToDevice, stream);
            (void)hipMemcpyAsync(w + SP + 223 * MiB, w + 295 * MiB, 4 * MiB, hipMemcpyDeviceToDevice, stream);
            (void)hipMemcpyAsync(w + SP + 227 * MiB, d_out, O_END * 4, hipMemcpyDeviceToDevice, stream);
#endif
#if defined(PROBE_DET_POISON)
            (void)hipMemsetAsync(w + PROBE_DET_POISON_LO * MiB, 0xAA, (size_t)(PROBE_DET_POISON_HI - PROBE_DET_POISON_LO) * MiB, stream);
#endif
            (void)hipMemsetAsync(w + WS_CTL, 0, CTL_ZERO_BYTES, stream);
        }
    }
#endif
    for (int li = 0; li < N_LAUNCHES; ++li) {
        a.li = 0; a.pad = 0;
        a.ph_lo = (N_LAUNCHES == 1) ? 0 : li; a.ph_hi = (N_LAUNCHES == 1) ? N_PHASES : li + 1;
        hipLaunchKernelGGL(fwd_kernel, dim3(grid), dim3(NWAVES * 64), LDS_BYTES, stream, a);
        const hipError_t le = hipPeekAtLastError();
        if (le != hipSuccess) { fprintf(stderr, "kernel_launch: launch %d failed: %s\n", li, hipGetErrorName(le)); break; }
    }
#if defined(PROBE_P3_TWICE)
    {   char* w = (char*)d_ws; float* o = (float*)d_out; unsigned* cnt = (unsigned*)(w + 643 * MiB + 900 * 1024);
        (void)hipMemsetAsync(cnt, 0, 256, stream); (void)hipMemsetAsync(cnt + 32, 0xFF, 64, stream);
        hipLaunchKernelGGL(det_cmp_kernel, dim3(2048), dim3(256), 0, stream, (const unsigned*)(w + WS_MIXED), (const unsigned*)(w + 644 * MiB), (size_t)MP * D * 2 / 4, cnt + PROBE_DET_COUNT, 0, 512, 384, 512);
        hipLaunchKernelGGL(det_mark_kernel, dim3(32), dim3(256), 0, stream, cnt, 1, o + O_SREP, (size_t)BP * 1024, -1);
    }
#endif
#if defined(PROBE_DET)
    {
        const size_t SP = 644 * MiB, need = 1005 * MiB;
        char* w = (char*)d_ws; float* o = (float*)d_out; unsigned* cnt = (unsigned*)(w + 640 * MiB);
        cnt = (unsigned*)(w + 643 * MiB + 900 * 1024);
        if (ws_size < need) { hipLaunchKernelGGL(det_mark_kernel, dim3(1024), dim3(256), 0, stream, cnt, 0, o, (size_t)MP * D, 19); }
        else {
            (void)hipMemsetAsync(cnt, 0, 256, stream); (void)hipMemsetAsync(cnt + 32, 0xFF, 64, stream);
            const char* c0 = w + SP - 1 * MiB;
            const float* oc = (const float*)(w + SP + 227 * MiB);
            struct Reg { const void* a; const void* b; size_t bytes; int tol; };
            struct Reg2 { const void* a; const void* b; size_t bytes; int rw, lo, hi; };
#if defined(PROBE_DUMP)
            const Reg2 regs[5] = {
                {w + 724 * MiB, w + 760 * MiB, (size_t)8 * MiB, 0, 0, 0}, {w + 741 * MiB, w + 777 * MiB, (size_t)2 * MiB, 0, 0, 0},
                {w + WS_MIXED, c0 + WS_MIXED, (size_t)MP * D * 2, 512, 384, 512}, {w + WS_MIXED, c0 + WS_MIXED, (size_t)MP * D * 2, 512, 384, 512}, {w + WS_MIXED, c0 + WS_MIXED, (size_t)MP * D * 2, 512, 384, 512} };
#else
            const Reg2 regs[14] = {
                {w + WS_U, c0 + WS_U, (size_t)MT * 256 * 4, 0, 0, 0}, {w + WS_Q, c0 + WS_Q, (size_t)MT * 768 * 2, 0, 0, 0}, {w + WS_K, c0 + WS_K, (size_t)MT * 768 * 2, 0, 0, 0}, {w + WS_VT, c0 + WS_VT, (size_t)MP * 768 * 2, 0, 0, 0},
                {o + O_KV1P, oc + O_KV1P, (O_SREP - O_KV1P) * 4, 0, 0, 0}, {o + O_MEMKV, oc + O_MEMKV, (O_KV1S - O_MEMKV) * 4, 0, 0, 0}, {o + O_KV1S, oc + O_KV1S, (O_SRES - O_KV1S) * 4, 0, 0, 0},
                {w + WS_SSMF, c0 + WS_SSMF, 2 * MiB, 0, 0, 0}, {w + WS_AO, c0 + WS_AO, (size_t)MT * 768 * 2, 0, 0, 0}, {w + WS_LSE, c0 + WS_LSE, (size_t)MT * 12 * 4, 0, 0, 0}, {w + WS_MEMK, w + SP + 223 * MiB, 4 * MiB, 0, 0, 0},
                {o + O_SREP, oc + O_SREP, (O_CONVP - O_SREP) * 4, 0, 0, 0}, {o + O_SRES, oc + O_SRES, (O_CONVS - O_SRES) * 4, 0, 0, 0}, {w + WS_MIXED, c0 + WS_MIXED, (size_t)MT * D * 2, 0, 0, 0} };
#endif
            for (int r = 0; r < (int)(sizeof(regs) / sizeof(regs[0])); ++r) hipLaunchKernelGGL(det_cmp_kernel, dim3(2048), dim3(256), 0, stream, (const unsigned*)regs[r].a, (const unsigned*)regs[r].b, regs[r].bytes / 4, cnt + r, 0, regs[r].rw, regs[r].lo, regs[r].hi);
            hipLaunchKernelGGL(det_mark_kernel, dim3(32), dim3(256), 0, stream, cnt, 14, o + O_SREP, (size_t)BP * 1024, -1);
        }
    }
#endif
}
```

```cpp
#include <hip/hip_runtime.h>
#include <cstdio>
#include <cstdint>

#define GAS __attribute__((address_space(1)))
#define LAS __attribute__((address_space(3)))
#define PG8_LAS __attribute__((address_space(3)))
typedef unsigned short bf16;
typedef short bf16x8 __attribute__((ext_vector_type(8)));
typedef float f32x4 __attribute__((ext_vector_type(4)));
typedef float f32x2 __attribute__((ext_vector_type(2)));
typedef float f32x16 __attribute__((ext_vector_type(16)));
typedef unsigned u32x4 __attribute__((ext_vector_type(4)));
typedef unsigned u32x2 __attribute__((ext_vector_type(2)));
typedef GAS unsigned gu32;
#define RLX_AGENT __ATOMIC_RELAXED, __HIP_MEMORY_SCOPE_AGENT
#define LDS_WAIT() asm volatile("s_waitcnt lgkmcnt(0)" ::: "memory")
#define VM_WAIT() asm volatile("s_waitcnt vmcnt(0)" ::: "memory")

constexpr int D = 1024, BP = 8, LP = 2048, MP = BP * LP, BS = 128, TS = 4, MS = BS * TS, MT = MP + MS;
constexpr int INW = 2560, AW = 768, SW = 256, NMEM = 256, MM = BP * NMEM, FF = 2816, FF2 = 5632;
constexpr float EPS = 1e-6f;
constexpr float LOG2E = 1.4426950408889634f, LN2 = 0.6931471805599453f;
constexpr int NWAVES = 8;

constexpr size_t MiB = 1u << 20;
constexpr size_t WS_CTL = 0, CTL_ZERO_BYTES = 1 * MiB;
constexpr size_t WS_ROPE = 1 * MiB;
constexpr size_t WS_SSMC = 1 * MiB + 512 * 1024;
constexpr size_t WS_WIN = 2 * MiB, WS_WOUT = 7 * MiB, WS_WXQ = 9 * MiB, WS_WXKV = 11 * MiB, WS_WXO = 15 * MiB, WS_WUP = 17 * MiB, WS_WDOWN = 28 * MiB, WS_WGLU = 34 * MiB;
constexpr size_t WS_XN = 35 * MiB, WS_MEMN = 68 * MiB, WS_Q = 72 * MiB, WS_K = 97 * MiB, WS_VT = 122 * MiB, WS_U = 146 * MiB, WS_AO = 163 * MiB, WS_LSE = 188 * MiB;
constexpr size_t WS_SSMF = 189 * MiB, WS_MIXED = 191 * MiB, WS_H1B = 224 * MiB, WS_SS1 = 257 * MiB, WS_QX = 259 * MiB, WS_QSS = 292 * MiB, WS_MSS = 294 * MiB, WS_MEMK = 295 * MiB, WS_MVT = 299 * MiB;
constexpr size_t WS_OX = 303 * MiB, WS_H2B = 336 * MiB, WS_SS2 = 369 * MiB, WS_UP = 371 * MiB, WS_ACT = 553 * MiB, WS_END = 644 * MiB;
constexpr size_t WS_EDGE = 371 * MiB;
constexpr size_t WS_SS1S = 258 * MiB + 512 * 1024, WS_QSSS = 293 * MiB + 512 * 1024, WS_SS2S = 370 * MiB + 512 * 1024;
constexpr size_t CTL_RS1 = 128 * 1024, CTL_RS2 = 256 * 1024, CTL_QS = 384 * 1024;
constexpr int CW_BAR = 4096;

constexpr int RING_BYTES = 131072;
constexpr int MISC_OFF = 135168;
constexpr int LDS_BYTES = 147456;

__device__ __forceinline__ unsigned f2bf(float f) { unsigned u = __builtin_bit_cast(unsigned, f); return (u + 0x7fffu + ((u >> 16) & 1u)) >> 16; }
__device__ __forceinline__ unsigned pk2(float lo, float hi) { return f2bf(lo) | (f2bf(hi) << 16); }
__device__ __forceinline__ float bf2f(unsigned h) { return __builtin_bit_cast(float, h << 16); }
typedef __bf16 bf16v2_t __attribute__((ext_vector_type(2)));
__device__ __forceinline__ unsigned cvt_pk_bf16(float lo, float hi) { const f32x2 v = {lo, hi}; return __builtin_bit_cast(unsigned, __builtin_convertvector(v, bf16v2_t)); }
__device__ __forceinline__ bf16x8 pack8(float a0, float a1, float a2, float a3, float a4, float a5, float a6, float a7) {
    u32x4 w; w.x = cvt_pk_bf16(a0, a1); w.y = cvt_pk_bf16(a2, a3); w.z = cvt_pk_bf16(a4, a5); w.w = cvt_pk_bf16(a6, a7); return __builtin_bit_cast(bf16x8, w); }
__device__ __forceinline__ float wave_sum(float v) {
#pragma unroll
    for (int o = 1; o < 64; o <<= 1) v += __shfl_xor(v, o);
    return v;
}
__device__ __forceinline__ float fexp2(float x) { return __builtin_amdgcn_exp2f(x); }
__device__ __forceinline__ float flog2(float x) { return __builtin_amdgcn_logf(x); }
__device__ __forceinline__ float frcp(float x) { return __builtin_amdgcn_rcpf(x); }
__device__ __forceinline__ float frsq(float x) { return __builtin_amdgcn_rsqf(x); }
__device__ __forceinline__ void sincos_d(double x, double& s, double& c) {
    const double k = __builtin_rint(x * 0.63661977236758134308);
    double r = __builtin_fma(-k, 1.57079632679489655800e+00, x); r = __builtin_fma(-k, 6.12323399573676603587e-17, r);
    const long long q = (long long)k; const double r2 = r * r;
    double sp = 1.0 / 6227020800.0; sp = sp * r2 - 1.0 / 39916800.0; sp = sp * r2 + 1.0 / 362880.0; sp = sp * r2 - 1.0 / 5040.0; sp = sp * r2 + 1.0 / 120.0; sp = sp * r2 - 1.0 / 6.0; sp = sp * r2 + 1.0; sp = sp * r;
    double cp = -1.0 / 87178291200.0; cp = cp * r2 + 1.0 / 479001600.0; cp = cp * r2 - 1.0 / 3628800.0; cp = cp * r2 + 1.0 / 40320.0; cp = cp * r2 - 1.0 / 720.0; cp = cp * r2 + 1.0 / 24.0; cp = cp * r2 - 0.5; cp = cp * r2 + 1.0;
    const int qq = (int)(q & 3);
    s = (qq == 0) ? sp : (qq == 1) ? cp : (qq == 2) ? -sp : -cp;
    c = (qq == 0) ? cp : (qq == 1) ? -sp : (qq == 2) ? -cp : sp;
}
__device__ __forceinline__ double exp_d(double x) {
    const double k = __builtin_rint(x * 1.44269504088896340736);
    double r = __builtin_fma(-k, 6.93147180369123816490e-01, x); r = __builtin_fma(-k, 1.90821492927058770002e-10, r);
    double p = 1.0 / 6227020800.0;
    p = p * r + 1.0 / 479001600.0; p = p * r + 1.0 / 39916800.0; p = p * r + 1.0 / 3628800.0; p = p * r + 1.0 / 362880.0; p = p * r + 1.0 / 40320.0; p = p * r + 1.0 / 5040.0;
    p = p * r + 1.0 / 720.0; p = p * r + 1.0 / 120.0; p = p * r + 1.0 / 24.0; p = p * r + 1.0 / 6.0; p = p * r + 0.5; p = p * r + 1.0; p = p * r + 1.0;
    const int ki = (int)k;
    return __builtin_ldexp(p, ki);
}
__device__ __forceinline__ float dot4(f32x4 a) { return (a[0] * a[0] + a[1] * a[1]) + (a[2] * a[2] + a[3] * a[3]); }
__device__ __forceinline__ u32x4 pk8(f32x4 a, f32x4 b) { u32x4 w; w.x = cvt_pk_bf16(a[0], a[1]); w.y = cvt_pk_bf16(a[2], a[3]); w.z = cvt_pk_bf16(b[0], b[1]); w.w = cvt_pk_bf16(b[2], b[3]); return w; }
__device__ __forceinline__ f32x4 shx16(f32x4 a) { f32x4 r; r[0] = __shfl_xor(a[0], 16); r[1] = __shfl_xor(a[1], 16); r[2] = __shfl_xor(a[2], 16); r[3] = __shfl_xor(a[3], 16); return r; }
constexpr size_t O_KV1P_ = (size_t)MT * D, O_KV4P_ = O_KV1P_ + (size_t)BP * 128 * 512, O_KV16P_ = O_KV4P_ + (size_t)BP * 512 * 512;
constexpr size_t O_KV1S_ = O_KV16P_ + (size_t)BP * 2048 * 512 + 2 * BP * 1024 + (size_t)BP * 2 * FF2 + (size_t)MM * 2048, O_KV4S_ = O_KV1S_ + (size_t)MS * 512, O_KV16S_ = O_KV4S_ + (size_t)MS * 512;
typedef short s16x4 __attribute__((ext_vector_type(4)));
__device__ __forceinline__ s16x4 lds_tr4(LAS unsigned char* p) { return __builtin_bit_cast(s16x4, __builtin_amdgcn_ds_read_tr16_b64_v4i16((LAS s16x4*)p)); }
__device__ __forceinline__ bf16x8 cat44(s16x4 a, s16x4 b) { return (bf16x8){a[0], a[1], a[2], a[3], b[0], b[1], b[2], b[3]}; }
__device__ __forceinline__ void atomic_addf(float* p, float v) { (void)__hip_atomic_fetch_add(p, v, __ATOMIC_RELAXED, __HIP_MEMORY_SCOPE_AGENT); }

namespace pg8 {
#define PG8_LAS __attribute__((address_space(3)))
typedef unsigned short bf16_t;
typedef short bf16x8 __attribute__((ext_vector_type(8)));
typedef float f32x4 __attribute__((ext_vector_type(4)));
typedef unsigned u32x4 __attribute__((ext_vector_type(4)));
constexpr int BM = 256, BK = 64, HALF = 128, HTB = HALF * BK * 2  , STAGE_BYTES = 8 * HTB, NXCD = 8, WGM = 8;

__host__ __device__ __forceinline__ int lds_byte(int r, int c) { const int st = (r >> 4) * 2 + (c >> 5), rr = r & 15, cc = c & 31, ob = rr * 64 + cc * 2; return st * 1024 + (ob ^ (((ob >> 9) & 1) << 5)); }
__host__ __device__ __forceinline__ void stage_rc(int b, int& R, int& C) { const int st = b / 1024, sb = b % 1024, swz = sb ^ (((sb >> 9) & 1) << 5); R = (st >> 1) * 16 + swz / 64; C = (st & 1) * 32 + (swz % 64) / 2; }
__host__ __device__ __forceinline__ int perm32(int rho) { const int n = rho >> 4, i = rho & 15; return 8 * (i >> 2) + 4 * n + (i & 3); }

struct Unit { int pm, pn; };
struct Gemm { const bf16_t* A; const bf16_t* Bt; int M, N, K; };

struct StaticOrder {
    int nM, nN, nwg, G, c;
    __host__ __device__ void init(int M, int N, int G_, int c_) { nM = M / BM; nN = N / BM; nwg = nM * nN; G = G_; c = c_; }
    __host__ __device__ bool next(int i, Unit& u) const {
        const long L = (long)i * G + c; if (L >= nwg) return false;
        int wgid = (int)L; { const int q = nwg / NXCD, r = nwg % NXCD, xcd = wgid % NXCD, off = wgid / NXCD; wgid = (xcd < r ? xcd * (q + 1) : r * (q + 1) + (xcd - r) * q) + off; }
        const int nig = WGM * nN, gid = wgid / nig, fm = gid * WGM, gsz = (nM - fm) < WGM ? (nM - fm) : WGM;
        u.pm = fm + ((wgid % nig) % gsz); u.pn = (wgid % nig) / gsz; return true;
    }
    __device__ __forceinline__ void a_ready(const Unit&) const {}
    __device__ __forceinline__ void done(const Unit&) const {}
};


struct RotOrder {
    int nM, nN, nwg, G, c;
    __host__ __device__ void init(int M, int N, int G_, int blk, int base) { nM = M / BM; nN = N / BM; nwg = nM * nN; G = G_; const int rot = base % G_; c = blk - rot; if (c < 0) c += G_; }
    __host__ __device__ __forceinline__ bool next(int i, Unit& u) const {
        const long L = (long)i * G + c; if (L >= nwg) return false;
        int wgid = (int)L; { const int q = nwg / NXCD, r = nwg % NXCD, xcd = wgid % NXCD, off = wgid / NXCD; wgid = (xcd < r ? xcd * (q + 1) : r * (q + 1) + (xcd - r) * q) + off; }
        const int nig = WGM * nN, gid = wgid / nig, fm = gid * WGM, gsz = (nM - fm) < WGM ? (nM - fm) : WGM;
        u.pm = fm + ((wgid % nig) % gsz); u.pn = (wgid % nig) / gsz; return true;
    }
    __device__ __forceinline__ void a_ready(const Unit&) const {}
    __device__ __forceinline__ void done(const Unit&) const {}
};


struct EpiZ {
    static constexpr bool PERM = true, AFTER_DRAIN = false, BMAP = false, AMAP = false;
    bf16_t* Q; bf16_t* Kb; bf16_t* VN; float* U; const float* rope; const float* qg; const float* kg;
    float* outp;
    __device__ __forceinline__ int bmap(int r) const { return r; }
    __device__ __forceinline__ void operator()(const f32x4 (&acc)[2][2][4][2], const Unit& u, int wr, int wc, int fr, int fq) const {
        const int pn = u.pn; const bool sample = u.pm >= 64;
        const int rbase = u.pm * BM + wr * 64 + fr;
        if (pn == 9) {
#pragma unroll
            for (int ai = 0; ai < 2; ++ai)
#pragma unroll
                for (int m = 0; m < 4; ++m) { const int R = rbase + ai * HALF + m * 16; float* p = U + (size_t)R * 256 + wc * 64 + 8 * fq;
#pragma unroll
                    for (int bj = 0; bj < 2; ++bj) { *(f32x4*)(p + 32 * bj) = acc[ai][bj][m][0]; *(f32x4*)(p + 32 * bj + 4) = acc[ai][bj][m][1]; } }
            return;
        }
        const int kind = pn / 3, g = pn - 3 * kind;
        const int keep = g == 0 ? 128 : (g == 1 ? 512 : 2048);
        float* kvp = outp + (g == 0 ? O_KV1P_ : (g == 1 ? O_KV4P_ : O_KV16P_)); float* kvs = outp + (g == 0 ? O_KV1S_ : (g == 1 ? O_KV4S_ : O_KV16S_));
        if (kind == 2) {
#pragma unroll
            for (int ai = 0; ai < 2; ++ai)
#pragma unroll
                for (int m = 0; m < 4; ++m) { const int R = rbase + ai * HALF + m * 16; float* dst = nullptr;
                    if (sample) dst = kvs + ((size_t)(R - MP) * 2 + 1) * 256;
                    else { const int b = R >> 11, t = R & 2047; if (t >= 2048 - keep) dst = kvp + ((size_t)(b * keep + t - (2048 - keep)) * 2 + 1) * 256; }
                    if (dst) { dst += wc * 64 + 8 * fq;
#pragma unroll
                        for (int bj = 0; bj < 2; ++bj) { *(f32x4*)(dst + 32 * bj) = acc[ai][bj][m][0]; *(f32x4*)(dst + 32 * bj + 4) = acc[ai][bj][m][1]; } }
                    if (!sample) { bf16_t* vp = VN + (size_t)R * AW + g * 256 + wc * 64 + 8 * fq;
                        *(u32x4*)vp = pk8(acc[ai][0][m][0], acc[ai][0][m][1]); *(u32x4*)(vp + 32) = pk8(acc[ai][1][m][0], acc[ai][1][m][1]); } }
            return;
        }
        const float* gp = (kind == 0 ? qg : kg) + 8 * fq;
        const f32x4 g00 = *(const f32x4*)(gp), g01 = *(const f32x4*)(gp + 4), g10 = *(const f32x4*)(gp + 32), g11 = *(const f32x4*)(gp + 36);
        const float sgn = fq == 0 ? -1.f : 1.f;
        const float qs = kind == 0 ? 0.125f * LOG2E : 1.f;
        bf16_t* ob = kind == 0 ? Q : Kb;
        f32x4 rc0, rc1, rs0, rs1;
        { const int R = rbase; const int pos = sample ? 2048 + (R & 3) : (R & 2047); const float* rp = rope + (size_t)pos * 16; rc0 = *(const f32x4*)rp; rc1 = *(const f32x4*)(rp + 4); rs0 = *(const f32x4*)(rp + 8); rs1 = *(const f32x4*)(rp + 12); }
#pragma unroll
        for (int ai = 0; ai < 2; ++ai)
#pragma unroll
            for (int m = 0; m < 4; ++m) { const int R = rbase + ai * HALF + m * 16;
                const f32x4 c0 = rc0, c1 = rc1, s0 = rs0, s1 = rs1;
                if (ai * 4 + m < 7) { const int Rn = rbase + ((ai * 4 + m + 1) >> 2) * HALF + ((ai * 4 + m + 1) & 3) * 16; const int pos = sample ? 2048 + (Rn & 3) : (Rn & 2047); const float* rp = rope + (size_t)pos * 16;
                    rc0 = *(const f32x4*)rp; rc1 = *(const f32x4*)(rp + 4); rs0 = *(const f32x4*)(rp + 8); rs1 = *(const f32x4*)(rp + 12); }
                float ss = (dot4(acc[ai][0][m][0]) + dot4(acc[ai][0][m][1])) + (dot4(acc[ai][1][m][0]) + dot4(acc[ai][1][m][1])); ss += __shfl_xor(ss, 16); ss += __shfl_xor(ss, 32);
                const float rs = frsq(ss * (1.0f / 64.0f) + EPS);
                float* dst = nullptr;
                if (kind == 1) { if (sample) dst = kvs + ((size_t)(R - MP) * 2) * 256; else { const int b = R >> 11, t = R & 2047; if (t >= 2048 - keep) dst = kvp + ((size_t)(b * keep + t - (2048 - keep)) * 2) * 256; }
                    if (dst) dst += wc * 64 + 8 * fq; }
                bf16_t* op = ob + (size_t)R * AW + g * 256 + wc * 64 + 8 * fq;
                f32x4 xa = acc[ai][0][m][0] * rs * g00, xb = acc[ai][0][m][1] * rs * g01;
                { const f32x4 oa = shx16(xa), ob2 = shx16(xb);
                  if (fq < 2) { xa = xa * c0 + (oa * s0) * sgn; xb = xb * c1 + (ob2 * s1) * sgn; } }
                if (dst) { *(f32x4*)(dst) = xa; *(f32x4*)(dst + 4) = xb; }
                *(u32x4*)(op) = pk8(xa * qs, xb * qs);
                xa = acc[ai][1][m][0] * rs * g10; xb = acc[ai][1][m][1] * rs * g11;
                if (dst) { *(f32x4*)(dst + 32) = xa; *(f32x4*)(dst + 36) = xb; }
                *(u32x4*)(op + 32) = pk8(xa * qs, xb * qs);
            }
    }
};

struct EpiVt {
    static constexpr bool PERM = true, AFTER_DRAIN = false, BMAP = true, AMAP = false;
    bf16_t* VT; int g;
    __device__ __forceinline__ int bmap(int r) const { return g == 0 ? r : (g == 1 ? ((r & 63) * 4 + (r >> 6)) : ((r & 15) * 16 + (r >> 4))); }
    __device__ __forceinline__ void operator()(const f32x4 (&acc)[2][2][4][2], const Unit& u, int wr, int wc, int fr, int fq) const {
        const int b = u.pn >> 3, t0 = (u.pn & 7) * 256, sh = 2 * g, S = 2048 >> sh, Wl = 8 - sh;
#pragma unroll
        for (int ai = 0; ai < 2; ++ai)
#pragma unroll
            for (int m = 0; m < 4; ++m) { const int hh = 2 * wr + (m >> 1), d = 32 * ai + 16 * (m & 1) + fr;
#pragma unroll
                for (int bj = 0; bj < 2; ++bj) { const int c8 = 128 * bj + 32 * wc + 8 * fq, res = c8 >> Wl, ds = c8 & ((1 << Wl) - 1), pos = res * S + (t0 >> sh) + ds;
                    bf16_t* p = VT + ((((size_t)((g * 4 + hh) * 8 + b) * 64 + (pos >> 5)) * 64 + d) * 32 + (pos & 31));
                    *(u32x4*)p = pk8(acc[ai][bj][m][0], acc[ai][bj][m][1]); } }
    }
};

struct EpiMem {
    static constexpr bool PERM = true, AFTER_DRAIN = false, BMAP = false, AMAP = false;
    float* out; float* mss; bf16_t* MVN;
    __device__ __forceinline__ int bmap(int r) const { return r; }
    __device__ __forceinline__ void operator()(const f32x4 (&acc)[2][2][4][2], const Unit& u, int wr, int wc, int fr, int fq) const {
        const int kv = u.pn >> 2, h = u.pn & 3;
#pragma unroll
        for (int ai = 0; ai < 2; ++ai)
#pragma unroll
            for (int m = 0; m < 4; ++m) { const int R = u.pm * BM + ai * HALF + wr * 64 + m * 16 + fr; float* dst = out + ((size_t)R * 2 + kv) * 1024 + h * 256 + 32 * wc + 8 * fq; float ss = 0.f;
#pragma unroll
                for (int bj = 0; bj < 2; ++bj) { const f32x4 a = acc[ai][bj][m][0], c = acc[ai][bj][m][1]; *(f32x4*)(dst + 128 * bj) = a; *(f32x4*)(dst + 128 * bj + 4) = c; ss += dot4(a) + dot4(c);
                    if (kv) *(u32x4*)(MVN + (size_t)R * 1024 + h * 256 + 32 * wc + 8 * fq + 128 * bj) = pk8(a, c); }
                if (kv == 0) { ss += __shfl_xor(ss, 16); ss += __shfl_xor(ss, 32); if (fq == 0) mss[(size_t)R * 16 + h * 4 + wc] = ss; } }
    }
};
struct EpiMemVt {
    static constexpr bool PERM = true, AFTER_DRAIN = false, BMAP = false, AMAP = false;
    bf16_t* MVT;
    __device__ __forceinline__ int bmap(int r) const { return r; }
    __device__ __forceinline__ void operator()(const f32x4 (&acc)[2][2][4][2], const Unit& u, int wr, int wc, int fr, int fq) const {
        const int h = u.pm, b = u.pn;
#pragma unroll
        for (int ai = 0; ai < 2; ++ai)
#pragma unroll
            for (int m = 0; m < 4; ++m) { const int d = ai * HALF + wr * 64 + m * 16 + fr;
#pragma unroll
                for (int bj = 0; bj < 2; ++bj) { const int c8 = 128 * bj + 32 * wc + 8 * fq;
                    bf16_t* p = MVT + ((((size_t)(h * 8 + b) * 8 + (c8 >> 5)) * 256 + d) * 32 + (c8 & 31));
                    *(u32x4*)p = pk8(acc[ai][bj][m][0], acc[ai][bj][m][1]); } }
    }
};
template <bool BASE_BF16, bool OUT_F32> struct EpiRes {
    static constexpr bool PERM = true, AFTER_DRAIN = false, BMAP = false, AMAP = false;
    const void* base; float* out; bf16_t* hb; float* ssq;
    __device__ __forceinline__ int bmap(int r) const { return r; }
    __device__ __forceinline__ void operator()(const f32x4 (&acc)[2][2][4][2], const Unit& u, int wr, int wc, int fr, int fq) const {
        const int c0 = u.pn * BM + 32 * wc + 8 * fq;
#pragma unroll
        for (int ai = 0; ai < 2; ++ai) {
            f32x4 b0[4][2], b1[4][2];
#pragma unroll
            for (int m = 0; m < 4; ++m)
#pragma unroll
                for (int bj = 0; bj < 2; ++bj) { const size_t off = (size_t)(u.pm * BM + ai * HALF + wr * 64 + m * 16 + fr) * D + c0 + 128 * bj;
                    if (BASE_BF16) { const u32x4 w = *(const u32x4*)((const bf16_t*)base + off); b0[m][bj] = (f32x4){bf2f(w.x & 0xffffu), bf2f(w.x >> 16), bf2f(w.y & 0xffffu), bf2f(w.y >> 16)}; b1[m][bj] = (f32x4){bf2f(w.z & 0xffffu), bf2f(w.z >> 16), bf2f(w.w & 0xffffu), bf2f(w.w >> 16)}; }
                    else { b0[m][bj] = *(const f32x4*)((const float*)base + off); b1[m][bj] = *(const f32x4*)((const float*)base + off + 4); } }
            asm volatile("" ::: "memory");
#pragma unroll
            for (int m = 0; m < 4; ++m) { const int R = u.pm * BM + ai * HALF + wr * 64 + m * 16 + fr; float ss = 0.f;
#pragma unroll
                for (int bj = 0; bj < 2; ++bj) { const size_t off = (size_t)R * D + c0 + 128 * bj;
                    const f32x4 o0 = b0[m][bj] + acc[ai][bj][m][0], o1 = b1[m][bj] + acc[ai][bj][m][1];
                    if (OUT_F32) { *(f32x4*)(out + off) = o0; *(f32x4*)(out + off + 4) = o1; }
                    if (hb) *(u32x4*)(hb + off) = pk8(o0, o1);
                    ss += dot4(o0) + dot4(o1); }
                if (ssq) { ss += __shfl_xor(ss, 16); ss += __shfl_xor(ss, 32); if (fq == 0) atomic_addf(ssq + R, ss); } }
        }
    }
};
struct EpiQx {
    static constexpr bool PERM = true, AFTER_DRAIN = false, BMAP = false, AMAP = false;
    bf16_t* QX; float* qss;
    __device__ __forceinline__ int bmap(int r) const { return r; }
    __device__ __forceinline__ void operator()(const f32x4 (&acc)[2][2][4][2], const Unit& u, int wr, int wc, int fr, int fq) const {
        const int c0 = u.pn * BM + 32 * wc + 8 * fq;
#pragma unroll
        for (int ai = 0; ai < 2; ++ai)
#pragma unroll
            for (int m = 0; m < 4; ++m) { const int R = u.pm * BM + ai * HALF + wr * 64 + m * 16 + fr; float ss = 0.f;
#pragma unroll
                for (int bj = 0; bj < 2; ++bj) { const f32x4 a = acc[ai][bj][m][0], c = acc[ai][bj][m][1]; *(u32x4*)(QX + (size_t)R * D + c0 + 128 * bj) = pk8(a, c); ss += dot4(a) + dot4(c); }
                ss += __shfl_xor(ss, 16); ss += __shfl_xor(ss, 32); if (fq == 0) atomic_addf(qss + (size_t)R * 4 + u.pn, ss); }
    }
};
template <int CTRL> __device__ __forceinline__ float dppf(float old, float src) { return __builtin_bit_cast(float, __builtin_amdgcn_update_dpp(__builtin_bit_cast(int, old), __builtin_bit_cast(int, src), CTRL, 0xf, 0xf, false)); }
__device__ __forceinline__ f32x4 prev_rows1(f32x4 pg, f32x4 cur) { f32x4 r;
#pragma unroll
    for (int e = 0; e < 4; ++e) r[e] = dppf<0x111>(dppf<0x121>(0.f, pg[e]), cur[e]);
    return r; }
__device__ __forceinline__ f32x4 prev_rows2(f32x4 pg, f32x4 cur) { f32x4 r;
#pragma unroll
    for (int e = 0; e < 4; ++e) r[e] = dppf<0x112>(dppf<0x122>(0.f, pg[e]), cur[e]);
    return r; }
__device__ __forceinline__ float silu_(float x) { return x * frcp(1.0f + fexp2(-x * LOG2E)); }
constexpr int HALO_OFF = 135680;
struct EpiUpConv {
    static constexpr bool PERM = true, AFTER_DRAIN = false, BMAP = false, AMAP = true;
    bf16_t* ACT; float* EDGE; const float* rs2; const float* cw; const float* cb; const float* sconv; float* convp; float* convs; PG8_LAS unsigned char* lds;
    __device__ __forceinline__ int bmap(int r) const { return r; }
    __device__ __forceinline__ int amap(int r) const { return (r & 64) + 4 * (r & 15) + ((r >> 4) & 3); }
    __device__ __forceinline__ void operator()(f32x4 (&acc)[2][2][4][2], const Unit& u, int wr, int wc, int fr, int fq) const {
        const bool smp = u.pm >= 64;
        const int j8 = u.pn * 128 + 32 * wc + 8 * fq;
        f32x4 cwv[8];
#define UPC_LOADW(n_) do { const int j4_ = j8 + 4 * (n_); cwv[0] = *(const f32x4*)(cw + j4_); cwv[1] = *(const f32x4*)(cw + FF2 + j4_); cwv[2] = *(const f32x4*)(cw + 2 * FF2 + j4_); cwv[3] = *(const f32x4*)(cb + j4_); \
        cwv[4] = *(const f32x4*)(cw + FF + j4_); cwv[5] = *(const f32x4*)(cw + FF2 + FF + j4_); cwv[6] = *(const f32x4*)(cw + 2 * FF2 + FF + j4_); cwv[7] = *(const f32x4*)(cb + FF + j4_); } while (0)
        UPC_LOADW(0);
        const int tok0 = u.pm * BM + wr * 64 + 4 * fr;
        { float tot[2][4];
#pragma unroll
          for (int ai = 0; ai < 2; ++ai)
#pragma unroll
              for (int m = 0; m < 4; ++m) tot[ai][m] = rs2[tok0 + ai * HALF + m];
#pragma unroll
          for (int ai = 0; ai < 2; ++ai)
#pragma unroll
              for (int m = 0; m < 4; ++m) { const float rstd = frsq(tot[ai][m] * (1.0f / 1024.0f) + EPS);
#pragma unroll
                  for (int bj = 0; bj < 2; ++bj) { acc[ai][bj][m][0] = acc[ai][bj][m][0] * rstd; acc[ai][bj][m][1] = acc[ai][bj][m][1] * rstd; } } }
        PG8_LAS float* halo = (PG8_LAS float*)(lds + HALO_OFF);
        if (!smp && fr == 15) {
#pragma unroll
            for (int ai = 0; ai < 2; ++ai)
#pragma unroll
                for (int mm = 2; mm < 4; ++mm) { PG8_LAS float* hp = halo + ((((2 * ai + wr + 1) * 2 + (mm - 2)) * 4 + wc) * 4 + fq) * 16;
                    *(PG8_LAS f32x4*)(hp) = acc[ai][0][mm][0]; *(PG8_LAS f32x4*)(hp + 4) = acc[ai][0][mm][1]; *(PG8_LAS f32x4*)(hp + 8) = acc[ai][1][mm][0]; *(PG8_LAS f32x4*)(hp + 12) = acc[ai][1][mm][1]; }
        }
        asm volatile("s_waitcnt lgkmcnt(0)\n\ts_barrier" ::: "memory");
#pragma unroll
        for (int n = 0; n < 2; ++n) {
            const int j4 = j8 + 4 * n;
            if (n == 1) UPC_LOADW(1);
            const f32x4 wg0 = cwv[0], wg1 = cwv[1], wg2 = cwv[2], bgv = cwv[3], wv0 = cwv[4], wv1 = cwv[5], wv2 = cwv[6], bvv = cwv[7];
#pragma unroll
            for (int ai = 0; ai < 2; ++ai) {
                const int blk = 2 * ai + wr, tokb = tok0 + ai * HALF;
                f32x4 gm1, gm2, vm1, vm2;
                if (smp) { const float* sb = sconv + (size_t)((tokb - MP) >> 2) * 2 * FF2;
                    gm2 = *(const f32x4*)(sb + j4); vm2 = *(const f32x4*)(sb + FF + j4); gm1 = *(const f32x4*)(sb + FF2 + j4); vm1 = *(const f32x4*)(sb + FF2 + FF + j4); }
                else { f32x4 h2g = {0.f, 0.f, 0.f, 0.f}, h3g = h2g, h2v = h2g, h3v = h2g;
                    if (blk > 0 && fr == 0) { const PG8_LAS float* hp = halo + (((blk * 2) * 4 + wc) * 4 + fq) * 16; h2g = *(const PG8_LAS f32x4*)(hp + 4 * n); h2v = *(const PG8_LAS f32x4*)(hp + 8 + 4 * n);
                        h3g = *(const PG8_LAS f32x4*)(hp + 256 + 4 * n); h3v = *(const PG8_LAS f32x4*)(hp + 256 + 8 + 4 * n); }
#pragma unroll
                    for (int e = 0; e < 4; ++e) { gm1[e] = dppf<0x111>(h3g[e], acc[ai][0][3][n][e]); gm2[e] = dppf<0x111>(h2g[e], acc[ai][0][2][n][e]); vm1[e] = dppf<0x111>(h3v[e], acc[ai][1][3][n][e]); vm2[e] = dppf<0x111>(h2v[e], acc[ai][1][2][n][e]); } }
#pragma unroll
                for (int m = 0; m < 4; ++m) { const int R = tokb + m;
                    const f32x4 g = acc[ai][0][m][n], v = acc[ai][1][m][n];
                    const f32x4 g1 = m == 0 ? gm1 : acc[ai][0][m > 0 ? m - 1 : 0][n], v1 = m == 0 ? vm1 : acc[ai][1][m > 0 ? m - 1 : 0][n];
                    const f32x4 g2 = m == 0 ? gm2 : (m == 1 ? gm1 : acc[ai][0][m > 1 ? m - 2 : 0][n]), v2 = m == 0 ? vm2 : (m == 1 ? vm1 : acc[ai][1][m > 1 ? m - 2 : 0][n]);
                    if (smp) { if (m >= 2) { float* cd = convs + ((size_t)((R - MP) >> 2) * 2 + (m - 2)) * FF2; *(f32x4*)(cd + j4) = g; *(f32x4*)(cd + FF + j4) = v; } }
                    else if ((ai == 0 && m < 2) || (ai == 1 && m >= 2)) {
                        const int t = R & 2047;
                        if (t >= 2046) { float* cd = convp + ((size_t)(R >> 11) * 2 + (t - 2046)) * FF2; *(f32x4*)(cd + j4) = g; *(f32x4*)(cd + FF + j4) = v; }
                        const int rt = R & 255;
                        if (rt < 2 || rt >= 254) { float* ed = EDGE + ((size_t)u.pm * 4 + (rt < 2 ? rt : rt - 252)) * FF2; *(f32x4*)(ed + j4) = g; *(f32x4*)(ed + FF + j4) = v; }
                    }
                    const f32x4 cg = bgv + wg0 * g2 + wg1 * g1 + wg2 * g, cv = bvv + wv0 * v2 + wv1 * v1 + wv2 * v;
                    u32x2 w; w.x = cvt_pk_bf16(silu_(cg[0]) * cv[0], silu_(cg[1]) * cv[1]); w.y = cvt_pk_bf16(silu_(cg[2]) * cv[2], silu_(cg[3]) * cv[3]);
                    *(u32x2*)(ACT + (size_t)R * FF + j4) = w;
                }
            }
        }
    }
};
#undef UPC_LOADW

template <class Epi, class Sched, bool ALIGN_EPI = false, bool SP2 = false>
__device__ __forceinline__ void gemm_phase(PG8_LAS unsigned char* lds, const Gemm g, const Sched& S, const Epi& E) {
    int tid_ = threadIdx.x; asm volatile("" : "+v"(tid_));
    const int tid = tid_, wid = __builtin_amdgcn_readfirstlane(tid >> 6), lane = tid & 63, wr = wid >> 2, wc = wid & 3, fr = lane & 15, fq = lane >> 4;
    const int K = g.K, nt = K / BK;
    unsigned voffA[2], voffB[2], voffB1[2];
#pragma unroll
    for (int i = 0; i < 2; ++i) { int R, C; stage_rc(tid * 16 + i * 8192, R, C); const int Rb = Epi::PERM ? ((R & ~31) + perm32(R & 31)) : R;
        int Ra = R; if constexpr (Epi::AMAP) Ra = E.amap(R); voffA[i] = (unsigned)(Ra * K + C) * 2u;     voffB[i] = (unsigned)(E.bmap(Rb) * K + C) * 2u; if constexpr (Epi::BMAP) voffB1[i] = (unsigned)(E.bmap(HALF + Rb) * K + C) * 2u; else voffB1[i] = 0u; }
    const size_t kstep = (size_t)(BK * 2);
    const size_t hstep = (size_t)HALF * K * 2;
    const unsigned* vB1 = Epi::BMAP ? voffB1 : voffB; const size_t h1step = Epi::BMAP ? (size_t)0 : hstep;
    const size_t tstep = 2 * hstep;
    const unsigned ldsw = (unsigned)wid * 1024u;
    const int aoff = lds_byte(wr * 64 + fr, fq * 8), boff = lds_byte(wc * 32 + fr, fq * 8);
#define PG8_SA(b, h) (((b) * 2 + (h)) * HTB)
#define PG8_SB(b, h) ((4 + (b) * 2 + (h)) * HTB)
#define PG8_STAGE(bufoff, gbase, voff) do { _Pragma("unroll") for (int _i = 0; _i < 2; ++_i) \
        __builtin_amdgcn_global_load_lds((const unsigned*)((const char*)(gbase) + (voff)[_i]), (PG8_LAS unsigned*)(lds + (bufoff) + ldsw + _i * 8192), 16, 0, 0); } while (0)
#define PG8_LDA(dst, b, h) do { _Pragma("unroll") for (int m = 0; m < 4; ++m) _Pragma("unroll") for (int k = 0; k < 2; ++k) dst[m][k] = *(const PG8_LAS bf16x8*)(lds + PG8_SA(b, h) + aoff + m * 2048 + k * 1024); } while (0)
#define PG8_LDB(dst, b, h) do { _Pragma("unroll") for (int n = 0; n < 2; ++n) _Pragma("unroll") for (int k = 0; k < 2; ++k) dst[n][k] = *(const PG8_LAS bf16x8*)(lds + PG8_SB(b, h) + boff + n * 2048 + k * 1024); } while (0)
#define PG8_MMA(ai, bj, At, Bt) do { __builtin_amdgcn_s_setprio(1); _Pragma("unroll") for (int m = 0; m < 4; ++m) _Pragma("unroll") for (int n = 0; n < 2; ++n) _Pragma("unroll") for (int k = 0; k < 2; ++k) \
        acc[ai][bj][m][n] = __builtin_amdgcn_mfma_f32_16x16x32_bf16(Bt[n][k], At[m][k], acc[ai][bj][m][n], 0, 0, 0); __builtin_amdgcn_s_setprio(0); } while (0)
#define PG8_WAIT_V(n) asm volatile("s_waitcnt vmcnt(" #n ")" ::: "memory")
#define PG8_WAIT_L(n) asm volatile("s_waitcnt lgkmcnt(" #n ")" ::: "memory")
#define PG8_BAR __builtin_amdgcn_s_barrier()
#define PG8_SCHED __builtin_amdgcn_sched_barrier(0)
    Unit cur, nxt; int ui = 0;
    if (!S.next(0, cur)) return;
    f32x4 acc[2][2][4][2];
#pragma unroll
    for (int a = 0; a < 2; ++a)
#pragma unroll
        for (int b = 0; b < 2; ++b)
#pragma unroll
            for (int m = 0; m < 4; ++m)
#pragma unroll
                for (int n = 0; n < 2; ++n) acc[a][b][m][n] = (f32x4){0.f, 0.f, 0.f, 0.f};
    bf16x8 At[4][2], B0[2][2], B1[2][2];
    const char* cA = (const char*)g.A + (size_t)cur.pm * tstep; const char* cB = (const char*)g.Bt + (size_t)cur.pn * tstep;
    S.a_ready(cur);
    if constexpr (SP2) {
        PG8_STAGE(PG8_SB(0, 0), cB, voffB); PG8_STAGE(PG8_SB(0, 1), cB + h1step, vB1); PG8_STAGE(PG8_SA(0, 0), cA, voffA); PG8_STAGE(PG8_SA(0, 1), cA + hstep, voffA);
        if (wr == 1) PG8_BAR;
        PG8_WAIT_V(2); PG8_BAR;
        PG8_STAGE(PG8_SB(1, 0), cB + kstep, voffB); PG8_STAGE(PG8_SA(1, 0), cA + kstep, voffA); PG8_STAGE(PG8_SB(1, 1), cB + h1step + kstep, vB1);
        PG8_WAIT_V(6); PG8_BAR;
    } else {
        PG8_STAGE(PG8_SB(0, 0), cB, voffB); PG8_STAGE(PG8_SA(0, 0), cA, voffA); PG8_STAGE(PG8_SB(0, 1), cB + h1step, vB1); PG8_STAGE(PG8_SA(0, 1), cA + hstep, voffA);
        if (wr == 1) PG8_BAR;
        PG8_WAIT_V(4); PG8_BAR;
        PG8_STAGE(PG8_SB(1, 0), cB + kstep, voffB); PG8_STAGE(PG8_SA(1, 0), cA + kstep, voffA); PG8_STAGE(PG8_SB(1, 1), cB + h1step + kstep, vB1);
        PG8_WAIT_V(6); PG8_BAR;
    }
    for (;;) {
        const bool has_next = S.next(ui + 1, nxt);
        const char* nA = has_next ? (const char*)g.A + (size_t)nxt.pm * tstep : cA; const char* nB = has_next ? (const char*)g.Bt + (size_t)nxt.pn * tstep : cB;
        for (int t = 0; t < nt; t += 2) {
            const bool last = (t == nt - 2);
            const char* a1 = cA + (size_t)(t + 1) * kstep;
            const char* a2 = last ? nA : cA + (size_t)(t + 2) * kstep; const char* b2 = last ? nB : cB + (size_t)(t + 2) * kstep;
            const char* a3 = a2 + kstep; const char* b3 = b2 + kstep;
            if (last && has_next) S.a_ready(nxt);
            if constexpr (SP2) {
            PG8_LDB(B0, 0, 0); PG8_LDB(B1, 0, 1); PG8_SCHED; PG8_LDA(At, 0, 0); PG8_STAGE(PG8_SA(1, 1), a1 + hstep, voffA);
            PG8_WAIT_V(8); PG8_WAIT_L(0); PG8_BAR; PG8_MMA(0, 0, At, B0); PG8_MMA(0, 1, At, B1); PG8_BAR; PG8_SCHED;
            PG8_LDA(At, 0, 1); PG8_STAGE(PG8_SB(0, 0), b2, voffB); PG8_STAGE(PG8_SB(0, 1), b2 + h1step, vB1); PG8_STAGE(PG8_SA(0, 0), a2, voffA);
            PG8_WAIT_V(8); PG8_WAIT_L(0); PG8_BAR; PG8_MMA(1, 0, At, B0); PG8_MMA(1, 1, At, B1); PG8_BAR; PG8_SCHED;
            PG8_LDB(B0, 1, 0); PG8_LDB(B1, 1, 1); PG8_SCHED; PG8_LDA(At, 1, 0); PG8_STAGE(PG8_SA(0, 1), a2 + hstep, voffA);
            PG8_WAIT_V(8); PG8_WAIT_L(0); PG8_BAR; PG8_MMA(0, 0, At, B0); PG8_MMA(0, 1, At, B1); PG8_BAR; PG8_SCHED;
            PG8_LDA(At, 1, 1); PG8_STAGE(PG8_SB(1, 0), b3, voffB); PG8_STAGE(PG8_SB(1, 1), b3 + h1step, vB1); PG8_STAGE(PG8_SA(1, 0), a3, voffA);
            PG8_WAIT_V(8); PG8_WAIT_L(0); PG8_BAR; PG8_MMA(1, 0, At, B0); PG8_MMA(1, 1, At, B1); PG8_BAR; PG8_SCHED;
            } else {
            PG8_LDB(B0, 0, 0); PG8_SCHED; PG8_LDA(At, 0, 0); PG8_STAGE(PG8_SA(1, 1), a1 + hstep, voffA);
            PG8_WAIT_L(8); PG8_BAR; PG8_WAIT_L(0); PG8_MMA(0, 0, At, B0); PG8_BAR; PG8_SCHED;
            PG8_LDB(B1, 0, 1); PG8_STAGE(PG8_SB(0, 0), b2, voffB);
            PG8_BAR; PG8_WAIT_L(0); PG8_MMA(0, 1, At, B1); PG8_BAR;
            PG8_LDA(At, 0, 1); PG8_STAGE(PG8_SA(0, 0), a2, voffA);
            PG8_BAR; PG8_WAIT_L(0); PG8_MMA(1, 0, At, B0); PG8_BAR; PG8_SCHED;
            PG8_STAGE(PG8_SB(0, 1), b2 + h1step, vB1);
            PG8_WAIT_V(6); PG8_BAR; PG8_MMA(1, 1, At, B1); PG8_BAR;
            PG8_LDB(B0, 1, 0); PG8_SCHED; PG8_LDA(At, 1, 0); PG8_STAGE(PG8_SA(0, 1), a2 + hstep, voffA);
            PG8_WAIT_L(8); PG8_BAR; PG8_WAIT_L(0); PG8_MMA(0, 0, At, B0); PG8_BAR; PG8_SCHED;
            PG8_LDB(B1, 1, 1); PG8_STAGE(PG8_SB(1, 0), b3, voffB);
            PG8_BAR; PG8_WAIT_L(0); PG8_MMA(0, 1, At, B1); PG8_BAR;
            PG8_LDA(At, 1, 1); PG8_STAGE(PG8_SA(1, 0), a3, voffA);
            PG8_BAR; PG8_WAIT_L(0); PG8_MMA(1, 0, At, B0); PG8_BAR; PG8_SCHED;
            PG8_STAGE(PG8_SB(1, 1), b3 + h1step, vB1);
            PG8_WAIT_V(6); PG8_BAR; PG8_MMA(1, 1, At, B1); PG8_BAR;
            }
        }
        if constexpr (ALIGN_EPI) { if (wr == 0) PG8_BAR; }
        if constexpr (!Epi::AFTER_DRAIN) { E(acc, cur, wr, wc, fr, fq); S.done(cur); }
        if (!has_next) break;
#pragma unroll
        for (int a = 0; a < 2; ++a)
#pragma unroll
            for (int b = 0; b < 2; ++b)
#pragma unroll
                for (int m = 0; m < 4; ++m)
#pragma unroll
                    for (int n = 0; n < 2; ++n) acc[a][b][m][n] = (f32x4){0.f, 0.f, 0.f, 0.f};
        cur = nxt; cA = nA; cB = nB; ++ui;
        if constexpr (ALIGN_EPI) { if (wr == 1) PG8_BAR; }
    }
    PG8_WAIT_V(0);
    if constexpr (!ALIGN_EPI) { if (wr == 0) PG8_BAR; }
    PG8_BAR;
    if constexpr (Epi::AFTER_DRAIN) { E.fused(acc, cur, wr, wc, fr, fq, lds, wid, lane); S.done(cur); }
#undef PG8_SA
#undef PG8_SB
#undef PG8_STAGE
#undef PG8_LDA
#undef PG8_LDB
#undef PG8_MMA
#undef PG8_WAIT_V
#undef PG8_WAIT_L
#undef PG8_BAR
#undef PG8_SCHED
}
}

#define XB_TMO      128
#define XB_XCNT(j)  (256  + 64 * (j))
#define XB_XSUB(j)  (1280 + 64 * (j))
#define XB_XGEN(j)  (2304 + 64 * (j))
#define XB_TOP      3328
#define XB_TOPGEN   3392
#define XCD_BAR_WORDS 3456
#define XB_SPIN_CAP (1u << 18)

__device__ __forceinline__ unsigned xb_ld(unsigned* p)              { return __hip_atomic_load(p, __ATOMIC_RELAXED, __HIP_MEMORY_SCOPE_AGENT); }
__device__ __forceinline__ unsigned xb_add(unsigned* p, unsigned v) { return __hip_atomic_fetch_add(p, v, __ATOMIC_RELAXED, __HIP_MEMORY_SCOPE_AGENT); }
__device__ __forceinline__ unsigned xb_xcc_id() { return (unsigned)__builtin_amdgcn_s_getreg((3 << 11) | 20) & 0xFu; }
#define XB_SPIN(cond, bar) do { unsigned _sp = 0; while (cond) { __builtin_amdgcn_s_sleep(1); \
    if ((++_sp & 255u) == 0u) { if (xb_ld(&(bar)[XB_TMO])) break; if (_sp > XB_SPIN_CAP) { atomicAdd(&(bar)[XB_TMO], 1u); break; } } } } while (0)

struct XcdBarrier {
    unsigned* bar; unsigned x;
    volatile LAS unsigned* st;
};

__device__ __forceinline__ XcdBarrier xcd_barrier_post(unsigned* bar, volatile LAS unsigned* st) {
    XcdBarrier b; b.bar = bar; b.x = xb_xcc_id(); b.st = st;
    if (threadIdx.x == 0) (void)xb_add(&bar[XB_XCNT(b.x)], 1u);
    return b;
}
__device__ __forceinline__ void xcd_barrier_complete(unsigned* bar, unsigned x, unsigned& nloc, unsigned& nx) {
    const unsigned G = gridDim.x * gridDim.y * gridDim.z;
    unsigned sum, cnt, mine, sp = 0u;
    for (;;) {
        sum = 0u; cnt = 0u; mine = 0u;
#pragma unroll
        for (unsigned j = 0; j < 16; ++j) { const unsigned c = xb_ld(&bar[XB_XCNT(j)]); sum += c; cnt += (c > 0u) ? 1u : 0u; mine = (j == x) ? c : mine; }
        if (sum == G) break;
        __builtin_amdgcn_s_sleep(1);
        if ((++sp & 255u) == 0u) { if (xb_ld(&bar[XB_TMO])) break; if (sp > XB_SPIN_CAP) { atomicAdd(&bar[XB_TMO], 1u); break; } }
    }
    nloc = mine > 0u ? mine : 1u; nx = cnt > 0u ? cnt : 1u;
}

__device__ __forceinline__ void xcd_barrier(const XcdBarrier& b) {
    asm volatile("s_waitcnt vmcnt(0)" ::: "memory");
    __syncthreads();
    if (threadIdx.x == 0) {
        unsigned* bar = b.bar;
        __builtin_amdgcn_s_waitcnt(0);
        unsigned nloc = b.st[0], nx = b.st[1];
        if (nloc == 0u) { xcd_barrier_complete(bar, b.x, nloc, nx); b.st[0] = nloc; b.st[1] = nx; }
        const unsigned old = xb_add(&bar[XB_XSUB(b.x)], 1u);
        const unsigned gen = old / nloc;
        if (old + 1u == (gen + 1u) * nloc) {
            __builtin_amdgcn_fence(__ATOMIC_RELEASE, "agent");
            asm volatile("s_waitcnt vmcnt(0)" ::: "memory");
            const unsigned og = xb_add(&bar[XB_TOP], 1u);
            const unsigned tg = og / nx;
            if (og + 1u == (tg + 1u) * nx) xb_add(&bar[XB_TOPGEN], 1u);
            else XB_SPIN(xb_ld(&bar[XB_TOPGEN]) == tg, bar);
            __builtin_amdgcn_fence(__ATOMIC_ACQUIRE, "agent");
            xb_add(&bar[XB_XGEN(b.x)], 1u);
            asm volatile("s_waitcnt vmcnt(0)" ::: "memory");
        } else {
            XB_SPIN(xb_ld(&bar[XB_XGEN(b.x)]) == gen, bar);
            __builtin_amdgcn_fence(__ATOMIC_ACQUIRE, "agent");
            asm volatile("s_waitcnt vmcnt(0)" ::: "memory");
        }
    }
    __syncthreads();
}

struct Args { const float* in[39]; float* out; unsigned char* ws; int ph_lo, ph_hi, li, pad; };
enum { I_XP = 0, I_XS, I_MEM, I_C1, I_C4, I_C16, I_SRE, I_SIM, I_SCONV, I_CMEM, I_NMIX, I_WIN, I_QN, I_KN, I_LRE, I_LIM, I_LDT, I_BRE, I_BIM, I_CRE, I_CIM, I_SD, I_WGLU, I_BGLU,
       I_AON, I_SON, I_WOUT, I_NX, I_NMEM, I_WXQ, I_WXKV, I_XQN, I_XKN, I_WXO, I_NFFN, I_WUP, I_CONVW, I_CONVB, I_WDOWN };
constexpr size_t O_YP = 0, O_YS = O_YP + (size_t)MP * D, O_KV1P = O_YS + (size_t)MS * D, O_KV4P = O_KV1P + (size_t)BP * 128 * 512, O_KV16P = O_KV4P + (size_t)BP * 512 * 512,
    O_SREP = O_KV16P + (size_t)BP * 2048 * 512, O_SIMP = O_SREP + BP * 1024, O_CONVP = O_SIMP + BP * 1024, O_MEMKV = O_CONVP + (size_t)BP * 2 * FF2, O_KV1S = O_MEMKV + (size_t)MM * 2048,
    O_KV4S = O_KV1S + (size_t)MS * 512, O_KV16S = O_KV4S + (size_t)MS * 512, O_SRES = O_KV16S + (size_t)MS * 512, O_SIMS = O_SRES + BS * 1024, O_CONVS = O_SIMS + BS * 1024, O_END = O_CONVS + (size_t)BS * 2 * FF2;
static_assert(O_END == 35102720 && O_KV1P == O_KV1P_ && O_KV4P == O_KV4P_ && O_KV16P == O_KV16P_ && O_KV1S == O_KV1S_ && O_KV4S == O_KV4S_ && O_KV16S == O_KV16S_, "output map");

template <int MODE> __device__ __forceinline__ int rowmap(int n) {
    if (MODE == 1) return (n & ~255) + 128 * ((n >> 5) & 1) + 32 * ((n >> 6) & 3) + (n & 31);
    if (MODE == 2) { return n < FF ? 256 * (n >> 7) + (n & 127) : 256 * ((n - FF) >> 7) + 128 + ((n - FF) & 127); }
    return n;
}
template <int MODE> __device__ __forceinline__ void p0_transpose_item(const float* W, int K, int N, bf16* WT, const float* gk, LAS float* scr, int item, int lane) {
    const int nblk = N / 32, kb = item / nblk, nb = item % nblk, k0 = 64 * kb, n0 = 32 * nb;
    float wv[32];
#pragma unroll
    for (int i = 0; i < 32; ++i) wv[i] = W[(size_t)(k0 + 2 * i + (lane >> 5)) * N + n0 + (lane & 31)];
    if (gk) {
#pragma unroll
        for (int i = 0; i < 32; ++i) wv[i] *= gk[k0 + 2 * i + (lane >> 5)]; }
#pragma unroll
    for (int i = 0; i < 32; ++i) scr[(2 * i + (lane >> 5)) * 33 + (lane & 31)] = wv[i];
    LDS_WAIT(); asm volatile("" ::: "memory");
    const int c = lane & 7;
#pragma unroll
    for (int j = 0; j < 4; ++j) { const int n = (lane >> 3) + 8 * j; const LAS float* s = scr + (8 * c) * 33 + n;
        u32x4 o; o.x = pk2(s[0 * 33], s[1 * 33]); o.y = pk2(s[2 * 33], s[3 * 33]); o.z = pk2(s[4 * 33], s[5 * 33]); o.w = pk2(s[6 * 33], s[7 * 33]);
        *(GAS u32x4*)(WT + (size_t)rowmap<MODE>(n0 + n) * K + k0 + 8 * c) = o; }
    LDS_WAIT(); asm volatile("" ::: "memory");
}
__device__ __forceinline__ void rms_rows2_to_bf16(const float* xrow0, const float* xrow1, const f32x4 (&gg)[4], bf16* orow0, bf16* orow1, int lane) {
    const f32x4* xr0 = (const f32x4*)xrow0 + lane; const f32x4* xr1 = (const f32x4*)xrow1 + lane;
    f32x4 v0[4], v1[4]; float s0 = 0.f, s1 = 0.f;
#pragma unroll
    for (int j = 0; j < 4; ++j) { v0[j] = xr0[64 * j]; v1[j] = xr1[64 * j]; }
#pragma unroll
    for (int j = 0; j < 4; ++j) { s0 += dot4(v0[j]); s1 += dot4(v1[j]); }
#pragma unroll
    for (int o = 1; o < 64; o <<= 1) { s0 += __shfl_xor(s0, o); s1 += __shfl_xor(s1, o); }
    const float r0 = frsq(s0 * (1.0f / D) + EPS), r1 = frsq(s1 * (1.0f / D) + EPS);
    u32x2* o0 = (u32x2*)orow0 + lane; u32x2* o1 = (u32x2*)orow1 + lane;
#pragma unroll
    for (int j = 0; j < 4; ++j) { const f32x4 a = v0[j] * r0 * gg[j], c = v1[j] * r1 * gg[j];
        u32x2 w; w.x = cvt_pk_bf16(a[0], a[1]); w.y = cvt_pk_bf16(a[2], a[3]); o0[64 * j] = w;
        u32x2 z; z.x = cvt_pk_bf16(c[0], c[1]); z.y = cvt_pk_bf16(c[2], c[3]); o1[64 * j] = z; }
}

__device__ __forceinline__ int pi23(int m) { return (m & ~12) | ((m & 4) << 1) | ((m & 8) >> 1); }
__device__ __forceinline__ void memk_fix_item(float* memkv, const float* mss, const float* xkn, const float* xqn, bf16* MEMK, int Rm, int lane) {
    const f32x4 gk = *(const f32x4*)(xkn + 4 * lane), gq = *(const f32x4*)(xqn + 4 * lane);
    f32x4 v[4], s[4];
#pragma unroll
    for (int h = 0; h < 4; ++h) { v[h] = *(const f32x4*)(memkv + (size_t)Rm * 2048 + h * 256 + 4 * lane); s[h] = *(const f32x4*)(mss + (size_t)Rm * 16 + 4 * h); }
#pragma unroll
    for (int h = 0; h < 4; ++h) {
        const float rs = frsq(((s[h][0] + s[h][1]) + (s[h][2] + s[h][3])) * (1.0f / 256.0f) + EPS);
        const f32x4 kn = v[h] * rs * gk; *(f32x4*)(memkv + (size_t)Rm * 2048 + h * 256 + 4 * lane) = kn; const f32x4 kq = kn * gq;
        u32x2 w; w.x = cvt_pk_bf16(kq[0], kq[1]); w.y = cvt_pk_bf16(kq[2], kq[3]); *(u32x2*)(MEMK + (size_t)Rm * 1024 + h * 256 + 4 * lane) = w;
    }
}
__device__ __forceinline__ void ssm_bfrags(const Args& a, const float* ssmc, int g, int lane, bf16x8 (&bb)[4]) {
    const int n = lane & 31, hi = lane >> 5;
#pragma unroll
    for (int s2 = 0; s2 < 2; ++s2) { const int st = g * 64 + 32 * s2 + n; const f32x4 c0 = *(const f32x4*)(ssmc + (size_t)st * 8); const float cr = c0[2], ci = c0[3];
        const f32x4 r0 = *(const f32x4*)(a.in[I_BRE] + (size_t)st * 16 + 8 * hi), r1 = *(const f32x4*)(a.in[I_BRE] + (size_t)st * 16 + 8 * hi + 4);
        const f32x4 i0 = *(const f32x4*)(a.in[I_BIM] + (size_t)st * 16 + 8 * hi), i1 = *(const f32x4*)(a.in[I_BIM] + (size_t)st * 16 + 8 * hi + 4);
        const f32x4 pr0 = r0 * cr - i0 * ci, pr1 = r1 * cr - i1 * ci, pi0 = i0 * cr + r0 * ci, pi1 = i1 * cr + r1 * ci;
        bb[s2] = pack8(pr0[0], pr0[1], pr0[2], pr0[3], pr1[0], pr1[1], pr1[2], pr1[3]); bb[2 + s2] = pack8(pi0[0], pi0[1], pi0[2], pi0[3], pi1[0], pi1[1], pi1[2], pi1[3]); }
}
__device__ __forceinline__ bf16x8 ssm_loadu(const float* U, int row0, int nrows, int g, int lane) {
    const int m = lane & 31, hi = lane >> 5; const int row = row0 + (m < nrows ? m : (m & (nrows - 1)));
    const f32x4 u0 = *(const f32x4*)(U + (size_t)row * 256 + g * 16 + 8 * hi), u1 = *(const f32x4*)(U + (size_t)row * 256 + g * 16 + 8 * hi + 4);
    return pack8(u0[0], u0[1], u0[2], u0[3], u1[0], u1[1], u1[2], u1[3]);
}
__device__ __forceinline__ void ssm_xcompute(bf16x8 ua, const bf16x8 (&bb)[4], f32x16 (&xr)[2], f32x16 (&xi)[2]) {
    const f32x16 z = {0.f, 0.f, 0.f, 0.f, 0.f, 0.f, 0.f, 0.f, 0.f, 0.f, 0.f, 0.f, 0.f, 0.f, 0.f, 0.f};
    f32x16 t0 = __builtin_amdgcn_mfma_f32_32x32x16_bf16(ua, bb[0], z, 0, 0, 0), t1 = __builtin_amdgcn_mfma_f32_32x32x16_bf16(ua, bb[1], z, 0, 0, 0);
    f32x16 t2 = __builtin_amdgcn_mfma_f32_32x32x16_bf16(ua, bb[2], z, 0, 0, 0), t3 = __builtin_amdgcn_mfma_f32_32x32x16_bf16(ua, bb[3], z, 0, 0, 0);
#pragma unroll
    for (int r = 0; r < 16; ++r) {
        const float a0 = t0[r], a1 = t1[r], a2 = t2[r], a3 = t3[r];
        const auto sr = __builtin_amdgcn_permlane32_swap(__float_as_uint(a0), __float_as_uint(a1), false, false);
        const unsigned s0 = sr[0], s1 = sr[1];
        xr[0][r] = __uint_as_float(s0); xr[1][r] = __uint_as_float(s1);
        const auto si = __builtin_amdgcn_permlane32_swap(__float_as_uint(a2), __float_as_uint(a3), false, false);
        const unsigned s2 = si[0], s3 = si[1];
        xi[0][r] = __uint_as_float(s2); xi[1][r] = __uint_as_float(s3); }
    __builtin_amdgcn_sched_barrier(0); asm volatile("s_nop 7" ::: "memory"); __builtin_amdgcn_sched_barrier(0);
}
#define SSM_XR(t) xr[((t) >> 2) & 1][((t) & 3) + 4 * ((t) >> 3)]
#define SSM_XI(t) xi[((t) >> 2) & 1][((t) & 3) + 4 * ((t) >> 3)]
__device__ __forceinline__ void ssm_a_item(const Args& a, const float* U, const float* ssmc, float* SSMF, LAS float* uL, int it, int lane) {
    const int g = it & 15, bc = it >> 4, b = bc / 31, c = bc - b * 31;
    const f32x4 c0 = *(const f32x4*)(ssmc + (size_t)(g * 64 + lane) * 8);
    const float ar = c0[0], ai = c0[1];
    bf16x8 bb[4]; ssm_bfrags(a, ssmc, g, lane, bb);
    float hr = 0.f, hi = 0.f;
    bf16x8 ua2[2]; ua2[0] = ssm_loadu(U, b * 2048 + c * 64, 32, g, lane); ua2[1] = ssm_loadu(U, b * 2048 + c * 64 + 32, 32, g, lane);
#pragma unroll
    for (int blk = 0; blk < 2; ++blk) {
        f32x16 xr[2], xi[2]; ssm_xcompute(ua2[blk], bb, xr, xi);
#pragma unroll
        for (int t = 0; t < 32; ++t) { const float nr = fmaf(ar, hr, fmaf(-ai, hi, SSM_XR(t))), ni = fmaf(ar, hi, fmaf(ai, hr, SSM_XI(t))); hr = nr; hi = ni; }
    }
    *(f32x2*)(SSMF + ((size_t)((b * 32 + c) * 16 + g) * 64 + lane) * 2) = (f32x2){hr, hi};
    (void)uL;
}
constexpr int SAB = 4;
struct SaBatch { f32x4 k[SAB], v[SAB]; };
__device__ __forceinline__ void sa_load(SaBatch& B, const float* cb, unsigned loff, int t, int dil, int nvalid, int i0) {
#pragma unroll
    for (int j = 0; j < SAB; ++j) { const int i = i0 + j, idx = i < nvalid ? t + i * dil : t; const char* rp = (const char*)(cb + (size_t)idx * 512);
        B.k[j] = __builtin_nontemporal_load((const f32x4*)(rp + loff)); B.v[j] = __builtin_nontemporal_load((const f32x4*)(rp + 1024 + loff)); }
}
__device__ __forceinline__ void sa_compute(const SaBatch& B, f32x4 q, int nvalid, int i0, float& m, float& l, f32x4& o) {
    float s[SAB]; float mb = m;
#pragma unroll
    for (int j = 0; j < SAB; ++j) { float d = (q[0] * B.k[j][0] + q[1] * B.k[j][1]) + (q[2] * B.k[j][2] + q[3] * B.k[j][3]);
        d += __shfl_xor(d, 1); d += __shfl_xor(d, 2); d += __shfl_xor(d, 4); d += __shfl_xor(d, 8);
        s[j] = (i0 + j) < nvalid ? d : -1e30f; mb = fmaxf(mb, s[j]); }
    const float sc = fexp2(m - mb); l *= sc; o = o * sc; m = mb;
#pragma unroll
    for (int j = 0; j < SAB; ++j) { const float p = fexp2(s[j] - mb); l += p; o = o + B.v[j] * p; }
}
__device__ __forceinline__ void sattn_item(const Args& a, const bf16* Q, bf16* AO, float* LSE, int it, int lane) {
    const int g = it >> 9, rem = it & 511, b = rem >> 2, t = rem & 3;
    const int dil = 1 << (2 * g), nbuf = 128 << (2 * g);
    const int R = MP + 4 * b + t, hh = lane >> 4, dq = (lane & 15) * 4;
    const u32x2 qw = *(const u32x2*)(Q + (size_t)R * AW + g * 256 + hh * 64 + dq);
    const f32x4 q = {bf2f(qw.x & 0xffffu), bf2f(qw.x >> 16), bf2f(qw.y & 0xffffu), bf2f(qw.y >> 16)};
    const float* cb = a.in[I_C1 + g] + (size_t)b * nbuf * 512; const unsigned loff = 4u * (unsigned)(hh * 64 + dq);
    const float* nb = a.out + (g == 0 ? O_KV1S : (g == 1 ? O_KV4S : O_KV16S)) + (size_t)(4 * b) * 512 + hh * 64 + dq;
    const int nvalid = g == 0 ? 128 - t : 128;
    float m = -1e30f, l = 0.f; f32x4 o = {0.f, 0.f, 0.f, 0.f};
    SaBatch A, B; sa_load(A, cb, loff, t, dil, nvalid, 0);
#pragma unroll 1
    for (int i0 = 0; i0 < 128; i0 += 2 * SAB) {
        sa_load(B, cb, loff, t, dil, nvalid, i0 + SAB);
        sa_compute(A, q, nvalid, i0, m, l, o);
        if (i0 + 2 * SAB < 128) sa_load(A, cb, loff, t, dil, nvalid, i0 + 2 * SAB);
        sa_compute(B, q, nvalid, i0 + SAB, m, l, o);
    }
    {
        f32x4 kk[4], vv[4]; float s[4]; float mb = m;
#pragma unroll
        for (int j = 0; j < 4; ++j) { const float* rp = nb + (size_t)j * 512; kk[j] = *(const f32x4*)rp; vv[j] = *(const f32x4*)(rp + 256); }
#pragma unroll
        for (int j = 0; j < 4; ++j) { float d = (q[0] * kk[j][0] + q[1] * kk[j][1]) + (q[2] * kk[j][2] + q[3] * kk[j][3]);
            d += __shfl_xor(d, 1); d += __shfl_xor(d, 2); d += __shfl_xor(d, 4); d += __shfl_xor(d, 8);
            const bool ok = g == 0 ? (j <= t) : (j == t); s[j] = ok ? d : -1e30f; mb = fmaxf(mb, s[j]); }
        const float sc = fexp2(m - mb); l *= sc; o = o * sc; m = mb;
#pragma unroll
        for (int j = 0; j < 4; ++j) { const float p = fexp2(s[j] - mb); l += p; o = o + vv[j] * p; }
    }
    const float il = frcp(l); o = o * il;
    u32x2 w; w.x = cvt_pk_bf16(o[0], o[1]); w.y = cvt_pk_bf16(o[2], o[3]); *(u32x2*)(AO + (size_t)R * AW + g * 256 + hh * 64 + dq) = w;
    if ((lane & 15) == 0) LSE[(size_t)R * 12 + g * 4 + hh] = (m + flog2(l)) * LN2;
}
__device__ __forceinline__ void pattn_item(const bf16* Q, const bf16* Kb, const bf16* VT, bf16* AO, float* LSE, int it, int lane) {
    const int g = it >> 11; int rem = it & 2047;
    const int sh = 2 * g, dil = 1 << sh, S = 2048 >> sh, nql = 6 - sh;
    const int qt = rem & ((1 << nql) - 1); rem >>= nql; const int res = rem & (dil - 1); rem >>= sh; const int hh = rem & 3, b = rem >> 2;
    const int n = lane & 31, hi = lane >> 5;
    const int s_q = 32 * qt + n, qrow = b * 2048 + s_q * dil + res;
    const int coff = g * 256 + hh * 64 + 32 * hi;
    bf16x8 qf[4];
    { const bf16* qp = Q + (size_t)qrow * AW + coff;
#pragma unroll
      for (int d0 = 0; d0 < 4; ++d0) qf[d0] = *(const bf16x8*)(qp + 8 * d0); }
    f32x16 sc[5];
    const int pm = pi23(n);
#pragma unroll
    for (int kt = 0; kt < 5; ++kt) {
        const int sb = 32 * qt - 128 + 32 * kt; int sk = sb + pm; sk = sk < 0 ? 0 : sk;
        const bf16* kp = Kb + (size_t)(b * 2048 + sk * dil + res) * AW + coff;
        bf16x8 kf[4];
#pragma unroll
        for (int d0 = 0; d0 < 4; ++d0) kf[d0] = *(const bf16x8*)(kp + 8 * d0);
        f32x16 acc = {0.f, 0.f, 0.f, 0.f, 0.f, 0.f, 0.f, 0.f, 0.f, 0.f, 0.f, 0.f, 0.f, 0.f, 0.f, 0.f};
#pragma unroll
        for (int d0 = 0; d0 < 4; ++d0) acc = __builtin_amdgcn_mfma_f32_32x32x16_bf16(kf[d0], qf[d0], acc, 0, 0, 0);
        sc[kt] = acc;
    }
    float mx = -1e30f;
#pragma unroll
    for (int kt = 0; kt < 5; ++kt) { const int sb = 32 * qt - 128 + 32 * kt;
#pragma unroll
        for (int r = 0; r < 16; ++r) { const int sk = sb + 16 * (r >> 3) + 8 * hi + (r & 7); const int dl = s_q - sk; const bool ok = (sk >= 0) && (dl >= 0) && (dl <= 128);
            const float v = ok ? sc[kt][r] : -1e30f; sc[kt][r] = v; mx = fmaxf(mx, v); } }
    mx = fmaxf(mx, __shfl_xor(mx, 32));
    float l = 0.f;
#pragma unroll
    for (int kt = 0; kt < 5; ++kt)
#pragma unroll
        for (int r = 0; r < 16; ++r) { const float p = fexp2(sc[kt][r] - mx); sc[kt][r] = p; l += p; }
    l += __shfl_xor(l, 32);
    f32x16 o[2];
#pragma unroll
    for (int dt = 0; dt < 2; ++dt) o[dt] = (f32x16){0.f, 0.f, 0.f, 0.f, 0.f, 0.f, 0.f, 0.f, 0.f, 0.f, 0.f, 0.f, 0.f, 0.f, 0.f, 0.f};
    const bf16* vbase = VT + (size_t)((g * 4 + hh) * 8 + b) * 64 * 2048;
#pragma unroll
    for (int kt = 0; kt < 5; ++kt) {
        int sb = 32 * qt - 128 + 32 * kt; sb = sb < 0 ? 0 : sb;
        const bf16* vp = vbase + (size_t)((res * S + sb) >> 5) * 2048 + n * 32 + 8 * hi;
#pragma unroll
        for (int jj = 0; jj < 2; ++jj) {
            const bf16x8 pb = pack8(sc[kt][8 * jj + 0], sc[kt][8 * jj + 1], sc[kt][8 * jj + 2], sc[kt][8 * jj + 3], sc[kt][8 * jj + 4], sc[kt][8 * jj + 5], sc[kt][8 * jj + 6], sc[kt][8 * jj + 7]);
#pragma unroll
            for (int dt = 0; dt < 2; ++dt) { const bf16x8 vf = *(const bf16x8*)(vp + dt * 1024 + 16 * jj); o[dt] = __builtin_amdgcn_mfma_f32_32x32x16_bf16(vf, pb, o[dt], 0, 0, 0); }
        }
    }
    const float il = frcp(l);
    bf16* op = AO + (size_t)qrow * AW + g * 256 + hh * 64 + 4 * hi;
#pragma unroll
    for (int dt = 0; dt < 2; ++dt)
#pragma unroll
        for (int r4 = 0; r4 < 4; ++r4) { u32x2 w; w.x = cvt_pk_bf16(o[dt][4 * r4] * il, o[dt][4 * r4 + 1] * il); w.y = cvt_pk_bf16(o[dt][4 * r4 + 2] * il, o[dt][4 * r4 + 3] * il);
            *(u32x2*)(op + 32 * dt + 8 * r4) = w; }
    if (hi == 0) LSE[(size_t)qrow * 12 + g * 4 + hh] = (mx + flog2(l)) * LN2;
}

constexpr int PK_ROW = 144, PK_SLOT = 32 * PK_ROW, PV_OFF = 12 * PK_SLOT;
__device__ __forceinline__ void pattn_wg_item(const bf16* Q, const bf16* Kb, const bf16* VT, bf16* AO, float* LSE, LAS unsigned char* lds, int item, int wave, int lane, int tid) {
    const int g = item >> 8, r = item & 255, hh = (r >> 3) & 3, b = r >> 5;
    const int sh = 2 * g, dil = 1 << sh, S = 2048 >> sh;
    const int qblk = g == 0 ? (r & 7) : (r & 1), resb = g == 0 ? 0 : (g == 1 ? ((r >> 1) & 3) : 2 * (r & 7));
    const int pc = tid & 255;
    u32x4 kreg[6], vreg[6];
#pragma unroll
    for (int i = 0; i < 6; ++i) { const int T = (tid >> 8) + 2 * i;
        int sb, rs; bool ok;
        if (g < 2) { sb = 256 * qblk - 128 + 32 * T; rs = resb; ok = sb >= 0; } else { sb = 32 * (T & 3); rs = resb + (T >> 2); ok = T < 8; }
        if (ok) { const int t = (sb + (pc >> 3)) * dil + rs;
            kreg[i] = *(const u32x4*)(Kb + (size_t)(b * 2048 + t) * AW + g * 256 + hh * 64 + 8 * (pc & 7));
            vreg[i] = *(const u32x4*)(VT + (size_t)(b * 2048 + t) * AW + g * 256 + hh * 64 + 8 * (pc & 7)); }
        else { kreg[i] = (u32x4){0u, 0u, 0u, 0u}; vreg[i] = kreg[i]; } }
    const int n = lane & 31, hi = lane >> 5;
    const int qt = g < 2 ? 8 * qblk + wave : (wave & 3), resw = g < 2 ? resb : resb + (wave >> 2);
    const int slot_base = g < 2 ? wave : 4 * (wave >> 2) + (wave & 3) - 4;
    const int s_q = 32 * qt + n, qrow = b * 2048 + s_q * dil + resw;
    bf16x8 qf[4];
    { const bf16* qp = Q + (size_t)qrow * AW + g * 256 + hh * 64 + 32 * hi;
#pragma unroll
      for (int d0 = 0; d0 < 4; ++d0) qf[d0] = *(const bf16x8*)(qp + 8 * d0); }
#pragma unroll
    for (int i = 0; i < 6; ++i) { const int T = (tid >> 8) + 2 * i;
        *(LAS u32x4*)(lds + T * PK_SLOT + (pc >> 3) * PK_ROW + (pc & 7) * 16) = kreg[i];
        *(LAS u32x4*)(lds + PV_OFF + T * PK_SLOT + (pc >> 3) * PK_ROW + (pc & 7) * 16) = vreg[i]; }
    __syncthreads();
    f32x16 sc[5];
    const int pm = pi23(n);
#pragma unroll
    for (int kt = 0; kt < 5; ++kt) {
        const int slot = slot_base + kt, sb = 32 * qt - 128 + 32 * kt;
        f32x16 acc = {0.f, 0.f, 0.f, 0.f, 0.f, 0.f, 0.f, 0.f, 0.f, 0.f, 0.f, 0.f, 0.f, 0.f, 0.f, 0.f};
        if (sb >= 0) {
            const LAS unsigned char* kp = lds + slot * PK_SLOT + pm * PK_ROW + 64 * hi;
            bf16x8 kf[4];
#pragma unroll
            for (int d0 = 0; d0 < 4; ++d0) kf[d0] = *(const LAS bf16x8*)(kp + 16 * d0);
#pragma unroll
            for (int d0 = 0; d0 < 4; ++d0) acc = __builtin_amdgcn_mfma_f32_32x32x16_bf16(kf[d0], qf[d0], acc, 0, 0, 0);
        }
        sc[kt] = acc;
    }
    float mx = -1e30f;
#pragma unroll
    for (int kt = 0; kt < 5; ++kt) { const int sb = 32 * qt - 128 + 32 * kt;
#pragma unroll
        for (int rr = 0; rr < 16; ++rr) { const int sk = sb + 16 * (rr >> 3) + 8 * hi + (rr & 7); const int dl = s_q - sk; const bool ok = (sk >= 0) && (dl >= 0) && (dl <= 128);
            const float v = ok ? sc[kt][rr] : -1e30f; sc[kt][rr] = v; mx = fmaxf(mx, v); } }
    mx = fmaxf(mx, __shfl_xor(mx, 32));
    float l = 0.f;
#pragma unroll
    for (int kt = 0; kt < 5; ++kt)
#pragma unroll
        for (int rr = 0; rr < 16; ++rr) { const float p = fexp2(sc[kt][rr] - mx); sc[kt][rr] = p; l += p; }
    l += __shfl_xor(l, 32);
    f32x16 o[2];
#pragma unroll
    for (int dt = 0; dt < 2; ++dt) o[dt] = (f32x16){0.f, 0.f, 0.f, 0.f, 0.f, 0.f, 0.f, 0.f, 0.f, 0.f, 0.f, 0.f, 0.f, 0.f, 0.f, 0.f};
#pragma unroll
    for (int kt = 0; kt < 5; ++kt) {
        const int slot = slot_base + kt, sb = 32 * qt - 128 + 32 * kt;
        if (sb >= 0) {
            LAS unsigned char* vp = lds + PV_OFF + slot * PK_SLOT + (8 * hi + ((lane >> 2) & 3)) * PK_ROW + (16 * ((lane >> 4) & 1) + 4 * (lane & 3)) * 2;
            bf16x8 vf[2][2];
#pragma unroll
            for (int jj = 0; jj < 2; ++jj)
#pragma unroll
                for (int dt = 0; dt < 2; ++dt) vf[jj][dt] = cat44(lds_tr4(vp + (16 * jj) * PK_ROW + 64 * dt), lds_tr4(vp + (16 * jj + 4) * PK_ROW + 64 * dt));
#pragma unroll
            for (int jj = 0; jj < 2; ++jj) {
                const bf16x8 pb = pack8(sc[kt][8 * jj + 0], sc[kt][8 * jj + 1], sc[kt][8 * jj + 2], sc[kt][8 * jj + 3], sc[kt][8 * jj + 4], sc[kt][8 * jj + 5], sc[kt][8 * jj + 6], sc[kt][8 * jj + 7]);
#pragma unroll
                for (int dt = 0; dt < 2; ++dt) o[dt] = __builtin_amdgcn_mfma_f32_32x32x16_bf16(vf[jj][dt], pb, o[dt], 0, 0, 0);
            }
        }
    }
    const float il = frcp(l);
    bf16* op = AO + (size_t)qrow * AW + g * 256 + hh * 64 + 4 * hi;
#pragma unroll
    for (int dt = 0; dt < 2; ++dt)
#pragma unroll
        for (int r4 = 0; r4 < 4; ++r4) { u32x2 w; w.x = cvt_pk_bf16(o[dt][4 * r4] * il, o[dt][4 * r4 + 1] * il); w.y = cvt_pk_bf16(o[dt][4 * r4 + 2] * il, o[dt][4 * r4 + 3] * il);
            *(u32x2*)(op + 32 * dt + 8 * r4) = w; }
    if (hi == 0) LSE[(size_t)qrow * 12 + g * 4 + hh] = (mx + flog2(l)) * LN2;
    __syncthreads();
}

template <int NB> __device__ __forceinline__ void combine_rows(const bf16* AO, const float* LSE, const float* aon, bf16* MIXED, int R0, int lane) {
    const int hh = lane >> 4; float ls[NB][3]; u32x2 ow[NB][3];
#pragma unroll
    for (int i = 0; i < NB; ++i)
#pragma unroll
        for (int g = 0; g < 3; ++g) { ow[i][g] = *(const u32x2*)(AO + (size_t)(R0 + i) * AW + g * 256 + 4 * lane); ls[i][g] = LSE[(size_t)(R0 + i) * 12 + g * 4 + hh]; }
    f32x4 gn[3];
#pragma unroll
    for (int g = 0; g < 3; ++g) gn[g] = *(const f32x4*)(aon + g * 256 + 4 * lane);
#pragma unroll
    for (int i = 0; i < NB; ++i) {
        const float mx = fmaxf(fmaxf(ls[i][0], ls[i][1]), ls[i][2]);
        float e[3]; e[0] = fexp2((ls[i][0] - mx) * LOG2E); e[1] = fexp2((ls[i][1] - mx) * LOG2E); e[2] = fexp2((ls[i][2] - mx) * LOG2E);
        const float inv = frcp(e[0] + e[1] + e[2]);
        f32x4 v[3]; float ss = 0.f;
#pragma unroll
        for (int g = 0; g < 3; ++g) { const float al = e[g] * inv; v[g] = (f32x4){bf2f(ow[i][g].x & 0xffffu), bf2f(ow[i][g].x >> 16), bf2f(ow[i][g].y & 0xffffu), bf2f(ow[i][g].y >> 16)} * al; ss += dot4(v[g]); }
        const float rs = frsq(wave_sum(ss) * (1.0f / 768.0f) + EPS);
#pragma unroll
        for (int g = 0; g < 3; ++g) { const f32x4 y = v[g] * rs * gn[g];
            u32x2 w; w.x = cvt_pk_bf16(y[0], y[1]); w.y = cvt_pk_bf16(y[2], y[3]); *(u32x2*)(MIXED + (size_t)(R0 + i) * D + g * 256 + 4 * lane) = w; }
    }
}
__device__ __forceinline__ float gelu_tanh(float x) { const float u2 = 1.5957691216057308f * (x + 0.044715f * x * x * x); return x * frcp(1.0f + fexp2(-u2 * LOG2E)); }
__device__ __forceinline__ float sigmoidf_(float z) { return frcp(1.0f + fexp2(-z * LOG2E)); }
__device__ __forceinline__ void ssm_c_item(const Args& a, const float* U, const float* ssmc, const float* SSMF, const bf16* WGLU, bf16* MIXED, LAS unsigned char* lds, int item, int wave, int lane) {
    const bool hs = item < 32;
    const int b = item >> 5, c = item & 31;
    const int R0 = item * 64, RS0 = MP + item * 16;
    LAS unsigned* HL = (LAS unsigned*)(lds + wave * 4352);
    LAS float* ZS = (LAS float*)(lds + 34816);
    const int t16 = lane & 15, q4 = lane >> 4;
    for (int gi = 0; gi < 2; ++gi) {
        const int g = 2 * wave + gi;
        const f32x4* cp = (const f32x4*)(ssmc + (size_t)(g * 64 + lane) * 8); const f32x4 c0 = cp[0], c1 = cp[1];
        const float ar = c0[0], ai = c0[1], a64r = c1[0], a64i = c1[1];
        bf16x8 bb[4]; ssm_bfrags(a, ssmc, g, lane, bb);
        bf16x8 cf[4];
#pragma unroll
        for (int s4 = 0; s4 < 4; ++s4) { const int p0 = 16 * s4 + 4 * q4; const f32x4 x = *(const f32x4*)(a.in[I_CRE] + (size_t)(g * 16 + t16) * 64 + p0), y = *(const f32x4*)(a.in[I_CIM] + (size_t)(g * 16 + t16) * 64 + p0);
            cf[s4] = pack8(x[0], -y[0], x[1], -y[1], x[2], -y[2], x[3], -y[3]); }
        const f32x4 dv = *(const f32x4*)(a.in[I_SD] + g * 16 + 4 * q4);
        float hr = 0.f, hi = 0.f;
        {
            const int nb16 = (c + 15) >> 4; int cc0 = c - 16 * nb16;
            for (int i16 = 0; i16 < nb16; ++i16, cc0 += 16) { f32x2 f[16];
#pragma unroll
                for (int j = 0; j < 16; ++j) { const int cc = cc0 + j; f[j] = cc >= 0 ? *(const f32x2*)(SSMF + ((size_t)((b * 32 + cc) * 16 + g) * 64 + lane) * 2) : (f32x2){0.f, 0.f}; }
#pragma unroll
                for (int j = 0; j < 16; ++j) { const float nr = fmaf(a64r, hr, fmaf(-a64i, hi, f[j][0])), ni = fmaf(a64r, hi, fmaf(a64i, hr, f[j][1])); hr = nr; hi = ni; } }
        }
#if defined(PROBE_DUMP)
        { float* dmp = (float*)((unsigned char*)MIXED - WS_MIXED + 741 * MiB) + ((size_t)(item * 16 + g) * 64 + lane) * 2; dmp[0] = hr; dmp[1] = hi; }
#endif
        bf16x8 ua2[2]; f32x4 uv4[4];
        ua2[0] = ssm_loadu(U, R0, 32, g, lane); ua2[1] = ssm_loadu(U, R0 + 32, 32, g, lane);
#pragma unroll
        for (int j = 0; j < 4; ++j) uv4[j] = *(const f32x4*)(U + (size_t)(R0 + 16 * j + t16) * 256 + g * 16 + 4 * q4);
#if defined(PROBE_DUMP)
        { u32x4* dmp = (u32x4*)((unsigned char*)MIXED - WS_MIXED + 724 * MiB) + ((size_t)(item * 16 + g) * 2) * 64 + lane; dmp[0] = __builtin_bit_cast(u32x4, ua2[0]); dmp[64] = __builtin_bit_cast(u32x4, ua2[1]); }
#endif
#pragma unroll
        for (int blk = 0; blk < 2; ++blk) {
            f32x16 xr[2], xi[2]; ssm_xcompute(ua2[blk], bb, xr, xi);
#pragma unroll
            for (int s2 = 0; s2 < 2; ++s2) {
                const int trow = 32 * blk + 16 * s2 + t16;
                const f32x4 uv = uv4[2 * blk + s2];
#pragma unroll
                for (int tt = 0; tt < 16; ++tt) { const int t = 16 * s2 + tt;
                    const float nr = fmaf(ar, hr, fmaf(-ai, hi, SSM_XR(t))), ni = fmaf(ar, hi, fmaf(ai, hr, SSM_XI(t))); hr = nr; hi = ni;
                    HL[tt * 68 + lane] = cvt_pk_bf16(hr, hi);
                }
                LDS_WAIT(); asm volatile("" ::: "memory");
                f32x4 y = {0.f, 0.f, 0.f, 0.f};
#pragma unroll
                for (int s4 = 0; s4 < 4; ++s4) { const bf16x8 hf = *(const LAS bf16x8*)((LAS unsigned short*)HL + t16 * 136 + 32 * s4 + 8 * q4); y = __builtin_amdgcn_mfma_f32_16x16x32_bf16(cf[s4], hf, y, 0, 0, 0); }
                f32x4 z;
#pragma unroll
                for (int e = 0; e < 4; ++e) z[e] = gelu_tanh(y[e] + dv[e] * uv[e]);
                *(LAS f32x4*)(ZS + trow * 260 + g * 16 + 4 * q4) = z;
                LDS_WAIT(); asm volatile("" ::: "memory");
            }
        }
        if (c == 31) { a.out[O_SREP + (size_t)(b * 16 + g) * 64 + lane] = hr; a.out[O_SIMP + (size_t)(b * 16 + g) * 64 + lane] = hi; }
        if (hs) {
            float sre[4], sim[4];
#pragma unroll
            for (int j = 0; j < 4; ++j) { const size_t o = (size_t)((4 * item + j) * 16 + g) * 64 + lane; sre[j] = a.in[I_SRE][o]; sim[j] = a.in[I_SIM][o]; }
            const bf16x8 ua = ssm_loadu(U, RS0, 16, g, lane);
            const f32x4 uv = *(const f32x4*)(U + (size_t)(RS0 + t16) * 256 + g * 16 + 4 * q4);
            f32x16 xr[2], xi[2]; ssm_xcompute(ua, bb, xr, xi);
#pragma unroll
            for (int tt = 0; tt < 16; ++tt) {
                if ((tt & 3) == 0) { hr = sre[tt >> 2]; hi = sim[tt >> 2]; }
                const float nr = fmaf(ar, hr, fmaf(-ai, hi, SSM_XR(tt))), ni = fmaf(ar, hi, fmaf(ai, hr, SSM_XI(tt))); hr = nr; hi = ni;
                HL[tt * 68 + lane] = cvt_pk_bf16(hr, hi);
                if ((tt & 3) == 3) { const size_t o = (size_t)((4 * item + (tt >> 2)) * 16 + g) * 64 + lane; a.out[O_SRES + o] = hr; a.out[O_SIMS + o] = hi; }
            }
            LDS_WAIT(); asm volatile("" ::: "memory");
            f32x4 y = {0.f, 0.f, 0.f, 0.f};
#pragma unroll
            for (int s4 = 0; s4 < 4; ++s4) { const bf16x8 hf = *(const LAS bf16x8*)((LAS unsigned short*)HL + t16 * 136 + 32 * s4 + 8 * q4); y = __builtin_amdgcn_mfma_f32_16x16x32_bf16(cf[s4], hf, y, 0, 0, 0); }
            f32x4 z;
#pragma unroll
            for (int e = 0; e < 4; ++e) z[e] = gelu_tanh(y[e] + dv[e] * uv[e]);
            *(LAS f32x4*)(ZS + (64 + t16) * 260 + g * 16 + 4 * q4) = z;
            LDS_WAIT(); asm volatile("" ::: "memory");
        }
    }
    const int n = lane & 31, hi5 = lane >> 5, n0 = 32 * wave, nmt = hs ? 3 : 2;
    bf16x8 bfr[16];
#pragma unroll
    for (int st = 0; st < 16; ++st) bfr[st] = *(const bf16x8*)(WGLU + (size_t)(n0 + n) * 256 + 16 * st + 8 * hi5);
    const float bias = a.in[I_BGLU][n0 + n];
    const f32x4 gn = *(const f32x4*)(a.in[I_SON] + 4 * lane);
    __syncthreads();
    f32x16 acc[3];
#pragma unroll
    for (int mt = 0; mt < 3; ++mt) acc[mt] = (f32x16){0.f, 0.f, 0.f, 0.f, 0.f, 0.f, 0.f, 0.f, 0.f, 0.f, 0.f, 0.f, 0.f, 0.f, 0.f, 0.f};
#pragma unroll
    for (int st = 0; st < 16; ++st) {
        const bf16x8 bf = bfr[st];
#pragma unroll
        for (int mt = 0; mt < 3; ++mt) { if (mt < nmt) { const LAS float* zp = ZS + (32 * mt + n) * 260 + 16 * st + 8 * hi5; const f32x4 x = *(const LAS f32x4*)zp, y = *(const LAS f32x4*)(zp + 4);
            acc[mt] = __builtin_amdgcn_mfma_f32_32x32x16_bf16(pack8(x[0], x[1], x[2], x[3], y[0], y[1], y[2], y[3]), bf, acc[mt], 0, 0, 0); } }
    }
    float so[3][16];
#pragma unroll
    for (int mt = 0; mt < 3; ++mt) { if (mt < nmt) {
#pragma unroll
        for (int r = 0; r < 16; ++r) { const int t = 32 * mt + (r & 3) + 8 * (r >> 2) + 4 * hi5; so[mt][r] = ZS[t * 260 + n0 + n] * sigmoidf_(acc[mt][r] + bias); } } }
    __syncthreads();
#pragma unroll
    for (int mt = 0; mt < 3; ++mt) { if (mt < nmt) {
#pragma unroll
        for (int r = 0; r < 16; ++r) { const int t = 32 * mt + (r & 3) + 8 * (r >> 2) + 4 * hi5; ZS[t * 260 + n0 + n] = so[mt][r]; } } }
    __syncthreads();
#pragma unroll
    for (int i = 0; i < 10; ++i) { if (i >= 8 && !hs) break;
        const int row = i < 8 ? 8 * wave + i : 64 + 2 * wave + (i - 8); const f32x4 v = *(const LAS f32x4*)(ZS + row * 260 + 4 * lane);
        const float rs = frsq(wave_sum(dot4(v)) * (1.0f / 256.0f) + EPS); const f32x4 y = v * rs * gn;
        const size_t orow = i < 8 ? (size_t)(R0 + row) : (size_t)(RS0 + row - 64);
        u32x2 w; w.x = cvt_pk_bf16(y[0], y[1]); w.y = cvt_pk_bf16(y[2], y[3]); *(u32x2*)(MIXED + orow * D + 768 + 4 * lane) = w; }
    __syncthreads();
}

__device__ __forceinline__ float xq_sigma(const float* RS1, const float* QS, int R, int h) {
    const float rstd = frsq(RS1[R] * (1.0f / 1024.0f) + EPS), msq = QS[(size_t)R * 4 + h] * (1.0f / 256.0f);
    return rstd / sqrtf(rstd * rstd * msq + EPS) * (0.0625f * LOG2E);
}
template <int MODE, bool BASE_BF16 = false> __device__ __forceinline__ void sample_gemm_tile(const bf16* A, const bf16* Bt, int K, const void* base, float* outp, bf16* hb, float* ssq, LAS unsigned char* lds, int tile, int wave, int lane, int tid) {
    const int tm = tile >> 5, tn = tile & 31, n = lane & 31, hi = lane >> 5, kw = K >> 3;
    const bf16* ap = A + (size_t)(64 * tm + n) * K + wave * kw + 8 * hi;
    const bf16* bp = Bt + (size_t)(32 * tn + n) * K + wave * kw + 8 * hi;
    f32x16 acc0 = {0.f, 0.f, 0.f, 0.f, 0.f, 0.f, 0.f, 0.f, 0.f, 0.f, 0.f, 0.f, 0.f, 0.f, 0.f, 0.f}, acc1 = acc0;
    const int row = tid >> 3, c4 = (tid & 7) * 4, rs = 64 * tm + row, col = 32 * tn + c4;
    f32x4 bs = {0.f, 0.f, 0.f, 0.f};
    if (MODE == 0) {
        if (BASE_BF16) { const u32x2 w = *(const u32x2*)((const bf16*)base + (size_t)rs * D + col); bs = (f32x4){bf2f(w.x & 0xffffu), bf2f(w.x >> 16), bf2f(w.y & 0xffffu), bf2f(w.y >> 16)}; }
        else bs = *(const f32x4*)((const float*)base + (size_t)rs * D + col); }
#pragma unroll 8
    for (int s = 0; s < kw; s += 16) { const bf16x8 a0 = *(const bf16x8*)(ap + s), a1 = *(const bf16x8*)(ap + (size_t)32 * K + s), bb = *(const bf16x8*)(bp + s);
        acc0 = __builtin_amdgcn_mfma_f32_32x32x16_bf16(a0, bb, acc0, 0, 0, 0); acc1 = __builtin_amdgcn_mfma_f32_32x32x16_bf16(a1, bb, acc1, 0, 0, 0); }
    LAS float* P = (LAS float*)lds;
#pragma unroll
    for (int r = 0; r < 16; ++r) { const int row = (r & 3) + 8 * (r >> 2) + 4 * hi; P[(wave * 64 + row) * 32 + n] = acc0[r]; P[(wave * 64 + 32 + row) * 32 + n] = acc1[r]; }
    __syncthreads();
    f32x4 v = {0.f, 0.f, 0.f, 0.f};
#pragma unroll
    for (int w = 0; w < 8; ++w) v = v + *(const LAS f32x4*)(P + (w * 64 + row) * 32 + c4);
    float s;
    if (MODE == 0) {
        const f32x4 o = bs + v; if (outp) *(f32x4*)(outp + (size_t)rs * D + col) = o;
        if (hb) { u32x2 w; w.x = cvt_pk_bf16(o[0], o[1]); w.y = cvt_pk_bf16(o[2], o[3]); *(u32x2*)(hb + (size_t)rs * D + col) = w; }
        s = dot4(o); }
    else { u32x2 w; w.x = cvt_pk_bf16(v[0], v[1]); w.y = cvt_pk_bf16(v[2], v[3]); *(u32x2*)(hb + (size_t)rs * D + col) = w; s = dot4(v); }
    if (ssq) { s += __shfl_xor(s, 1); s += __shfl_xor(s, 2); s += __shfl_xor(s, 4); if ((tid & 7) == 0) atomic_addf(MODE == 0 ? ssq + rs : ssq + (size_t)rs * 4 + (tn >> 3), s); }
    __syncthreads();
}
constexpr int XK_ROW = 272, XK_BUF = 32 * XK_ROW, XV_BUF = XK_BUF, XV_OFF = 2 * XK_BUF;
__device__ __forceinline__ void xattn_wg_item(const bf16* QX, const float* SS1, const float* QSS, const bf16* MEMK, const bf16* MVT, bf16* OX, LAS unsigned char* lds, int it, int wave, int lane, int tid) {
    const int qb = it & 7, h = (it >> 3) & 3, b = it >> 5;
    const int n = lane & 31, hi = lane >> 5, R = b * 2048 + 256 * qb + 32 * wave + n;
    const float sigma = xq_sigma(SS1, QSS, R, h);
    const bf16* kg = MEMK + (size_t)(b * 256 + (tid >> 4)) * 1024 + h * 256 + 128 * ((tid >> 3) & 1) + 8 * (tid & 7);
    const bf16* vg = MVT + (size_t)(b * 256 + (tid >> 4)) * 1024 + h * 256 + 8 * (tid & 15);
    LAS unsigned char* kl = lds + (tid >> 4) * XK_ROW + (tid & 15) * 16;
    LAS unsigned char* vl = lds + XV_OFF + (tid >> 4) * XK_ROW + (tid & 15) * 16;
#define XSRC(t) ((t) < 16 ? (const u32x4*)(kg + (size_t)((t) & 7) * 32 * 1024 + ((t) >> 3) * 64) : (const u32x4*)(vg + (size_t)(((t) - 16) & 7) * 32 * 1024 + (((t) - 16) >> 3) * 128))
#define XPUT(t, w_) do { if ((t) < 16) *(LAS u32x4*)(kl + ((t) & 1) * XK_BUF) = (w_); else *(LAS u32x4*)(vl + ((t) & 1) * XV_BUF) = (w_); } while (0)
    u32x4 ring[3]; ring[0] = *XSRC(0); ring[1] = *XSRC(1); ring[2] = *XSRC(2);
    f32x16 sc[8];
#pragma unroll
    for (int kt = 0; kt < 8; ++kt) sc[kt] = (f32x16){0.f, 0.f, 0.f, 0.f, 0.f, 0.f, 0.f, 0.f, 0.f, 0.f, 0.f, 0.f, 0.f, 0.f, 0.f, 0.f};
    XPUT(0, ring[0]);
    __syncthreads();
    const LAS unsigned char* kr = lds + pi23(n) * XK_ROW + 128 * hi;
#pragma unroll
    for (int dh = 0; dh < 2; ++dh) {
        bf16x8 qf[8];
        { const bf16* qp = QX + (size_t)R * D + h * 256 + 128 * hi + 64 * dh;
#pragma unroll
          for (int st = 0; st < 8; ++st) qf[st] = *(const bf16x8*)(qp + 8 * st); }
#pragma unroll
        for (int kt = 0; kt < 8; ++kt) {
            const int s = dh * 8 + kt;
            ring[s % 3] = *XSRC(s + 3);
            const LAS unsigned char* kp = kr + (s & 1) * XK_BUF;
            bf16x8 kf[8];
#pragma unroll
            for (int st = 0; st < 8; ++st) kf[st] = *(const LAS bf16x8*)(kp + 16 * st);
            __builtin_amdgcn_sched_barrier(0);
#pragma unroll
            for (int st = 0; st < 8; ++st) sc[kt] = __builtin_amdgcn_mfma_f32_32x32x16_bf16(kf[st], qf[st], sc[kt], 0, 0, 0);
            XPUT(s + 1, ring[(s + 1) % 3]);
            asm volatile("s_waitcnt lgkmcnt(0)\n\ts_barrier" ::: "memory");
        }
    }
    float mx = -1e30f;
#pragma unroll
    for (int kt = 0; kt < 8; ++kt)
#pragma unroll
        for (int r = 0; r < 16; ++r) { sc[kt][r] *= sigma; mx = fmaxf(mx, sc[kt][r]); }
    mx = fmaxf(mx, __shfl_xor(mx, 32));
    float l = 0.f;
#pragma unroll
    for (int kt = 0; kt < 8; ++kt)
#pragma unroll
        for (int r = 0; r < 16; ++r) { const float p = fexp2(sc[kt][r] - mx); sc[kt][r] = p; l += p; }
    l += __shfl_xor(l, 32);
    const float il = frcp(l);
    bf16x8 pb[8][2];
#pragma unroll
    for (int kt = 0; kt < 8; ++kt)
#pragma unroll
        for (int jj = 0; jj < 2; ++jj) pb[kt][jj] = pack8(sc[kt][8 * jj + 0], sc[kt][8 * jj + 1], sc[kt][8 * jj + 2], sc[kt][8 * jj + 3], sc[kt][8 * jj + 4], sc[kt][8 * jj + 5], sc[kt][8 * jj + 6], sc[kt][8 * jj + 7]);
    LAS unsigned char* vr = lds + XV_OFF + (8 * hi + ((lane >> 2) & 3)) * XK_ROW + (16 * ((lane >> 4) & 1) + 4 * (lane & 3)) * 2;
    bf16* op = OX + (size_t)R * D + h * 256 + 4 * hi;
#pragma unroll
    for (int dh = 0; dh < 2; ++dh) {
        f32x16 o[4];
#pragma unroll
        for (int dt = 0; dt < 4; ++dt) o[dt] = (f32x16){0.f, 0.f, 0.f, 0.f, 0.f, 0.f, 0.f, 0.f, 0.f, 0.f, 0.f, 0.f, 0.f, 0.f, 0.f, 0.f};
#pragma unroll
        for (int kt = 0; kt < 8; ++kt) {
            const int s = 16 + dh * 8 + kt;
            if (s + 3 < 32) ring[s % 3] = *XSRC(s + 3);
            LAS unsigned char* vp = vr + (s & 1) * XV_BUF;
            bf16x8 vf[4][2];
#pragma unroll
            for (int dt = 0; dt < 4; ++dt)
#pragma unroll
                for (int jj = 0; jj < 2; ++jj) vf[dt][jj] = cat44(lds_tr4(vp + (16 * jj) * XK_ROW + 64 * dt), lds_tr4(vp + (16 * jj + 4) * XK_ROW + 64 * dt));
            __builtin_amdgcn_sched_barrier(0);
#pragma unroll
            for (int jj = 0; jj < 2; ++jj)
#pragma unroll
                for (int dt = 0; dt < 4; ++dt) o[dt] = __builtin_amdgcn_mfma_f32_32x32x16_bf16(vf[dt][jj], pb[kt][jj], o[dt], 0, 0, 0);
            if (s + 1 < 32) XPUT(s + 1, ring[(s + 1) % 3]);
            asm volatile("s_waitcnt lgkmcnt(0)\n\ts_barrier" ::: "memory");
        }
#pragma unroll
        for (int dt = 0; dt < 4; ++dt)
#pragma unroll
            for (int r4 = 0; r4 < 4; ++r4) { u32x2 w; w.x = cvt_pk_bf16(o[dt][4 * r4] * il, o[dt][4 * r4 + 1] * il); w.y = cvt_pk_bf16(o[dt][4 * r4 + 2] * il, o[dt][4 * r4 + 3] * il);
                *(u32x2*)(op + 128 * dh + 32 * dt + 8 * r4) = w; }
    }
}
#undef XSRC
#undef XPUT
constexpr int SXB = 4;
struct SxBatch { f32x4 k[SXB], v[SXB]; };
__device__ __forceinline__ void sx_load(SxBatch& B, const float* kb, unsigned loff, int j0) {
#pragma unroll
    for (int j = 0; j < SXB; ++j) { const char* p = (const char*)(kb + (size_t)(j0 + j) * 2048); B.k[j] = __builtin_nontemporal_load((const f32x4*)(p + loff)); B.v[j] = __builtin_nontemporal_load((const f32x4*)(p + 4096 + loff)); }
}
__device__ __forceinline__ float rdl(float v, int l) { return __builtin_bit_cast(float, __builtin_amdgcn_readlane(__builtin_bit_cast(int, v), l)); }
__device__ __forceinline__ void sx_compute(const SxBatch& B, const f32x4 (&q)[4], bool b5, bool b4, float& m, float& l, f32x4 (&o)[4]) {
    float s[SXB]; float mb = m;
#pragma unroll
    for (int j = 0; j < SXB; ++j) {
        float d[4];
#pragma unroll
        for (int t = 0; t < 4; ++t) d[t] = (q[t][0] * B.k[j][0] + q[t][1] * B.k[j][1]) + (q[t][2] * B.k[j][2] + q[t][3] * B.k[j][3]);
        const float x0 = b5 ? d[0] : d[2], x1 = b5 ? d[1] : d[3], k0 = b5 ? d[2] : d[0], k1 = b5 ? d[3] : d[1];
        const float r0 = k0 + __shfl_xor(x0, 32), r1 = k1 + __shfl_xor(x1, 32);
        const float xs = b4 ? r0 : r1, ks = b4 ? r1 : r0;
        float r = ks + __shfl_xor(xs, 16);
        r += __shfl_xor(r, 8); r += __shfl_xor(r, 4); r += __shfl_xor(r, 2); r += __shfl_xor(r, 1);
        s[j] = r; mb = fmaxf(mb, r);
    }
    const float sc = fexp2(m - mb); m = mb; l *= sc;
#pragma unroll
    for (int t = 0; t < 4; ++t) o[t] = o[t] * rdl(sc, 16 * t);
#pragma unroll
    for (int j = 0; j < SXB; ++j) { const float p = fexp2(s[j] - mb); l += p;
#pragma unroll
        for (int t = 0; t < 4; ++t) o[t] = o[t] + B.v[j] * rdl(p, 16 * t); }
}
template <int NSW> __device__ __forceinline__ void sxattn_stream(const Args& a, const bf16* QX, const float* SS1S, const float* QSSS, bf16* OX, LAS unsigned char* lds, LAS unsigned* cnt, int pair, int slot, int sw, int lane) {
    const int b = pair >> 2, h = pair & 3;
    LAS float* OL = (LAS float*)lds + (size_t)slot * (NSW * 1024); LAS float* ML = (LAS float*)(lds + 65536) + slot * 32; LAS float* LL = (LAS float*)(lds + 65536 + 256) + slot * 32;
    const f32x4 gq = *(const f32x4*)(a.in[I_XQN] + 4 * lane);
    f32x4 q[4];
    const float sgc = xq_sigma(SS1S, QSSS, MP + 4 * b + (lane >> 4), h);
#pragma unroll
    for (int t = 0; t < 4; ++t) { const int R = MP + 4 * b + t; const float sg = rdl(sgc, 16 * t); const u32x2 w = *(const u32x2*)(QX + (size_t)R * D + h * 256 + 4 * lane);
        q[t] = (f32x4){bf2f(w.x & 0xffffu), bf2f(w.x >> 16), bf2f(w.y & 0xffffu), bf2f(w.y >> 16)} * gq * sg; }
    constexpr int NK = 256 / NSW;
    const float* kb = a.in[I_CMEM] + ((size_t)(b * 256 + NK * sw) * 2) * 1024 + h * 256; const unsigned loff = 16u * (unsigned)lane;
    const bool b5 = (lane & 32) != 0, b4 = (lane & 16) != 0;
    float m = -1e30f, l = 0.f;
    f32x4 o[4];
#pragma unroll
    for (int t = 0; t < 4; ++t) o[t] = (f32x4){0.f, 0.f, 0.f, 0.f};
    SxBatch A, B; sx_load(A, kb, loff, 0);
#pragma unroll 1
    for (int j0 = 0; j0 < NK; j0 += 2 * SXB) {
        sx_load(B, kb, loff, j0 + SXB);
        sx_compute(A, q, b5, b4, m, l, o);
        if (j0 + 2 * SXB < NK) sx_load(A, kb, loff, j0 + 2 * SXB);
        sx_compute(B, q, b5, b4, m, l, o);
    }
#pragma unroll
    for (int t = 0; t < 4; ++t) *(LAS f32x4*)(OL + (sw * 4 + t) * 256 + 4 * lane) = o[t];
    if ((lane & 15) == 0) { ML[sw * 4 + (lane >> 4)] = m; LL[sw * 4 + (lane >> 4)] = l; }
    asm volatile("s_waitcnt lgkmcnt(0)" ::: "memory");
    unsigned old = 0u; if (lane == 0) old = __hip_atomic_fetch_add(cnt, 1u, __ATOMIC_ACQ_REL, __HIP_MEMORY_SCOPE_WORKGROUP);
    old = __builtin_amdgcn_readfirstlane(old);
    if (old == (unsigned)(NSW - 1)) {
        asm volatile("s_waitcnt lgkmcnt(0)" ::: "memory");
#pragma unroll
        for (int t = 0; t < 4; ++t) {
            float M = -1e30f;
#pragma unroll
            for (int w = 0; w < NSW; ++w) M = fmaxf(M, ML[w * 4 + t]);
            float L = 0.f; f32x4 acc = {0.f, 0.f, 0.f, 0.f};
#pragma unroll
            for (int w = 0; w < NSW; ++w) { const float f = fexp2(ML[w * 4 + t] - M); L += LL[w * 4 + t] * f; acc = acc + *(const LAS f32x4*)(OL + (w * 4 + t) * 256 + 4 * lane) * f; }
            const float il = frcp(L); u32x2 wv; wv.x = cvt_pk_bf16(acc[0] * il, acc[1] * il); wv.y = cvt_pk_bf16(acc[2] * il, acc[3] * il);
            *(u32x2*)(OX + (size_t)(MP + 4 * b + t) * D + h * 256 + 4 * lane) = wv;
        }
    }
}

__device__ __forceinline__ void up8(const bf16* p, float (&v)[8]) { const u32x4 w = *(const u32x4*)p;
    v[0] = bf2f(w.x & 0xffffu); v[1] = bf2f(w.x >> 16); v[2] = bf2f(w.y & 0xffffu); v[3] = bf2f(w.y >> 16); v[4] = bf2f(w.z & 0xffffu); v[5] = bf2f(w.z >> 16); v[6] = bf2f(w.w & 0xffffu); v[7] = bf2f(w.w >> 16); }
__device__ __forceinline__ void ld8(const float* p, float (&v)[8]) { const f32x4 a = *(const f32x4*)p, b = *(const f32x4*)(p + 4); v[0] = a[0]; v[1] = a[1]; v[2] = a[2]; v[3] = a[3]; v[4] = b[0]; v[5] = b[1]; v[6] = b[2]; v[7] = b[3]; }
__device__ __forceinline__ void conv_item(const Args& a, const bf16* UP, bf16* ACT, int it) {
    const int cgp = it % 352, rc = it / 352, j0 = cgp * 8, R0 = rc * 32;
    const float* cw = a.in[I_CONVW]; const float* cbp = a.in[I_CONVB];
    float wg[3][8], wv[3][8], bg[8], bv[8];
#pragma unroll
    for (int i = 0; i < 3; ++i) { ld8(cw + (size_t)i * FF2 + j0, wg[i]); ld8(cw + (size_t)i * FF2 + FF + j0, wv[i]); }
    ld8(cbp + j0, bg); ld8(cbp + FF + j0, bv);
    float g2[8], g1[8], v2[8], v1[8];
    const bool sample = R0 >= MP;
    if (!sample && (R0 & 2047) != 0) { up8(UP + (size_t)(R0 - 2) * FF2 + j0, g2); up8(UP + (size_t)(R0 - 1) * FF2 + j0, g1); up8(UP + (size_t)(R0 - 2) * FF2 + FF + j0, v2); up8(UP + (size_t)(R0 - 1) * FF2 + FF + j0, v1); }
    else {
#pragma unroll
        for (int e = 0; e < 8; ++e) { g2[e] = 0.f; g1[e] = 0.f; v2[e] = 0.f; v1[e] = 0.f; } }
    for (int r = 0; r < 32; ++r) { const int R = R0 + r;
        if (sample && (r & 3) == 0) { const float* sb = a.in[I_SCONV] + (size_t)((R - MP) >> 2) * 2 * FF2; ld8(sb + j0, g2); ld8(sb + FF2 + j0, g1); ld8(sb + FF + j0, v2); ld8(sb + FF2 + FF + j0, v1); }
        float gc[8], vc[8]; up8(UP + (size_t)R * FF2 + j0, gc); up8(UP + (size_t)R * FF2 + FF + j0, vc);
        float o[8];
#pragma unroll
        for (int e = 0; e < 8; ++e) { const float cgv = bg[e] + wg[0][e] * g2[e] + wg[1][e] * g1[e] + wg[2][e] * gc[e]; const float cvv = bv[e] + wv[0][e] * v2[e] + wv[1][e] * v1[e] + wv[2][e] * vc[e];
            o[e] = cgv * sigmoidf_(cgv) * cvv; g2[e] = g1[e]; g1[e] = gc[e]; v2[e] = v1[e]; v1[e] = vc[e]; }
        u32x4 w; w.x = cvt_pk_bf16(o[0], o[1]); w.y = cvt_pk_bf16(o[2], o[3]); w.z = cvt_pk_bf16(o[4], o[5]); w.w = cvt_pk_bf16(o[6], o[7]);
        *(u32x4*)(ACT + (size_t)R * FF + j0) = w;
    }
}

__device__ __forceinline__ void conv_fix_item(const Args& a, const float* EDGE, bf16* ACT, int it) {
    const int cgp = it % 352, rr = it / 352, r = rr & 1, ti = rr >> 1;
    const int pm = 8 * (ti / 7) + 1 + ti % 7, j0 = cgp * 8;
    const float* cw = a.in[I_CONVW]; const float* cbp = a.in[I_CONVB];
    const float* e_prev = EDGE + (size_t)(pm - 1) * 4 * FF2; const float* e_cur = EDGE + (size_t)pm * 4 * FF2;
    const float* r2 = r == 0 ? e_prev + 2 * FF2 : e_prev + 3 * FF2; const float* r1 = r == 0 ? e_prev + 3 * FF2 : e_cur; const float* r0 = r == 0 ? e_cur : e_cur + FF2;
    float o[8];
#pragma unroll
    for (int hf = 0; hf < 2; ++hf) { const int j4 = j0 + 4 * hf;
        const f32x4 cg = *(const f32x4*)(cbp + j4) + *(const f32x4*)(cw + j4) * *(const f32x4*)(r2 + j4) + *(const f32x4*)(cw + FF2 + j4) * *(const f32x4*)(r1 + j4) + *(const f32x4*)(cw + 2 * FF2 + j4) * *(const f32x4*)(r0 + j4);
        const f32x4 cv = *(const f32x4*)(cbp + FF + j4) + *(const f32x4*)(cw + FF + j4) * *(const f32x4*)(r2 + FF + j4) + *(const f32x4*)(cw + FF2 + FF + j4) * *(const f32x4*)(r1 + FF + j4) + *(const f32x4*)(cw + 2 * FF2 + FF + j4) * *(const f32x4*)(r0 + FF + j4);
#pragma unroll
        for (int e = 0; e < 4; ++e) o[4 * hf + e] = cg[e] * sigmoidf_(cg[e]) * cv[e]; }
    u32x4 w; w.x = cvt_pk_bf16(o[0], o[1]); w.y = cvt_pk_bf16(o[2], o[3]); w.z = cvt_pk_bf16(o[4], o[5]); w.w = cvt_pk_bf16(o[6], o[7]);
    *(u32x4*)(ACT + (size_t)(pm * 256 + r) * FF + j0) = w;
}

__device__ __forceinline__ void conv_fix_tile(const Args& a, const float* EDGE, bf16* ACT, int pm, int tid) {
    const float* cw = a.in[I_CONVW]; const float* cbp = a.in[I_CONVB];
    const float* e_prev = EDGE + (size_t)(pm - 1) * 4 * FF2; const float* e_cur = EDGE + (size_t)pm * 4 * FF2;
    for (int it = tid; it < 2 * 352; it += NWAVES * 64) { const int r = it / 352, j0 = (it - r * 352) * 8;
        const float* r2 = r == 0 ? e_prev + 2 * FF2 : e_prev + 3 * FF2; const float* r1 = r == 0 ? e_prev + 3 * FF2 : e_cur; const float* r0 = r == 0 ? e_cur : e_cur + FF2;
        float o[8];
#pragma unroll
        for (int hf = 0; hf < 2; ++hf) { const int j4 = j0 + 4 * hf;
            const f32x4 cg = *(const f32x4*)(cbp + j4) + *(const f32x4*)(cw + j4) * *(const f32x4*)(r2 + j4) + *(const f32x4*)(cw + FF2 + j4) * *(const f32x4*)(r1 + j4) + *(const f32x4*)(cw + 2 * FF2 + j4) * *(const f32x4*)(r0 + j4);
            const f32x4 cv = *(const f32x4*)(cbp + FF + j4) + *(const f32x4*)(cw + FF + j4) * *(const f32x4*)(r2 + FF + j4) + *(const f32x4*)(cw + FF2 + FF + j4) * *(const f32x4*)(r1 + FF + j4) + *(const f32x4*)(cw + 2 * FF2 + FF + j4) * *(const f32x4*)(r0 + FF + j4);
#pragma unroll
            for (int e = 0; e < 4; ++e) o[4 * hf + e] = cg[e] * sigmoidf_(cg[e]) * cv[e]; }
        u32x4 w; w.x = cvt_pk_bf16(o[0], o[1]); w.y = cvt_pk_bf16(o[2], o[3]); w.z = cvt_pk_bf16(o[4], o[5]); w.w = cvt_pk_bf16(o[6], o[7]);
        *(u32x4*)(ACT + (size_t)(pm * 256 + r) * FF + j0) = w; }
}

#ifndef MK_N_LAUNCHES
#define MK_N_LAUNCHES 1
#endif
constexpr int N_PHASES = 11;
#ifndef DUP_PHASE
#define DUP_PHASE -1
#endif
#define NREP(k) ((DUP_PHASE) == (k) ? 2 : 1)
constexpr int N_LAUNCHES = MK_N_LAUNCHES;
static_assert(N_LAUNCHES == 1 || N_LAUNCHES == N_PHASES, "MK_N_LAUNCHES is 1 or 11");

__global__ void __launch_bounds__(NWAVES * 64, 2) fwd_kernel(Args args) {
    extern __shared__ __attribute__((aligned(16))) unsigned char lds_raw[];
    LAS unsigned char* lds = (LAS unsigned char*)lds_raw;
    volatile LAS unsigned* MISC = (volatile LAS unsigned*)(lds + MISC_OFF);
    const int tid0 = threadIdx.x, wave0 = __builtin_amdgcn_readfirstlane(tid0 >> 6);
    const int G = gridDim.x; const int bx = blockIdx.x; const int vcu = (G % 8 == 0) ? (bx % 8) * (G / 8) + bx / 8 : bx;
    const int NGW = G * NWAVES;
    unsigned char* ws = args.ws;
    gu32* ctl = (gu32*)(ws + WS_CTL);
    for (int u = tid0; u < 128; u += NWAVES * 64) ((LAS unsigned*)(lds + MISC_OFF))[u] = 0u;
    __syncthreads();
    XcdBarrier bar; bar.bar = (unsigned*)(ctl + CW_BAR); bar.x = 0; bar.st = nullptr;
    if (N_LAUNCHES == 1) bar = xcd_barrier_post((unsigned*)(ctl + CW_BAR) + args.li * XCD_BAR_WORDS, MISC + 8);
#ifdef DOUBLE_BAR
#define GRID_BAR() do { if (N_LAUNCHES == 1) { xcd_barrier(bar); xcd_barrier(bar); } } while (0)
#else
#define GRID_BAR() do { if (N_LAUNCHES == 1) xcd_barrier(bar); } while (0)
#endif
    const int lo = args.ph_lo, hi = args.ph_hi;
#define IN(k) (lo <= (k) && (k) < hi)
#define WSBASE() GAS unsigned char* wsl = (GAS unsigned char*)ws; asm volatile("" : "+s"(wsl));     int tid = threadIdx.x; asm volatile("" : "+v"(tid)); const int lane = tid & 63, wave = __builtin_amdgcn_readfirstlane(tid >> 6), gw = vcu * NWAVES + wave; (void)lane; (void)gw
#define ROPE_ ((float*)(wsl + WS_ROPE))
#define SSMC_ ((float*)(wsl + WS_SSMC))
#define WIN ((bf16*)(wsl + WS_WIN))
#define WOUT ((bf16*)(wsl + WS_WOUT))
#define WXQ ((bf16*)(wsl + WS_WXQ))
#define WXKV ((bf16*)(wsl + WS_WXKV))
#define WXO ((bf16*)(wsl + WS_WXO))
#define WUP ((bf16*)(wsl + WS_WUP))
#define WDOWN ((bf16*)(wsl + WS_WDOWN))
#define WGLU ((bf16*)(wsl + WS_WGLU))
#define XN ((bf16*)(wsl + WS_XN))
#define MEMN ((bf16*)(wsl + WS_MEMN))
#define Qb ((bf16*)(wsl + WS_Q))
#define Kb ((bf16*)(wsl + WS_K))
#define VT ((bf16*)(wsl + WS_VT))
#define U_ ((float*)(wsl + WS_U))
#define AO ((bf16*)(wsl + WS_AO))
#define LSE ((float*)(wsl + WS_LSE))
#define SSMF ((float*)(wsl + WS_SSMF))
#define MIXED ((bf16*)(wsl + WS_MIXED))
#define H1B ((bf16*)(wsl + WS_H1B))
#define SS1 ((float*)(wsl + WS_CTL + CTL_RS1))
#define QX ((bf16*)(wsl + WS_QX))
#define QSS ((float*)(wsl + WS_CTL + CTL_QS))
#define MSS ((float*)(wsl + WS_MSS))
#define MEMK ((bf16*)(wsl + WS_MEMK))
#define MVT ((bf16*)(wsl + WS_MVT))
#define OX ((bf16*)(wsl + WS_OX))
#define H2B ((bf16*)(wsl + WS_H2B))
#define SS2 ((float*)(wsl + WS_CTL + CTL_RS2))
#define UP ((bf16*)(wsl + WS_UP))
#define ACT ((bf16*)(wsl + WS_ACT))
#define SS1S (SS1 + MP)
#define QSSS (QSS + (size_t)MP * 4)
#define SS2S (SS2 + MP)
    float* out = args.out;

    if (IN(0)) for (int rep_ = 0; rep_ < NREP(0); ++rep_) { WSBASE();
        LAS float* scr = (LAS float*)(lds + wave * 16384);
        constexpr int I_IN = 16 * (INW / 32), I_SQ = 16 * (D / 32), I_KV = 16 * (2048 / 32), I_UP = 16 * (FF2 / 32), I_DN = (FF / 64) * (D / 32), I_GL = 4 * 8;
        constexpr int NIT = I_IN + 3 * I_SQ + I_KV + I_UP + I_DN + I_GL;
        for (int it = gw; it < NIT; it += NGW) {
            int r = it;
            if (r < I_IN) { p0_transpose_item<1>(args.in[I_WIN], D, INW, WIN, nullptr, scr, r, lane); continue; } r -= I_IN;
            if (r < I_SQ) { p0_transpose_item<0>(args.in[I_WOUT], D, D, WOUT, nullptr, scr, r, lane); continue; } r -= I_SQ;
            if (r < I_SQ) { p0_transpose_item<0>(args.in[I_WXQ], D, D, WXQ, args.in[I_NX], scr, r, lane); continue; } r -= I_SQ;
            if (r < I_SQ) { p0_transpose_item<0>(args.in[I_WXO], D, D, WXO, nullptr, scr, r, lane); continue; } r -= I_SQ;
            if (r < I_KV) { p0_transpose_item<0>(args.in[I_WXKV], D, 2048, WXKV, nullptr, scr, r, lane); continue; } r -= I_KV;
            if (r < I_UP) { p0_transpose_item<2>(args.in[I_WUP], D, FF2, WUP, args.in[I_NFFN], scr, r, lane); continue; } r -= I_UP;
            if (r < I_DN) { p0_transpose_item<0>(args.in[I_WDOWN], FF, D, WDOWN, nullptr, scr, r, lane); continue; } r -= I_DN;
            p0_transpose_item<0>(args.in[I_WGLU], 256, 256, WGLU, nullptr, scr, r, lane);
        }
        { f32x4 gg[4];
#pragma unroll
          for (int j = 0; j < 4; ++j) gg[j] = ((const f32x4*)args.in[I_NMIX])[lane + 64 * j];
          for (int m = 2 * gw; m < MT; m += 2 * NGW) { const float* x0 = m < MP ? args.in[I_XP] + (size_t)m * D : args.in[I_XS] + (size_t)(m - MP) * D;
              rms_rows2_to_bf16(x0, x0 + D, gg, XN + (size_t)m * D, XN + (size_t)(m + 1) * D, lane); }
#pragma unroll
          for (int j = 0; j < 4; ++j) gg[j] = ((const f32x4*)args.in[I_NMEM])[lane + 64 * j];
          for (int m = 2 * gw; m < MM; m += 2 * NGW) rms_rows2_to_bf16(args.in[I_MEM] + (size_t)m * D, args.in[I_MEM] + (size_t)(m + 1) * D, gg, MEMN + (size_t)m * D, MEMN + (size_t)(m + 1) * D, lane); }
        {
            const int gt = vcu * (NWAVES * 64) + tid;
            if (gt < 2052 * 8) { const int pos = gt >> 3, i = gt & 7; const float iv = i == 0 ? 1.0f : i == 1 ? 0.1939227432012558f : i == 2 ? 0.03760603070259094f : i == 3 ? 0.007292664609849453f : i == 4 ? 0.0014142135623842478f : i == 5 ? 0.00027424818836152554f : i == 6 ? 5.3182957344688475e-05f : 1.0313385246263351e-05f;
                const float ang = (float)pos * iv; double s, c; sincos_d((double)ang, s, c); ROPE_[pos * 16 + i] = (float)c; ROPE_[pos * 16 + 8 + i] = (float)s; }
            const int st = gt - 2052 * 8;
            if (st >= 0 && st < 1024) {
                const int g = st >> 6; const double dt = exp_d((double)args.in[I_LDT][g]); const double lr = (double)args.in[I_LRE][st], li = (double)args.in[I_LIM][st];
                const double mag = exp_d(lr * dt); double s, c; sincos_d(li * dt, s, c); const double are = mag * c, aim = mag * s;
                const double den = lr * lr + li * li, nr = are - 1.0, ni = aim; const double cre = (nr * lr + ni * li) / den, cim = (ni * lr - nr * li) / den;
                const double mag64 = exp_d(64.0 * lr * dt); double s64, c64; sincos_d(64.0 * li * dt, s64, c64);
                float* o = SSMC_ + (size_t)st * 8; o[0] = (float)are; o[1] = (float)aim; o[2] = (float)cre; o[3] = (float)cim; o[4] = (float)(mag64 * c64); o[5] = (float)(mag64 * s64); o[6] = 0.f; o[7] = 0.f; }
        }
        GRID_BAR();
    }

    if (IN(1)) for (int rep_ = 0; rep_ < NREP(1); ++rep_) { WSBASE();
        int base = 0;
        { pg8::Gemm g{XN, WIN, MT, INW, D}; pg8::RotOrder S; S.init(MT, INW, G, bx, base); base += S.nwg;
          pg8::EpiZ E{Qb, Kb, VT, U_, ROPE_, args.in[I_QN], args.in[I_KN], out};
          pg8::gemm_phase<pg8::EpiZ, pg8::RotOrder, true, true>(lds, g, S, E); }
        { pg8::Gemm g{MEMN, WXKV, MM, 2048, D}; pg8::RotOrder S; S.init(MM, 2048, G, bx, base); base += S.nwg;
          pg8::EpiMem E{out + O_MEMKV, MSS, MVT}; pg8::gemm_phase<pg8::EpiMem, pg8::RotOrder, true, true>(lds, g, S, E); }
        GRID_BAR();
    }

    if (IN(2)) for (int rep_ = 0; rep_ < NREP(2); ++rep_) { WSBASE();
        LAS float* uL = (LAS float*)(lds + wave * 4096);
        const int swapo = (bx >> 3) & 1;
#pragma unroll 1
        for (int pass = 0; pass < 2; ++pass) {
            if (pass == swapo) {
                for (int it = vcu; it < 3 * 256; it += G) pattn_wg_item(Qb, Kb, VT, AO, LSE, lds, it, wave, lane, tid);
            } else {
                if (wave < 6) { for (int it = vcu * 6 + wave; it < 3 * 512; it += G * 6) sattn_item(args, Qb, AO, LSE, it, lane); }
                else { if (rep_ == 0) for (int it = vcu * 2 + (wave - 6); it < MM; it += G * 2) memk_fix_item(out + O_MEMKV, MSS, args.in[I_XKN], args.in[I_XQN], MEMK, it, lane);
                       for (int it = vcu * 2 + (wave - 6); it < 8 * 31 * 16; it += G * 2) ssm_a_item(args, U_, SSMC_, SSMF, uL, it, lane); }
            }
            __syncthreads();
        }
        GRID_BAR();
    }

    if (IN(3)) for (int rep_ = 0; rep_ < NREP(3); ++rep_) { WSBASE();
#if defined(PROBE_LDS_FILL)
        for (int u_ = tid; u_ < 134656 / 4; u_ += NWAVES * 64) ((LAS unsigned*)lds)[u_] = PROBE_LDS_FILL;
        __syncthreads();
#endif
#if defined(PROBE_DELAY_P3)
        for (int i_ = 0; i_ < 10; ++i_) __builtin_amdgcn_s_sleep(127);
        __builtin_amdgcn_fence(__ATOMIC_ACQUIRE, "agent"); asm volatile("s_waitcnt vmcnt(0)" ::: "memory"); __syncthreads();
#endif
        for (int r1_ = 0; r1_ < ((DUP_PHASE) == 31 ? 2 : 1); ++r1_)
        if (G > 64) {
            if (vcu >= 32) { const int ncw = (G - 32) * NWAVES; for (int R = ((vcu - 32) * NWAVES + wave) * 8; R < MT; R += ncw * 8) combine_rows<8>(AO, LSE, args.in[I_AON], MIXED, R, lane); }
        } else { for (int R = gw * 4; R < MT; R += NGW * 4) combine_rows<4>(AO, LSE, args.in[I_AON], MIXED, R, lane); }
#if defined(PROBE_P3_TWICE)
        for (int it = vcu; it < 256; it += G) ssm_c_item(args, U_, SSMC_, SSMF, WGLU, (bf16*)(wsl + 644 * MiB), lds, it, wave, lane);
#endif
        for (int r2_ = 0; r2_ < ((DUP_PHASE) == 32 ? 2 : 1); ++r2_)
        for (int it = vcu; it < 256; it += G) ssm_c_item(args, U_, SSMC_, SSMF, WGLU, MIXED, lds, it, wave, lane);
        GRID_BAR();
    }

    if (IN(4)) for (int rep_ = 0; rep_ < NREP(4); ++rep_) { WSBASE();
        pg8::Gemm g{MIXED, WOUT, MP, D, D}; pg8::RotOrder S; S.init(MP, D, G, bx, 0);
        pg8::EpiRes<false, false> E{args.in[I_XP], nullptr, H1B, SS1}; pg8::gemm_phase<pg8::EpiRes<false, false>, pg8::RotOrder, true, true>(lds, g, S, E);
        for (int tile = bx; tile < 256; tile += G)
            sample_gemm_tile<0, false>(MIXED + (size_t)MP * D, WOUT, D, args.in[I_XS], nullptr, H1B + (size_t)MP * D, SS1S, lds, tile, wave, lane, tid);
        GRID_BAR();
    }
    if (IN(5)) for (int rep_ = 0; rep_ < NREP(5); ++rep_) { WSBASE();
        pg8::Gemm g{H1B, WXQ, MP, D, D}; pg8::RotOrder S; S.init(MP, D, G, bx, 0);
        pg8::EpiQx E{QX, QSS}; pg8::gemm_phase<pg8::EpiQx, pg8::RotOrder, true, true>(lds, g, S, E);
        for (int tile = bx; tile < 256; tile += G)
            sample_gemm_tile<1>(H1B + (size_t)MP * D, WXQ, D, nullptr, nullptr, QX + (size_t)MP * D, QSSS, lds, tile, wave, lane, tid);
        GRID_BAR();
    }
    if (IN(6)) for (int rep_ = 0; rep_ < NREP(6); ++rep_) { WSBASE();
        if (tid < 8) ((LAS unsigned*)(lds + MISC_OFF))[16 + tid] = 0u;
        __syncthreads();
        int swapo = (bx >> 3) & 1; asm volatile("" : "+s"(swapo));
#pragma unroll 1
        for (int pass = 0; pass < 2; ++pass) {
            if (pass == swapo) {
                int tid3 = threadIdx.x; asm volatile("" : "+v"(tid3)); const int lane3 = tid3 & 63, wave3 = __builtin_amdgcn_readfirstlane(tid3 >> 6);
                GAS unsigned char* wsl3 = (GAS unsigned char*)ws; asm volatile("" : "+s"(wsl3));
                int slot = 0;
                for (int pair = vcu; pair < BS * 4; pair += G, ++slot) sxattn_stream<8>(args, (bf16*)(wsl3 + WS_QX), (float*)(wsl3 + WS_CTL + CTL_RS1), (float*)(wsl3 + WS_CTL + CTL_QS), (bf16*)(wsl3 + WS_OX), lds, (LAS unsigned*)(lds + MISC_OFF) + 16 + (slot & 7), pair, slot & 1, wave3, lane3);
            } else {
                int tid2 = threadIdx.x; asm volatile("" : "+v"(tid2)); const int lane2 = tid2 & 63, wave2 = __builtin_amdgcn_readfirstlane(tid2 >> 6);
                GAS unsigned char* wsl2 = (GAS unsigned char*)ws; asm volatile("" : "+s"(wsl2));
                for (int it = vcu; it < 8 * 4 * 8; it += G) xattn_wg_item((bf16*)(wsl2 + WS_QX), (float*)(wsl2 + WS_CTL + CTL_RS1), (float*)(wsl2 + WS_CTL + CTL_QS), (bf16*)(wsl2 + WS_MEMK), (bf16*)(wsl2 + WS_MVT), (bf16*)(wsl2 + WS_OX), lds, it, wave2, lane2, tid2);
            }
            __syncthreads();
        }
        GRID_BAR();
    }
    if (IN(7)) for (int rep_ = 0; rep_ < NREP(7); ++rep_) { WSBASE();
        pg8::Gemm g{OX, WXO, MP, D, D}; pg8::RotOrder S; S.init(MP, D, G, bx, 0);
        pg8::EpiRes<true, false> E{H1B, nullptr, H2B, SS2}; pg8::gemm_phase<pg8::EpiRes<true, false>, pg8::RotOrder, true, true>(lds, g, S, E);
        for (int tile = bx; tile < 256; tile += G)
            sample_gemm_tile<0, true>(OX + (size_t)MP * D, WXO, D, H1B + (size_t)MP * D, nullptr, H2B + (size_t)MP * D, SS2S, lds, tile, wave, lane, tid);
        GRID_BAR();
    }
    if (IN(8)) for (int rep_ = 0; rep_ < NREP(8); ++rep_) { WSBASE();
        pg8::Gemm g{H2B, WUP, MT, FF2, D}; pg8::RotOrder S; S.init(MT, FF2, G, bx, 0);
        pg8::EpiUpConv E{ACT, (float*)(wsl + WS_EDGE), SS2, args.in[I_CONVW], args.in[I_CONVB], args.in[I_SCONV], out + O_CONVP, out + O_CONVS, lds}; pg8::gemm_phase<pg8::EpiUpConv, pg8::RotOrder, true, true>(lds, g, S, E);
        GRID_BAR();
    }
    if (IN(10)) for (int rep_ = 0; rep_ < NREP(10); ++rep_) { WSBASE();
        pg8::Gemm g{ACT, WDOWN, MP, D, FF}; pg8::RotOrder S; S.init(MP, D, G, bx, 0);
        { pg8::Unit uu; for (int i = 0; S.next(i, uu); ++i) if ((uu.pm & 7) != 0) conv_fix_tile(args, (const float*)(wsl + WS_EDGE), ACT, uu.pm, tid);
          VM_WAIT(); __syncthreads(); }
        pg8::EpiRes<true, true> E{H2B, out, nullptr, nullptr}; pg8::gemm_phase<pg8::EpiRes<true, true>, pg8::RotOrder, true, true>(lds, g, S, E);
        for (int tile = bx; tile < 256; tile += G)
            sample_gemm_tile<0, true>(ACT + (size_t)MP * FF, WDOWN, FF, H2B + (size_t)MP * D, out + (size_t)MP * D, nullptr, nullptr, lds, tile, wave, lane, tid);
    }
#if defined(DBG_SCALE_MASK)
    if (hi == N_PHASES) { GRID_BAR();
        const size_t offs[16] = {O_YP, O_YS, O_KV1P, O_KV4P, O_KV16P, O_SREP, O_SIMP, O_CONVP, O_MEMKV, O_KV1S, O_KV4S, O_KV16S, O_SRES, O_SIMS, O_CONVS, O_END};
        const size_t gt = (size_t)vcu * (NWAVES * 64) + tid, NT = (size_t)G * NWAVES * 64;
#pragma unroll
        for (int o = 0; o < 15; ++o) if ((DBG_SCALE_MASK >> o) & 1) { for (size_t i = offs[o] + gt; i < offs[o + 1]; i += NT) out[i] *= 3.0f; }
    }
#endif
#undef IN
#undef GRID_BAR
}


#if defined(PROBE_DET) || defined(PROBE_P3_TWICE)
__global__ void det_cmp_kernel(const unsigned* a, const unsigned* b, size_t nwords, unsigned* counter, int tol, int rw, int lo, int hi) {
    unsigned c = 0;
    for (size_t i = (size_t)blockIdx.x * blockDim.x + threadIdx.x; i < nwords; i += (size_t)gridDim.x * blockDim.x) {
        if (rw > 0) { const int cw = (int)(i % (size_t)rw); if (cw < lo || cw >= hi) continue; }
        const unsigned x = a[i], y = b[i];
        if (tol) { const float fx = __uint_as_float(x), fy = __uint_as_float(y); if (!(fabsf(fx - fy) <= 0.02f)) ++c; } else if (x != y) { ++c; atomicMin(counter + 32, (unsigned)i); atomicMax(counter + 48, (unsigned)i); } }
    if (c) atomicAdd(counter, c);
}
__global__ void det_mark_kernel(const unsigned* counters, int nreg, float* y, size_t n, int forced) {
    int r = -1; for (int i = nreg - 1; i >= 0; --i) if (counters[i] != 0u) r = i;
#if defined(PROBE_DET_COUNT)
    { const unsigned c = counters[PROBE_DET_COUNT], fw = counters[32 + PROBE_DET_COUNT], lw = counters[48 + PROBE_DET_COUNT]; const int fitem = (int)(fw / 512u) / 64, litem = (int)(lw / 512u) / 64;
      r = -1;
      if (c) { switch (PROBE_DET_MODE) { case 1: r = (int)(c >> 10); break; case 2: r = fitem >> 4; break; case 3: r = fitem & 15; break; case 4: r = litem - fitem; break; case 5: r = (int)((fw / 512u) & 63) >> 2; break; case 6: r = (int)(fw & 511u) >> 5; break; default: r = 0; } if (r > 21) r = 21; } }
#endif
    if (forced >= 0) r = forced;
#if defined(PROBE_CAL)
    r = (int)((wall_clock64() >> 12) & 1) ? 19 : -1;
#endif
    if (r < 0) return;
    const float f = 1.0f + 0.1f * (float)(r + 1);
    for (size_t i = (size_t)blockIdx.x * blockDim.x + threadIdx.x; i < n; i += (size_t)gridDim.x * blockDim.x) y[i] *= f;
}
#endif

extern "C" void kernel_launch(void* const* d_in, const int* in_sizes, int n_in, void* d_out, int out_size, void* d_ws, size_t ws_size, hipStream_t stream) {
    static int grid = 0;
    if (grid == 0) {
        if (n_in != 39 || (size_t)out_size != O_END || ws_size < WS_END) { fprintf(stderr, "kernel_launch: unexpected problem shape (n_in %d, out %d, ws %zu); nothing launched\n", n_in, out_size, ws_size); grid = -1; return; }
        int dev = 0, cus = 0, per_cu = 0;
        if (hipGetDevice(&dev) != hipSuccess || hipDeviceGetAttribute(&cus, hipDeviceAttributeMultiprocessorCount, dev) != hipSuccess) { grid = -1; return; }
        if (hipFuncSetAttribute((const void*)fwd_kernel, hipFuncAttributeMaxDynamicSharedMemorySize, LDS_BYTES) != hipSuccess) { fprintf(stderr, "kernel_launch: hipFuncSetAttribute failed\n"); grid = -1; return; }
        if (hipOccupancyMaxActiveBlocksPerMultiprocessor(&per_cu, (const void*)fwd_kernel, NWAVES * 64, LDS_BYTES) != hipSuccess || per_cu < 1) { fprintf(stderr, "kernel_launch: occupancy query says %d workgroups per CU\n", per_cu); (void)hipGetLastError(); grid = -1; return; }
        grid = cus;
    }
    if (grid < 0) return;
    (void)hipMemsetAsync((char*)d_ws + WS_CTL, 0, CTL_ZERO_BYTES, stream);
    Args a{};
    for (int i = 0; i < 39; ++i) a.in[i] = (const float*)d_in[i];
    a.out = (float*)d_out; a.ws = (unsigned char*)d_ws;
#if defined(PROBE_PRE_HI)
    a.ph_lo = 0; a.ph_hi = PROBE_PRE_HI; a.li = 1; a.pad = 0;
    hipLaunchKernelGGL(fwd_kernel, dim3(grid), dim3(NWAVES * 64), LDS_BYTES, stream, a);
    (void)hipMemsetAsync((char*)d_ws + WS_CTL, 0, CTL_ZERO_BYTES, stream);
#endif
#if defined(PROBE_DET)
    {
        const size_t SP = 644 * MiB, need = 1005 * MiB;
        char* w = (char*)d_ws; float* o = (float*)d_out;
        if (ws_size >= need) {
            a.ph_lo = 0; a.ph_hi = N_PHASES; a.li = 0; a.pad = 0;
            hipLaunchKernelGGL(fwd_kernel, dim3(grid), dim3(NWAVES * 64), LDS_BYTES, stream, a);
#if defined(PROBE_DUMP)
            (void)hipMemcpyAsync(w + SP + 190 * MiB, w + 191 * MiB, 33 * MiB, hipMemcpyDeviceToDevice, stream);
            (void)hipMemcpyAsync(w + 760 * MiB, w + 724 * MiB, 34 * MiB, hipMemcpyDeviceToDevice, stream);
#else
            (void)hipMemcpyAsync(w + SP, w + 1 * MiB, 223 * MiB, hipMemcpyDeviceToDevice, stream);
            (void)hipMemcpyAsync(w + SP + 223 * MiB, w + 295 * MiB, 4 * MiB, hipMemcpyDeviceToDevice, stream);
            (void)hipMemcpyAsync(w + SP + 227 * MiB, d_out, O_END * 4, hipMemcpyDeviceToDevice, stream);
#endif
#if defined(PROBE_DET_POISON)
            (void)hipMemsetAsync(w + PROBE_DET_POISON_LO * MiB, 0xAA, (size_t)(PROBE_DET_POISON_HI - PROBE_DET_POISON_LO) * MiB, stream);
#endif
            (void)hipMemsetAsync(w + WS_CTL, 0, CTL_ZERO_BYTES, stream);
        }
    }
#endif
    for (int li = 0; li < N_LAUNCHES; ++li) {
        a.li = 0; a.pad = 0;
        a.ph_lo = (N_LAUNCHES == 1) ? 0 : li; a.ph_hi = (N_LAUNCHES == 1) ? N_PHASES : li + 1;
        hipLaunchKernelGGL(fwd_kernel, dim3(grid), dim3(NWAVES * 64), LDS_BYTES, stream, a);
        const hipError_t le = hipPeekAtLastError();
        if (le != hipSuccess) { fprintf(stderr, "kernel_launch: launch %d failed: %s\n", li, hipGetErrorName(le)); break; }
    }
#if defined(PROBE_P3_TWICE)
    {   char* w = (char*)d_ws; float* o = (float*)d_out; unsigned* cnt = (unsigned*)(w + 643 * MiB + 900 * 1024);
        (void)hipMemsetAsync(cnt, 0, 256, stream); (void)hipMemsetAsync(cnt + 32, 0xFF, 64, stream);
        hipLaunchKernelGGL(det_cmp_kernel, dim3(2048), dim3(256), 0, stream, (const unsigned*)(w + WS_MIXED), (const unsigned*)(w + 644 * MiB), (size_t)MP * D * 2 / 4, cnt + PROBE_DET_COUNT, 0, 512, 384, 512);
        hipLaunchKernelGGL(det_mark_kernel, dim3(32), dim3(256), 0, stream, cnt, 1, o + O_SREP, (size_t)BP * 1024, -1);
    }
#endif
#if defined(PROBE_DET)
    {
        const size_t SP = 644 * MiB, need = 1005 * MiB;
        char* w = (char*)d_ws; float* o = (float*)d_out; unsigned* cnt = (unsigned*)(w + 640 * MiB);
        cnt = (unsigned*)(w + 643 * MiB + 900 * 1024);
        if (ws_size < need) { hipLaunchKernelGGL(det_mark_kernel, dim3(1024), dim3(256), 0, stream, cnt, 0, o, (size_t)MP * D, 19); }
        else {
            (void)hipMemsetAsync(cnt, 0, 256, stream); (void)hipMemsetAsync(cnt + 32, 0xFF, 64, stream);
            const char* c0 = w + SP - 1 * MiB;
            const float* oc = (const float*)(w + SP + 227 * MiB);
            struct Reg { const void* a; const void* b; size_t bytes; int tol; };
            struct Reg2 { const void* a; const void* b; size_t bytes; int rw, lo, hi; };
#if defined(PROBE_DUMP)
            const Reg2 regs[5] = {
                {w + 724 * MiB, w + 760 * MiB, (size_t)8 * MiB, 0, 0, 0}, {w + 741 * MiB, w + 777 * MiB, (size_t)2 * MiB, 0, 0, 0},
                {w + WS_MIXED, c0 + WS_MIXED, (size_t)MP * D * 2, 512, 384, 512}, {w + WS_MIXED, c0 + WS_MIXED, (size_t)MP * D * 2, 512, 384, 512}, {w + WS_MIXED, c0 + WS_MIXED, (size_t)MP * D * 2, 512, 384, 512} };
#else
            const Reg2 regs[14] = {
                {w + WS_U, c0 + WS_U, (size_t)MT * 256 * 4, 0, 0, 0}, {w + WS_Q, c0 + WS_Q, (size_t)MT * 768 * 2, 0, 0, 0}, {w + WS_K, c0 + WS_K, (size_t)MT * 768 * 2, 0, 0, 0}, {w + WS_VT, c0 + WS_VT, (size_t)MP * 768 * 2, 0, 0, 0},
                {o + O_KV1P, oc + O_KV1P, (O_SREP - O_KV1P) * 4, 0, 0, 0}, {o + O_MEMKV, oc + O_MEMKV, (O_KV1S - O_MEMKV) * 4, 0, 0, 0}, {o + O_KV1S, oc + O_KV1S, (O_SRES - O_KV1S) * 4, 0, 0, 0},
                {w + WS_SSMF, c0 + WS_SSMF, 2 * MiB, 0, 0, 0}, {w + WS_AO, c0 + WS_AO, (size_t)MT * 768 * 2, 0, 0, 0}, {w + WS_LSE, c0 + WS_LSE, (size_t)MT * 12 * 4, 0, 0, 0}, {w + WS_MEMK, w + SP + 223 * MiB, 4 * MiB, 0, 0, 0},
                {o + O_SREP, oc + O_SREP, (O_CONVP - O_SREP) * 4, 0, 0, 0}, {o + O_SRES, oc + O_SRES, (O_CONVS - O_SRES) * 4, 0, 0, 0}, {w + WS_MIXED, c0 + WS_MIXED, (size_t)MT * D * 2, 0, 0, 0} };
#endif
            for (int r = 0; r < (int)(sizeof(regs) / sizeof(regs[0])); ++r) hipLaunchKernelGGL(det_cmp_kernel, dim3(2048), dim3(256), 0, stream, (const unsigned*)regs[r].a, (const unsigned*)regs[r].b, regs[r].bytes / 4, cnt + r, 0, regs[r].rw, regs[r].lo, regs[r].hi);
            hipLaunchKernelGGL(det_mark_kernel, dim3(32), dim3(256), 0, stream, cnt, 14, o + O_SREP, (size_t)BP * 1024, -1);
        }
    }
#endif
}
```

```cpp
#include <hip/hip_runtime.h>
#include <cstdio>
#include <cstdint>

#define GAS __attribute__((address_space(1)))
#define LAS __attribute__((address_space(3)))
#define PG8_LAS __attribute__((address_space(3)))
typedef unsigned short bf16;
typedef short bf16x8 __attribute__((ext_vector_type(8)));
typedef float f32x4 __attribute__((ext_vector_type(4)));
typedef float f32x2 __attribute__((ext_vector_type(2)));
typedef float f32x16 __attribute__((ext_vector_type(16)));
typedef unsigned u32x4 __attribute__((ext_vector_type(4)));
typedef unsigned u32x2 __attribute__((ext_vector_type(2)));
typedef GAS unsigned gu32;
#define RLX_AGENT __ATOMIC_RELAXED, __HIP_MEMORY_SCOPE_AGENT
#define LDS_WAIT() asm volatile("s_waitcnt lgkmcnt(0)" ::: "memory")
#define VM_WAIT() asm volatile("s_waitcnt vmcnt(0)" ::: "memory")

constexpr int D = 1024, BP = 8, LP = 2048, MP = BP * LP, BS = 128, TS = 4, MS = BS * TS, MT = MP + MS;
constexpr int INW = 2560, AW = 768, SW = 256, NMEM = 256, MM = BP * NMEM, FF = 2816, FF2 = 5632;
constexpr float EPS = 1e-6f;
constexpr float LOG2E = 1.4426950408889634f, LN2 = 0.6931471805599453f;
constexpr int NWAVES = 8;

constexpr size_t MiB = 1u << 20;
constexpr size_t WS_CTL = 0, CTL_ZERO_BYTES = 1 * MiB;
constexpr size_t WS_ROPE = 1 * MiB;
constexpr size_t WS_SSMC = 1 * MiB + 512 * 1024;
constexpr size_t WS_WIN = 2 * MiB, WS_WOUT = 7 * MiB, WS_WXQ = 9 * MiB, WS_WXKV = 11 * MiB, WS_WXO = 15 * MiB, WS_WUP = 17 * MiB, WS_WDOWN = 28 * MiB, WS_WGLU = 34 * MiB;
constexpr size_t WS_XN = 35 * MiB, WS_MEMN = 68 * MiB, WS_Q = 72 * MiB, WS_K = 97 * MiB, WS_VT = 122 * MiB, WS_U = 146 * MiB, WS_AO = 163 * MiB, WS_LSE = 188 * MiB;
constexpr size_t WS_SSMF = 189 * MiB, WS_MIXED = 191 * MiB, WS_H1B = 224 * MiB, WS_SS1 = 257 * MiB, WS_QX = 259 * MiB, WS_QSS = 292 * MiB, WS_MSS = 294 * MiB, WS_MEMK = 295 * MiB, WS_MVT = 299 * MiB;
constexpr size_t WS_OX = 303 * MiB, WS_H2B = 336 * MiB, WS_SS2 = 369 * MiB, WS_UP = 371 * MiB, WS_ACT = 553 * MiB, WS_END = 644 * MiB;
constexpr size_t WS_EDGE = 371 * MiB;
constexpr size_t WS_SS1S = 258 * MiB + 512 * 1024, WS_QSSS = 293 * MiB + 512 * 1024, WS_SS2S = 370 * MiB + 512 * 1024;
constexpr size_t CTL_RS1 = 128 * 1024, CTL_RS2 = 256 * 1024, CTL_QS = 384 * 1024;
constexpr int CW_BAR = 4096;

constexpr int RING_BYTES = 131072;
constexpr int MISC_OFF = 135168;
constexpr int LDS_BYTES = 147456;

__device__ __forceinline__ unsigned f2bf(float f) { unsigned u = __builtin_bit_cast(unsigned, f); return (u + 0x7fffu + ((u >> 16) & 1u)) >> 16; }
__device__ __forceinline__ unsigned pk2(float lo, float hi) { return f2bf(lo) | (f2bf(hi) << 16); }
__device__ __forceinline__ float bf2f(unsigned h) { return __builtin_bit_cast(float, h << 16); }
typedef __bf16 bf16v2_t __attribute__((ext_vector_type(2)));
__device__ __forceinline__ unsigned cvt_pk_bf16(float lo, float hi) { const f32x2 v = {lo, hi}; return __builtin_bit_cast(unsigned, __builtin_convertvector(v, bf16v2_t)); }
__device__ __forceinline__ bf16x8 pack8(float a0, float a1, float a2, float a3, float a4, float a5, float a6, float a7) {
    u32x4 w; w.x = cvt_pk_bf16(a0, a1); w.y = cvt_pk_bf16(a2, a3); w.z = cvt_pk_bf16(a4, a5); w.w = cvt_pk_bf16(a6, a7); return __builtin_bit_cast(bf16x8, w); }
__device__ __forceinline__ float wave_sum(float v) {
#pragma unroll
    for (int o = 1; o < 64; o <<= 1) v += __shfl_xor(v, o);
    return v;
}
__device__ __forceinline__ float fexp2(float x) { return __builtin_amdgcn_exp2f(x); }
__device__ __forceinline__ float flog2(float x) { return __builtin_amdgcn_logf(x); }
__device__ __forceinline__ float frcp(float x) { return __builtin_amdgcn_rcpf(x); }
__device__ __forceinline__ float frsq(float x) { return __builtin_amdgcn_rsqf(x); }
__device__ __forceinline__ void sincos_d(double x, double& s, double& c) {
    const double k = __builtin_rint(x * 0.63661977236758134308);
    double r = __builtin_fma(-k, 1.57079632679489655800e+00, x); r = __builtin_fma(-k, 6.12323399573676603587e-17, r);
    const long long q = (long long)k; const double r2 = r * r;
    double sp = 1.0 / 6227020800.0; sp = sp * r2 - 1.0 / 39916800.0; sp = sp * r2 + 1.0 / 362880.0; sp = sp * r2 - 1.0 / 5040.0; sp = sp * r2 + 1.0 / 120.0; sp = sp * r2 - 1.0 / 6.0; sp = sp * r2 + 1.0; sp = sp * r;
    double cp = -1.0 / 87178291200.0; cp = cp * r2 + 1.0 / 479001600.0; cp = cp * r2 - 1.0 / 3628800.0; cp = cp * r2 + 1.0 / 40320.0; cp = cp * r2 - 1.0 / 720.0; cp = cp * r2 + 1.0 / 24.0; cp = cp * r2 - 0.5; cp = cp * r2 + 1.0;
    const int qq = (int)(q & 3);
    s = (qq == 0) ? sp : (qq == 1) ? cp : (qq == 2) ? -sp : -cp;
    c = (qq == 0) ? cp : (qq == 1) ? -sp : (qq == 2) ? -cp : sp;
}
__device__ __forceinline__ double exp_d(double x) {
    const double k = __builtin_rint(x * 1.44269504088896340736);
    double r = __builtin_fma(-k, 6.93147180369123816490e-01, x); r = __builtin_fma(-k, 1.90821492927058770002e-10, r);
    double p = 1.0 / 6227020800.0;
    p = p * r + 1.0 / 479001600.0; p = p * r + 1.0 / 39916800.0; p = p * r + 1.0 / 3628800.0; p = p * r + 1.0 / 362880.0; p = p * r + 1.0 / 40320.0; p = p * r + 1.0 / 5040.0;
    p = p * r + 1.0 / 720.0; p = p * r + 1.0 / 120.0; p = p * r + 1.0 / 24.0; p = p * r + 1.0 / 6.0; p = p * r + 0.5; p = p * r + 1.0; p = p * r + 1.0;
    const int ki = (int)k;
    return __builtin_ldexp(p, ki);
}
__device__ __forceinline__ float dot4(f32x4 a) { return (a[0] * a[0] + a[1] * a[1]) + (a[2] * a[2] + a[3] * a[3]); }
__device__ __forceinline__ u32x4 pk8(f32x4 a, f32x4 b) { u32x4 w; w.x = cvt_pk_bf16(a[0], a[1]); w.y = cvt_pk_bf16(a[2], a[3]); w.z = cvt_pk_bf16(b[0], b[1]); w.w = cvt_pk_bf16(b[2], b[3]); return w; }
__device__ __forceinline__ f32x4 shx16(f32x4 a) { f32x4 r; r[0] = __shfl_xor(a[0], 16); r[1] = __shfl_xor(a[1], 16); r[2] = __shfl_xor(a[2], 16); r[3] = __shfl_xor(a[3], 16); return r; }
constexpr size_t O_KV1P_ = (size_t)MT * D, O_KV4P_ = O_KV1P_ + (size_t)BP * 128 * 512, O_KV16P_ = O_KV4P_ + (size_t)BP * 512 * 512;
constexpr size_t O_KV1S_ = O_KV16P_ + (size_t)BP * 2048 * 512 + 2 * BP * 1024 + (size_t)BP * 2 * FF2 + (size_t)MM * 2048, O_KV4S_ = O_KV1S_ + (size_t)MS * 512, O_KV16S_ = O_KV4S_ + (size_t)MS * 512;
typedef short s16x4 __attribute__((ext_vector_type(4)));
__device__ __forceinline__ s16x4 lds_tr4(LAS unsigned char* p) { return __builtin_bit_cast(s16x4, __builtin_amdgcn_ds_read_tr16_b64_v4i16((LAS s16x4*)p)); }
__device__ __forceinline__ bf16x8 cat44(s16x4 a, s16x4 b) { return (bf16x8){a[0], a[1], a[2], a[3], b[0], b[1], b[2], b[3]}; }
__device__ __forceinline__ void atomic_addf(float* p, float v) { (void)__hip_atomic_fetch_add(p, v, __ATOMIC_RELAXED, __HIP_MEMORY_SCOPE_AGENT); }

namespace pg8 {
#define PG8_LAS __attribute__((address_space(3)))
typedef unsigned short bf16_t;
typedef short bf16x8 __attribute__((ext_vector_type(8)));
typedef float f32x4 __attribute__((ext_vector_type(4)));
typedef unsigned u32x4 __attribute__((ext_vector_type(4)));
constexpr int BM = 256, BK = 64, HALF = 128, HTB = HALF * BK * 2  , STAGE_BYTES = 8 * HTB, NXCD = 8, WGM = 8;

__host__ __device__ __forceinline__ int lds_byte(int r, int c) { const int st = (r >> 4) * 2 + (c >> 5), rr = r & 15, cc = c & 31, ob = rr * 64 + cc * 2; return st * 1024 + (ob ^ (((ob >> 9) & 1) << 5)); }
__host__ __device__ __forceinline__ void stage_rc(int b, int& R, int& C) { const int st = b / 1024, sb = b % 1024, swz = sb ^ (((sb >> 9) & 1) << 5); R = (st >> 1) * 16 + swz / 64; C = (st & 1) * 32 + (swz % 64) / 2; }
__host__ __device__ __forceinline__ int perm32(int rho) { const int n = rho >> 4, i = rho & 15; return 8 * (i >> 2) + 4 * n + (i & 3); }

struct Unit { int pm, pn; };
struct Gemm { const bf16_t* A; const bf16_t* Bt; int M, N, K; };

struct StaticOrder {
    int nM, nN, nwg, G, c;
    __host__ __device__ void init(int M, int N, int G_, int c_) { nM = M / BM; nN = N / BM; nwg = nM * nN; G = G_; c = c_; }
    __host__ __device__ bool next(int i, Unit& u) const {
        const long L = (long)i * G + c; if (L >= nwg) return false;
        int wgid = (int)L; { const int q = nwg / NXCD, r = nwg % NXCD, xcd = wgid % NXCD, off = wgid / NXCD; wgid = (xcd < r ? xcd * (q + 1) : r * (q + 1) + (xcd - r) * q) + off; }
        const int nig = WGM * nN, gid = wgid / nig, fm = gid * WGM, gsz = (nM - fm) < WGM ? (nM - fm) : WGM;
        u.pm = fm + ((wgid % nig) % gsz); u.pn = (wgid % nig) / gsz; return true;
    }
    __device__ __forceinline__ void a_ready(const Unit&) const {}
    __device__ __forceinline__ void done(const Unit&) const {}
};


struct RotOrder {
    int nM, nN, nwg, G, c;
    __host__ __device__ void init(int M, int N, int G_, int blk, int base) { nM = M / BM; nN = N / BM; nwg = nM * nN; G = G_; const int rot = base % G_; c = blk - rot; if (c < 0) c += G_; }
    __host__ __device__ __forceinline__ bool next(int i, Unit& u) const {
        const long L = (long)i * G + c; if (L >= nwg) return false;
        int wgid = (int)L; { const int q = nwg / NXCD, r = nwg % NXCD, xcd = wgid % NXCD, off = wgid / NXCD; wgid = (xcd < r ? xcd * (q + 1) : r * (q + 1) + (xcd - r) * q) + off; }
        const int nig = WGM * nN, gid = wgid / nig, fm = gid * WGM, gsz = (nM - fm) < WGM ? (nM - fm) : WGM;
        u.pm = fm + ((wgid % nig) % gsz); u.pn = (wgid % nig) / gsz; return true;
    }
    __device__ __forceinline__ void a_ready(const Unit&) const {}
    __device__ __forceinline__ void done(const Unit&) const {}
};


struct EpiZ {
    static constexpr bool PERM = true, AFTER_DRAIN = false, BMAP = false, AMAP = false;
    bf16_t* Q; bf16_t* Kb; bf16_t* VN; float* U; const float* rope; const float* qg; const float* kg;
    float* outp;
    __device__ __forceinline__ int bmap(int r) const { return r; }
    __device__ __forceinline__ void operator()(const f32x4 (&acc)[2][2][4][2], const Unit& u, int wr, int wc, int fr, int fq) const {
        const int pn = u.pn; const bool sample = u.pm >= 64;
        const int rbase = u.pm * BM + wr * 64 + fr;
        if (pn == 9) {
#pragma unroll
            for (int ai = 0; ai < 2; ++ai)
#pragma unroll
                for (int m = 0; m < 4; ++m) { const int R = rbase + ai * HALF + m * 16; float* p = U + (size_t)R * 256 + wc * 64 + 8 * fq;
#pragma unroll
                    for (int bj = 0; bj < 2; ++bj) { *(f32x4*)(p + 32 * bj) = acc[ai][bj][m][0]; *(f32x4*)(p + 32 * bj + 4) = acc[ai][bj][m][1]; } }
            return;
        }
        const int kind = pn / 3, g = pn - 3 * kind;
        const int keep = g == 0 ? 128 : (g == 1 ? 512 : 2048);
        float* kvp = outp + (g == 0 ? O_KV1P_ : (g == 1 ? O_KV4P_ : O_KV16P_)); float* kvs = outp + (g == 0 ? O_KV1S_ : (g == 1 ? O_KV4S_ : O_KV16S_));
        if (kind == 2) {
#pragma unroll
            for (int ai = 0; ai < 2; ++ai)
#pragma unroll
                for (int m = 0; m < 4; ++m) { const int R = rbase + ai * HALF + m * 16; float* dst = nullptr;
                    if (sample) dst = kvs + ((size_t)(R - MP) * 2 + 1) * 256;
                    else { const int b = R >> 11, t = R & 2047; if (t >= 2048 - keep) dst = kvp + ((size_t)(b * keep + t - (2048 - keep)) * 2 + 1) * 256; }
                    if (dst) { dst += wc * 64 + 8 * fq;
#pragma unroll
                        for (int bj = 0; bj < 2; ++bj) { *(f32x4*)(dst + 32 * bj) = acc[ai][bj][m][0]; *(f32x4*)(dst + 32 * bj + 4) = acc[ai][bj][m][1]; } }
                    if (!sample) { bf16_t* vp = VN + (size_t)R * AW + g * 256 + wc * 64 + 8 * fq;
                        *(u32x4*)vp = pk8(acc[ai][0][m][0], acc[ai][0][m][1]); *(u32x4*)(vp + 32) = pk8(acc[ai][1][m][0], acc[ai][1][m][1]); } }
            return;
        }
        const float* gp = (kind == 0 ? qg : kg) + 8 * fq;
        const f32x4 g00 = *(const f32x4*)(gp), g01 = *(const f32x4*)(gp + 4), g10 = *(const f32x4*)(gp + 32), g11 = *(const f32x4*)(gp + 36);
        const float sgn = fq == 0 ? -1.f : 1.f;
        const float qs = kind == 0 ? 0.125f * LOG2E : 1.f;
        bf16_t* ob = kind == 0 ? Q : Kb;
        f32x4 rc0, rc1, rs0, rs1;
        { const int R = rbase; const int pos = sample ? 2048 + (R & 3) : (R & 2047); const float* rp = rope + (size_t)pos * 16; rc0 = *(const f32x4*)rp; rc1 = *(const f32x4*)(rp + 4); rs0 = *(const f32x4*)(rp + 8); rs1 = *(const f32x4*)(rp + 12); }
#pragma unroll
        for (int ai = 0; ai < 2; ++ai)
#pragma unroll
            for (int m = 0; m < 4; ++m) { const int R = rbase + ai * HALF + m * 16;
                const f32x4 c0 = rc0, c1 = rc1, s0 = rs0, s1 = rs1;
                if (ai * 4 + m < 7) { const int Rn = rbase + ((ai * 4 + m + 1) >> 2) * HALF + ((ai * 4 + m + 1) & 3) * 16; const int pos = sample ? 2048 + (Rn & 3) : (Rn & 2047); const float* rp = rope + (size_t)pos * 16;
                    rc0 = *(const f32x4*)rp; rc1 = *(const f32x4*)(rp + 4); rs0 = *(const f32x4*)(rp + 8); rs1 = *(const f32x4*)(rp + 12); }
                float ss = (dot4(acc[ai][0][m][0]) + dot4(acc[ai][0][m][1])) + (dot4(acc[ai][1][m][0]) + dot4(acc[ai][1][m][1])); ss += __shfl_xor(ss, 16); ss += __shfl_xor(ss, 32);
                const float rs = frsq(ss * (1.0f / 64.0f) + EPS);
                float* dst = nullptr;
                if (kind == 1) { if (sample) dst = kvs + ((size_t)(R - MP) * 2) * 256; else { const int b = R >> 11, t = R & 2047; if (t >= 2048 - keep) dst = kvp + ((size_t)(b * keep + t - (2048 - keep)) * 2) * 256; }
                    if (dst) dst += wc * 64 + 8 * fq; }
                bf16_t* op = ob + (size_t)R * AW + g * 256 + wc * 64 + 8 * fq;
                f32x4 xa = acc[ai][0][m][0] * rs * g00, xb = acc[ai][0][m][1] * rs * g01;
                { const f32x4 oa = shx16(xa), ob2 = shx16(xb);
                  if (fq < 2) { xa = xa * c0 + (oa * s0) * sgn; xb = xb * c1 + (ob2 * s1) * sgn; } }
                if (dst) { *(f32x4*)(dst) = xa; *(f32x4*)(dst + 4) = xb; }
                *(u32x4*)(op) = pk8(xa * qs, xb * qs);
                xa = acc[ai][1][m][0] * rs * g10; xb = acc[ai][1][m][1] * rs * g11;
                if (dst) { *(f32x4*)(dst + 32) = xa; *(f32x4*)(dst + 36) = xb; }
                *(u32x4*)(op + 32) = pk8(xa * qs, xb * qs);
            }
    }
};

struct EpiVt {
    static constexpr bool PERM = true, AFTER_DRAIN = false, BMAP = true, AMAP = false;
    bf16_t* VT; int g;
    __device__ __forceinline__ int bmap(int r) const { return g == 0 ? r : (g == 1 ? ((r & 63) * 4 + (r >> 6)) : ((r & 15) * 16 + (r >> 4))); }
    __device__ __forceinline__ void operator()(const f32x4 (&acc)[2][2][4][2], const Unit& u, int wr, int wc, int fr, int fq) const {
        const int b = u.pn >> 3, t0 = (u.pn & 7) * 256, sh = 2 * g, S = 2048 >> sh, Wl = 8 - sh;
#pragma unroll
        for (int ai = 0; ai < 2; ++ai)
#pragma unroll
            for (int m = 0; m < 4; ++m) { const int hh = 2 * wr + (m >> 1), d = 32 * ai + 16 * (m & 1) + fr;
#pragma unroll
                for (int bj = 0; bj < 2; ++bj) { const int c8 = 128 * bj + 32 * wc + 8 * fq, res = c8 >> Wl, ds = c8 & ((1 << Wl) - 1), pos = res * S + (t0 >> sh) + ds;
                    bf16_t* p = VT + ((((size_t)((g * 4 + hh) * 8 + b) * 64 + (pos >> 5)) * 64 + d) * 32 + (pos & 31));
                    *(u32x4*)p = pk8(acc[ai][bj][m][0], acc[ai][bj][m][1]); } }
    }
};

struct EpiMem {
    static constexpr bool PERM = true, AFTER_DRAIN = false, BMAP = false, AMAP = false;
    float* out; float* mss; bf16_t* MVN;
    __device__ __forceinline__ int bmap(int r) const { return r; }
    __device__ __forceinline__ void operator()(const f32x4 (&acc)[2][2][4][2], const Unit& u, int wr, int wc, int fr, int fq) const {
        const int kv = u.pn >> 2, h = u.pn & 3;
#pragma unroll
        for (int ai = 0; ai < 2; ++ai)
#pragma unroll
            for (int m = 0; m < 4; ++m) { const int R = u.pm * BM + ai * HALF + wr * 64 + m * 16 + fr; float* dst = out + ((size_t)R * 2 + kv) * 1024 + h * 256 + 32 * wc + 8 * fq; float ss = 0.f;
#pragma unroll
                for (int bj = 0; bj < 2; ++bj) { const f32x4 a = acc[ai][bj][m][0], c = acc[ai][bj][m][1]; *(f32x4*)(dst + 128 * bj) = a; *(f32x4*)(dst + 128 * bj + 4) = c; ss += dot4(a) + dot4(c);
                    if (kv) *(u32x4*)(MVN + (size_t)R * 1024 + h * 256 + 32 * wc + 8 * fq + 128 * bj) = pk8(a, c); }
                if (kv == 0) { ss += __shfl_xor(ss, 16); ss += __shfl_xor(ss, 32); if (fq == 0) mss[(size_t)R * 16 + h * 4 + wc] = ss; } }
    }
};
struct EpiMemVt {
    static constexpr bool PERM = true, AFTER_DRAIN = false, BMAP = false, AMAP = false;
    bf16_t* MVT;
    __device__ __forceinline__ int bmap(int r) const { return r; }
    __device__ __forceinline__ void operator()(const f32x4 (&acc)[2][2][4][2], const Unit& u, int wr, int wc, int fr, int fq) const {
        const int h = u.pm, b = u.pn;
#pragma unroll
        for (int ai = 0; ai < 2; ++ai)
#pragma unroll
            for (int m = 0; m < 4; ++m) { const int d = ai * HALF + wr * 64 + m * 16 + fr;
#pragma unroll
                for (int bj = 0; bj < 2; ++bj) { const int c8 = 128 * bj + 32 * wc + 8 * fq;
                    bf16_t* p = MVT + ((((size_t)(h * 8 + b) * 8 + (c8 >> 5)) * 256 + d) * 32 + (c8 & 31));
                    *(u32x4*)p = pk8(acc[ai][bj][m][0], acc[ai][bj][m][1]); } }
    }
};
template <bool BASE_BF16, bool OUT_F32> struct EpiRes {
    static constexpr bool PERM = true, AFTER_DRAIN = false, BMAP = false, AMAP = false;
    const void* base; float* out; bf16_t* hb; float* ssq;
    __device__ __forceinline__ int bmap(int r) const { return r; }
    __device__ __forceinline__ void operator()(const f32x4 (&acc)[2][2][4][2], const Unit& u, int wr, int wc, int fr, int fq) const {
        const int c0 = u.pn * BM + 32 * wc + 8 * fq;
#pragma unroll
        for (int ai = 0; ai < 2; ++ai) {
            f32x4 b0[4][2], b1[4][2];
#pragma unroll
            for (int m = 0; m < 4; ++m)
#pragma unroll
                for (int bj = 0; bj < 2; ++bj) { const size_t off = (size_t)(u.pm * BM + ai * HALF + wr * 64 + m * 16 + fr) * D + c0 + 128 * bj;
                    if (BASE_BF16) { const u32x4 w = *(const u32x4*)((const bf16_t*)base + off); b0[m][bj] = (f32x4){bf2f(w.x & 0xffffu), bf2f(w.x >> 16), bf2f(w.y & 0xffffu), bf2f(w.y >> 16)}; b1[m][bj] = (f32x4){bf2f(w.z & 0xffffu), bf2f(w.z >> 16), bf2f(w.w & 0xffffu), bf2f(w.w >> 16)}; }
                    else { b0[m][bj] = *(const f32x4*)((const float*)base + off); b1[m][bj] = *(const f32x4*)((const float*)base + off + 4); } }
            asm volatile("" ::: "memory");
#pragma unroll
            for (int m = 0; m < 4; ++m) { const int R = u.pm * BM + ai * HALF + wr * 64 + m * 16 + fr; float ss = 0.f;
#pragma unroll
                for (int bj = 0; bj < 2; ++bj) { const size_t off = (size_t)R * D + c0 + 128 * bj;
                    const f32x4 o0 = b0[m][bj] + acc[ai][bj][m][0], o1 = b1[m][bj] + acc[ai][bj][m][1];
                    if (OUT_F32) { *(f32x4*)(out + off) = o0; *(f32x4*)(out + off + 4) = o1; }
                    if (hb) *(u32x4*)(hb + off) = pk8(o0, o1);
                    ss += dot4(o0) + dot4(o1); }
                if (ssq) { ss += __shfl_xor(ss, 16); ss += __shfl_xor(ss, 32); if (fq == 0) atomic_addf(ssq + R, ss); } }
        }
    }
};
struct EpiQx {
    static constexpr bool PERM = true, AFTER_DRAIN = false, BMAP = false, AMAP = false;
    bf16_t* QX; float* qss;
    __device__ __forceinline__ int bmap(int r) const { return r; }
    __device__ __forceinline__ void operator()(const f32x4 (&acc)[2][2][4][2], const Unit& u, int wr, int wc, int fr, int fq) const {
        const int c0 = u.pn * BM + 32 * wc + 8 * fq;
#pragma unroll
        for (int ai = 0; ai < 2; ++ai)
#pragma unroll
            for (int m = 0; m < 4; ++m) { const int R = u.pm * BM + ai * HALF + wr * 64 + m * 16 + fr; float ss = 0.f;
#pragma unroll
                for (int bj = 0; bj < 2; ++bj) { const f32x4 a = acc[ai][bj][m][0], c = acc[ai][bj][m][1]; *(u32x4*)(QX + (size_t)R * D + c0 + 128 * bj) = pk8(a, c); ss += dot4(a) + dot4(c); }
                ss += __shfl_xor(ss, 16); ss += __shfl_xor(ss, 32); if (fq == 0) atomic_addf(qss + (size_t)R * 4 + u.pn, ss); }
    }
};
template <int CTRL> __device__ __forceinline__ float dppf(float old, float src) { return __builtin_bit_cast(float, __builtin_amdgcn_update_dpp(__builtin_bit_cast(int, old), __builtin_bit_cast(int, src), CTRL, 0xf, 0xf, false)); }
__device__ __forceinline__ f32x4 prev_rows1(f32x4 pg, f32x4 cur) { f32x4 r;
#pragma unroll
    for (int e = 0; e < 4; ++e) r[e] = dppf<0x111>(dppf<0x121>(0.f, pg[e]), cur[e]);
    return r; }
__device__ __forceinline__ f32x4 prev_rows2(f32x4 pg, f32x4 cur) { f32x4 r;
#pragma unroll
    for (int e = 0; e < 4; ++e) r[e] = dppf<0x112>(dppf<0x122>(0.f, pg[e]), cur[e]);
    return r; }
__device__ __forceinline__ float silu_(float x) { return x * frcp(1.0f + fexp2(-x * LOG2E)); }
constexpr int HALO_OFF = 135680;
struct EpiUpConv {
    static constexpr bool PERM = true, AFTER_DRAIN = false, BMAP = false, AMAP = true;
    bf16_t* ACT; float* EDGE; const float* rs2; const float* cw; const float* cb; const float* sconv; float* convp; float* convs; PG8_LAS unsigned char* lds;
    __device__ __forceinline__ int bmap(int r) const { return r; }
    __device__ __forceinline__ int amap(int r) const { return (r & 64) + 4 * (r & 15) + ((r >> 4) & 3); }
    __device__ __forceinline__ void operator()(f32x4 (&acc)[2][2][4][2], const Unit& u, int wr, int wc, int fr, int fq) const {
        const bool smp = u.pm >= 64;
        const int j8 = u.pn * 128 + 32 * wc + 8 * fq;
        f32x4 cwv[8];
#define UPC_LOADW(n_) do { const int j4_ = j8 + 4 * (n_); cwv[0] = *(const f32x4*)(cw + j4_); cwv[1] = *(const f32x4*)(cw + FF2 + j4_); cwv[2] = *(const f32x4*)(cw + 2 * FF2 + j4_); cwv[3] = *(const f32x4*)(cb + j4_); \
        cwv[4] = *(const f32x4*)(cw + FF + j4_); cwv[5] = *(const f32x4*)(cw + FF2 + FF + j4_); cwv[6] = *(const f32x4*)(cw + 2 * FF2 + FF + j4_); cwv[7] = *(const f32x4*)(cb + FF + j4_); } while (0)
        UPC_LOADW(0);
        const int tok0 = u.pm * BM + wr * 64 + 4 * fr;
        { float tot[2][4];
#pragma unroll
          for (int ai = 0; ai < 2; ++ai)
#pragma unroll
              for (int m = 0; m < 4; ++m) tot[ai][m] = rs2[tok0 + ai * HALF + m];
#pragma unroll
          for (int ai = 0; ai < 2; ++ai)
#pragma unroll
              for (int m = 0; m < 4; ++m) { const float rstd = frsq(tot[ai][m] * (1.0f / 1024.0f) + EPS);
#pragma unroll
                  for (int bj = 0; bj < 2; ++bj) { acc[ai][bj][m][0] = acc[ai][bj][m][0] * rstd; acc[ai][bj][m][1] = acc[ai][bj][m][1] * rstd; } } }
        PG8_LAS float* halo = (PG8_LAS float*)(lds + HALO_OFF);
        if (!smp && fr == 15) {
#pragma unroll
            for (int ai = 0; ai < 2; ++ai)
#pragma unroll
                for (int mm = 2; mm < 4; ++mm) { PG8_LAS float* hp = halo + ((((2 * ai + wr + 1) * 2 + (mm - 2)) * 4 + wc) * 4 + fq) * 16;
                    *(PG8_LAS f32x4*)(hp) = acc[ai][0][mm][0]; *(PG8_LAS f32x4*)(hp + 4) = acc[ai][0][mm][1]; *(PG8_LAS f32x4*)(hp + 8) = acc[ai][1][mm][0]; *(PG8_LAS f32x4*)(hp + 12) = acc[ai][1][mm][1]; }
        }
        asm volatile("s_waitcnt lgkmcnt(0)\n\ts_barrier" ::: "memory");
#pragma unroll
        for (int n = 0; n < 2; ++n) {
            const int j4 = j8 + 4 * n;
            if (n == 1) UPC_LOADW(1);
            const f32x4 wg0 = cwv[0], wg1 = cwv[1], wg2 = cwv[2], bgv = cwv[3], wv0 = cwv[4], wv1 = cwv[5], wv2 = cwv[6], bvv = cwv[7];
#pragma unroll
            for (int ai = 0; ai < 2; ++ai) {
                const int blk = 2 * ai + wr, tokb = tok0 + ai * HALF;
                f32x4 gm1, gm2, vm1, vm2;
                if (smp) { const float* sb = sconv + (size_t)((tokb - MP) >> 2) * 2 * FF2;
                    gm2 = *(const f32x4*)(sb + j4); vm2 = *(const f32x4*)(sb + FF + j4); gm1 = *(const f32x4*)(sb + FF2 + j4); vm1 = *(const f32x4*)(sb + FF2 + FF + j4); }
                else { f32x4 h2g = {0.f, 0.f, 0.f, 0.f}, h3g = h2g, h2v = h2g, h3v = h2g;
                    if (blk > 0 && fr == 0) { const PG8_LAS float* hp = halo + (((blk * 2) * 4 + wc) * 4 + fq) * 16; h2g = *(const PG8_LAS f32x4*)(hp + 4 * n); h2v = *(const PG8_LAS f32x4*)(hp + 8 + 4 * n);
                        h3g = *(const PG8_LAS f32x4*)(hp + 256 + 4 * n); h3v = *(const PG8_LAS f32x4*)(hp + 256 + 8 + 4 * n); }
#pragma unroll
                    for (int e = 0; e < 4; ++e) { gm1[e] = dppf<0x111>(h3g[e], acc[ai][0][3][n][e]); gm2[e] = dppf<0x111>(h2g[e], acc[ai][0][2][n][e]); vm1[e] = dppf<0x111>(h3v[e], acc[ai][1][3][n][e]); vm2[e] = dppf<0x111>(h2v[e], acc[ai][1][2][n][e]); } }
#pragma unroll
                for (int m = 0; m < 4; ++m) { const int R = tokb + m;
                    const f32x4 g = acc[ai][0][m][n], v = acc[ai][1][m][n];
                    const f32x4 g1 = m == 0 ? gm1 : acc[ai][0][m > 0 ? m - 1 : 0][n], v1 = m == 0 ? vm1 : acc[ai][1][m > 0 ? m - 1 : 0][n];
                    const f32x4 g2 = m == 0 ? gm2 : (m == 1 ? gm1 : acc[ai][0][m > 1 ? m - 2 : 0][n]), v2 = m == 0 ? vm2 : (m == 1 ? vm1 : acc[ai][1][m > 1 ? m - 2 : 0][n]);
                    if (smp) { if (m >= 2) { float* cd = convs + ((size_t)((R - MP) >> 2) * 2 + (m - 2)) * FF2; *(f32x4*)(cd + j4) = g; *(f32x4*)(cd + FF + j4) = v; } }
                    else if ((ai == 0 && m < 2) || (ai == 1 && m >= 2)) {
                        const int t = R & 2047;
                        if (t >= 2046) { float* cd = convp + ((size_t)(R >> 11) * 2 + (t - 2046)) * FF2; *(f32x4*)(cd + j4) = g; *(f32x4*)(cd + FF + j4) = v; }
                        const int rt = R & 255;
                        if (rt < 2 || rt >= 254) { float* ed = EDGE + ((size_t)u.pm * 4 + (rt < 2 ? rt : rt - 252)) * FF2; *(f32x4*)(ed + j4) = g; *(f32x4*)(ed + FF + j4) = v; }
                    }
                    const f32x4 cg = bgv + wg0 * g2 + wg1 * g1 + wg2 * g, cv = bvv + wv0 * v2 + wv1 * v1 + wv2 * v;
                    u32x2 w; w.x = cvt_pk_bf16(silu_(cg[0]) * cv[0], silu_(cg[1]) * cv[1]); w.y = cvt_pk_bf16(silu_(cg[2]) * cv[2], silu_(cg[3]) * cv[3]);
                    *(u32x2*)(ACT + (size_t)R * FF + j4) = w;
                }
            }
        }
    }
};
#undef UPC_LOADW

template <class Epi, class Sched, bool ALIGN_EPI = false, bool SP2 = false>
__device__ __forceinline__ void gemm_phase(PG8_LAS unsigned char* lds, const Gemm g, const Sched& S, const Epi& E) {
    int tid_ = threadIdx.x; asm volatile("" : "+v"(tid_));
    const int tid = tid_, wid = __builtin_amdgcn_readfirstlane(tid >> 6), lane = tid & 63, wr = wid >> 2, wc = wid & 3, fr = lane & 15, fq = lane >> 4;
    const int K = g.K, nt = K / BK;
    unsigned voffA[2], voffB[2], voffB1[2];
#pragma unroll
    for (int i = 0; i < 2; ++i) { int R, C; stage_rc(tid * 16 + i * 8192, R, C); const int Rb = Epi::PERM ? ((R & ~31) + perm32(R & 31)) : R;
        int Ra = R; if constexpr (Epi::AMAP) Ra = E.amap(R); voffA[i] = (unsigned)(Ra * K + C) * 2u;     voffB[i] = (unsigned)(E.bmap(Rb) * K + C) * 2u; if constexpr (Epi::BMAP) voffB1[i] = (unsigned)(E.bmap(HALF + Rb) * K + C) * 2u; else voffB1[i] = 0u; }
    const size_t kstep = (size_t)(BK * 2);
    const size_t hstep = (size_t)HALF * K * 2;
    const unsigned* vB1 = Epi::BMAP ? voffB1 : voffB; const size_t h1step = Epi::BMAP ? (size_t)0 : hstep;
    const size_t tstep = 2 * hstep;
    const unsigned ldsw = (unsigned)wid * 1024u;
    const int aoff = lds_byte(wr * 64 + fr, fq * 8), boff = lds_byte(wc * 32 + fr, fq * 8);
#define PG8_SA(b, h) (((b) * 2 + (h)) * HTB)
#define PG8_SB(b, h) ((4 + (b) * 2 + (h)) * HTB)
#define PG8_STAGE(bufoff, gbase, voff) do { _Pragma("unroll") for (int _i = 0; _i < 2; ++_i) \
        __builtin_amdgcn_global_load_lds((const unsigned*)((const char*)(gbase) + (voff)[_i]), (PG8_LAS unsigned*)(lds + (bufoff) + ldsw + _i * 8192), 16, 0, 0); } while (0)
#define PG8_LDA(dst, b, h) do { _Pragma("unroll") for (int m = 0; m < 4; ++m) _Pragma("unroll") for (int k = 0; k < 2; ++k) dst[m][k] = *(const PG8_LAS bf16x8*)(lds + PG8_SA(b, h) + aoff + m * 2048 + k * 1024); } while (0)
#define PG8_LDB(dst, b, h) do { _Pragma("unroll") for (int n = 0; n < 2; ++n) _Pragma("unroll") for (int k = 0; k < 2; ++k) dst[n][k] = *(const PG8_LAS bf16x8*)(lds + PG8_SB(b, h) + boff + n * 2048 + k * 1024); } while (0)
#define PG8_MMA(ai, bj, At, Bt) do { __builtin_amdgcn_s_setprio(1); _Pragma("unroll") for (int m = 0; m < 4; ++m) _Pragma("unroll") for (int n = 0; n < 2; ++n) _Pragma("unroll") for (int k = 0; k < 2; ++k) \
        acc[ai][bj][m][n] = __builtin_amdgcn_mfma_f32_16x16x32_bf16(Bt[n][k], At[m][k], acc[ai][bj][m][n], 0, 0, 0); __builtin_amdgcn_s_setprio(0); } while (0)
#define PG8_WAIT_V(n) asm volatile("s_waitcnt vmcnt(" #n ")" ::: "memory")
#define PG8_WAIT_L(n) asm volatile("s_waitcnt lgkmcnt(" #n ")" ::: "memory")
#define PG8_BAR __builtin_amdgcn_s_barrier()
#define PG8_SCHED __builtin_amdgcn_sched_barrier(0)
    Unit cur, nxt; int ui = 0;
    if (!S.next(0, cur)) return;
    f32x4 acc[2][2][4][2];
#pragma unroll
    for (int a = 0; a < 2; ++a)
#pragma unroll
        for (int b = 0; b < 2; ++b)
#pragma unroll
            for (int m = 0; m < 4; ++m)
#pragma unroll
                for (int n = 0; n < 2; ++n) acc[a][b][m][n] = (f32x4){0.f, 0.f, 0.f, 0.f};
    bf16x8 At[4][2], B0[2][2], B1[2][2];
    const char* cA = (const char*)g.A + (size_t)cur.pm * tstep; const char* cB = (const char*)g.Bt + (size_t)cur.pn * tstep;
    S.a_ready(cur);
    if constexpr (SP2) {
        PG8_STAGE(PG8_SB(0, 0), cB, voffB); PG8_STAGE(PG8_SB(0, 1), cB + h1step, vB1); PG8_STAGE(PG8_SA(0, 0), cA, voffA); PG8_STAGE(PG8_SA(0, 1), cA + hstep, voffA);
        if (wr == 1) PG8_BAR;
        PG8_WAIT_V(2); PG8_BAR;
        PG8_STAGE(PG8_SB(1, 0), cB + kstep, voffB); PG8_STAGE(PG8_SA(1, 0), cA + kstep, voffA); PG8_STAGE(PG8_SB(1, 1), cB + h1step + kstep, vB1);
        PG8_WAIT_V(6); PG8_BAR;
    } else {
        PG8_STAGE(PG8_SB(0, 0), cB, voffB); PG8_STAGE(PG8_SA(0, 0), cA, voffA); PG8_STAGE(PG8_SB(0, 1), cB + h1step, vB1); PG8_STAGE(PG8_SA(0, 1), cA + hstep, voffA);
        if (wr == 1) PG8_BAR;
        PG8_WAIT_V(4); PG8_BAR;
        PG8_STAGE(PG8_SB(1, 0), cB + kstep, voffB); PG8_STAGE(PG8_SA(1, 0), cA + kstep, voffA); PG8_STAGE(PG8_SB(1, 1), cB + h1step + kstep, vB1);
        PG8_WAIT_V(6); PG8_BAR;
    }
    for (;;) {
        const bool has_next = S.next(ui + 1, nxt);
        const char* nA = has_next ? (const char*)g.A + (size_t)nxt.pm * tstep : cA; const char* nB = has_next ? (const char*)g.Bt + (size_t)nxt.pn * tstep : cB;
        for (int t = 0; t < nt; t += 2) {
            const bool last = (t == nt - 2);
            const char* a1 = cA + (size_t)(t + 1) * kstep;
            const char* a2 = last ? nA : cA + (size_t)(t + 2) * kstep; const char* b2 = last ? nB : cB + (size_t)(t + 2) * kstep;
            const char* a3 = a2 + kstep; const char* b3 = b2 + kstep;
            if (last && has_next) S.a_ready(nxt);
            if constexpr (SP2) {
            PG8_LDB(B0, 0, 0); PG8_LDB(B1, 0, 1); PG8_SCHED; PG8_LDA(At, 0, 0); PG8_STAGE(PG8_SA(1, 1), a1 + hstep, voffA);
            PG8_WAIT_V(8); PG8_WAIT_L(0); PG8_BAR; PG8_MMA(0, 0, At, B0); PG8_MMA(0, 1, At, B1); PG8_BAR; PG8_SCHED;
            PG8_LDA(At, 0, 1); PG8_STAGE(PG8_SB(0, 0), b2, voffB); PG8_STAGE(PG8_SB(0, 1), b2 + h1step, vB1); PG8_STAGE(PG8_SA(0, 0), a2, voffA);
            PG8_WAIT_V(8); PG8_WAIT_L(0); PG8_BAR; PG8_MMA(1, 0, At, B0); PG8_MMA(1, 1, At, B1); PG8_BAR; PG8_SCHED;
            PG8_LDB(B0, 1, 0); PG8_LDB(B1, 1, 1); PG8_SCHED; PG8_LDA(At, 1, 0); PG8_STAGE(PG8_SA(0, 1), a2 + hstep, voffA);
            PG8_WAIT_V(8); PG8_WAIT_L(0); PG8_BAR; PG8_MMA(0, 0, At, B0); PG8_MMA(0, 1, At, B1); PG8_BAR; PG8_SCHED;
            PG8_LDA(At, 1, 1); PG8_STAGE(PG8_SB(1, 0), b3, voffB); PG8_STAGE(PG8_SB(1, 1), b3 + h1step, vB1); PG8_STAGE(PG8_SA(1, 0), a3, voffA);
            PG8_WAIT_V(8); PG8_WAIT_L(0); PG8_BAR; PG8_MMA(1, 0, At, B0); PG8_MMA(1, 1, At, B1); PG8_BAR; PG8_SCHED;
            } else {
            PG8_LDB(B0, 0, 0); PG8_SCHED; PG8_LDA(At, 0, 0); PG8_STAGE(PG8_SA(1, 1), a1 + hstep, voffA);
            PG8_WAIT_L(8); PG8_BAR; PG8_WAIT_L(0); PG8_MMA(0, 0, At, B0); PG8_BAR; PG8_SCHED;
            PG8_LDB(B1, 0, 1); PG8_STAGE(PG8_SB(0, 0), b2, voffB);
            PG8_BAR; PG8_WAIT_L(0); PG8_MMA(0, 1, At, B1); PG8_BAR;
            PG8_LDA(At, 0, 1); PG8_STAGE(PG8_SA(0, 0), a2, voffA);
            PG8_BAR; PG8_WAIT_L(0); PG8_MMA(1, 0, At, B0); PG8_BAR; PG8_SCHED;
            PG8_STAGE(PG8_SB(0, 1), b2 + h1step, vB1);
            PG8_WAIT_V(6); PG8_BAR; PG8_MMA(1, 1, At, B1); PG8_BAR;
            PG8_LDB(B0, 1, 0); PG8_SCHED; PG8_LDA(At, 1, 0); PG8_STAGE(PG8_SA(0, 1), a2 + hstep, voffA);
            PG8_WAIT_L(8); PG8_BAR; PG8_WAIT_L(0); PG8_MMA(0, 0, At, B0); PG8_BAR; PG8_SCHED;
            PG8_LDB(B1, 1, 1); PG8_STAGE(PG8_SB(1, 0), b3, voffB);
            PG8_BAR; PG8_WAIT_L(0); PG8_MMA(0, 1, At, B1); PG8_BAR;
            PG8_LDA(At, 1, 1); PG8_STAGE(PG8_SA(1, 0), a3, voffA);
            PG8_BAR; PG8_WAIT_L(0); PG8_MMA(1, 0, At, B0); PG8_BAR; PG8_SCHED;
            PG8_STAGE(PG8_SB(1, 1), b3 + h1step, vB1);
            PG8_WAIT_V(6); PG8_BAR; PG8_MMA(1, 1, At, B1); PG8_BAR;
            }
        }
        if constexpr (ALIGN_EPI) { if (wr == 0) PG8_BAR; }
        if constexpr (!Epi::AFTER_DRAIN) { E(acc, cur, wr, wc, fr, fq); S.done(cur); }
        if (!has_next) break;
#pragma unroll
        for (int a = 0; a < 2; ++a)
#pragma unroll
            for (int b = 0; b < 2; ++b)
#pragma unroll
                for (int m = 0; m < 4; ++m)
#pragma unroll
                    for (int n = 0; n < 2; ++n) acc[a][b][m][n] = (f32x4){0.f, 0.f, 0.f, 0.f};
        cur = nxt; cA = nA; cB = nB; ++ui;
        if constexpr (ALIGN_EPI) { if (wr == 1) PG8_BAR; }
    }
    PG8_WAIT_V(0);
    if constexpr (!ALIGN_EPI) { if (wr == 0) PG8_BAR; }
    PG8_BAR;
    if constexpr (Epi::AFTER_DRAIN) { E.fused(acc, cur, wr, wc, fr, fq, lds, wid, lane); S.done(cur); }
#undef PG8_SA
#undef PG8_SB
#undef PG8_STAGE
#undef PG8_LDA
#undef PG8_LDB
#undef PG8_MMA
#undef PG8_WAIT_V
#undef PG8_WAIT_L
#undef PG8_BAR
#undef PG8_SCHED
}
}

#define XB_TMO      128
#define XB_XCNT(j)  (256  + 64 * (j))
#define XB_XSUB(j)  (1280 + 64 * (j))
#define XB_XGEN(j)  (2304 + 64 * (j))
#define XB_TOP      3328
#define XB_TOPGEN   3392
#define XCD_BAR_WORDS 3456
#define XB_SPIN_CAP (1u << 18)

__device__ __forceinline__ unsigned xb_ld(unsigned* p)              { return __hip_atomic_load(p, __ATOMIC_RELAXED, __HIP_MEMORY_SCOPE_AGENT); }
__device__ __forceinline__ unsigned xb_add(unsigned* p, unsigned v) { return __hip_atomic_fetch_add(p, v, __ATOMIC_RELAXED, __HIP_MEMORY_SCOPE_AGENT); }
__device__ __forceinline__ unsigned xb_xcc_id() { return (unsigned)__builtin_amdgcn_s_getreg((3 << 11) | 20) & 0xFu; }
#define XB_SPIN(cond, bar) do { unsigned _sp = 0; while (cond) { __builtin_amdgcn_s_sleep(1); \
    if ((++_sp & 255u) == 0u) { if (xb_ld(&(bar)[XB_TMO])) break; if (_sp > XB_SPIN_CAP) { atomicAdd(&(bar)[XB_TMO], 1u); break; } } } } while (0)

struct XcdBarrier {
    unsigned* bar; unsigned x;
    volatile LAS unsigned* st;
};

__device__ __forceinline__ XcdBarrier xcd_barrier_post(unsigned* bar, volatile LAS unsigned* st) {
    XcdBarrier b; b.bar = bar; b.x = xb_xcc_id(); b.st = st;
    if (threadIdx.x == 0) (void)xb_add(&bar[XB_XCNT(b.x)], 1u);
    return b;
}
__device__ __forceinline__ void xcd_barrier_complete(unsigned* bar, unsigned x, unsigned& nloc, unsigned& nx) {
    const unsigned G = gridDim.x * gridDim.y * gridDim.z;
    unsigned sum, cnt, mine, sp = 0u;
    for (;;) {
        sum = 0u; cnt = 0u; mine = 0u;
#pragma unroll
        for (unsigned j = 0; j < 16; ++j) { const unsigned c = xb_ld(&bar[XB_XCNT(j)]); sum += c; cnt += (c > 0u) ? 1u : 0u; mine = (j == x) ? c : mine; }
        if (sum == G) break;
        __builtin_amdgcn_s_sleep(1);
        if ((++sp & 255u) == 0u) { if (xb_ld(&bar[XB_TMO])) break; if (sp > XB_SPIN_CAP) { atomicAdd(&bar[XB_TMO], 1u); break; } }
    }
    nloc = mine > 0u ? mine : 1u; nx = cnt > 0u ? cnt : 1u;
}

__device__ __forceinline__ void xcd_barrier(const XcdBarrier& b) {
    asm volatile("s_waitcnt vmcnt(0)" ::: "memory");
    __syncthreads();
    if (threadIdx.x == 0) {
        unsigned* bar = b.bar;
        __builtin_amdgcn_s_waitcnt(0);
        unsigned nloc = b.st[0], nx = b.st[1];
        if (nloc == 0u) { xcd_barrier_complete(bar, b.x, nloc, nx); b.st[0] = nloc; b.st[1] = nx; }
        const unsigned old = xb_add(&bar[XB_XSUB(b.x)], 1u);
        const unsigned gen = old / nloc;
        if (old + 1u == (gen + 1u) * nloc) {
            __builtin_amdgcn_fence(__ATOMIC_RELEASE, "agent");
            asm volatile("s_waitcnt vmcnt(0)" ::: "memory");
            const unsigned og = xb_add(&bar[XB_TOP], 1u);
            const unsigned tg = og / nx;
            if (og + 1u == (tg + 1u) * nx) xb_add(&bar[XB_TOPGEN], 1u);
            else XB_SPIN(xb_ld(&bar[XB_TOPGEN]) == tg, bar);
            __builtin_amdgcn_fence(__ATOMIC_ACQUIRE, "agent");
            xb_add(&bar[XB_XGEN(b.x)], 1u);
            asm volatile("s_waitcnt vmcnt(0)" ::: "memory");
        } else {
            XB_SPIN(xb_ld(&bar[XB_XGEN(b.x)]) == gen, bar);
            __builtin_amdgcn_fence(__ATOMIC_ACQUIRE, "agent");
            asm volatile("s_waitcnt vmcnt(0)" ::: "memory");
        }
    }
    __syncthreads();
}

struct Args { const float* in[39]; float* out; unsigned char* ws; int ph_lo, ph_hi, li, pad; };
enum { I_XP = 0, I_XS, I_MEM, I_C1, I_C4, I_C16, I_SRE, I_SIM, I_SCONV, I_CMEM, I_NMIX, I_WIN, I_QN, I_KN, I_LRE, I_LIM, I_LDT, I_BRE, I_BIM, I_CRE, I_CIM, I_SD, I_WGLU, I_BGLU,
       I_AON, I_SON, I_WOUT, I_NX, I_NMEM, I_WXQ, I_WXKV, I_XQN, I_XKN, I_WXO, I_NFFN, I_WUP, I_CONVW, I_CONVB, I_WDOWN };
constexpr size_t O_YP = 0, O_YS = O_YP + (size_t)MP * D, O_KV1P = O_YS + (size_t)MS * D, O_KV4P = O_KV1P + (size_t)BP * 128 * 512, O_KV16P = O_KV4P + (size_t)BP * 512 * 512,
    O_SREP = O_KV16P + (size_t)BP * 2048 * 512, O_SIMP = O_SREP + BP * 1024, O_CONVP = O_SIMP + BP * 1024, O_MEMKV = O_CONVP + (size_t)BP * 2 * FF2, O_KV1S = O_MEMKV + (size_t)MM * 2048,
    O_KV4S = O_KV1S + (size_t)MS * 512, O_KV16S = O_KV4S + (size_t)MS * 512, O_SRES = O_KV16S + (size_t)MS * 512, O_SIMS = O_SRES + BS * 1024, O_CONVS = O_SIMS + BS * 1024, O_END = O_CONVS + (size_t)BS * 2 * FF2;
static_assert(O_END == 35102720 && O_KV1P == O_KV1P_ && O_KV4P == O_KV4P_ && O_KV16P == O_KV16P_ && O_KV1S == O_KV1S_ && O_KV4S == O_KV4S_ && O_KV16S == O_KV16S_, "output map");

template <int MODE> __device__ __forceinline__ int rowmap(int n) {
    if (MODE == 1) return (n & ~255) + 128 * ((n >> 5) & 1) + 32 * ((n >> 6) & 3) + (n & 31);
    if (MODE == 2) { return n < FF ? 256 * (n >> 7) + (n & 127) : 256 * ((n - FF) >> 7) + 128 + ((n - FF) & 127); }
    return n;
}
template <int MODE> __device__ __forceinline__ void p0_transpose_item(const float* W, int K, int N, bf16* WT, const float* gk, LAS float* scr, int item, int lane) {
    const int nblk = N / 32, kb = item / nblk, nb = item % nblk, k0 = 64 * kb, n0 = 32 * nb;
    float wv[32];
#pragma unroll
    for (int i = 0; i < 32; ++i) wv[i] = W[(size_t)(k0 + 2 * i + (lane >> 5)) * N + n0 + (lane & 31)];
    if (gk) {
#pragma unroll
        for (int i = 0; i < 32; ++i) wv[i] *= gk[k0 + 2 * i + (lane >> 5)]; }
#pragma unroll
    for (int i = 0; i < 32; ++i) scr[(2 * i + (lane >> 5)) * 33 + (lane & 31)] = wv[i];
    LDS_WAIT(); asm volatile("" ::: "memory");
    const int c = lane & 7;
#pragma unroll
    for (int j = 0; j < 4; ++j) { const int n = (lane >> 3) + 8 * j; const LAS float* s = scr + (8 * c) * 33 + n;
        u32x4 o; o.x = pk2(s[0 * 33], s[1 * 33]); o.y = pk2(s[2 * 33], s[3 * 33]); o.z = pk2(s[4 * 33], s[5 * 33]); o.w = pk2(s[6 * 33], s[7 * 33]);
        *(GAS u32x4*)(WT + (size_t)rowmap<MODE>(n0 + n) * K + k0 + 8 * c) = o; }
    LDS_WAIT(); asm volatile("" ::: "memory");
}
__device__ __forceinline__ void p0_tr_load(const float* W, int N, int item, int lane, float (&wv)[32]) {
    const int nblk = N / 32, kb = item / nblk, nb = item % nblk, k0 = 64 * kb, n0 = 32 * nb;
#pragma unroll
    for (int i = 0; i < 32; ++i) wv[i] = W[(size_t)(k0 + 2 * i + (lane >> 5)) * N + n0 + (lane & 31)];
}
template <int MODE> __device__ __forceinline__ void p0_tr_store(int K, int N, bf16* WT, const float* gk, LAS float* scr, int item, int lane, const float (&wv)[32]) {
    const int nblk = N / 32, kb = item / nblk, nb = item % nblk, k0 = 64 * kb, n0 = 32 * nb;
    const int c = lane & 7;
    f32x4 g0 = {1.f, 1.f, 1.f, 1.f}, g1 = g0;
    if (gk) { g0 = *(const f32x4*)(gk + k0 + 8 * c); g1 = *(const f32x4*)(gk + k0 + 8 * c + 4); }
#pragma unroll
    for (int i = 0; i < 32; ++i) scr[(2 * i + (lane >> 5)) * 33 + (lane & 31)] = wv[i];
    LDS_WAIT(); asm volatile("" ::: "memory");
#pragma unroll
    for (int j = 0; j < 4; ++j) { const int n = (lane >> 3) + 8 * j; const LAS float* s = scr + (8 * c) * 33 + n;
        u32x4 o; o.x = pk2(s[0 * 33] * g0[0], s[1 * 33] * g0[1]); o.y = pk2(s[2 * 33] * g0[2], s[3 * 33] * g0[3]); o.z = pk2(s[4 * 33] * g1[0], s[5 * 33] * g1[1]); o.w = pk2(s[6 * 33] * g1[2], s[7 * 33] * g1[3]);
        *(GAS u32x4*)(WT + (size_t)rowmap<MODE>(n0 + n) * K + k0 + 8 * c) = o; }
    LDS_WAIT(); asm volatile("" ::: "memory");
}
template <int MODE> __device__ __forceinline__ void p0_transpose_stream(const float* W, int K, int N, bf16* WT, const float* gk, LAS float* scr, int it, int nitems, int stride, int lane) {
    if (it >= nitems) return;
    float wa[32], wb[32];
    p0_tr_load(W, N, it, lane, wa);
    for (;;) {
        const int i1 = it + stride; if (i1 < nitems) p0_tr_load(W, N, i1, lane, wb);
        p0_tr_store<MODE>(K, N, WT, gk, scr, it, lane, wa);
        if (i1 >= nitems) break;
        const int i2 = i1 + stride; if (i2 < nitems) p0_tr_load(W, N, i2, lane, wa);
        p0_tr_store<MODE>(K, N, WT, gk, scr, i1, lane, wb);
        if (i2 >= nitems) break;
        it = i2;
    }
}
__device__ __forceinline__ void rms_rows2_to_bf16(const float* xrow0, const float* xrow1, const f32x4 (&gg)[4], bf16* orow0, bf16* orow1, int lane) {
    const f32x4* xr0 = (const f32x4*)xrow0 + lane; const f32x4* xr1 = (const f32x4*)xrow1 + lane;
    f32x4 v0[4], v1[4]; float s0 = 0.f, s1 = 0.f;
#pragma unroll
    for (int j = 0; j < 4; ++j) { v0[j] = xr0[64 * j]; v1[j] = xr1[64 * j]; }
#pragma unroll
    for (int j = 0; j < 4; ++j) { s0 += dot4(v0[j]); s1 += dot4(v1[j]); }
#pragma unroll
    for (int o = 1; o < 64; o <<= 1) { s0 += __shfl_xor(s0, o); s1 += __shfl_xor(s1, o); }
    const float r0 = frsq(s0 * (1.0f / D) + EPS), r1 = frsq(s1 * (1.0f / D) + EPS);
    u32x2* o0 = (u32x2*)orow0 + lane; u32x2* o1 = (u32x2*)orow1 + lane;
#pragma unroll
    for (int j = 0; j < 4; ++j) { const f32x4 a = v0[j] * r0 * gg[j], c = v1[j] * r1 * gg[j];
        u32x2 w; w.x = cvt_pk_bf16(a[0], a[1]); w.y = cvt_pk_bf16(a[2], a[3]); o0[64 * j] = w;
        u32x2 z; z.x = cvt_pk_bf16(c[0], c[1]); z.y = cvt_pk_bf16(c[2], c[3]); o1[64 * j] = z; }
}

__device__ __forceinline__ int pi23(int m) { return (m & ~12) | ((m & 4) << 1) | ((m & 8) >> 1); }
__device__ __forceinline__ void memk_fix_item(float* memkv, const float* mss, const float* xkn, const float* xqn, bf16* MEMK, int Rm, int lane) {
    const f32x4 gk = *(const f32x4*)(xkn + 4 * lane), gq = *(const f32x4*)(xqn + 4 * lane);
    f32x4 v[4], s[4];
#pragma unroll
    for (int h = 0; h < 4; ++h) { v[h] = *(const f32x4*)(memkv + (size_t)Rm * 2048 + h * 256 + 4 * lane); s[h] = *(const f32x4*)(mss + (size_t)Rm * 16 + 4 * h); }
#pragma unroll
    for (int h = 0; h < 4; ++h) {
        const float rs = frsq(((s[h][0] + s[h][1]) + (s[h][2] + s[h][3])) * (1.0f / 256.0f) + EPS);
        const f32x4 kn = v[h] * rs * gk; *(f32x4*)(memkv + (size_t)Rm * 2048 + h * 256 + 4 * lane) = kn; const f32x4 kq = kn * gq;
        u32x2 w; w.x = cvt_pk_bf16(kq[0], kq[1]); w.y = cvt_pk_bf16(kq[2], kq[3]); *(u32x2*)(MEMK + (size_t)Rm * 1024 + h * 256 + 4 * lane) = w;
    }
}
__device__ __forceinline__ void ssm_bfrags(const Args& a, const float* ssmc, int g, int lane, bf16x8 (&bb)[4]) {
    const int n = lane & 31, hi = lane >> 5;
#pragma unroll
    for (int s2 = 0; s2 < 2; ++s2) { const int st = g * 64 + 32 * s2 + n; const f32x4 c0 = *(const f32x4*)(ssmc + (size_t)st * 8); const float cr = c0[2], ci = c0[3];
        const f32x4 r0 = *(const f32x4*)(a.in[I_BRE] + (size_t)st * 16 + 8 * hi), r1 = *(const f32x4*)(a.in[I_BRE] + (size_t)st * 16 + 8 * hi + 4);
        const f32x4 i0 = *(const f32x4*)(a.in[I_BIM] + (size_t)st * 16 + 8 * hi), i1 = *(const f32x4*)(a.in[I_BIM] + (size_t)st * 16 + 8 * hi + 4);
        const f32x4 pr0 = r0 * cr - i0 * ci, pr1 = r1 * cr - i1 * ci, pi0 = i0 * cr + r0 * ci, pi1 = i1 * cr + r1 * ci;
        bb[s2] = pack8(pr0[0], pr0[1], pr0[2], pr0[3], pr1[0], pr1[1], pr1[2], pr1[3]); bb[2 + s2] = pack8(pi0[0], pi0[1], pi0[2], pi0[3], pi1[0], pi1[1], pi1[2], pi1[3]); }
}
__device__ __forceinline__ bf16x8 ssm_loadu(const float* U, int row0, int nrows, int g, int lane) {
    const int m = lane & 31, hi = lane >> 5; const int row = row0 + (m < nrows ? m : (m & (nrows - 1)));
    const f32x4 u0 = *(const f32x4*)(U + (size_t)row * 256 + g * 16 + 8 * hi), u1 = *(const f32x4*)(U + (size_t)row * 256 + g * 16 + 8 * hi + 4);
    return pack8(u0[0], u0[1], u0[2], u0[3], u1[0], u1[1], u1[2], u1[3]);
}
__device__ __forceinline__ void ssm_xcompute(bf16x8 ua, const bf16x8 (&bb)[4], f32x16 (&xr)[2], f32x16 (&xi)[2]) {
    const f32x16 z = {0.f, 0.f, 0.f, 0.f, 0.f, 0.f, 0.f, 0.f, 0.f, 0.f, 0.f, 0.f, 0.f, 0.f, 0.f, 0.f};
    f32x16 t0 = __builtin_amdgcn_mfma_f32_32x32x16_bf16(ua, bb[0], z, 0, 0, 0), t1 = __builtin_amdgcn_mfma_f32_32x32x16_bf16(ua, bb[1], z, 0, 0, 0);
    f32x16 t2 = __builtin_amdgcn_mfma_f32_32x32x16_bf16(ua, bb[2], z, 0, 0, 0), t3 = __builtin_amdgcn_mfma_f32_32x32x16_bf16(ua, bb[3], z, 0, 0, 0);
#pragma unroll
    for (int r = 0; r < 16; ++r) {
        const float a0 = t0[r], a1 = t1[r], a2 = t2[r], a3 = t3[r];
        const auto sr = __builtin_amdgcn_permlane32_swap(__float_as_uint(a0), __float_as_uint(a1), false, false);
        const unsigned s0 = sr[0], s1 = sr[1];
        xr[0][r] = __uint_as_float(s0); xr[1][r] = __uint_as_float(s1);
        const auto si = __builtin_amdgcn_permlane32_swap(__float_as_uint(a2), __float_as_uint(a3), false, false);
        const unsigned s2 = si[0], s3 = si[1];
        xi[0][r] = __uint_as_float(s2); xi[1][r] = __uint_as_float(s3); }
    __builtin_amdgcn_sched_barrier(0); asm volatile("s_nop 7" ::: "memory"); __builtin_amdgcn_sched_barrier(0);
}
#define SSM_XR(t) xr[((t) >> 2) & 1][((t) & 3) + 4 * ((t) >> 3)]
#define SSM_XI(t) xi[((t) >> 2) & 1][((t) & 3) + 4 * ((t) >> 3)]
__device__ __forceinline__ void ssm_a_item(const Args& a, const float* U, const float* ssmc, float* SSMF, LAS float* uL, int it, int lane) {
    const int g = it & 15, bc = it >> 4, b = bc / 31, c = bc - b * 31;
    const f32x4 c0 = *(const f32x4*)(ssmc + (size_t)(g * 64 + lane) * 8);
    const float ar = c0[0], ai = c0[1];
    bf16x8 bb[4]; ssm_bfrags(a, ssmc, g, lane, bb);
    float hr = 0.f, hi = 0.f;
    bf16x8 ua2[2]; ua2[0] = ssm_loadu(U, b * 2048 + c * 64, 32, g, lane); ua2[1] = ssm_loadu(U, b * 2048 + c * 64 + 32, 32, g, lane);
#pragma unroll
    for (int blk = 0; blk < 2; ++blk) {
        f32x16 xr[2], xi[2]; ssm_xcompute(ua2[blk], bb, xr, xi);
#pragma unroll
        for (int t = 0; t < 32; ++t) { const float nr = fmaf(ar, hr, fmaf(-ai, hi, SSM_XR(t))), ni = fmaf(ar, hi, fmaf(ai, hr, SSM_XI(t))); hr = nr; hi = ni; }
    }
    *(f32x2*)(SSMF + ((size_t)((b * 32 + c) * 16 + g) * 64 + lane) * 2) = (f32x2){hr, hi};
    (void)uL;
}
constexpr int SAB = 4;
struct SaBatch { f32x4 k[SAB], v[SAB]; };
__device__ __forceinline__ void sa_load(SaBatch& B, const float* cb, unsigned loff, int t, int dil, int nvalid, int i0) {
#pragma unroll
    for (int j = 0; j < SAB; ++j) { const int i = i0 + j, idx = i < nvalid ? t + i * dil : t; const char* rp = (const char*)(cb + (size_t)idx * 512);
        B.k[j] = __builtin_nontemporal_load((const f32x4*)(rp + loff)); B.v[j] = __builtin_nontemporal_load((const f32x4*)(rp + 1024 + loff)); }
}
__device__ __forceinline__ void sa_compute(const SaBatch& B, f32x4 q, int nvalid, int i0, float& m, float& l, f32x4& o) {
    float s[SAB]; float mb = m;
#pragma unroll
    for (int j = 0; j < SAB; ++j) { float d = (q[0] * B.k[j][0] + q[1] * B.k[j][1]) + (q[2] * B.k[j][2] + q[3] * B.k[j][3]);
        d += __shfl_xor(d, 1); d += __shfl_xor(d, 2); d += __shfl_xor(d, 4); d += __shfl_xor(d, 8);
        s[j] = (i0 + j) < nvalid ? d : -1e30f; mb = fmaxf(mb, s[j]); }
    const float sc = fexp2(m - mb); l *= sc; o = o * sc; m = mb;
#pragma unroll
    for (int j = 0; j < SAB; ++j) { const float p = fexp2(s[j] - mb); l += p; o = o + B.v[j] * p; }
}
__device__ __forceinline__ void sattn_item(const Args& a, const bf16* Q, bf16* AO, float* LSE, int it, int lane) {
    const int g = it >> 9, rem = it & 511, b = rem >> 2, t = rem & 3;
    const int dil = 1 << (2 * g), nbuf = 128 << (2 * g);
    const int R = MP + 4 * b + t, hh = lane >> 4, dq = (lane & 15) * 4;
    const u32x2 qw = *(const u32x2*)(Q + (size_t)R * AW + g * 256 + hh * 64 + dq);
    const f32x4 q = {bf2f(qw.x & 0xffffu), bf2f(qw.x >> 16), bf2f(qw.y & 0xffffu), bf2f(qw.y >> 16)};
    const float* cb = a.in[I_C1 + g] + (size_t)b * nbuf * 512; const unsigned loff = 4u * (unsigned)(hh * 64 + dq);
    const float* nb = a.out + (g == 0 ? O_KV1S : (g == 1 ? O_KV4S : O_KV16S)) + (size_t)(4 * b) * 512 + hh * 64 + dq;
    const int nvalid = g == 0 ? 128 - t : 128;
    float m = -1e30f, l = 0.f; f32x4 o = {0.f, 0.f, 0.f, 0.f};
    SaBatch A, B; sa_load(A, cb, loff, t, dil, nvalid, 0);
#pragma unroll 1
    for (int i0 = 0; i0 < 128; i0 += 2 * SAB) {
        sa_load(B, cb, loff, t, dil, nvalid, i0 + SAB);
        sa_compute(A, q, nvalid, i0, m, l, o);
        if (i0 + 2 * SAB < 128) sa_load(A, cb, loff, t, dil, nvalid, i0 + 2 * SAB);
        sa_compute(B, q, nvalid, i0 + SAB, m, l, o);
    }
    {
        f32x4 kk[4], vv[4]; float s[4]; float mb = m;
#pragma unroll
        for (int j = 0; j < 4; ++j) { const float* rp = nb + (size_t)j * 512; kk[j] = *(const f32x4*)rp; vv[j] = *(const f32x4*)(rp + 256); }
#pragma unroll
        for (int j = 0; j < 4; ++j) { float d = (q[0] * kk[j][0] + q[1] * kk[j][1]) + (q[2] * kk[j][2] + q[3] * kk[j][3]);
            d += __shfl_xor(d, 1); d += __shfl_xor(d, 2); d += __shfl_xor(d, 4); d += __shfl_xor(d, 8);
            const bool ok = g == 0 ? (j <= t) : (j == t); s[j] = ok ? d : -1e30f; mb = fmaxf(mb, s[j]); }
        const float sc = fexp2(m - mb); l *= sc; o = o * sc; m = mb;
#pragma unroll
        for (int j = 0; j < 4; ++j) { const float p = fexp2(s[j] - mb); l += p; o = o + vv[j] * p; }
    }
    const float il = frcp(l); o = o * il;
    u32x2 w; w.x = cvt_pk_bf16(o[0], o[1]); w.y = cvt_pk_bf16(o[2], o[3]); *(u32x2*)(AO + (size_t)R * AW + g * 256 + hh * 64 + dq) = w;
    if ((lane & 15) == 0) LSE[(size_t)R * 12 + g * 4 + hh] = (m + flog2(l)) * LN2;
}
__device__ __forceinline__ void pattn_item(const bf16* Q, const bf16* Kb, const bf16* VT, bf16* AO, float* LSE, int it, int lane) {
    const int g = it >> 11; int rem = it & 2047;
    const int sh = 2 * g, dil = 1 << sh, S = 2048 >> sh, nql = 6 - sh;
    const int qt = rem & ((1 << nql) - 1); rem >>= nql; const int res = rem & (dil - 1); rem >>= sh; const int hh = rem & 3, b = rem >> 2;
    const int n = lane & 31, hi = lane >> 5;
    const int s_q = 32 * qt + n, qrow = b * 2048 + s_q * dil + res;
    const int coff = g * 256 + hh * 64 + 32 * hi;
    bf16x8 qf[4];
    { const bf16* qp = Q + (size_t)qrow * AW + coff;
#pragma unroll
      for (int d0 = 0; d0 < 4; ++d0) qf[d0] = *(const bf16x8*)(qp + 8 * d0); }
    f32x16 sc[5];
    const int pm = pi23(n);
#pragma unroll
    for (int kt = 0; kt < 5; ++kt) {
        const int sb = 32 * qt - 128 + 32 * kt; int sk = sb + pm; sk = sk < 0 ? 0 : sk;
        const bf16* kp = Kb + (size_t)(b * 2048 + sk * dil + res) * AW + coff;
        bf16x8 kf[4];
#pragma unroll
        for (int d0 = 0; d0 < 4; ++d0) kf[d0] = *(const bf16x8*)(kp + 8 * d0);
        f32x16 acc = {0.f, 0.f, 0.f, 0.f, 0.f, 0.f, 0.f, 0.f, 0.f, 0.f, 0.f, 0.f, 0.f, 0.f, 0.f, 0.f};
#pragma unroll
        for (int d0 = 0; d0 < 4; ++d0) acc = __builtin_amdgcn_mfma_f32_32x32x16_bf16(kf[d0], qf[d0], acc, 0, 0, 0);
        sc[kt] = acc;
    }
    float mx = -1e30f;
#pragma unroll
    for (int kt = 0; kt < 5; ++kt) { const int sb = 32 * qt - 128 + 32 * kt;
#pragma unroll
        for (int r = 0; r < 16; ++r) { const int sk = sb + 16 * (r >> 3) + 8 * hi + (r & 7); const int dl = s_q - sk; const bool ok = (sk >= 0) && (dl >= 0) && (dl <= 128);
            const float v = ok ? sc[kt][r] : -1e30f; sc[kt][r] = v; mx = fmaxf(mx, v); } }
    mx = fmaxf(mx, __shfl_xor(mx, 32));
    float l = 0.f;
#pragma unroll
    for (int kt = 0; kt < 5; ++kt)
#pragma unroll
        for (int r = 0; r < 16; ++r) { const float p = fexp2(sc[kt][r] - mx); sc[kt][r] = p; l += p; }
    l += __shfl_xor(l, 32);
    f32x16 o[2];
#pragma unroll
    for (int dt = 0; dt < 2; ++dt) o[dt] = (f32x16){0.f, 0.f, 0.f, 0.f, 0.f, 0.f, 0.f, 0.f, 0.f, 0.f, 0.f, 0.f, 0.f, 0.f, 0.f, 0.f};
    const bf16* vbase = VT + (size_t)((g * 4 + hh) * 8 + b) * 64 * 2048;
#pragma unroll
    for (int kt = 0; kt < 5; ++kt) {
        int sb = 32 * qt - 128 + 32 * kt; sb = sb < 0 ? 0 : sb;
        const bf16* vp = vbase + (size_t)((res * S + sb) >> 5) * 2048 + n * 32 + 8 * hi;
#pragma unroll
        for (int jj = 0; jj < 2; ++jj) {
            const bf16x8 pb = pack8(sc[kt][8 * jj + 0], sc[kt][8 * jj + 1], sc[kt][8 * jj + 2], sc[kt][8 * jj + 3], sc[kt][8 * jj + 4], sc[kt][8 * jj + 5], sc[kt][8 * jj + 6], sc[kt][8 * jj + 7]);
#pragma unroll
            for (int dt = 0; dt < 2; ++dt) { const bf16x8 vf = *(const bf16x8*)(vp + dt * 1024 + 16 * jj); o[dt] = __builtin_amdgcn_mfma_f32_32x32x16_bf16(vf, pb, o[dt], 0, 0, 0); }
        }
    }
    const float il = frcp(l);
    bf16* op = AO + (size_t)qrow * AW + g * 256 + hh * 64 + 4 * hi;
#pragma unroll
    for (int dt = 0; dt < 2; ++dt)
#pragma unroll
        for (int r4 = 0; r4 < 4; ++r4) { u32x2 w; w.x = cvt_pk_bf16(o[dt][4 * r4] * il, o[dt][4 * r4 + 1] * il); w.y = cvt_pk_bf16(o[dt][4 * r4 + 2] * il, o[dt][4 * r4 + 3] * il);
            *(u32x2*)(op + 32 * dt + 8 * r4) = w; }
    if (hi == 0) LSE[(size_t)qrow * 12 + g * 4 + hh] = (mx + flog2(l)) * LN2;
}

constexpr int PK_ROW = 144, PK_SLOT = 32 * PK_ROW, PV_OFF = 12 * PK_SLOT;
__device__ __forceinline__ void pattn_wg_item(const bf16* Q, const bf16* Kb, const bf16* VT, bf16* AO, float* LSE, LAS unsigned char* lds, int item, int wave, int lane, int tid) {
    const int g = item >> 8, r = item & 255, hh = (r >> 3) & 3, b = r >> 5;
    const int sh = 2 * g, dil = 1 << sh, S = 2048 >> sh;
    const int qblk = g == 0 ? (r & 7) : (r & 1), resb = g == 0 ? 0 : (g == 1 ? ((r >> 1) & 3) : 2 * (r & 7));
    const int pc = tid & 255;
    u32x4 kreg[6], vreg[6];
#pragma unroll
    for (int i = 0; i < 6; ++i) { const int T = (tid >> 8) + 2 * i;
        int sb, rs; bool ok;
        if (g < 2) { sb = 256 * qblk - 128 + 32 * T; rs = resb; ok = sb >= 0; } else { sb = 32 * (T & 3); rs = resb + (T >> 2); ok = T < 8; }
        if (ok) { const int t = (sb + (pc >> 3)) * dil + rs;
            kreg[i] = *(const u32x4*)(Kb + (size_t)(b * 2048 + t) * AW + g * 256 + hh * 64 + 8 * (pc & 7));
            vreg[i] = *(const u32x4*)(VT + (size_t)(b * 2048 + t) * AW + g * 256 + hh * 64 + 8 * (pc & 7)); }
        else { kreg[i] = (u32x4){0u, 0u, 0u, 0u}; vreg[i] = kreg[i]; } }
    const int n = lane & 31, hi = lane >> 5;
    const int qt = g < 2 ? 8 * qblk + wave : (wave & 3), resw = g < 2 ? resb : resb + (wave >> 2);
    const int slot_base = g < 2 ? wave : 4 * (wave >> 2) + (wave & 3) - 4;
    const int s_q = 32 * qt + n, qrow = b * 2048 + s_q * dil + resw;
    bf16x8 qf[4];
    { const bf16* qp = Q + (size_t)qrow * AW + g * 256 + hh * 64 + 32 * hi;
#pragma unroll
      for (int d0 = 0; d0 < 4; ++d0) qf[d0] = *(const bf16x8*)(qp + 8 * d0); }
#pragma unroll
    for (int i = 0; i < 6; ++i) { const int T = (tid >> 8) + 2 * i;
        *(LAS u32x4*)(lds + T * PK_SLOT + (pc >> 3) * PK_ROW + (pc & 7) * 16) = kreg[i];
        *(LAS u32x4*)(lds + PV_OFF + T * PK_SLOT + (pc >> 3) * PK_ROW + (pc & 7) * 16) = vreg[i]; }
    __syncthreads();
    f32x16 sc[5];
    const int pm = pi23(n);
#pragma unroll
    for (int kt = 0; kt < 5; ++kt) {
        const int slot = slot_base + kt, sb = 32 * qt - 128 + 32 * kt;
        f32x16 acc = {0.f, 0.f, 0.f, 0.f, 0.f, 0.f, 0.f, 0.f, 0.f, 0.f, 0.f, 0.f, 0.f, 0.f, 0.f, 0.f};
        if (sb >= 0) {
            const LAS unsigned char* kp = lds + slot * PK_SLOT + pm * PK_ROW + 64 * hi;
            bf16x8 kf[4];
#pragma unroll
            for (int d0 = 0; d0 < 4; ++d0) kf[d0] = *(const LAS bf16x8*)(kp + 16 * d0);
#pragma unroll
            for (int d0 = 0; d0 < 4; ++d0) acc = __builtin_amdgcn_mfma_f32_32x32x16_bf16(kf[d0], qf[d0], acc, 0, 0, 0);
        }
        sc[kt] = acc;
    }
    float mx = -1e30f;
#pragma unroll
    for (int kt = 0; kt < 5; ++kt) { const int sb = 32 * qt - 128 + 32 * kt;
#pragma unroll
        for (int rr = 0; rr < 16; ++rr) { const int sk = sb + 16 * (rr >> 3) + 8 * hi + (rr & 7); const int dl = s_q - sk; const bool ok = (sk >= 0) && (dl >= 0) && (dl <= 128);
            const float v = ok ? sc[kt][rr] : -1e30f; sc[kt][rr] = v; mx = fmaxf(mx, v); } }
    mx = fmaxf(mx, __shfl_xor(mx, 32));
    float l = 0.f;
#pragma unroll
    for (int kt = 0; kt < 5; ++kt)
#pragma unroll
        for (int rr = 0; rr < 16; ++rr) { const float p = fexp2(sc[kt][rr] - mx); sc[kt][rr] = p; l += p; }
    l += __shfl_xor(l, 32);
    f32x16 o[2];
#pragma unroll
    for (int dt = 0; dt < 2; ++dt) o[dt] = (f32x16){0.f, 0.f, 0.f, 0.f, 0.f, 0.f, 0.f, 0.f, 0.f, 0.f, 0.f, 0.f, 0.f, 0.f, 0.f, 0.f};
#pragma unroll
    for (int kt = 0; kt < 5; ++kt) {
        const int slot = slot_base + kt, sb = 32 * qt - 128 + 32 * kt;
        if (sb >= 0) {
            LAS unsigned char* vp = lds + PV_OFF + slot * PK_SLOT + (8 * hi + ((lane >> 2) & 3)) * PK_ROW + (16 * ((lane >> 4) & 1) + 4 * (lane & 3)) * 2;
            bf16x8 vf[2][2];
#pragma unroll
            for (int jj = 0; jj < 2; ++jj)
#pragma unroll
                for (int dt = 0; dt < 2; ++dt) vf[jj][dt] = cat44(lds_tr4(vp + (16 * jj) * PK_ROW + 64 * dt), lds_tr4(vp + (16 * jj + 4) * PK_ROW + 64 * dt));
#pragma unroll
            for (int jj = 0; jj < 2; ++jj) {
                const bf16x8 pb = pack8(sc[kt][8 * jj + 0], sc[kt][8 * jj + 1], sc[kt][8 * jj + 2], sc[kt][8 * jj + 3], sc[kt][8 * jj + 4], sc[kt][8 * jj + 5], sc[kt][8 * jj + 6], sc[kt][8 * jj + 7]);
#pragma unroll
                for (int dt = 0; dt < 2; ++dt) o[dt] = __builtin_amdgcn_mfma_f32_32x32x16_bf16(vf[jj][dt], pb, o[dt], 0, 0, 0);
            }
        }
    }
    const float il = frcp(l);
    bf16* op = AO + (size_t)qrow * AW + g * 256 + hh * 64 + 4 * hi;
#pragma unroll
    for (int dt = 0; dt < 2; ++dt)
#pragma unroll
        for (int r4 = 0; r4 < 4; ++r4) { u32x2 w; w.x = cvt_pk_bf16(o[dt][4 * r4] * il, o[dt][4 * r4 + 1] * il); w.y = cvt_pk_bf16(o[dt][4 * r4 + 2] * il, o[dt][4 * r4 + 3] * il);
            *(u32x2*)(op + 32 * dt + 8 * r4) = w; }
    if (hi == 0) LSE[(size_t)qrow * 12 + g * 4 + hh] = (mx + flog2(l)) * LN2;
    __syncthreads();
}

template <int NB> __device__ __forceinline__ void combine_rows(const bf16* AO, const float* LSE, const float* aon, bf16* MIXED, int R0, int lane) {
    const int hh = lane >> 4; float ls[NB][3]; u32x2 ow[NB][3];
#pragma unroll
    for (int i = 0; i < NB; ++i)
#pragma unroll
        for (int g = 0; g < 3; ++g) { ow[i][g] = *(const u32x2*)(AO + (size_t)(R0 + i) * AW + g * 256 + 4 * lane); ls[i][g] = LSE[(size_t)(R0 + i) * 12 + g * 4 + hh]; }
    f32x4 gn[3];
#pragma unroll
    for (int g = 0; g < 3; ++g) gn[g] = *(const f32x4*)(aon + g * 256 + 4 * lane);
#pragma unroll
    for (int i = 0; i < NB; ++i) {
        const float mx = fmaxf(fmaxf(ls[i][0], ls[i][1]), ls[i][2]);
        float e[3]; e[0] = fexp2((ls[i][0] - mx) * LOG2E); e[1] = fexp2((ls[i][1] - mx) * LOG2E); e[2] = fexp2((ls[i][2] - mx) * LOG2E);
        const float inv = frcp(e[0] + e[1] + e[2]);
        f32x4 v[3]; float ss = 0.f;
#pragma unroll
        for (int g = 0; g < 3; ++g) { const float al = e[g] * inv; v[g] = (f32x4){bf2f(ow[i][g].x & 0xffffu), bf2f(ow[i][g].x >> 16), bf2f(ow[i][g].y & 0xffffu), bf2f(ow[i][g].y >> 16)} * al; ss += dot4(v[g]); }
        const float rs = frsq(wave_sum(ss) * (1.0f / 768.0f) + EPS);
#pragma unroll
        for (int g = 0; g < 3; ++g) { const f32x4 y = v[g] * rs * gn[g];
            u32x2 w; w.x = cvt_pk_bf16(y[0], y[1]); w.y = cvt_pk_bf16(y[2], y[3]); *(u32x2*)(MIXED + (size_t)(R0 + i) * D + g * 256 + 4 * lane) = w; }
    }
}
__device__ __forceinline__ float gelu_tanh(float x) { const float u2 = 1.5957691216057308f * (x + 0.044715f * x * x * x); return x * frcp(1.0f + fexp2(-u2 * LOG2E)); }
__device__ __forceinline__ float sigmoidf_(float z) { return frcp(1.0f + fexp2(-z * LOG2E)); }
__device__ __forceinline__ void ssm_c_item(const Args& a, const float* U, const float* ssmc, const float* SSMF, const bf16* WGLU, bf16* MIXED, LAS unsigned char* lds, int item, int wave, int lane) {
    const bool hs = item < 32;
    const int b = item >> 5, c = item & 31;
    const int R0 = item * 64, RS0 = MP + item * 16;
    LAS unsigned* HL = (LAS unsigned*)(lds + wave * 4352);
    LAS float* ZS = (LAS float*)(lds + 34816);
    const int t16 = lane & 15, q4 = lane >> 4;
    for (int gi = 0; gi < 2; ++gi) {
        const int g = 2 * wave + gi;
        const f32x4* cp = (const f32x4*)(ssmc + (size_t)(g * 64 + lane) * 8); const f32x4 c0 = cp[0], c1 = cp[1];
        const float ar = c0[0], ai = c0[1], a64r = c1[0], a64i = c1[1];
        bf16x8 bb[4]; ssm_bfrags(a, ssmc, g, lane, bb);
        bf16x8 cf[4];
#pragma unroll
        for (int s4 = 0; s4 < 4; ++s4) { const int p0 = 16 * s4 + 4 * q4; const f32x4 x = *(const f32x4*)(a.in[I_CRE] + (size_t)(g * 16 + t16) * 64 + p0), y = *(const f32x4*)(a.in[I_CIM] + (size_t)(g * 16 + t16) * 64 + p0);
            cf[s4] = pack8(x[0], -y[0], x[1], -y[1], x[2], -y[2], x[3], -y[3]); }
        const f32x4 dv = *(const f32x4*)(a.in[I_SD] + g * 16 + 4 * q4);
        float hr = 0.f, hi = 0.f;
        {
            const int nb16 = (c + 15) >> 4; int cc0 = c - 16 * nb16;
            for (int i16 = 0; i16 < nb16; ++i16, cc0 += 16) { f32x2 f[16];
#pragma unroll
                for (int j = 0; j < 16; ++j) { const int cc = cc0 + j; f[j] = cc >= 0 ? *(const f32x2*)(SSMF + ((size_t)((b * 32 + cc) * 16 + g) * 64 + lane) * 2) : (f32x2){0.f, 0.f}; }
#pragma unroll
                for (int j = 0; j < 16; ++j) { const float nr = fmaf(a64r, hr, fmaf(-a64i, hi, f[j][0])), ni = fmaf(a64r, hi, fmaf(a64i, hr, f[j][1])); hr = nr; hi = ni; } }
        }
#if defined(PROBE_DUMP)
        { float* dmp = (float*)((unsigned char*)MIXED - WS_MIXED + 741 * MiB) + ((size_t)(item * 16 + g) * 64 + lane) * 2; dmp[0] = hr; dmp[1] = hi; }
#endif
        bf16x8 ua2[2]; f32x4 uv4[4];
        ua2[0] = ssm_loadu(U, R0, 32, g, lane); ua2[1] = ssm_loadu(U, R0 + 32, 32, g, lane);
#pragma unroll
        for (int j = 0; j < 4; ++j) uv4[j] = *(const f32x4*)(U + (size_t)(R0 + 16 * j + t16) * 256 + g * 16 + 4 * q4);
#if defined(PROBE_DUMP)
        { u32x4* dmp = (u32x4*)((unsigned char*)MIXED - WS_MIXED + 724 * MiB) + ((size_t)(item * 16 + g) * 2) * 64 + lane; dmp[0] = __builtin_bit_cast(u32x4, ua2[0]); dmp[64] = __builtin_bit_cast(u32x4, ua2[1]); }
#endif
#pragma unroll
        for (int blk = 0; blk < 2; ++blk) {
            f32x16 xr[2], xi[2]; ssm_xcompute(ua2[blk], bb, xr, xi);
#pragma unroll
            for (int s2 = 0; s2 < 2; ++s2) {
                const int trow = 32 * blk + 16 * s2 + t16;
                const f32x4 uv = uv4[2 * blk + s2];
#pragma unroll
                for (int tt = 0; tt < 16; ++tt) { const int t = 16 * s2 + tt;
                    const float nr = fmaf(ar, hr, fmaf(-ai, hi, SSM_XR(t))), ni = fmaf(ar, hi, fmaf(ai, hr, SSM_XI(t))); hr = nr; hi = ni;
                    HL[tt * 68 + lane] = cvt_pk_bf16(hr, hi);
                }
                LDS_WAIT(); asm volatile("" ::: "memory");
                f32x4 y = {0.f, 0.f, 0.f, 0.f};
#pragma unroll
                for (int s4 = 0; s4 < 4; ++s4) { const bf16x8 hf = *(const LAS bf16x8*)((LAS unsigned short*)HL + t16 * 136 + 32 * s4 + 8 * q4); y = __builtin_amdgcn_mfma_f32_16x16x32_bf16(cf[s4], hf, y, 0, 0, 0); }
                f32x4 z;
#pragma unroll
                for (int e = 0; e < 4; ++e) z[e] = gelu_tanh(y[e] + dv[e] * uv[e]);
                *(LAS f32x4*)(ZS + trow * 260 + g * 16 + 4 * q4) = z;
                LDS_WAIT(); asm volatile("" ::: "memory");
            }
        }
        if (c == 31) { a.out[O_SREP + (size_t)(b * 16 + g) * 64 + lane] = hr; a.out[O_SIMP + (size_t)(b * 16 + g) * 64 + lane] = hi; }
        if (hs) {
            float sre[4], sim[4];
#pragma unroll
            for (int j = 0; j < 4; ++j) { const size_t o = (size_t)((4 * item + j) * 16 + g) * 64 + lane; sre[j] = a.in[I_SRE][o]; sim[j] = a.in[I_SIM][o]; }
            const bf16x8 ua = ssm_loadu(U, RS0, 16, g, lane);
            const f32x4 uv = *(const f32x4*)(U + (size_t)(RS0 + t16) * 256 + g * 16 + 4 * q4);
            f32x16 xr[2], xi[2]; ssm_xcompute(ua, bb, xr, xi);
#pragma unroll
            for (int tt = 0; tt < 16; ++tt) {
                if ((tt & 3) == 0) { hr = sre[tt >> 2]; hi = sim[tt >> 2]; }
                const float nr = fmaf(ar, hr, fmaf(-ai, hi, SSM_XR(tt))), ni = fmaf(ar, hi, fmaf(ai, hr, SSM_XI(tt))); hr = nr; hi = ni;
                HL[tt * 68 + lane] = cvt_pk_bf16(hr, hi);
                if ((tt & 3) == 3) { const size_t o = (size_t)((4 * item + (tt >> 2)) * 16 + g) * 64 + lane; a.out[O_SRES + o] = hr; a.out[O_SIMS + o] = hi; }
            }
            LDS_WAIT(); asm volatile("" ::: "memory");
            f32x4 y = {0.f, 0.f, 0.f, 0.f};
#pragma unroll
            for (int s4 = 0; s4 < 4; ++s4) { const bf16x8 hf = *(const LAS bf16x8*)((LAS unsigned short*)HL + t16 * 136 + 32 * s4 + 8 * q4); y = __builtin_amdgcn_mfma_f32_16x16x32_bf16(cf[s4], hf, y, 0, 0, 0); }
            f32x4 z;
#pragma unroll
            for (int e = 0; e < 4; ++e) z[e] = gelu_tanh(y[e] + dv[e] * uv[e]);
            *(LAS f32x4*)(ZS + (64 + t16) * 260 + g * 16 + 4 * q4) = z;
            LDS_WAIT(); asm volatile("" ::: "memory");
        }
    }
    const int n = lane & 31, hi5 = lane >> 5, n0 = 32 * wave, nmt = hs ? 3 : 2;
    bf16x8 bfr[16];
#pragma unroll
    for (int st = 0; st < 16; ++st) bfr[st] = *(const bf16x8*)(WGLU + (size_t)(n0 + n) * 256 + 16 * st + 8 * hi5);
    const float bias = a.in[I_BGLU][n0 + n];
    const f32x4 gn = *(const f32x4*)(a.in[I_SON] + 4 * lane);
    __syncthreads();
    f32x16 acc[3];
#pragma unroll
    for (int mt = 0; mt < 3; ++mt) acc[mt] = (f32x16){0.f, 0.f, 0.f, 0.f, 0.f, 0.f, 0.f, 0.f, 0.f, 0.f, 0.f, 0.f, 0.f, 0.f, 0.f, 0.f};
#pragma unroll
    for (int st = 0; st < 16; ++st) {
        const bf16x8 bf = bfr[st];
#pragma unroll
        for (int mt = 0; mt < 3; ++mt) { if (mt < nmt) { const LAS float* zp = ZS + (32 * mt + n) * 260 + 16 * st + 8 * hi5; const f32x4 x = *(const LAS f32x4*)zp, y = *(const LAS f32x4*)(zp + 4);
            acc[mt] = __builtin_amdgcn_mfma_f32_32x32x16_bf16(pack8(x[0], x[1], x[2], x[3], y[0], y[1], y[2], y[3]), bf, acc[mt], 0, 0, 0); } }
    }
    float so[3][16];
#pragma unroll
    for (int mt = 0; mt < 3; ++mt) { if (mt < nmt) {
#pragma unroll
        for (int r = 0; r < 16; ++r) { const int t = 32 * mt + (r & 3) + 8 * (r >> 2) + 4 * hi5; so[mt][r] = ZS[t * 260 + n0 + n] * sigmoidf_(acc[mt][r] + bias); } } }
    __syncthreads();
#pragma unroll
    for (int mt = 0; mt < 3; ++mt) { if (mt < nmt) {
#pragma unroll
        for (int r = 0; r < 16; ++r) { const int t = 32 * mt + (r & 3) + 8 * (r >> 2) + 4 * hi5; ZS[t * 260 + n0 + n] = so[mt][r]; } } }
    __syncthreads();
#pragma unroll
    for (int i = 0; i < 10; ++i) { if (i >= 8 && !hs) break;
        const int row = i < 8 ? 8 * wave + i : 64 + 2 * wave + (i - 8); const f32x4 v = *(const LAS f32x4*)(ZS + row * 260 + 4 * lane);
        const float rs = frsq(wave_sum(dot4(v)) * (1.0f / 256.0f) + EPS); const f32x4 y = v * rs * gn;
        const size_t orow = i < 8 ? (size_t)(R0 + row) : (size_t)(RS0 + row - 64);
        u32x2 w; w.x = cvt_pk_bf16(y[0], y[1]); w.y = cvt_pk_bf16(y[2], y[3]); *(u32x2*)(MIXED + orow * D + 768 + 4 * lane) = w; }
    __syncthreads();
}

__device__ __forceinline__ float xq_sigma(const float* RS1, const float* QS, int R, int h) {
    const float rstd = frsq(RS1[R] * (1.0f / 1024.0f) + EPS), msq = QS[(size_t)R * 4 + h] * (1.0f / 256.0f);
    return rstd / sqrtf(rstd * rstd * msq + EPS) * (0.0625f * LOG2E);
}
template <int MODE, bool BASE_BF16 = false> __device__ __forceinline__ void sample_gemm_tile(const bf16* A, const bf16* Bt, int K, const void* base, float* outp, bf16* hb, float* ssq, LAS unsigned char* lds, int tile, int wave, int lane, int tid) {
    const int tm = tile >> 5, tn = tile & 31, n = lane & 31, hi = lane >> 5, kw = K >> 3;
    const bf16* ap = A + (size_t)(64 * tm + n) * K + wave * kw + 8 * hi;
    const bf16* bp = Bt + (size_t)(32 * tn + n) * K + wave * kw + 8 * hi;
    f32x16 acc0 = {0.f, 0.f, 0.f, 0.f, 0.f, 0.f, 0.f, 0.f, 0.f, 0.f, 0.f, 0.f, 0.f, 0.f, 0.f, 0.f}, acc1 = acc0;
    const int row = tid >> 3, c4 = (tid & 7) * 4, rs = 64 * tm + row, col = 32 * tn + c4;
    f32x4 bs = {0.f, 0.f, 0.f, 0.f};
    if (MODE == 0) {
        if (BASE_BF16) { const u32x2 w = *(const u32x2*)((const bf16*)base + (size_t)rs * D + col); bs = (f32x4){bf2f(w.x & 0xffffu), bf2f(w.x >> 16), bf2f(w.y & 0xffffu), bf2f(w.y >> 16)}; }
        else bs = *(const f32x4*)((const float*)base + (size_t)rs * D + col); }
#pragma unroll 8
    for (int s = 0; s < kw; s += 16) { const bf16x8 a0 = *(const bf16x8*)(ap + s), a1 = *(const bf16x8*)(ap + (size_t)32 * K + s), bb = *(const bf16x8*)(bp + s);
        acc0 = __builtin_amdgcn_mfma_f32_32x32x16_bf16(a0, bb, acc0, 0, 0, 0); acc1 = __builtin_amdgcn_mfma_f32_32x32x16_bf16(a1, bb, acc1, 0, 0, 0); }
    LAS float* P = (LAS float*)lds;
#pragma unroll
    for (int r = 0; r < 16; ++r) { const int row = (r & 3) + 8 * (r >> 2) + 4 * hi; P[(wave * 64 + row) * 32 + n] = acc0[r]; P[(wave * 64 + 32 + row) * 32 + n] = acc1[r]; }
    __syncthreads();
    f32x4 v = {0.f, 0.f, 0.f, 0.f};
#pragma unroll
    for (int w = 0; w < 8; ++w) v = v + *(const LAS f32x4*)(P + (w * 64 + row) * 32 + c4);
    float s;
    if (MODE == 0) {
        const f32x4 o = bs + v; if (outp) *(f32x4*)(outp + (size_t)rs * D + col) = o;
        if (hb) { u32x2 w; w.x = cvt_pk_bf16(o[0], o[1]); w.y = cvt_pk_bf16(o[2], o[3]); *(u32x2*)(hb + (size_t)rs * D + col) = w; }
        s = dot4(o); }
    else { u32x2 w; w.x = cvt_pk_bf16(v[0], v[1]); w.y = cvt_pk_bf16(v[2], v[3]); *(u32x2*)(hb + (size_t)rs * D + col) = w; s = dot4(v); }
    if (ssq) { s += __shfl_xor(s, 1); s += __shfl_xor(s, 2); s += __shfl_xor(s, 4); if ((tid & 7) == 0) atomic_addf(MODE == 0 ? ssq + rs : ssq + (size_t)rs * 4 + (tn >> 3), s); }
    __syncthreads();
}
constexpr int XK_ROW = 272, XK_BUF = 32 * XK_ROW, XV_BUF = XK_BUF, XV_OFF = 2 * XK_BUF;
__device__ __forceinline__ void xattn_wg_item(const bf16* QX, const float* SS1, const float* QSS, const bf16* MEMK, const bf16* MVT, bf16* OX, LAS unsigned char* lds, int it, int wave, int lane, int tid) {
    const int qb = it & 7, h = (it >> 3) & 3, b = it >> 5;
    const int n = lane & 31, hi = lane >> 5, R = b * 2048 + 256 * qb + 32 * wave + n;
    const float sigma = xq_sigma(SS1, QSS, R, h);
    const bf16* kg = MEMK + (size_t)(b * 256 + (tid >> 4)) * 1024 + h * 256 + 128 * ((tid >> 3) & 1) + 8 * (tid & 7);
    const bf16* vg = MVT + (size_t)(b * 256 + (tid >> 4)) * 1024 + h * 256 + 8 * (tid & 15);
    LAS unsigned char* kl = lds + (tid >> 4) * XK_ROW + (tid & 15) * 16;
    LAS unsigned char* vl = lds + XV_OFF + (tid >> 4) * XK_ROW + (tid & 15) * 16;
#define XSRC(t) ((t) < 16 ? (const u32x4*)(kg + (size_t)((t) & 7) * 32 * 1024 + ((t) >> 3) * 64) : (const u32x4*)(vg + (size_t)(((t) - 16) & 7) * 32 * 1024 + (((t) - 16) >> 3) * 128))
#define XPUT(t, w_) do { if ((t) < 16) *(LAS u32x4*)(kl + ((t) & 1) * XK_BUF) = (w_); else *(LAS u32x4*)(vl + ((t) & 1) * XV_BUF) = (w_); } while (0)
    u32x4 ring[3]; ring[0] = *XSRC(0); ring[1] = *XSRC(1); ring[2] = *XSRC(2);
    f32x16 sc[8];
#pragma unroll
    for (int kt = 0; kt < 8; ++kt) sc[kt] = (f32x16){0.f, 0.f, 0.f, 0.f, 0.f, 0.f, 0.f, 0.f, 0.f, 0.f, 0.f, 0.f, 0.f, 0.f, 0.f, 0.f};
    XPUT(0, ring[0]);
    __syncthreads();
    const LAS unsigned char* kr = lds + pi23(n) * XK_ROW + 128 * hi;
#pragma unroll
    for (int dh = 0; dh < 2; ++dh) {
        bf16x8 qf[8];
        { const bf16* qp = QX + (size_t)R * D + h * 256 + 128 * hi + 64 * dh;
#pragma unroll
          for (int st = 0; st < 8; ++st) qf[st] = *(const bf16x8*)(qp + 8 * st); }
#pragma unroll
        for (int kt = 0; kt < 8; ++kt) {
            const int s = dh * 8 + kt;
            ring[s % 3] = *XSRC(s + 3);
            const LAS unsigned char* kp = kr + (s & 1) * XK_BUF;
            bf16x8 kf[8];
#pragma unroll
            for (int st = 0; st < 8; ++st) kf[st] = *(const LAS bf16x8*)(kp + 16 * st);
            __builtin_amdgcn_sched_barrier(0);
#pragma unroll
            for (int st = 0; st < 8; ++st) sc[kt] = __builtin_amdgcn_mfma_f32_32x32x16_bf16(kf[st], qf[st], sc[kt], 0, 0, 0);
            XPUT(s + 1, ring[(s + 1) % 3]);
            asm volatile("s_waitcnt lgkmcnt(0)\n\ts_barrier" ::: "memory");
        }
    }
    float mx = -1e30f;
#pragma unroll
    for (int kt = 0; kt < 8; ++kt)
#pragma unroll
        for (int r = 0; r < 16; ++r) { sc[kt][r] *= sigma; mx = fmaxf(mx, sc[kt][r]); }
    mx = fmaxf(mx, __shfl_xor(mx, 32));
    float l = 0.f;
#pragma unroll
    for (int kt = 0; kt < 8; ++kt)
#pragma unroll
        for (int r = 0; r < 16; ++r) { const float p = fexp2(sc[kt][r] - mx); sc[kt][r] = p; l += p; }
    l += __shfl_xor(l, 32);
    const float il = frcp(l);
    bf16x8 pb[8][2];
#pragma unroll
    for (int kt = 0; kt < 8; ++kt)
#pragma unroll
        for (int jj = 0; jj < 2; ++jj) pb[kt][jj] = pack8(sc[kt][8 * jj + 0], sc[kt][8 * jj + 1], sc[kt][8 * jj + 2], sc[kt][8 * jj + 3], sc[kt][8 * jj + 4], sc[kt][8 * jj + 5], sc[kt][8 * jj + 6], sc[kt][8 * jj + 7]);
    LAS unsigned char* vr = lds + XV_OFF + (8 * hi + ((lane >> 2) & 3)) * XK_ROW + (16 * ((lane >> 4) & 1) + 4 * (lane & 3)) * 2;
    bf16* op = OX + (size_t)R * D + h * 256 + 4 * hi;
#pragma unroll
    for (int dh = 0; dh < 2; ++dh) {
        f32x16 o[4];
#pragma unroll
        for (int dt = 0; dt < 4; ++dt) o[dt] = (f32x16){0.f, 0.f, 0.f, 0.f, 0.f, 0.f, 0.f, 0.f, 0.f, 0.f, 0.f, 0.f, 0.f, 0.f, 0.f, 0.f};
#pragma unroll
        for (int kt = 0; kt < 8; ++kt) {
            const int s = 16 + dh * 8 + kt;
            if (s + 3 < 32) ring[s % 3] = *XSRC(s + 3);
            LAS unsigned char* vp = vr + (s & 1) * XV_BUF;
            bf16x8 vf[4][2];
#pragma unroll
            for (int dt = 0; dt < 4; ++dt)
#pragma unroll
                for (int jj = 0; jj < 2; ++jj) vf[dt][jj] = cat44(lds_tr4(vp + (16 * jj) * XK_ROW + 64 * dt), lds_tr4(vp + (16 * jj + 4) * XK_ROW + 64 * dt));
            __builtin_amdgcn_sched_barrier(0);
#pragma unroll
            for (int jj = 0; jj < 2; ++jj)
#pragma unroll
                for (int dt = 0; dt < 4; ++dt) o[dt] = __builtin_amdgcn_mfma_f32_32x32x16_bf16(vf[dt][jj], pb[kt][jj], o[dt], 0, 0, 0);
            if (s + 1 < 32) XPUT(s + 1, ring[(s + 1) % 3]);
            asm volatile("s_waitcnt lgkmcnt(0)\n\ts_barrier" ::: "memory");
        }
#pragma unroll
        for (int dt = 0; dt < 4; ++dt)
#pragma unroll
            for (int r4 = 0; r4 < 4; ++r4) { u32x2 w; w.x = cvt_pk_bf16(o[dt][4 * r4] * il, o[dt][4 * r4 + 1] * il); w.y = cvt_pk_bf16(o[dt][4 * r4 + 2] * il, o[dt][4 * r4 + 3] * il);
                *(u32x2*)(op + 128 * dh + 32 * dt + 8 * r4) = w; }
    }
}
#undef XSRC
#undef XPUT
constexpr int SXB = 4;
struct SxBatch { f32x4 k[SXB], v[SXB]; };
__device__ __forceinline__ void sx_load(SxBatch& B, const float* kb, unsigned loff, int j0) {
#pragma unroll
    for (int j = 0; j < SXB; ++j) { const char* p = (const char*)(kb + (size_t)(j0 + j) * 2048); B.k[j] = __builtin_nontemporal_load((const f32x4*)(p + loff)); B.v[j] = __builtin_nontemporal_load((const f32x4*)(p + 4096 + loff)); }
}
__device__ __forceinline__ float rdl(float v, int l) { return __builtin_bit_cast(float, __builtin_amdgcn_readlane(__builtin_bit_cast(int, v), l)); }
__device__ __forceinline__ void sx_compute(const SxBatch& B, const f32x4 (&q)[4], bool b5, bool b4, float& m, float& l, f32x4 (&o)[4]) {
    float s[SXB]; float mb = m;
#pragma unroll
    for (int j = 0; j < SXB; ++j) {
        float d[4];
#pragma unroll
        for (int t = 0; t < 4; ++t) d[t] = (q[t][0] * B.k[j][0] + q[t][1] * B.k[j][1]) + (q[t][2] * B.k[j][2] + q[t][3] * B.k[j][3]);
        const float x0 = b5 ? d[0] : d[2], x1 = b5 ? d[1] : d[3], k0 = b5 ? d[2] : d[0], k1 = b5 ? d[3] : d[1];
        const float r0 = k0 + __shfl_xor(x0, 32), r1 = k1 + __shfl_xor(x1, 32);
        const float xs = b4 ? r0 : r1, ks = b4 ? r1 : r0;
        float r = ks + __shfl_xor(xs, 16);
        r += __shfl_xor(r, 8); r += __shfl_xor(r, 4); r += __shfl_xor(r, 2); r += __shfl_xor(r, 1);
        s[j] = r; mb = fmaxf(mb, r);
    }
    const float sc = fexp2(m - mb); m = mb; l *= sc;
#pragma unroll
    for (int t = 0; t < 4; ++t) o[t] = o[t] * rdl(sc, 16 * t);
#pragma unroll
    for (int j = 0; j < SXB; ++j) { const float p = fexp2(s[j] - mb); l += p;
#pragma unroll
        for (int t = 0; t < 4; ++t) o[t] = o[t] + B.v[j] * rdl(p, 16 * t); }
}
template <int NSW> __device__ __forceinline__ void sxattn_stream(const Args& a, const bf16* QX, const float* SS1S, const float* QSSS, bf16* OX, LAS unsigned char* lds, LAS unsigned* cnt, int pair, int slot, int sw, int lane) {
    const int b = pair >> 2, h = pair & 3;
    LAS float* OL = (LAS float*)lds + (size_t)slot * (NSW * 1024); LAS float* ML = (LAS float*)(lds + 65536) + slot * 32; LAS float* LL = (LAS float*)(lds + 65536 + 256) + slot * 32;
    const f32x4 gq = *(const f32x4*)(a.in[I_XQN] + 4 * lane);
    f32x4 q[4];
    const float sgc = xq_sigma(SS1S, QSSS, MP + 4 * b + (lane >> 4), h);
#pragma unroll
    for (int t = 0; t < 4; ++t) { const int R = MP + 4 * b + t; const float sg = rdl(sgc, 16 * t); const u32x2 w = *(const u32x2*)(QX + (size_t)R * D + h * 256 + 4 * lane);
        q[t] = (f32x4){bf2f(w.x & 0xffffu), bf2f(w.x >> 16), bf2f(w.y & 0xffffu), bf2f(w.y >> 16)} * gq * sg; }
    constexpr int NK = 256 / NSW;
    const float* kb = a.in[I_CMEM] + ((size_t)(b * 256 + NK * sw) * 2) * 1024 + h * 256; const unsigned loff = 16u * (unsigned)lane;
    const bool b5 = (lane & 32) != 0, b4 = (lane & 16) != 0;
    float m = -1e30f, l = 0.f;
    f32x4 o[4];
#pragma unroll
    for (int t = 0; t < 4; ++t) o[t] = (f32x4){0.f, 0.f, 0.f, 0.f};
    SxBatch A, B; sx_load(A, kb, loff, 0);
#pragma unroll 1
    for (int j0 = 0; j0 < NK; j0 += 2 * SXB) {
        sx_load(B, kb, loff, j0 + SXB);
        sx_compute(A, q, b5, b4, m, l, o);
        if (j0 + 2 * SXB < NK) sx_load(A, kb, loff, j0 + 2 * SXB);
        sx_compute(B, q, b5, b4, m, l, o);
    }
#pragma unroll
    for (int t = 0; t < 4; ++t) *(LAS f32x4*)(OL + (sw * 4 + t) * 256 + 4 * lane) = o[t];
    if ((lane & 15) == 0) { ML[sw * 4 + (lane >> 4)] = m; LL[sw * 4 + (lane >> 4)] = l; }
    asm volatile("s_waitcnt lgkmcnt(0)" ::: "memory");
    unsigned old = 0u; if (lane == 0) old = __hip_atomic_fetch_add(cnt, 1u, __ATOMIC_ACQ_REL, __HIP_MEMORY_SCOPE_WORKGROUP);
    old = __builtin_amdgcn_readfirstlane(old);
    if (old == (unsigned)(NSW - 1)) {
        asm volatile("s_waitcnt lgkmcnt(0)" ::: "memory");
#pragma unroll
        for (int t = 0; t < 4; ++t) {
            float M = -1e30f;
#pragma unroll
            for (int w = 0; w < NSW; ++w) M = fmaxf(M, ML[w * 4 + t]);
            float L = 0.f; f32x4 acc = {0.f, 0.f, 0.f, 0.f};
#pragma unroll
            for (int w = 0; w < NSW; ++w) { const float f = fexp2(ML[w * 4 + t] - M); L += LL[w * 4 + t] * f; acc = acc + *(const LAS f32x4*)(OL + (w * 4 + t) * 256 + 4 * lane) * f; }
            const float il = frcp(L); u32x2 wv; wv.x = cvt_pk_bf16(acc[0] * il, acc[1] * il); wv.y = cvt_pk_bf16(acc[2] * il, acc[3] * il);
            *(u32x2*)(OX + (size_t)(MP + 4 * b + t) * D + h * 256 + 4 * lane) = wv;
        }
    }
}

__device__ __forceinline__ void up8(const bf16* p, float (&v)[8]) { const u32x4 w = *(const u32x4*)p;
    v[0] = bf2f(w.x & 0xffffu); v[1] = bf2f(w.x >> 16); v[2] = bf2f(w.y & 0xffffu); v[3] = bf2f(w.y >> 16); v[4] = bf2f(w.z & 0xffffu); v[5] = bf2f(w.z >> 16); v[6] = bf2f(w.w & 0xffffu); v[7] = bf2f(w.w >> 16); }
__device__ __forceinline__ void ld8(const float* p, float (&v)[8]) { const f32x4 a = *(const f32x4*)p, b = *(const f32x4*)(p + 4); v[0] = a[0]; v[1] = a[1]; v[2] = a[2]; v[3] = a[3]; v[4] = b[0]; v[5] = b[1]; v[6] = b[2]; v[7] = b[3]; }
__device__ __forceinline__ void conv_item(const Args& a, const bf16* UP, bf16* ACT, int it) {
    const int cgp = it % 352, rc = it / 352, j0 = cgp * 8, R0 = rc * 32;
    const float* cw = a.in[I_CONVW]; const float* cbp = a.in[I_CONVB];
    float wg[3][8], wv[3][8], bg[8], bv[8];
#pragma unroll
    for (int i = 0; i < 3; ++i) { ld8(cw + (size_t)i * FF2 + j0, wg[i]); ld8(cw + (size_t)i * FF2 + FF + j0, wv[i]); }
    ld8(cbp + j0, bg); ld8(cbp + FF + j0, bv);
    float g2[8], g1[8], v2[8], v1[8];
    const bool sample = R0 >= MP;
    if (!sample && (R0 & 2047) != 0) { up8(UP + (size_t)(R0 - 2) * FF2 + j0, g2); up8(UP + (size_t)(R0 - 1) * FF2 + j0, g1); up8(UP + (size_t)(R0 - 2) * FF2 + FF + j0, v2); up8(UP + (size_t)(R0 - 1) * FF2 + FF + j0, v1); }
    else {
#pragma unroll
        for (int e = 0; e < 8; ++e) { g2[e] = 0.f; g1[e] = 0.f; v2[e] = 0.f; v1[e] = 0.f; } }
    for (int r = 0; r < 32; ++r) { const int R = R0 + r;
        if (sample && (r & 3) == 0) { const float* sb = a.in[I_SCONV] + (size_t)((R - MP) >> 2) * 2 * FF2; ld8(sb + j0, g2); ld8(sb + FF2 + j0, g1); ld8(sb + FF + j0, v2); ld8(sb + FF2 + FF + j0, v1); }
        float gc[8], vc[8]; up8(UP + (size_t)R * FF2 + j0, gc); up8(UP + (size_t)R * FF2 + FF + j0, vc);
        float o[8];
#pragma unroll
        for (int e = 0; e < 8; ++e) { const float cgv = bg[e] + wg[0][e] * g2[e] + wg[1][e] * g1[e] + wg[2][e] * gc[e]; const float cvv = bv[e] + wv[0][e] * v2[e] + wv[1][e] * v1[e] + wv[2][e] * vc[e];
            o[e] = cgv * sigmoidf_(cgv) * cvv; g2[e] = g1[e]; g1[e] = gc[e]; v2[e] = v1[e]; v1[e] = vc[e]; }
        u32x4 w; w.x = cvt_pk_bf16(o[0], o[1]); w.y = cvt_pk_bf16(o[2], o[3]); w.z = cvt_pk_bf16(o[4], o[5]); w.w = cvt_pk_bf16(o[6], o[7]);
        *(u32x4*)(ACT + (size_t)R * FF + j0) = w;
    }
}

__device__ __forceinline__ void conv_fix_item(const Args& a, const float* EDGE, bf16* ACT, int it) {
    const int cgp = it % 352, rr = it / 352, r = rr & 1, ti = rr >> 1;
    const int pm = 8 * (ti / 7) + 1 + ti % 7, j0 = cgp * 8;
    const float* cw = a.in[I_CONVW]; const float* cbp = a.in[I_CONVB];
    const float* e_prev = EDGE + (size_t)(pm - 1) * 4 * FF2; const float* e_cur = EDGE + (size_t)pm * 4 * FF2;
    const float* r2 = r == 0 ? e_prev + 2 * FF2 : e_prev + 3 * FF2; const float* r1 = r == 0 ? e_prev + 3 * FF2 : e_cur; const float* r0 = r == 0 ? e_cur : e_cur + FF2;
    float o[8];
#pragma unroll
    for (int hf = 0; hf < 2; ++hf) { const int j4 = j0 + 4 * hf;
        const f32x4 cg = *(const f32x4*)(cbp + j4) + *(const f32x4*)(cw + j4) * *(const f32x4*)(r2 + j4) + *(const f32x4*)(cw + FF2 + j4) * *(const f32x4*)(r1 + j4) + *(const f32x4*)(cw + 2 * FF2 + j4) * *(const f32x4*)(r0 + j4);
        const f32x4 cv = *(const f32x4*)(cbp + FF + j4) + *(const f32x4*)(cw + FF + j4) * *(const f32x4*)(r2 + FF + j4) + *(const f32x4*)(cw + FF2 + FF + j4) * *(const f32x4*)(r1 + FF + j4) + *(const f32x4*)(cw + 2 * FF2 + FF + j4) * *(const f32x4*)(r0 + FF + j4);
#pragma unroll
        for (int e = 0; e < 4; ++e) o[4 * hf + e] = cg[e] * sigmoidf_(cg[e]) * cv[e]; }
    u32x4 w; w.x = cvt_pk_bf16(o[0], o[1]); w.y = cvt_pk_bf16(o[2], o[3]); w.z = cvt_pk_bf16(o[4], o[5]); w.w = cvt_pk_bf16(o[6], o[7]);
    *(u32x4*)(ACT + (size_t)(pm * 256 + r) * FF + j0) = w;
}

__device__ __forceinline__ void conv_fix_tile(const Args& a, const float* EDGE, bf16* ACT, int pm, int tid) {
    const float* cw = a.in[I_CONVW]; const float* cbp = a.in[I_CONVB];
    const float* e_prev = EDGE + (size_t)(pm - 1) * 4 * FF2; const float* e_cur = EDGE + (size_t)pm * 4 * FF2;
    for (int it = tid; it < 2 * 352; it += NWAVES * 64) { const int r = it / 352, j0 = (it - r * 352) * 8;
        const float* r2 = r == 0 ? e_prev + 2 * FF2 : e_prev + 3 * FF2; const float* r1 = r == 0 ? e_prev + 3 * FF2 : e_cur; const float* r0 = r == 0 ? e_cur : e_cur + FF2;
        float o[8];
#pragma unroll
        for (int hf = 0; hf < 2; ++hf) { const int j4 = j0 + 4 * hf;
            const f32x4 cg = *(const f32x4*)(cbp + j4) + *(const f32x4*)(cw + j4) * *(const f32x4*)(r2 + j4) + *(const f32x4*)(cw + FF2 + j4) * *(const f32x4*)(r1 + j4) + *(const f32x4*)(cw + 2 * FF2 + j4) * *(const f32x4*)(r0 + j4);
            const f32x4 cv = *(const f32x4*)(cbp + FF + j4) + *(const f32x4*)(cw + FF + j4) * *(const f32x4*)(r2 + FF + j4) + *(const f32x4*)(cw + FF2 + FF + j4) * *(const f32x4*)(r1 + FF + j4) + *(const f32x4*)(cw + 2 * FF2 + FF + j4) * *(const f32x4*)(r0 + FF + j4);
#pragma unroll
            for (int e = 0; e < 4; ++e) o[4 * hf + e] = cg[e] * sigmoidf_(cg[e]) * cv[e]; }
        u32x4 w; w.x = cvt_pk_bf16(o[0], o[1]); w.y = cvt_pk_bf16(o[2], o[3]); w.z = cvt_pk_bf16(o[4], o[5]); w.w = cvt_pk_bf16(o[6], o[7]);
        *(u32x4*)(ACT + (size_t)(pm * 256 + r) * FF + j0) = w; }
}

#ifndef MK_N_LAUNCHES
#define MK_N_LAUNCHES 1
#endif
constexpr int N_PHASES = 11;
#ifndef DUP_PHASE
#define DUP_PHASE -1
#endif
#define NREP(k) ((DUP_PHASE) == (k) ? 2 : 1)
constexpr int N_LAUNCHES = MK_N_LAUNCHES;
static_assert(N_LAUNCHES == 1 || N_LAUNCHES == N_PHASES, "MK_N_LAUNCHES is 1 or 11");

__global__ void __launch_bounds__(NWAVES * 64, 2) fwd_kernel(Args args) {
    extern __shared__ __attribute__((aligned(16))) unsigned char lds_raw[];
    LAS unsigned char* lds = (LAS unsigned char*)lds_raw;
    volatile LAS unsigned* MISC = (volatile LAS unsigned*)(lds + MISC_OFF);
    const int tid0 = threadIdx.x, wave0 = __builtin_amdgcn_readfirstlane(tid0 >> 6);
    const int G = gridDim.x; const int bx = blockIdx.x; const int vcu = (G % 8 == 0) ? (bx % 8) * (G / 8) + bx / 8 : bx;
    const int NGW = G * NWAVES;
    unsigned char* ws = args.ws;
    gu32* ctl = (gu32*)(ws + WS_CTL);
    for (int u = tid0; u < 128; u += NWAVES * 64) ((LAS unsigned*)(lds + MISC_OFF))[u] = 0u;
    __syncthreads();
    XcdBarrier bar; bar.bar = (unsigned*)(ctl + CW_BAR); bar.x = 0; bar.st = nullptr;
    if (N_LAUNCHES == 1) bar = xcd_barrier_post((unsigned*)(ctl + CW_BAR) + args.li * XCD_BAR_WORDS, MISC + 8);
#ifdef DOUBLE_BAR
#define GRID_BAR() do { if (N_LAUNCHES == 1) { xcd_barrier(bar); xcd_barrier(bar); } } while (0)
#else
#define GRID_BAR() do { if (N_LAUNCHES == 1) xcd_barrier(bar); } while (0)
#endif
    const int lo = args.ph_lo, hi = args.ph_hi;
#define IN(k) (lo <= (k) && (k) < hi)
#define WSBASE() GAS unsigned char* wsl = (GAS unsigned char*)ws; asm volatile("" : "+s"(wsl));     int tid = threadIdx.x; asm volatile("" : "+v"(tid)); const int lane = tid & 63, wave = __builtin_amdgcn_readfirstlane(tid >> 6), gw = vcu * NWAVES + wave; (void)lane; (void)gw
#define ROPE_ ((float*)(wsl + WS_ROPE))
#define SSMC_ ((float*)(wsl + WS_SSMC))
#define WIN ((bf16*)(wsl + WS_WIN))
#define WOUT ((bf16*)(wsl + WS_WOUT))
#define WXQ ((bf16*)(wsl + WS_WXQ))
#define WXKV ((bf16*)(wsl + WS_WXKV))
#define WXO ((bf16*)(wsl + WS_WXO))
#define WUP ((bf16*)(wsl + WS_WUP))
#define WDOWN ((bf16*)(wsl + WS_WDOWN))
#define WGLU ((bf16*)(wsl + WS_WGLU))
#define XN ((bf16*)(wsl + WS_XN))
#define MEMN ((bf16*)(wsl + WS_MEMN))
#define Qb ((bf16*)(wsl + WS_Q))
#define Kb ((bf16*)(wsl + WS_K))
#define VT ((bf16*)(wsl + WS_VT))
#define U_ ((float*)(wsl + WS_U))
#define AO ((bf16*)(wsl + WS_AO))
#define LSE ((float*)(wsl + WS_LSE))
#define SSMF ((float*)(wsl + WS_SSMF))
#define MIXED ((bf16*)(wsl + WS_MIXED))
#define H1B ((bf16*)(wsl + WS_H1B))
#define SS1 ((float*)(wsl + WS_CTL + CTL_RS1))
#define QX ((bf16*)(wsl + WS_QX))
#define QSS ((float*)(wsl + WS_CTL + CTL_QS))
#define MSS ((float*)(wsl + WS_MSS))
#define MEMK ((bf16*)(wsl + WS_MEMK))
#define MVT ((bf16*)(wsl + WS_MVT))
#define OX ((bf16*)(wsl + WS_OX))
#define H2B ((bf16*)(wsl + WS_H2B))
#define SS2 ((float*)(wsl + WS_CTL + CTL_RS2))
#define UP ((bf16*)(wsl + WS_UP))
#define ACT ((bf16*)(wsl + WS_ACT))
#define SS1S (SS1 + MP)
#define QSSS (QSS + (size_t)MP * 4)
#define SS2S (SS2 + MP)
    float* out = args.out;

    if (IN(0)) for (int rep_ = 0; rep_ < NREP(0); ++rep_) { WSBASE();
        LAS float* scr = (LAS float*)(lds + wave * 16384);
        constexpr int I_IN = 16 * (INW / 32), I_SQ = 16 * (D / 32), I_KV = 16 * (2048 / 32), I_UP = 16 * (FF2 / 32), I_DN = (FF / 64) * (D / 32), I_GL = 4 * 8;
        constexpr int NIT = I_IN + 3 * I_SQ + I_KV + I_GL; (void)I_UP; (void)I_DN;
        for (int it = gw; it < NIT; it += NGW) {
            int r = it;
            if (r < I_IN) { p0_transpose_item<1>(args.in[I_WIN], D, INW, WIN, nullptr, scr, r, lane); continue; } r -= I_IN;
            if (r < I_SQ) { p0_transpose_item<0>(args.in[I_WOUT], D, D, WOUT, nullptr, scr, r, lane); continue; } r -= I_SQ;
            if (r < I_SQ) { p0_transpose_item<0>(args.in[I_WXQ], D, D, WXQ, args.in[I_NX], scr, r, lane); continue; } r -= I_SQ;
            if (r < I_SQ) { p0_transpose_item<0>(args.in[I_WXO], D, D, WXO, nullptr, scr, r, lane); continue; } r -= I_SQ;
            if (r < I_KV) { p0_transpose_item<0>(args.in[I_WXKV], D, 2048, WXKV, nullptr, scr, r, lane); continue; } r -= I_KV;
            p0_transpose_item<0>(args.in[I_WGLU], 256, 256, WGLU, nullptr, scr, r, lane);
        }
        { f32x4 gg[4];
#pragma unroll
          for (int j = 0; j < 4; ++j) gg[j] = ((const f32x4*)args.in[I_NMIX])[lane + 64 * j];
          for (int m = 2 * gw; m < MT; m += 2 * NGW) { const float* x0 = m < MP ? args.in[I_XP] + (size_t)m * D : args.in[I_XS] + (size_t)(m - MP) * D;
              rms_rows2_to_bf16(x0, x0 + D, gg, XN + (size_t)m * D, XN + (size_t)(m + 1) * D, lane); }
#pragma unroll
          for (int j = 0; j < 4; ++j) gg[j] = ((const f32x4*)args.in[I_NMEM])[lane + 64 * j];
          for (int m = 2 * gw; m < MM; m += 2 * NGW) rms_rows2_to_bf16(args.in[I_MEM] + (size_t)m * D, args.in[I_MEM] + (size_t)(m + 1) * D, gg, MEMN + (size_t)m * D, MEMN + (size_t)(m + 1) * D, lane); }
        {
            const int gt = vcu * (NWAVES * 64) + tid;
            if (gt < 2052 * 8) { const int pos = gt >> 3, i = gt & 7; const float iv = i == 0 ? 1.0f : i == 1 ? 0.1939227432012558f : i == 2 ? 0.03760603070259094f : i == 3 ? 0.007292664609849453f : i == 4 ? 0.0014142135623842478f : i == 5 ? 0.00027424818836152554f : i == 6 ? 5.3182957344688475e-05f : 1.0313385246263351e-05f;
                const float ang = (float)pos * iv; double s, c; sincos_d((double)ang, s, c); ROPE_[pos * 16 + i] = (float)c; ROPE_[pos * 16 + 8 + i] = (float)s; }
            const int st = gt - 2052 * 8;
            if (st >= 0 && st < 1024) {
                const int g = st >> 6; const double dt = exp_d((double)args.in[I_LDT][g]); const double lr = (double)args.in[I_LRE][st], li = (double)args.in[I_LIM][st];
                const double mag = exp_d(lr * dt); double s, c; sincos_d(li * dt, s, c); const double are = mag * c, aim = mag * s;
                const double den = lr * lr + li * li, nr = are - 1.0, ni = aim; const double cre = (nr * lr + ni * li) / den, cim = (ni * lr - nr * li) / den;
                const double mag64 = exp_d(64.0 * lr * dt); double s64, c64; sincos_d(64.0 * li * dt, s64, c64);
                float* o = SSMC_ + (size_t)st * 8; o[0] = (float)are; o[1] = (float)aim; o[2] = (float)cre; o[3] = (float)cim; o[4] = (float)(mag64 * c64); o[5] = (float)(mag64 * s64); o[6] = 0.f; o[7] = 0.f; }
        }
        GRID_BAR();
    }

    if (IN(1)) for (int rep_ = 0; rep_ < NREP(1); ++rep_) { WSBASE();
        int base = 0;
        { pg8::Gemm g{XN, WIN, MT, INW, D}; pg8::RotOrder S; S.init(MT, INW, G, bx, base); base += S.nwg;
          pg8::EpiZ E{Qb, Kb, VT, U_, ROPE_, args.in[I_QN], args.in[I_KN], out};
          pg8::gemm_phase<pg8::EpiZ, pg8::RotOrder, true, true>(lds, g, S, E); }
        { pg8::Gemm g{MEMN, WXKV, MM, 2048, D}; pg8::RotOrder S; S.init(MM, 2048, G, bx, base); base += S.nwg;
          pg8::EpiMem E{out + O_MEMKV, MSS, MVT}; pg8::gemm_phase<pg8::EpiMem, pg8::RotOrder, true, true>(lds, g, S, E); }
        {
            constexpr int I_UP = 16 * (FF2 / 32);
            const int first = base % G, nidle = G - first;
            if (bx >= first) {
                __syncthreads();
                LAS float* scr = (LAS float*)(lds + wave * 16384);
                p0_transpose_stream<2>(args.in[I_WUP], D, FF2, WUP, args.in[I_NFFN], scr, (bx - first) * NWAVES + wave, I_UP, nidle * NWAVES, lane);
            }
        }
        GRID_BAR();
    }

    if (IN(2)) for (int rep_ = 0; rep_ < NREP(2); ++rep_) { WSBASE();
        LAS float* uL = (LAS float*)(lds + wave * 4096);
        const int swapo = (bx >> 3) & 1;
#pragma unroll 1
        for (int pass = 0; pass < 2; ++pass) {
            if (pass == swapo) {
                for (int it = vcu; it < 3 * 256; it += G) pattn_wg_item(Qb, Kb, VT, AO, LSE, lds, it, wave, lane, tid);
            } else {
                if (wave < 6) { for (int it = vcu * 6 + wave; it < 3 * 512; it += G * 6) sattn_item(args, Qb, AO, LSE, it, lane); }
                else { if (rep_ == 0) for (int it = vcu * 2 + (wave - 6); it < MM; it += G * 2) memk_fix_item(out + O_MEMKV, MSS, args.in[I_XKN], args.in[I_XQN], MEMK, it, lane);
                       for (int it = vcu * 2 + (wave - 6); it < 8 * 31 * 16; it += G * 2) ssm_a_item(args, U_, SSMC_, SSMF, uL, it, lane); }
            }
            __syncthreads();
        }
        GRID_BAR();
    }

    if (IN(3)) for (int rep_ = 0; rep_ < NREP(3); ++rep_) { WSBASE();
#if defined(PROBE_LDS_FILL)
        for (int u_ = tid; u_ < 134656 / 4; u_ += NWAVES * 64) ((LAS unsigned*)lds)[u_] = PROBE_LDS_FILL;
        __syncthreads();
#endif
#if defined(PROBE_DELAY_P3)
        for (int i_ = 0; i_ < 10; ++i_) __builtin_amdgcn_s_sleep(127);
        __builtin_amdgcn_fence(__ATOMIC_ACQUIRE, "agent"); asm volatile("s_waitcnt vmcnt(0)" ::: "memory"); __syncthreads();
#endif
        for (int r1_ = 0; r1_ < ((DUP_PHASE) == 31 ? 2 : 1); ++r1_)
        if (G > 64) {
            if (vcu >= 32) { const int ncw = (G - 32) * NWAVES; for (int R = ((vcu - 32) * NWAVES + wave) * 8; R < MT; R += ncw * 8) combine_rows<8>(AO, LSE, args.in[I_AON], MIXED, R, lane); }
        } else { for (int R = gw * 4; R < MT; R += NGW * 4) combine_rows<4>(AO, LSE, args.in[I_AON], MIXED, R, lane); }
#if defined(PROBE_P3_TWICE)
        for (int it = vcu; it < 256; it += G) ssm_c_item(args, U_, SSMC_, SSMF, WGLU, (bf16*)(wsl + 644 * MiB), lds, it, wave, lane);
#endif
        for (int r2_ = 0; r2_ < ((DUP_PHASE) == 32 ? 2 : 1); ++r2_)
        for (int it = vcu; it < 256; it += G) ssm_c_item(args, U_, SSMC_, SSMF, WGLU, MIXED, lds, it, wave, lane);
        GRID_BAR();
    }

    if (IN(4)) for (int rep_ = 0; rep_ < NREP(4); ++rep_) { WSBASE();
        pg8::Gemm g{MIXED, WOUT, MP, D, D}; pg8::RotOrder S; S.init(MP, D, G, bx, 0);
        pg8::EpiRes<false, false> E{args.in[I_XP], nullptr, H1B, SS1}; pg8::gemm_phase<pg8::EpiRes<false, false>, pg8::RotOrder, true, true>(lds, g, S, E);
        for (int tile = bx; tile < 256; tile += G)
            sample_gemm_tile<0, false>(MIXED + (size_t)MP * D, WOUT, D, args.in[I_XS], nullptr, H1B + (size_t)MP * D, SS1S, lds, tile, wave, lane, tid);
        GRID_BAR();
    }
    if (IN(5)) for (int rep_ = 0; rep_ < NREP(5); ++rep_) { WSBASE();
        pg8::Gemm g{H1B, WXQ, MP, D, D}; pg8::RotOrder S; S.init(MP, D, G, bx, 0);
        pg8::EpiQx E{QX, QSS}; pg8::gemm_phase<pg8::EpiQx, pg8::RotOrder, true, true>(lds, g, S, E);
        for (int tile = bx; tile < 256; tile += G)
            sample_gemm_tile<1>(H1B + (size_t)MP * D, WXQ, D, nullptr, nullptr, QX + (size_t)MP * D, QSSS, lds, tile, wave, lane, tid);
        GRID_BAR();
    }
    if (IN(6)) for (int rep_ = 0; rep_ < NREP(6); ++rep_) { WSBASE();
        if (tid < 8) ((LAS unsigned*)(lds + MISC_OFF))[16 + tid] = 0u;
        __syncthreads();
        int swapo = (bx >> 3) & 1; asm volatile("" : "+s"(swapo));
#pragma unroll 1
        for (int pass = 0; pass < 2; ++pass) {
            if (pass == swapo) {
                int tid3 = threadIdx.x; asm volatile("" : "+v"(tid3)); const int lane3 = tid3 & 63, wave3 = __builtin_amdgcn_readfirstlane(tid3 >> 6);
                GAS unsigned char* wsl3 = (GAS unsigned char*)ws; asm volatile("" : "+s"(wsl3));
                int slot = 0;
                for (int pair = vcu; pair < BS * 4; pair += G, ++slot) sxattn_stream<8>(args, (bf16*)(wsl3 + WS_QX), (float*)(wsl3 + WS_CTL + CTL_RS1), (float*)(wsl3 + WS_CTL + CTL_QS), (bf16*)(wsl3 + WS_OX), lds, (LAS unsigned*)(lds + MISC_OFF) + 16 + (slot & 7), pair, slot & 1, wave3, lane3);
            } else {
                int tid2 = threadIdx.x; asm volatile("" : "+v"(tid2)); const int lane2 = tid2 & 63, wave2 = __builtin_amdgcn_readfirstlane(tid2 >> 6);
                GAS unsigned char* wsl2 = (GAS unsigned char*)ws; asm volatile("" : "+s"(wsl2));
                for (int it = vcu; it < 8 * 4 * 8; it += G) xattn_wg_item((bf16*)(wsl2 + WS_QX), (float*)(wsl2 + WS_CTL + CTL_RS1), (float*)(wsl2 + WS_CTL + CTL_QS), (bf16*)(wsl2 + WS_MEMK), (bf16*)(wsl2 + WS_MVT), (bf16*)(wsl2 + WS_OX), lds, it, wave2, lane2, tid2);
            }
            __syncthreads();
        }
        GRID_BAR();
    }
    if (IN(7)) for (int rep_ = 0; rep_ < NREP(7); ++rep_) { WSBASE();
        pg8::Gemm g{OX, WXO, MP, D, D}; pg8::RotOrder S; S.init(MP, D, G, bx, 0);
        pg8::EpiRes<true, false> E{H1B, nullptr, H2B, SS2}; pg8::gemm_phase<pg8::EpiRes<true, false>, pg8::RotOrder, true, true>(lds, g, S, E);
        for (int tile = bx; tile < 256; tile += G)
            sample_gemm_tile<0, true>(OX + (size_t)MP * D, WXO, D, H1B + (size_t)MP * D, nullptr, H2B + (size_t)MP * D, SS2S, lds, tile, wave, lane, tid);
        GRID_BAR();
    }
    if (IN(8)) for (int rep_ = 0; rep_ < NREP(8); ++rep_) { WSBASE();
        pg8::Gemm g{H2B, WUP, MT, FF2, D}; pg8::RotOrder S; S.init(MT, FF2, G, bx, 0);
        pg8::EpiUpConv E{ACT, (float*)(wsl + WS_EDGE), SS2, args.in[I_CONVW], args.in[I_CONVB], args.in[I_SCONV], out + O_CONVP, out + O_CONVS, lds}; pg8::gemm_phase<pg8::EpiUpConv, pg8::RotOrder, true, true>(lds, g, S, E);
        {
            constexpr int I_DN = (FF / 64) * (D / 32);
            const int first = S.nwg % G, nidle = G - first;
            if (bx >= first) {
                __syncthreads();
                p0_transpose_stream<0>(args.in[I_WDOWN], FF, D, WDOWN, nullptr, (LAS float*)(lds + wave * 16384), (bx - first) * NWAVES + wave, I_DN, nidle * NWAVES, lane);
            }
        }
        GRID_BAR();
    }
    if (IN(10)) for (int rep_ = 0; rep_ < NREP(10); ++rep_) { WSBASE();
        pg8::Gemm g{ACT, WDOWN, MP, D, FF}; pg8::RotOrder S; S.init(MP, D, G, bx, 0);
        { pg8::Unit uu; for (int i = 0; S.next(i, uu); ++i) if ((uu.pm & 7) != 0) conv_fix_tile(args, (const float*)(wsl + WS_EDGE), ACT, uu.pm, tid);
          VM_WAIT(); __syncthreads(); }
        pg8::EpiRes<true, true> E{H2B, out, nullptr, nullptr}; pg8::gemm_phase<pg8::EpiRes<true, true>, pg8::RotOrder, true, true>(lds, g, S, E);
        for (int tile = bx; tile < 256; tile += G)
            sample_gemm_tile<0, true>(ACT + (size_t)MP * FF, WDOWN, FF, H2B + (size_t)MP * D, out + (size_t)MP * D, nullptr, nullptr, lds, tile, wave, lane, tid);
    }
#if defined(DBG_SCALE_MASK)
    if (hi == N_PHASES) { GRID_BAR();
        const size_t offs[16] = {O_YP, O_YS, O_KV1P, O_KV4P, O_KV16P, O_SREP, O_SIMP, O_CONVP, O_MEMKV, O_KV1S, O_KV4S, O_KV16S, O_SRES, O_SIMS, O_CONVS, O_END};
        const size_t gt = (size_t)vcu * (NWAVES * 64) + tid, NT = (size_t)G * NWAVES * 64;
#pragma unroll
        for (int o = 0; o < 15; ++o) if ((DBG_SCALE_MASK >> o) & 1) { for (size_t i = offs[o] + gt; i < offs[o + 1]; i += NT) out[i] *= 3.0f; }
    }
#endif
#undef IN
#undef GRID_BAR
}


#if defined(PROBE_DET) || defined(PROBE_P3_TWICE)
__global__ void det_cmp_kernel(const unsigned* a, const unsigned* b, size_t nwords, unsigned* counter, int tol, int rw, int lo, int hi) {
    unsigned c = 0;
    for (size_t i = (size_t)blockIdx.x * blockDim.x + threadIdx.x; i < nwords; i += (size_t)gridDim.x * blockDim.x) {
        if (rw > 0) { const int cw = (int)(i % (size_t)rw); if (cw < lo || cw >= hi) continue; }
        const unsigned x = a[i], y = b[i];
        if (tol) { const float fx = __uint_as_float(x), fy = __uint_as_float(y); if (!(fabsf(fx - fy) <= 0.02f)) ++c; } else if (x != y) { ++c; atomicMin(counter + 32, (unsigned)i); atomicMax(counter + 48, (unsigned)i); } }
    if (c) atomicAdd(counter, c);
}
__global__ void det_mark_kernel(const unsigned* counters, int nreg, float* y, size_t n, int forced) {
    int r = -1; for (int i = nreg - 1; i >= 0; --i) if (counters[i] != 0u) r = i;
#if defined(PROBE_DET_COUNT)
    { const unsigned c = counters[PROBE_DET_COUNT], fw = counters[32 + PROBE_DET_COUNT], lw = counters[48 + PROBE_DET_COUNT]; const int fitem = (int)(fw / 512u) / 64, litem = (int)(lw / 512u) / 64;
      r = -1;
      if (c) { switch (PROBE_DET_MODE) { case 1: r = (int)(c >> 10); break; case 2: r = fitem >> 4; break; case 3: r = fitem & 15; break; case 4: r = litem - fitem; break; case 5: r = (int)((fw / 512u) & 63) >> 2; break; case 6: r = (int)(fw & 511u) >> 5; break; default: r = 0; } if (r > 21) r = 21; } }
#endif
    if (forced >= 0) r = forced;
#if defined(PROBE_CAL)
    r = (int)((wall_clock64() >> 12) & 1) ? 19 : -1;
#endif
    if (r < 0) return;
    const float f = 1.0f + 0.1f * (float)(r + 1);
    for (size_t i = (size_t)blockIdx.x * blockDim.x + threadIdx.x; i < n; i += (size_t)gridDim.x * blockDim.x) y[i] *= f;
}
#endif

extern "C" void kernel_launch(void* const* d_in, const int* in_sizes, int n_in, void* d_out, int out_size, void* d_ws, size_t ws_size, hipStream_t stream) {
    static int grid = 0;
    if (grid == 0) {
        if (n_in != 39 || (size_t)out_size != O_END || ws_size < WS_END) { fprintf(stderr, "kernel_launch: unexpected problem shape (n_in %d, out %d, ws %zu); nothing launched\n", n_in, out_size, ws_size); grid = -1; return; }
        int dev = 0, cus = 0, per_cu = 0;
        if (hipGetDevice(&dev) != hipSuccess || hipDeviceGetAttribute(&cus, hipDeviceAttributeMultiprocessorCount, dev) != hipSuccess) { grid = -1; return; }
        if (hipFuncSetAttribute((const void*)fwd_kernel, hipFuncAttributeMaxDynamicSharedMemorySize, LDS_BYTES) != hipSuccess) { fprintf(stderr, "kernel_launch: hipFuncSetAttribute failed\n"); grid = -1; return; }
        if (hipOccupancyMaxActiveBlocksPerMultiprocessor(&per_cu, (const void*)fwd_kernel, NWAVES * 64, LDS_BYTES) != hipSuccess || per_cu < 1) { fprintf(stderr, "kernel_launch: occupancy query says %d workgroups per CU\n", per_cu); (void)hipGetLastError(); grid = -1; return; }
        grid = cus;
    }
    if (grid < 0) return;
    (void)hipMemsetAsync((char*)d_ws + WS_CTL, 0, CTL_ZERO_BYTES, stream);
    Args a{};
    for (int i = 0; i < 39; ++i) a.in[i] = (const float*)d_in[i];
    a.out = (float*)d_out; a.ws = (unsigned char*)d_ws;
#if defined(PROBE_PRE_HI)
    a.ph_lo = 0; a.ph_hi = PROBE_PRE_HI; a.li = 1; a.pad = 0;
    hipLaunchKernelGGL(fwd_kernel, dim3(grid), dim3(NWAVES * 64), LDS_BYTES, stream, a);
    (void)hipMemsetAsync((char*)d_ws + WS_CTL, 0, CTL_ZERO_BYTES, stream);
#endif
#if defined(PROBE_DET)
    {
        const size_t SP = 644 * MiB, need = 1005 * MiB;
        char* w = (char*)d_ws; float* o = (float*)d_out;
        if (ws_size >= need) {
            a.ph_lo = 0; a.ph_hi = N_PHASES; a.li = 0; a.pad = 0;
            hipLaunchKernelGGL(fwd_kernel, dim3(grid), dim3(NWAVES * 64), LDS_BYTES, stream, a);
#if defined(PROBE_DUMP)
            (void)hipMemcpyAsync(w + SP + 190 * MiB, w + 191 * MiB, 33 * MiB, hipMemcpyDeviceToDevice, stream);
            (void)hipMemcpyAsync(w + 760 * MiB, w + 724 * MiB, 34 * MiB, hipMemcpyDeviceToDevice, stream);
#else
            (void)hipMemcpyAsync(w + SP, w + 1 * MiB, 223 * MiB, hipMemcpyDeviceToDevice, stream);
            (void)hipMemcpyAsync(w + SP + 223 * MiB, w + 295 * MiB, 4 * MiB, hipMemcpyDeviceToDevice, stream);
            (void)hipMemcpyAsync(w + SP + 227 * MiB, d_out, O_END * 4, hipMemcpyDeviceToDevice, stream);
#endif
#if defined(PROBE_DET_POISON)
            (void)hipMemsetAsync(w + PROBE_DET_POISON_LO * MiB, 0xAA, (size_t)(PROBE_DET_POISON_HI - PROBE_DET_POISON_LO) * MiB, stream);
#endif
            (void)hipMemsetAsync(w + WS_CTL, 0, CTL_ZERO_BYTES, stream);
        }
    }
#endif
    for (int li = 0; li < N_LAUNCHES; ++li) {
        a.li = 0; a.pad = 0;
        a.ph_lo = (N_LAUNCHES == 1) ? 0 : li; a.ph_hi = (N_LAUNCHES == 1) ? N_PHASES : li + 1;
        hipLaunchKernelGGL(fwd_kernel, dim3(grid), dim3(NWAVES * 64), LDS_BYTES, stream, a);
        const hipError_t le = hipPeekAtLastError();
        if (le != hipSuccess) { fprintf(stderr, "kernel_launch: launch %d failed: %s\n", li, hipGetErrorName(le)); break; }
    }
#if defined(PROBE_P3_TWICE)
    {   char* w = (char*)d_ws; float* o = (float*)d_out; unsigned* cnt = (unsigned*)(w + 643 * MiB + 900 * 1024);
        (void)hipMemsetAsync(cnt, 0, 256, stream); (void)hipMemsetAsync(cnt + 32, 0xFF, 64, stream);
        hipLaunchKernelGGL(det_cmp_kernel, dim3(2048), dim3(256), 0, stream, (const unsigned*)(w + WS_MIXED), (const unsigned*)(w + 644 * MiB), (size_t)MP * D * 2 / 4, cnt + PROBE_DET_COUNT, 0, 512, 384, 512);
        hipLaunchKernelGGL(det_mark_kernel, dim3(32), dim3(256), 0, stream, cnt, 1, o + O_SREP, (size_t)BP * 1024, -1);
    }
#endif
#if defined(PROBE_DET)
    {
        const size_t SP = 644 * MiB, need = 1005 * MiB;
        char* w = (char*)d_ws; float* o = (float*)d_out; unsigned* cnt = (unsigned*)(w + 640 * MiB);
        cnt = (unsigned*)(w + 643 * MiB + 900 * 1024);
        if (ws_size < need) { hipLaunchKernelGGL(det_mark_kernel, dim3(1024), dim3(256), 0, stream, cnt, 0, o, (size_t)MP * D, 19); }
        else {
            (void)hipMemsetAsync(cnt, 0, 256, stream); (void)hipMemsetAsync(cnt + 32, 0xFF, 64, stream);
            const char* c0 = w + SP - 1 * MiB;
            const float* oc = (const float*)(w + SP + 227 * MiB);
            struct Reg { const void* a; const void* b; size_t bytes; int tol; };
            struct Reg2 { const void* a; const void* b; size_t bytes; int rw, lo, hi; };
#if defined(PROBE_DUMP)
            const Reg2 regs[5] = {
                {w + 724 * MiB, w + 760 * MiB, (size_t)8 * MiB, 0, 0, 0}, {w + 741 * MiB, w + 777 * MiB, (size_t)2 * MiB, 0, 0, 0},
                {w + WS_MIXED, c0 + WS_MIXED, (size_t)MP * D * 2, 512, 384, 512}, {w + WS_MIXED, c0 + WS_MIXED, (size_t)MP * D * 2, 512, 384, 512}, {w + WS_MIXED, c0 + WS_MIXED, (size_t)MP * D * 2, 512, 384, 512} };
#else
            const Reg2 regs[14] = {
                {w + WS_U, c0 + WS_U, (size_t)MT * 256 * 4, 0, 0, 0}, {w + WS_Q, c0 + WS_Q, (size_t)MT * 768 * 2, 0, 0, 0}, {w + WS_K, c0 + WS_K, (size_t)MT * 768 * 2, 0, 0, 0}, {w + WS_VT, c0 + WS_VT, (size_t)MP * 768 * 2, 0, 0, 0},
                {o + O_KV1P, oc + O_KV1P, (O_SREP - O_KV1P) * 4, 0, 0, 0}, {o + O_MEMKV, oc + O_MEMKV, (O_KV1S - O_MEMKV) * 4, 0, 0, 0}, {o + O_KV1S, oc + O_KV1S, (O_SRES - O_KV1S) * 4, 0, 0, 0},
                {w + WS_SSMF, c0 + WS_SSMF, 2 * MiB, 0, 0, 0}, {w + WS_AO, c0 + WS_AO, (size_t)MT * 768 * 2, 0, 0, 0}, {w + WS_LSE, c0 + WS_LSE, (size_t)MT * 12 * 4, 0, 0, 0}, {w + WS_MEMK, w + SP + 223 * MiB, 4 * MiB, 0, 0, 0},
                {o + O_SREP, oc + O_SREP, (O_CONVP - O_SREP) * 4, 0, 0, 0}, {o + O_SRES, oc + O_SRES, (O_CONVS - O_SRES) * 4, 0, 0, 0}, {w + WS_MIXED, c0 + WS_MIXED, (size_t)MT * D * 2, 0, 0, 0} };
#endif
            for (int r = 0; r < (int)(sizeof(regs) / sizeof(regs[0])); ++r) hipLaunchKernelGGL(det_cmp_kernel, dim3(2048), dim3(256), 0, stream, (const unsigned*)regs[r].a, (const unsigned*)regs[r].b, regs[r].bytes / 4, cnt + r, 0, regs[r].rw, regs[r].lo, regs[r].hi);
            hipLaunchKernelGGL(det_mark_kernel, dim3(32), dim3(256), 0, stream, cnt, 14, o + O_SREP, (size_t)BP * 1024, -1);
        }
    }
#endif
}
```

```cpp
#include <hip/hip_runtime.h>
#include <cstdio>
#include <cstdint>

#define GAS __attribute__((address_space(1)))
#define LAS __attribute__((address_space(3)))
#define PG8_LAS __attribute__((address_space(3)))
typedef unsigned short bf16;
typedef short bf16x8 __attribute__((ext_vector_type(8)));
typedef float f32x4 __attribute__((ext_vector_type(4)));
typedef float f32x2 __attribute__((ext_vector_type(2)));
typedef float f32x16 __attribute__((ext_vector_type(16)));
typedef unsigned u32x4 __attribute__((ext_vector_type(4)));
typedef unsigned u32x2 __attribute__((ext_vector_type(2)));
typedef GAS unsigned gu32;
#define RLX_AGENT __ATOMIC_RELAXED, __HIP_MEMORY_SCOPE_AGENT
#define LDS_WAIT() asm volatile("s_waitcnt lgkmcnt(0)" ::: "memory")
#define VM_WAIT() asm volatile("s_waitcnt vmcnt(0)" ::: "memory")

constexpr int D = 1024, BP = 8, LP = 2048, MP = BP * LP, BS = 128, TS = 4, MS = BS * TS, MT = MP + MS;
constexpr int INW = 2560, AW = 768, SW = 256, NMEM = 256, MM = BP * NMEM, FF = 2816, FF2 = 5632;
constexpr float EPS = 1e-6f;
constexpr float LOG2E = 1.4426950408889634f, LN2 = 0.6931471805599453f;
constexpr int NWAVES = 8;

constexpr size_t MiB = 1u << 20;
constexpr size_t WS_CTL = 0, CTL_ZERO_BYTES = 1 * MiB;
constexpr size_t WS_ROPE = 1 * MiB;
constexpr size_t WS_SSMC = 1 * MiB + 512 * 1024;
constexpr size_t WS_WIN = 2 * MiB, WS_WOUT = 7 * MiB, WS_WXQ = 9 * MiB, WS_WXKV = 11 * MiB, WS_WXO = 15 * MiB, WS_WUP = 17 * MiB, WS_WDOWN = 28 * MiB, WS_WGLU = 34 * MiB;
constexpr size_t WS_XN = 35 * MiB, WS_MEMN = 68 * MiB, WS_Q = 72 * MiB, WS_K = 97 * MiB, WS_VT = 122 * MiB, WS_U = 146 * MiB, WS_AO = 163 * MiB, WS_LSE = 188 * MiB;
constexpr size_t WS_SSMF = 189 * MiB, WS_MIXED = 191 * MiB, WS_H1B = 224 * MiB, WS_SS1 = 257 * MiB, WS_QX = 259 * MiB, WS_QSS = 292 * MiB, WS_MSS = 294 * MiB, WS_MEMK = 295 * MiB, WS_MVT = 299 * MiB;
constexpr size_t WS_OX = 303 * MiB, WS_H2B = 336 * MiB, WS_SS2 = 369 * MiB, WS_UP = 371 * MiB, WS_ACT = 553 * MiB, WS_END = 644 * MiB;
constexpr size_t WS_EDGE = 371 * MiB;
constexpr size_t WS_SS1S = 258 * MiB + 512 * 1024, WS_QSSS = 293 * MiB + 512 * 1024, WS_SS2S = 370 * MiB + 512 * 1024;
constexpr size_t CTL_RS1 = 128 * 1024, CTL_RS2 = 256 * 1024, CTL_QS = 384 * 1024;
constexpr int CW_BAR = 4096;

constexpr int RING_BYTES = 131072;
constexpr int MISC_OFF = 135168;
constexpr int LDS_BYTES = 147456;

__device__ __forceinline__ unsigned f2bf(float f) { unsigned u = __builtin_bit_cast(unsigned, f); return (u + 0x7fffu + ((u >> 16) & 1u)) >> 16; }
__device__ __forceinline__ unsigned pk2(float lo, float hi) { return f2bf(lo) | (f2bf(hi) << 16); }
__device__ __forceinline__ float bf2f(unsigned h) { return __builtin_bit_cast(float, h << 16); }
typedef __bf16 bf16v2_t __attribute__((ext_vector_type(2)));
__device__ __forceinline__ unsigned cvt_pk_bf16(float lo, float hi) { const f32x2 v = {lo, hi}; return __builtin_bit_cast(unsigned, __builtin_convertvector(v, bf16v2_t)); }
__device__ __forceinline__ bf16x8 pack8(float a0, float a1, float a2, float a3, float a4, float a5, float a6, float a7) {
    u32x4 w; w.x = cvt_pk_bf16(a0, a1); w.y = cvt_pk_bf16(a2, a3); w.z = cvt_pk_bf16(a4, a5); w.w = cvt_pk_bf16(a6, a7); return __builtin_bit_cast(bf16x8, w); }
__device__ __forceinline__ float wave_sum(float v) {
#pragma unroll
    for (int o = 1; o < 64; o <<= 1) v += __shfl_xor(v, o);
    return v;
}
__device__ __forceinline__ float fexp2(float x) { return __builtin_amdgcn_exp2f(x); }
__device__ __forceinline__ float flog2(float x) { return __builtin_amdgcn_logf(x); }
__device__ __forceinline__ float frcp(float x) { return __builtin_amdgcn_rcpf(x); }
__device__ __forceinline__ float frsq(float x) { return __builtin_amdgcn_rsqf(x); }
__device__ __forceinline__ void sincos_d(double x, double& s, double& c) {
    const double k = __builtin_rint(x * 0.63661977236758134308);
    double r = __builtin_fma(-k, 1.57079632679489655800e+00, x); r = __builtin_fma(-k, 6.12323399573676603587e-17, r);
    const long long q = (long long)k; const double r2 = r * r;
    double sp = 1.0 / 6227020800.0; sp = sp * r2 - 1.0 / 39916800.0; sp = sp * r2 + 1.0 / 362880.0; sp = sp * r2 - 1.0 / 5040.0; sp = sp * r2 + 1.0 / 120.0; sp = sp * r2 - 1.0 / 6.0; sp = sp * r2 + 1.0; sp = sp * r;
    double cp = -1.0 / 87178291200.0; cp = cp * r2 + 1.0 / 479001600.0; cp = cp * r2 - 1.0 / 3628800.0; cp = cp * r2 + 1.0 / 40320.0; cp = cp * r2 - 1.0 / 720.0; cp = cp * r2 + 1.0 / 24.0; cp = cp * r2 - 0.5; cp = cp * r2 + 1.0;
    const int qq = (int)(q & 3);
    s = (qq == 0) ? sp : (qq == 1) ? cp : (qq == 2) ? -sp : -cp;
    c = (qq == 0) ? cp : (qq == 1) ? -sp : (qq == 2) ? -cp : sp;
}
__device__ __forceinline__ double exp_d(double x) {
    const double k = __builtin_rint(x * 1.44269504088896340736);
    double r = __builtin_fma(-k, 6.93147180369123816490e-01, x); r = __builtin_fma(-k, 1.90821492927058770002e-10, r);
    double p = 1.0 / 6227020800.0;
    p = p * r + 1.0 / 479001600.0; p = p * r + 1.0 / 39916800.0; p = p * r + 1.0 / 3628800.0; p = p * r + 1.0 / 362880.0; p = p * r + 1.0 / 40320.0; p = p * r + 1.0 / 5040.0;
    p = p * r + 1.0 / 720.0; p = p * r + 1.0 / 120.0; p = p * r + 1.0 / 24.0; p = p * r + 1.0 / 6.0; p = p * r + 0.5; p = p * r + 1.0; p = p * r + 1.0;
    const int ki = (int)k;
    return __builtin_ldexp(p, ki);
}
__device__ __forceinline__ float dot4(f32x4 a) { return (a[0] * a[0] + a[1] * a[1]) + (a[2] * a[2] + a[3] * a[3]); }
__device__ __forceinline__ u32x4 pk8(f32x4 a, f32x4 b) { u32x4 w; w.x = cvt_pk_bf16(a[0], a[1]); w.y = cvt_pk_bf16(a[2], a[3]); w.z = cvt_pk_bf16(b[0], b[1]); w.w = cvt_pk_bf16(b[2], b[3]); return w; }
__device__ __forceinline__ f32x4 shx16(f32x4 a) { f32x4 r; r[0] = __shfl_xor(a[0], 16); r[1] = __shfl_xor(a[1], 16); r[2] = __shfl_xor(a[2], 16); r[3] = __shfl_xor(a[3], 16); return r; }
constexpr size_t O_KV1P_ = (size_t)MT * D, O_KV4P_ = O_KV1P_ + (size_t)BP * 128 * 512, O_KV16P_ = O_KV4P_ + (size_t)BP * 512 * 512;
constexpr size_t O_KV1S_ = O_KV16P_ + (size_t)BP * 2048 * 512 + 2 * BP * 1024 + (size_t)BP * 2 * FF2 + (size_t)MM * 2048, O_KV4S_ = O_KV1S_ + (size_t)MS * 512, O_KV16S_ = O_KV4S_ + (size_t)MS * 512;
typedef short s16x4 __attribute__((ext_vector_type(4)));
__device__ __forceinline__ s16x4 lds_tr4(LAS unsigned char* p) { return __builtin_bit_cast(s16x4, __builtin_amdgcn_ds_read_tr16_b64_v4i16((LAS s16x4*)p)); }
__device__ __forceinline__ bf16x8 cat44(s16x4 a, s16x4 b) { return (bf16x8){a[0], a[1], a[2], a[3], b[0], b[1], b[2], b[3]}; }
__device__ __forceinline__ void atomic_addf(float* p, float v) { (void)__hip_atomic_fetch_add(p, v, __ATOMIC_RELAXED, __HIP_MEMORY_SCOPE_AGENT); }

namespace pg8 {
#define PG8_LAS __attribute__((address_space(3)))
typedef unsigned short bf16_t;
typedef short bf16x8 __attribute__((ext_vector_type(8)));
typedef float f32x4 __attribute__((ext_vector_type(4)));
typedef unsigned u32x4 __attribute__((ext_vector_type(4)));
constexpr int BM = 256, BK = 64, HALF = 128, HTB = HALF * BK * 2  , STAGE_BYTES = 8 * HTB, NXCD = 8, WGM = 8;

__host__ __device__ __forceinline__ int lds_byte(int r, int c) { const int st = (r >> 4) * 2 + (c >> 5), rr = r & 15, cc = c & 31, ob = rr * 64 + cc * 2; return st * 1024 + (ob ^ (((ob >> 9) & 1) << 5)); }
__host__ __device__ __forceinline__ void stage_rc(int b, int& R, int& C) { const int st = b / 1024, sb = b % 1024, swz = sb ^ (((sb >> 9) & 1) << 5); R = (st >> 1) * 16 + swz / 64; C = (st & 1) * 32 + (swz % 64) / 2; }
__host__ __device__ __forceinline__ int perm32(int rho) { const int n = rho >> 4, i = rho & 15; return 8 * (i >> 2) + 4 * n + (i & 3); }

struct Unit { int pm, pn; };
struct Gemm { const bf16_t* A; const bf16_t* Bt; int M, N, K; };

struct StaticOrder {
    int nM, nN, nwg, G, c;
    __host__ __device__ void init(int M, int N, int G_, int c_) { nM = M / BM; nN = N / BM; nwg = nM * nN; G = G_; c = c_; }
    __host__ __device__ bool next(int i, Unit& u) const {
        const long L = (long)i * G + c; if (L >= nwg) return false;
        int wgid = (int)L; { const int q = nwg / NXCD, r = nwg % NXCD, xcd = wgid % NXCD, off = wgid / NXCD; wgid = (xcd < r ? xcd * (q + 1) : r * (q + 1) + (xcd - r) * q) + off; }
        const int nig = WGM * nN, gid = wgid / nig, fm = gid * WGM, gsz = (nM - fm) < WGM ? (nM - fm) : WGM;
        u.pm = fm + ((wgid % nig) % gsz); u.pn = (wgid % nig) / gsz; return true;
    }
    __device__ __forceinline__ void a_ready(const Unit&) const {}
    __device__ __forceinline__ void done(const Unit&) const {}
};


struct RotOrder {
    int nM, nN, nwg, G, c;
    __host__ __device__ void init(int M, int N, int G_, int blk, int base) { nM = M / BM; nN = N / BM; nwg = nM * nN; G = G_; const int rot = base % G_; c = blk - rot; if (c < 0) c += G_; }
    __host__ __device__ __forceinline__ bool next(int i, Unit& u) const {
        const long L = (long)i * G + c; if (L >= nwg) return false;
        int wgid = (int)L; { const int q = nwg / NXCD, r = nwg % NXCD, xcd = wgid % NXCD, off = wgid / NXCD; wgid = (xcd < r ? xcd * (q + 1) : r * (q + 1) + (xcd - r) * q) + off; }
        const int nig = WGM * nN, gid = wgid / nig, fm = gid * WGM, gsz = (nM - fm) < WGM ? (nM - fm) : WGM;
        u.pm = fm + ((wgid % nig) % gsz); u.pn = (wgid % nig) / gsz; return true;
    }
    __device__ __forceinline__ void a_ready(const Unit&) const {}
    __device__ __forceinline__ void done(const Unit&) const {}
};


struct EpiZ {
    static constexpr bool PERM = true, AFTER_DRAIN = false, BMAP = false, AMAP = false;
    bf16_t* Q; bf16_t* Kb; bf16_t* VN; float* U; const float* rope; const float* qg; const float* kg;
    float* outp;
    __device__ __forceinline__ int bmap(int r) const { return r; }
    __device__ __forceinline__ void operator()(const f32x4 (&acc)[2][2][4][2], const Unit& u, int wr, int wc, int fr, int fq) const {
        const int pn = u.pn; const bool sample = u.pm >= 64;
        const int rbase = u.pm * BM + wr * 64 + fr;
        if (pn == 9) {
#pragma unroll
            for (int ai = 0; ai < 2; ++ai)
#pragma unroll
                for (int m = 0; m < 4; ++m) { const int R = rbase + ai * HALF + m * 16; float* p = U + (size_t)R * 256 + wc * 64 + 8 * fq;
#pragma unroll
                    for (int bj = 0; bj < 2; ++bj) { *(f32x4*)(p + 32 * bj) = acc[ai][bj][m][0]; *(f32x4*)(p + 32 * bj + 4) = acc[ai][bj][m][1]; } }
            return;
        }
        const int kind = pn / 3, g = pn - 3 * kind;
        const int keep = g == 0 ? 128 : (g == 1 ? 512 : 2048);
        float* kvp = outp + (g == 0 ? O_KV1P_ : (g == 1 ? O_KV4P_ : O_KV16P_)); float* kvs = outp + (g == 0 ? O_KV1S_ : (g == 1 ? O_KV4S_ : O_KV16S_));
        if (kind == 2) {
#pragma unroll
            for (int ai = 0; ai < 2; ++ai)
#pragma unroll
                for (int m = 0; m < 4; ++m) { const int R = rbase + ai * HALF + m * 16; float* dst = nullptr;
                    if (sample) dst = kvs + ((size_t)(R - MP) * 2 + 1) * 256;
                    else { const int b = R >> 11, t = R & 2047; if (t >= 2048 - keep) dst = kvp + ((size_t)(b * keep + t - (2048 - keep)) * 2 + 1) * 256; }
                    if (dst) { dst += wc * 64 + 8 * fq;
#pragma unroll
                        for (int bj = 0; bj < 2; ++bj) { *(f32x4*)(dst + 32 * bj) = acc[ai][bj][m][0]; *(f32x4*)(dst + 32 * bj + 4) = acc[ai][bj][m][1]; } }
                    if (!sample) { bf16_t* vp = VN + (size_t)R * AW + g * 256 + wc * 64 + 8 * fq;
                        *(u32x4*)vp = pk8(acc[ai][0][m][0], acc[ai][0][m][1]); *(u32x4*)(vp + 32) = pk8(acc[ai][1][m][0], acc[ai][1][m][1]); } }
            return;
        }
        const float* gp = (kind == 0 ? qg : kg) + 8 * fq;
        const f32x4 g00 = *(const f32x4*)(gp), g01 = *(const f32x4*)(gp + 4), g10 = *(const f32x4*)(gp + 32), g11 = *(const f32x4*)(gp + 36);
        const float sgn = fq == 0 ? -1.f : 1.f;
        const float qs = kind == 0 ? 0.125f * LOG2E : 1.f;
        bf16_t* ob = kind == 0 ? Q : Kb;
        f32x4 rc0, rc1, rs0, rs1;
        { const int R = rbase; const int pos = sample ? 2048 + (R & 3) : (R & 2047); const float* rp = rope + (size_t)pos * 16; rc0 = *(const f32x4*)rp; rc1 = *(const f32x4*)(rp + 4); rs0 = *(const f32x4*)(rp + 8); rs1 = *(const f32x4*)(rp + 12); }
#pragma unroll
        for (int ai = 0; ai < 2; ++ai)
#pragma unroll
            for (int m = 0; m < 4; ++m) { const int R = rbase + ai * HALF + m * 16;
                const f32x4 c0 = rc0, c1 = rc1, s0 = rs0, s1 = rs1;
                if (ai * 4 + m < 7) { const int Rn = rbase + ((ai * 4 + m + 1) >> 2) * HALF + ((ai * 4 + m + 1) & 3) * 16; const int pos = sample ? 2048 + (Rn & 3) : (Rn & 2047); const float* rp = rope + (size_t)pos * 16;
                    rc0 = *(const f32x4*)rp; rc1 = *(const f32x4*)(rp + 4); rs0 = *(const f32x4*)(rp + 8); rs1 = *(const f32x4*)(rp + 12); }
                float ss = (dot4(acc[ai][0][m][0]) + dot4(acc[ai][0][m][1])) + (dot4(acc[ai][1][m][0]) + dot4(acc[ai][1][m][1])); ss += __shfl_xor(ss, 16); ss += __shfl_xor(ss, 32);
                const float rs = frsq(ss * (1.0f / 64.0f) + EPS);
                float* dst = nullptr;
                if (kind == 1) { if (sample) dst = kvs + ((size_t)(R - MP) * 2) * 256; else { const int b = R >> 11, t = R & 2047; if (t >= 2048 - keep) dst = kvp + ((size_t)(b * keep + t - (2048 - keep)) * 2) * 256; }
                    if (dst) dst += wc * 64 + 8 * fq; }
                bf16_t* op = ob + (size_t)R * AW + g * 256 + wc * 64 + 8 * fq;
                f32x4 xa = acc[ai][0][m][0] * rs * g00, xb = acc[ai][0][m][1] * rs * g01;
                { const f32x4 oa = shx16(xa), ob2 = shx16(xb);
                  if (fq < 2) { xa = xa * c0 + (oa * s0) * sgn; xb = xb * c1 + (ob2 * s1) * sgn; } }
                if (dst) { *(f32x4*)(dst) = xa; *(f32x4*)(dst + 4) = xb; }
                *(u32x4*)(op) = pk8(xa * qs, xb * qs);
                xa = acc[ai][1][m][0] * rs * g10; xb = acc[ai][1][m][1] * rs * g11;
                if (dst) { *(f32x4*)(dst + 32) = xa; *(f32x4*)(dst + 36) = xb; }
                *(u32x4*)(op + 32) = pk8(xa * qs, xb * qs);
            }
    }
};

struct EpiVt {
    static constexpr bool PERM = true, AFTER_DRAIN = false, BMAP = true, AMAP = false;
    bf16_t* VT; int g;
    __device__ __forceinline__ int bmap(int r) const { return g == 0 ? r : (g == 1 ? ((r & 63) * 4 + (r >> 6)) : ((r & 15) * 16 + (r >> 4))); }
    __device__ __forceinline__ void operator()(const f32x4 (&acc)[2][2][4][2], const Unit& u, int wr, int wc, int fr, int fq) const {
        const int b = u.pn >> 3, t0 = (u.pn & 7) * 256, sh = 2 * g, S = 2048 >> sh, Wl = 8 - sh;
#pragma unroll
        for (int ai = 0; ai < 2; ++ai)
#pragma unroll
            for (int m = 0; m < 4; ++m) { const int hh = 2 * wr + (m >> 1), d = 32 * ai + 16 * (m & 1) + fr;
#pragma unroll
                for (int bj = 0; bj < 2; ++bj) { const int c8 = 128 * bj + 32 * wc + 8 * fq, res = c8 >> Wl, ds = c8 & ((1 << Wl) - 1), pos = res * S + (t0 >> sh) + ds;
                    bf16_t* p = VT + ((((size_t)((g * 4 + hh) * 8 + b) * 64 + (pos >> 5)) * 64 + d) * 32 + (pos & 31));
                    *(u32x4*)p = pk8(acc[ai][bj][m][0], acc[ai][bj][m][1]); } }
    }
};

struct EpiMem {
    static constexpr bool PERM = true, AFTER_DRAIN = false, BMAP = false, AMAP = false;
    float* out; float* mss; bf16_t* MVN;
    __device__ __forceinline__ int bmap(int r) const { return r; }
    __device__ __forceinline__ void operator()(const f32x4 (&acc)[2][2][4][2], const Unit& u, int wr, int wc, int fr, int fq) const {
        const int kv = u.pn >> 2, h = u.pn & 3;
#pragma unroll
        for (int ai = 0; ai < 2; ++ai)
#pragma unroll
            for (int m = 0; m < 4; ++m) { const int R = u.pm * BM + ai * HALF + wr * 64 + m * 16 + fr; float* dst = out + ((size_t)R * 2 + kv) * 1024 + h * 256 + 32 * wc + 8 * fq; float ss = 0.f;
#pragma unroll
                for (int bj = 0; bj < 2; ++bj) { const f32x4 a = acc[ai][bj][m][0], c = acc[ai][bj][m][1]; *(f32x4*)(dst + 128 * bj) = a; *(f32x4*)(dst + 128 * bj + 4) = c; ss += dot4(a) + dot4(c);
                    if (kv) *(u32x4*)(MVN + (size_t)R * 1024 + h * 256 + 32 * wc + 8 * fq + 128 * bj) = pk8(a, c); }
                if (kv == 0) { ss += __shfl_xor(ss, 16); ss += __shfl_xor(ss, 32); if (fq == 0) mss[(size_t)R * 16 + h * 4 + wc] = ss; } }
    }
};
struct EpiMemVt {
    static constexpr bool PERM = true, AFTER_DRAIN = false, BMAP = false, AMAP = false;
    bf16_t* MVT;
    __device__ __forceinline__ int bmap(int r) const { return r; }
    __device__ __forceinline__ void operator()(const f32x4 (&acc)[2][2][4][2], const Unit& u, int wr, int wc, int fr, int fq) const {
        const int h = u.pm, b = u.pn;
#pragma unroll
        for (int ai = 0; ai < 2; ++ai)
#pragma unroll
            for (int m = 0; m < 4; ++m) { const int d = ai * HALF + wr * 64 + m * 16 + fr;
#pragma unroll
                for (int bj = 0; bj < 2; ++bj) { const int c8 = 128 * bj + 32 * wc + 8 * fq;
                    bf16_t* p = MVT + ((((size_t)(h * 8 + b) * 8 + (c8 >> 5)) * 256 + d) * 32 + (c8 & 31));
                    *(u32x4*)p = pk8(acc[ai][bj][m][0], acc[ai][bj][m][1]); } }
    }
};
template <bool BASE_BF16, bool OUT_F32> struct EpiRes {
    static constexpr bool PERM = true, AFTER_DRAIN = false, BMAP = false, AMAP = false;
    const void* base; float* out; bf16_t* hb; float* ssq;
    __device__ __forceinline__ int bmap(int r) const { return r; }
    __device__ __forceinline__ void operator()(const f32x4 (&acc)[2][2][4][2], const Unit& u, int wr, int wc, int fr, int fq) const {
        const int c0 = u.pn * BM + 32 * wc + 8 * fq;
#pragma unroll
        for (int ai = 0; ai < 2; ++ai) {
            f32x4 b0[4][2], b1[4][2];
#pragma unroll
            for (int m = 0; m < 4; ++m)
#pragma unroll
                for (int bj = 0; bj < 2; ++bj) { const size_t off = (size_t)(u.pm * BM + ai * HALF + wr * 64 + m * 16 + fr) * D + c0 + 128 * bj;
                    if (BASE_BF16) { const u32x4 w = *(const u32x4*)((const bf16_t*)base + off); b0[m][bj] = (f32x4){bf2f(w.x & 0xffffu), bf2f(w.x >> 16), bf2f(w.y & 0xffffu), bf2f(w.y >> 16)}; b1[m][bj] = (f32x4){bf2f(w.z & 0xffffu), bf2f(w.z >> 16), bf2f(w.w & 0xffffu), bf2f(w.w >> 16)}; }
                    else { b0[m][bj] = *(const f32x4*)((const float*)base + off); b1[m][bj] = *(const f32x4*)((const float*)base + off + 4); } }
            asm volatile("" ::: "memory");
#pragma unroll
            for (int m = 0; m < 4; ++m) { const int R = u.pm * BM + ai * HALF + wr * 64 + m * 16 + fr; float ss = 0.f;
#pragma unroll
                for (int bj = 0; bj < 2; ++bj) { const size_t off = (size_t)R * D + c0 + 128 * bj;
                    const f32x4 o0 = b0[m][bj] + acc[ai][bj][m][0], o1 = b1[m][bj] + acc[ai][bj][m][1];
                    if (OUT_F32) { *(f32x4*)(out + off) = o0; *(f32x4*)(out + off + 4) = o1; }
                    if (hb) *(u32x4*)(hb + off) = pk8(o0, o1);
                    ss += dot4(o0) + dot4(o1); }
                if (ssq) { ss += __shfl_xor(ss, 16); ss += __shfl_xor(ss, 32); if (fq == 0) atomic_addf(ssq + R, ss); } }
        }
    }
};
struct EpiQx {
    static constexpr bool PERM = true, AFTER_DRAIN = false, BMAP = false, AMAP = false;
    bf16_t* QX; float* qss;
    __device__ __forceinline__ int bmap(int r) const { return r; }
    __device__ __forceinline__ void operator()(const f32x4 (&acc)[2][2][4][2], const Unit& u, int wr, int wc, int fr, int fq) const {
        const int c0 = u.pn * BM + 32 * wc + 8 * fq;
#pragma unroll
        for (int ai = 0; ai < 2; ++ai)
#pragma unroll
            for (int m = 0; m < 4; ++m) { const int R = u.pm * BM + ai * HALF + wr * 64 + m * 16 + fr; float ss = 0.f;
#pragma unroll
                for (int bj = 0; bj < 2; ++bj) { const f32x4 a = acc[ai][bj][m][0], c = acc[ai][bj][m][1]; *(u32x4*)(QX + (size_t)R * D + c0 + 128 * bj) = pk8(a, c); ss += dot4(a) + dot4(c); }
                ss += __shfl_xor(ss, 16); ss += __shfl_xor(ss, 32); if (fq == 0) atomic_addf(qss + (size_t)R * 4 + u.pn, ss); }
    }
};
template <int CTRL> __device__ __forceinline__ float dppf(float old, float src) { return __builtin_bit_cast(float, __builtin_amdgcn_update_dpp(__builtin_bit_cast(int, old), __builtin_bit_cast(int, src), CTRL, 0xf, 0xf, false)); }
__device__ __forceinline__ f32x4 prev_rows1(f32x4 pg, f32x4 cur) { f32x4 r;
#pragma unroll
    for (int e = 0; e < 4; ++e) r[e] = dppf<0x111>(dppf<0x121>(0.f, pg[e]), cur[e]);
    return r; }
__device__ __forceinline__ f32x4 prev_rows2(f32x4 pg, f32x4 cur) { f32x4 r;
#pragma unroll
    for (int e = 0; e < 4; ++e) r[e] = dppf<0x112>(dppf<0x122>(0.f, pg[e]), cur[e]);
    return r; }
__device__ __forceinline__ float silu_(float x) { return x * frcp(1.0f + fexp2(-x * LOG2E)); }
constexpr int HALO_OFF = 135680;
struct EpiUpConv {
    static constexpr bool PERM = true, AFTER_DRAIN = false, BMAP = false, AMAP = true;
    bf16_t* ACT; float* EDGE; const float* rs2; const float* cw; const float* cb; const float* sconv; float* convp; float* convs; PG8_LAS unsigned char* lds;
    __device__ __forceinline__ int bmap(int r) const { return r; }
    __device__ __forceinline__ int amap(int r) const { return (r & 64) + 4 * (r & 15) + ((r >> 4) & 3); }
    __device__ __forceinline__ void operator()(f32x4 (&acc)[2][2][4][2], const Unit& u, int wr, int wc, int fr, int fq) const {
        const bool smp = u.pm >= 64;
        const int j8 = u.pn * 128 + 32 * wc + 8 * fq;
        f32x4 cwv[8];
#define UPC_LOADW(n_) do { const int j4_ = j8 + 4 * (n_); cwv[0] = *(const f32x4*)(cw + j4_); cwv[1] = *(const f32x4*)(cw + FF2 + j4_); cwv[2] = *(const f32x4*)(cw + 2 * FF2 + j4_); cwv[3] = *(const f32x4*)(cb + j4_); \
        cwv[4] = *(const f32x4*)(cw + FF + j4_); cwv[5] = *(const f32x4*)(cw + FF2 + FF + j4_); cwv[6] = *(const f32x4*)(cw + 2 * FF2 + FF + j4_); cwv[7] = *(const f32x4*)(cb + FF + j4_); } while (0)
        UPC_LOADW(0);
        const int tok0 = u.pm * BM + wr * 64 + 4 * fr;
        { float tot[2][4];
#pragma unroll
          for (int ai = 0; ai < 2; ++ai)
#pragma unroll
              for (int m = 0; m < 4; ++m) tot[ai][m] = rs2[tok0 + ai * HALF + m];
#pragma unroll
          for (int ai = 0; ai < 2; ++ai)
#pragma unroll
              for (int m = 0; m < 4; ++m) { const float rstd = frsq(tot[ai][m] * (1.0f / 1024.0f) + EPS);
#pragma unroll
                  for (int bj = 0; bj < 2; ++bj) { acc[ai][bj][m][0] = acc[ai][bj][m][0] * rstd; acc[ai][bj][m][1] = acc[ai][bj][m][1] * rstd; } } }
        PG8_LAS float* halo = (PG8_LAS float*)(lds + HALO_OFF);
        if (!smp && fr == 15) {
#pragma unroll
            for (int ai = 0; ai < 2; ++ai)
#pragma unroll
                for (int mm = 2; mm < 4; ++mm) { PG8_LAS float* hp = halo + ((((2 * ai + wr + 1) * 2 + (mm - 2)) * 4 + wc) * 4 + fq) * 16;
                    *(PG8_LAS f32x4*)(hp) = acc[ai][0][mm][0]; *(PG8_LAS f32x4*)(hp + 4) = acc[ai][0][mm][1]; *(PG8_LAS f32x4*)(hp + 8) = acc[ai][1][mm][0]; *(PG8_LAS f32x4*)(hp + 12) = acc[ai][1][mm][1]; }
        }
        asm volatile("s_waitcnt lgkmcnt(0)\n\ts_barrier" ::: "memory");
#pragma unroll
        for (int n = 0; n < 2; ++n) {
            const int j4 = j8 + 4 * n;
            if (n == 1) UPC_LOADW(1);
            const f32x4 wg0 = cwv[0], wg1 = cwv[1], wg2 = cwv[2], bgv = cwv[3], wv0 = cwv[4], wv1 = cwv[5], wv2 = cwv[6], bvv = cwv[7];
#pragma unroll
            for (int ai = 0; ai < 2; ++ai) {
                const int blk = 2 * ai + wr, tokb = tok0 + ai * HALF;
                f32x4 gm1, gm2, vm1, vm2;
                if (smp) { const float* sb = sconv + (size_t)((tokb - MP) >> 2) * 2 * FF2;
                    gm2 = *(const f32x4*)(sb + j4); vm2 = *(const f32x4*)(sb + FF + j4); gm1 = *(const f32x4*)(sb + FF2 + j4); vm1 = *(const f32x4*)(sb + FF2 + FF + j4); }
                else { f32x4 h2g = {0.f, 0.f, 0.f, 0.f}, h3g = h2g, h2v = h2g, h3v = h2g;
                    if (blk > 0 && fr == 0) { const PG8_LAS float* hp = halo + (((blk * 2) * 4 + wc) * 4 + fq) * 16; h2g = *(const PG8_LAS f32x4*)(hp + 4 * n); h2v = *(const PG8_LAS f32x4*)(hp + 8 + 4 * n);
                        h3g = *(const PG8_LAS f32x4*)(hp + 256 + 4 * n); h3v = *(const PG8_LAS f32x4*)(hp + 256 + 8 + 4 * n); }
#pragma unroll
                    for (int e = 0; e < 4; ++e) { gm1[e] = dppf<0x111>(h3g[e], acc[ai][0][3][n][e]); gm2[e] = dppf<0x111>(h2g[e], acc[ai][0][2][n][e]); vm1[e] = dppf<0x111>(h3v[e], acc[ai][1][3][n][e]); vm2[e] = dppf<0x111>(h2v[e], acc[ai][1][2][n][e]); } }
#pragma unroll
                for (int m = 0; m < 4; ++m) { const int R = tokb + m;
                    const f32x4 g = acc[ai][0][m][n], v = acc[ai][1][m][n];
                    const f32x4 g1 = m == 0 ? gm1 : acc[ai][0][m > 0 ? m - 1 : 0][n], v1 = m == 0 ? vm1 : acc[ai][1][m > 0 ? m - 1 : 0][n];
                    const f32x4 g2 = m == 0 ? gm2 : (m == 1 ? gm1 : acc[ai][0][m > 1 ? m - 2 : 0][n]), v2 = m == 0 ? vm2 : (m == 1 ? vm1 : acc[ai][1][m > 1 ? m - 2 : 0][n]);
                    if (smp) { if (m >= 2) { float* cd = convs + ((size_t)((R - MP) >> 2) * 2 + (m - 2)) * FF2; *(f32x4*)(cd + j4) = g; *(f32x4*)(cd + FF + j4) = v; } }
                    else if ((ai == 0 && m < 2) || (ai == 1 && m >= 2)) {
                        const int t = R & 2047;
                        if (t >= 2046) { float* cd = convp + ((size_t)(R >> 11) * 2 + (t - 2046)) * FF2; *(f32x4*)(cd + j4) = g; *(f32x4*)(cd + FF + j4) = v; }
                        const int rt = R & 255;
                        if (rt < 2 || rt >= 254) { float* ed = EDGE + ((size_t)u.pm * 4 + (rt < 2 ? rt : rt - 252)) * FF2; *(f32x4*)(ed + j4) = g; *(f32x4*)(ed + FF + j4) = v; }
                    }
                    const f32x4 cg = bgv + wg0 * g2 + wg1 * g1 + wg2 * g, cv = bvv + wv0 * v2 + wv1 * v1 + wv2 * v;
                    u32x2 w; w.x = cvt_pk_bf16(silu_(cg[0]) * cv[0], silu_(cg[1]) * cv[1]); w.y = cvt_pk_bf16(silu_(cg[2]) * cv[2], silu_(cg[3]) * cv[3]);
                    *(u32x2*)(ACT + (size_t)R * FF + j4) = w;
                }
            }
        }
    }
};
#undef UPC_LOADW

template <class Epi, class Sched, bool ALIGN_EPI = false, bool SP2 = false>
__device__ __forceinline__ void gemm_phase(PG8_LAS unsigned char* lds, const Gemm g, const Sched& S, const Epi& E) {
    int tid_ = threadIdx.x; asm volatile("" : "+v"(tid_));
    const int tid = tid_, wid = __builtin_amdgcn_readfirstlane(tid >> 6), lane = tid & 63, wr = wid >> 2, wc = wid & 3, fr = lane & 15, fq = lane >> 4;
    const int K = g.K, nt = K / BK;
    unsigned voffA[2], voffB[2], voffB1[2];
#pragma unroll
    for (int i = 0; i < 2; ++i) { int R, C; stage_rc(tid * 16 + i * 8192, R, C); const int Rb = Epi::PERM ? ((R & ~31) + perm32(R & 31)) : R;
        int Ra = R; if constexpr (Epi::AMAP) Ra = E.amap(R); voffA[i] = (unsigned)(Ra * K + C) * 2u;     voffB[i] = (unsigned)(E.bmap(Rb) * K + C) * 2u; if constexpr (Epi::BMAP) voffB1[i] = (unsigned)(E.bmap(HALF + Rb) * K + C) * 2u; else voffB1[i] = 0u; }
    const size_t kstep = (size_t)(BK * 2);
    const size_t hstep = (size_t)HALF * K * 2;
    const unsigned* vB1 = Epi::BMAP ? voffB1 : voffB; const size_t h1step = Epi::BMAP ? (size_t)0 : hstep;
    const size_t tstep = 2 * hstep;
    const unsigned ldsw = (unsigned)wid * 1024u;
    const int aoff = lds_byte(wr * 64 + fr, fq * 8), boff = lds_byte(wc * 32 + fr, fq * 8);
#define PG8_SA(b, h) (((b) * 2 + (h)) * HTB)
#define PG8_SB(b, h) ((4 + (b) * 2 + (h)) * HTB)
#define PG8_STAGE(bufoff, gbase, voff) do { _Pragma("unroll") for (int _i = 0; _i < 2; ++_i) \
        __builtin_amdgcn_global_load_lds((const unsigned*)((const char*)(gbase) + (voff)[_i]), (PG8_LAS unsigned*)(lds + (bufoff) + ldsw + _i * 8192), 16, 0, 0); } while (0)
#define PG8_LDA(dst, b, h) do { _Pragma("unroll") for (int m = 0; m < 4; ++m) _Pragma("unroll") for (int k = 0; k < 2; ++k) dst[m][k] = *(const PG8_LAS bf16x8*)(lds + PG8_SA(b, h) + aoff + m * 2048 + k * 1024); } while (0)
#define PG8_LDB(dst, b, h) do { _Pragma("unroll") for (int n = 0; n < 2; ++n) _Pragma("unroll") for (int k = 0; k < 2; ++k) dst[n][k] = *(const PG8_LAS bf16x8*)(lds + PG8_SB(b, h) + boff + n * 2048 + k * 1024); } while (0)
#define PG8_MMA(ai, bj, At, Bt) do { __builtin_amdgcn_s_setprio(1); _Pragma("unroll") for (int m = 0; m < 4; ++m) _Pragma("unroll") for (int n = 0; n < 2; ++n) _Pragma("unroll") for (int k = 0; k < 2; ++k) \
        acc[ai][bj][m][n] = __builtin_amdgcn_mfma_f32_16x16x32_bf16(Bt[n][k], At[m][k], acc[ai][bj][m][n], 0, 0, 0); __builtin_amdgcn_s_setprio(0); } while (0)
#define PG8_WAIT_V(n) asm volatile("s_waitcnt vmcnt(" #n ")" ::: "memory")
#define PG8_WAIT_L(n) asm volatile("s_waitcnt lgkmcnt(" #n ")" ::: "memory")
#define PG8_BAR __builtin_amdgcn_s_barrier()
#define PG8_SCHED __builtin_amdgcn_sched_barrier(0)
    Unit cur, nxt; int ui = 0;
    if (!S.next(0, cur)) return;
    f32x4 acc[2][2][4][2];
#pragma unroll
    for (int a = 0; a < 2; ++a)
#pragma unroll
        for (int b = 0; b < 2; ++b)
#pragma unroll
            for (int m = 0; m < 4; ++m)
#pragma unroll
                for (int n = 0; n < 2; ++n) acc[a][b][m][n] = (f32x4){0.f, 0.f, 0.f, 0.f};
    bf16x8 At[4][2], B0[2][2], B1[2][2];
    const char* cA = (const char*)g.A + (size_t)cur.pm * tstep; const char* cB = (const char*)g.Bt + (size_t)cur.pn * tstep;
    S.a_ready(cur);
    if constexpr (SP2) {
        PG8_STAGE(PG8_SB(0, 0), cB, voffB); PG8_STAGE(PG8_SB(0, 1), cB + h1step, vB1); PG8_STAGE(PG8_SA(0, 0), cA, voffA); PG8_STAGE(PG8_SA(0, 1), cA + hstep, voffA);
        if (wr == 1) PG8_BAR;
        PG8_WAIT_V(2); PG8_BAR;
        PG8_STAGE(PG8_SB(1, 0), cB + kstep, voffB); PG8_STAGE(PG8_SA(1, 0), cA + kstep, voffA); PG8_STAGE(PG8_SB(1, 1), cB + h1step + kstep, vB1);
        PG8_WAIT_V(6); PG8_BAR;
    } else {
        PG8_STAGE(PG8_SB(0, 0), cB, voffB); PG8_STAGE(PG8_SA(0, 0), cA, voffA); PG8_STAGE(PG8_SB(0, 1), cB + h1step, vB1); PG8_STAGE(PG8_SA(0, 1), cA + hstep, voffA);
        if (wr == 1) PG8_BAR;
        PG8_WAIT_V(4); PG8_BAR;
        PG8_STAGE(PG8_SB(1, 0), cB + kstep, voffB); PG8_STAGE(PG8_SA(1, 0), cA + kstep, voffA); PG8_STAGE(PG8_SB(1, 1), cB + h1step + kstep, vB1);
        PG8_WAIT_V(6); PG8_BAR;
    }
    for (;;) {
        const bool has_next = S.next(ui + 1, nxt);
        const char* nA = has_next ? (const char*)g.A + (size_t)nxt.pm * tstep : cA; const char* nB = has_next ? (const char*)g.Bt + (size_t)nxt.pn * tstep : cB;
        for (int t = 0; t < nt; t += 2) {
            const bool last = (t == nt - 2);
            const char* a1 = cA + (size_t)(t + 1) * kstep;
            const char* a2 = last ? nA : cA + (size_t)(t + 2) * kstep; const char* b2 = last ? nB : cB + (size_t)(t + 2) * kstep;
            const char* a3 = a2 + kstep; const char* b3 = b2 + kstep;
            if (last && has_next) S.a_ready(nxt);
            if constexpr (SP2) {
            PG8_LDB(B0, 0, 0); PG8_LDB(B1, 0, 1); PG8_SCHED; PG8_LDA(At, 0, 0); PG8_STAGE(PG8_SA(1, 1), a1 + hstep, voffA);
            PG8_WAIT_V(8); PG8_WAIT_L(0); PG8_BAR; PG8_MMA(0, 0, At, B0); PG8_MMA(0, 1, At, B1); PG8_BAR; PG8_SCHED;
            PG8_LDA(At, 0, 1); PG8_STAGE(PG8_SB(0, 0), b2, voffB); PG8_STAGE(PG8_SB(0, 1), b2 + h1step, vB1); PG8_STAGE(PG8_SA(0, 0), a2, voffA);
            PG8_WAIT_V(8); PG8_WAIT_L(0); PG8_BAR; PG8_MMA(1, 0, At, B0); PG8_MMA(1, 1, At, B1); PG8_BAR; PG8_SCHED;
            PG8_LDB(B0, 1, 0); PG8_LDB(B1, 1, 1); PG8_SCHED; PG8_LDA(At, 1, 0); PG8_STAGE(PG8_SA(0, 1), a2 + hstep, voffA);
            PG8_WAIT_V(8); PG8_WAIT_L(0); PG8_BAR; PG8_MMA(0, 0, At, B0); PG8_MMA(0, 1, At, B1); PG8_BAR; PG8_SCHED;
            PG8_LDA(At, 1, 1); PG8_STAGE(PG8_SB(1, 0), b3, voffB); PG8_STAGE(PG8_SB(1, 1), b3 + h1step, vB1); PG8_STAGE(PG8_SA(1, 0), a3, voffA);
            PG8_WAIT_V(8); PG8_WAIT_L(0); PG8_BAR; PG8_MMA(1, 0, At, B0); PG8_MMA(1, 1, At, B1); PG8_BAR; PG8_SCHED;
            } else {
            PG8_LDB(B0, 0, 0); PG8_SCHED; PG8_LDA(At, 0, 0); PG8_STAGE(PG8_SA(1, 1), a1 + hstep, voffA);
            PG8_WAIT_L(8); PG8_BAR; PG8_WAIT_L(0); PG8_MMA(0, 0, At, B0); PG8_BAR; PG8_SCHED;
            PG8_LDB(B1, 0, 1); PG8_STAGE(PG8_SB(0, 0), b2, voffB);
            PG8_BAR; PG8_WAIT_L(0); PG8_MMA(0, 1, At, B1); PG8_BAR;
            PG8_LDA(At, 0, 1); PG8_STAGE(PG8_SA(0, 0), a2, voffA);
            PG8_BAR; PG8_WAIT_L(0); PG8_MMA(1, 0, At, B0); PG8_BAR; PG8_SCHED;
            PG8_STAGE(PG8_SB(0, 1), b2 + h1step, vB1);
            PG8_WAIT_V(6); PG8_BAR; PG8_MMA(1, 1, At, B1); PG8_BAR;
            PG8_LDB(B0, 1, 0); PG8_SCHED; PG8_LDA(At, 1, 0); PG8_STAGE(PG8_SA(0, 1), a2 + hstep, voffA);
            PG8_WAIT_L(8); PG8_BAR; PG8_WAIT_L(0); PG8_MMA(0, 0, At, B0); PG8_BAR; PG8_SCHED;
            PG8_LDB(B1, 1, 1); PG8_STAGE(PG8_SB(1, 0), b3, voffB);
            PG8_BAR; PG8_WAIT_L(0); PG8_MMA(0, 1, At, B1); PG8_BAR;
            PG8_LDA(At, 1, 1); PG8_STAGE(PG8_SA(1, 0), a3, voffA);
            PG8_BAR; PG8_WAIT_L(0); PG8_MMA(1, 0, At, B0); PG8_BAR; PG8_SCHED;
            PG8_STAGE(PG8_SB(1, 1), b3 + h1step, vB1);
            PG8_WAIT_V(6); PG8_BAR; PG8_MMA(1, 1, At, B1); PG8_BAR;
            }
        }
        if constexpr (ALIGN_EPI) { if (wr == 0) PG8_BAR; }
        if constexpr (!Epi::AFTER_DRAIN) { E(acc, cur, wr, wc, fr, fq); S.done(cur); }
        if (!has_next) break;
#pragma unroll
        for (int a = 0; a < 2; ++a)
#pragma unroll
            for (int b = 0; b < 2; ++b)
#pragma unroll
                for (int m = 0; m < 4; ++m)
#pragma unroll
                    for (int n = 0; n < 2; ++n) acc[a][b][m][n] = (f32x4){0.f, 0.f, 0.f, 0.f};
        cur = nxt; cA = nA; cB = nB; ++ui;
        if constexpr (ALIGN_EPI) { if (wr == 1) PG8_BAR; }
    }
    PG8_WAIT_V(0);
    if constexpr (!ALIGN_EPI) { if (wr == 0) PG8_BAR; }
    PG8_BAR;
    if constexpr (Epi::AFTER_DRAIN) { E.fused(acc, cur, wr, wc, fr, fq, lds, wid, lane); S.done(cur); }
#undef PG8_SA
#undef PG8_SB
#undef PG8_STAGE
#undef PG8_LDA
#undef PG8_LDB
#undef PG8_MMA
#undef PG8_WAIT_V
#undef PG8_WAIT_L
#undef PG8_BAR
#undef PG8_SCHED
}
}

#define XB_TMO      128
#define XB_XCNT(j)  (256  + 64 * (j))
#define XB_XSUB(j)  (1280 + 64 * (j))
#define XB_XGEN(j)  (2304 + 64 * (j))
#define XB_TOP      3328
#define XB_TOPGEN   3392
#define XCD_BAR_WORDS 3456
#define XB_SPIN_CAP (1u << 18)

__device__ __forceinline__ unsigned xb_ld(unsigned* p)              { return __hip_atomic_load(p, __ATOMIC_RELAXED, __HIP_MEMORY_SCOPE_AGENT); }
__device__ __forceinline__ unsigned xb_add(unsigned* p, unsigned v) { return __hip_atomic_fetch_add(p, v, __ATOMIC_RELAXED, __HIP_MEMORY_SCOPE_AGENT); }
__device__ __forceinline__ unsigned xb_xcc_id() { return (unsigned)__builtin_amdgcn_s_getreg((3 << 11) | 20) & 0xFu; }
#define XB_SPIN(cond, bar) do { unsigned _sp = 0; while (cond) { __builtin_amdgcn_s_sleep(1); \
    if ((++_sp & 255u) == 0u) { if (xb_ld(&(bar)[XB_TMO])) break; if (_sp > XB_SPIN_CAP) { atomicAdd(&(bar)[XB_TMO], 1u); break; } } } } while (0)

struct XcdBarrier {
    unsigned* bar; unsigned x;
    volatile LAS unsigned* st;
};

__device__ __forceinline__ XcdBarrier xcd_barrier_post(unsigned* bar, volatile LAS unsigned* st) {
    XcdBarrier b; b.bar = bar; b.x = xb_xcc_id(); b.st = st;
    if (threadIdx.x == 0) (void)xb_add(&bar[XB_XCNT(b.x)], 1u);
    return b;
}
__device__ __forceinline__ void xcd_barrier_complete(unsigned* bar, unsigned x, unsigned& nloc, unsigned& nx) {
    const unsigned G = gridDim.x * gridDim.y * gridDim.z;
    unsigned sum, cnt, mine, sp = 0u;
    for (;;) {
        sum = 0u; cnt = 0u; mine = 0u;
#pragma unroll
        for (unsigned j = 0; j < 16; ++j) { const unsigned c = xb_ld(&bar[XB_XCNT(j)]); sum += c; cnt += (c > 0u) ? 1u : 0u; mine = (j == x) ? c : mine; }
        if (sum == G) break;
        __builtin_amdgcn_s_sleep(1);
        if ((++sp & 255u) == 0u) { if (xb_ld(&bar[XB_TMO])) break; if (sp > XB_SPIN_CAP) { atomicAdd(&bar[XB_TMO], 1u); break; } }
    }
    nloc = mine > 0u ? mine : 1u; nx = cnt > 0u ? cnt : 1u;
}

__device__ __forceinline__ void xcd_barrier(const XcdBarrier& b) {
    asm volatile("s_waitcnt vmcnt(0)" ::: "memory");
    __syncthreads();
    if (threadIdx.x == 0) {
        unsigned* bar = b.bar;
        __builtin_amdgcn_s_waitcnt(0);
        unsigned nloc = b.st[0], nx = b.st[1];
        if (nloc == 0u) { xcd_barrier_complete(bar, b.x, nloc, nx); b.st[0] = nloc; b.st[1] = nx; }
        const unsigned old = xb_add(&bar[XB_XSUB(b.x)], 1u);
        const unsigned gen = old / nloc;
        if (old + 1u == (gen + 1u) * nloc) {
            __builtin_amdgcn_fence(__ATOMIC_RELEASE, "agent");
            asm volatile("s_waitcnt vmcnt(0)" ::: "memory");
            const unsigned og = xb_add(&bar[XB_TOP], 1u);
            const unsigned tg = og / nx;
            if (og + 1u == (tg + 1u) * nx) xb_add(&bar[XB_TOPGEN], 1u);
            else XB_SPIN(xb_ld(&bar[XB_TOPGEN]) == tg, bar);
            __builtin_amdgcn_fence(__ATOMIC_ACQUIRE, "agent");
            xb_add(&bar[XB_XGEN(b.x)], 1u);
            asm volatile("s_waitcnt vmcnt(0)" ::: "memory");
        } else {
            XB_SPIN(xb_ld(&bar[XB_XGEN(b.x)]) == gen, bar);
            __builtin_amdgcn_fence(__ATOMIC_ACQUIRE, "agent");
            asm volatile("s_waitcnt vmcnt(0)" ::: "memory");
        }
    }
    __syncthreads();
}

struct Args { const float* in[39]; float* out; unsigned char* ws; int ph_lo, ph_hi, li, pad; };
enum { I_XP = 0, I_XS, I_MEM, I_C1, I_C4, I_C16, I_SRE, I_SIM, I_SCONV, I_CMEM, I_NMIX, I_WIN, I_QN, I_KN, I_LRE, I_LIM, I_LDT, I_BRE, I_BIM, I_CRE, I_CIM, I_SD, I_WGLU, I_BGLU,
       I_AON, I_SON, I_WOUT, I_NX, I_NMEM, I_WXQ, I_WXKV, I_XQN, I_XKN, I_WXO, I_NFFN, I_WUP, I_CONVW, I_CONVB, I_WDOWN };
constexpr size_t O_YP = 0, O_YS = O_YP + (size_t)MP * D, O_KV1P = O_YS + (size_t)MS * D, O_KV4P = O_KV1P + (size_t)BP * 128 * 512, O_KV16P = O_KV4P + (size_t)BP * 512 * 512,
    O_SREP = O_KV16P + (size_t)BP * 2048 * 512, O_SIMP = O_SREP + BP * 1024, O_CONVP = O_SIMP + BP * 1024, O_MEMKV = O_CONVP + (size_t)BP * 2 * FF2, O_KV1S = O_MEMKV + (size_t)MM * 2048,
    O_KV4S = O_KV1S + (size_t)MS * 512, O_KV16S = O_KV4S + (size_t)MS * 512, O_SRES = O_KV16S + (size_t)MS * 512, O_SIMS = O_SRES + BS * 1024, O_CONVS = O_SIMS + BS * 1024, O_END = O_CONVS + (size_t)BS * 2 * FF2;
static_assert(O_END == 35102720 && O_KV1P == O_KV1P_ && O_KV4P == O_KV4P_ && O_KV16P == O_KV16P_ && O_KV1S == O_KV1S_ && O_KV4S == O_KV4S_ && O_KV16S == O_KV16S_, "output map");

template <int MODE> __device__ __forceinline__ int rowmap(int n) {
    if (MODE == 1) return (n & ~255) + 128 * ((n >> 5) & 1) + 32 * ((n >> 6) & 3) + (n & 31);
    if (MODE == 2) { return n < FF ? 256 * (n >> 7) + (n & 127) : 256 * ((n - FF) >> 7) + 128 + ((n - FF) & 127); }
    return n;
}
template <int MODE> __device__ __forceinline__ void p0_transpose_item(const float* W, int K, int N, bf16* WT, const float* gk, LAS float* scr, int item, int lane) {
    const int nblk = N / 32, kb = item / nblk, nb = item % nblk, k0 = 64 * kb, n0 = 32 * nb;
    float wv[32];
#pragma unroll
    for (int i = 0; i < 32; ++i) wv[i] = W[(size_t)(k0 + 2 * i + (lane >> 5)) * N + n0 + (lane & 31)];
    if (gk) {
#pragma unroll
        for (int i = 0; i < 32; ++i) wv[i] *= gk[k0 + 2 * i + (lane >> 5)]; }
#pragma unroll
    for (int i = 0; i < 32; ++i) scr[(2 * i + (lane >> 5)) * 33 + (lane & 31)] = wv[i];
    LDS_WAIT(); asm volatile("" ::: "memory");
    const int c = lane & 7;
#pragma unroll
    for (int j = 0; j < 4; ++j) { const int n = (lane >> 3) + 8 * j; const LAS float* s = scr + (8 * c) * 33 + n;
        u32x4 o; o.x = pk2(s[0 * 33], s[1 * 33]); o.y = pk2(s[2 * 33], s[3 * 33]); o.z = pk2(s[4 * 33], s[5 * 33]); o.w = pk2(s[6 * 33], s[7 * 33]);
        *(GAS u32x4*)(WT + (size_t)rowmap<MODE>(n0 + n) * K + k0 + 8 * c) = o; }
    LDS_WAIT(); asm volatile("" ::: "memory");
}
__device__ __forceinline__ void p0_tr_load(const float* W, int N, int item, int lane, float (&wv)[32]) {
    const int nblk = N / 32, kb = item / nblk, nb = item % nblk, k0 = 64 * kb, n0 = 32 * nb;
#pragma unroll
    for (int i = 0; i < 32; ++i) wv[i] = W[(size_t)(k0 + 2 * i + (lane >> 5)) * N + n0 + (lane & 31)];
}
template <int MODE> __device__ __forceinline__ void p0_tr_store(int K, int N, bf16* WT, const float* gk, LAS float* scr, int item, int lane, const float (&wv)[32]) {
    const int nblk = N / 32, kb = item / nblk, nb = item % nblk, k0 = 64 * kb, n0 = 32 * nb;
    const int c = lane & 7;
    f32x4 g0 = {1.f, 1.f, 1.f, 1.f}, g1 = g0;
    if (gk) { g0 = *(const f32x4*)(gk + k0 + 8 * c); g1 = *(const f32x4*)(gk + k0 + 8 * c + 4); }
#pragma unroll
    for (int i = 0; i < 32; ++i) scr[(2 * i + (lane >> 5)) * 33 + (lane & 31)] = wv[i];
    LDS_WAIT(); asm volatile("" ::: "memory");
#pragma unroll
    for (int j = 0; j < 4; ++j) { const int n = (lane >> 3) + 8 * j; const LAS float* s = scr + (8 * c) * 33 + n;
        u32x4 o; o.x = pk2(s[0 * 33] * g0[0], s[1 * 33] * g0[1]); o.y = pk2(s[2 * 33] * g0[2], s[3 * 33] * g0[3]); o.z = pk2(s[4 * 33] * g1[0], s[5 * 33] * g1[1]); o.w = pk2(s[6 * 33] * g1[2], s[7 * 33] * g1[3]);
        *(GAS u32x4*)(WT + (size_t)rowmap<MODE>(n0 + n) * K + k0 + 8 * c) = o; }
    LDS_WAIT(); asm volatile("" ::: "memory");
}
template <int MODE> __device__ __forceinline__ void p0_transpose_stream(const float* W, int K, int N, bf16* WT, const float* gk, LAS float* scr, int it, int nitems, int stride, int lane) {
    if (it >= nitems) return;
    float wa[32], wb[32];
    p0_tr_load(W, N, it, lane, wa);
    for (;;) {
        const int i1 = it + stride; if (i1 < nitems) p0_tr_load(W, N, i1, lane, wb);
        p0_tr_store<MODE>(K, N, WT, gk, scr, it, lane, wa);
        if (i1 >= nitems) break;
        const int i2 = i1 + stride; if (i2 < nitems) p0_tr_load(W, N, i2, lane, wa);
        p0_tr_store<MODE>(K, N, WT, gk, scr, i1, lane, wb);
        if (i2 >= nitems) break;
        it = i2;
    }
}
__device__ __forceinline__ void rms_rows2_to_bf16(const float* xrow0, const float* xrow1, const f32x4 (&gg)[4], bf16* orow0, bf16* orow1, int lane) {
    const f32x4* xr0 = (const f32x4*)xrow0 + lane; const f32x4* xr1 = (const f32x4*)xrow1 + lane;
    f32x4 v0[4], v1[4]; float s0 = 0.f, s1 = 0.f;
#pragma unroll
    for (int j = 0; j < 4; ++j) { v0[j] = xr0[64 * j]; v1[j] = xr1[64 * j]; }
#pragma unroll
    for (int j = 0; j < 4; ++j) { s0 += dot4(v0[j]); s1 += dot4(v1[j]); }
#pragma unroll
    for (int o = 1; o < 64; o <<= 1) { s0 += __shfl_xor(s0, o); s1 += __shfl_xor(s1, o); }
    const float r0 = frsq(s0 * (1.0f / D) + EPS), r1 = frsq(s1 * (1.0f / D) + EPS);
    u32x2* o0 = (u32x2*)orow0 + lane; u32x2* o1 = (u32x2*)orow1 + lane;
#pragma unroll
    for (int j = 0; j < 4; ++j) { const f32x4 a = v0[j] * r0 * gg[j], c = v1[j] * r1 * gg[j];
        u32x2 w; w.x = cvt_pk_bf16(a[0], a[1]); w.y = cvt_pk_bf16(a[2], a[3]); o0[64 * j] = w;
        u32x2 z; z.x = cvt_pk_bf16(c[0], c[1]); z.y = cvt_pk_bf16(c[2], c[3]); o1[64 * j] = z; }
}

__device__ __forceinline__ int pi23(int m) { return (m & ~12) | ((m & 4) << 1) | ((m & 8) >> 1); }
__device__ __forceinline__ void memk_fix_item(float* memkv, const float* mss, const float* xkn, const float* xqn, bf16* MEMK, int Rm, int lane) {
    const f32x4 gk = *(const f32x4*)(xkn + 4 * lane), gq = *(const f32x4*)(xqn + 4 * lane);
    f32x4 v[4], s[4];
#pragma unroll
    for (int h = 0; h < 4; ++h) { v[h] = *(const f32x4*)(memkv + (size_t)Rm * 2048 + h * 256 + 4 * lane); s[h] = *(const f32x4*)(mss + (size_t)Rm * 16 + 4 * h); }
#pragma unroll
    for (int h = 0; h < 4; ++h) {
        const float rs = frsq(((s[h][0] + s[h][1]) + (s[h][2] + s[h][3])) * (1.0f / 256.0f) + EPS);
        const f32x4 kn = v[h] * rs * gk; *(f32x4*)(memkv + (size_t)Rm * 2048 + h * 256 + 4 * lane) = kn; const f32x4 kq = kn * gq;
        u32x2 w; w.x = cvt_pk_bf16(kq[0], kq[1]); w.y = cvt_pk_bf16(kq[2], kq[3]); *(u32x2*)(MEMK + (size_t)Rm * 1024 + h * 256 + 4 * lane) = w;
    }
}
__device__ __forceinline__ void ssm_bfrags(const Args& a, const float* ssmc, int g, int lane, bf16x8 (&bb)[4]) {
    const int n = lane & 31, hi = lane >> 5;
#pragma unroll
    for (int s2 = 0; s2 < 2; ++s2) { const int st = g * 64 + 32 * s2 + n; const f32x4 c0 = *(const f32x4*)(ssmc + (size_t)st * 8); const float cr = c0[2], ci = c0[3];
        const f32x4 r0 = *(const f32x4*)(a.in[I_BRE] + (size_t)st * 16 + 8 * hi), r1 = *(const f32x4*)(a.in[I_BRE] + (size_t)st * 16 + 8 * hi + 4);
        const f32x4 i0 = *(const f32x4*)(a.in[I_BIM] + (size_t)st * 16 + 8 * hi), i1 = *(const f32x4*)(a.in[I_BIM] + (size_t)st * 16 + 8 * hi + 4);
        const f32x4 pr0 = r0 * cr - i0 * ci, pr1 = r1 * cr - i1 * ci, pi0 = i0 * cr + r0 * ci, pi1 = i1 * cr + r1 * ci;
        bb[s2] = pack8(pr0[0], pr0[1], pr0[2], pr0[3], pr1[0], pr1[1], pr1[2], pr1[3]); bb[2 + s2] = pack8(pi0[0], pi0[1], pi0[2], pi0[3], pi1[0], pi1[1], pi1[2], pi1[3]); }
}
__device__ __forceinline__ bf16x8 ssm_loadu(const float* U, int row0, int nrows, int g, int lane) {
    const int m = lane & 31, hi = lane >> 5; const int row = row0 + (m < nrows ? m : (m & (nrows - 1)));
    const f32x4 u0 = *(const f32x4*)(U + (size_t)row * 256 + g * 16 + 8 * hi), u1 = *(const f32x4*)(U + (size_t)row * 256 + g * 16 + 8 * hi + 4);
    return pack8(u0[0], u0[1], u0[2], u0[3], u1[0], u1[1], u1[2], u1[3]);
}
__device__ __forceinline__ void ssm_xcompute(bf16x8 ua, const bf16x8 (&bb)[4], f32x16 (&xr)[2], f32x16 (&xi)[2]) {
    const f32x16 z = {0.f, 0.f, 0.f, 0.f, 0.f, 0.f, 0.f, 0.f, 0.f, 0.f, 0.f, 0.f, 0.f, 0.f, 0.f, 0.f};
    f32x16 t0 = __builtin_amdgcn_mfma_f32_32x32x16_bf16(ua, bb[0], z, 0, 0, 0), t1 = __builtin_amdgcn_mfma_f32_32x32x16_bf16(ua, bb[1], z, 0, 0, 0);
    f32x16 t2 = __builtin_amdgcn_mfma_f32_32x32x16_bf16(ua, bb[2], z, 0, 0, 0), t3 = __builtin_amdgcn_mfma_f32_32x32x16_bf16(ua, bb[3], z, 0, 0, 0);
#pragma unroll
    for (int r = 0; r < 16; ++r) {
        const float a0 = t0[r], a1 = t1[r], a2 = t2[r], a3 = t3[r];
        const auto sr = __builtin_amdgcn_permlane32_swap(__float_as_uint(a0), __float_as_uint(a1), false, false);
        const unsigned s0 = sr[0], s1 = sr[1];
        xr[0][r] = __uint_as_float(s0); xr[1][r] = __uint_as_float(s1);
        const auto si = __builtin_amdgcn_permlane32_swap(__float_as_uint(a2), __float_as_uint(a3), false, false);
        const unsigned s2 = si[0], s3 = si[1];
        xi[0][r] = __uint_as_float(s2); xi[1][r] = __uint_as_float(s3); }
    __builtin_amdgcn_sched_barrier(0); asm volatile("s_nop 7" ::: "memory"); __builtin_amdgcn_sched_barrier(0);
}
#define SSM_XR(t) xr[((t) >> 2) & 1][((t) & 3) + 4 * ((t) >> 3)]
#define SSM_XI(t) xi[((t) >> 2) & 1][((t) & 3) + 4 * ((t) >> 3)]
__device__ __forceinline__ void ssm_a_item(const Args& a, const float* U, const float* ssmc, float* SSMF, LAS float* uL, int it, int lane) {
    const int g = it & 15, bc = it >> 4, b = bc / 31, c = bc - b * 31;
    const f32x4 c0 = *(const f32x4*)(ssmc + (size_t)(g * 64 + lane) * 8);
    const float ar = c0[0], ai = c0[1];
    bf16x8 bb[4]; ssm_bfrags(a, ssmc, g, lane, bb);
    float hr = 0.f, hi = 0.f;
    bf16x8 ua2[2]; ua2[0] = ssm_loadu(U, b * 2048 + c * 64, 32, g, lane); ua2[1] = ssm_loadu(U, b * 2048 + c * 64 + 32, 32, g, lane);
#pragma unroll
    for (int blk = 0; blk < 2; ++blk) {
        f32x16 xr[2], xi[2]; ssm_xcompute(ua2[blk], bb, xr, xi);
#pragma unroll
        for (int t = 0; t < 32; ++t) { const float nr = fmaf(ar, hr, fmaf(-ai, hi, SSM_XR(t))), ni = fmaf(ar, hi, fmaf(ai, hr, SSM_XI(t))); hr = nr; hi = ni; }
    }
    *(f32x2*)(SSMF + ((size_t)((b * 32 + c) * 16 + g) * 64 + lane) * 2) = (f32x2){hr, hi};
    (void)uL;
}
constexpr int SAB = 4;
struct SaBatch { f32x4 k[SAB], v[SAB]; };
__device__ __forceinline__ void sa_load(SaBatch& B, const float* cb, unsigned loff, int t, int dil, int nvalid, int i0) {
#pragma unroll
    for (int j = 0; j < SAB; ++j) { const int i = i0 + j, idx = i < nvalid ? t + i * dil : t; const char* rp = (const char*)(cb + (size_t)idx * 512);
        B.k[j] = __builtin_nontemporal_load((const f32x4*)(rp + loff)); B.v[j] = __builtin_nontemporal_load((const f32x4*)(rp + 1024 + loff)); }
}
__device__ __forceinline__ void sa_compute(const SaBatch& B, f32x4 q, int nvalid, int i0, float& m, float& l, f32x4& o) {
    float s[SAB]; float mb = m;
#pragma unroll
    for (int j = 0; j < SAB; ++j) { float d = (q[0] * B.k[j][0] + q[1] * B.k[j][1]) + (q[2] * B.k[j][2] + q[3] * B.k[j][3]);
        d += __shfl_xor(d, 1); d += __shfl_xor(d, 2); d += __shfl_xor(d, 4); d += __shfl_xor(d, 8);
        s[j] = (i0 + j) < nvalid ? d : -1e30f; mb = fmaxf(mb, s[j]); }
    const float sc = fexp2(m - mb); l *= sc; o = o * sc; m = mb;
#pragma unroll
    for (int j = 0; j < SAB; ++j) { const float p = fexp2(s[j] - mb); l += p; o = o + B.v[j] * p; }
}
__device__ __forceinline__ void sattn_item(const Args& a, const bf16* Q, bf16* AO, float* LSE, int it, int lane) {
    const int g = it >> 9, rem = it & 511, b = rem >> 2, t = rem & 3;
    const int dil = 1 << (2 * g), nbuf = 128 << (2 * g);
    const int R = MP + 4 * b + t, hh = lane >> 4, dq = (lane & 15) * 4;
    const u32x2 qw = *(const u32x2*)(Q + (size_t)R * AW + g * 256 + hh * 64 + dq);
    const f32x4 q = {bf2f(qw.x & 0xffffu), bf2f(qw.x >> 16), bf2f(qw.y & 0xffffu), bf2f(qw.y >> 16)};
    const float* cb = a.in[I_C1 + g] + (size_t)b * nbuf * 512; const unsigned loff = 4u * (unsigned)(hh * 64 + dq);
    const float* nb = a.out + (g == 0 ? O_KV1S : (g == 1 ? O_KV4S : O_KV16S)) + (size_t)(4 * b) * 512 + hh * 64 + dq;
    const int nvalid = g == 0 ? 128 - t : 128;
    float m = -1e30f, l = 0.f; f32x4 o = {0.f, 0.f, 0.f, 0.f};
    SaBatch A, B; sa_load(A, cb, loff, t, dil, nvalid, 0);
#pragma unroll 1
    for (int i0 = 0; i0 < 128; i0 += 2 * SAB) {
        sa_load(B, cb, loff, t, dil, nvalid, i0 + SAB);
        sa_compute(A, q, nvalid, i0, m, l, o);
        if (i0 + 2 * SAB < 128) sa_load(A, cb, loff, t, dil, nvalid, i0 + 2 * SAB);
        sa_compute(B, q, nvalid, i0 + SAB, m, l, o);
    }
    {
        f32x4 kk[4], vv[4]; float s[4]; float mb = m;
#pragma unroll
        for (int j = 0; j < 4; ++j) { const float* rp = nb + (size_t)j * 512; kk[j] = *(const f32x4*)rp; vv[j] = *(const f32x4*)(rp + 256); }
#pragma unroll
        for (int j = 0; j < 4; ++j) { float d = (q[0] * kk[j][0] + q[1] * kk[j][1]) + (q[2] * kk[j][2] + q[3] * kk[j][3]);
            d += __shfl_xor(d, 1); d += __shfl_xor(d, 2); d += __shfl_xor(d, 4); d += __shfl_xor(d, 8);
            const bool ok = g == 0 ? (j <= t) : (j == t); s[j] = ok ? d : -1e30f; mb = fmaxf(mb, s[j]); }
        const float sc = fexp2(m - mb); l *= sc; o = o * sc; m = mb;
#pragma unroll
        for (int j = 0; j < 4; ++j) { const float p = fexp2(s[j] - mb); l += p; o = o + vv[j] * p; }
    }
    const float il = frcp(l); o = o * il;
    u32x2 w; w.x = cvt_pk_bf16(o[0], o[1]); w.y = cvt_pk_bf16(o[2], o[3]); *(u32x2*)(AO + (size_t)R * AW + g * 256 + hh * 64 + dq) = w;
    if ((lane & 15) == 0) LSE[(size_t)R * 12 + g * 4 + hh] = (m + flog2(l)) * LN2;
}
__device__ __forceinline__ void pattn_item(const bf16* Q, const bf16* Kb, const bf16* VT, bf16* AO, float* LSE, int it, int lane) {
    const int g = it >> 11; int rem = it & 2047;
    const int sh = 2 * g, dil = 1 << sh, S = 2048 >> sh, nql = 6 - sh;
    const int qt = rem & ((1 << nql) - 1); rem >>= nql; const int res = rem & (dil - 1); rem >>= sh; const int hh = rem & 3, b = rem >> 2;
    const int n = lane & 31, hi = lane >> 5;
    const int s_q = 32 * qt + n, qrow = b * 2048 + s_q * dil + res;
    const int coff = g * 256 + hh * 64 + 32 * hi;
    bf16x8 qf[4];
    { const bf16* qp = Q + (size_t)qrow * AW + coff;
#pragma unroll
      for (int d0 = 0; d0 < 4; ++d0) qf[d0] = *(const bf16x8*)(qp + 8 * d0); }
    f32x16 sc[5];
    const int pm = pi23(n);
#pragma unroll
    for (int kt = 0; kt < 5; ++kt) {
        const int sb = 32 * qt - 128 + 32 * kt; int sk = sb + pm; sk = sk < 0 ? 0 : sk;
        const bf16* kp = Kb + (size_t)(b * 2048 + sk * dil + res) * AW + coff;
        bf16x8 kf[4];
#pragma unroll
        for (int d0 = 0; d0 < 4; ++d0) kf[d0] = *(const bf16x8*)(kp + 8 * d0);
        f32x16 acc = {0.f, 0.f, 0.f, 0.f, 0.f, 0.f, 0.f, 0.f, 0.f, 0.f, 0.f, 0.f, 0.f, 0.f, 0.f, 0.f};
#pragma unroll
        for (int d0 = 0; d0 < 4; ++d0) acc = __builtin_amdgcn_mfma_f32_32x32x16_bf16(kf[d0], qf[d0], acc, 0, 0, 0);
        sc[kt] = acc;
    }
    float mx = -1e30f;
#pragma unroll
    for (int kt = 0; kt < 5; ++kt) { const int sb = 32 * qt - 128 + 32 * kt;
#pragma unroll
        for (int r = 0; r < 16; ++r) { const int sk = sb + 16 * (r >> 3) + 8 * hi + (r & 7); const int dl = s_q - sk; const bool ok = (sk >= 0) && (dl >= 0) && (dl <= 128);
            const float v = ok ? sc[kt][r] : -1e30f; sc[kt][r] = v; mx = fmaxf(mx, v); } }
    mx = fmaxf(mx, __shfl_xor(mx, 32));
    float l = 0.f;
#pragma unroll
    for (int kt = 0; kt < 5; ++kt)
#pragma unroll
        for (int r = 0; r < 16; ++r) { const float p = fexp2(sc[kt][r] - mx); sc[kt][r] = p; l += p; }
    l += __shfl_xor(l, 32);
    f32x16 o[2];
#pragma unroll
    for (int dt = 0; dt < 2; ++dt) o[dt] = (f32x16){0.f, 0.f, 0.f, 0.f, 0.f, 0.f, 0.f, 0.f, 0.f, 0.f, 0.f, 0.f, 0.f, 0.f, 0.f, 0.f};
    const bf16* vbase = VT + (size_t)((g * 4 + hh) * 8 + b) * 64 * 2048;
#pragma unroll
    for (int kt = 0; kt < 5; ++kt) {
        int sb = 32 * qt - 128 + 32 * kt; sb = sb < 0 ? 0 : sb;
        const bf16* vp = vbase + (size_t)((res * S + sb) >> 5) * 2048 + n * 32 + 8 * hi;
#pragma unroll
        for (int jj = 0; jj < 2; ++jj) {
            const bf16x8 pb = pack8(sc[kt][8 * jj + 0], sc[kt][8 * jj + 1], sc[kt][8 * jj + 2], sc[kt][8 * jj + 3], sc[kt][8 * jj + 4], sc[kt][8 * jj + 5], sc[kt][8 * jj + 6], sc[kt][8 * jj + 7]);
#pragma unroll
            for (int dt = 0; dt < 2; ++dt) { const bf16x8 vf = *(const bf16x8*)(vp + dt * 1024 + 16 * jj); o[dt] = __builtin_amdgcn_mfma_f32_32x32x16_bf16(vf, pb, o[dt], 0, 0, 0); }
        }
    }
    const float il = frcp(l);
    bf16* op = AO + (size_t)qrow * AW + g * 256 + hh * 64 + 4 * hi;
#pragma unroll
    for (int dt = 0; dt < 2; ++dt)
#pragma unroll
        for (int r4 = 0; r4 < 4; ++r4) { u32x2 w; w.x = cvt_pk_bf16(o[dt][4 * r4] * il, o[dt][4 * r4 + 1] * il); w.y = cvt_pk_bf16(o[dt][4 * r4 + 2] * il, o[dt][4 * r4 + 3] * il);
            *(u32x2*)(op + 32 * dt + 8 * r4) = w; }
    if (hi == 0) LSE[(size_t)qrow * 12 + g * 4 + hh] = (mx + flog2(l)) * LN2;
}

constexpr int PK_ROW = 144, PK_SLOT = 32 * PK_ROW, PV_OFF = 12 * PK_SLOT;
__device__ __forceinline__ void pattn_wg_item(const bf16* Q, const bf16* Kb, const bf16* VT, bf16* AO, float* LSE, LAS unsigned char* lds, int item, int wave, int lane, int tid) {
    const int g = item >> 8, r = item & 255, hh = (r >> 3) & 3, b = r >> 5;
    const int sh = 2 * g, dil = 1 << sh, S = 2048 >> sh;
    const int qblk = g == 0 ? (r & 7) : (r & 1), resb = g == 0 ? 0 : (g == 1 ? ((r >> 1) & 3) : 2 * (r & 7));
    const int pc = tid & 255;
    u32x4 kreg[6], vreg[6];
#pragma unroll
    for (int i = 0; i < 6; ++i) { const int T = (tid >> 8) + 2 * i;
        int sb, rs; bool ok;
        if (g < 2) { sb = 256 * qblk - 128 + 32 * T; rs = resb; ok = sb >= 0; } else { sb = 32 * (T & 3); rs = resb + (T >> 2); ok = T < 8; }
        if (ok) { const int t = (sb + (pc >> 3)) * dil + rs;
            kreg[i] = *(const u32x4*)(Kb + (size_t)(b * 2048 + t) * AW + g * 256 + hh * 64 + 8 * (pc & 7));
            vreg[i] = *(const u32x4*)(VT + (size_t)(b * 2048 + t) * AW + g * 256 + hh * 64 + 8 * (pc & 7)); }
        else { kreg[i] = (u32x4){0u, 0u, 0u, 0u}; vreg[i] = kreg[i]; } }
    const int n = lane & 31, hi = lane >> 5;
    const int qt = g < 2 ? 8 * qblk + wave : (wave & 3), resw = g < 2 ? resb : resb + (wave >> 2);
    const int slot_base = g < 2 ? wave : 4 * (wave >> 2) + (wave & 3) - 4;
    const int s_q = 32 * qt + n, qrow = b * 2048 + s_q * dil + resw;
    bf16x8 qf[4];
    { const bf16* qp = Q + (size_t)qrow * AW + g * 256 + hh * 64 + 32 * hi;
#pragma unroll
      for (int d0 = 0; d0 < 4; ++d0) qf[d0] = *(const bf16x8*)(qp + 8 * d0); }
#pragma unroll
    for (int i = 0; i < 6; ++i) { const int T = (tid >> 8) + 2 * i;
        *(LAS u32x4*)(lds + T * PK_SLOT + (pc >> 3) * PK_ROW + (pc & 7) * 16) = kreg[i];
        *(LAS u32x4*)(lds + PV_OFF + T * PK_SLOT + (pc >> 3) * PK_ROW + (pc & 7) * 16) = vreg[i]; }
    __syncthreads();
    f32x16 sc[5];
    const int pm = pi23(n);
#pragma unroll
    for (int kt = 0; kt < 5; ++kt) {
        const int slot = slot_base + kt, sb = 32 * qt - 128 + 32 * kt;
        f32x16 acc = {0.f, 0.f, 0.f, 0.f, 0.f, 0.f, 0.f, 0.f, 0.f, 0.f, 0.f, 0.f, 0.f, 0.f, 0.f, 0.f};
        if (sb >= 0) {
            const LAS unsigned char* kp = lds + slot * PK_SLOT + pm * PK_ROW + 64 * hi;
            bf16x8 kf[4];
#pragma unroll
            for (int d0 = 0; d0 < 4; ++d0) kf[d0] = *(const LAS bf16x8*)(kp + 16 * d0);
#pragma unroll
            for (int d0 = 0; d0 < 4; ++d0) acc = __builtin_amdgcn_mfma_f32_32x32x16_bf16(kf[d0], qf[d0], acc, 0, 0, 0);
        }
        sc[kt] = acc;
    }
    float mx = -1e30f;
#pragma unroll
    for (int kt = 0; kt < 5; ++kt) { const int sb = 32 * qt - 128 + 32 * kt;
#pragma unroll
        for (int rr = 0; rr < 16; ++rr) { const int sk = sb + 16 * (rr >> 3) + 8 * hi + (rr & 7); const int dl = s_q - sk; const bool ok = (sk >= 0) && (dl >= 0) && (dl <= 128);
            const float v = ok ? sc[kt][rr] : -1e30f; sc[kt][rr] = v; mx = fmaxf(mx, v); } }
    mx = fmaxf(mx, __shfl_xor(mx, 32));
    float l = 0.f;
#pragma unroll
    for (int kt = 0; kt < 5; ++kt)
#pragma unroll
        for (int rr = 0; rr < 16; ++rr) { const float p = fexp2(sc[kt][rr] - mx); sc[kt][rr] = p; l += p; }
    l += __shfl_xor(l, 32);
    f32x16 o[2];
#pragma unroll
    for (int dt = 0; dt < 2; ++dt) o[dt] = (f32x16){0.f, 0.f, 0.f, 0.f, 0.f, 0.f, 0.f, 0.f, 0.f, 0.f, 0.f, 0.f, 0.f, 0.f, 0.f, 0.f};
#pragma unroll
    for (int kt = 0; kt < 5; ++kt) {
        const int slot = slot_base + kt, sb = 32 * qt - 128 + 32 * kt;
        if (sb >= 0) {
            LAS unsigned char* vp = lds + PV_OFF + slot * PK_SLOT + (8 * hi + ((lane >> 2) & 3)) * PK_ROW + (16 * ((lane >> 4) & 1) + 4 * (lane & 3)) * 2;
            bf16x8 vf[2][2];
#pragma unroll
            for (int jj = 0; jj < 2; ++jj)
#pragma unroll
                for (int dt = 0; dt < 2; ++dt) vf[jj][dt] = cat44(lds_tr4(vp + (16 * jj) * PK_ROW + 64 * dt), lds_tr4(vp + (16 * jj + 4) * PK_ROW + 64 * dt));
#pragma unroll
            for (int jj = 0; jj < 2; ++jj) {
                const bf16x8 pb = pack8(sc[kt][8 * jj + 0], sc[kt][8 * jj + 1], sc[kt][8 * jj + 2], sc[kt][8 * jj + 3], sc[kt][8 * jj + 4], sc[kt][8 * jj + 5], sc[kt][8 * jj + 6], sc[kt][8 * jj + 7]);
#pragma unroll
                for (int dt = 0; dt < 2; ++dt) o[dt] = __builtin_amdgcn_mfma_f32_32x32x16_bf16(vf[jj][dt], pb, o[dt], 0, 0, 0);
            }
        }
    }
    const float il = frcp(l);
    bf16* op = AO + (size_t)qrow * AW + g * 256 + hh * 64 + 4 * hi;
#pragma unroll
    for (int dt = 0; dt < 2; ++dt)
#pragma unroll
        for (int r4 = 0; r4 < 4; ++r4) { u32x2 w; w.x = cvt_pk_bf16(o[dt][4 * r4] * il, o[dt][4 * r4 + 1] * il); w.y = cvt_pk_bf16(o[dt][4 * r4 + 2] * il, o[dt][4 * r4 + 3] * il);
            *(u32x2*)(op + 32 * dt + 8 * r4) = w; }
    if (hi == 0) LSE[(size_t)qrow * 12 + g * 4 + hh] = (mx + flog2(l)) * LN2;
    __syncthreads();
}

template <int NB> __device__ __forceinline__ void combine_rows(const bf16* AO, const float* LSE, const float* aon, bf16* MIXED, int R0, int lane) {
    const int hh = lane >> 4; float ls[NB][3]; u32x2 ow[NB][3];
#pragma unroll
    for (int i = 0; i < NB; ++i)
#pragma unroll
        for (int g = 0; g < 3; ++g) { ow[i][g] = *(const u32x2*)(AO + (size_t)(R0 + i) * AW + g * 256 + 4 * lane); ls[i][g] = LSE[(size_t)(R0 + i) * 12 + g * 4 + hh]; }
    f32x4 gn[3];
#pragma unroll
    for (int g = 0; g < 3; ++g) gn[g] = *(const f32x4*)(aon + g * 256 + 4 * lane);
#pragma unroll
    for (int i = 0; i < NB; ++i) {
        const float mx = fmaxf(fmaxf(ls[i][0], ls[i][1]), ls[i][2]);
        float e[3]; e[0] = fexp2((ls[i][0] - mx) * LOG2E); e[1] = fexp2((ls[i][1] - mx) * LOG2E); e[2] = fexp2((ls[i][2] - mx) * LOG2E);
        const float inv = frcp(e[0] + e[1] + e[2]);
        f32x4 v[3]; float ss = 0.f;
#pragma unroll
        for (int g = 0; g < 3; ++g) { const float al = e[g] * inv; v[g] = (f32x4){bf2f(ow[i][g].x & 0xffffu), bf2f(ow[i][g].x >> 16), bf2f(ow[i][g].y & 0xffffu), bf2f(ow[i][g].y >> 16)} * al; ss += dot4(v[g]); }
        const float rs = frsq(wave_sum(ss) * (1.0f / 768.0f) + EPS);
#pragma unroll
        for (int g = 0; g < 3; ++g) { const f32x4 y = v[g] * rs * gn[g];
            u32x2 w; w.x = cvt_pk_bf16(y[0], y[1]); w.y = cvt_pk_bf16(y[2], y[3]); *(u32x2*)(MIXED + (size_t)(R0 + i) * D + g * 256 + 4 * lane) = w; }
    }
}
__device__ __forceinline__ float gelu_tanh(float x) { const float u2 = 1.5957691216057308f * (x + 0.044715f * x * x * x); return x * frcp(1.0f + fexp2(-u2 * LOG2E)); }
__device__ __forceinline__ float sigmoidf_(float z) { return frcp(1.0f + fexp2(-z * LOG2E)); }
__device__ __forceinline__ void ssm_c_item(const Args& a, const float* U, const float* ssmc, const float* SSMF, const bf16* WGLU, bf16* MIXED, LAS unsigned char* lds, int item, int wave, int lane) {
    const bool hs = item < 32;
    const int b = item >> 5, c = item & 31;
    const int R0 = item * 64, RS0 = MP + item * 16;
    LAS unsigned* HL = (LAS unsigned*)(lds + wave * 4352);
    LAS float* ZS = (LAS float*)(lds + 34816);
    const int t16 = lane & 15, q4 = lane >> 4;
    for (int gi = 0; gi < 2; ++gi) {
        const int g = 2 * wave + gi;
        const f32x4* cp = (const f32x4*)(ssmc + (size_t)(g * 64 + lane) * 8); const f32x4 c0 = cp[0], c1 = cp[1];
        const float ar = c0[0], ai = c0[1], a64r = c1[0], a64i = c1[1];
        bf16x8 bb[4]; ssm_bfrags(a, ssmc, g, lane, bb);
        bf16x8 cf[4];
#pragma unroll
        for (int s4 = 0; s4 < 4; ++s4) { const int p0 = 16 * s4 + 4 * q4; const f32x4 x = *(const f32x4*)(a.in[I_CRE] + (size_t)(g * 16 + t16) * 64 + p0), y = *(const f32x4*)(a.in[I_CIM] + (size_t)(g * 16 + t16) * 64 + p0);
            cf[s4] = pack8(x[0], -y[0], x[1], -y[1], x[2], -y[2], x[3], -y[3]); }
        const f32x4 dv = *(const f32x4*)(a.in[I_SD] + g * 16 + 4 * q4);
        float hr = 0.f, hi = 0.f;
        {
            const int nb16 = (c + 15) >> 4; int cc0 = c - 16 * nb16;
            for (int i16 = 0; i16 < nb16; ++i16, cc0 += 16) { f32x2 f[16];
#pragma unroll
                for (int j = 0; j < 16; ++j) { const int cc = cc0 + j; f[j] = cc >= 0 ? *(const f32x2*)(SSMF + ((size_t)((b * 32 + cc) * 16 + g) * 64 + lane) * 2) : (f32x2){0.f, 0.f}; }
#pragma unroll
                for (int j = 0; j < 16; ++j) { const float nr = fmaf(a64r, hr, fmaf(-a64i, hi, f[j][0])), ni = fmaf(a64r, hi, fmaf(a64i, hr, f[j][1])); hr = nr; hi = ni; } }
        }
#if defined(PROBE_DUMP)
        { float* dmp = (float*)((unsigned char*)MIXED - WS_MIXED + 741 * MiB) + ((size_t)(item * 16 + g) * 64 + lane) * 2; dmp[0] = hr; dmp[1] = hi; }
#endif
        bf16x8 ua2[2]; f32x4 uv4[4];
        ua2[0] = ssm_loadu(U, R0, 32, g, lane); ua2[1] = ssm_loadu(U, R0 + 32, 32, g, lane);
#pragma unroll
        for (int j = 0; j < 4; ++j) uv4[j] = *(const f32x4*)(U + (size_t)(R0 + 16 * j + t16) * 256 + g * 16 + 4 * q4);
#if defined(PROBE_DUMP)
        { u32x4* dmp = (u32x4*)((unsigned char*)MIXED - WS_MIXED + 724 * MiB) + ((size_t)(item * 16 + g) * 2) * 64 + lane; dmp[0] = __builtin_bit_cast(u32x4, ua2[0]); dmp[64] = __builtin_bit_cast(u32x4, ua2[1]); }
#endif
#pragma unroll
        for (int blk = 0; blk < 2; ++blk) {
            f32x16 xr[2], xi[2]; ssm_xcompute(ua2[blk], bb, xr, xi);
#pragma unroll
            for (int s2 = 0; s2 < 2; ++s2) {
                const int trow = 32 * blk + 16 * s2 + t16;
                const f32x4 uv = uv4[2 * blk + s2];
#pragma unroll
                for (int tt = 0; tt < 16; ++tt) { const int t = 16 * s2 + tt;
                    const float nr = fmaf(ar, hr, fmaf(-ai, hi, SSM_XR(t))), ni = fmaf(ar, hi, fmaf(ai, hr, SSM_XI(t))); hr = nr; hi = ni;
                    HL[tt * 68 + lane] = cvt_pk_bf16(hr, hi);
                }
                LDS_WAIT(); asm volatile("" ::: "memory");
                f32x4 y = {0.f, 0.f, 0.f, 0.f};
#pragma unroll
                for (int s4 = 0; s4 < 4; ++s4) { const bf16x8 hf = *(const LAS bf16x8*)((LAS unsigned short*)HL + t16 * 136 + 32 * s4 + 8 * q4); y = __builtin_amdgcn_mfma_f32_16x16x32_bf16(cf[s4], hf, y, 0, 0, 0); }
                f32x4 z;
#pragma unroll
                for (int e = 0; e < 4; ++e) z[e] = gelu_tanh(y[e] + dv[e] * uv[e]);
                *(LAS f32x4*)(ZS + trow * 260 + g * 16 + 4 * q4) = z;
                LDS_WAIT(); asm volatile("" ::: "memory");
            }
        }
        if (c == 31) { a.out[O_SREP + (size_t)(b * 16 + g) * 64 + lane] = hr; a.out[O_SIMP + (size_t)(b * 16 + g) * 64 + lane] = hi; }
        if (hs) {
            float sre[4], sim[4];
#pragma unroll
            for (int j = 0; j < 4; ++j) { const size_t o = (size_t)((4 * item + j) * 16 + g) * 64 + lane; sre[j] = a.in[I_SRE][o]; sim[j] = a.in[I_SIM][o]; }
            const bf16x8 ua = ssm_loadu(U, RS0, 16, g, lane);
            const f32x4 uv = *(const f32x4*)(U + (size_t)(RS0 + t16) * 256 + g * 16 + 4 * q4);
            f32x16 xr[2], xi[2]; ssm_xcompute(ua, bb, xr, xi);
#pragma unroll
            for (int tt = 0; tt < 16; ++tt) {
                if ((tt & 3) == 0) { hr = sre[tt >> 2]; hi = sim[tt >> 2]; }
                const float nr = fmaf(ar, hr, fmaf(-ai, hi, SSM_XR(tt))), ni = fmaf(ar, hi, fmaf(ai, hr, SSM_XI(tt))); hr = nr; hi = ni;
                HL[tt * 68 + lane] = cvt_pk_bf16(hr, hi);
                if ((tt & 3) == 3) { const size_t o = (size_t)((4 * item + (tt >> 2)) * 16 + g) * 64 + lane; a.out[O_SRES + o] = hr; a.out[O_SIMS + o] = hi; }
            }
            LDS_WAIT(); asm volatile("" ::: "memory");
            f32x4 y = {0.f, 0.f, 0.f, 0.f};
#pragma unroll
            for (int s4 = 0; s4 < 4; ++s4) { const bf16x8 hf = *(const LAS bf16x8*)((LAS unsigned short*)HL + t16 * 136 + 32 * s4 + 8 * q4); y = __builtin_amdgcn_mfma_f32_16x16x32_bf16(cf[s4], hf, y, 0, 0, 0); }
            f32x4 z;
#pragma unroll
            for (int e = 0; e < 4; ++e) z[e] = gelu_tanh(y[e] + dv[e] * uv[e]);
            *(LAS f32x4*)(ZS + (64 + t16) * 260 + g * 16 + 4 * q4) = z;
            LDS_WAIT(); asm volatile("" ::: "memory");
        }
    }
    const int n = lane & 31, hi5 = lane >> 5, n0 = 32 * wave, nmt = hs ? 3 : 2;
    bf16x8 bfr[16];
#pragma unroll
    for (int st = 0; st < 16; ++st) bfr[st] = *(const bf16x8*)(WGLU + (size_t)(n0 + n) * 256 + 16 * st + 8 * hi5);
    const float bias = a.in[I_BGLU][n0 + n];
    const f32x4 gn = *(const f32x4*)(a.in[I_SON] + 4 * lane);
    __syncthreads();
    f32x16 acc[3];
#pragma unroll
    for (int mt = 0; mt < 3; ++mt) acc[mt] = (f32x16){0.f, 0.f, 0.f, 0.f, 0.f, 0.f, 0.f, 0.f, 0.f, 0.f, 0.f, 0.f, 0.f, 0.f, 0.f, 0.f};
#pragma unroll
    for (int st = 0; st < 16; ++st) {
        const bf16x8 bf = bfr[st];
#pragma unroll
        for (int mt = 0; mt < 3; ++mt) { if (mt < nmt) { const LAS float* zp = ZS + (32 * mt + n) * 260 + 16 * st + 8 * hi5; const f32x4 x = *(const LAS f32x4*)zp, y = *(const LAS f32x4*)(zp + 4);
            acc[mt] = __builtin_amdgcn_mfma_f32_32x32x16_bf16(pack8(x[0], x[1], x[2], x[3], y[0], y[1], y[2], y[3]), bf, acc[mt], 0, 0, 0); } }
    }
    float so[3][16];
#pragma unroll
    for (int mt = 0; mt < 3; ++mt) { if (mt < nmt) {
#pragma unroll
        for (int r = 0; r < 16; ++r) { const int t = 32 * mt + (r & 3) + 8 * (r >> 2) + 4 * hi5; so[mt][r] = ZS[t * 260 + n0 + n] * sigmoidf_(acc[mt][r] + bias); } } }
    __syncthreads();
#pragma unroll
    for (int mt = 0; mt < 3; ++mt) { if (mt < nmt) {
#pragma unroll
        for (int r = 0; r < 16; ++r) { const int t = 32 * mt + (r & 3) + 8 * (r >> 2) + 4 * hi5; ZS[t * 260 + n0 + n] = so[mt][r]; } } }
    __syncthreads();
#pragma unroll
    for (int i = 0; i < 10; ++i) { if (i >= 8 && !hs) break;
        const int row = i < 8 ? 8 * wave + i : 64 + 2 * wave + (i - 8); const f32x4 v = *(const LAS f32x4*)(ZS + row * 260 + 4 * lane);
        const float rs = frsq(wave_sum(dot4(v)) * (1.0f / 256.0f) + EPS); const f32x4 y = v * rs * gn;
        const size_t orow = i < 8 ? (size_t)(R0 + row) : (size_t)(RS0 + row - 64);
        u32x2 w; w.x = cvt_pk_bf16(y[0], y[1]); w.y = cvt_pk_bf16(y[2], y[3]); *(u32x2*)(MIXED + orow * D + 768 + 4 * lane) = w; }
    __syncthreads();
}

__device__ __forceinline__ float xq_sigma(const float* RS1, const float* QS, int R, int h) {
    const float rstd = frsq(RS1[R] * (1.0f / 1024.0f) + EPS), msq = QS[(size_t)R * 4 + h] * (1.0f / 256.0f);
    return rstd / sqrtf(rstd * rstd * msq + EPS) * (0.0625f * LOG2E);
}
template <int MODE, bool BASE_BF16 = false> __device__ __forceinline__ void sample_gemm_tile(const bf16* A, const bf16* Bt, int K, const void* base, float* outp, bf16* hb, float* ssq, LAS unsigned char* lds, int tile, int wave, int lane, int tid) {
    const int tm = tile >> 5, tn = tile & 31, n = lane & 31, hi = lane >> 5, kw = K >> 3;
    const bf16* ap = A + (size_t)(64 * tm + n) * K + wave * kw + 8 * hi;
    const bf16* bp = Bt + (size_t)(32 * tn + n) * K + wave * kw + 8 * hi;
    f32x16 acc0 = {0.f, 0.f, 0.f, 0.f, 0.f, 0.f, 0.f, 0.f, 0.f, 0.f, 0.f, 0.f, 0.f, 0.f, 0.f, 0.f}, acc1 = acc0;
    const int row = tid >> 3, c4 = (tid & 7) * 4, rs = 64 * tm + row, col = 32 * tn + c4;
    f32x4 bs = {0.f, 0.f, 0.f, 0.f};
    if (MODE == 0) {
        if (BASE_BF16) { const u32x2 w = *(const u32x2*)((const bf16*)base + (size_t)rs * D + col); bs = (f32x4){bf2f(w.x & 0xffffu), bf2f(w.x >> 16), bf2f(w.y & 0xffffu), bf2f(w.y >> 16)}; }
        else bs = *(const f32x4*)((const float*)base + (size_t)rs * D + col); }
#pragma unroll 8
    for (int s = 0; s < kw; s += 16) { const bf16x8 a0 = *(const bf16x8*)(ap + s), a1 = *(const bf16x8*)(ap + (size_t)32 * K + s), bb = *(const bf16x8*)(bp + s);
        acc0 = __builtin_amdgcn_mfma_f32_32x32x16_bf16(a0, bb, acc0, 0, 0, 0); acc1 = __builtin_amdgcn_mfma_f32_32x32x16_bf16(a1, bb, acc1, 0, 0, 0); }
    LAS float* P = (LAS float*)lds;
#pragma unroll
    for (int r = 0; r < 16; ++r) { const int row = (r & 3) + 8 * (r >> 2) + 4 * hi; P[(wave * 64 + row) * 32 + n] = acc0[r]; P[(wave * 64 + 32 + row) * 32 + n] = acc1[r]; }
    __syncthreads();
    f32x4 v = {0.f, 0.f, 0.f, 0.f};
#pragma unroll
    for (int w = 0; w < 8; ++w) v = v + *(const LAS f32x4*)(P + (w * 64 + row) * 32 + c4);
    float s;
    if (MODE == 0) {
        const f32x4 o = bs + v; if (outp) *(f32x4*)(outp + (size_t)rs * D + col) = o;
        if (hb) { u32x2 w; w.x = cvt_pk_bf16(o[0], o[1]); w.y = cvt_pk_bf16(o[2], o[3]); *(u32x2*)(hb + (size_t)rs * D + col) = w; }
        s = dot4(o); }
    else { u32x2 w; w.x = cvt_pk_bf16(v[0], v[1]); w.y = cvt_pk_bf16(v[2], v[3]); *(u32x2*)(hb + (size_t)rs * D + col) = w; s = dot4(v); }
    if (ssq) { s += __shfl_xor(s, 1); s += __shfl_xor(s, 2); s += __shfl_xor(s, 4); if ((tid & 7) == 0) atomic_addf(MODE == 0 ? ssq + rs : ssq + (size_t)rs * 4 + (tn >> 3), s); }
    __syncthreads();
}
constexpr int XK_ROW = 272, XK_BUF = 32 * XK_ROW, XV_BUF = XK_BUF, XV_OFF = 2 * XK_BUF;
__device__ __forceinline__ void xattn_wg_item(const bf16* QX, const float* SS1, const float* QSS, const bf16* MEMK, const bf16* MVT, bf16* OX, LAS unsigned char* lds, int it, int wave, int lane, int tid) {
    const int qb = it & 7, h = (it >> 3) & 3, b = it >> 5;
    const int n = lane & 31, hi = lane >> 5, R = b * 2048 + 256 * qb + 32 * wave + n;
    const float sigma = xq_sigma(SS1, QSS, R, h);
    const bf16* kg = MEMK + (size_t)(b * 256 + (tid >> 4)) * 1024 + h * 256 + 128 * ((tid >> 3) & 1) + 8 * (tid & 7);
    const bf16* vg = MVT + (size_t)(b * 256 + (tid >> 4)) * 1024 + h * 256 + 8 * (tid & 15);
    LAS unsigned char* kl = lds + (tid >> 4) * XK_ROW + (tid & 15) * 16;
    LAS unsigned char* vl = lds + XV_OFF + (tid >> 4) * XK_ROW + (tid & 15) * 16;
#define XSRC(t) ((t) < 16 ? (const u32x4*)(kg + (size_t)((t) & 7) * 32 * 1024 + ((t) >> 3) * 64) : (const u32x4*)(vg + (size_t)(((t) - 16) & 7) * 32 * 1024 + (((t) - 16) >> 3) * 128))
#define XPUT(t, w_) do { if ((t) < 16) *(LAS u32x4*)(kl + ((t) & 1) * XK_BUF) = (w_); else *(LAS u32x4*)(vl + ((t) & 1) * XV_BUF) = (w_); } while (0)
    u32x4 ring[3]; ring[0] = *XSRC(0); ring[1] = *XSRC(1); ring[2] = *XSRC(2);
    f32x16 sc[8];
#pragma unroll
    for (int kt = 0; kt < 8; ++kt) sc[kt] = (f32x16){0.f, 0.f, 0.f, 0.f, 0.f, 0.f, 0.f, 0.f, 0.f, 0.f, 0.f, 0.f, 0.f, 0.f, 0.f, 0.f};
    XPUT(0, ring[0]);
    __syncthreads();
    const LAS unsigned char* kr = lds + pi23(n) * XK_ROW + 128 * hi;
#pragma unroll
    for (int dh = 0; dh < 2; ++dh) {
        bf16x8 qf[8];
        { const bf16* qp = QX + (size_t)R * D + h * 256 + 128 * hi + 64 * dh;
#pragma unroll
          for (int st = 0; st < 8; ++st) qf[st] = *(const bf16x8*)(qp + 8 * st); }
#pragma unroll
        for (int kt = 0; kt < 8; ++kt) {
            const int s = dh * 8 + kt;
            ring[s % 3] = *XSRC(s + 3);
            const LAS unsigned char* kp = kr + (s & 1) * XK_BUF;
            bf16x8 kf[8];
#pragma unroll
            for (int st = 0; st < 8; ++st) kf[st] = *(const LAS bf16x8*)(kp + 16 * st);
            __builtin_amdgcn_sched_barrier(0);
#pragma unroll
            for (int st = 0; st < 8; ++st) sc[kt] = __builtin_amdgcn_mfma_f32_32x32x16_bf16(kf[st], qf[st], sc[kt], 0, 0, 0);
            XPUT(s + 1, ring[(s + 1) % 3]);
            asm volatile("s_waitcnt lgkmcnt(0)\n\ts_barrier" ::: "memory");
        }
    }
    float mx = -1e30f;
#pragma unroll
    for (int kt = 0; kt < 8; ++kt)
#pragma unroll
        for (int r = 0; r < 16; ++r) { sc[kt][r] *= sigma; mx = fmaxf(mx, sc[kt][r]); }
    mx = fmaxf(mx, __shfl_xor(mx, 32));
    float l = 0.f;
#pragma unroll
    for (int kt = 0; kt < 8; ++kt)
#pragma unroll
        for (int r = 0; r < 16; ++r) { const float p = fexp2(sc[kt][r] - mx); sc[kt][r] = p; l += p; }
    l += __shfl_xor(l, 32);
    const float il = frcp(l);
    bf16x8 pb[8][2];
#pragma unroll
    for (int kt = 0; kt < 8; ++kt)
#pragma unroll
        for (int jj = 0; jj < 2; ++jj) pb[kt][jj] = pack8(sc[kt][8 * jj + 0], sc[kt][8 * jj + 1], sc[kt][8 * jj + 2], sc[kt][8 * jj + 3], sc[kt][8 * jj + 4], sc[kt][8 * jj + 5], sc[kt][8 * jj + 6], sc[kt][8 * jj + 7]);
    LAS unsigned char* vr = lds + XV_OFF + (8 * hi + ((lane >> 2) & 3)) * XK_ROW + (16 * ((lane >> 4) & 1) + 4 * (lane & 3)) * 2;
    bf16* op = OX + (size_t)R * D + h * 256 + 4 * hi;
#pragma unroll
    for (int dh = 0; dh < 2; ++dh) {
        f32x16 o[4];
#pragma unroll
        for (int dt = 0; dt < 4; ++dt) o[dt] = (f32x16){0.f, 0.f, 0.f, 0.f, 0.f, 0.f, 0.f, 0.f, 0.f, 0.f, 0.f, 0.f, 0.f, 0.f, 0.f, 0.f};
#pragma unroll
        for (int kt = 0; kt < 8; ++kt) {
            const int s = 16 + dh * 8 + kt;
            if (s + 3 < 32) ring[s % 3] = *XSRC(s + 3);
            LAS unsigned char* vp = vr + (s & 1) * XV_BUF;
            bf16x8 vf[4][2];
#pragma unroll
            for (int dt = 0; dt < 4; ++dt)
#pragma unroll
                for (int jj = 0; jj < 2; ++jj) vf[dt][jj] = cat44(lds_tr4(vp + (16 * jj) * XK_ROW + 64 * dt), lds_tr4(vp + (16 * jj + 4) * XK_ROW + 64 * dt));
            __builtin_amdgcn_sched_barrier(0);
#pragma unroll
            for (int jj = 0; jj < 2; ++jj)
#pragma unroll
                for (int dt = 0; dt < 4; ++dt) o[dt] = __builtin_amdgcn_mfma_f32_32x32x16_bf16(vf[dt][jj], pb[kt][jj], o[dt], 0, 0, 0);
            if (s + 1 < 32) XPUT(s + 1, ring[(s + 1) % 3]);
            asm volatile("s_waitcnt lgkmcnt(0)\n\ts_barrier" ::: "memory");
        }
#pragma unroll
        for (int dt = 0; dt < 4; ++dt)
#pragma unroll
            for (int r4 = 0; r4 < 4; ++r4) { u32x2 w; w.x = cvt_pk_bf16(o[dt][4 * r4] * il, o[dt][4 * r4 + 1] * il); w.y = cvt_pk_bf16(o[dt][4 * r4 + 2] * il, o[dt][4 * r4 + 3] * il);
                *(u32x2*)(op + 128 * dh + 32 * dt + 8 * r4) = w; }
    }
}
#undef XSRC
#undef XPUT
constexpr int SXB = 4;
struct SxBatch { f32x4 k[SXB], v[SXB]; };
__device__ __forceinline__ void sx_load(SxBatch& B, const float* kb, unsigned loff, int j0) {
#pragma unroll
    for (int j = 0; j < SXB; ++j) { const char* p = (const char*)(kb + (size_t)(j0 + j) * 2048); B.k[j] = __builtin_nontemporal_load((const f32x4*)(p + loff)); B.v[j] = __builtin_nontemporal_load((const f32x4*)(p + 4096 + loff)); }
}
__device__ __forceinline__ float rdl(float v, int l) { return __builtin_bit_cast(float, __builtin_amdgcn_readlane(__builtin_bit_cast(int, v), l)); }
__device__ __forceinline__ void sx_compute(const SxBatch& B, const f32x4 (&q)[4], bool b5, bool b4, float& m, float& l, f32x4 (&o)[4]) {
    float s[SXB]; float mb = m;
#pragma unroll
    for (int j = 0; j < SXB; ++j) {
        float d[4];
#pragma unroll
        for (int t = 0; t < 4; ++t) d[t] = (q[t][0] * B.k[j][0] + q[t][1] * B.k[j][1]) + (q[t][2] * B.k[j][2] + q[t][3] * B.k[j][3]);
        const float x0 = b5 ? d[0] : d[2], x1 = b5 ? d[1] : d[3], k0 = b5 ? d[2] : d[0], k1 = b5 ? d[3] : d[1];
        const float r0 = k0 + __shfl_xor(x0, 32), r1 = k1 + __shfl_xor(x1, 32);
        const float xs = b4 ? r0 : r1, ks = b4 ? r1 : r0;
        float r = ks + __shfl_xor(xs, 16);
        r += __shfl_xor(r, 8); r += __shfl_xor(r, 4); r += __shfl_xor(r, 2); r += __shfl_xor(r, 1);
        s[j] = r; mb = fmaxf(mb, r);
    }
    const float sc = fexp2(m - mb); m = mb; l *= sc;
#pragma unroll
    for (int t = 0; t < 4; ++t) o[t] = o[t] * rdl(sc, 16 * t);
#pragma unroll
    for (int j = 0; j < SXB; ++j) { const float p = fexp2(s[j] - mb); l += p;
#pragma unroll
        for (int t = 0; t < 4; ++t) o[t] = o[t] + B.v[j] * rdl(p, 16 * t); }
}
template <int NSW> __device__ __forceinline__ void sxattn_stream(const Args& a, const bf16* QX, const float* SS1S, const float* QSSS, bf16* OX, LAS unsigned char* lds, LAS unsigned* cnt, int pair, int slot, int sw, int lane) {
    const int b = pair >> 2, h = pair & 3;
    LAS float* OL = (LAS float*)lds + (size_t)slot * (NSW * 1024); LAS float* ML = (LAS float*)(lds + 65536) + slot * 32; LAS float* LL = (LAS float*)(lds + 65536 + 256) + slot * 32;
    const f32x4 gq = *(const f32x4*)(a.in[I_XQN] + 4 * lane);
    f32x4 q[4];
    const float sgc = xq_sigma(SS1S, QSSS, MP + 4 * b + (lane >> 4), h);
#pragma unroll
    for (int t = 0; t < 4; ++t) { const int R = MP + 4 * b + t; const float sg = rdl(sgc, 16 * t); const u32x2 w = *(const u32x2*)(QX + (size_t)R * D + h * 256 + 4 * lane);
        q[t] = (f32x4){bf2f(w.x & 0xffffu), bf2f(w.x >> 16), bf2f(w.y & 0xffffu), bf2f(w.y >> 16)} * gq * sg; }
    constexpr int NK = 256 / NSW;
    const float* kb = a.in[I_CMEM] + ((size_t)(b * 256 + NK * sw) * 2) * 1024 + h * 256; const unsigned loff = 16u * (unsigned)lane;
    const bool b5 = (lane & 32) != 0, b4 = (lane & 16) != 0;
    float m = -1e30f, l = 0.f;
    f32x4 o[4];
#pragma unroll
    for (int t = 0; t < 4; ++t) o[t] = (f32x4){0.f, 0.f, 0.f, 0.f};
    SxBatch A, B; sx_load(A, kb, loff, 0);
#pragma unroll 1
    for (int j0 = 0; j0 < NK; j0 += 2 * SXB) {
        sx_load(B, kb, loff, j0 + SXB);
        sx_compute(A, q, b5, b4, m, l, o);
        if (j0 + 2 * SXB < NK) sx_load(A, kb, loff, j0 + 2 * SXB);
        sx_compute(B, q, b5, b4, m, l, o);
    }
#pragma unroll
    for (int t = 0; t < 4; ++t) *(LAS f32x4*)(OL + (sw * 4 + t) * 256 + 4 * lane) = o[t];
    if ((lane & 15) == 0) { ML[sw * 4 + (lane >> 4)] = m; LL[sw * 4 + (lane >> 4)] = l; }
    asm volatile("s_waitcnt lgkmcnt(0)" ::: "memory");
    unsigned old = 0u; if (lane == 0) old = __hip_atomic_fetch_add(cnt, 1u, __ATOMIC_ACQ_REL, __HIP_MEMORY_SCOPE_WORKGROUP);
    old = __builtin_amdgcn_readfirstlane(old);
    if (old == (unsigned)(NSW - 1)) {
        asm volatile("s_waitcnt lgkmcnt(0)" ::: "memory");
#pragma unroll
        for (int t = 0; t < 4; ++t) {
            float M = -1e30f;
#pragma unroll
            for (int w = 0; w < NSW; ++w) M = fmaxf(M, ML[w * 4 + t]);
            float L = 0.f; f32x4 acc = {0.f, 0.f, 0.f, 0.f};
#pragma unroll
            for (int w = 0; w < NSW; ++w) { const float f = fexp2(ML[w * 4 + t] - M); L += LL[w * 4 + t] * f; acc = acc + *(const LAS f32x4*)(OL + (w * 4 + t) * 256 + 4 * lane) * f; }
            const float il = frcp(L); u32x2 wv; wv.x = cvt_pk_bf16(acc[0] * il, acc[1] * il); wv.y = cvt_pk_bf16(acc[2] * il, acc[3] * il);
            *(u32x2*)(OX + (size_t)(MP + 4 * b + t) * D + h * 256 + 4 * lane) = wv;
        }
    }
}

__device__ __forceinline__ void up8(const bf16* p, float (&v)[8]) { const u32x4 w = *(const u32x4*)p;
    v[0] = bf2f(w.x & 0xffffu); v[1] = bf2f(w.x >> 16); v[2] = bf2f(w.y & 0xffffu); v[3] = bf2f(w.y >> 16); v[4] = bf2f(w.z & 0xffffu); v[5] = bf2f(w.z >> 16); v[6] = bf2f(w.w & 0xffffu); v[7] = bf2f(w.w >> 16); }
__device__ __forceinline__ void ld8(const float* p, float (&v)[8]) { const f32x4 a = *(const f32x4*)p, b = *(const f32x4*)(p + 4); v[0] = a[0]; v[1] = a[1]; v[2] = a[2]; v[3] = a[3]; v[4] = b[0]; v[5] = b[1]; v[6] = b[2]; v[7] = b[3]; }
__device__ __forceinline__ void conv_item(const Args& a, const bf16* UP, bf16* ACT, int it) {
    const int cgp = it % 352, rc = it / 352, j0 = cgp * 8, R0 = rc * 32;
    const float* cw = a.in[I_CONVW]; const float* cbp = a.in[I_CONVB];
    float wg[3][8], wv[3][8], bg[8], bv[8];
#pragma unroll
    for (int i = 0; i < 3; ++i) { ld8(cw + (size_t)i * FF2 + j0, wg[i]); ld8(cw + (size_t)i * FF2 + FF + j0, wv[i]); }
    ld8(cbp + j0, bg); ld8(cbp + FF + j0, bv);
    float g2[8], g1[8], v2[8], v1[8];
    const bool sample = R0 >= MP;
    if (!sample && (R0 & 2047) != 0) { up8(UP + (size_t)(R0 - 2) * FF2 + j0, g2); up8(UP + (size_t)(R0 - 1) * FF2 + j0, g1); up8(UP + (size_t)(R0 - 2) * FF2 + FF + j0, v2); up8(UP + (size_t)(R0 - 1) * FF2 + FF + j0, v1); }
    else {
#pragma unroll
        for (int e = 0; e < 8; ++e) { g2[e] = 0.f; g1[e] = 0.f; v2[e] = 0.f; v1[e] = 0.f; } }
    for (int r = 0; r < 32; ++r) { const int R = R0 + r;
        if (sample && (r & 3) == 0) { const float* sb = a.in[I_SCONV] + (size_t)((R - MP) >> 2) * 2 * FF2; ld8(sb + j0, g2); ld8(sb + FF2 + j0, g1); ld8(sb + FF + j0, v2); ld8(sb + FF2 + FF + j0, v1); }
        float gc[8], vc[8]; up8(UP + (size_t)R * FF2 + j0, gc); up8(UP + (size_t)R * FF2 + FF + j0, vc);
        float o[8];
#pragma unroll
        for (int e = 0; e < 8; ++e) { const float cgv = bg[e] + wg[0][e] * g2[e] + wg[1][e] * g1[e] + wg[2][e] * gc[e]; const float cvv = bv[e] + wv[0][e] * v2[e] + wv[1][e] * v1[e] + wv[2][e] * vc[e];
            o[e] = cgv * sigmoidf_(cgv) * cvv; g2[e] = g1[e]; g1[e] = gc[e]; v2[e] = v1[e]; v1[e] = vc[e]; }
        u32x4 w; w.x = cvt_pk_bf16(o[0], o[1]); w.y = cvt_pk_bf16(o[2], o[3]); w.z = cvt_pk_bf16(o[4], o[5]); w.w = cvt_pk_bf16(o[6], o[7]);
        *(u32x4*)(ACT + (size_t)R * FF + j0) = w;
    }
}

__device__ __forceinline__ void conv_fix_item(const Args& a, const float* EDGE, bf16* ACT, int it) {
    const int cgp = it % 352, rr = it / 352, r = rr & 1, ti = rr >> 1;
    const int pm = 8 * (ti / 7) + 1 + ti % 7, j0 = cgp * 8;
    const float* cw = a.in[I_CONVW]; const float* cbp = a.in[I_CONVB];
    const float* e_prev = EDGE + (size_t)(pm - 1) * 4 * FF2; const float* e_cur = EDGE + (size_t)pm * 4 * FF2;
    const float* r2 = r == 0 ? e_prev + 2 * FF2 : e_prev + 3 * FF2; const float* r1 = r == 0 ? e_prev + 3 * FF2 : e_cur; const float* r0 = r == 0 ? e_cur : e_cur + FF2;
    float o[8];
#pragma unroll
    for (int hf = 0; hf < 2; ++hf) { const int j4 = j0 + 4 * hf;
        const f32x4 cg = *(const f32x4*)(cbp + j4) + *(const f32x4*)(cw + j4) * *(const f32x4*)(r2 + j4) + *(const f32x4*)(cw + FF2 + j4) * *(const f32x4*)(r1 + j4) + *(const f32x4*)(cw + 2 * FF2 + j4) * *(const f32x4*)(r0 + j4);
        const f32x4 cv = *(const f32x4*)(cbp + FF + j4) + *(const f32x4*)(cw + FF + j4) * *(const f32x4*)(r2 + FF + j4) + *(const f32x4*)(cw + FF2 + FF + j4) * *(const f32x4*)(r1 + FF + j4) + *(const f32x4*)(cw + 2 * FF2 + FF + j4) * *(const f32x4*)(r0 + FF + j4);
#pragma unroll
        for (int e = 0; e < 4; ++e) o[4 * hf + e] = cg[e] * sigmoidf_(cg[e]) * cv[e]; }
    u32x4 w; w.x = cvt_pk_bf16(o[0], o[1]); w.y = cvt_pk_bf16(o[2], o[3]); w.z = cvt_pk_bf16(o[4], o[5]); w.w = cvt_pk_bf16(o[6], o[7]);
    *(u32x4*)(ACT + (size_t)(pm * 256 + r) * FF + j0) = w;
}

__device__ __forceinline__ void conv_fix_tile(const Args& a, const float* EDGE, bf16* ACT, int pm, int tid) {
    const float* cw = a.in[I_CONVW]; const float* cbp = a.in[I_CONVB];
    const float* e_prev = EDGE + (size_t)(pm - 1) * 4 * FF2; const float* e_cur = EDGE + (size_t)pm * 4 * FF2;
    for (int it = tid; it < 2 * 352; it += NWAVES * 64) { const int r = it / 352, j0 = (it - r * 352) * 8;
        const float* r2 = r == 0 ? e_prev + 2 * FF2 : e_prev + 3 * FF2; const float* r1 = r == 0 ? e_prev + 3 * FF2 : e_cur; const float* r0 = r == 0 ? e_cur : e_cur + FF2;
        float o[8];
#pragma unroll
        for (int hf = 0; hf < 2; ++hf) { const int j4 = j0 + 4 * hf;
            const f32x4 cg = *(const f32x4*)(cbp + j4) + *(const f32x4*)(cw + j4) * *(const f32x4*)(r2 + j4) + *(const f32x4*)(cw + FF2 + j4) * *(const f32x4*)(r1 + j4) + *(const f32x4*)(cw + 2 * FF2 + j4) * *(const f32x4*)(r0 + j4);
            const f32x4 cv = *(const f32x4*)(cbp + FF + j4) + *(const f32x4*)(cw + FF + j4) * *(const f32x4*)(r2 + FF + j4) + *(const f32x4*)(cw + FF2 + FF + j4) * *(const f32x4*)(r1 + FF + j4) + *(const f32x4*)(cw + 2 * FF2 + FF + j4) * *(const f32x4*)(r0 + FF + j4);
#pragma unroll
            for (int e = 0; e < 4; ++e) o[4 * hf + e] = cg[e] * sigmoidf_(cg[e]) * cv[e]; }
        u32x4 w; w.x = cvt_pk_bf16(o[0], o[1]); w.y = cvt_pk_bf16(o[2], o[3]); w.z = cvt_pk_bf16(o[4], o[5]); w.w = cvt_pk_bf16(o[6], o[7]);
        *(u32x4*)(ACT + (size_t)(pm * 256 + r) * FF + j0) = w; }
}

#ifndef MK_N_LAUNCHES
#define MK_N_LAUNCHES 1
#endif
constexpr int N_PHASES = 11;
#ifndef DUP_PHASE
#define DUP_PHASE -1
#endif
#define NREP(k) ((DUP_PHASE) == (k) ? 2 : 1)
constexpr int N_LAUNCHES = MK_N_LAUNCHES;
static_assert(N_LAUNCHES == 1 || N_LAUNCHES == N_PHASES, "MK_N_LAUNCHES is 1 or 11");

__global__ void __launch_bounds__(NWAVES * 64, 2) fwd_kernel(Args args) {
    extern __shared__ __attribute__((aligned(16))) unsigned char lds_raw[];
    LAS unsigned char* lds = (LAS unsigned char*)lds_raw;
    volatile LAS unsigned* MISC = (volatile LAS unsigned*)(lds + MISC_OFF);
    const int tid0 = threadIdx.x, wave0 = __builtin_amdgcn_readfirstlane(tid0 >> 6);
    const int G = gridDim.x; const int bx = blockIdx.x; const int vcu = (G % 8 == 0) ? (bx % 8) * (G / 8) + bx / 8 : bx;
    const int NGW = G * NWAVES;
    unsigned char* ws = args.ws;
    gu32* ctl = (gu32*)(ws + WS_CTL);
    for (int u = tid0; u < 128; u += NWAVES * 64) ((LAS unsigned*)(lds + MISC_OFF))[u] = 0u;
    __syncthreads();
    XcdBarrier bar; bar.bar = (unsigned*)(ctl + CW_BAR); bar.x = 0; bar.st = nullptr;
    if (N_LAUNCHES == 1) bar = xcd_barrier_post((unsigned*)(ctl + CW_BAR) + args.li * XCD_BAR_WORDS, MISC + 8);
#ifdef DOUBLE_BAR
#define GRID_BAR() do { if (N_LAUNCHES == 1) { xcd_barrier(bar); xcd_barrier(bar); } } while (0)
#else
#define GRID_BAR() do { if (N_LAUNCHES == 1) xcd_barrier(bar); } while (0)
#endif
    const int lo = args.ph_lo, hi = args.ph_hi;
#define IN(k) (lo <= (k) && (k) < hi)
#define WSBASE() GAS unsigned char* wsl = (GAS unsigned char*)ws; asm volatile("" : "+s"(wsl));     int tid = threadIdx.x; asm volatile("" : "+v"(tid)); const int lane = tid & 63, wave = __builtin_amdgcn_readfirstlane(tid >> 6), gw = vcu * NWAVES + wave; (void)lane; (void)gw
#define ROPE_ ((float*)(wsl + WS_ROPE))
#define SSMC_ ((float*)(wsl + WS_SSMC))
#define WIN ((bf16*)(wsl + WS_WIN))
#define WOUT ((bf16*)(wsl + WS_WOUT))
#define WXQ ((bf16*)(wsl + WS_WXQ))
#define WXKV ((bf16*)(wsl + WS_WXKV))
#define WXO ((bf16*)(wsl + WS_WXO))
#define WUP ((bf16*)(wsl + WS_WUP))
#define WDOWN ((bf16*)(wsl + WS_WDOWN))
#define WGLU ((bf16*)(wsl + WS_WGLU))
#define XN ((bf16*)(wsl + WS_XN))
#define MEMN ((bf16*)(wsl + WS_MEMN))
#define Qb ((bf16*)(wsl + WS_Q))
#define Kb ((bf16*)(wsl + WS_K))
#define VT ((bf16*)(wsl + WS_VT))
#define U_ ((float*)(wsl + WS_U))
#define AO ((bf16*)(wsl + WS_AO))
#define LSE ((float*)(wsl + WS_LSE))
#define SSMF ((float*)(wsl + WS_SSMF))
#define MIXED ((bf16*)(wsl + WS_MIXED))
#define H1B ((bf16*)(wsl + WS_H1B))
#define SS1 ((float*)(wsl + WS_CTL + CTL_RS1))
#define QX ((bf16*)(wsl + WS_QX))
#define QSS ((float*)(wsl + WS_CTL + CTL_QS))
#define MSS ((float*)(wsl + WS_MSS))
#define MEMK ((bf16*)(wsl + WS_MEMK))
#define MVT ((bf16*)(wsl + WS_MVT))
#define OX ((bf16*)(wsl + WS_OX))
#define H2B ((bf16*)(wsl + WS_H2B))
#define SS2 ((float*)(wsl + WS_CTL + CTL_RS2))
#define UP ((bf16*)(wsl + WS_UP))
#define ACT ((bf16*)(wsl + WS_ACT))
#define SS1S (SS1 + MP)
#define QSSS (QSS + (size_t)MP * 4)
#define SS2S (SS2 + MP)
    float* out = args.out;

    if (IN(0)) for (int rep_ = 0; rep_ < NREP(0); ++rep_) { WSBASE();
        LAS float* scr = (LAS float*)(lds + wave * 16384);
        constexpr int I_IN = 16 * (INW / 32), I_SQ = 16 * (D / 32), I_KV = 16 * (2048 / 32), I_UP = 16 * (FF2 / 32), I_DN = (FF / 64) * (D / 32), I_GL = 4 * 8;
        constexpr int NIT = I_IN + 3 * I_SQ + I_KV + I_GL; (void)I_UP; (void)I_DN;
        for (int it = gw; it < NIT; it += NGW) {
            int r = it;
            if (r < I_IN) { p0_transpose_item<1>(args.in[I_WIN], D, INW, WIN, nullptr, scr, r, lane); continue; } r -= I_IN;
            if (r < I_SQ) { p0_transpose_item<0>(args.in[I_WOUT], D, D, WOUT, nullptr, scr, r, lane); continue; } r -= I_SQ;
            if (r < I_SQ) { p0_transpose_item<0>(args.in[I_WXQ], D, D, WXQ, args.in[I_NX], scr, r, lane); continue; } r -= I_SQ;
            if (r < I_SQ) { p0_transpose_item<0>(args.in[I_WXO], D, D, WXO, nullptr, scr, r, lane); continue; } r -= I_SQ;
            if (r < I_KV) { p0_transpose_item<0>(args.in[I_WXKV], D, 2048, WXKV, nullptr, scr, r, lane); continue; } r -= I_KV;
            p0_transpose_item<0>(args.in[I_WGLU], 256, 256, WGLU, nullptr, scr, r, lane);
        }
        { f32x4 gg[4];
#pragma unroll
          for (int j = 0; j < 4; ++j) gg[j] = ((const f32x4*)args.in[I_NMIX])[lane + 64 * j];
          for (int m = 2 * gw; m < MT; m += 2 * NGW) { const float* x0 = m < MP ? args.in[I_XP] + (size_t)m * D : args.in[I_XS] + (size_t)(m - MP) * D;
              rms_rows2_to_bf16(x0, x0 + D, gg, XN + (size_t)m * D, XN + (size_t)(m + 1) * D, lane); }
#pragma unroll
          for (int j = 0; j < 4; ++j) gg[j] = ((const f32x4*)args.in[I_NMEM])[lane + 64 * j];
          for (int m = 2 * gw; m < MM; m += 2 * NGW) rms_rows2_to_bf16(args.in[I_MEM] + (size_t)m * D, args.in[I_MEM] + (size_t)(m + 1) * D, gg, MEMN + (size_t)m * D, MEMN + (size_t)(m + 1) * D, lane); }
        {
            const int gt = vcu * (NWAVES * 64) + tid;
            if (gt < 2052 * 8) { const int pos = gt >> 3, i = gt & 7; const float iv = i == 0 ? 1.0f : i == 1 ? 0.1939227432012558f : i == 2 ? 0.03760603070259094f : i == 3 ? 0.007292664609849453f : i == 4 ? 0.0014142135623842478f : i == 5 ? 0.00027424818836152554f : i == 6 ? 5.3182957344688475e-05f : 1.0313385246263351e-05f;
                const float ang = (float)pos * iv; double s, c; sincos_d((double)ang, s, c); ROPE_[pos * 16 + i] = (float)c; ROPE_[pos * 16 + 8 + i] = (float)s; }
            const int st = gt - 2052 * 8;
            if (st >= 0 && st < 1024) {
                const int g = st >> 6; const double dt = exp_d((double)args.in[I_LDT][g]); const double lr = (double)args.in[I_LRE][st], li = (double)args.in[I_LIM][st];
                const double mag = exp_d(lr * dt); double s, c; sincos_d(li * dt, s, c); const double are = mag * c, aim = mag * s;
                const double den = lr * lr + li * li, nr = are - 1.0, ni = aim; const double cre = (nr * lr + ni * li) / den, cim = (ni * lr - nr * li) / den;
                const double mag64 = exp_d(64.0 * lr * dt); double s64, c64; sincos_d(64.0 * li * dt, s64, c64);
                float* o = SSMC_ + (size_t)st * 8; o[0] = (float)are; o[1] = (float)aim; o[2] = (float)cre; o[3] = (float)cim; o[4] = (float)(mag64 * c64); o[5] = (float)(mag64 * s64); o[6] = 0.f; o[7] = 0.f; }
        }
        GRID_BAR();
    }

    if (IN(1)) for (int rep_ = 0; rep_ < NREP(1); ++rep_) { WSBASE();
        int base = 0;
        { pg8::Gemm g{XN, WIN, MT, INW, D}; pg8::RotOrder S; S.init(MT, INW, G, bx, base); base += S.nwg;
          pg8::EpiZ E{Qb, Kb, VT, U_, ROPE_, args.in[I_QN], args.in[I_KN], out};
          pg8::gemm_phase<pg8::EpiZ, pg8::RotOrder, true, true>(lds, g, S, E); }
        { pg8::Gemm g{MEMN, WXKV, MM, 2048, D}; pg8::RotOrder S; S.init(MM, 2048, G, bx, base); base += S.nwg;
          pg8::EpiMem E{out + O_MEMKV, MSS, MVT}; pg8::gemm_phase<pg8::EpiMem, pg8::RotOrder, true, true>(lds, g, S, E); }
        {
            constexpr int I_UP = 16 * (FF2 / 32);
            const int first = base % G, nidle = G - first;
            if (bx >= first) {
                __syncthreads();
                LAS float* scr = (LAS float*)(lds + wave * 16384);
                p0_transpose_stream<2>(args.in[I_WUP], D, FF2, WUP, args.in[I_NFFN], scr, (bx - first) * NWAVES + wave, I_UP, nidle * NWAVES, lane);
            }
        }
        GRID_BAR();
    }

    if (IN(2)) for (int rep_ = 0; rep_ < NREP(2); ++rep_) { WSBASE();
        LAS float* uL = (LAS float*)(lds + wave * 4096);
        const int swapo = (bx >> 3) & 1;
#pragma unroll 1
        for (int pass = 0; pass < 2; ++pass) {
            if (pass == swapo) {
                for (int it = vcu; it < 3 * 256; it += G) pattn_wg_item(Qb, Kb, VT, AO, LSE, lds, it, wave, lane, tid);
            } else {
                if (wave < 6) { for (int it = vcu * 6 + wave; it < 3 * 512; it += G * 6) sattn_item(args, Qb, AO, LSE, it, lane); }
                else { if (rep_ == 0) for (int it = vcu * 2 + (wave - 6); it < MM; it += G * 2) memk_fix_item(out + O_MEMKV, MSS, args.in[I_XKN], args.in[I_XQN], MEMK, it, lane);
                       for (int it = vcu * 2 + (wave - 6); it < 8 * 31 * 16; it += G * 2) ssm_a_item(args, U_, SSMC_, SSMF, uL, it, lane); }
            }
            __syncthreads();
        }
        GRID_BAR();
    }

    if (IN(3)) for (int rep_ = 0; rep_ < NREP(3); ++rep_) { WSBASE();
#if defined(PROBE_LDS_FILL)
        for (int u_ = tid; u_ < 134656 / 4; u_ += NWAVES * 64) ((LAS unsigned*)lds)[u_] = PROBE_LDS_FILL;
        __syncthreads();
#endif
#if defined(PROBE_DELAY_P3)
        for (int i_ = 0; i_ < 10; ++i_) __builtin_amdgcn_s_sleep(127);
        __builtin_amdgcn_fence(__ATOMIC_ACQUIRE, "agent"); asm volatile("s_waitcnt vmcnt(0)" ::: "memory"); __syncthreads();
#endif
        const int swapo = (bx >> 3) & 1;
#pragma unroll 1
        for (int pass = 0; pass < 2; ++pass) {
            int tid3 = threadIdx.x; asm volatile("" : "+v"(tid3)); const int lane3 = tid3 & 63, wave3 = __builtin_amdgcn_readfirstlane(tid3 >> 6);
            if (pass == swapo) {
                if (G > 64) {
                    if (vcu >= 32) { const int ncw = (G - 32) * NWAVES; for (int R = ((vcu - 32) * NWAVES + wave3) * 8; R < MT; R += ncw * 8) combine_rows<8>(AO, LSE, args.in[I_AON], MIXED, R, lane3); }
                } else { for (int R = (vcu * NWAVES + wave3) * 4; R < MT; R += NGW * 4) combine_rows<4>(AO, LSE, args.in[I_AON], MIXED, R, lane3); }
            } else {
                for (int it = vcu; it < 256; it += G) ssm_c_item(args, U_, SSMC_, SSMF, WGLU, MIXED, lds, it, wave3, lane3);
            }
        }
        GRID_BAR();
    }

    if (IN(4)) for (int rep_ = 0; rep_ < NREP(4); ++rep_) { WSBASE();
        pg8::Gemm g{MIXED, WOUT, MP, D, D}; pg8::RotOrder S; S.init(MP, D, G, bx, 0);
        pg8::EpiRes<false, false> E{args.in[I_XP], nullptr, H1B, SS1}; pg8::gemm_phase<pg8::EpiRes<false, false>, pg8::RotOrder, true, true>(lds, g, S, E);
        for (int tile = bx; tile < 256; tile += G)
            sample_gemm_tile<0, false>(MIXED + (size_t)MP * D, WOUT, D, args.in[I_XS], nullptr, H1B + (size_t)MP * D, SS1S, lds, tile, wave, lane, tid);
        GRID_BAR();
    }
    if (IN(5)) for (int rep_ = 0; rep_ < NREP(5); ++rep_) { WSBASE();
        pg8::Gemm g{H1B, WXQ, MP, D, D}; pg8::RotOrder S; S.init(MP, D, G, bx, 0);
        pg8::EpiQx E{QX, QSS}; pg8::gemm_phase<pg8::EpiQx, pg8::RotOrder, true, true>(lds, g, S, E);
        for (int tile = bx; tile < 256; tile += G)
            sample_gemm_tile<1>(H1B + (size_t)MP * D, WXQ, D, nullptr, nullptr, QX + (size_t)MP * D, QSSS, lds, tile, wave, lane, tid);
        GRID_BAR();
    }
    if (IN(6)) for (int rep_ = 0; rep_ < NREP(6); ++rep_) { WSBASE();
        if (tid < 8) ((LAS unsigned*)(lds + MISC_OFF))[16 + tid] = 0u;
        __syncthreads();
        int swapo = (bx >> 3) & 1; asm volatile("" : "+s"(swapo));
#pragma unroll 1
        for (int pass = 0; pass < 2; ++pass) {
            if (pass == swapo) {
                int tid3 = threadIdx.x; asm volatile("" : "+v"(tid3)); const int lane3 = tid3 & 63, wave3 = __builtin_amdgcn_readfirstlane(tid3 >> 6);
                GAS unsigned char* wsl3 = (GAS unsigned char*)ws; asm volatile("" : "+s"(wsl3));
                int slot = 0;
                for (int pair = vcu; pair < BS * 4; pair += G, ++slot) sxattn_stream<8>(args, (bf16*)(wsl3 + WS_QX), (float*)(wsl3 + WS_CTL + CTL_RS1), (float*)(wsl3 + WS_CTL + CTL_QS), (bf16*)(wsl3 + WS_OX), lds, (LAS unsigned*)(lds + MISC_OFF) + 16 + (slot & 7), pair, slot & 1, wave3, lane3);
            } else {
                int tid2 = threadIdx.x; asm volatile("" : "+v"(tid2)); const int lane2 = tid2 & 63, wave2 = __builtin_amdgcn_readfirstlane(tid2 >> 6);
                GAS unsigned char* wsl2 = (GAS unsigned char*)ws; asm volatile("" : "+s"(wsl2));
                for (int it = vcu; it < 8 * 4 * 8; it += G) xattn_wg_item((bf16*)(wsl2 + WS_QX), (float*)(wsl2 + WS_CTL + CTL_RS1), (float*)(wsl2 + WS_CTL + CTL_QS), (bf16*)(wsl2 + WS_MEMK), (bf16*)(wsl2 + WS_MVT), (bf16*)(wsl2 + WS_OX), lds, it, wave2, lane2, tid2);
            }
            __syncthreads();
        }
        GRID_BAR();
    }
    if (IN(7)) for (int rep_ = 0; rep_ < NREP(7); ++rep_) { WSBASE();
        pg8::Gemm g{OX, WXO, MP, D, D}; pg8::RotOrder S; S.init(MP, D, G, bx, 0);
        pg8::EpiRes<true, false> E{H1B, nullptr, H2B, SS2}; pg8::gemm_phase<pg8::EpiRes<true, false>, pg8::RotOrder, true, true>(lds, g, S, E);
        for (int tile = bx; tile < 256; tile += G)
            sample_gemm_tile<0, true>(OX + (size_t)MP * D, WXO, D, H1B + (size_t)MP * D, nullptr, H2B + (size_t)MP * D, SS2S, lds, tile, wave, lane, tid);
        GRID_BAR();
    }
    if (IN(8)) for (int rep_ = 0; rep_ < NREP(8); ++rep_) { WSBASE();
        pg8::Gemm g{H2B, WUP, MT, FF2, D}; pg8::RotOrder S; S.init(MT, FF2, G, bx, 0);
        pg8::EpiUpConv E{ACT, (float*)(wsl + WS_EDGE), SS2, args.in[I_CONVW], args.in[I_CONVB], args.in[I_SCONV], out + O_CONVP, out + O_CONVS, lds}; pg8::gemm_phase<pg8::EpiUpConv, pg8::RotOrder, true, true>(lds, g, S, E);
        {
            constexpr int I_DN = (FF / 64) * (D / 32);
            const int first = S.nwg % G, nidle = G - first;
            if (bx >= first) {
                __syncthreads();
                p0_transpose_stream<0>(args.in[I_WDOWN], FF, D, WDOWN, nullptr, (LAS float*)(lds + wave * 16384), (bx - first) * NWAVES + wave, I_DN, nidle * NWAVES, lane);
            }
        }
        GRID_BAR();
    }
    if (IN(10)) for (int rep_ = 0; rep_ < NREP(10); ++rep_) { WSBASE();
        pg8::Gemm g{ACT, WDOWN, MP, D, FF}; pg8::RotOrder S; S.init(MP, D, G, bx, 0);
        { pg8::Unit uu; for (int i = 0; S.next(i, uu); ++i) if ((uu.pm & 7) != 0) conv_fix_tile(args, (const float*)(wsl + WS_EDGE), ACT, uu.pm, tid);
          VM_WAIT(); __syncthreads(); }
        pg8::EpiRes<true, true> E{H2B, out, nullptr, nullptr}; pg8::gemm_phase<pg8::EpiRes<true, true>, pg8::RotOrder, true, true>(lds, g, S, E);
        for (int tile = bx; tile < 256; tile += G)
            sample_gemm_tile<0, true>(ACT + (size_t)MP * FF, WDOWN, FF, H2B + (size_t)MP * D, out + (size_t)MP * D, nullptr, nullptr, lds, tile, wave, lane, tid);
    }
#if defined(DBG_SCALE_MASK)
    if (hi == N_PHASES) { GRID_BAR();
        const size_t offs[16] = {O_YP, O_YS, O_KV1P, O_KV4P, O_KV16P, O_SREP, O_SIMP, O_CONVP, O_MEMKV, O_KV1S, O_KV4S, O_KV16S, O_SRES, O_SIMS, O_CONVS, O_END};
        const size_t gt = (size_t)vcu * (NWAVES * 64) + tid, NT = (size_t)G * NWAVES * 64;
#pragma unroll
        for (int o = 0; o < 15; ++o) if ((DBG_SCALE_MASK >> o) & 1) { for (size_t i = offs[o] + gt; i < offs[o + 1]; i += NT) out[i] *= 3.0f; }
    }
#endif
#undef IN
#undef GRID_BAR
}


#if defined(PROBE_DET) || defined(PROBE_P3_TWICE)
__global__ void det_cmp_kernel(const unsigned* a, const unsigned* b, size_t nwords, unsigned* counter, int tol, int rw, int lo, int hi) {
    unsigned c = 0;
    for (size_t i = (size_t)blockIdx.x * blockDim.x + threadIdx.x; i < nwords; i += (size_t)gridDim.x * blockDim.x) {
        if (rw > 0) { const int cw = (int)(i % (size_t)rw); if (cw < lo || cw >= hi) continue; }
        const unsigned x = a[i], y = b[i];
        if (tol) { const float fx = __uint_as_float(x), fy = __uint_as_float(y); if (!(fabsf(fx - fy) <= 0.02f)) ++c; } else if (x != y) { ++c; atomicMin(counter + 32, (unsigned)i); atomicMax(counter + 48, (unsigned)i); } }
    if (c) atomicAdd(counter, c);
}
__global__ void det_mark_kernel(const unsigned* counters, int nreg, float* y, size_t n, int forced) {
    int r = -1; for (int i = nreg - 1; i >= 0; --i) if (counters[i] != 0u) r = i;
#if defined(PROBE_DET_COUNT)
    { const unsigned c = counters[PROBE_DET_COUNT], fw = counters[32 + PROBE_DET_COUNT], lw = counters[48 + PROBE_DET_COUNT]; const int fitem = (int)(fw / 512u) / 64, litem = (int)(lw / 512u) / 64;
      r = -1;
      if (c) { switch (PROBE_DET_MODE) { case 1: r = (int)(c >> 10); break; case 2: r = fitem >> 4; break; case 3: r = fitem & 15; break; case 4: r = litem - fitem; break; case 5: r = (int)((fw / 512u) & 63) >> 2; break; case 6: r = (int)(fw & 511u) >> 5; break; default: r = 0; } if (r > 21) r = 21; } }
#endif
    if (forced >= 0) r = forced;
#if defined(PROBE_CAL)
    r = (int)((wall_clock64() >> 12) & 1) ? 19 : -1;
#endif
    if (r < 0) return;
    const float f = 1.0f + 0.1f * (float)(r + 1);
    for (size_t i = (size_t)blockIdx.x * blockDim.x + threadIdx.x; i < n; i += (size_t)gridDim.x * blockDim.x) y[i] *= f;
}
#endif

extern "C" void kernel_launch(void* const* d_in, const int* in_sizes, int n_in, void* d_out, int out_size, void* d_ws, size_t ws_size, hipStream_t stream) {
    static int grid = 0;
    if (grid == 0) {
        if (n_in != 39 || (size_t)out_size != O_END || ws_size < WS_END) { fprintf(stderr, "kernel_launch: unexpected problem shape (n_in %d, out %d, ws %zu); nothing launched\n", n_in, out_size, ws_size); grid = -1; return; }
        int dev = 0, cus = 0, per_cu = 0;
        if (hipGetDevice(&dev) != hipSuccess || hipDeviceGetAttribute(&cus, hipDeviceAttributeMultiprocessorCount, dev) != hipSuccess) { grid = -1; return; }
        if (hipFuncSetAttribute((const void*)fwd_kernel, hipFuncAttributeMaxDynamicSharedMemorySize, LDS_BYTES) != hipSuccess) { fprintf(stderr, "kernel_launch: hipFuncSetAttribute failed\n"); grid = -1; return; }
        if (hipOccupancyMaxActiveBlocksPerMultiprocessor(&per_cu, (const void*)fwd_kernel, NWAVES * 64, LDS_BYTES) != hipSuccess || per_cu < 1) { fprintf(stderr, "kernel_launch: occupancy query says %d workgroups per CU\n", per_cu); (void)hipGetLastError(); grid = -1; return; }
        grid = cus;
    }
    if (grid < 0) return;
    (void)hipMemsetAsync((char*)d_ws + WS_CTL, 0, CTL_ZERO_BYTES, stream);
    Args a{};
    for (int i = 0; i < 39; ++i) a.in[i] = (const float*)d_in[i];
    a.out = (float*)d_out; a.ws = (unsigned char*)d_ws;
#if defined(PROBE_PRE_HI)
    a.ph_lo = 0; a.ph_hi = PROBE_PRE_HI; a.li = 1; a.pad = 0;
    hipLaunchKernelGGL(fwd_kernel, dim3(grid), dim3(NWAVES * 64), LDS_BYTES, stream, a);
    (void)hipMemsetAsync((char*)d_ws + WS_CTL, 0, CTL_ZERO_BYTES, stream);
#endif
#if defined(PROBE_DET)
    {
        const size_t SP = 644 * MiB, need = 1005 * MiB;
        char* w = (char*)d_ws; float* o = (float*)d_out;
        if (ws_size >= need) {
            a.ph_lo = 0; a.ph_hi = N_PHASES; a.li = 0; a.pad = 0;
            hipLaunchKernelGGL(fwd_kernel, dim3(grid), dim3(NWAVES * 64), LDS_BYTES, stream, a);
#if defined(PROBE_DUMP)
            (void)hipMemcpyAsync(w + SP + 190 * MiB, w + 191 * MiB, 33 * MiB, hipMemcpyDeviceToDevice, stream);
            (void)hipMemcpyAsync(w + 760 * MiB, w + 724 * MiB, 34 * MiB, hipMemcpyDeviceToDevice, stream);
#else
            (void)hipMemcpyAsync(w + SP, w + 1 * MiB, 223 * MiB, hipMemcpyDeviceToDevice, stream);
            (void)hipMemcpyAsync(w + SP + 223 * MiB, w + 295 * MiB, 4 * MiB, hipMemcpyDeviceToDevice, stream);
            (void)hipMemcpyAsync(w + SP + 227 * MiB, d_out, O_END * 4, hipMemcpyDeviceToDevice, stream);
#endif
#if defined(PROBE_DET_POISON)
            (void)hipMemsetAsync(w + PROBE_DET_POISON_LO * MiB, 0xAA, (size_t)(PROBE_DET_POISON_HI - PROBE_DET_POISON_LO) * MiB, stream);
#endif
            (void)hipMemsetAsync(w + WS_CTL, 0, CTL_ZERO_BYTES, stream);
        }
    }
#endif
    for (int li = 0; li < N_LAUNCHES; ++li) {
        a.li = 0; a.pad = 0;
        a.ph_lo = (N_LAUNCHES == 1) ? 0 : li; a.ph_hi = (N_LAUNCHES == 1) ? N_PHASES : li + 1;
        hipLaunchKernelGGL(fwd_kernel, dim3(grid), dim3(NWAVES * 64), LDS_BYTES, stream, a);
        const hipError_t le = hipPeekAtLastError();
        if (le != hipSuccess) { fprintf(stderr, "kernel_launch: launch %d failed: %s\n", li, hipGetErrorName(le)); break; }
    }
#if defined(PROBE_P3_TWICE)
    {   char* w = (char*)d_ws; float* o = (float*)d_out; unsigned* cnt = (unsigned*)(w + 643 * MiB + 900 * 1024);
        (void)hipMemsetAsync(cnt, 0, 256, stream); (void)hipMemsetAsync(cnt + 32, 0xFF, 64, stream);
        hipLaunchKernelGGL(det_cmp_kernel, dim3(2048), dim3(256), 0, stream, (const unsigned*)(w + WS_MIXED), (const unsigned*)(w + 644 * MiB), (size_t)MP * D * 2 / 4, cnt + PROBE_DET_COUNT, 0, 512, 384, 512);
        hipLaunchKernelGGL(det_mark_kernel, dim3(32), dim3(256), 0, stream, cnt, 1, o + O_SREP, (size_t)BP * 1024, -1);
    }
#endif
#if defined(PROBE_DET)
    {
        const size_t SP = 644 * MiB, need = 1005 * MiB;
        char* w = (char*)d_ws; float* o = (float*)d_out; unsigned* cnt = (unsigned*)(w + 640 * MiB);
        cnt = (unsigned*)(w + 643 * MiB + 900 * 1024);
        if (ws_size < need) { hipLaunchKernelGGL(det_mark_kernel, dim3(1024), dim3(256), 0, stream, cnt, 0, o, (size_t)MP * D, 19); }
        else {
            (void)hipMemsetAsync(cnt, 0, 256, stream); (void)hipMemsetAsync(cnt + 32, 0xFF, 64, stream);
            const char* c0 = w + SP - 1 * MiB;
            const float* oc = (const float*)(w + SP + 227 * MiB);
            struct Reg { const void* a; const void* b; size_t bytes; int tol; };
            struct Reg2 { const void* a; const void* b; size_t bytes; int rw, lo, hi; };
#if defined(PROBE_DUMP)
            const Reg2 regs[5] = {
                {w + 724 * MiB, w + 760 * MiB, (size_t)8 * MiB, 0, 0, 0}, {w + 741 * MiB, w + 777 * MiB, (size_t)2 * MiB, 0, 0, 0},
                {w + WS_MIXED, c0 + WS_MIXED, (size_t)MP * D * 2, 512, 384, 512}, {w + WS_MIXED, c0 + WS_MIXED, (size_t)MP * D * 2, 512, 384, 512}, {w + WS_MIXED, c0 + WS_MIXED, (size_t)MP * D * 2, 512, 384, 512} };
#else
            const Reg2 regs[14] = {
                {w + WS_U, c0 + WS_U, (size_t)MT * 256 * 4, 0, 0, 0}, {w + WS_Q, c0 + WS_Q, (size_t)MT * 768 * 2, 0, 0, 0}, {w + WS_K, c0 + WS_K, (size_t)MT * 768 * 2, 0, 0, 0}, {w + WS_VT, c0 + WS_VT, (size_t)MP * 768 * 2, 0, 0, 0},
                {o + O_KV1P, oc + O_KV1P, (O_SREP - O_KV1P) * 4, 0, 0, 0}, {o + O_MEMKV, oc + O_MEMKV, (O_KV1S - O_MEMKV) * 4, 0, 0, 0}, {o + O_KV1S, oc + O_KV1S, (O_SRES - O_KV1S) * 4, 0, 0, 0},
                {w + WS_SSMF, c0 + WS_SSMF, 2 * MiB, 0, 0, 0}, {w + WS_AO, c0 + WS_AO, (size_t)MT * 768 * 2, 0, 0, 0}, {w + WS_LSE, c0 + WS_LSE, (size_t)MT * 12 * 4, 0, 0, 0}, {w + WS_MEMK, w + SP + 223 * MiB, 4 * MiB, 0, 0, 0},
                {o + O_SREP, oc + O_SREP, (O_CONVP - O_SREP) * 4, 0, 0, 0}, {o + O_SRES, oc + O_SRES, (O_CONVS - O_SRES) * 4, 0, 0, 0}, {w + WS_MIXED, c0 + WS_MIXED, (size_t)MT * D * 2, 0, 0, 0} };
#endif
            for (int r = 0; r < (int)(sizeof(regs) / sizeof(regs[0])); ++r) hipLaunchKernelGGL(det_cmp_kernel, dim3(2048), dim3(256), 0, stream, (const unsigned*)regs[r].a, (const unsigned*)regs[r].b, regs[r].bytes / 4, cnt + r, 0, regs[r].rw, regs[r].lo, regs[r].hi);
            hipLaunchKernelGGL(det_mark_kernel, dim3(32), dim3(256), 0, stream, cnt, 14, o + O_SREP, (size_t)BP * 1024, -1);
        }
    }
#endif
}
```

```cpp
#include <hip/hip_runtime.h>
#include <cstdio>
#include <cstdint>

#define GAS __attribute__((address_space(1)))
#define LAS __attribute__((address_space(3)))
#define PG8_LAS __attribute__((address_space(3)))
typedef unsigned short bf16;
typedef short bf16x8 __attribute__((ext_vector_type(8)));
typedef float f32x4 __attribute__((ext_vector_type(4)));
typedef float f32x2 __attribute__((ext_vector_type(2)));
typedef float f32x16 __attribute__((ext_vector_type(16)));
typedef unsigned u32x4 __attribute__((ext_vector_type(4)));
typedef unsigned u32x2 __attribute__((ext_vector_type(2)));
typedef GAS unsigned gu32;
#define RLX_AGENT __ATOMIC_RELAXED, __HIP_MEMORY_SCOPE_AGENT
#define LDS_WAIT() asm volatile("s_waitcnt lgkmcnt(0)" ::: "memory")
#define VM_WAIT() asm volatile("s_waitcnt vmcnt(0)" ::: "memory")

constexpr int D = 1024, BP = 8, LP = 2048, MP = BP * LP, BS = 128, TS = 4, MS = BS * TS, MT = MP + MS;
constexpr int INW = 2560, AW = 768, SW = 256, NMEM = 256, MM = BP * NMEM, FF = 2816, FF2 = 5632;
constexpr float EPS = 1e-6f;
constexpr float LOG2E = 1.4426950408889634f, LN2 = 0.6931471805599453f;
constexpr int NWAVES = 8;

constexpr size_t MiB = 1u << 20;
constexpr size_t WS_CTL = 0, CTL_ZERO_BYTES = 1 * MiB;
constexpr size_t WS_ROPE = 1 * MiB;
constexpr size_t WS_SSMC = 1 * MiB + 512 * 1024;
constexpr size_t WS_WIN = 2 * MiB, WS_WOUT = 7 * MiB, WS_WXQ = 9 * MiB, WS_WXKV = 11 * MiB, WS_WXO = 15 * MiB, WS_WUP = 17 * MiB, WS_WDOWN = 28 * MiB, WS_WGLU = 34 * MiB;
constexpr size_t WS_XN = 35 * MiB, WS_MEMN = 68 * MiB, WS_Q = 72 * MiB, WS_K = 97 * MiB, WS_VT = 122 * MiB, WS_U = 146 * MiB, WS_AO = 163 * MiB, WS_LSE = 188 * MiB;
constexpr size_t WS_SSMF = 189 * MiB, WS_MIXED = 191 * MiB, WS_H1B = 224 * MiB, WS_SS1 = 257 * MiB, WS_QX = 259 * MiB, WS_QSS = 292 * MiB, WS_MSS = 294 * MiB, WS_MEMK = 295 * MiB, WS_MVT = 299 * MiB;
constexpr size_t WS_OX = 303 * MiB, WS_H2B = 336 * MiB, WS_SS2 = 369 * MiB, WS_UP = 371 * MiB, WS_ACT = 553 * MiB, WS_END = 644 * MiB;
constexpr size_t WS_EDGE = 371 * MiB;
constexpr size_t WS_SS1S = 258 * MiB + 512 * 1024, WS_QSSS = 293 * MiB + 512 * 1024, WS_SS2S = 370 * MiB + 512 * 1024;
constexpr size_t CTL_RS1 = 128 * 1024, CTL_RS2 = 256 * 1024, CTL_QS = 384 * 1024;
constexpr int CW_BAR = 4096;

constexpr int RING_BYTES = 131072;
constexpr int MISC_OFF = 135168;
constexpr int LDS_BYTES = 147456;

__device__ __forceinline__ unsigned f2bf(float f) { unsigned u = __builtin_bit_cast(unsigned, f); return (u + 0x7fffu + ((u >> 16) & 1u)) >> 16; }
__device__ __forceinline__ unsigned pk2(float lo, float hi) { return f2bf(lo) | (f2bf(hi) << 16); }
__device__ __forceinline__ float bf2f(unsigned h) { return __builtin_bit_cast(float, h << 16); }
typedef __bf16 bf16v2_t __attribute__((ext_vector_type(2)));
__device__ __forceinline__ unsigned cvt_pk_bf16(float lo, float hi) { const f32x2 v = {lo, hi}; return __builtin_bit_cast(unsigned, __builtin_convertvector(v, bf16v2_t)); }
__device__ __forceinline__ bf16x8 pack8(float a0, float a1, float a2, float a3, float a4, float a5, float a6, float a7) {
    u32x4 w; w.x = cvt_pk_bf16(a0, a1); w.y = cvt_pk_bf16(a2, a3); w.z = cvt_pk_bf16(a4, a5); w.w = cvt_pk_bf16(a6, a7); return __builtin_bit_cast(bf16x8, w); }
__device__ __forceinline__ float wave_sum(float v) {
#pragma unroll
    for (int o = 1; o < 64; o <<= 1) v += __shfl_xor(v, o);
    return v;
}
__device__ __forceinline__ float fexp2(float x) { return __builtin_amdgcn_exp2f(x); }
__device__ __forceinline__ float flog2(float x) { return __builtin_amdgcn_logf(x); }
__device__ __forceinline__ float frcp(float x) { return __builtin_amdgcn_rcpf(x); }
__device__ __forceinline__ float frsq(float x) { return __builtin_amdgcn_rsqf(x); }
__device__ __forceinline__ void sincos_d(double x, double& s, double& c) {
    const double k = __builtin_rint(x * 0.63661977236758134308);
    double r = __builtin_fma(-k, 1.57079632679489655800e+00, x); r = __builtin_fma(-k, 6.12323399573676603587e-17, r);
    const long long q = (long long)k; const double r2 = r * r;
    double sp = 1.0 / 6227020800.0; sp = sp * r2 - 1.0 / 39916800.0; sp = sp * r2 + 1.0 / 362880.0; sp = sp * r2 - 1.0 / 5040.0; sp = sp * r2 + 1.0 / 120.0; sp = sp * r2 - 1.0 / 6.0; sp = sp * r2 + 1.0; sp = sp * r;
    double cp = -1.0 / 87178291200.0; cp = cp * r2 + 1.0 / 479001600.0; cp = cp * r2 - 1.0 / 3628800.0; cp = cp * r2 + 1.0 / 40320.0; cp = cp * r2 - 1.0 / 720.0; cp = cp * r2 + 1.0 / 24.0; cp = cp * r2 - 0.5; cp = cp * r2 + 1.0;
    const int qq = (int)(q & 3);
    s = (qq == 0) ? sp : (qq == 1) ? cp : (qq == 2) ? -sp : -cp;
    c = (qq == 0) ? cp : (qq == 1) ? -sp : (qq == 2) ? -cp : sp;
}
__device__ __forceinline__ double exp_d(double x) {
    const double k = __builtin_rint(x * 1.44269504088896340736);
    double r = __builtin_fma(-k, 6.93147180369123816490e-01, x); r = __builtin_fma(-k, 1.90821492927058770002e-10, r);
    double p = 1.0 / 6227020800.0;
    p = p * r + 1.0 / 479001600.0; p = p * r + 1.0 / 39916800.0; p = p * r + 1.0 / 3628800.0; p = p * r + 1.0 / 362880.0; p = p * r + 1.0 / 40320.0; p = p * r + 1.0 / 5040.0;
    p = p * r + 1.0 / 720.0; p = p * r + 1.0 / 120.0; p = p * r + 1.0 / 24.0; p = p * r + 1.0 / 6.0; p = p * r + 0.5; p = p * r + 1.0; p = p * r + 1.0;
    const int ki = (int)k;
    return __builtin_ldexp(p, ki);
}
__device__ __forceinline__ float dot4(f32x4 a) { return (a[0] * a[0] + a[1] * a[1]) + (a[2] * a[2] + a[3] * a[3]); }
__device__ __forceinline__ u32x4 pk8(f32x4 a, f32x4 b) { u32x4 w; w.x = cvt_pk_bf16(a[0], a[1]); w.y = cvt_pk_bf16(a[2], a[3]); w.z = cvt_pk_bf16(b[0], b[1]); w.w = cvt_pk_bf16(b[2], b[3]); return w; }
__device__ __forceinline__ f32x4 shx16(f32x4 a) { f32x4 r; r[0] = __shfl_xor(a[0], 16); r[1] = __shfl_xor(a[1], 16); r[2] = __shfl_xor(a[2], 16); r[3] = __shfl_xor(a[3], 16); return r; }
constexpr size_t O_KV1P_ = (size_t)MT * D, O_KV4P_ = O_KV1P_ + (size_t)BP * 128 * 512, O_KV16P_ = O_KV4P_ + (size_t)BP * 512 * 512;
constexpr size_t O_KV1S_ = O_KV16P_ + (size_t)BP * 2048 * 512 + 2 * BP * 1024 + (size_t)BP * 2 * FF2 + (size_t)MM * 2048, O_KV4S_ = O_KV1S_ + (size_t)MS * 512, O_KV16S_ = O_KV4S_ + (size_t)MS * 512;
typedef short s16x4 __attribute__((ext_vector_type(4)));
__device__ __forceinline__ s16x4 lds_tr4(LAS unsigned char* p) { return __builtin_bit_cast(s16x4, __builtin_amdgcn_ds_read_tr16_b64_v4i16((LAS s16x4*)p)); }
__device__ __forceinline__ bf16x8 cat44(s16x4 a, s16x4 b) { return (bf16x8){a[0], a[1], a[2], a[3], b[0], b[1], b[2], b[3]}; }
__device__ __forceinline__ void atomic_addf(float* p, float v) { (void)__hip_atomic_fetch_add(p, v, __ATOMIC_RELAXED, __HIP_MEMORY_SCOPE_AGENT); }

namespace pg8 {
#define PG8_LAS __attribute__((address_space(3)))
typedef unsigned short bf16_t;
typedef short bf16x8 __attribute__((ext_vector_type(8)));
typedef float f32x4 __attribute__((ext_vector_type(4)));
typedef unsigned u32x4 __attribute__((ext_vector_type(4)));
constexpr int BM = 256, BK = 64, HALF = 128, HTB = HALF * BK * 2  , STAGE_BYTES = 8 * HTB, NXCD = 8, WGM = 8;

__host__ __device__ __forceinline__ int lds_byte(int r, int c) { const int st = (r >> 4) * 2 + (c >> 5), rr = r & 15, cc = c & 31, ob = rr * 64 + cc * 2; return st * 1024 + (ob ^ (((ob >> 9) & 1) << 5)); }
__host__ __device__ __forceinline__ void stage_rc(int b, int& R, int& C) { const int st = b / 1024, sb = b % 1024, swz = sb ^ (((sb >> 9) & 1) << 5); R = (st >> 1) * 16 + swz / 64; C = (st & 1) * 32 + (swz % 64) / 2; }
__host__ __device__ __forceinline__ int perm32(int rho) { const int n = rho >> 4, i = rho & 15; return 8 * (i >> 2) + 4 * n + (i & 3); }

struct Unit { int pm, pn; };
struct Gemm { const bf16_t* A; const bf16_t* Bt; int M, N, K; };

struct StaticOrder {
    int nM, nN, nwg, G, c;
    __host__ __device__ void init(int M, int N, int G_, int c_) { nM = M / BM; nN = N / BM; nwg = nM * nN; G = G_; c = c_; }
    __host__ __device__ bool next(int i, Unit& u) const {
        const long L = (long)i * G + c; if (L >= nwg) return false;
        int wgid = (int)L; { const int q = nwg / NXCD, r = nwg % NXCD, xcd = wgid % NXCD, off = wgid / NXCD; wgid = (xcd < r ? xcd * (q + 1) : r * (q + 1) + (xcd - r) * q) + off; }
        const int nig = WGM * nN, gid = wgid / nig, fm = gid * WGM, gsz = (nM - fm) < WGM ? (nM - fm) : WGM;
        u.pm = fm + ((wgid % nig) % gsz); u.pn = (wgid % nig) / gsz; return true;
    }
    __device__ __forceinline__ void a_ready(const Unit&) const {}
    __device__ __forceinline__ void done(const Unit&) const {}
};


struct RotOrder {
    int nM, nN, nwg, G, c;
    __host__ __device__ void init(int M, int N, int G_, int blk, int base) { nM = M / BM; nN = N / BM; nwg = nM * nN; G = G_; const int rot = base % G_; c = blk - rot; if (c < 0) c += G_; }
    __host__ __device__ __forceinline__ bool next(int i, Unit& u) const {
        const long L = (long)i * G + c; if (L >= nwg) return false;
        int wgid = (int)L; { const int q = nwg / NXCD, r = nwg % NXCD, xcd = wgid % NXCD, off = wgid / NXCD; wgid = (xcd < r ? xcd * (q + 1) : r * (q + 1) + (xcd - r) * q) + off; }
        const int nig = WGM * nN, gid = wgid / nig, fm = gid * WGM, gsz = (nM - fm) < WGM ? (nM - fm) : WGM;
        u.pm = fm + ((wgid % nig) % gsz); u.pn = (wgid % nig) / gsz; return true;
    }
    __device__ __forceinline__ void a_ready(const Unit&) const {}
    __device__ __forceinline__ void done(const Unit&) const {}
};


struct EpiZ {
    static constexpr bool PERM = true, AFTER_DRAIN = false, BMAP = false, AMAP = false;
    bf16_t* Q; bf16_t* Kb; bf16_t* VN; float* U; const float* rope; const float* qg; const float* kg;
    float* outp;
    __device__ __forceinline__ int bmap(int r) const { return r; }
    __device__ __forceinline__ void operator()(const f32x4 (&acc)[2][2][4][2], const Unit& u, int wr, int wc, int fr, int fq) const {
        const int pn = u.pn; const bool sample = u.pm >= 64;
        const int rbase = u.pm * BM + wr * 64 + fr;
        if (pn == 9) {
#pragma unroll
            for (int ai = 0; ai < 2; ++ai)
#pragma unroll
                for (int m = 0; m < 4; ++m) { const int R = rbase + ai * HALF + m * 16; float* p = U + (size_t)R * 256 + wc * 64 + 8 * fq;
#pragma unroll
                    for (int bj = 0; bj < 2; ++bj) { *(f32x4*)(p + 32 * bj) = acc[ai][bj][m][0]; *(f32x4*)(p + 32 * bj + 4) = acc[ai][bj][m][1]; } }
            return;
        }
        const int kind = pn / 3, g = pn - 3 * kind;
        const int keep = g == 0 ? 128 : (g == 1 ? 512 : 2048);
        float* kvp = outp + (g == 0 ? O_KV1P_ : (g == 1 ? O_KV4P_ : O_KV16P_)); float* kvs = outp + (g == 0 ? O_KV1S_ : (g == 1 ? O_KV4S_ : O_KV16S_));
        if (kind == 2) {
#pragma unroll
            for (int ai = 0; ai < 2; ++ai)
#pragma unroll
                for (int m = 0; m < 4; ++m) { const int R = rbase + ai * HALF + m * 16; float* dst = nullptr;
                    if (sample) dst = kvs + ((size_t)(R - MP) * 2 + 1) * 256;
                    else { const int b = R >> 11, t = R & 2047; if (t >= 2048 - keep) dst = kvp + ((size_t)(b * keep + t - (2048 - keep)) * 2 + 1) * 256; }
                    if (dst) { dst += wc * 64 + 8 * fq;
#pragma unroll
                        for (int bj = 0; bj < 2; ++bj) { *(f32x4*)(dst + 32 * bj) = acc[ai][bj][m][0]; *(f32x4*)(dst + 32 * bj + 4) = acc[ai][bj][m][1]; } }
                    if (!sample) { bf16_t* vp = VN + (size_t)R * AW + g * 256 + wc * 64 + 8 * fq;
                        *(u32x4*)vp = pk8(acc[ai][0][m][0], acc[ai][0][m][1]); *(u32x4*)(vp + 32) = pk8(acc[ai][1][m][0], acc[ai][1][m][1]); } }
            return;
        }
        const float* gp = (kind == 0 ? qg : kg) + 8 * fq;
        const f32x4 g00 = *(const f32x4*)(gp), g01 = *(const f32x4*)(gp + 4), g10 = *(const f32x4*)(gp + 32), g11 = *(const f32x4*)(gp + 36);
        const float sgn = fq == 0 ? -1.f : 1.f;
        const float qs = kind == 0 ? 0.125f * LOG2E : 1.f;
        bf16_t* ob = kind == 0 ? Q : Kb;
        f32x4 rc0, rc1, rs0, rs1;
        { const int R = rbase; const int pos = sample ? 2048 + (R & 3) : (R & 2047); const float* rp = rope + (size_t)pos * 16; rc0 = *(const f32x4*)rp; rc1 = *(const f32x4*)(rp + 4); rs0 = *(const f32x4*)(rp + 8); rs1 = *(const f32x4*)(rp + 12); }
#pragma unroll
        for (int ai = 0; ai < 2; ++ai)
#pragma unroll
            for (int m = 0; m < 4; ++m) { const int R = rbase + ai * HALF + m * 16;
                const f32x4 c0 = rc0, c1 = rc1, s0 = rs0, s1 = rs1;
                if (ai * 4 + m < 7) { const int Rn = rbase + ((ai * 4 + m + 1) >> 2) * HALF + ((ai * 4 + m + 1) & 3) * 16; const int pos = sample ? 2048 + (Rn & 3) : (Rn & 2047); const float* rp = rope + (size_t)pos * 16;
                    rc0 = *(const f32x4*)rp; rc1 = *(const f32x4*)(rp + 4); rs0 = *(const f32x4*)(rp + 8); rs1 = *(const f32x4*)(rp + 12); }
                float ss = (dot4(acc[ai][0][m][0]) + dot4(acc[ai][0][m][1])) + (dot4(acc[ai][1][m][0]) + dot4(acc[ai][1][m][1])); ss += __shfl_xor(ss, 16); ss += __shfl_xor(ss, 32);
                const float rs = frsq(ss * (1.0f / 64.0f) + EPS);
                float* dst = nullptr;
                if (kind == 1) { if (sample) dst = kvs + ((size_t)(R - MP) * 2) * 256; else { const int b = R >> 11, t = R & 2047; if (t >= 2048 - keep) dst = kvp + ((size_t)(b * keep + t - (2048 - keep)) * 2) * 256; }
                    if (dst) dst += wc * 64 + 8 * fq; }
                bf16_t* op = ob + (size_t)R * AW + g * 256 + wc * 64 + 8 * fq;
                f32x4 xa = acc[ai][0][m][0] * rs * g00, xb = acc[ai][0][m][1] * rs * g01;
                { const f32x4 oa = shx16(xa), ob2 = shx16(xb);
                  if (fq < 2) { xa = xa * c0 + (oa * s0) * sgn; xb = xb * c1 + (ob2 * s1) * sgn; } }
                if (dst) { *(f32x4*)(dst) = xa; *(f32x4*)(dst + 4) = xb; }
                *(u32x4*)(op) = pk8(xa * qs, xb * qs);
                xa = acc[ai][1][m][0] * rs * g10; xb = acc[ai][1][m][1] * rs * g11;
                if (dst) { *(f32x4*)(dst + 32) = xa; *(f32x4*)(dst + 36) = xb; }
                *(u32x4*)(op + 32) = pk8(xa * qs, xb * qs);
            }
    }
};

struct EpiVt {
    static constexpr bool PERM = true, AFTER_DRAIN = false, BMAP = true, AMAP = false;
    bf16_t* VT; int g;
    __device__ __forceinline__ int bmap(int r) const { return g == 0 ? r : (g == 1 ? ((r & 63) * 4 + (r >> 6)) : ((r & 15) * 16 + (r >> 4))); }
    __device__ __forceinline__ void operator()(const f32x4 (&acc)[2][2][4][2], const Unit& u, int wr, int wc, int fr, int fq) const {
        const int b = u.pn >> 3, t0 = (u.pn & 7) * 256, sh = 2 * g, S = 2048 >> sh, Wl = 8 - sh;
#pragma unroll
        for (int ai = 0; ai < 2; ++ai)
#pragma unroll
            for (int m = 0; m < 4; ++m) { const int hh = 2 * wr + (m >> 1), d = 32 * ai + 16 * (m & 1) + fr;
#pragma unroll
                for (int bj = 0; bj < 2; ++bj) { const int c8 = 128 * bj + 32 * wc + 8 * fq, res = c8 >> Wl, ds = c8 & ((1 << Wl) - 1), pos = res * S + (t0 >> sh) + ds;
                    bf16_t* p = VT + ((((size_t)((g * 4 + hh) * 8 + b) * 64 + (pos >> 5)) * 64 + d) * 32 + (pos & 31));
                    *(u32x4*)p = pk8(acc[ai][bj][m][0], acc[ai][bj][m][1]); } }
    }
};

struct EpiMem {
    static constexpr bool PERM = true, AFTER_DRAIN = false, BMAP = false, AMAP = false;
    float* out; float* mss; bf16_t* MVN;
    __device__ __forceinline__ int bmap(int r) const { return r; }
    __device__ __forceinline__ void operator()(const f32x4 (&acc)[2][2][4][2], const Unit& u, int wr, int wc, int fr, int fq) const {
        const int kv = u.pn >> 2, h = u.pn & 3;
#pragma unroll
        for (int ai = 0; ai < 2; ++ai)
#pragma unroll
            for (int m = 0; m < 4; ++m) { const int R = u.pm * BM + ai * HALF + wr * 64 + m * 16 + fr; float* dst = out + ((size_t)R * 2 + kv) * 1024 + h * 256 + 32 * wc + 8 * fq; float ss = 0.f;
#pragma unroll
                for (int bj = 0; bj < 2; ++bj) { const f32x4 a = acc[ai][bj][m][0], c = acc[ai][bj][m][1]; *(f32x4*)(dst + 128 * bj) = a; *(f32x4*)(dst + 128 * bj + 4) = c; ss += dot4(a) + dot4(c);
                    if (kv) *(u32x4*)(MVN + (size_t)R * 1024 + h * 256 + 32 * wc + 8 * fq + 128 * bj) = pk8(a, c); }
                if (kv == 0) { ss += __shfl_xor(ss, 16); ss += __shfl_xor(ss, 32); if (fq == 0) mss[(size_t)R * 16 + h * 4 + wc] = ss; } }
    }
};
struct EpiMemVt {
    static constexpr bool PERM = true, AFTER_DRAIN = false, BMAP = false, AMAP = false;
    bf16_t* MVT;
    __device__ __forceinline__ int bmap(int r) const { return r; }
    __device__ __forceinline__ void operator()(const f32x4 (&acc)[2][2][4][2], const Unit& u, int wr, int wc, int fr, int fq) const {
        const int h = u.pm, b = u.pn;
#pragma unroll
        for (int ai = 0; ai < 2; ++ai)
#pragma unroll
            for (int m = 0; m < 4; ++m) { const int d = ai * HALF + wr * 64 + m * 16 + fr;
#pragma unroll
                for (int bj = 0; bj < 2; ++bj) { const int c8 = 128 * bj + 32 * wc + 8 * fq;
                    bf16_t* p = MVT + ((((size_t)(h * 8 + b) * 8 + (c8 >> 5)) * 256 + d) * 32 + (c8 & 31));
                    *(u32x4*)p = pk8(acc[ai][bj][m][0], acc[ai][bj][m][1]); } }
    }
};
template <bool BASE_BF16, bool OUT_F32> struct EpiRes {
    static constexpr bool PERM = true, AFTER_DRAIN = false, BMAP = false, AMAP = false;
    const void* base; float* out; bf16_t* hb; float* ssq;
    __device__ __forceinline__ int bmap(int r) const { return r; }
    __device__ __forceinline__ void operator()(const f32x4 (&acc)[2][2][4][2], const Unit& u, int wr, int wc, int fr, int fq) const {
        const int c0 = u.pn * BM + 32 * wc + 8 * fq;
#pragma unroll
        for (int ai = 0; ai < 2; ++ai) {
            f32x4 b0[4][2], b1[4][2];
#pragma unroll
            for (int m = 0; m < 4; ++m)
#pragma unroll
                for (int bj = 0; bj < 2; ++bj) { const size_t off = (size_t)(u.pm * BM + ai * HALF + wr * 64 + m * 16 + fr) * D + c0 + 128 * bj;
                    if (BASE_BF16) { const u32x4 w = *(const u32x4*)((const bf16_t*)base + off); b0[m][bj] = (f32x4){bf2f(w.x & 0xffffu), bf2f(w.x >> 16), bf2f(w.y & 0xffffu), bf2f(w.y >> 16)}; b1[m][bj] = (f32x4){bf2f(w.z & 0xffffu), bf2f(w.z >> 16), bf2f(w.w & 0xffffu), bf2f(w.w >> 16)}; }
                    else { b0[m][bj] = *(const f32x4*)((const float*)base + off); b1[m][bj] = *(const f32x4*)((const float*)base + off + 4); } }
            asm volatile("" ::: "memory");
#pragma unroll
            for (int m = 0; m < 4; ++m) { const int R = u.pm * BM + ai * HALF + wr * 64 + m * 16 + fr; float ss = 0.f;
#pragma unroll
                for (int bj = 0; bj < 2; ++bj) { const size_t off = (size_t)R * D + c0 + 128 * bj;
                    const f32x4 o0 = b0[m][bj] + acc[ai][bj][m][0], o1 = b1[m][bj] + acc[ai][bj][m][1];
                    if (OUT_F32) { *(f32x4*)(out + off) = o0; *(f32x4*)(out + off + 4) = o1; }
                    if (hb) *(u32x4*)(hb + off) = pk8(o0, o1);
                    ss += dot4(o0) + dot4(o1); }
                if (ssq) { ss += __shfl_xor(ss, 16); ss += __shfl_xor(ss, 32); if (fq == 0) atomic_addf(ssq + R, ss); } }
        }
    }
};
struct EpiQx {
    static constexpr bool PERM = true, AFTER_DRAIN = false, BMAP = false, AMAP = false;
    bf16_t* QX; float* qss;
    __device__ __forceinline__ int bmap(int r) const { return r; }
    __device__ __forceinline__ void operator()(const f32x4 (&acc)[2][2][4][2], const Unit& u, int wr, int wc, int fr, int fq) const {
        const int c0 = u.pn * BM + 32 * wc + 8 * fq;
#pragma unroll
        for (int ai = 0; ai < 2; ++ai)
#pragma unroll
            for (int m = 0; m < 4; ++m) { const int R = u.pm * BM + ai * HALF + wr * 64 + m * 16 + fr; float ss = 0.f;
#pragma unroll
                for (int bj = 0; bj < 2; ++bj) { const f32x4 a = acc[ai][bj][m][0], c = acc[ai][bj][m][1]; *(u32x4*)(QX + (size_t)R * D + c0 + 128 * bj) = pk8(a, c); ss += dot4(a) + dot4(c); }
                ss += __shfl_xor(ss, 16); ss += __shfl_xor(ss, 32); if (fq == 0) atomic_addf(qss + (size_t)R * 4 + u.pn, ss); }
    }
};
template <int CTRL> __device__ __forceinline__ float dppf(float old, float src) { return __builtin_bit_cast(float, __builtin_amdgcn_update_dpp(__builtin_bit_cast(int, old), __builtin_bit_cast(int, src), CTRL, 0xf, 0xf, false)); }
__device__ __forceinline__ f32x4 prev_rows1(f32x4 pg, f32x4 cur) { f32x4 r;
#pragma unroll
    for (int e = 0; e < 4; ++e) r[e] = dppf<0x111>(dppf<0x121>(0.f, pg[e]), cur[e]);
    return r; }
__device__ __forceinline__ f32x4 prev_rows2(f32x4 pg, f32x4 cur) { f32x4 r;
#pragma unroll
    for (int e = 0; e < 4; ++e) r[e] = dppf<0x112>(dppf<0x122>(0.f, pg[e]), cur[e]);
    return r; }
__device__ __forceinline__ float silu_(float x) { return x * frcp(1.0f + fexp2(-x * LOG2E)); }
constexpr int HALO_OFF = 135680;
struct EpiUpConv {
    static constexpr bool PERM = true, AFTER_DRAIN = false, BMAP = false, AMAP = true;
    bf16_t* ACT; float* EDGE; const float* rs2; const float* cw; const float* cb; const float* sconv; float* convp; float* convs; PG8_LAS unsigned char* lds;
    __device__ __forceinline__ int bmap(int r) const { return r; }
    __device__ __forceinline__ int amap(int r) const { return (r & 64) + 4 * (r & 15) + ((r >> 4) & 3); }
    __device__ __forceinline__ void operator()(f32x4 (&acc)[2][2][4][2], const Unit& u, int wr, int wc, int fr, int fq) const {
        const bool smp = u.pm >= 64;
        const int j8 = u.pn * 128 + 32 * wc + 8 * fq;
        f32x4 cwv[8];
#define UPC_LOADW(n_) do { const int j4_ = j8 + 4 * (n_); cwv[0] = *(const f32x4*)(cw + j4_); cwv[1] = *(const f32x4*)(cw + FF2 + j4_); cwv[2] = *(const f32x4*)(cw + 2 * FF2 + j4_); cwv[3] = *(const f32x4*)(cb + j4_); \
        cwv[4] = *(const f32x4*)(cw + FF + j4_); cwv[5] = *(const f32x4*)(cw + FF2 + FF + j4_); cwv[6] = *(const f32x4*)(cw + 2 * FF2 + FF + j4_); cwv[7] = *(const f32x4*)(cb + FF + j4_); } while (0)
        UPC_LOADW(0);
        const int tok0 = u.pm * BM + wr * 64 + 4 * fr;
        { float tot[2][4];
#pragma unroll
          for (int ai = 0; ai < 2; ++ai)
#pragma unroll
              for (int m = 0; m < 4; ++m) tot[ai][m] = rs2[tok0 + ai * HALF + m];
#pragma unroll
          for (int ai = 0; ai < 2; ++ai)
#pragma unroll
              for (int m = 0; m < 4; ++m) { const float rstd = frsq(tot[ai][m] * (1.0f / 1024.0f) + EPS);
#pragma unroll
                  for (int bj = 0; bj < 2; ++bj) { acc[ai][bj][m][0] = acc[ai][bj][m][0] * rstd; acc[ai][bj][m][1] = acc[ai][bj][m][1] * rstd; } } }
        PG8_LAS float* halo = (PG8_LAS float*)(lds + HALO_OFF);
        if (!smp && fr == 15) {
#pragma unroll
            for (int ai = 0; ai < 2; ++ai)
#pragma unroll
                for (int mm = 2; mm < 4; ++mm) { PG8_LAS float* hp = halo + ((((2 * ai + wr + 1) * 2 + (mm - 2)) * 4 + wc) * 4 + fq) * 16;
                    *(PG8_LAS f32x4*)(hp) = acc[ai][0][mm][0]; *(PG8_LAS f32x4*)(hp + 4) = acc[ai][0][mm][1]; *(PG8_LAS f32x4*)(hp + 8) = acc[ai][1][mm][0]; *(PG8_LAS f32x4*)(hp + 12) = acc[ai][1][mm][1]; }
        }
        asm volatile("s_waitcnt lgkmcnt(0)\n\ts_barrier" ::: "memory");
#pragma unroll
        for (int n = 0; n < 2; ++n) {
            const int j4 = j8 + 4 * n;
            if (n == 1) UPC_LOADW(1);
            const f32x4 wg0 = cwv[0], wg1 = cwv[1], wg2 = cwv[2], bgv = cwv[3], wv0 = cwv[4], wv1 = cwv[5], wv2 = cwv[6], bvv = cwv[7];
#pragma unroll
            for (int ai = 0; ai < 2; ++ai) {
                const int blk = 2 * ai + wr, tokb = tok0 + ai * HALF;
                f32x4 gm1, gm2, vm1, vm2;
                if (smp) { const float* sb = sconv + (size_t)((tokb - MP) >> 2) * 2 * FF2;
                    gm2 = *(const f32x4*)(sb + j4); vm2 = *(const f32x4*)(sb + FF + j4); gm1 = *(const f32x4*)(sb + FF2 + j4); vm1 = *(const f32x4*)(sb + FF2 + FF + j4); }
                else { f32x4 h2g = {0.f, 0.f, 0.f, 0.f}, h3g = h2g, h2v = h2g, h3v = h2g;
                    if (blk > 0 && fr == 0) { const PG8_LAS float* hp = halo + (((blk * 2) * 4 + wc) * 4 + fq) * 16; h2g = *(const PG8_LAS f32x4*)(hp + 4 * n); h2v = *(const PG8_LAS f32x4*)(hp + 8 + 4 * n);
                        h3g = *(const PG8_LAS f32x4*)(hp + 256 + 4 * n); h3v = *(const PG8_LAS f32x4*)(hp + 256 + 8 + 4 * n); }
#pragma unroll
                    for (int e = 0; e < 4; ++e) { gm1[e] = dppf<0x111>(h3g[e], acc[ai][0][3][n][e]); gm2[e] = dppf<0x111>(h2g[e], acc[ai][0][2][n][e]); vm1[e] = dppf<0x111>(h3v[e], acc[ai][1][3][n][e]); vm2[e] = dppf<0x111>(h2v[e], acc[ai][1][2][n][e]); } }
#pragma unroll
                for (int m = 0; m < 4; ++m) { const int R = tokb + m;
                    const f32x4 g = acc[ai][0][m][n], v = acc[ai][1][m][n];
                    const f32x4 g1 = m == 0 ? gm1 : acc[ai][0][m > 0 ? m - 1 : 0][n], v1 = m == 0 ? vm1 : acc[ai][1][m > 0 ? m - 1 : 0][n];
                    const f32x4 g2 = m == 0 ? gm2 : (m == 1 ? gm1 : acc[ai][0][m > 1 ? m - 2 : 0][n]), v2 = m == 0 ? vm2 : (m == 1 ? vm1 : acc[ai][1][m > 1 ? m - 2 : 0][n]);
                    if (smp) { if (m >= 2) { float* cd = convs + ((size_t)((R - MP) >> 2) * 2 + (m - 2)) * FF2; *(f32x4*)(cd + j4) = g; *(f32x4*)(cd + FF + j4) = v; } }
                    else if ((ai == 0 && m < 2) || (ai == 1 && m >= 2)) {
                        const int t = R & 2047;
                        if (t >= 2046) { float* cd = convp + ((size_t)(R >> 11) * 2 + (t - 2046)) * FF2; *(f32x4*)(cd + j4) = g; *(f32x4*)(cd + FF + j4) = v; }
                        const int rt = R & 255;
                        if (rt < 2 || rt >= 254) { float* ed = EDGE + ((size_t)u.pm * 4 + (rt < 2 ? rt : rt - 252)) * FF2; *(f32x4*)(ed + j4) = g; *(f32x4*)(ed + FF + j4) = v; }
                    }
                    const f32x4 cg = bgv + wg0 * g2 + wg1 * g1 + wg2 * g, cv = bvv + wv0 * v2 + wv1 * v1 + wv2 * v;
                    u32x2 w; w.x = cvt_pk_bf16(silu_(cg[0]) * cv[0], silu_(cg[1]) * cv[1]); w.y = cvt_pk_bf16(silu_(cg[2]) * cv[2], silu_(cg[3]) * cv[3]);
                    *(u32x2*)(ACT + (size_t)R * FF + j4) = w;
                }
            }
        }
    }
};
#undef UPC_LOADW

template <class Epi, class Sched, bool ALIGN_EPI = false, bool SP2 = false>
__device__ __forceinline__ void gemm_phase(PG8_LAS unsigned char* lds, const Gemm g, const Sched& S, const Epi& E) {
    int tid_ = threadIdx.x; asm volatile("" : "+v"(tid_));
    const int tid = tid_, wid = __builtin_amdgcn_readfirstlane(tid >> 6), lane = tid & 63, wr = wid >> 2, wc = wid & 3, fr = lane & 15, fq = lane >> 4;
    const int K = g.K, nt = K / BK;
    unsigned voffA[2], voffB[2], voffB1[2];
#pragma unroll
    for (int i = 0; i < 2; ++i) { int R, C; stage_rc(tid * 16 + i * 8192, R, C); const int Rb = Epi::PERM ? ((R & ~31) + perm32(R & 31)) : R;
        int Ra = R; if constexpr (Epi::AMAP) Ra = E.amap(R); voffA[i] = (unsigned)(Ra * K + C) * 2u;     voffB[i] = (unsigned)(E.bmap(Rb) * K + C) * 2u; if constexpr (Epi::BMAP) voffB1[i] = (unsigned)(E.bmap(HALF + Rb) * K + C) * 2u; else voffB1[i] = 0u; }
    const size_t kstep = (size_t)(BK * 2);
    const size_t hstep = (size_t)HALF * K * 2;
    const unsigned* vB1 = Epi::BMAP ? voffB1 : voffB; const size_t h1step = Epi::BMAP ? (size_t)0 : hstep;
    const size_t tstep = 2 * hstep;
    const unsigned ldsw = (unsigned)wid * 1024u;
    const int aoff = lds_byte(wr * 64 + fr, fq * 8), boff = lds_byte(wc * 32 + fr, fq * 8);
#define PG8_SA(b, h) (((b) * 2 + (h)) * HTB)
#define PG8_SB(b, h) ((4 + (b) * 2 + (h)) * HTB)
#define PG8_STAGE(bufoff, gbase, voff) do { _Pragma("unroll") for (int _i = 0; _i < 2; ++_i) \
        __builtin_amdgcn_global_load_lds((const unsigned*)((const char*)(gbase) + (voff)[_i]), (PG8_LAS unsigned*)(lds + (bufoff) + ldsw + _i * 8192), 16, 0, 0); } while (0)
#define PG8_LDA(dst, b, h) do { _Pragma("unroll") for (int m = 0; m < 4; ++m) _Pragma("unroll") for (int k = 0; k < 2; ++k) dst[m][k] = *(const PG8_LAS bf16x8*)(lds + PG8_SA(b, h) + aoff + m * 2048 + k * 1024); } while (0)
#define PG8_LDB(dst, b, h) do { _Pragma("unroll") for (int n = 0; n < 2; ++n) _Pragma("unroll") for (int k = 0; k < 2; ++k) dst[n][k] = *(const PG8_LAS bf16x8*)(lds + PG8_SB(b, h) + boff + n * 2048 + k * 1024); } while (0)
#define PG8_MMA(ai, bj, At, Bt) do { __builtin_amdgcn_s_setprio(1); _Pragma("unroll") for (int m = 0; m < 4; ++m) _Pragma("unroll") for (int n = 0; n < 2; ++n) _Pragma("unroll") for (int k = 0; k < 2; ++k) \
        acc[ai][bj][m][n] = __builtin_amdgcn_mfma_f32_16x16x32_bf16(Bt[n][k], At[m][k], acc[ai][bj][m][n], 0, 0, 0); __builtin_amdgcn_s_setprio(0); } while (0)
#define PG8_WAIT_V(n) asm volatile("s_waitcnt vmcnt(" #n ")" ::: "memory")
#define PG8_WAIT_L(n) asm volatile("s_waitcnt lgkmcnt(" #n ")" ::: "memory")
#define PG8_BAR __builtin_amdgcn_s_barrier()
#define PG8_SCHED __builtin_amdgcn_sched_barrier(0)
    Unit cur, nxt; int ui = 0;
    if (!S.next(0, cur)) return;
    f32x4 acc[2][2][4][2];
#pragma unroll
    for (int a = 0; a < 2; ++a)
#pragma unroll
        for (int b = 0; b < 2; ++b)
#pragma unroll
            for (int m = 0; m < 4; ++m)
#pragma unroll
                for (int n = 0; n < 2; ++n) acc[a][b][m][n] = (f32x4){0.f, 0.f, 0.f, 0.f};
    bf16x8 At[4][2], B0[2][2], B1[2][2];
    const char* cA = (const char*)g.A + (size_t)cur.pm * tstep; const char* cB = (const char*)g.Bt + (size_t)cur.pn * tstep;
    S.a_ready(cur);
    if constexpr (SP2) {
        PG8_STAGE(PG8_SB(0, 0), cB, voffB); PG8_STAGE(PG8_SB(0, 1), cB + h1step, vB1); PG8_STAGE(PG8_SA(0, 0), cA, voffA); PG8_STAGE(PG8_SA(0, 1), cA + hstep, voffA);
        if (wr == 1) PG8_BAR;
        PG8_WAIT_V(2); PG8_BAR;
        PG8_STAGE(PG8_SB(1, 0), cB + kstep, voffB); PG8_STAGE(PG8_SA(1, 0), cA + kstep, voffA); PG8_STAGE(PG8_SB(1, 1), cB + h1step + kstep, vB1);
        PG8_WAIT_V(6); PG8_BAR;
    } else {
        PG8_STAGE(PG8_SB(0, 0), cB, voffB); PG8_STAGE(PG8_SA(0, 0), cA, voffA); PG8_STAGE(PG8_SB(0, 1), cB + h1step, vB1); PG8_STAGE(PG8_SA(0, 1), cA + hstep, voffA);
        if (wr == 1) PG8_BAR;
        PG8_WAIT_V(4); PG8_BAR;
        PG8_STAGE(PG8_SB(1, 0), cB + kstep, voffB); PG8_STAGE(PG8_SA(1, 0), cA + kstep, voffA); PG8_STAGE(PG8_SB(1, 1), cB + h1step + kstep, vB1);
        PG8_WAIT_V(6); PG8_BAR;
    }
    for (;;) {
        const bool has_next = S.next(ui + 1, nxt);
        const char* nA = has_next ? (const char*)g.A + (size_t)nxt.pm * tstep : cA; const char* nB = has_next ? (const char*)g.Bt + (size_t)nxt.pn * tstep : cB;
        for (int t = 0; t < nt; t += 2) {
            const bool last = (t == nt - 2);
            const char* a1 = cA + (size_t)(t + 1) * kstep;
            const char* a2 = last ? nA : cA + (size_t)(t + 2) * kstep; const char* b2 = last ? nB : cB + (size_t)(t + 2) * kstep;
            const char* a3 = a2 + kstep; const char* b3 = b2 + kstep;
            if (last && has_next) S.a_ready(nxt);
            if constexpr (SP2) {
            PG8_LDB(B0, 0, 0); PG8_LDB(B1, 0, 1); PG8_SCHED; PG8_LDA(At, 0, 0); PG8_STAGE(PG8_SA(1, 1), a1 + hstep, voffA);
            PG8_WAIT_V(8); PG8_WAIT_L(0); PG8_BAR; PG8_MMA(0, 0, At, B0); PG8_MMA(0, 1, At, B1); PG8_BAR; PG8_SCHED;
            PG8_LDA(At, 0, 1); PG8_STAGE(PG8_SB(0, 0), b2, voffB); PG8_STAGE(PG8_SB(0, 1), b2 + h1step, vB1); PG8_STAGE(PG8_SA(0, 0), a2, voffA);
            PG8_WAIT_V(8); PG8_WAIT_L(0); PG8_BAR; PG8_MMA(1, 0, At, B0); PG8_MMA(1, 1, At, B1); PG8_BAR; PG8_SCHED;
            PG8_LDB(B0, 1, 0); PG8_LDB(B1, 1, 1); PG8_SCHED; PG8_LDA(At, 1, 0); PG8_STAGE(PG8_SA(0, 1), a2 + hstep, voffA);
            PG8_WAIT_V(8); PG8_WAIT_L(0); PG8_BAR; PG8_MMA(0, 0, At, B0); PG8_MMA(0, 1, At, B1); PG8_BAR; PG8_SCHED;
            PG8_LDA(At, 1, 1); PG8_STAGE(PG8_SB(1, 0), b3, voffB); PG8_STAGE(PG8_SB(1, 1), b3 + h1step, vB1); PG8_STAGE(PG8_SA(1, 0), a3, voffA);
            PG8_WAIT_V(8); PG8_WAIT_L(0); PG8_BAR; PG8_MMA(1, 0, At, B0); PG8_MMA(1, 1, At, B1); PG8_BAR; PG8_SCHED;
            } else {
            PG8_LDB(B0, 0, 0); PG8_SCHED; PG8_LDA(At, 0, 0); PG8_STAGE(PG8_SA(1, 1), a1 + hstep, voffA);
            PG8_WAIT_L(8); PG8_BAR; PG8_WAIT_L(0); PG8_MMA(0, 0, At, B0); PG8_BAR; PG8_SCHED;
            PG8_LDB(B1, 0, 1); PG8_STAGE(PG8_SB(0, 0), b2, voffB);
            PG8_BAR; PG8_WAIT_L(0); PG8_MMA(0, 1, At, B1); PG8_BAR;
            PG8_LDA(At, 0, 1); PG8_STAGE(PG8_SA(0, 0), a2, voffA);
            PG8_BAR; PG8_WAIT_L(0); PG8_MMA(1, 0, At, B0); PG8_BAR; PG8_SCHED;
            PG8_STAGE(PG8_SB(0, 1), b2 + h1step, vB1);
            PG8_WAIT_V(6); PG8_BAR; PG8_MMA(1, 1, At, B1); PG8_BAR;
            PG8_LDB(B0, 1, 0); PG8_SCHED; PG8_LDA(At, 1, 0); PG8_STAGE(PG8_SA(0, 1), a2 + hstep, voffA);
            PG8_WAIT_L(8); PG8_BAR; PG8_WAIT_L(0); PG8_MMA(0, 0, At, B0); PG8_BAR; PG8_SCHED;
            PG8_LDB(B1, 1, 1); PG8_STAGE(PG8_SB(1, 0), b3, voffB);
            PG8_BAR; PG8_WAIT_L(0); PG8_MMA(0, 1, At, B1); PG8_BAR;
            PG8_LDA(At, 1, 1); PG8_STAGE(PG8_SA(1, 0), a3, voffA);
            PG8_BAR; PG8_WAIT_L(0); PG8_MMA(1, 0, At, B0); PG8_BAR; PG8_SCHED;
            PG8_STAGE(PG8_SB(1, 1), b3 + h1step, vB1);
            PG8_WAIT_V(6); PG8_BAR; PG8_MMA(1, 1, At, B1); PG8_BAR;
            }
        }
        if constexpr (ALIGN_EPI) { if (wr == 0) PG8_BAR; }
        if constexpr (!Epi::AFTER_DRAIN) { E(acc, cur, wr, wc, fr, fq); S.done(cur); }
        if (!has_next) break;
#pragma unroll
        for (int a = 0; a < 2; ++a)
#pragma unroll
            for (int b = 0; b < 2; ++b)
#pragma unroll
                for (int m = 0; m < 4; ++m)
#pragma unroll
                    for (int n = 0; n < 2; ++n) acc[a][b][m][n] = (f32x4){0.f, 0.f, 0.f, 0.f};
        cur = nxt; cA = nA; cB = nB; ++ui;
        if constexpr (ALIGN_EPI) { if (wr == 1) PG8_BAR; }
    }
    PG8_WAIT_V(0);
    if constexpr (!ALIGN_EPI) { if (wr == 0) PG8_BAR; }
    PG8_BAR;
    if constexpr (Epi::AFTER_DRAIN) { E.fused(acc, cur, wr, wc, fr, fq, lds, wid, lane); S.done(cur); }
#undef PG8_SA
#undef PG8_SB
#undef PG8_STAGE
#undef PG8_LDA
#undef PG8_LDB
#undef PG8_MMA
#undef PG8_WAIT_V
#undef PG8_WAIT_L
#undef PG8_BAR
#undef PG8_SCHED
}
}

#define XB_TMO      128
#define XB_XCNT(j)  (256  + 64 * (j))
#define XB_XSUB(j)  (1280 + 64 * (j))
#define XB_XGEN(j)  (2304 + 64 * (j))
#define XB_TOP      3328
#define XB_TOPGEN   3392
#define XCD_BAR_WORDS 3456
#define XB_SPIN_CAP (1u << 18)

__device__ __forceinline__ unsigned xb_ld(unsigned* p)              { return __hip_atomic_load(p, __ATOMIC_RELAXED, __HIP_MEMORY_SCOPE_AGENT); }
__device__ __forceinline__ unsigned xb_add(unsigned* p, unsigned v) { return __hip_atomic_fetch_add(p, v, __ATOMIC_RELAXED, __HIP_MEMORY_SCOPE_AGENT); }
__device__ __forceinline__ unsigned xb_xcc_id() { return (unsigned)__builtin_amdgcn_s_getreg((3 << 11) | 20) & 0xFu; }
#define XB_SPIN(cond, bar) do { unsigned _sp = 0; while (cond) { __builtin_amdgcn_s_sleep(1); \
    if ((++_sp & 255u) == 0u) { if (xb_ld(&(bar)[XB_TMO])) break; if (_sp > XB_SPIN_CAP) { atomicAdd(&(bar)[XB_TMO], 1u); break; } } } } while (0)

struct XcdBarrier {
    unsigned* bar; unsigned x;
    volatile LAS unsigned* st;
};

__device__ __forceinline__ XcdBarrier xcd_barrier_post(unsigned* bar, volatile LAS unsigned* st) {
    XcdBarrier b; b.bar = bar; b.x = xb_xcc_id(); b.st = st;
    if (threadIdx.x == 0) (void)xb_add(&bar[XB_XCNT(b.x)], 1u);
    return b;
}
__device__ __forceinline__ void xcd_barrier_complete(unsigned* bar, unsigned x, unsigned& nloc, unsigned& nx) {
    const unsigned G = gridDim.x * gridDim.y * gridDim.z;
    unsigned sum, cnt, mine, sp = 0u;
    for (;;) {
        sum = 0u; cnt = 0u; mine = 0u;
#pragma unroll
        for (unsigned j = 0; j < 16; ++j) { const unsigned c = xb_ld(&bar[XB_XCNT(j)]); sum += c; cnt += (c > 0u) ? 1u : 0u; mine = (j == x) ? c : mine; }
        if (sum == G) break;
        __builtin_amdgcn_s_sleep(1);
        if ((++sp & 255u) == 0u) { if (xb_ld(&bar[XB_TMO])) break; if (sp > XB_SPIN_CAP) { atomicAdd(&bar[XB_TMO], 1u); break; } }
    }
    nloc = mine > 0u ? mine : 1u; nx = cnt > 0u ? cnt : 1u;
}

__device__ __forceinline__ void xcd_barrier(const XcdBarrier& b) {
    asm volatile("s_waitcnt vmcnt(0)" ::: "memory");
    __syncthreads();
    if (threadIdx.x == 0) {
        unsigned* bar = b.bar;
        __builtin_amdgcn_s_waitcnt(0);
        unsigned nloc = b.st[0], nx = b.st[1];
        if (nloc == 0u) { xcd_barrier_complete(bar, b.x, nloc, nx); b.st[0] = nloc; b.st[1] = nx; }
        const unsigned old = xb_add(&bar[XB_XSUB(b.x)], 1u);
        const unsigned gen = old / nloc;
        if (old + 1u == (gen + 1u) * nloc) {
            __builtin_amdgcn_fence(__ATOMIC_RELEASE, "agent");
            asm volatile("s_waitcnt vmcnt(0)" ::: "memory");
            const unsigned og = xb_add(&bar[XB_TOP], 1u);
            const unsigned tg = og / nx;
            if (og + 1u == (tg + 1u) * nx) xb_add(&bar[XB_TOPGEN], 1u);
            else XB_SPIN(xb_ld(&bar[XB_TOPGEN]) == tg, bar);
            __builtin_amdgcn_fence(__ATOMIC_ACQUIRE, "agent");
            xb_add(&bar[XB_XGEN(b.x)], 1u);
            asm volatile("s_waitcnt vmcnt(0)" ::: "memory");
        } else {
            XB_SPIN(xb_ld(&bar[XB_XGEN(b.x)]) == gen, bar);
            __builtin_amdgcn_fence(__ATOMIC_ACQUIRE, "agent");
            asm volatile("s_waitcnt vmcnt(0)" ::: "memory");
        }
    }
    __syncthreads();
}

struct Args { const float* in[39]; float* out; unsigned char* ws; int ph_lo, ph_hi, li, pad; };
enum { I_XP = 0, I_XS, I_MEM, I_C1, I_C4, I_C16, I_SRE, I_SIM, I_SCONV, I_CMEM, I_NMIX, I_WIN, I_QN, I_KN, I_LRE, I_LIM, I_LDT, I_BRE, I_BIM, I_CRE, I_CIM, I_SD, I_WGLU, I_BGLU,
       I_AON, I_SON, I_WOUT, I_NX, I_NMEM, I_WXQ, I_WXKV, I_XQN, I_XKN, I_WXO, I_NFFN, I_WUP, I_CONVW, I_CONVB, I_WDOWN };
constexpr size_t O_YP = 0, O_YS = O_YP + (size_t)MP * D, O_KV1P = O_YS + (size_t)MS * D, O_KV4P = O_KV1P + (size_t)BP * 128 * 512, O_KV16P = O_KV4P + (size_t)BP * 512 * 512,
    O_SREP = O_KV16P + (size_t)BP * 2048 * 512, O_SIMP = O_SREP + BP * 1024, O_CONVP = O_SIMP + BP * 1024, O_MEMKV = O_CONVP + (size_t)BP * 2 * FF2, O_KV1S = O_MEMKV + (size_t)MM * 2048,
    O_KV4S = O_KV1S + (size_t)MS * 512, O_KV16S = O_KV4S + (size_t)MS * 512, O_SRES = O_KV16S + (size_t)MS * 512, O_SIMS = O_SRES + BS * 1024, O_CONVS = O_SIMS + BS * 1024, O_END = O_CONVS + (size_t)BS * 2 * FF2;
static_assert(O_END == 35102720 && O_KV1P == O_KV1P_ && O_KV4P == O_KV4P_ && O_KV16P == O_KV16P_ && O_KV1S == O_KV1S_ && O_KV4S == O_KV4S_ && O_KV16S == O_KV16S_, "output map");

template <int MODE> __device__ __forceinline__ int rowmap(int n) {
    if (MODE == 1) return (n & ~255) + 128 * ((n >> 5) & 1) + 32 * ((n >> 6) & 3) + (n & 31);
    if (MODE == 2) { return n < FF ? 256 * (n >> 7) + (n & 127) : 256 * ((n - FF) >> 7) + 128 + ((n - FF) & 127); }
    return n;
}
template <int MODE> __device__ __forceinline__ void p0_transpose_item(const float* W, int K, int N, bf16* WT, const float* gk, LAS float* scr, int item, int lane) {
    const int nblk = N / 32, kb = item / nblk, nb = item % nblk, k0 = 64 * kb, n0 = 32 * nb;
    float wv[32];
#pragma unroll
    for (int i = 0; i < 32; ++i) wv[i] = W[(size_t)(k0 + 2 * i + (lane >> 5)) * N + n0 + (lane & 31)];
    if (gk) {
#pragma unroll
        for (int i = 0; i < 32; ++i) wv[i] *= gk[k0 + 2 * i + (lane >> 5)]; }
#pragma unroll
    for (int i = 0; i < 32; ++i) scr[(2 * i + (lane >> 5)) * 33 + (lane & 31)] = wv[i];
    LDS_WAIT(); asm volatile("" ::: "memory");
    const int c = lane & 7;
#pragma unroll
    for (int j = 0; j < 4; ++j) { const int n = (lane >> 3) + 8 * j; const LAS float* s = scr + (8 * c) * 33 + n;
        u32x4 o; o.x = pk2(s[0 * 33], s[1 * 33]); o.y = pk2(s[2 * 33], s[3 * 33]); o.z = pk2(s[4 * 33], s[5 * 33]); o.w = pk2(s[6 * 33], s[7 * 33]);
        *(GAS u32x4*)(WT + (size_t)rowmap<MODE>(n0 + n) * K + k0 + 8 * c) = o; }
    LDS_WAIT(); asm volatile("" ::: "memory");
}
__device__ __forceinline__ void p0_tr_load(const float* W, int N, int item, int lane, float (&wv)[32]) {
    const int nblk = N / 32, kb = item / nblk, nb = item % nblk, k0 = 64 * kb, n0 = 32 * nb;
#pragma unroll
    for (int i = 0; i < 32; ++i) wv[i] = W[(size_t)(k0 + 2 * i + (lane >> 5)) * N + n0 + (lane & 31)];
}
template <int MODE> __device__ __forceinline__ void p0_tr_store(int K, int N, bf16* WT, const float* gk, LAS float* scr, int item, int lane, const float (&wv)[32]) {
    const int nblk = N / 32, kb = item / nblk, nb = item % nblk, k0 = 64 * kb, n0 = 32 * nb;
    const int c = lane & 7;
    f32x4 g0 = {1.f, 1.f, 1.f, 1.f}, g1 = g0;
    if (gk) { g0 = *(const f32x4*)(gk + k0 + 8 * c); g1 = *(const f32x4*)(gk + k0 + 8 * c + 4); }
#pragma unroll
    for (int i = 0; i < 32; ++i) scr[(2 * i + (lane >> 5)) * 33 + (lane & 31)] = wv[i];
    LDS_WAIT(); asm volatile("" ::: "memory");
#pragma unroll
    for (int j = 0; j < 4; ++j) { const int n = (lane >> 3) + 8 * j; const LAS float* s = scr + (8 * c) * 33 + n;
        u32x4 o; o.x = pk2(s[0 * 33] * g0[0], s[1 * 33] * g0[1]); o.y = pk2(s[2 * 33] * g0[2], s[3 * 33] * g0[3]); o.z = pk2(s[4 * 33] * g1[0], s[5 * 33] * g1[1]); o.w = pk2(s[6 * 33] * g1[2], s[7 * 33] * g1[3]);
        *(GAS u32x4*)(WT + (size_t)rowmap<MODE>(n0 + n) * K + k0 + 8 * c) = o; }
    LDS_WAIT(); asm volatile("" ::: "memory");
}
template <int MODE> __device__ __forceinline__ void p0_transpose_stream(const float* W, int K, int N, bf16* WT, const float* gk, LAS float* scr, int it, int nitems, int stride, int lane) {
    if (it >= nitems) return;
    float wa[32], wb[32];
    p0_tr_load(W, N, it, lane, wa);
    for (;;) {
        const int i1 = it + stride; if (i1 < nitems) p0_tr_load(W, N, i1, lane, wb);
        p0_tr_store<MODE>(K, N, WT, gk, scr, it, lane, wa);
        if (i1 >= nitems) break;
        const int i2 = i1 + stride; if (i2 < nitems) p0_tr_load(W, N, i2, lane, wa);
        p0_tr_store<MODE>(K, N, WT, gk, scr, i1, lane, wb);
        if (i2 >= nitems) break;
        it = i2;
    }
}
__device__ __forceinline__ void rms_rows2_to_bf16(const float* xrow0, const float* xrow1, const f32x4 (&gg)[4], bf16* orow0, bf16* orow1, int lane) {
    const f32x4* xr0 = (const f32x4*)xrow0 + lane; const f32x4* xr1 = (const f32x4*)xrow1 + lane;
    f32x4 v0[4], v1[4]; float s0 = 0.f, s1 = 0.f;
#pragma unroll
    for (int j = 0; j < 4; ++j) { v0[j] = xr0[64 * j]; v1[j] = xr1[64 * j]; }
#pragma unroll
    for (int j = 0; j < 4; ++j) { s0 += dot4(v0[j]); s1 += dot4(v1[j]); }
#pragma unroll
    for (int o = 1; o < 64; o <<= 1) { s0 += __shfl_xor(s0, o); s1 += __shfl_xor(s1, o); }
    const float r0 = frsq(s0 * (1.0f / D) + EPS), r1 = frsq(s1 * (1.0f / D) + EPS);
    u32x2* o0 = (u32x2*)orow0 + lane; u32x2* o1 = (u32x2*)orow1 + lane;
#pragma unroll
    for (int j = 0; j < 4; ++j) { const f32x4 a = v0[j] * r0 * gg[j], c = v1[j] * r1 * gg[j];
        u32x2 w; w.x = cvt_pk_bf16(a[0], a[1]); w.y = cvt_pk_bf16(a[2], a[3]); o0[64 * j] = w;
        u32x2 z; z.x = cvt_pk_bf16(c[0], c[1]); z.y = cvt_pk_bf16(c[2], c[3]); o1[64 * j] = z; }
}

__device__ __forceinline__ int pi23(int m) { return (m & ~12) | ((m & 4) << 1) | ((m & 8) >> 1); }
__device__ __forceinline__ void memk_fix_item(float* memkv, const float* mss, const float* xkn, const float* xqn, bf16* MEMK, int Rm, int lane) {
    const f32x4 gk = *(const f32x4*)(xkn + 4 * lane), gq = *(const f32x4*)(xqn + 4 * lane);
    f32x4 v[4], s[4];
#pragma unroll
    for (int h = 0; h < 4; ++h) { v[h] = *(const f32x4*)(memkv + (size_t)Rm * 2048 + h * 256 + 4 * lane); s[h] = *(const f32x4*)(mss + (size_t)Rm * 16 + 4 * h); }
#pragma unroll
    for (int h = 0; h < 4; ++h) {
        const float rs = frsq(((s[h][0] + s[h][1]) + (s[h][2] + s[h][3])) * (1.0f / 256.0f) + EPS);
        const f32x4 kn = v[h] * rs * gk; *(f32x4*)(memkv + (size_t)Rm * 2048 + h * 256 + 4 * lane) = kn; const f32x4 kq = kn * gq;
        u32x2 w; w.x = cvt_pk_bf16(kq[0], kq[1]); w.y = cvt_pk_bf16(kq[2], kq[3]); *(u32x2*)(MEMK + (size_t)Rm * 1024 + h * 256 + 4 * lane) = w;
    }
}
__device__ __forceinline__ void ssm_bfrags(const Args& a, const float* ssmc, int g, int lane, bf16x8 (&bb)[4]) {
    const int n = lane & 31, hi = lane >> 5;
#pragma unroll
    for (int s2 = 0; s2 < 2; ++s2) { const int st = g * 64 + 32 * s2 + n; const f32x4 c0 = *(const f32x4*)(ssmc + (size_t)st * 8); const float cr = c0[2], ci = c0[3];
        const f32x4 r0 = *(const f32x4*)(a.in[I_BRE] + (size_t)st * 16 + 8 * hi), r1 = *(const f32x4*)(a.in[I_BRE] + (size_t)st * 16 + 8 * hi + 4);
        const f32x4 i0 = *(const f32x4*)(a.in[I_BIM] + (size_t)st * 16 + 8 * hi), i1 = *(const f32x4*)(a.in[I_BIM] + (size_t)st * 16 + 8 * hi + 4);
        const f32x4 pr0 = r0 * cr - i0 * ci, pr1 = r1 * cr - i1 * ci, pi0 = i0 * cr + r0 * ci, pi1 = i1 * cr + r1 * ci;
        bb[s2] = pack8(pr0[0], pr0[1], pr0[2], pr0[3], pr1[0], pr1[1], pr1[2], pr1[3]); bb[2 + s2] = pack8(pi0[0], pi0[1], pi0[2], pi0[3], pi1[0], pi1[1], pi1[2], pi1[3]); }
}
__device__ __forceinline__ bf16x8 ssm_loadu(const float* U, int row0, int nrows, int g, int lane) {
    const int m = lane & 31, hi = lane >> 5; const int row = row0 + (m < nrows ? m : (m & (nrows - 1)));
    const f32x4 u0 = *(const f32x4*)(U + (size_t)row * 256 + g * 16 + 8 * hi), u1 = *(const f32x4*)(U + (size_t)row * 256 + g * 16 + 8 * hi + 4);
    return pack8(u0[0], u0[1], u0[2], u0[3], u1[0], u1[1], u1[2], u1[3]);
}
__device__ __forceinline__ void ssm_xcompute(bf16x8 ua, const bf16x8 (&bb)[4], f32x16 (&xr)[2], f32x16 (&xi)[2]) {
    const f32x16 z = {0.f, 0.f, 0.f, 0.f, 0.f, 0.f, 0.f, 0.f, 0.f, 0.f, 0.f, 0.f, 0.f, 0.f, 0.f, 0.f};
    f32x16 t0 = __builtin_amdgcn_mfma_f32_32x32x16_bf16(ua, bb[0], z, 0, 0, 0), t1 = __builtin_amdgcn_mfma_f32_32x32x16_bf16(ua, bb[1], z, 0, 0, 0);
    f32x16 t2 = __builtin_amdgcn_mfma_f32_32x32x16_bf16(ua, bb[2], z, 0, 0, 0), t3 = __builtin_amdgcn_mfma_f32_32x32x16_bf16(ua, bb[3], z, 0, 0, 0);
#pragma unroll
    for (int r = 0; r < 16; ++r) {
        const float a0 = t0[r], a1 = t1[r], a2 = t2[r], a3 = t3[r];
        const auto sr = __builtin_amdgcn_permlane32_swap(__float_as_uint(a0), __float_as_uint(a1), false, false);
        const unsigned s0 = sr[0], s1 = sr[1];
        xr[0][r] = __uint_as_float(s0); xr[1][r] = __uint_as_float(s1);
        const auto si = __builtin_amdgcn_permlane32_swap(__float_as_uint(a2), __float_as_uint(a3), false, false);
        const unsigned s2 = si[0], s3 = si[1];
        xi[0][r] = __uint_as_float(s2); xi[1][r] = __uint_as_float(s3); }
    __builtin_amdgcn_sched_barrier(0); asm volatile("s_nop 7" ::: "memory"); __builtin_amdgcn_sched_barrier(0);
}
#define SSM_XR(t) xr[((t) >> 2) & 1][((t) & 3) + 4 * ((t) >> 3)]
#define SSM_XI(t) xi[((t) >> 2) & 1][((t) & 3) + 4 * ((t) >> 3)]
__device__ __forceinline__ void ssm_a_item(const Args& a, const float* U, const float* ssmc, float* SSMF, LAS float* uL, int it, int lane) {
    const int g = it & 15, bc = it >> 4, b = bc / 31, c = bc - b * 31;
    const f32x4 c0 = *(const f32x4*)(ssmc + (size_t)(g * 64 + lane) * 8);
    const float ar = c0[0], ai = c0[1];
    bf16x8 bb[4]; ssm_bfrags(a, ssmc, g, lane, bb);
    float hr = 0.f, hi = 0.f;
    bf16x8 ua2[2]; ua2[0] = ssm_loadu(U, b * 2048 + c * 64, 32, g, lane); ua2[1] = ssm_loadu(U, b * 2048 + c * 64 + 32, 32, g, lane);
#pragma unroll
    for (int blk = 0; blk < 2; ++blk) {
        f32x16 xr[2], xi[2]; ssm_xcompute(ua2[blk], bb, xr, xi);
#pragma unroll
        for (int t = 0; t < 32; ++t) { const float nr = fmaf(ar, hr, fmaf(-ai, hi, SSM_XR(t))), ni = fmaf(ar, hi, fmaf(ai, hr, SSM_XI(t))); hr = nr; hi = ni; }
    }
    *(f32x2*)(SSMF + ((size_t)((b * 32 + c) * 16 + g) * 64 + lane) * 2) = (f32x2){hr, hi};
    (void)uL;
}
constexpr int SAB = 4;
struct SaBatch { f32x4 k[SAB], v[SAB]; };
__device__ __forceinline__ void sa_load(SaBatch& B, const float* cb, unsigned loff, int t, int dil, int nvalid, int i0) {
#pragma unroll
    for (int j = 0; j < SAB; ++j) { const int i = i0 + j, idx = i < nvalid ? t + i * dil : t; const char* rp = (const char*)(cb + (size_t)idx * 512);
        B.k[j] = __builtin_nontemporal_load((const f32x4*)(rp + loff)); B.v[j] = __builtin_nontemporal_load((const f32x4*)(rp + 1024 + loff)); }
}
__device__ __forceinline__ void sa_compute(const SaBatch& B, f32x4 q, int nvalid, int i0, float& m, float& l, f32x4& o) {
    float s[SAB]; float mb = m;
#pragma unroll
    for (int j = 0; j < SAB; ++j) { float d = (q[0] * B.k[j][0] + q[1] * B.k[j][1]) + (q[2] * B.k[j][2] + q[3] * B.k[j][3]);
        d += __shfl_xor(d, 1); d += __shfl_xor(d, 2); d += __shfl_xor(d, 4); d += __shfl_xor(d, 8);
        s[j] = (i0 + j) < nvalid ? d : -1e30f; mb = fmaxf(mb, s[j]); }
    const float sc = fexp2(m - mb); l *= sc; o = o * sc; m = mb;
#pragma unroll
    for (int j = 0; j < SAB; ++j) { const float p = fexp2(s[j] - mb); l += p; o = o + B.v[j] * p; }
}
__device__ __forceinline__ void sattn_item(const Args& a, const bf16* Q, bf16* AO, float* LSE, int it, int lane) {
    const int g = it >> 9, rem = it & 511, b = rem >> 2, t = rem & 3;
    const int dil = 1 << (2 * g), nbuf = 128 << (2 * g);
    const int R = MP + 4 * b + t, hh = lane >> 4, dq = (lane & 15) * 4;
    const u32x2 qw = *(const u32x2*)(Q + (size_t)R * AW + g * 256 + hh * 64 + dq);
    const f32x4 q = {bf2f(qw.x & 0xffffu), bf2f(qw.x >> 16), bf2f(qw.y & 0xffffu), bf2f(qw.y >> 16)};
    const float* cb = a.in[I_C1 + g] + (size_t)b * nbuf * 512; const unsigned loff = 4u * (unsigned)(hh * 64 + dq);
    const float* nb = a.out + (g == 0 ? O_KV1S : (g == 1 ? O_KV4S : O_KV16S)) + (size_t)(4 * b) * 512 + hh * 64 + dq;
    const int nvalid = g == 0 ? 128 - t : 128;
    float m = -1e30f, l = 0.f; f32x4 o = {0.f, 0.f, 0.f, 0.f};
    SaBatch A, B; sa_load(A, cb, loff, t, dil, nvalid, 0);
#pragma unroll 1
    for (int i0 = 0; i0 < 128; i0 += 2 * SAB) {
        sa_load(B, cb, loff, t, dil, nvalid, i0 + SAB);
        sa_compute(A, q, nvalid, i0, m, l, o);
        if (i0 + 2 * SAB < 128) sa_load(A, cb, loff, t, dil, nvalid, i0 + 2 * SAB);
        sa_compute(B, q, nvalid, i0 + SAB, m, l, o);
    }
    {
        f32x4 kk[4], vv[4]; float s[4]; float mb = m;
#pragma unroll
        for (int j = 0; j < 4; ++j) { const float* rp = nb + (size_t)j * 512; kk[j] = *(const f32x4*)rp; vv[j] = *(const f32x4*)(rp + 256); }
#pragma unroll
        for (int j = 0; j < 4; ++j) { float d = (q[0] * kk[j][0] + q[1] * kk[j][1]) + (q[2] * kk[j][2] + q[3] * kk[j][3]);
            d += __shfl_xor(d, 1); d += __shfl_xor(d, 2); d += __shfl_xor(d, 4); d += __shfl_xor(d, 8);
            const bool ok = g == 0 ? (j <= t) : (j == t); s[j] = ok ? d : -1e30f; mb = fmaxf(mb, s[j]); }
        const float sc = fexp2(m - mb); l *= sc; o = o * sc; m = mb;
#pragma unroll
        for (int j = 0; j < 4; ++j) { const float p = fexp2(s[j] - mb); l += p; o = o + vv[j] * p; }
    }
    const float il = frcp(l); o = o * il;
    u32x2 w; w.x = cvt_pk_bf16(o[0], o[1]); w.y = cvt_pk_bf16(o[2], o[3]); *(u32x2*)(AO + (size_t)R * AW + g * 256 + hh * 64 + dq) = w;
    if ((lane & 15) == 0) LSE[(size_t)R * 12 + g * 4 + hh] = (m + flog2(l)) * LN2;
}
__device__ __forceinline__ void pattn_item(const bf16* Q, const bf16* Kb, const bf16* VT, bf16* AO, float* LSE, int it, int lane) {
    const int g = it >> 11; int rem = it & 2047;
    const int sh = 2 * g, dil = 1 << sh, S = 2048 >> sh, nql = 6 - sh;
    const int qt = rem & ((1 << nql) - 1); rem >>= nql; const int res = rem & (dil - 1); rem >>= sh; const int hh = rem & 3, b = rem >> 2;
    const int n = lane & 31, hi = lane >> 5;
    const int s_q = 32 * qt + n, qrow = b * 2048 + s_q * dil + res;
    const int coff = g * 256 + hh * 64 + 32 * hi;
    bf16x8 qf[4];
    { const bf16* qp = Q + (size_t)qrow * AW + coff;
#pragma unroll
      for (int d0 = 0; d0 < 4; ++d0) qf[d0] = *(const bf16x8*)(qp + 8 * d0); }
    f32x16 sc[5];
    const int pm = pi23(n);
#pragma unroll
    for (int kt = 0; kt < 5; ++kt) {
        const int sb = 32 * qt - 128 + 32 * kt; int sk = sb + pm; sk = sk < 0 ? 0 : sk;
        const bf16* kp = Kb + (size_t)(b * 2048 + sk * dil + res) * AW + coff;
        bf16x8 kf[4];
#pragma unroll
        for (int d0 = 0; d0 < 4; ++d0) kf[d0] = *(const bf16x8*)(kp + 8 * d0);
        f32x16 acc = {0.f, 0.f, 0.f, 0.f, 0.f, 0.f, 0.f, 0.f, 0.f, 0.f, 0.f, 0.f, 0.f, 0.f, 0.f, 0.f};
#pragma unroll
        for (int d0 = 0; d0 < 4; ++d0) acc = __builtin_amdgcn_mfma_f32_32x32x16_bf16(kf[d0], qf[d0], acc, 0, 0, 0);
        sc[kt] = acc;
    }
    float mx = -1e30f;
#pragma unroll
    for (int kt = 0; kt < 5; ++kt) { const int sb = 32 * qt - 128 + 32 * kt;
#pragma unroll
        for (int r = 0; r < 16; ++r) { const int sk = sb + 16 * (r >> 3) + 8 * hi + (r & 7); const int dl = s_q - sk; const bool ok = (sk >= 0) && (dl >= 0) && (dl <= 128);
            const float v = ok ? sc[kt][r] : -1e30f; sc[kt][r] = v; mx = fmaxf(mx, v); } }
    mx = fmaxf(mx, __shfl_xor(mx, 32));
    float l = 0.f;
#pragma unroll
    for (int kt = 0; kt < 5; ++kt)
#pragma unroll
        for (int r = 0; r < 16; ++r) { const float p = fexp2(sc[kt][r] - mx); sc[kt][r] = p; l += p; }
    l += __shfl_xor(l, 32);
    f32x16 o[2];
#pragma unroll
    for (int dt = 0; dt < 2; ++dt) o[dt] = (f32x16){0.f, 0.f, 0.f, 0.f, 0.f, 0.f, 0.f, 0.f, 0.f, 0.f, 0.f, 0.f, 0.f, 0.f, 0.f, 0.f};
    const bf16* vbase = VT + (size_t)((g * 4 + hh) * 8 + b) * 64 * 2048;
#pragma unroll
    for (int kt = 0; kt < 5; ++kt) {
        int sb = 32 * qt - 128 + 32 * kt; sb = sb < 0 ? 0 : sb;
        const bf16* vp = vbase + (size_t)((res * S + sb) >> 5) * 2048 + n * 32 + 8 * hi;
#pragma unroll
        for (int jj = 0; jj < 2; ++jj) {
            const bf16x8 pb = pack8(sc[kt][8 * jj + 0], sc[kt][8 * jj + 1], sc[kt][8 * jj + 2], sc[kt][8 * jj + 3], sc[kt][8 * jj + 4], sc[kt][8 * jj + 5], sc[kt][8 * jj + 6], sc[kt][8 * jj + 7]);
#pragma unroll
            for (int dt = 0; dt < 2; ++dt) { const bf16x8 vf = *(const bf16x8*)(vp + dt * 1024 + 16 * jj); o[dt] = __builtin_amdgcn_mfma_f32_32x32x16_bf16(vf, pb, o[dt], 0, 0, 0); }
        }
    }
    const float il = frcp(l);
    bf16* op = AO + (size_t)qrow * AW + g * 256 + hh * 64 + 4 * hi;
#pragma unroll
    for (int dt = 0; dt < 2; ++dt)
#pragma unroll
        for (int r4 = 0; r4 < 4; ++r4) { u32x2 w; w.x = cvt_pk_bf16(o[dt][4 * r4] * il, o[dt][4 * r4 + 1] * il); w.y = cvt_pk_bf16(o[dt][4 * r4 + 2] * il, o[dt][4 * r4 + 3] * il);
            *(u32x2*)(op + 32 * dt + 8 * r4) = w; }
    if (hi == 0) LSE[(size_t)qrow * 12 + g * 4 + hh] = (mx + flog2(l)) * LN2;
}

constexpr int PK_ROW = 144, PK_SLOT = 32 * PK_ROW, PV_OFF = 12 * PK_SLOT;
__device__ __forceinline__ void pattn_wg_item(const bf16* Q, const bf16* Kb, const bf16* VT, bf16* AO, float* LSE, LAS unsigned char* lds, int item, int wave, int lane, int tid) {
    const int g = item >> 8, r = item & 255, hh = (r >> 3) & 3, b = r >> 5;
    const int sh = 2 * g, dil = 1 << sh, S = 2048 >> sh;
    const int qblk = g == 0 ? (r & 7) : (r & 1), resb = g == 0 ? 0 : (g == 1 ? ((r >> 1) & 3) : 2 * (r & 7));
    const int pc = tid & 255;
    u32x4 kreg[6], vreg[6];
#pragma unroll
    for (int i = 0; i < 6; ++i) { const int T = (tid >> 8) + 2 * i;
        int sb, rs; bool ok;
        if (g < 2) { sb = 256 * qblk - 128 + 32 * T; rs = resb; ok = sb >= 0; } else { sb = 32 * (T & 3); rs = resb + (T >> 2); ok = T < 8; }
        if (ok) { const int t = (sb + (pc >> 3)) * dil + rs;
            kreg[i] = *(const u32x4*)(Kb + (size_t)(b * 2048 + t) * AW + g * 256 + hh * 64 + 8 * (pc & 7));
            vreg[i] = *(const u32x4*)(VT + (size_t)(b * 2048 + t) * AW + g * 256 + hh * 64 + 8 * (pc & 7)); }
        else { kreg[i] = (u32x4){0u, 0u, 0u, 0u}; vreg[i] = kreg[i]; } }
    const int n = lane & 31, hi = lane >> 5;
    const int qt = g < 2 ? 8 * qblk + wave : (wave & 3), resw = g < 2 ? resb : resb + (wave >> 2);
    const int slot_base = g < 2 ? wave : 4 * (wave >> 2) + (wave & 3) - 4;
    const int s_q = 32 * qt + n, qrow = b * 2048 + s_q * dil + resw;
    bf16x8 qf[4];
    { const bf16* qp = Q + (size_t)qrow * AW + g * 256 + hh * 64 + 32 * hi;
#pragma unroll
      for (int d0 = 0; d0 < 4; ++d0) qf[d0] = *(const bf16x8*)(qp + 8 * d0); }
#pragma unroll
    for (int i = 0; i < 6; ++i) { const int T = (tid >> 8) + 2 * i;
        *(LAS u32x4*)(lds + T * PK_SLOT + (pc >> 3) * PK_ROW + (pc & 7) * 16) = kreg[i];
        *(LAS u32x4*)(lds + PV_OFF + T * PK_SLOT + (pc >> 3) * PK_ROW + (pc & 7) * 16) = vreg[i]; }
    __syncthreads();
    f32x16 sc[5];
    const int pm = pi23(n);
#pragma unroll
    for (int kt = 0; kt < 5; ++kt) {
        const int slot = slot_base + kt, sb = 32 * qt - 128 + 32 * kt;
        f32x16 acc = {0.f, 0.f, 0.f, 0.f, 0.f, 0.f, 0.f, 0.f, 0.f, 0.f, 0.f, 0.f, 0.f, 0.f, 0.f, 0.f};
        if (sb >= 0) {
            const LAS unsigned char* kp = lds + slot * PK_SLOT + pm * PK_ROW + 64 * hi;
            bf16x8 kf[4];
#pragma unroll
            for (int d0 = 0; d0 < 4; ++d0) kf[d0] = *(const LAS bf16x8*)(kp + 16 * d0);
#pragma unroll
            for (int d0 = 0; d0 < 4; ++d0) acc = __builtin_amdgcn_mfma_f32_32x32x16_bf16(kf[d0], qf[d0], acc, 0, 0, 0);
        }
        sc[kt] = acc;
    }
    float mx = -1e30f;
#pragma unroll
    for (int kt = 0; kt < 5; ++kt) { const int sb = 32 * qt - 128 + 32 * kt;
#pragma unroll
        for (int rr = 0; rr < 16; ++rr) { const int sk = sb + 16 * (rr >> 3) + 8 * hi + (rr & 7); const int dl = s_q - sk; const bool ok = (sk >= 0) && (dl >= 0) && (dl <= 128);
            const float v = ok ? sc[kt][rr] : -1e30f; sc[kt][rr] = v; mx = fmaxf(mx, v); } }
    mx = fmaxf(mx, __shfl_xor(mx, 32));
    float l = 0.f;
#pragma unroll
    for (int kt = 0; kt < 5; ++kt)
#pragma unroll
        for (int rr = 0; rr < 16; ++rr) { const float p = fexp2(sc[kt][rr] - mx); sc[kt][rr] = p; l += p; }
    l += __shfl_xor(l, 32);
    f32x16 o[2];
#pragma unroll
    for (int dt = 0; dt < 2; ++dt) o[dt] = (f32x16){0.f, 0.f, 0.f, 0.f, 0.f, 0.f, 0.f, 0.f, 0.f, 0.f, 0.f, 0.f, 0.f, 0.f, 0.f, 0.f};
#pragma unroll
    for (int kt = 0; kt < 5; ++kt) {
        const int slot = slot_base + kt, sb = 32 * qt - 128 + 32 * kt;
        if (sb >= 0) {
            LAS unsigned char* vp = lds + PV_OFF + slot * PK_SLOT + (8 * hi + ((lane >> 2) & 3)) * PK_ROW + (16 * ((lane >> 4) & 1) + 4 * (lane & 3)) * 2;
            bf16x8 vf[2][2];
#pragma unroll
            for (int jj = 0; jj < 2; ++jj)
#pragma unroll
                for (int dt = 0; dt < 2; ++dt) vf[jj][dt] = cat44(lds_tr4(vp + (16 * jj) * PK_ROW + 64 * dt), lds_tr4(vp + (16 * jj + 4) * PK_ROW + 64 * dt));
#pragma unroll
            for (int jj = 0; jj < 2; ++jj) {
                const bf16x8 pb = pack8(sc[kt][8 * jj + 0], sc[kt][8 * jj + 1], sc[kt][8 * jj + 2], sc[kt][8 * jj + 3], sc[kt][8 * jj + 4], sc[kt][8 * jj + 5], sc[kt][8 * jj + 6], sc[kt][8 * jj + 7]);
#pragma unroll
                for (int dt = 0; dt < 2; ++dt) o[dt] = __builtin_amdgcn_mfma_f32_32x32x16_bf16(vf[jj][dt], pb, o[dt], 0, 0, 0);
            }
        }
    }
    const float il = frcp(l);
    bf16* op = AO + (size_t)qrow * AW + g * 256 + hh * 64 + 4 * hi;
#pragma unroll
    for (int dt = 0; dt < 2; ++dt)
#pragma unroll
        for (int r4 = 0; r4 < 4; ++r4) { u32x2 w; w.x = cvt_pk_bf16(o[dt][4 * r4] * il, o[dt][4 * r4 + 1] * il); w.y = cvt_pk_bf16(o[dt][4 * r4 + 2] * il, o[dt][4 * r4 + 3] * il);
            *(u32x2*)(op + 32 * dt + 8 * r4) = w; }
    if (hi == 0) LSE[(size_t)qrow * 12 + g * 4 + hh] = (mx + flog2(l)) * LN2;
    __syncthreads();
}

template <int NB> __device__ __forceinline__ void combine_rows(const bf16* AO, const float* LSE, const float* aon, bf16* MIXED, int R0, int lane) {
    const int hh = lane >> 4; float ls[NB][3]; u32x2 ow[NB][3];
#pragma unroll
    for (int i = 0; i < NB; ++i)
#pragma unroll
        for (int g = 0; g < 3; ++g) { ow[i][g] = *(const u32x2*)(AO + (size_t)(R0 + i) * AW + g * 256 + 4 * lane); ls[i][g] = LSE[(size_t)(R0 + i) * 12 + g * 4 + hh]; }
    f32x4 gn[3];
#pragma unroll
    for (int g = 0; g < 3; ++g) gn[g] = *(const f32x4*)(aon + g * 256 + 4 * lane);
#pragma unroll
    for (int i = 0; i < NB; ++i) {
        const float mx = fmaxf(fmaxf(ls[i][0], ls[i][1]), ls[i][2]);
        float e[3]; e[0] = fexp2((ls[i][0] - mx) * LOG2E); e[1] = fexp2((ls[i][1] - mx) * LOG2E); e[2] = fexp2((ls[i][2] - mx) * LOG2E);
        const float inv = frcp(e[0] + e[1] + e[2]);
        f32x4 v[3]; float ss = 0.f;
#pragma unroll
        for (int g = 0; g < 3; ++g) { const float al = e[g] * inv; v[g] = (f32x4){bf2f(ow[i][g].x & 0xffffu), bf2f(ow[i][g].x >> 16), bf2f(ow[i][g].y & 0xffffu), bf2f(ow[i][g].y >> 16)} * al; ss += dot4(v[g]); }
        const float rs = frsq(wave_sum(ss) * (1.0f / 768.0f) + EPS);
#pragma unroll
        for (int g = 0; g < 3; ++g) { const f32x4 y = v[g] * rs * gn[g];
            u32x2 w; w.x = cvt_pk_bf16(y[0], y[1]); w.y = cvt_pk_bf16(y[2], y[3]); *(u32x2*)(MIXED + (size_t)(R0 + i) * D + g * 256 + 4 * lane) = w; }
    }
}
__device__ __forceinline__ float gelu_tanh(float x) { const float u2 = 1.5957691216057308f * (x + 0.044715f * x * x * x); return x * frcp(1.0f + fexp2(-u2 * LOG2E)); }
__device__ __forceinline__ float sigmoidf_(float z) { return frcp(1.0f + fexp2(-z * LOG2E)); }
__device__ __forceinline__ void ssm_c_item(const Args& a, const float* U, const float* ssmc, const float* SSMF, const bf16* WGLU, bf16* MIXED, LAS unsigned char* lds, int item, int wave, int lane) {
    const bool hs = item < 32;
    const int b = item >> 5, c = item & 31;
    const int R0 = item * 64, RS0 = MP + item * 16;
    LAS unsigned* HL = (LAS unsigned*)(lds + wave * 4352);
    LAS float* ZS = (LAS float*)(lds + 34816);
    const int t16 = lane & 15, q4 = lane >> 4;
    for (int gi = 0; gi < 2; ++gi) {
        const int g = 2 * wave + gi;
        const f32x4* cp = (const f32x4*)(ssmc + (size_t)(g * 64 + lane) * 8); const f32x4 c0 = cp[0], c1 = cp[1];
        const float ar = c0[0], ai = c0[1], a64r = c1[0], a64i = c1[1];
        bf16x8 bb[4]; ssm_bfrags(a, ssmc, g, lane, bb);
        bf16x8 cf[4];
#pragma unroll
        for (int s4 = 0; s4 < 4; ++s4) { const int p0 = 16 * s4 + 4 * q4; const f32x4 x = *(const f32x4*)(a.in[I_CRE] + (size_t)(g * 16 + t16) * 64 + p0), y = *(const f32x4*)(a.in[I_CIM] + (size_t)(g * 16 + t16) * 64 + p0);
            cf[s4] = pack8(x[0], -y[0], x[1], -y[1], x[2], -y[2], x[3], -y[3]); }
        const f32x4 dv = *(const f32x4*)(a.in[I_SD] + g * 16 + 4 * q4);
        float hr = 0.f, hi = 0.f;
        {
            const int nb16 = (c + 15) >> 4; int cc0 = c - 16 * nb16;
            for (int i16 = 0; i16 < nb16; ++i16, cc0 += 16) { f32x2 f[16];
#pragma unroll
                for (int j = 0; j < 16; ++j) { const int cc = cc0 + j; f[j] = cc >= 0 ? *(const f32x2*)(SSMF + ((size_t)((b * 32 + cc) * 16 + g) * 64 + lane) * 2) : (f32x2){0.f, 0.f}; }
#pragma unroll
                for (int j = 0; j < 16; ++j) { const float nr = fmaf(a64r, hr, fmaf(-a64i, hi, f[j][0])), ni = fmaf(a64r, hi, fmaf(a64i, hr, f[j][1])); hr = nr; hi = ni; } }
        }
#if defined(PROBE_DUMP)
        { float* dmp = (float*)((unsigned char*)MIXED - WS_MIXED + 741 * MiB) + ((size_t)(item * 16 + g) * 64 + lane) * 2; dmp[0] = hr; dmp[1] = hi; }
#endif
        bf16x8 ua2[2]; f32x4 uv4[4];
        ua2[0] = ssm_loadu(U, R0, 32, g, lane); ua2[1] = ssm_loadu(U, R0 + 32, 32, g, lane);
#pragma unroll
        for (int j = 0; j < 4; ++j) uv4[j] = *(const f32x4*)(U + (size_t)(R0 + 16 * j + t16) * 256 + g * 16 + 4 * q4);
#if defined(PROBE_DUMP)
        { u32x4* dmp = (u32x4*)((unsigned char*)MIXED - WS_MIXED + 724 * MiB) + ((size_t)(item * 16 + g) * 2) * 64 + lane; dmp[0] = __builtin_bit_cast(u32x4, ua2[0]); dmp[64] = __builtin_bit_cast(u32x4, ua2[1]); }
#endif
#pragma unroll
        for (int blk = 0; blk < 2; ++blk) {
            f32x16 xr[2], xi[2]; ssm_xcompute(ua2[blk], bb, xr, xi);
#pragma unroll
            for (int s2 = 0; s2 < 2; ++s2) {
                const int trow = 32 * blk + 16 * s2 + t16;
                const f32x4 uv = uv4[2 * blk + s2];
#pragma unroll
                for (int tt = 0; tt < 16; ++tt) { const int t = 16 * s2 + tt;
                    const float nr = fmaf(ar, hr, fmaf(-ai, hi, SSM_XR(t))), ni = fmaf(ar, hi, fmaf(ai, hr, SSM_XI(t))); hr = nr; hi = ni;
                    HL[tt * 68 + lane] = cvt_pk_bf16(hr, hi);
                }
                LDS_WAIT(); asm volatile("" ::: "memory");
                f32x4 y = {0.f, 0.f, 0.f, 0.f};
#pragma unroll
                for (int s4 = 0; s4 < 4; ++s4) { const bf16x8 hf = *(const LAS bf16x8*)((LAS unsigned short*)HL + t16 * 136 + 32 * s4 + 8 * q4); y = __builtin_amdgcn_mfma_f32_16x16x32_bf16(cf[s4], hf, y, 0, 0, 0); }
                f32x4 z;
#pragma unroll
                for (int e = 0; e < 4; ++e) z[e] = gelu_tanh(y[e] + dv[e] * uv[e]);
                *(LAS f32x4*)(ZS + trow * 260 + g * 16 + 4 * q4) = z;
                LDS_WAIT(); asm volatile("" ::: "memory");
            }
        }
        if (c == 31) { a.out[O_SREP + (size_t)(b * 16 + g) * 64 + lane] = hr; a.out[O_SIMP + (size_t)(b * 16 + g) * 64 + lane] = hi; }
        if (hs) {
            float sre[4], sim[4];
#pragma unroll
            for (int j = 0; j < 4; ++j) { const size_t o = (size_t)((4 * item + j) * 16 + g) * 64 + lane; sre[j] = a.in[I_SRE][o]; sim[j] = a.in[I_SIM][o]; }
            const bf16x8 ua = ssm_loadu(U, RS0, 16, g, lane);
            const f32x4 uv = *(const f32x4*)(U + (size_t)(RS0 + t16) * 256 + g * 16 + 4 * q4);
            f32x16 xr[2], xi[2]; ssm_xcompute(ua, bb, xr, xi);
#pragma unroll
            for (int tt = 0; tt < 16; ++tt) {
                if ((tt & 3) == 0) { hr = sre[tt >> 2]; hi = sim[tt >> 2]; }
                const float nr = fmaf(ar, hr, fmaf(-ai, hi, SSM_XR(tt))), ni = fmaf(ar, hi, fmaf(ai, hr, SSM_XI(tt))); hr = nr; hi = ni;
                HL[tt * 68 + lane] = cvt_pk_bf16(hr, hi);
                if ((tt & 3) == 3) { const size_t o = (size_t)((4 * item + (tt >> 2)) * 16 + g) * 64 + lane; a.out[O_SRES + o] = hr; a.out[O_SIMS + o] = hi; }
            }
            LDS_WAIT(); asm volatile("" ::: "memory");
            f32x4 y = {0.f, 0.f, 0.f, 0.f};
#pragma unroll
            for (int s4 = 0; s4 < 4; ++s4) { const bf16x8 hf = *(const LAS bf16x8*)((LAS unsigned short*)HL + t16 * 136 + 32 * s4 + 8 * q4); y = __builtin_amdgcn_mfma_f32_16x16x32_bf16(cf[s4], hf, y, 0, 0, 0); }
            f32x4 z;
#pragma unroll
            for (int e = 0; e < 4; ++e) z[e] = gelu_tanh(y[e] + dv[e] * uv[e]);
            *(LAS f32x4*)(ZS + (64 + t16) * 260 + g * 16 + 4 * q4) = z;
            LDS_WAIT(); asm volatile("" ::: "memory");
        }
    }
    const int n = lane & 31, hi5 = lane >> 5, n0 = 32 * wave, nmt = hs ? 3 : 2;
    bf16x8 bfr[16];
#pragma unroll
    for (int st = 0; st < 16; ++st) bfr[st] = *(const bf16x8*)(WGLU + (size_t)(n0 + n) * 256 + 16 * st + 8 * hi5);
    const float bias = a.in[I_BGLU][n0 + n];
    const f32x4 gn = *(const f32x4*)(a.in[I_SON] + 4 * lane);
    __syncthreads();
    f32x16 acc[3];
#pragma unroll
    for (int mt = 0; mt < 3; ++mt) acc[mt] = (f32x16){0.f, 0.f, 0.f, 0.f, 0.f, 0.f, 0.f, 0.f, 0.f, 0.f, 0.f, 0.f, 0.f, 0.f, 0.f, 0.f};
#pragma unroll
    for (int st = 0; st < 16; ++st) {
        const bf16x8 bf = bfr[st];
#pragma unroll
        for (int mt = 0; mt < 3; ++mt) { if (mt < nmt) { const LAS float* zp = ZS + (32 * mt + n) * 260 + 16 * st + 8 * hi5; const f32x4 x = *(const LAS f32x4*)zp, y = *(const LAS f32x4*)(zp + 4);
            acc[mt] = __builtin_amdgcn_mfma_f32_32x32x16_bf16(pack8(x[0], x[1], x[2], x[3], y[0], y[1], y[2], y[3]), bf, acc[mt], 0, 0, 0); } }
    }
    float so[3][16];
#pragma unroll
    for (int mt = 0; mt < 3; ++mt) { if (mt < nmt) {
#pragma unroll
        for (int r = 0; r < 16; ++r) { const int t = 32 * mt + (r & 3) + 8 * (r >> 2) + 4 * hi5; so[mt][r] = ZS[t * 260 + n0 + n] * sigmoidf_(acc[mt][r] + bias); } } }
    __syncthreads();
#pragma unroll
    for (int mt = 0; mt < 3; ++mt) { if (mt < nmt) {
#pragma unroll
        for (int r = 0; r < 16; ++r) { const int t = 32 * mt + (r & 3) + 8 * (r >> 2) + 4 * hi5; ZS[t * 260 + n0 + n] = so[mt][r]; } } }
    __syncthreads();
#pragma unroll
    for (int i = 0; i < 10; ++i) { if (i >= 8 && !hs) break;
        const int row = i < 8 ? 8 * wave + i : 64 + 2 * wave + (i - 8); const f32x4 v = *(const LAS f32x4*)(ZS + row * 260 + 4 * lane);
        const float rs = frsq(wave_sum(dot4(v)) * (1.0f / 256.0f) + EPS); const f32x4 y = v * rs * gn;
        const size_t orow = i < 8 ? (size_t)(R0 + row) : (size_t)(RS0 + row - 64);
        u32x2 w; w.x = cvt_pk_bf16(y[0], y[1]); w.y = cvt_pk_bf16(y[2], y[3]); *(u32x2*)(MIXED + orow * D + 768 + 4 * lane) = w; }
    __syncthreads();
}

__device__ __forceinline__ float xq_sigma(const float* RS1, const float* QS, int R, int h) {
    const float rstd = frsq(RS1[R] * (1.0f / 1024.0f) + EPS), msq = QS[(size_t)R * 4 + h] * (1.0f / 256.0f);
    return rstd / sqrtf(rstd * rstd * msq + EPS) * (0.0625f * LOG2E);
}
template <int MODE, bool BASE_BF16 = false> __device__ __forceinline__ void sample_gemm_tile(const bf16* A, const bf16* Bt, int K, const void* base, float* outp, bf16* hb, float* ssq, LAS unsigned char* lds, int tile, int wave, int lane, int tid) {
    const int tm = tile >> 5, tn = tile & 31, n = lane & 31, hi = lane >> 5, kw = K >> 3;
    const bf16* ap = A + (size_t)(64 * tm + n) * K + wave * kw + 8 * hi;
    const bf16* bp = Bt + (size_t)(32 * tn + n) * K + wave * kw + 8 * hi;
    f32x16 acc0 = {0.f, 0.f, 0.f, 0.f, 0.f, 0.f, 0.f, 0.f, 0.f, 0.f, 0.f, 0.f, 0.f, 0.f, 0.f, 0.f}, acc1 = acc0;
    const int row = tid >> 3, c4 = (tid & 7) * 4, rs = 64 * tm + row, col = 32 * tn + c4;
    f32x4 bs = {0.f, 0.f, 0.f, 0.f};
    if (MODE == 0) {
        if (BASE_BF16) { const u32x2 w = *(const u32x2*)((const bf16*)base + (size_t)rs * D + col); bs = (f32x4){bf2f(w.x & 0xffffu), bf2f(w.x >> 16), bf2f(w.y & 0xffffu), bf2f(w.y >> 16)}; }
        else bs = *(const f32x4*)((const float*)base + (size_t)rs * D + col); }
#pragma unroll 8
    for (int s = 0; s < kw; s += 16) { const bf16x8 a0 = *(const bf16x8*)(ap + s), a1 = *(const bf16x8*)(ap + (size_t)32 * K + s), bb = *(const bf16x8*)(bp + s);
        acc0 = __builtin_amdgcn_mfma_f32_32x32x16_bf16(a0, bb, acc0, 0, 0, 0); acc1 = __builtin_amdgcn_mfma_f32_32x32x16_bf16(a1, bb, acc1, 0, 0, 0); }
    LAS float* P = (LAS float*)lds;
#pragma unroll
    for (int r = 0; r < 16; ++r) { const int row = (r & 3) + 8 * (r >> 2) + 4 * hi; P[(wave * 64 + row) * 32 + n] = acc0[r]; P[(wave * 64 + 32 + row) * 32 + n] = acc1[r]; }
    __syncthreads();
    f32x4 v = {0.f, 0.f, 0.f, 0.f};
#pragma unroll
    for (int w = 0; w < 8; ++w) v = v + *(const LAS f32x4*)(P + (w * 64 + row) * 32 + c4);
    float s;
    if (MODE == 0) {
        const f32x4 o = bs + v; if (outp) *(f32x4*)(outp + (size_t)rs * D + col) = o;
        if (hb) { u32x2 w; w.x = cvt_pk_bf16(o[0], o[1]); w.y = cvt_pk_bf16(o[2], o[3]); *(u32x2*)(hb + (size_t)rs * D + col) = w; }
        s = dot4(o); }
    else { u32x2 w; w.x = cvt_pk_bf16(v[0], v[1]); w.y = cvt_pk_bf16(v[2], v[3]); *(u32x2*)(hb + (size_t)rs * D + col) = w; s = dot4(v); }
    if (ssq) { s += __shfl_xor(s, 1); s += __shfl_xor(s, 2); s += __shfl_xor(s, 4); if ((tid & 7) == 0) atomic_addf(MODE == 0 ? ssq + rs : ssq + (size_t)rs * 4 + (tn >> 3), s); }
    __syncthreads();
}
constexpr int XK_ROW = 272, XK_BUF = 32 * XK_ROW, XV_BUF = XK_BUF, XV_OFF = 2 * XK_BUF;
__device__ __forceinline__ void xattn_wg_item(const bf16* QX, const float* SS1, const float* QSS, const bf16* MEMK, const bf16* MVT, bf16* OX, LAS unsigned char* lds, int it, int wave, int lane, int tid) {
    const int qb = it & 7, h = (it >> 3) & 3, b = it >> 5;
    const int n = lane & 31, hi = lane >> 5, R = b * 2048 + 256 * qb + 32 * wave + n;
    const float sigma = xq_sigma(SS1, QSS, R, h);
    const bf16* kg = MEMK + (size_t)(b * 256 + (tid >> 4)) * 1024 + h * 256 + 128 * ((tid >> 3) & 1) + 8 * (tid & 7);
    const bf16* vg = MVT + (size_t)(b * 256 + (tid >> 4)) * 1024 + h * 256 + 8 * (tid & 15);
    LAS unsigned char* kl = lds + (tid >> 4) * XK_ROW + (tid & 15) * 16;
    LAS unsigned char* vl = lds + XV_OFF + (tid >> 4) * XK_ROW + (tid & 15) * 16;
#define XSRC(t) ((t) < 16 ? (const u32x4*)(kg + (size_t)((t) & 7) * 32 * 1024 + ((t) >> 3) * 64) : (const u32x4*)(vg + (size_t)(((t) - 16) & 7) * 32 * 1024 + (((t) - 16) >> 3) * 128))
#define XPUT(t, w_) do { if ((t) < 16) *(LAS u32x4*)(kl + ((t) & 1) * XK_BUF) = (w_); else *(LAS u32x4*)(vl + ((t) & 1) * XV_BUF) = (w_); } while (0)
    u32x4 ring[3]; ring[0] = *XSRC(0); ring[1] = *XSRC(1); ring[2] = *XSRC(2);
    f32x16 sc[8];
#pragma unroll
    for (int kt = 0; kt < 8; ++kt) sc[kt] = (f32x16){0.f, 0.f, 0.f, 0.f, 0.f, 0.f, 0.f, 0.f, 0.f, 0.f, 0.f, 0.f, 0.f, 0.f, 0.f, 0.f};
    XPUT(0, ring[0]);
    __syncthreads();
    const LAS unsigned char* kr = lds + pi23(n) * XK_ROW + 128 * hi;
#pragma unroll
    for (int dh = 0; dh < 2; ++dh) {
        bf16x8 qf[8];
        { const bf16* qp = QX + (size_t)R * D + h * 256 + 128 * hi + 64 * dh;
#pragma unroll
          for (int st = 0; st < 8; ++st) qf[st] = *(const bf16x8*)(qp + 8 * st); }
#pragma unroll
        for (int kt = 0; kt < 8; ++kt) {
            const int s = dh * 8 + kt;
            ring[s % 3] = *XSRC(s + 3);
            const LAS unsigned char* kp = kr + (s & 1) * XK_BUF;
            bf16x8 kf[8];
#pragma unroll
            for (int st = 0; st < 8; ++st) kf[st] = *(const LAS bf16x8*)(kp + 16 * st);
            __builtin_amdgcn_sched_barrier(0);
#pragma unroll
            for (int st = 0; st < 8; ++st) sc[kt] = __builtin_amdgcn_mfma_f32_32x32x16_bf16(kf[st], qf[st], sc[kt], 0, 0, 0);
            XPUT(s + 1, ring[(s + 1) % 3]);
            asm volatile("s_waitcnt lgkmcnt(0)\n\ts_barrier" ::: "memory");
        }
    }
    float mx = -1e30f;
#pragma unroll
    for (int kt = 0; kt < 8; ++kt)
#pragma unroll
        for (int r = 0; r < 16; ++r) { sc[kt][r] *= sigma; mx = fmaxf(mx, sc[kt][r]); }
    mx = fmaxf(mx, __shfl_xor(mx, 32));
    float l = 0.f;
#pragma unroll
    for (int kt = 0; kt < 8; ++kt)
#pragma unroll
        for (int r = 0; r < 16; ++r) { const float p = fexp2(sc[kt][r] - mx); sc[kt][r] = p; l += p; }
    l += __shfl_xor(l, 32);
    const float il = frcp(l);
    bf16x8 pb[8][2];
#pragma unroll
    for (int kt = 0; kt < 8; ++kt)
#pragma unroll
        for (int jj = 0; jj < 2; ++jj) pb[kt][jj] = pack8(sc[kt][8 * jj + 0], sc[kt][8 * jj + 1], sc[kt][8 * jj + 2], sc[kt][8 * jj + 3], sc[kt][8 * jj + 4], sc[kt][8 * jj + 5], sc[kt][8 * jj + 6], sc[kt][8 * jj + 7]);
    LAS unsigned char* vr = lds + XV_OFF + (8 * hi + ((lane >> 2) & 3)) * XK_ROW + (16 * ((lane >> 4) & 1) + 4 * (lane & 3)) * 2;
    bf16* op = OX + (size_t)R * D + h * 256 + 4 * hi;
#pragma unroll
    for (int dh = 0; dh < 2; ++dh) {
        f32x16 o[4];
#pragma unroll
        for (int dt = 0; dt < 4; ++dt) o[dt] = (f32x16){0.f, 0.f, 0.f, 0.f, 0.f, 0.f, 0.f, 0.f, 0.f, 0.f, 0.f, 0.f, 0.f, 0.f, 0.f, 0.f};
#pragma unroll
        for (int kt = 0; kt < 8; ++kt) {
            const int s = 16 + dh * 8 + kt;
            if (s + 3 < 32) ring[s % 3] = *XSRC(s + 3);
            LAS unsigned char* vp = vr + (s & 1) * XV_BUF;
            bf16x8 vf[4][2];
#pragma unroll
            for (int dt = 0; dt < 4; ++dt)
#pragma unroll
                for (int jj = 0; jj < 2; ++jj) vf[dt][jj] = cat44(lds_tr4(vp + (16 * jj) * XK_ROW + 64 * dt), lds_tr4(vp + (16 * jj + 4) * XK_ROW + 64 * dt));
            __builtin_amdgcn_sched_barrier(0);
#pragma unroll
            for (int jj = 0; jj < 2; ++jj)
#pragma unroll
                for (int dt = 0; dt < 4; ++dt) o[dt] = __builtin_amdgcn_mfma_f32_32x32x16_bf16(vf[dt][jj], pb[kt][jj], o[dt], 0, 0, 0);
            if (s + 1 < 32) XPUT(s + 1, ring[(s + 1) % 3]);
            asm volatile("s_waitcnt lgkmcnt(0)\n\ts_barrier" ::: "memory");
        }
#pragma unroll
        for (int dt = 0; dt < 4; ++dt)
#pragma unroll
            for (int r4 = 0; r4 < 4; ++r4) { u32x2 w; w.x = cvt_pk_bf16(o[dt][4 * r4] * il, o[dt][4 * r4 + 1] * il); w.y = cvt_pk_bf16(o[dt][4 * r4 + 2] * il, o[dt][4 * r4 + 3] * il);
                *(u32x2*)(op + 128 * dh + 32 * dt + 8 * r4) = w; }
    }
}
#undef XSRC
#undef XPUT
constexpr int SXB = 4;
struct SxBatch { f32x4 k[SXB], v[SXB]; };
__device__ __forceinline__ void sx_load(SxBatch& B, const float* kb, unsigned loff, int j0) {
#pragma unroll
    for (int j = 0; j < SXB; ++j) { const char* p = (const char*)(kb + (size_t)(j0 + j) * 2048); B.k[j] = __builtin_nontemporal_load((const f32x4*)(p + loff)); B.v[j] = __builtin_nontemporal_load((const f32x4*)(p + 4096 + loff)); }
}
__device__ __forceinline__ float rdl(float v, int l) { return __builtin_bit_cast(float, __builtin_amdgcn_readlane(__builtin_bit_cast(int, v), l)); }
__device__ __forceinline__ void sx_compute(const SxBatch& B, const f32x4 (&q)[4], bool b5, bool b4, float& m, float& l, f32x4 (&o)[4]) {
    float s[SXB]; float mb = m;
#pragma unroll
    for (int j = 0; j < SXB; ++j) {
        float d[4];
#pragma unroll
        for (int t = 0; t < 4; ++t) d[t] = (q[t][0] * B.k[j][0] + q[t][1] * B.k[j][1]) + (q[t][2] * B.k[j][2] + q[t][3] * B.k[j][3]);
        const float x0 = b5 ? d[0] : d[2], x1 = b5 ? d[1] : d[3], k0 = b5 ? d[2] : d[0], k1 = b5 ? d[3] : d[1];
        const float r0 = k0 + __shfl_xor(x0, 32), r1 = k1 + __shfl_xor(x1, 32);
        const float xs = b4 ? r0 : r1, ks = b4 ? r1 : r0;
        float r = ks + __shfl_xor(xs, 16);
        r += __shfl_xor(r, 8); r += __shfl_xor(r, 4); r += __shfl_xor(r, 2); r += __shfl_xor(r, 1);
        s[j] = r; mb = fmaxf(mb, r);
    }
    const float sc = fexp2(m - mb); m = mb; l *= sc;
#pragma unroll
    for (int t = 0; t < 4; ++t) o[t] = o[t] * rdl(sc, 16 * t);
#pragma unroll
    for (int j = 0; j < SXB; ++j) { const float p = fexp2(s[j] - mb); l += p;
#pragma unroll
        for (int t = 0; t < 4; ++t) o[t] = o[t] + B.v[j] * rdl(p, 16 * t); }
}
template <int NSW> __device__ __forceinline__ void sxattn_stream(const Args& a, const bf16* QX, const float* SS1S, const float* QSSS, bf16* OX, LAS unsigned char* lds, LAS unsigned* cnt, int pair, int slot, int sw, int lane) {
    const int b = pair >> 2, h = pair & 3;
    LAS float* OL = (LAS float*)lds + (size_t)slot * (NSW * 1024); LAS float* ML = (LAS float*)(lds + 65536) + slot * 32; LAS float* LL = (LAS float*)(lds + 65536 + 256) + slot * 32;
    const f32x4 gq = *(const f32x4*)(a.in[I_XQN] + 4 * lane);
    f32x4 q[4];
    const float sgc = xq_sigma(SS1S, QSSS, MP + 4 * b + (lane >> 4), h);
#pragma unroll
    for (int t = 0; t < 4; ++t) { const int R = MP + 4 * b + t; const float sg = rdl(sgc, 16 * t); const u32x2 w = *(const u32x2*)(QX + (size_t)R * D + h * 256 + 4 * lane);
        q[t] = (f32x4){bf2f(w.x & 0xffffu), bf2f(w.x >> 16), bf2f(w.y & 0xffffu), bf2f(w.y >> 16)} * gq * sg; }
    constexpr int NK = 256 / NSW;
    const float* kb = a.in[I_CMEM] + ((size_t)(b * 256 + NK * sw) * 2) * 1024 + h * 256; const unsigned loff = 16u * (unsigned)lane;
    const bool b5 = (lane & 32) != 0, b4 = (lane & 16) != 0;
    float m = -1e30f, l = 0.f;
    f32x4 o[4];
#pragma unroll
    for (int t = 0; t < 4; ++t) o[t] = (f32x4){0.f, 0.f, 0.f, 0.f};
    SxBatch A, B; sx_load(A, kb, loff, 0);
#pragma unroll 1
    for (int j0 = 0; j0 < NK; j0 += 2 * SXB) {
        sx_load(B, kb, loff, j0 + SXB);
        sx_compute(A, q, b5, b4, m, l, o);
        if (j0 + 2 * SXB < NK) sx_load(A, kb, loff, j0 + 2 * SXB);
        sx_compute(B, q, b5, b4, m, l, o);
    }
#pragma unroll
    for (int t = 0; t < 4; ++t) *(LAS f32x4*)(OL + (sw * 4 + t) * 256 + 4 * lane) = o[t];
    if ((lane & 15) == 0) { ML[sw * 4 + (lane >> 4)] = m; LL[sw * 4 + (lane >> 4)] = l; }
    asm volatile("s_waitcnt lgkmcnt(0)" ::: "memory");
    unsigned old = 0u; if (lane == 0) old = __hip_atomic_fetch_add(cnt, 1u, __ATOMIC_ACQ_REL, __HIP_MEMORY_SCOPE_WORKGROUP);
    old = __builtin_amdgcn_readfirstlane(old);
    if (old == (unsigned)(NSW - 1)) {
        asm volatile("s_waitcnt lgkmcnt(0)" ::: "memory");
#pragma unroll
        for (int t = 0; t < 4; ++t) {
            float M = -1e30f;
#pragma unroll
            for (int w = 0; w < NSW; ++w) M = fmaxf(M, ML[w * 4 + t]);
            float L = 0.f; f32x4 acc = {0.f, 0.f, 0.f, 0.f};
#pragma unroll
            for (int w = 0; w < NSW; ++w) { const float f = fexp2(ML[w * 4 + t] - M); L += LL[w * 4 + t] * f; acc = acc + *(const LAS f32x4*)(OL + (w * 4 + t) * 256 + 4 * lane) * f; }
            const float il = frcp(L); u32x2 wv; wv.x = cvt_pk_bf16(acc[0] * il, acc[1] * il); wv.y = cvt_pk_bf16(acc[2] * il, acc[3] * il);
            *(u32x2*)(OX + (size_t)(MP + 4 * b + t) * D + h * 256 + 4 * lane) = wv;
        }
    }
}

__device__ __forceinline__ void up8(const bf16* p, float (&v)[8]) { const u32x4 w = *(const u32x4*)p;
    v[0] = bf2f(w.x & 0xffffu); v[1] = bf2f(w.x >> 16); v[2] = bf2f(w.y & 0xffffu); v[3] = bf2f(w.y >> 16); v[4] = bf2f(w.z & 0xffffu); v[5] = bf2f(w.z >> 16); v[6] = bf2f(w.w & 0xffffu); v[7] = bf2f(w.w >> 16); }
__device__ __forceinline__ void ld8(const float* p, float (&v)[8]) { const f32x4 a = *(const f32x4*)p, b = *(const f32x4*)(p + 4); v[0] = a[0]; v[1] = a[1]; v[2] = a[2]; v[3] = a[3]; v[4] = b[0]; v[5] = b[1]; v[6] = b[2]; v[7] = b[3]; }
__device__ __forceinline__ void conv_item(const Args& a, const bf16* UP, bf16* ACT, int it) {
    const int cgp = it % 352, rc = it / 352, j0 = cgp * 8, R0 = rc * 32;
    const float* cw = a.in[I_CONVW]; const float* cbp = a.in[I_CONVB];
    float wg[3][8], wv[3][8], bg[8], bv[8];
#pragma unroll
    for (int i = 0; i < 3; ++i) { ld8(cw + (size_t)i * FF2 + j0, wg[i]); ld8(cw + (size_t)i * FF2 + FF + j0, wv[i]); }
    ld8(cbp + j0, bg); ld8(cbp + FF + j0, bv);
    float g2[8], g1[8], v2[8], v1[8];
    const bool sample = R0 >= MP;
    if (!sample && (R0 & 2047) != 0) { up8(UP + (size_t)(R0 - 2) * FF2 + j0, g2); up8(UP + (size_t)(R0 - 1) * FF2 + j0, g1); up8(UP + (size_t)(R0 - 2) * FF2 + FF + j0, v2); up8(UP + (size_t)(R0 - 1) * FF2 + FF + j0, v1); }
    else {
#pragma unroll
        for (int e = 0; e < 8; ++e) { g2[e] = 0.f; g1[e] = 0.f; v2[e] = 0.f; v1[e] = 0.f; } }
    for (int r = 0; r < 32; ++r) { const int R = R0 + r;
        if (sample && (r & 3) == 0) { const float* sb = a.in[I_SCONV] + (size_t)((R - MP) >> 2) * 2 * FF2; ld8(sb + j0, g2); ld8(sb + FF2 + j0, g1); ld8(sb + FF + j0, v2); ld8(sb + FF2 + FF + j0, v1); }
        float gc[8], vc[8]; up8(UP + (size_t)R * FF2 + j0, gc); up8(UP + (size_t)R * FF2 + FF + j0, vc);
        float o[8];
#pragma unroll
        for (int e = 0; e < 8; ++e) { const float cgv = bg[e] + wg[0][e] * g2[e] + wg[1][e] * g1[e] + wg[2][e] * gc[e]; const float cvv = bv[e] + wv[0][e] * v2[e] + wv[1][e] * v1[e] + wv[2][e] * vc[e];
            o[e] = cgv * sigmoidf_(cgv) * cvv; g2[e] = g1[e]; g1[e] = gc[e]; v2[e] = v1[e]; v1[e] = vc[e]; }
        u32x4 w; w.x = cvt_pk_bf16(o[0], o[1]); w.y = cvt_pk_bf16(o[2], o[3]); w.z = cvt_pk_bf16(o[4], o[5]); w.w = cvt_pk_bf16(o[6], o[7]);
        *(u32x4*)(ACT + (size_t)R * FF + j0) = w;
    }
}

__device__ __forceinline__ void conv_fix_item(const Args& a, const float* EDGE, bf16* ACT, int it) {
    const int cgp = it % 352, rr = it / 352, r = rr & 1, ti = rr >> 1;
    const int pm = 8 * (ti / 7) + 1 + ti % 7, j0 = cgp * 8;
    const float* cw = a.in[I_CONVW]; const float* cbp = a.in[I_CONVB];
    const float* e_prev = EDGE + (size_t)(pm - 1) * 4 * FF2; const float* e_cur = EDGE + (size_t)pm * 4 * FF2;
    const float* r2 = r == 0 ? e_prev + 2 * FF2 : e_prev + 3 * FF2; const float* r1 = r == 0 ? e_prev + 3 * FF2 : e_cur; const float* r0 = r == 0 ? e_cur : e_cur + FF2;
    float o[8];
#pragma unroll
    for (int hf = 0; hf < 2; ++hf) { const int j4 = j0 + 4 * hf;
        const f32x4 cg = *(const f32x4*)(cbp + j4) + *(const f32x4*)(cw + j4) * *(const f32x4*)(r2 + j4) + *(const f32x4*)(cw + FF2 + j4) * *(const f32x4*)(r1 + j4) + *(const f32x4*)(cw + 2 * FF2 + j4) * *(const f32x4*)(r0 + j4);
        const f32x4 cv = *(const f32x4*)(cbp + FF + j4) + *(const f32x4*)(cw + FF + j4) * *(const f32x4*)(r2 + FF + j4) + *(const f32x4*)(cw + FF2 + FF + j4) * *(const f32x4*)(r1 + FF + j4) + *(const f32x4*)(cw + 2 * FF2 + FF + j4) * *(const f32x4*)(r0 + FF + j4);
#pragma unroll
        for (int e = 0; e < 4; ++e) o[4 * hf + e] = cg[e] * sigmoidf_(cg[e]) * cv[e]; }
    u32x4 w; w.x = cvt_pk_bf16(o[0], o[1]); w.y = cvt_pk_bf16(o[2], o[3]); w.z = cvt_pk_bf16(o[4], o[5]); w.w = cvt_pk_bf16(o[6], o[7]);
    *(u32x4*)(ACT + (size_t)(pm * 256 + r) * FF + j0) = w;
}

__device__ __forceinline__ void conv_fix_tile(const Args& a, const float* EDGE, bf16* ACT, int pm, int tid) {
    const float* cw = a.in[I_CONVW]; const float* cbp = a.in[I_CONVB];
    const float* e_prev = EDGE + (size_t)(pm - 1) * 4 * FF2; const float* e_cur = EDGE + (size_t)pm * 4 * FF2;
    for (int it = tid; it < 2 * 352; it += NWAVES * 64) { const int r = it / 352, j0 = (it - r * 352) * 8;
        const float* r2 = r == 0 ? e_prev + 2 * FF2 : e_prev + 3 * FF2; const float* r1 = r == 0 ? e_prev + 3 * FF2 : e_cur; const float* r0 = r == 0 ? e_cur : e_cur + FF2;
        float o[8];
#pragma unroll
        for (int hf = 0; hf < 2; ++hf) { const int j4 = j0 + 4 * hf;
            const f32x4 cg = *(const f32x4*)(cbp + j4) + *(const f32x4*)(cw + j4) * *(const f32x4*)(r2 + j4) + *(const f32x4*)(cw + FF2 + j4) * *(const f32x4*)(r1 + j4) + *(const f32x4*)(cw + 2 * FF2 + j4) * *(const f32x4*)(r0 + j4);
            const f32x4 cv = *(const f32x4*)(cbp + FF + j4) + *(const f32x4*)(cw + FF + j4) * *(const f32x4*)(r2 + FF + j4) + *(const f32x4*)(cw + FF2 + FF + j4) * *(const f32x4*)(r1 + FF + j4) + *(const f32x4*)(cw + 2 * FF2 + FF + j4) * *(const f32x4*)(r0 + FF + j4);
#pragma unroll
            for (int e = 0; e < 4; ++e) o[4 * hf + e] = cg[e] * sigmoidf_(cg[e]) * cv[e]; }
        u32x4 w; w.x = cvt_pk_bf16(o[0], o[1]); w.y = cvt_pk_bf16(o[2], o[3]); w.z = cvt_pk_bf16(o[4], o[5]); w.w = cvt_pk_bf16(o[6], o[7]);
        *(u32x4*)(ACT + (size_t)(pm * 256 + r) * FF + j0) = w; }
}

#ifndef MK_N_LAUNCHES
#define MK_N_LAUNCHES 1
#endif
constexpr int N_PHASES = 11;
#ifndef DUP_PHASE
#define DUP_PHASE -1
#endif
#define NREP(k) ((DUP_PHASE) == (k) ? 2 : 1)
constexpr int N_LAUNCHES = MK_N_LAUNCHES;
static_assert(N_LAUNCHES == 1 || N_LAUNCHES == N_PHASES, "MK_N_LAUNCHES is 1 or 11");

__global__ void __launch_bounds__(NWAVES * 64, 2) fwd_kernel(Args args) {
    extern __shared__ __attribute__((aligned(16))) unsigned char lds_raw[];
    LAS unsigned char* lds = (LAS unsigned char*)lds_raw;
    volatile LAS unsigned* MISC = (volatile LAS unsigned*)(lds + MISC_OFF);
    const int tid0 = threadIdx.x, wave0 = __builtin_amdgcn_readfirstlane(tid0 >> 6);
    const int G = gridDim.x; const int bx = blockIdx.x; const int vcu = (G % 8 == 0) ? (bx % 8) * (G / 8) + bx / 8 : bx;
    const int NGW = G * NWAVES;
    unsigned char* ws = args.ws;
    gu32* ctl = (gu32*)(ws + WS_CTL);
    for (int u = tid0; u < 128; u += NWAVES * 64) ((LAS unsigned*)(lds + MISC_OFF))[u] = 0u;
    __syncthreads();
    XcdBarrier bar; bar.bar = (unsigned*)(ctl + CW_BAR); bar.x = 0; bar.st = nullptr;
    if (N_LAUNCHES == 1) bar = xcd_barrier_post((unsigned*)(ctl + CW_BAR) + args.li * XCD_BAR_WORDS, MISC + 8);
#ifdef DOUBLE_BAR
#define GRID_BAR() do { if (N_LAUNCHES == 1) { xcd_barrier(bar); xcd_barrier(bar); } } while (0)
#else
#define GRID_BAR() do { if (N_LAUNCHES == 1) xcd_barrier(bar); } while (0)
#endif
    const int lo = args.ph_lo, hi = args.ph_hi;
#define IN(k) (lo <= (k) && (k) < hi)
#define WSBASE() GAS unsigned char* wsl = (GAS unsigned char*)ws; asm volatile("" : "+s"(wsl));     int tid = threadIdx.x; asm volatile("" : "+v"(tid)); const int lane = tid & 63, wave = __builtin_amdgcn_readfirstlane(tid >> 6), gw = vcu * NWAVES + wave; (void)lane; (void)gw
#define ROPE_ ((float*)(wsl + WS_ROPE))
#define SSMC_ ((float*)(wsl + WS_SSMC))
#define WIN ((bf16*)(wsl + WS_WIN))
#define WOUT ((bf16*)(wsl + WS_WOUT))
#define WXQ ((bf16*)(wsl + WS_WXQ))
#define WXKV ((bf16*)(wsl + WS_WXKV))
#define WXO ((bf16*)(wsl + WS_WXO))
#define WUP ((bf16*)(wsl + WS_WUP))
#define WDOWN ((bf16*)(wsl + WS_WDOWN))
#define WGLU ((bf16*)(wsl + WS_WGLU))
#define XN ((bf16*)(wsl + WS_XN))
#define MEMN ((bf16*)(wsl + WS_MEMN))
#define Qb ((bf16*)(wsl + WS_Q))
#define Kb ((bf16*)(wsl + WS_K))
#define VT ((bf16*)(wsl + WS_VT))
#define U_ ((float*)(wsl + WS_U))
#define AO ((bf16*)(wsl + WS_AO))
#define LSE ((float*)(wsl + WS_LSE))
#define SSMF ((float*)(wsl + WS_SSMF))
#define MIXED ((bf16*)(wsl + WS_MIXED))
#define H1B ((bf16*)(wsl + WS_H1B))
#define SS1 ((float*)(wsl + WS_CTL + CTL_RS1))
#define QX ((bf16*)(wsl + WS_QX))
#define QSS ((float*)(wsl + WS_CTL + CTL_QS))
#define MSS ((float*)(wsl + WS_MSS))
#define MEMK ((bf16*)(wsl + WS_MEMK))
#define MVT ((bf16*)(wsl + WS_MVT))
#define OX ((bf16*)(wsl + WS_OX))
#define H2B ((bf16*)(wsl + WS_H2B))
#define SS2 ((float*)(wsl + WS_CTL + CTL_RS2))
#define UP ((bf16*)(wsl + WS_UP))
#define ACT ((bf16*)(wsl + WS_ACT))
#define SS1S (SS1 + MP)
#define QSSS (QSS + (size_t)MP * 4)
#define SS2S (SS2 + MP)
    float* out = args.out;

    if (IN(0)) for (int rep_ = 0; rep_ < NREP(0); ++rep_) { WSBASE();
        LAS float* scr = (LAS float*)(lds + wave * 16384);
        constexpr int I_IN = 16 * (INW / 32), I_SQ = 16 * (D / 32), I_KV = 16 * (2048 / 32), I_UP = 16 * (FF2 / 32), I_DN = (FF / 64) * (D / 32), I_GL = 4 * 8;
        constexpr int NIT = I_IN + 3 * I_SQ + I_KV + I_GL; (void)I_UP; (void)I_DN;
        for (int it = gw; it < NIT; it += NGW) {
            int r = it;
            if (r < I_IN) { p0_transpose_item<1>(args.in[I_WIN], D, INW, WIN, nullptr, scr, r, lane); continue; } r -= I_IN;
            if (r < I_SQ) { p0_transpose_item<0>(args.in[I_WOUT], D, D, WOUT, nullptr, scr, r, lane); continue; } r -= I_SQ;
            if (r < I_SQ) { p0_transpose_item<0>(args.in[I_WXQ], D, D, WXQ, args.in[I_NX], scr, r, lane); continue; } r -= I_SQ;
            if (r < I_SQ) { p0_transpose_item<0>(args.in[I_WXO], D, D, WXO, nullptr, scr, r, lane); continue; } r -= I_SQ;
            if (r < I_KV) { p0_transpose_item<0>(args.in[I_WXKV], D, 2048, WXKV, nullptr, scr, r, lane); continue; } r -= I_KV;
            p0_transpose_item<0>(args.in[I_WGLU], 256, 256, WGLU, nullptr, scr, r, lane);
        }
        { f32x4 gg[4];
#pragma unroll
          for (int j = 0; j < 4; ++j) gg[j] = ((const f32x4*)args.in[I_NMIX])[lane + 64 * j];
          for (int m = 2 * gw; m < MT; m += 2 * NGW) { const float* x0 = m < MP ? args.in[I_XP] + (size_t)m * D : args.in[I_XS] + (size_t)(m - MP) * D;
              rms_rows2_to_bf16(x0, x0 + D, gg, XN + (size_t)m * D, XN + (size_t)(m + 1) * D, lane); }
#pragma unroll
          for (int j = 0; j < 4; ++j) gg[j] = ((const f32x4*)args.in[I_NMEM])[lane + 64 * j];
          for (int m = 2 * gw; m < MM; m += 2 * NGW) rms_rows2_to_bf16(args.in[I_MEM] + (size_t)m * D, args.in[I_MEM] + (size_t)(m + 1) * D, gg, MEMN + (size_t)m * D, MEMN + (size_t)(m + 1) * D, lane); }
        {
            const int gt = vcu * (NWAVES * 64) + tid;
            if (gt < 2052 * 8) { const int pos = gt >> 3, i = gt & 7; const float iv = i == 0 ? 1.0f : i == 1 ? 0.1939227432012558f : i == 2 ? 0.03760603070259094f : i == 3 ? 0.007292664609849453f : i == 4 ? 0.0014142135623842478f : i == 5 ? 0.00027424818836152554f : i == 6 ? 5.3182957344688475e-05f : 1.0313385246263351e-05f;
                const float ang = (float)pos * iv; double s, c; sincos_d((double)ang, s, c); ROPE_[pos * 16 + i] = (float)c; ROPE_[pos * 16 + 8 + i] = (float)s; }
            const int st = gt - 2052 * 8;
            if (st >= 0 && st < 1024) {
                const int g = st >> 6; const double dt = exp_d((double)args.in[I_LDT][g]); const double lr = (double)args.in[I_LRE][st], li = (double)args.in[I_LIM][st];
                const double mag = exp_d(lr * dt); double s, c; sincos_d(li * dt, s, c); const double are = mag * c, aim = mag * s;
                const double den = lr * lr + li * li, nr = are - 1.0, ni = aim; const double cre = (nr * lr + ni * li) / den, cim = (ni * lr - nr * li) / den;
                const double mag64 = exp_d(64.0 * lr * dt); double s64, c64; sincos_d(64.0 * li * dt, s64, c64);
                float* o = SSMC_ + (size_t)st * 8; o[0] = (float)are; o[1] = (float)aim; o[2] = (float)cre; o[3] = (float)cim; o[4] = (float)(mag64 * c64); o[5] = (float)(mag64 * s64); o[6] = 0.f; o[7] = 0.f; }
        }
        GRID_BAR();
    }

    if (IN(1)) for (int rep_ = 0; rep_ < NREP(1); ++rep_) { WSBASE();
        int base = 0;
        { pg8::Gemm g{XN, WIN, MT, INW, D}; pg8::RotOrder S; S.init(MT, INW, G, bx, base); base += S.nwg;
          pg8::EpiZ E{Qb, Kb, VT, U_, ROPE_, args.in[I_QN], args.in[I_KN], out};
          pg8::gemm_phase<pg8::EpiZ, pg8::RotOrder, true, true>(lds, g, S, E); }
        { pg8::Gemm g{MEMN, WXKV, MM, 2048, D}; pg8::RotOrder S; S.init(MM, 2048, G, bx, base); base += S.nwg;
          pg8::EpiMem E{out + O_MEMKV, MSS, MVT}; pg8::gemm_phase<pg8::EpiMem, pg8::RotOrder, true, true>(lds, g, S, E); }
        {
            constexpr int I_UP = 16 * (FF2 / 32);
            const int first = base % G, nidle = G - first;
            if (bx >= first) {
                __syncthreads();
                LAS float* scr = (LAS float*)(lds + wave * 16384);
                p0_transpose_stream<2>(args.in[I_WUP], D, FF2, WUP, args.in[I_NFFN], scr, (bx - first) * NWAVES + wave, I_UP, nidle * NWAVES, lane);
            }
        }
        GRID_BAR();
    }

    if (IN(2)) for (int rep_ = 0; rep_ < NREP(2); ++rep_) { WSBASE();
        LAS float* uL = (LAS float*)(lds + wave * 4096);
        const int swapo = (bx >> 3) & 1;
#pragma unroll 1
        for (int pass = 0; pass < 2; ++pass) {
            if (pass == swapo) {
                for (int it = vcu; it < 3 * 256; it += G) pattn_wg_item(Qb, Kb, VT, AO, LSE, lds, it, wave, lane, tid);
            } else {
                if (wave < 6) { for (int it = vcu * 6 + wave; it < 3 * 512; it += G * 6) sattn_item(args, Qb, AO, LSE, it, lane); }
                else { if (rep_ == 0) for (int it = vcu * 2 + (wave - 6); it < MM; it += G * 2) memk_fix_item(out + O_MEMKV, MSS, args.in[I_XKN], args.in[I_XQN], MEMK, it, lane);
                       for (int it = vcu * 2 + (wave - 6); it < 8 * 31 * 16; it += G * 2) ssm_a_item(args, U_, SSMC_, SSMF, uL, it, lane); }
            }
            __syncthreads();
        }
        GRID_BAR();
    }

    if (IN(3)) for (int rep_ = 0; rep_ < NREP(3); ++rep_) { WSBASE();
#if defined(PROBE_LDS_FILL)
        for (int u_ = tid; u_ < 134656 / 4; u_ += NWAVES * 64) ((LAS unsigned*)lds)[u_] = PROBE_LDS_FILL;
        __syncthreads();
#endif
#if defined(PROBE_DELAY_P3)
        for (int i_ = 0; i_ < 10; ++i_) __builtin_amdgcn_s_sleep(127);
        __builtin_amdgcn_fence(__ATOMIC_ACQUIRE, "agent"); asm volatile("s_waitcnt vmcnt(0)" ::: "memory"); __syncthreads();
#endif
        const int swapo = (bx >> 3) & 1;
#pragma unroll 1
        for (int pass = 0; pass < 2; ++pass) {
            int tid3 = threadIdx.x; asm volatile("" : "+v"(tid3)); const int lane3 = tid3 & 63, wave3 = __builtin_amdgcn_readfirstlane(tid3 >> 6);
            if (pass == swapo) {
                if (G > 64) {
                    if (vcu >= 32) { const int ncw = (G - 32) * NWAVES; for (int R = ((vcu - 32) * NWAVES + wave3) * 8; R < MT; R += ncw * 8) combine_rows<8>(AO, LSE, args.in[I_AON], MIXED, R, lane3); }
                } else { for (int R = (vcu * NWAVES + wave3) * 4; R < MT; R += NGW * 4) combine_rows<4>(AO, LSE, args.in[I_AON], MIXED, R, lane3); }
            } else {
                for (int it = vcu; it < 256; it += G) ssm_c_item(args, U_, SSMC_, SSMF, WGLU, MIXED, lds, it, wave3, lane3);
            }
        }
        GRID_BAR();
    }

    if (IN(4)) for (int rep_ = 0; rep_ < NREP(4); ++rep_) { WSBASE();
        pg8::Gemm g{MIXED, WOUT, MP, D, D}; pg8::RotOrder S; S.init(MP, D, G, bx, 0);
        const bool tile_first = ((bx >> 3) & 1) != 0;
        if (tile_first) for (int tile = bx; tile < 256; tile += G)
            sample_gemm_tile<0, false>(MIXED + (size_t)MP * D, WOUT, D, args.in[I_XS], nullptr, H1B + (size_t)MP * D, SS1S, lds, tile, wave, lane, tid);
        pg8::EpiRes<false, false> E{args.in[I_XP], nullptr, H1B, SS1}; pg8::gemm_phase<pg8::EpiRes<false, false>, pg8::RotOrder, true, true>(lds, g, S, E);
        if (!tile_first) for (int tile = bx; tile < 256; tile += G)
            sample_gemm_tile<0, false>(MIXED + (size_t)MP * D, WOUT, D, args.in[I_XS], nullptr, H1B + (size_t)MP * D, SS1S, lds, tile, wave, lane, tid);
        GRID_BAR();
    }
    if (IN(5)) for (int rep_ = 0; rep_ < NREP(5); ++rep_) { WSBASE();
        pg8::Gemm g{H1B, WXQ, MP, D, D}; pg8::RotOrder S; S.init(MP, D, G, bx, 0);
        const bool tile_first = ((bx >> 3) & 1) != 0;
        if (tile_first) for (int tile = bx; tile < 256; tile += G)
            sample_gemm_tile<1>(H1B + (size_t)MP * D, WXQ, D, nullptr, nullptr, QX + (size_t)MP * D, QSSS, lds, tile, wave, lane, tid);
        pg8::EpiQx E{QX, QSS}; pg8::gemm_phase<pg8::EpiQx, pg8::RotOrder, true, true>(lds, g, S, E);
        if (!tile_first) for (int tile = bx; tile < 256; tile += G)
            sample_gemm_tile<1>(H1B + (size_t)MP * D, WXQ, D, nullptr, nullptr, QX + (size_t)MP * D, QSSS, lds, tile, wave, lane, tid);
        GRID_BAR();
    }
    if (IN(6)) for (int rep_ = 0; rep_ < NREP(6); ++rep_) { WSBASE();
        if (tid < 8) ((LAS unsigned*)(lds + MISC_OFF))[16 + tid] = 0u;
        __syncthreads();
        int swapo = (bx >> 3) & 1; asm volatile("" : "+s"(swapo));
#pragma unroll 1
        for (int pass = 0; pass < 2; ++pass) {
            if (pass == swapo) {
                int tid3 = threadIdx.x; asm volatile("" : "+v"(tid3)); const int lane3 = tid3 & 63, wave3 = __builtin_amdgcn_readfirstlane(tid3 >> 6);
                GAS unsigned char* wsl3 = (GAS unsigned char*)ws; asm volatile("" : "+s"(wsl3));
                int slot = 0;
                for (int pair = vcu; pair < BS * 4; pair += G, ++slot) sxattn_stream<8>(args, (bf16*)(wsl3 + WS_QX), (float*)(wsl3 + WS_CTL + CTL_RS1), (float*)(wsl3 + WS_CTL + CTL_QS), (bf16*)(wsl3 + WS_OX), lds, (LAS unsigned*)(lds + MISC_OFF) + 16 + (slot & 7), pair, slot & 1, wave3, lane3);
            } else {
                int tid2 = threadIdx.x; asm volatile("" : "+v"(tid2)); const int lane2 = tid2 & 63, wave2 = __builtin_amdgcn_readfirstlane(tid2 >> 6);
                GAS unsigned char* wsl2 = (GAS unsigned char*)ws; asm volatile("" : "+s"(wsl2));
                for (int it = vcu; it < 8 * 4 * 8; it += G) xattn_wg_item((bf16*)(wsl2 + WS_QX), (float*)(wsl2 + WS_CTL + CTL_RS1), (float*)(wsl2 + WS_CTL + CTL_QS), (bf16*)(wsl2 + WS_MEMK), (bf16*)(wsl2 + WS_MVT), (bf16*)(wsl2 + WS_OX), lds, it, wave2, lane2, tid2);
            }
            __syncthreads();
        }
        GRID_BAR();
    }
    if (IN(7)) for (int rep_ = 0; rep_ < NREP(7); ++rep_) { WSBASE();
        pg8::Gemm g{OX, WXO, MP, D, D}; pg8::RotOrder S; S.init(MP, D, G, bx, 0);
        const bool tile_first = ((bx >> 3) & 1) != 0;
        if (tile_first) for (int tile = bx; tile < 256; tile += G)
            sample_gemm_tile<0, true>(OX + (size_t)MP * D, WXO, D, H1B + (size_t)MP * D, nullptr, H2B + (size_t)MP * D, SS2S, lds, tile, wave, lane, tid);
        pg8::EpiRes<true, false> E{H1B, nullptr, H2B, SS2}; pg8::gemm_phase<pg8::EpiRes<true, false>, pg8::RotOrder, true, true>(lds, g, S, E);
        if (!tile_first) for (int tile = bx; tile < 256; tile += G)
            sample_gemm_tile<0, true>(OX + (size_t)MP * D, WXO, D, H1B + (size_t)MP * D, nullptr, H2B + (size_t)MP * D, SS2S, lds, tile, wave, lane, tid);
        GRID_BAR();
    }
    if (IN(8)) for (int rep_ = 0; rep_ < NREP(8); ++rep_) { WSBASE();
        pg8::Gemm g{H2B, WUP, MT, FF2, D}; pg8::RotOrder S; S.init(MT, FF2, G, bx, 0);
        pg8::EpiUpConv E{ACT, (float*)(wsl + WS_EDGE), SS2, args.in[I_CONVW], args.in[I_CONVB], args.in[I_SCONV], out + O_CONVP, out + O_CONVS, lds}; pg8::gemm_phase<pg8::EpiUpConv, pg8::RotOrder, true, true>(lds, g, S, E);
        {
            constexpr int I_DN = (FF / 64) * (D / 32);
            const int first = S.nwg % G, nidle = G - first;
            if (bx >= first) {
                __syncthreads();
                p0_transpose_stream<0>(args.in[I_WDOWN], FF, D, WDOWN, nullptr, (LAS float*)(lds + wave * 16384), (bx - first) * NWAVES + wave, I_DN, nidle * NWAVES, lane);
            }
        }
        GRID_BAR();
    }
    if (IN(10)) for (int rep_ = 0; rep_ < NREP(10); ++rep_) { WSBASE();
        pg8::Gemm g{ACT, WDOWN, MP, D, FF}; pg8::RotOrder S; S.init(MP, D, G, bx, 0);
        const bool tile_first = ((bx >> 3) & 1) != 0;
        if (tile_first) for (int tile = bx; tile < 256; tile += G)
            sample_gemm_tile<0, true>(ACT + (size_t)MP * FF, WDOWN, FF, H2B + (size_t)MP * D, out + (size_t)MP * D, nullptr, nullptr, lds, tile, wave, lane, tid);
        { pg8::Unit uu; for (int i = 0; S.next(i, uu); ++i) if ((uu.pm & 7) != 0) conv_fix_tile(args, (const float*)(wsl + WS_EDGE), ACT, uu.pm, tid);
          VM_WAIT(); __syncthreads(); }
        pg8::EpiRes<true, true> E{H2B, out, nullptr, nullptr}; pg8::gemm_phase<pg8::EpiRes<true, true>, pg8::RotOrder, true, true>(lds, g, S, E);
        if (!tile_first) for (int tile = bx; tile < 256; tile += G)
            sample_gemm_tile<0, true>(ACT + (size_t)MP * FF, WDOWN, FF, H2B + (size_t)MP * D, out + (size_t)MP * D, nullptr, nullptr, lds, tile, wave, lane, tid);
    }
#if defined(DBG_SCALE_MASK)
    if (hi == N_PHASES) { GRID_BAR();
        const size_t offs[16] = {O_YP, O_YS, O_KV1P, O_KV4P, O_KV16P, O_SREP, O_SIMP, O_CONVP, O_MEMKV, O_KV1S, O_KV4S, O_KV16S, O_SRES, O_SIMS, O_CONVS, O_END};
        const size_t gt = (size_t)vcu * (NWAVES * 64) + tid, NT = (size_t)G * NWAVES * 64;
#pragma unroll
        for (int o = 0; o < 15; ++o) if ((DBG_SCALE_MASK >> o) & 1) { for (size_t i = offs[o] + gt; i < offs[o + 1]; i += NT) out[i] *= 3.0f; }
    }
#endif
#undef IN
#undef GRID_BAR
}


#if defined(PROBE_DET) || defined(PROBE_P3_TWICE)
__global__ void det_cmp_kernel(const unsigned* a, const unsigned* b, size_t nwords, unsigned* counter, int tol, int rw, int lo, int hi) {
    unsigned c = 0;
    for (size_t i = (size_t)blockIdx.x * blockDim.x + threadIdx.x; i < nwords; i += (size_t)gridDim.x * blockDim.x) {
        if (rw > 0) { const int cw = (int)(i % (size_t)rw); if (cw < lo || cw >= hi) continue; }
        const unsigned x = a[i], y = b[i];
        if (tol) { const float fx = __uint_as_float(x), fy = __uint_as_float(y); if (!(fabsf(fx - fy) <= 0.02f)) ++c; } else if (x != y) { ++c; atomicMin(counter + 32, (unsigned)i); atomicMax(counter + 48, (unsigned)i); } }
    if (c) atomicAdd(counter, c);
}
__global__ void det_mark_kernel(const unsigned* counters, int nreg, float* y, size_t n, int forced) {
    int r = -1; for (int i = nreg - 1; i >= 0; --i) if (counters[i] != 0u) r = i;
#if defined(PROBE_DET_COUNT)
    { const unsigned c = counters[PROBE_DET_COUNT], fw = counters[32 + PROBE_DET_COUNT], lw = counters[48 + PROBE_DET_COUNT]; const int fitem = (int)(fw / 512u) / 64, litem = (int)(lw / 512u) / 64;
      r = -1;
      if (c) { switch (PROBE_DET_MODE) { case 1: r = (int)(c >> 10); break; case 2: r = fitem >> 4; break; case 3: r = fitem & 15; break; case 4: r = litem - fitem; break; case 5: r = (int)((fw / 512u) & 63) >> 2; break; case 6: r = (int)(fw & 511u) >> 5; break; default: r = 0; } if (r > 21) r = 21; } }
#endif
    if (forced >= 0) r = forced;
#if defined(PROBE_CAL)
    r = (int)((wall_clock64() >> 12) & 1) ? 19 : -1;
#endif
    if (r < 0) return;
    const float f = 1.0f + 0.1f * (float)(r + 1);
    for (size_t i = (size_t)blockIdx.x * blockDim.x + threadIdx.x; i < n; i += (size_t)gridDim.x * blockDim.x) y[i] *= f;
}
#endif

extern "C" void kernel_launch(void* const* d_in, const int* in_sizes, int n_in, void* d_out, int out_size, void* d_ws, size_t ws_size, hipStream_t stream) {
    static int grid = 0;
    if (grid == 0) {
        if (n_in != 39 || (size_t)out_size != O_END || ws_size < WS_END) { fprintf(stderr, "kernel_launch: unexpected problem shape (n_in %d, out %d, ws %zu); nothing launched\n", n_in, out_size, ws_size); grid = -1; return; }
        int dev = 0, cus = 0, per_cu = 0;
        if (hipGetDevice(&dev) != hipSuccess || hipDeviceGetAttribute(&cus, hipDeviceAttributeMultiprocessorCount, dev) != hipSuccess) { grid = -1; return; }
        if (hipFuncSetAttribute((const void*)fwd_kernel, hipFuncAttributeMaxDynamicSharedMemorySize, LDS_BYTES) != hipSuccess) { fprintf(stderr, "kernel_launch: hipFuncSetAttribute failed\n"); grid = -1; return; }
        if (hipOccupancyMaxActiveBlocksPerMultiprocessor(&per_cu, (const void*)fwd_kernel, NWAVES * 64, LDS_BYTES) != hipSuccess || per_cu < 1) { fprintf(stderr, "kernel_launch: occupancy query says %d workgroups per CU\n", per_cu); (void)hipGetLastError(); grid = -1; return; }
        grid = cus;
    }
    if (grid < 0) return;
    (void)hipMemsetAsync((char*)d_ws + WS_CTL, 0, CTL_ZERO_BYTES, stream);
    Args a{};
    for (int i = 0; i < 39; ++i) a.in[i] = (const float*)d_in[i];
    a.out = (float*)d_out; a.ws = (unsigned char*)d_ws;
#if defined(PROBE_PRE_HI)
    a.ph_lo = 0; a.ph_hi = PROBE_PRE_HI; a.li = 1; a.pad = 0;
    hipLaunchKernelGGL(fwd_kernel, dim3(grid), dim3(NWAVES * 64), LDS_BYTES, stream, a);
    (void)hipMemsetAsync((char*)d_ws + WS_CTL, 0, CTL_ZERO_BYTES, stream);
#endif
#if defined(PROBE_DET)
    {
        const size_t SP = 644 * MiB, need = 1005 * MiB;
        char* w = (char*)d_ws; float* o = (float*)d_out;
        if (ws_size >= need) {
            a.ph_lo = 0; a.ph_hi = N_PHASES; a.li = 0; a.pad = 0;
            hipLaunchKernelGGL(fwd_kernel, dim3(grid), dim3(NWAVES * 64), LDS_BYTES, stream, a);
#if defined(PROBE_DUMP)
            (void)hipMemcpyAsync(w + SP + 190 * MiB, w + 191 * MiB, 33 * MiB, hipMemcpyDeviceToDevice, stream);
            (void)hipMemcpyAsync(w + 760 * MiB, w + 724 * MiB, 34 * MiB, hipMemcpyDeviceToDevice, stream);
#else
            (void)hipMemcpyAsync(w + SP, w + 1 * MiB, 223 * MiB, hipMemcpyDeviceToDevice, stream);
            (void)hipMemcpyAsync(w + SP + 223 * MiB, w + 295 * MiB, 4 * MiB, hipMemcpyDeviceToDevice, stream);
            (void)hipMemcpyAsync(w + SP + 227 * MiB, d_out, O_END * 4, hipMemcpyDeviceToDevice, stream);
#endif
#if defined(PROBE_DET_POISON)
            (void)hipMemsetAsync(w + PROBE_DET_POISON_LO * MiB, 0xAA, (size_t)(PROBE_DET_POISON_HI - PROBE_DET_POISON_LO) * MiB, stream);
#endif
            (void)hipMemsetAsync(w + WS_CTL, 0, CTL_ZERO_BYTES, stream);
        }
    }
#endif
    for (int li = 0; li < N_LAUNCHES; ++li) {
        a.li = 0; a.pad = 0;
        a.ph_lo = (N_LAUNCHES == 1) ? 0 : li; a.ph_hi = (N_LAUNCHES == 1) ? N_PHASES : li + 1;
        hipLaunchKernelGGL(fwd_kernel, dim3(grid), dim3(NWAVES * 64), LDS_BYTES, stream, a);
        const hipError_t le = hipPeekAtLastError();
        if (le != hipSuccess) { fprintf(stderr, "kernel_launch: launch %d failed: %s\n", li, hipGetErrorName(le)); break; }
    }
#if defined(PROBE_P3_TWICE)
    {   char* w = (char*)d_ws; float* o = (float*)d_out; unsigned* cnt = (unsigned*)(w + 643 * MiB + 900 * 1024);
        (void)hipMemsetAsync(cnt, 0, 256, stream); (void)hipMemsetAsync(cnt + 32, 0xFF, 64, stream);
        hipLaunchKernelGGL(det_cmp_kernel, dim3(2048), dim3(256), 0, stream, (const unsigned*)(w + WS_MIXED), (const unsigned*)(w + 644 * MiB), (size_t)MP * D * 2 / 4, cnt + PROBE_DET_COUNT, 0, 512, 384, 512);
        hipLaunchKernelGGL(det_mark_kernel, dim3(32), dim3(256), 0, stream, cnt, 1, o + O_SREP, (size_t)BP * 1024, -1);
    }
#endif
#if defined(PROBE_DET)
    {
        const size_t SP = 644 * MiB, need = 1005 * MiB;
        char* w = (char*)d_ws; float* o = (float*)d_out; unsigned* cnt = (unsigned*)(w + 640 * MiB);
        cnt = (unsigned*)(w + 643 * MiB + 900 * 1024);
        if (ws_size < need) { hipLaunchKernelGGL(det_mark_kernel, dim3(1024), dim3(256), 0, stream, cnt, 0, o, (size_t)MP * D, 19); }
        else {
            (void)hipMemsetAsync(cnt, 0, 256, stream); (void)hipMemsetAsync(cnt + 32, 0xFF, 64, stream);
            const char* c0 = w + SP - 1 * MiB;
            const float* oc = (const float*)(w + SP + 227 * MiB);
            struct Reg { const void* a; const void* b; size_t bytes; int tol; };
            struct Reg2 { const void* a; const void* b; size_t bytes; int rw, lo, hi; };
#if defined(PROBE_DUMP)
            const Reg2 regs[5] = {
                {w + 724 * MiB, w + 760 * MiB, (size_t)8 * MiB, 0, 0, 0}, {w + 741 * MiB, w + 777 * MiB, (size_t)2 * MiB, 0, 0, 0},
                {w + WS_MIXED, c0 + WS_MIXED, (size_t)MP * D * 2, 512, 384, 512}, {w + WS_MIXED, c0 + WS_MIXED, (size_t)MP * D * 2, 512, 384, 512}, {w + WS_MIXED, c0 + WS_MIXED, (size_t)MP * D * 2, 512, 384, 512} };
#else
            const Reg2 regs[14] = {
                {w + WS_U, c0 + WS_U, (size_t)MT * 256 * 4, 0, 0, 0}, {w + WS_Q, c0 + WS_Q, (size_t)MT * 768 * 2, 0, 0, 0}, {w + WS_K, c0 + WS_K, (size_t)MT * 768 * 2, 0, 0, 0}, {w + WS_VT, c0 + WS_VT, (size_t)MP * 768 * 2, 0, 0, 0},
                {o + O_KV1P, oc + O_KV1P, (O_SREP - O_KV1P) * 4, 0, 0, 0}, {o + O_MEMKV, oc + O_MEMKV, (O_KV1S - O_MEMKV) * 4, 0, 0, 0}, {o + O_KV1S, oc + O_KV1S, (O_SRES - O_KV1S) * 4, 0, 0, 0},
                {w + WS_SSMF, c0 + WS_SSMF, 2 * MiB, 0, 0, 0}, {w + WS_AO, c0 + WS_AO, (size_t)MT * 768 * 2, 0, 0, 0}, {w + WS_LSE, c0 + WS_LSE, (size_t)MT * 12 * 4, 0, 0, 0}, {w + WS_MEMK, w + SP + 223 * MiB, 4 * MiB, 0, 0, 0},
                {o + O_SREP, oc + O_SREP, (O_CONVP - O_SREP) * 4, 0, 0, 0}, {o + O_SRES, oc + O_SRES, (O_CONVS - O_SRES) * 4, 0, 0, 0}, {w + WS_MIXED, c0 + WS_MIXED, (size_t)MT * D * 2, 0, 0, 0} };
#endif
            for (int r = 0; r < (int)(sizeof(regs) / sizeof(regs[0])); ++r) hipLaunchKernelGGL(det_cmp_kernel, dim3(2048), dim3(256), 0, stream, (const unsigned*)regs[r].a, (const unsigned*)regs[r].b, regs[r].bytes / 4, cnt + r, 0, regs[r].rw, regs[r].lo, regs[r].hi);
            hipLaunchKernelGGL(det_mark_kernel, dim3(32), dim3(256), 0, stream, cnt, 14, o + O_SREP, (size_t)BP * 1024, -1);
        }
    }
#endif
}
```

```cpp
#include <hip/hip_runtime.h>
#include <cstdio>
#include <cstdint>

#define GAS __attribute__((address_space(1)))
#define LAS __attribute__((address_space(3)))
#define PG8_LAS __attribute__((address_space(3)))
typedef unsigned short bf16;
typedef short bf16x8 __attribute__((ext_vector_type(8)));
typedef float f32x4 __attribute__((ext_vector_type(4)));
typedef float f32x2 __attribute__((ext_vector_type(2)));
typedef float f32x16 __attribute__((ext_vector_type(16)));
typedef unsigned u32x4 __attribute__((ext_vector_type(4)));
typedef unsigned u32x2 __attribute__((ext_vector_type(2)));
typedef GAS unsigned gu32;
#define RLX_AGENT __ATOMIC_RELAXED, __HIP_MEMORY_SCOPE_AGENT
#define LDS_WAIT() asm volatile("s_waitcnt lgkmcnt(0)" ::: "memory")
#define VM_WAIT() asm volatile("s_waitcnt vmcnt(0)" ::: "memory")

constexpr int D = 1024, BP = 8, LP = 2048, MP = BP * LP, BS = 128, TS = 4, MS = BS * TS, MT = MP + MS;
constexpr int INW = 2560, AW = 768, SW = 256, NMEM = 256, MM = BP * NMEM, FF = 2816, FF2 = 5632;
constexpr float EPS = 1e-6f;
constexpr float LOG2E = 1.4426950408889634f, LN2 = 0.6931471805599453f;
constexpr int NWAVES = 8;

constexpr size_t MiB = 1u << 20;
constexpr size_t WS_CTL = 0, CTL_ZERO_BYTES = 1 * MiB;
constexpr size_t WS_ROPE = 1 * MiB;
constexpr size_t WS_SSMC = 1 * MiB + 512 * 1024;
constexpr size_t WS_WIN = 2 * MiB, WS_WOUT = 7 * MiB, WS_WXQ = 9 * MiB, WS_WXKV = 11 * MiB, WS_WXO = 15 * MiB, WS_WUP = 17 * MiB, WS_WDOWN = 28 * MiB, WS_WGLU = 34 * MiB;
constexpr size_t WS_XN = 35 * MiB, WS_MEMN = 68 * MiB, WS_Q = 72 * MiB, WS_K = 97 * MiB, WS_VT = 122 * MiB, WS_U = 146 * MiB, WS_AO = 163 * MiB, WS_LSE = 188 * MiB;
constexpr size_t WS_SSMF = 189 * MiB, WS_MIXED = 191 * MiB, WS_H1B = 224 * MiB, WS_SS1 = 257 * MiB, WS_QX = 259 * MiB, WS_QSS = 292 * MiB, WS_MSS = 294 * MiB, WS_MEMK = 295 * MiB, WS_MVT = 299 * MiB;
constexpr size_t WS_OX = 303 * MiB, WS_H2B = 336 * MiB, WS_SS2 = 369 * MiB, WS_UP = 371 * MiB, WS_ACT = 553 * MiB, WS_END = 644 * MiB;
constexpr size_t WS_EDGE = 371 * MiB;
constexpr size_t WS_SS1S = 258 * MiB + 512 * 1024, WS_QSSS = 293 * MiB + 512 * 1024, WS_SS2S = 370 * MiB + 512 * 1024;
constexpr size_t CTL_RS1 = 128 * 1024, CTL_RS2 = 256 * 1024, CTL_QS = 384 * 1024;
constexpr int CW_BAR = 4096;

constexpr int RING_BYTES = 131072;
constexpr int MISC_OFF = 135168;
constexpr int LDS_BYTES = 147456;

__device__ __forceinline__ unsigned f2bf(float f) { unsigned u = __builtin_bit_cast(unsigned, f); return (u + 0x7fffu + ((u >> 16) & 1u)) >> 16; }
__device__ __forceinline__ unsigned pk2(float lo, float hi) { return f2bf(lo) | (f2bf(hi) << 16); }
__device__ __forceinline__ float bf2f(unsigned h) { return __builtin_bit_cast(float, h << 16); }
typedef __bf16 bf16v2_t __attribute__((ext_vector_type(2)));
__device__ __forceinline__ unsigned cvt_pk_bf16(float lo, float hi) { const f32x2 v = {lo, hi}; return __builtin_bit_cast(unsigned, __builtin_convertvector(v, bf16v2_t)); }
__device__ __forceinline__ bf16x8 pack8(float a0, float a1, float a2, float a3, float a4, float a5, float a6, float a7) {
    u32x4 w; w.x = cvt_pk_bf16(a0, a1); w.y = cvt_pk_bf16(a2, a3); w.z = cvt_pk_bf16(a4, a5); w.w = cvt_pk_bf16(a6, a7); return __builtin_bit_cast(bf16x8, w); }
__device__ __forceinline__ float wave_sum(float v) {
#pragma unroll
    for (int o = 1; o < 64; o <<= 1) v += __shfl_xor(v, o);
    return v;
}
__device__ __forceinline__ float fexp2(float x) { return __builtin_amdgcn_exp2f(x); }
__device__ __forceinline__ float flog2(float x) { return __builtin_amdgcn_logf(x); }
__device__ __forceinline__ float frcp(float x) { return __builtin_amdgcn_rcpf(x); }
__device__ __forceinline__ float frsq(float x) { return __builtin_amdgcn_rsqf(x); }
__device__ __forceinline__ void sincos_d(double x, double& s, double& c) {
    const double k = __builtin_rint(x * 0.63661977236758134308);
    double r = __builtin_fma(-k, 1.57079632679489655800e+00, x); r = __builtin_fma(-k, 6.12323399573676603587e-17, r);
    const long long q = (long long)k; const double r2 = r * r;
    double sp = 1.0 / 6227020800.0; sp = sp * r2 - 1.0 / 39916800.0; sp = sp * r2 + 1.0 / 362880.0; sp = sp * r2 - 1.0 / 5040.0; sp = sp * r2 + 1.0 / 120.0; sp = sp * r2 - 1.0 / 6.0; sp = sp * r2 + 1.0; sp = sp * r;
    double cp = -1.0 / 87178291200.0; cp = cp * r2 + 1.0 / 479001600.0; cp = cp * r2 - 1.0 / 3628800.0; cp = cp * r2 + 1.0 / 40320.0; cp = cp * r2 - 1.0 / 720.0; cp = cp * r2 + 1.0 / 24.0; cp = cp * r2 - 0.5; cp = cp * r2 + 1.0;
    const int qq = (int)(q & 3);
    s = (qq == 0) ? sp : (qq == 1) ? cp : (qq == 2) ? -sp : -cp;
    c = (qq == 0) ? cp : (qq == 1) ? -sp : (qq == 2) ? -cp : sp;
}
__device__ __forceinline__ double exp_d(double x) {
    const double k = __builtin_rint(x * 1.44269504088896340736);
    double r = __builtin_fma(-k, 6.93147180369123816490e-01, x); r = __builtin_fma(-k, 1.90821492927058770002e-10, r);
    double p = 1.0 / 6227020800.0;
    p = p * r + 1.0 / 479001600.0; p = p * r + 1.0 / 39916800.0; p = p * r + 1.0 / 3628800.0; p = p * r + 1.0 / 362880.0; p = p * r + 1.0 / 40320.0; p = p * r + 1.0 / 5040.0;
    p = p * r + 1.0 / 720.0; p = p * r + 1.0 / 120.0; p = p * r + 1.0 / 24.0; p = p * r + 1.0 / 6.0; p = p * r + 0.5; p = p * r + 1.0; p = p * r + 1.0;
    const int ki = (int)k;
    return __builtin_ldexp(p, ki);
}
__device__ __forceinline__ float dot4(f32x4 a) { return (a[0] * a[0] + a[1] * a[1]) + (a[2] * a[2] + a[3] * a[3]); }
__device__ __forceinline__ u32x4 pk8(f32x4 a, f32x4 b) { u32x4 w; w.x = cvt_pk_bf16(a[0], a[1]); w.y = cvt_pk_bf16(a[2], a[3]); w.z = cvt_pk_bf16(b[0], b[1]); w.w = cvt_pk_bf16(b[2], b[3]); return w; }
__device__ __forceinline__ f32x4 shx16(f32x4 a) { f32x4 r; r[0] = __shfl_xor(a[0], 16); r[1] = __shfl_xor(a[1], 16); r[2] = __shfl_xor(a[2], 16); r[3] = __shfl_xor(a[3], 16); return r; }
constexpr size_t O_KV1P_ = (size_t)MT * D, O_KV4P_ = O_KV1P_ + (size_t)BP * 128 * 512, O_KV16P_ = O_KV4P_ + (size_t)BP * 512 * 512;
constexpr size_t O_KV1S_ = O_KV16P_ + (size_t)BP * 2048 * 512 + 2 * BP * 1024 + (size_t)BP * 2 * FF2 + (size_t)MM * 2048, O_KV4S_ = O_KV1S_ + (size_t)MS * 512, O_KV16S_ = O_KV4S_ + (size_t)MS * 512;
typedef short s16x4 __attribute__((ext_vector_type(4)));
__device__ __forceinline__ s16x4 lds_tr4(LAS unsigned char* p) { return __builtin_bit_cast(s16x4, __builtin_amdgcn_ds_read_tr16_b64_v4i16((LAS s16x4*)p)); }
__device__ __forceinline__ bf16x8 cat44(s16x4 a, s16x4 b) { return (bf16x8){a[0], a[1], a[2], a[3], b[0], b[1], b[2], b[3]}; }
__device__ __forceinline__ void atomic_addf(float* p, float v) { (void)__hip_atomic_fetch_add(p, v, __ATOMIC_RELAXED, __HIP_MEMORY_SCOPE_AGENT); }

namespace pg8 {
#define PG8_LAS __attribute__((address_space(3)))
typedef unsigned short bf16_t;
typedef short bf16x8 __attribute__((ext_vector_type(8)));
typedef float f32x4 __attribute__((ext_vector_type(4)));
typedef unsigned u32x4 __attribute__((ext_vector_type(4)));
constexpr int BM = 256, BK = 64, HALF = 128, HTB = HALF * BK * 2  , STAGE_BYTES = 8 * HTB, NXCD = 8, WGM = 8;

__host__ __device__ __forceinline__ int lds_byte(int r, int c) { const int st = (r >> 4) * 2 + (c >> 5), rr = r & 15, cc = c & 31, ob = rr * 64 + cc * 2; return st * 1024 + (ob ^ (((ob >> 9) & 1) << 5)); }
__host__ __device__ __forceinline__ void stage_rc(int b, int& R, int& C) { const int st = b / 1024, sb = b % 1024, swz = sb ^ (((sb >> 9) & 1) << 5); R = (st >> 1) * 16 + swz / 64; C = (st & 1) * 32 + (swz % 64) / 2; }
__host__ __device__ __forceinline__ int perm32(int rho) { const int n = rho >> 4, i = rho & 15; return 8 * (i >> 2) + 4 * n + (i & 3); }

struct Unit { int pm, pn; };
struct Gemm { const bf16_t* A; const bf16_t* Bt; int M, N, K; };

struct StaticOrder {
    int nM, nN, nwg, G, c;
    __host__ __device__ void init(int M, int N, int G_, int c_) { nM = M / BM; nN = N / BM; nwg = nM * nN; G = G_; c = c_; }
    __host__ __device__ bool next(int i, Unit& u) const {
        const long L = (long)i * G + c; if (L >= nwg) return false;
        int wgid = (int)L; { const int q = nwg / NXCD, r = nwg % NXCD, xcd = wgid % NXCD, off = wgid / NXCD; wgid = (xcd < r ? xcd * (q + 1) : r * (q + 1) + (xcd - r) * q) + off; }
        const int nig = WGM * nN, gid = wgid / nig, fm = gid * WGM, gsz = (nM - fm) < WGM ? (nM - fm) : WGM;
        u.pm = fm + ((wgid % nig) % gsz); u.pn = (wgid % nig) / gsz; return true;
    }
    __device__ __forceinline__ void a_ready(const Unit&) const {}
    __device__ __forceinline__ void done(const Unit&) const {}
};


struct RotOrder {
    int nM, nN, nwg, G, c;
    __host__ __device__ void init(int M, int N, int G_, int blk, int base) { nM = M / BM; nN = N / BM; nwg = nM * nN; G = G_; const int rot = base % G_; c = blk - rot; if (c < 0) c += G_; }
    __host__ __device__ __forceinline__ bool next(int i, Unit& u) const {
        const long L = (long)i * G + c; if (L >= nwg) return false;
        int wgid = (int)L; { const int q = nwg / NXCD, r = nwg % NXCD, xcd = wgid % NXCD, off = wgid / NXCD; wgid = (xcd < r ? xcd * (q + 1) : r * (q + 1) + (xcd - r) * q) + off; }
        const int nig = WGM * nN, gid = wgid / nig, fm = gid * WGM, gsz = (nM - fm) < WGM ? (nM - fm) : WGM;
        u.pm = fm + ((wgid % nig) % gsz); u.pn = (wgid % nig) / gsz; return true;
    }
    __device__ __forceinline__ void a_ready(const Unit&) const {}
    __device__ __forceinline__ void done(const Unit&) const {}
};


struct EpiZ {
    static constexpr bool PERM = true, AFTER_DRAIN = false, BMAP = false, AMAP = false;
    bf16_t* Q; bf16_t* Kb; bf16_t* VN; float* U; const float* rope; const float* qg; const float* kg;
    float* outp;
    __device__ __forceinline__ int bmap(int r) const { return r; }
    __device__ __forceinline__ void operator()(const f32x4 (&acc)[2][2][4][2], const Unit& u, int wr, int wc, int fr, int fq) const {
        const int pn = u.pn; const bool sample = u.pm >= 64;
        const int rbase = u.pm * BM + wr * 64 + fr;
        if (pn == 9) {
#pragma unroll
            for (int ai = 0; ai < 2; ++ai)
#pragma unroll
                for (int m = 0; m < 4; ++m) { const int R = rbase + ai * HALF + m * 16; float* p = U + (size_t)R * 256 + wc * 64 + 8 * fq;
#pragma unroll
                    for (int bj = 0; bj < 2; ++bj) { *(f32x4*)(p + 32 * bj) = acc[ai][bj][m][0]; *(f32x4*)(p + 32 * bj + 4) = acc[ai][bj][m][1]; } }
            return;
        }
        const int kind = pn / 3, g = pn - 3 * kind;
        const int keep = g == 0 ? 128 : (g == 1 ? 512 : 2048);
        float* kvp = outp + (g == 0 ? O_KV1P_ : (g == 1 ? O_KV4P_ : O_KV16P_)); float* kvs = outp + (g == 0 ? O_KV1S_ : (g == 1 ? O_KV4S_ : O_KV16S_));
        if (kind == 2) {
#pragma unroll
            for (int ai = 0; ai < 2; ++ai)
#pragma unroll
                for (int m = 0; m < 4; ++m) { const int R = rbase + ai * HALF + m * 16; float* dst = nullptr;
                    if (sample) dst = kvs + ((size_t)(R - MP) * 2 + 1) * 256;
                    else { const int b = R >> 11, t = R & 2047; if (t >= 2048 - keep) dst = kvp + ((size_t)(b * keep + t - (2048 - keep)) * 2 + 1) * 256; }
                    if (dst) { dst += wc * 64 + 8 * fq;
#pragma unroll
                        for (int bj = 0; bj < 2; ++bj) { *(f32x4*)(dst + 32 * bj) = acc[ai][bj][m][0]; *(f32x4*)(dst + 32 * bj + 4) = acc[ai][bj][m][1]; } }
                    if (!sample) { bf16_t* vp = VN + (size_t)R * AW + g * 256 + wc * 64 + 8 * fq;
                        *(u32x4*)vp = pk8(acc[ai][0][m][0], acc[ai][0][m][1]); *(u32x4*)(vp + 32) = pk8(acc[ai][1][m][0], acc[ai][1][m][1]); } }
            return;
        }
        const float* gp = (kind == 0 ? qg : kg) + 8 * fq;
        const f32x4 g00 = *(const f32x4*)(gp), g01 = *(const f32x4*)(gp + 4), g10 = *(const f32x4*)(gp + 32), g11 = *(const f32x4*)(gp + 36);
        const float sgn = fq == 0 ? -1.f : 1.f;
        const float qs = kind == 0 ? 0.125f * LOG2E : 1.f;
        bf16_t* ob = kind == 0 ? Q : Kb;
        f32x4 rc0, rc1, rs0, rs1;
        { const int R = rbase; const int pos = sample ? 2048 + (R & 3) : (R & 2047); const float* rp = rope + (size_t)pos * 16; rc0 = *(const f32x4*)rp; rc1 = *(const f32x4*)(rp + 4); rs0 = *(const f32x4*)(rp + 8); rs1 = *(const f32x4*)(rp + 12); }
#pragma unroll
        for (int ai = 0; ai < 2; ++ai)
#pragma unroll
            for (int m = 0; m < 4; ++m) { const int R = rbase + ai * HALF + m * 16;
                const f32x4 c0 = rc0, c1 = rc1, s0 = rs0, s1 = rs1;
                if (ai * 4 + m < 7) { const int Rn = rbase + ((ai * 4 + m + 1) >> 2) * HALF + ((ai * 4 + m + 1) & 3) * 16; const int pos = sample ? 2048 + (Rn & 3) : (Rn & 2047); const float* rp = rope + (size_t)pos * 16;
                    rc0 = *(const f32x4*)rp; rc1 = *(const f32x4*)(rp + 4); rs0 = *(const f32x4*)(rp + 8); rs1 = *(const f32x4*)(rp + 12); }
                float ss = (dot4(acc[ai][0][m][0]) + dot4(acc[ai][0][m][1])) + (dot4(acc[ai][1][m][0]) + dot4(acc[ai][1][m][1])); ss += __shfl_xor(ss, 16); ss += __shfl_xor(ss, 32);
                const float rs = frsq(ss * (1.0f / 64.0f) + EPS);
                float* dst = nullptr;
                if (kind == 1) { if (sample) dst = kvs + ((size_t)(R - MP) * 2) * 256; else { const int b = R >> 11, t = R & 2047; if (t >= 2048 - keep) dst = kvp + ((size_t)(b * keep + t - (2048 - keep)) * 2) * 256; }
                    if (dst) dst += wc * 64 + 8 * fq; }
                bf16_t* op = ob + (size_t)R * AW + g * 256 + wc * 64 + 8 * fq;
                f32x4 xa = acc[ai][0][m][0] * rs * g00, xb = acc[ai][0][m][1] * rs * g01;
                { const f32x4 oa = shx16(xa), ob2 = shx16(xb);
                  if (fq < 2) { xa = xa * c0 + (oa * s0) * sgn; xb = xb * c1 + (ob2 * s1) * sgn; } }
                if (dst) { *(f32x4*)(dst) = xa; *(f32x4*)(dst + 4) = xb; }
                *(u32x4*)(op) = pk8(xa * qs, xb * qs);
                xa = acc[ai][1][m][0] * rs * g10; xb = acc[ai][1][m][1] * rs * g11;
                if (dst) { *(f32x4*)(dst + 32) = xa; *(f32x4*)(dst + 36) = xb; }
                *(u32x4*)(op + 32) = pk8(xa * qs, xb * qs);
            }
    }
};

struct EpiVt {
    static constexpr bool PERM = true, AFTER_DRAIN = false, BMAP = true, AMAP = false;
    bf16_t* VT; int g;
    __device__ __forceinline__ int bmap(int r) const { return g == 0 ? r : (g == 1 ? ((r & 63) * 4 + (r >> 6)) : ((r & 15) * 16 + (r >> 4))); }
    __device__ __forceinline__ void operator()(const f32x4 (&acc)[2][2][4][2], const Unit& u, int wr, int wc, int fr, int fq) const {
        const int b = u.pn >> 3, t0 = (u.pn & 7) * 256, sh = 2 * g, S = 2048 >> sh, Wl = 8 - sh;
#pragma unroll
        for (int ai = 0; ai < 2; ++ai)
#pragma unroll
            for (int m = 0; m < 4; ++m) { const int hh = 2 * wr + (m >> 1), d = 32 * ai + 16 * (m & 1) + fr;
#pragma unroll
                for (int bj = 0; bj < 2; ++bj) { const int c8 = 128 * bj + 32 * wc + 8 * fq, res = c8 >> Wl, ds = c8 & ((1 << Wl) - 1), pos = res * S + (t0 >> sh) + ds;
                    bf16_t* p = VT + ((((size_t)((g * 4 + hh) * 8 + b) * 64 + (pos >> 5)) * 64 + d) * 32 + (pos & 31));
                    *(u32x4*)p = pk8(acc[ai][bj][m][0], acc[ai][bj][m][1]); } }
    }
};

struct EpiMem {
    static constexpr bool PERM = true, AFTER_DRAIN = false, BMAP = false, AMAP = false;
    float* out; float* mss; bf16_t* MVN;
    __device__ __forceinline__ int bmap(int r) const { return r; }
    __device__ __forceinline__ void operator()(const f32x4 (&acc)[2][2][4][2], const Unit& u, int wr, int wc, int fr, int fq) const {
        const int kv = u.pn >> 2, h = u.pn & 3;
#pragma unroll
        for (int ai = 0; ai < 2; ++ai)
#pragma unroll
            for (int m = 0; m < 4; ++m) { const int R = u.pm * BM + ai * HALF + wr * 64 + m * 16 + fr; float* dst = out + ((size_t)R * 2 + kv) * 1024 + h * 256 + 32 * wc + 8 * fq; float ss = 0.f;
#pragma unroll
                for (int bj = 0; bj < 2; ++bj) { const f32x4 a = acc[ai][bj][m][0], c = acc[ai][bj][m][1]; *(f32x4*)(dst + 128 * bj) = a; *(f32x4*)(dst + 128 * bj + 4) = c; ss += dot4(a) + dot4(c);
                    if (kv) *(u32x4*)(MVN + (size_t)R * 1024 + h * 256 + 32 * wc + 8 * fq + 128 * bj) = pk8(a, c); }
                if (kv == 0) { ss += __shfl_xor(ss, 16); ss += __shfl_xor(ss, 32); if (fq == 0) mss[(size_t)R * 16 + h * 4 + wc] = ss; } }
    }
};
struct EpiMemVt {
    static constexpr bool PERM = true, AFTER_DRAIN = false, BMAP = false, AMAP = false;
    bf16_t* MVT;
    __device__ __forceinline__ int bmap(int r) const { return r; }
    __device__ __forceinline__ void operator()(const f32x4 (&acc)[2][2][4][2], const Unit& u, int wr, int wc, int fr, int fq) const {
        const int h = u.pm, b = u.pn;
#pragma unroll
        for (int ai = 0; ai < 2; ++ai)
#pragma unroll
            for (int m = 0; m < 4; ++m) { const int d = ai * HALF + wr * 64 + m * 16 + fr;
#pragma unroll
                for (int bj = 0; bj < 2; ++bj) { const int c8 = 128 * bj + 32 * wc + 8 * fq;
                    bf16_t* p = MVT + ((((size_t)(h * 8 + b) * 8 + (c8 >> 5)) * 256 + d) * 32 + (c8 & 31));
                    *(u32x4*)p = pk8(acc[ai][bj][m][0], acc[ai][bj][m][1]); } }
    }
};
template <bool BASE_BF16, bool OUT_F32> struct EpiRes {
    static constexpr bool PERM = true, AFTER_DRAIN = false, BMAP = false, AMAP = false;
    const void* base; float* out; bf16_t* hb; float* ssq;
    __device__ __forceinline__ int bmap(int r) const { return r; }
    __device__ __forceinline__ void operator()(const f32x4 (&acc)[2][2][4][2], const Unit& u, int wr, int wc, int fr, int fq) const {
        const int c0 = u.pn * BM + 32 * wc + 8 * fq;
#pragma unroll
        for (int ai = 0; ai < 2; ++ai) {
            f32x4 b0[4][2], b1[4][2];
#pragma unroll
            for (int m = 0; m < 4; ++m)
#pragma unroll
                for (int bj = 0; bj < 2; ++bj) { const size_t off = (size_t)(u.pm * BM + ai * HALF + wr * 64 + m * 16 + fr) * D + c0 + 128 * bj;
                    if (BASE_BF16) { const u32x4 w = *(const u32x4*)((const bf16_t*)base + off); b0[m][bj] = (f32x4){bf2f(w.x & 0xffffu), bf2f(w.x >> 16), bf2f(w.y & 0xffffu), bf2f(w.y >> 16)}; b1[m][bj] = (f32x4){bf2f(w.z & 0xffffu), bf2f(w.z >> 16), bf2f(w.w & 0xffffu), bf2f(w.w >> 16)}; }
                    else { b0[m][bj] = *(const f32x4*)((const float*)base + off); b1[m][bj] = *(const f32x4*)((const float*)base + off + 4); } }
            asm volatile("" ::: "memory");
#pragma unroll
            for (int m = 0; m < 4; ++m) { const int R = u.pm * BM + ai * HALF + wr * 64 + m * 16 + fr; float ss = 0.f;
#pragma unroll
                for (int bj = 0; bj < 2; ++bj) { const size_t off = (size_t)R * D + c0 + 128 * bj;
                    const f32x4 o0 = b0[m][bj] + acc[ai][bj][m][0], o1 = b1[m][bj] + acc[ai][bj][m][1];
                    if (OUT_F32) { *(f32x4*)(out + off) = o0; *(f32x4*)(out + off + 4) = o1; }
                    if (hb) *(u32x4*)(hb + off) = pk8(o0, o1);
                    ss += dot4(o0) + dot4(o1); }
                if (ssq) { ss += __shfl_xor(ss, 16); ss += __shfl_xor(ss, 32); if (fq == 0) atomic_addf(ssq + R, ss); } }
        }
    }
};
struct EpiQx {
    static constexpr bool PERM = true, AFTER_DRAIN = false, BMAP = false, AMAP = false;
    bf16_t* QX; float* qss;
    __device__ __forceinline__ int bmap(int r) const { return r; }
    __device__ __forceinline__ void operator()(const f32x4 (&acc)[2][2][4][2], const Unit& u, int wr, int wc, int fr, int fq) const {
        const int c0 = u.pn * BM + 32 * wc + 8 * fq;
#pragma unroll
        for (int ai = 0; ai < 2; ++ai)
#pragma unroll
            for (int m = 0; m < 4; ++m) { const int R = u.pm * BM + ai * HALF + wr * 64 + m * 16 + fr; float ss = 0.f;
#pragma unroll
                for (int bj = 0; bj < 2; ++bj) { const f32x4 a = acc[ai][bj][m][0], c = acc[ai][bj][m][1]; *(u32x4*)(QX + (size_t)R * D + c0 + 128 * bj) = pk8(a, c); ss += dot4(a) + dot4(c); }
                ss += __shfl_xor(ss, 16); ss += __shfl_xor(ss, 32); if (fq == 0) atomic_addf(qss + (size_t)R * 4 + u.pn, ss); }
    }
};
template <int CTRL> __device__ __forceinline__ float dppf(float old, float src) { return __builtin_bit_cast(float, __builtin_amdgcn_update_dpp(__builtin_bit_cast(int, old), __builtin_bit_cast(int, src), CTRL, 0xf, 0xf, false)); }
__device__ __forceinline__ f32x4 prev_rows1(f32x4 pg, f32x4 cur) { f32x4 r;
#pragma unroll
    for (int e = 0; e < 4; ++e) r[e] = dppf<0x111>(dppf<0x121>(0.f, pg[e]), cur[e]);
    return r; }
__device__ __forceinline__ f32x4 prev_rows2(f32x4 pg, f32x4 cur) { f32x4 r;
#pragma unroll
    for (int e = 0; e < 4; ++e) r[e] = dppf<0x112>(dppf<0x122>(0.f, pg[e]), cur[e]);
    return r; }
__device__ __forceinline__ float silu_(float x) { return x * frcp(1.0f + fexp2(-x * LOG2E)); }
constexpr int HALO_OFF = 135680;
struct EpiUpConv {
    static constexpr bool PERM = true, AFTER_DRAIN = false, BMAP = false, AMAP = true;
    bf16_t* ACT; float* EDGE; const float* rs2; const float* cw; const float* cb; const float* sconv; float* convp; float* convs; PG8_LAS unsigned char* lds;
    __device__ __forceinline__ int bmap(int r) const { return r; }
    __device__ __forceinline__ int amap(int r) const { return (r & 64) + 4 * (r & 15) + ((r >> 4) & 3); }
    __device__ __forceinline__ void operator()(f32x4 (&acc)[2][2][4][2], const Unit& u, int wr, int wc, int fr, int fq) const {
        const bool smp = u.pm >= 64;
        const int j8 = u.pn * 128 + 32 * wc + 8 * fq;
        f32x4 cwv[8];
#define UPC_LOADW(n_) do { const int j4_ = j8 + 4 * (n_); cwv[0] = *(const f32x4*)(cw + j4_); cwv[1] = *(const f32x4*)(cw + FF2 + j4_); cwv[2] = *(const f32x4*)(cw + 2 * FF2 + j4_); cwv[3] = *(const f32x4*)(cb + j4_); \
        cwv[4] = *(const f32x4*)(cw + FF + j4_); cwv[5] = *(const f32x4*)(cw + FF2 + FF + j4_); cwv[6] = *(const f32x4*)(cw + 2 * FF2 + FF + j4_); cwv[7] = *(const f32x4*)(cb + FF + j4_); } while (0)
        UPC_LOADW(0);
        const int tok0 = u.pm * BM + wr * 64 + 4 * fr;
        { float tot[2][4];
#pragma unroll
          for (int ai = 0; ai < 2; ++ai)
#pragma unroll
              for (int m = 0; m < 4; ++m) tot[ai][m] = rs2[tok0 + ai * HALF + m];
#pragma unroll
          for (int ai = 0; ai < 2; ++ai)
#pragma unroll
              for (int m = 0; m < 4; ++m) { const float rstd = frsq(tot[ai][m] * (1.0f / 1024.0f) + EPS);
#pragma unroll
                  for (int bj = 0; bj < 2; ++bj) { acc[ai][bj][m][0] = acc[ai][bj][m][0] * rstd; acc[ai][bj][m][1] = acc[ai][bj][m][1] * rstd; } } }
        PG8_LAS float* halo = (PG8_LAS float*)(lds + HALO_OFF);
        if (!smp && fr == 15) {
#pragma unroll
            for (int ai = 0; ai < 2; ++ai)
#pragma unroll
                for (int mm = 2; mm < 4; ++mm) { PG8_LAS float* hp = halo + ((((2 * ai + wr + 1) * 2 + (mm - 2)) * 4 + wc) * 4 + fq) * 16;
                    *(PG8_LAS f32x4*)(hp) = acc[ai][0][mm][0]; *(PG8_LAS f32x4*)(hp + 4) = acc[ai][0][mm][1]; *(PG8_LAS f32x4*)(hp + 8) = acc[ai][1][mm][0]; *(PG8_LAS f32x4*)(hp + 12) = acc[ai][1][mm][1]; }
        }
        asm volatile("s_waitcnt lgkmcnt(0)\n\ts_barrier" ::: "memory");
#pragma unroll
        for (int n = 0; n < 2; ++n) {
            const int j4 = j8 + 4 * n;
            if (n == 1) UPC_LOADW(1);
            const f32x4 wg0 = cwv[0], wg1 = cwv[1], wg2 = cwv[2], bgv = cwv[3], wv0 = cwv[4], wv1 = cwv[5], wv2 = cwv[6], bvv = cwv[7];
#pragma unroll
            for (int ai = 0; ai < 2; ++ai) {
                const int blk = 2 * ai + wr, tokb = tok0 + ai * HALF;
                f32x4 gm1, gm2, vm1, vm2;
                if (smp) { const float* sb = sconv + (size_t)((tokb - MP) >> 2) * 2 * FF2;
                    gm2 = *(const f32x4*)(sb + j4); vm2 = *(const f32x4*)(sb + FF + j4); gm1 = *(const f32x4*)(sb + FF2 + j4); vm1 = *(const f32x4*)(sb + FF2 + FF + j4); }
                else { f32x4 h2g = {0.f, 0.f, 0.f, 0.f}, h3g = h2g, h2v = h2g, h3v = h2g;
                    if (blk > 0 && fr == 0) { const PG8_LAS float* hp = halo + (((blk * 2) * 4 + wc) * 4 + fq) * 16; h2g = *(const PG8_LAS f32x4*)(hp + 4 * n); h2v = *(const PG8_LAS f32x4*)(hp + 8 + 4 * n);
                        h3g = *(const PG8_LAS f32x4*)(hp + 256 + 4 * n); h3v = *(const PG8_LAS f32x4*)(hp + 256 + 8 + 4 * n); }
#pragma unroll
                    for (int e = 0; e < 4; ++e) { gm1[e] = dppf<0x111>(h3g[e], acc[ai][0][3][n][e]); gm2[e] = dppf<0x111>(h2g[e], acc[ai][0][2][n][e]); vm1[e] = dppf<0x111>(h3v[e], acc[ai][1][3][n][e]); vm2[e] = dppf<0x111>(h2v[e], acc[ai][1][2][n][e]); } }
#pragma unroll
                for (int m = 0; m < 4; ++m) { const int R = tokb + m;
                    const f32x4 g = acc[ai][0][m][n], v = acc[ai][1][m][n];
                    const f32x4 g1 = m == 0 ? gm1 : acc[ai][0][m > 0 ? m - 1 : 0][n], v1 = m == 0 ? vm1 : acc[ai][1][m > 0 ? m - 1 : 0][n];
                    const f32x4 g2 = m == 0 ? gm2 : (m == 1 ? gm1 : acc[ai][0][m > 1 ? m - 2 : 0][n]), v2 = m == 0 ? vm2 : (m == 1 ? vm1 : acc[ai][1][m > 1 ? m - 2 : 0][n]);
                    if (smp) { if (m >= 2) { float* cd = convs + ((size_t)((R - MP) >> 2) * 2 + (m - 2)) * FF2; *(f32x4*)(cd + j4) = g; *(f32x4*)(cd + FF + j4) = v; } }
                    else if ((ai == 0 && m < 2) || (ai == 1 && m >= 2)) {
                        const int t = R & 2047;
                        if (t >= 2046) { float* cd = convp + ((size_t)(R >> 11) * 2 + (t - 2046)) * FF2; *(f32x4*)(cd + j4) = g; *(f32x4*)(cd + FF + j4) = v; }
                        const int rt = R & 255;
                        if (rt < 2 || rt >= 254) { float* ed = EDGE + ((size_t)u.pm * 4 + (rt < 2 ? rt : rt - 252)) * FF2; *(f32x4*)(ed + j4) = g; *(f32x4*)(ed + FF + j4) = v; }
                    }
                    const f32x4 cg = bgv + wg0 * g2 + wg1 * g1 + wg2 * g, cv = bvv + wv0 * v2 + wv1 * v1 + wv2 * v;
                    u32x2 w; w.x = cvt_pk_bf16(silu_(cg[0]) * cv[0], silu_(cg[1]) * cv[1]); w.y = cvt_pk_bf16(silu_(cg[2]) * cv[2], silu_(cg[3]) * cv[3]);
                    *(u32x2*)(ACT + (size_t)R * FF + j4) = w;
                }
            }
        }
    }
};
#undef UPC_LOADW

template <class Epi, class Sched, bool ALIGN_EPI = false, bool SP2 = false>
__device__ __forceinline__ void gemm_phase(PG8_LAS unsigned char* lds, const Gemm g, const Sched& S, const Epi& E) {
    int tid_ = threadIdx.x; asm volatile("" : "+v"(tid_));
    const int tid = tid_, wid = __builtin_amdgcn_readfirstlane(tid >> 6), lane = tid & 63, wr = wid >> 2, wc = wid & 3, fr = lane & 15, fq = lane >> 4;
    const int K = g.K, nt = K / BK;
    unsigned voffA[2], voffB[2], voffB1[2];
#pragma unroll
    for (int i = 0; i < 2; ++i) { int R, C; stage_rc(tid * 16 + i * 8192, R, C); const int Rb = Epi::PERM ? ((R & ~31) + perm32(R & 31)) : R;
        int Ra = R; if constexpr (Epi::AMAP) Ra = E.amap(R); voffA[i] = (unsigned)(Ra * K + C) * 2u;     voffB[i] = (unsigned)(E.bmap(Rb) * K + C) * 2u; if constexpr (Epi::BMAP) voffB1[i] = (unsigned)(E.bmap(HALF + Rb) * K + C) * 2u; else voffB1[i] = 0u; }
    const size_t kstep = (size_t)(BK * 2);
    const size_t hstep = (size_t)HALF * K * 2;
    const unsigned* vB1 = Epi::BMAP ? voffB1 : voffB; const size_t h1step = Epi::BMAP ? (size_t)0 : hstep;
    const size_t tstep = 2 * hstep;
    const unsigned ldsw = (unsigned)wid * 1024u;
    const int aoff = lds_byte(wr * 64 + fr, fq * 8), boff = lds_byte(wc * 32 + fr, fq * 8);
#define PG8_SA(b, h) (((b) * 2 + (h)) * HTB)
#define PG8_SB(b, h) ((4 + (b) * 2 + (h)) * HTB)
#define PG8_STAGE(bufoff, gbase, voff) do { _Pragma("unroll") for (int _i = 0; _i < 2; ++_i) \
        __builtin_amdgcn_global_load_lds((const unsigned*)((const char*)(gbase) + (voff)[_i]), (PG8_LAS unsigned*)(lds + (bufoff) + ldsw + _i * 8192), 16, 0, 0); } while (0)
#define PG8_LDA(dst, b, h) do { _Pragma("unroll") for (int m = 0; m < 4; ++m) _Pragma("unroll") for (int k = 0; k < 2; ++k) dst[m][k] = *(const PG8_LAS bf16x8*)(lds + PG8_SA(b, h) + aoff + m * 2048 + k * 1024); } while (0)
#define PG8_LDB(dst, b, h) do { _Pragma("unroll") for (int n = 0; n < 2; ++n) _Pragma("unroll") for (int k = 0; k < 2; ++k) dst[n][k] = *(const PG8_LAS bf16x8*)(lds + PG8_SB(b, h) + boff + n * 2048 + k * 1024); } while (0)
#define PG8_MMA(ai, bj, At, Bt) do { __builtin_amdgcn_s_setprio(1); _Pragma("unroll") for (int m = 0; m < 4; ++m) _Pragma("unroll") for (int n = 0; n < 2; ++n) _Pragma("unroll") for (int k = 0; k < 2; ++k) \
        acc[ai][bj][m][n] = __builtin_amdgcn_mfma_f32_16x16x32_bf16(Bt[n][k], At[m][k], acc[ai][bj][m][n], 0, 0, 0); __builtin_amdgcn_s_setprio(0); } while (0)
#define PG8_WAIT_V(n) asm volatile("s_waitcnt vmcnt(" #n ")" ::: "memory")
#define PG8_WAIT_L(n) asm volatile("s_waitcnt lgkmcnt(" #n ")" ::: "memory")
#define PG8_BAR __builtin_amdgcn_s_barrier()
#define PG8_SCHED __builtin_amdgcn_sched_barrier(0)
    Unit cur, nxt; int ui = 0;
    if (!S.next(0, cur)) return;
    f32x4 acc[2][2][4][2];
#pragma unroll
    for (int a = 0; a < 2; ++a)
#pragma unroll
        for (int b = 0; b < 2; ++b)
#pragma unroll
            for (int m = 0; m < 4; ++m)
#pragma unroll
                for (int n = 0; n < 2; ++n) acc[a][b][m][n] = (f32x4){0.f, 0.f, 0.f, 0.f};
    bf16x8 At[4][2], B0[2][2], B1[2][2];
    const char* cA = (const char*)g.A + (size_t)cur.pm * tstep; const char* cB = (const char*)g.Bt + (size_t)cur.pn * tstep;
    S.a_ready(cur);
    if constexpr (SP2) {
        PG8_STAGE(PG8_SB(0, 0), cB, voffB); PG8_STAGE(PG8_SB(0, 1), cB + h1step, vB1); PG8_STAGE(PG8_SA(0, 0), cA, voffA); PG8_STAGE(PG8_SA(0, 1), cA + hstep, voffA);
        if (wr == 1) PG8_BAR;
        PG8_WAIT_V(2); PG8_BAR;
        PG8_STAGE(PG8_SB(1, 0), cB + kstep, voffB); PG8_STAGE(PG8_SA(1, 0), cA + kstep, voffA); PG8_STAGE(PG8_SB(1, 1), cB + h1step + kstep, vB1);
        PG8_WAIT_V(6); PG8_BAR;
    } else {
        PG8_STAGE(PG8_SB(0, 0), cB, voffB); PG8_STAGE(PG8_SA(0, 0), cA, voffA); PG8_STAGE(PG8_SB(0, 1), cB + h1step, vB1); PG8_STAGE(PG8_SA(0, 1), cA + hstep, voffA);
        if (wr == 1) PG8_BAR;
        PG8_WAIT_V(4); PG8_BAR;
        PG8_STAGE(PG8_SB(1, 0), cB + kstep, voffB); PG8_STAGE(PG8_SA(1, 0), cA + kstep, voffA); PG8_STAGE(PG8_SB(1, 1), cB + h1step + kstep, vB1);
        PG8_WAIT_V(6); PG8_BAR;
    }
    for (;;) {
        const bool has_next = S.next(ui + 1, nxt);
        const char* nA = has_next ? (const char*)g.A + (size_t)nxt.pm * tstep : cA; const char* nB = has_next ? (const char*)g.Bt + (size_t)nxt.pn * tstep : cB;
        for (int t = 0; t < nt; t += 2) {
            const bool last = (t == nt - 2);
            const char* a1 = cA + (size_t)(t + 1) * kstep;
            const char* a2 = last ? nA : cA + (size_t)(t + 2) * kstep; const char* b2 = last ? nB : cB + (size_t)(t + 2) * kstep;
            const char* a3 = a2 + kstep; const char* b3 = b2 + kstep;
            if (last && has_next) S.a_ready(nxt);
            if constexpr (SP2) {
            PG8_LDB(B0, 0, 0); PG8_LDB(B1, 0, 1); PG8_SCHED; PG8_LDA(At, 0, 0); PG8_STAGE(PG8_SA(1, 1), a1 + hstep, voffA);
            PG8_WAIT_V(8); PG8_WAIT_L(0); PG8_BAR; PG8_MMA(0, 0, At, B0); PG8_MMA(0, 1, At, B1); PG8_BAR; PG8_SCHED;
            PG8_LDA(At, 0, 1); PG8_STAGE(PG8_SB(0, 0), b2, voffB); PG8_STAGE(PG8_SB(0, 1), b2 + h1step, vB1); PG8_STAGE(PG8_SA(0, 0), a2, voffA);
            PG8_WAIT_V(8); PG8_WAIT_L(0); PG8_BAR; PG8_MMA(1, 0, At, B0); PG8_MMA(1, 1, At, B1); PG8_BAR; PG8_SCHED;
            PG8_LDB(B0, 1, 0); PG8_LDB(B1, 1, 1); PG8_SCHED; PG8_LDA(At, 1, 0); PG8_STAGE(PG8_SA(0, 1), a2 + hstep, voffA);
            PG8_WAIT_V(8); PG8_WAIT_L(0); PG8_BAR; PG8_MMA(0, 0, At, B0); PG8_MMA(0, 1, At, B1); PG8_BAR; PG8_SCHED;
            PG8_LDA(At, 1, 1); PG8_STAGE(PG8_SB(1, 0), b3, voffB); PG8_STAGE(PG8_SB(1, 1), b3 + h1step, vB1); PG8_STAGE(PG8_SA(1, 0), a3, voffA);
            PG8_WAIT_V(8); PG8_WAIT_L(0); PG8_BAR; PG8_MMA(1, 0, At, B0); PG8_MMA(1, 1, At, B1); PG8_BAR; PG8_SCHED;
            } else {
            PG8_LDB(B0, 0, 0); PG8_SCHED; PG8_LDA(At, 0, 0); PG8_STAGE(PG8_SA(1, 1), a1 + hstep, voffA);
            PG8_WAIT_L(8); PG8_BAR; PG8_WAIT_L(0); PG8_MMA(0, 0, At, B0); PG8_BAR; PG8_SCHED;
            PG8_LDB(B1, 0, 1); PG8_STAGE(PG8_SB(0, 0), b2, voffB);
            PG8_BAR; PG8_WAIT_L(0); PG8_MMA(0, 1, At, B1); PG8_BAR;
            PG8_LDA(At, 0, 1); PG8_STAGE(PG8_SA(0, 0), a2, voffA);
            PG8_BAR; PG8_WAIT_L(0); PG8_MMA(1, 0, At, B0); PG8_BAR; PG8_SCHED;
            PG8_STAGE(PG8_SB(0, 1), b2 + h1step, vB1);
            PG8_WAIT_V(6); PG8_BAR; PG8_MMA(1, 1, At, B1); PG8_BAR;
            PG8_LDB(B0, 1, 0); PG8_SCHED; PG8_LDA(At, 1, 0); PG8_STAGE(PG8_SA(0, 1), a2 + hstep, voffA);
            PG8_WAIT_L(8); PG8_BAR; PG8_WAIT_L(0); PG8_MMA(0, 0, At, B0); PG8_BAR; PG8_SCHED;
            PG8_LDB(B1, 1, 1); PG8_STAGE(PG8_SB(1, 0), b3, voffB);
            PG8_BAR; PG8_WAIT_L(0); PG8_MMA(0, 1, At, B1); PG8_BAR;
            PG8_LDA(At, 1, 1); PG8_STAGE(PG8_SA(1, 0), a3, voffA);
            PG8_BAR; PG8_WAIT_L(0); PG8_MMA(1, 0, At, B0); PG8_BAR; PG8_SCHED;
            PG8_STAGE(PG8_SB(1, 1), b3 + h1step, vB1);
            PG8_WAIT_V(6); PG8_BAR; PG8_MMA(1, 1, At, B1); PG8_BAR;
            }
        }
        if constexpr (ALIGN_EPI) { if (wr == 0) PG8_BAR; }
        if constexpr (!Epi::AFTER_DRAIN) { E(acc, cur, wr, wc, fr, fq); S.done(cur); }
        if (!has_next) break;
#pragma unroll
        for (int a = 0; a < 2; ++a)
#pragma unroll
            for (int b = 0; b < 2; ++b)
#pragma unroll
                for (int m = 0; m < 4; ++m)
#pragma unroll
                    for (int n = 0; n < 2; ++n) acc[a][b][m][n] = (f32x4){0.f, 0.f, 0.f, 0.f};
        cur = nxt; cA = nA; cB = nB; ++ui;
        if constexpr (ALIGN_EPI) { if (wr == 1) PG8_BAR; }
    }
    PG8_WAIT_V(0);
    if constexpr (!ALIGN_EPI) { if (wr == 0) PG8_BAR; }
    PG8_BAR;
    if constexpr (Epi::AFTER_DRAIN) { E.fused(acc, cur, wr, wc, fr, fq, lds, wid, lane); S.done(cur); }
#undef PG8_SA
#undef PG8_SB
#undef PG8_STAGE
#undef PG8_LDA
#undef PG8_LDB
#undef PG8_MMA
#undef PG8_WAIT_V
#undef PG8_WAIT_L
#undef PG8_BAR
#undef PG8_SCHED
}
}

#define XB_TMO      128
#define XB_XCNT(j)  (256  + 64 * (j))
#define XB_XSUB(j)  (1280 + 64 * (j))
#define XB_XGEN(j)  (2304 + 64 * (j))
#define XB_TOP      3328
#define XB_TOPGEN   3392
#define XCD_BAR_WORDS 3456
#define XB_SPIN_CAP (1u << 18)

__device__ __forceinline__ unsigned xb_ld(unsigned* p)              { return __hip_atomic_load(p, __ATOMIC_RELAXED, __HIP_MEMORY_SCOPE_AGENT); }
__device__ __forceinline__ unsigned xb_add(unsigned* p, unsigned v) { return __hip_atomic_fetch_add(p, v, __ATOMIC_RELAXED, __HIP_MEMORY_SCOPE_AGENT); }
__device__ __forceinline__ unsigned xb_xcc_id() { return (unsigned)__builtin_amdgcn_s_getreg((3 << 11) | 20) & 0xFu; }
#define XB_SPIN(cond, bar) do { unsigned _sp = 0; while (cond) { __builtin_amdgcn_s_sleep(1); \
    if ((++_sp & 255u) == 0u) { if (xb_ld(&(bar)[XB_TMO])) break; if (_sp > XB_SPIN_CAP) { atomicAdd(&(bar)[XB_TMO], 1u); break; } } } } while (0)

struct XcdBarrier {
    unsigned* bar; unsigned x;
    volatile LAS unsigned* st;
};

__device__ __forceinline__ XcdBarrier xcd_barrier_post(unsigned* bar, volatile LAS unsigned* st) {
    XcdBarrier b; b.bar = bar; b.x = xb_xcc_id(); b.st = st;
    if (threadIdx.x == 0) (void)xb_add(&bar[XB_XCNT(b.x)], 1u);
    return b;
}
__device__ __forceinline__ void xcd_barrier_complete(unsigned* bar, unsigned x, unsigned& nloc, unsigned& nx) {
    const unsigned G = gridDim.x * gridDim.y * gridDim.z;
    unsigned sum, cnt, mine, sp = 0u;
    for (;;) {
        sum = 0u; cnt = 0u; mine = 0u;
#pragma unroll
        for (unsigned j = 0; j < 16; ++j) { const unsigned c = xb_ld(&bar[XB_XCNT(j)]); sum += c; cnt += (c > 0u) ? 1u : 0u; mine = (j == x) ? c : mine; }
        if (sum == G) break;
        __builtin_amdgcn_s_sleep(1);
        if ((++sp & 255u) == 0u) { if (xb_ld(&bar[XB_TMO])) break; if (sp > XB_SPIN_CAP) { atomicAdd(&bar[XB_TMO], 1u); break; } }
    }
    nloc = mine > 0u ? mine : 1u; nx = cnt > 0u ? cnt : 1u;
}

__device__ __forceinline__ void xcd_barrier(const XcdBarrier& b) {
    asm volatile("s_waitcnt vmcnt(0)" ::: "memory");
    __syncthreads();
    if (threadIdx.x == 0) {
        unsigned* bar = b.bar;
        __builtin_amdgcn_s_waitcnt(0);
        unsigned nloc = b.st[0], nx = b.st[1];
        if (nloc == 0u) { xcd_barrier_complete(bar, b.x, nloc, nx); b.st[0] = nloc; b.st[1] = nx; }
        const unsigned old = xb_add(&bar[XB_XSUB(b.x)], 1u);
        const unsigned gen = old / nloc;
        if (old + 1u == (gen + 1u) * nloc) {
            __builtin_amdgcn_fence(__ATOMIC_RELEASE, "agent");
            asm volatile("s_waitcnt vmcnt(0)" ::: "memory");
            const unsigned og = xb_add(&bar[XB_TOP], 1u);
            const unsigned tg = og / nx;
            if (og + 1u == (tg + 1u) * nx) xb_add(&bar[XB_TOPGEN], 1u);
            else XB_SPIN(xb_ld(&bar[XB_TOPGEN]) == tg, bar);
            __builtin_amdgcn_fence(__ATOMIC_ACQUIRE, "agent");
            xb_add(&bar[XB_XGEN(b.x)], 1u);
            asm volatile("s_waitcnt vmcnt(0)" ::: "memory");
        } else {
            XB_SPIN(xb_ld(&bar[XB_XGEN(b.x)]) == gen, bar);
            __builtin_amdgcn_fence(__ATOMIC_ACQUIRE, "agent");
            asm volatile("s_waitcnt vmcnt(0)" ::: "memory");
        }
    }
    __syncthreads();
}

struct Args { const float* in[39]; float* out; unsigned char* ws; int ph_lo, ph_hi, li, pad; };
enum { I_XP = 0, I_XS, I_MEM, I_C1, I_C4, I_C16, I_SRE, I_SIM, I_SCONV, I_CMEM, I_NMIX, I_WIN, I_QN, I_KN, I_LRE, I_LIM, I_LDT, I_BRE, I_BIM, I_CRE, I_CIM, I_SD, I_WGLU, I_BGLU,
       I_AON, I_SON, I_WOUT, I_NX, I_NMEM, I_WXQ, I_WXKV, I_XQN, I_XKN, I_WXO, I_NFFN, I_WUP, I_CONVW, I_CONVB, I_WDOWN };
constexpr size_t O_YP = 0, O_YS = O_YP + (size_t)MP * D, O_KV1P = O_YS + (size_t)MS * D, O_KV4P = O_KV1P + (size_t)BP * 128 * 512, O_KV16P = O_KV4P + (size_t)BP * 512 * 512,
    O_SREP = O_KV16P + (size_t)BP * 2048 * 512, O_SIMP = O_SREP + BP * 1024, O_CONVP = O_SIMP + BP * 1024, O_MEMKV = O_CONVP + (size_t)BP * 2 * FF2, O_KV1S = O_MEMKV + (size_t)MM * 2048,
    O_KV4S = O_KV1S + (size_t)MS * 512, O_KV16S = O_KV4S + (size_t)MS * 512, O_SRES = O_KV16S + (size_t)MS * 512, O_SIMS = O_SRES + BS * 1024, O_CONVS = O_SIMS + BS * 1024, O_END = O_CONVS + (size_t)BS * 2 * FF2;
static_assert(O_END == 35102720 && O_KV1P == O_KV1P_ && O_KV4P == O_KV4P_ && O_KV16P == O_KV16P_ && O_KV1S == O_KV1S_ && O_KV4S == O_KV4S_ && O_KV16S == O_KV16S_, "output map");

template <int MODE> __device__ __forceinline__ int rowmap(int n) {
    if (MODE == 1) return (n & ~255) + 128 * ((n >> 5) & 1) + 32 * ((n >> 6) & 3) + (n & 31);
    if (MODE == 2) { return n < FF ? 256 * (n >> 7) + (n & 127) : 256 * ((n - FF) >> 7) + 128 + ((n - FF) & 127); }
    return n;
}
template <int MODE> __device__ __forceinline__ void p0_transpose_item(const float* W, int K, int N, bf16* WT, const float* gk, LAS float* scr, int item, int lane) {
    const int nblk = N / 32, kb = item / nblk, nb = item % nblk, k0 = 64 * kb, n0 = 32 * nb;
    float wv[32];
#pragma unroll
    for (int i = 0; i < 32; ++i) wv[i] = W[(size_t)(k0 + 2 * i + (lane >> 5)) * N + n0 + (lane & 31)];
    if (gk) {
#pragma unroll
        for (int i = 0; i < 32; ++i) wv[i] *= gk[k0 + 2 * i + (lane >> 5)]; }
#pragma unroll
    for (int i = 0; i < 32; ++i) scr[(2 * i + (lane >> 5)) * 33 + (lane & 31)] = wv[i];
    LDS_WAIT(); asm volatile("" ::: "memory");
    const int c = lane & 7;
#pragma unroll
    for (int j = 0; j < 4; ++j) { const int n = (lane >> 3) + 8 * j; const LAS float* s = scr + (8 * c) * 33 + n;
        u32x4 o; o.x = pk2(s[0 * 33], s[1 * 33]); o.y = pk2(s[2 * 33], s[3 * 33]); o.z = pk2(s[4 * 33], s[5 * 33]); o.w = pk2(s[6 * 33], s[7 * 33]);
        *(GAS u32x4*)(WT + (size_t)rowmap<MODE>(n0 + n) * K + k0 + 8 * c) = o; }
    LDS_WAIT(); asm volatile("" ::: "memory");
}
__device__ __forceinline__ void p0_tr_load(const float* W, int N, int item, int lane, float (&wv)[32]) {
    const int nblk = N / 32, kb = item / nblk, nb = item % nblk, k0 = 64 * kb, n0 = 32 * nb;
#pragma unroll
    for (int i = 0; i < 32; ++i) wv[i] = W[(size_t)(k0 + 2 * i + (lane >> 5)) * N + n0 + (lane & 31)];
}
template <int MODE> __device__ __forceinline__ void p0_tr_store(int K, int N, bf16* WT, const float* gk, LAS float* scr, int item, int lane, const float (&wv)[32]) {
    const int nblk = N / 32, kb = item / nblk, nb = item % nblk, k0 = 64 * kb, n0 = 32 * nb;
    const int c = lane & 7;
    f32x4 g0 = {1.f, 1.f, 1.f, 1.f}, g1 = g0;
    if (gk) { g0 = *(const f32x4*)(gk + k0 + 8 * c); g1 = *(const f32x4*)(gk + k0 + 8 * c + 4); }
#pragma unroll
    for (int i = 0; i < 32; ++i) scr[(2 * i + (lane >> 5)) * 33 + (lane & 31)] = wv[i];
    LDS_WAIT(); asm volatile("" ::: "memory");
#pragma unroll
    for (int j = 0; j < 4; ++j) { const int n = (lane >> 3) + 8 * j; const LAS float* s = scr + (8 * c) * 33 + n;
        u32x4 o; o.x = pk2(s[0 * 33] * g0[0], s[1 * 33] * g0[1]); o.y = pk2(s[2 * 33] * g0[2], s[3 * 33] * g0[3]); o.z = pk2(s[4 * 33] * g1[0], s[5 * 33] * g1[1]); o.w = pk2(s[6 * 33] * g1[2], s[7 * 33] * g1[3]);
        *(GAS u32x4*)(WT + (size_t)rowmap<MODE>(n0 + n) * K + k0 + 8 * c) = o; }
    LDS_WAIT(); asm volatile("" ::: "memory");
}
template <int MODE> __device__ __forceinline__ void p0_transpose_stream(const float* W, int K, int N, bf16* WT, const float* gk, LAS float* scr, int it, int nitems, int stride, int lane) {
    if (it >= nitems) return;
    float wa[32], wb[32];
    p0_tr_load(W, N, it, lane, wa);
    for (;;) {
        const int i1 = it + stride; if (i1 < nitems) p0_tr_load(W, N, i1, lane, wb);
        p0_tr_store<MODE>(K, N, WT, gk, scr, it, lane, wa);
        if (i1 >= nitems) break;
        const int i2 = i1 + stride; if (i2 < nitems) p0_tr_load(W, N, i2, lane, wa);
        p0_tr_store<MODE>(K, N, WT, gk, scr, i1, lane, wb);
        if (i2 >= nitems) break;
        it = i2;
    }
}
__device__ __forceinline__ void rms_rows2_to_bf16(const float* xrow0, const float* xrow1, const f32x4 (&gg)[4], bf16* orow0, bf16* orow1, int lane) {
    const f32x4* xr0 = (const f32x4*)xrow0 + lane; const f32x4* xr1 = (const f32x4*)xrow1 + lane;
    f32x4 v0[4], v1[4]; float s0 = 0.f, s1 = 0.f;
#pragma unroll
    for (int j = 0; j < 4; ++j) { v0[j] = xr0[64 * j]; v1[j] = xr1[64 * j]; }
#pragma unroll
    for (int j = 0; j < 4; ++j) { s0 += dot4(v0[j]); s1 += dot4(v1[j]); }
#pragma unroll
    for (int o = 1; o < 64; o <<= 1) { s0 += __shfl_xor(s0, o); s1 += __shfl_xor(s1, o); }
    const float r0 = frsq(s0 * (1.0f / D) + EPS), r1 = frsq(s1 * (1.0f / D) + EPS);
    u32x2* o0 = (u32x2*)orow0 + lane; u32x2* o1 = (u32x2*)orow1 + lane;
#pragma unroll
    for (int j = 0; j < 4; ++j) { const f32x4 a = v0[j] * r0 * gg[j], c = v1[j] * r1 * gg[j];
        u32x2 w; w.x = cvt_pk_bf16(a[0], a[1]); w.y = cvt_pk_bf16(a[2], a[3]); o0[64 * j] = w;
        u32x2 z; z.x = cvt_pk_bf16(c[0], c[1]); z.y = cvt_pk_bf16(c[2], c[3]); o1[64 * j] = z; }
}

__device__ __forceinline__ int pi23(int m) { return (m & ~12) | ((m & 4) << 1) | ((m & 8) >> 1); }
__device__ __forceinline__ void memk_fix_item(float* memkv, const float* mss, const float* xkn, const float* xqn, bf16* MEMK, int Rm, int lane) {
    const f32x4 gk = *(const f32x4*)(xkn + 4 * lane), gq = *(const f32x4*)(xqn + 4 * lane);
    f32x4 v[4], s[4];
#pragma unroll
    for (int h = 0; h < 4; ++h) { v[h] = *(const f32x4*)(memkv + (size_t)Rm * 2048 + h * 256 + 4 * lane); s[h] = *(const f32x4*)(mss + (size_t)Rm * 16 + 4 * h); }
#pragma unroll
    for (int h = 0; h < 4; ++h) {
        const float rs = frsq(((s[h][0] + s[h][1]) + (s[h][2] + s[h][3])) * (1.0f / 256.0f) + EPS);
        const f32x4 kn = v[h] * rs * gk; *(f32x4*)(memkv + (size_t)Rm * 2048 + h * 256 + 4 * lane) = kn; const f32x4 kq = kn * gq;
        u32x2 w; w.x = cvt_pk_bf16(kq[0], kq[1]); w.y = cvt_pk_bf16(kq[2], kq[3]); *(u32x2*)(MEMK + (size_t)Rm * 1024 + h * 256 + 4 * lane) = w;
    }
}
__device__ __forceinline__ void ssm_bfrags(const Args& a, const float* ssmc, int g, int lane, bf16x8 (&bb)[4]) {
    const int n = lane & 31, hi = lane >> 5;
#pragma unroll
    for (int s2 = 0; s2 < 2; ++s2) { const int st = g * 64 + 32 * s2 + n; const f32x4 c0 = *(const f32x4*)(ssmc + (size_t)st * 8); const float cr = c0[2], ci = c0[3];
        const f32x4 r0 = *(const f32x4*)(a.in[I_BRE] + (size_t)st * 16 + 8 * hi), r1 = *(const f32x4*)(a.in[I_BRE] + (size_t)st * 16 + 8 * hi + 4);
        const f32x4 i0 = *(const f32x4*)(a.in[I_BIM] + (size_t)st * 16 + 8 * hi), i1 = *(const f32x4*)(a.in[I_BIM] + (size_t)st * 16 + 8 * hi + 4);
        const f32x4 pr0 = r0 * cr - i0 * ci, pr1 = r1 * cr - i1 * ci, pi0 = i0 * cr + r0 * ci, pi1 = i1 * cr + r1 * ci;
        bb[s2] = pack8(pr0[0], pr0[1], pr0[2], pr0[3], pr1[0], pr1[1], pr1[2], pr1[3]); bb[2 + s2] = pack8(pi0[0], pi0[1], pi0[2], pi0[3], pi1[0], pi1[1], pi1[2], pi1[3]); }
}
__device__ __forceinline__ bf16x8 ssm_loadu(const float* U, int row0, int nrows, int g, int lane) {
    const int m = lane & 31, hi = lane >> 5; const int row = row0 + (m < nrows ? m : (m & (nrows - 1)));
    const f32x4 u0 = *(const f32x4*)(U + (size_t)row * 256 + g * 16 + 8 * hi), u1 = *(const f32x4*)(U + (size_t)row * 256 + g * 16 + 8 * hi + 4);
    return pack8(u0[0], u0[1], u0[2], u0[3], u1[0], u1[1], u1[2], u1[3]);
}
__device__ __forceinline__ void ssm_xcompute(bf16x8 ua, const bf16x8 (&bb)[4], f32x16 (&xr)[2], f32x16 (&xi)[2]) {
    const f32x16 z = {0.f, 0.f, 0.f, 0.f, 0.f, 0.f, 0.f, 0.f, 0.f, 0.f, 0.f, 0.f, 0.f, 0.f, 0.f, 0.f};
    f32x16 t0 = __builtin_amdgcn_mfma_f32_32x32x16_bf16(ua, bb[0], z, 0, 0, 0), t1 = __builtin_amdgcn_mfma_f32_32x32x16_bf16(ua, bb[1], z, 0, 0, 0);
    f32x16 t2 = __builtin_amdgcn_mfma_f32_32x32x16_bf16(ua, bb[2], z, 0, 0, 0), t3 = __builtin_amdgcn_mfma_f32_32x32x16_bf16(ua, bb[3], z, 0, 0, 0);
#pragma unroll
    for (int r = 0; r < 16; ++r) {
        const float a0 = t0[r], a1 = t1[r], a2 = t2[r], a3 = t3[r];
        const auto sr = __builtin_amdgcn_permlane32_swap(__float_as_uint(a0), __float_as_uint(a1), false, false);
        const unsigned s0 = sr[0], s1 = sr[1];
        xr[0][r] = __uint_as_float(s0); xr[1][r] = __uint_as_float(s1);
        const auto si = __builtin_amdgcn_permlane32_swap(__float_as_uint(a2), __float_as_uint(a3), false, false);
        const unsigned s2 = si[0], s3 = si[1];
        xi[0][r] = __uint_as_float(s2); xi[1][r] = __uint_as_float(s3); }
    __builtin_amdgcn_sched_barrier(0); asm volatile("s_nop 7" ::: "memory"); __builtin_amdgcn_sched_barrier(0);
}
#define SSM_XR(t) xr[((t) >> 2) & 1][((t) & 3) + 4 * ((t) >> 3)]
#define SSM_XI(t) xi[((t) >> 2) & 1][((t) & 3) + 4 * ((t) >> 3)]
__device__ __forceinline__ void ssm_a_item(const Args& a, const float* U, const float* ssmc, float* SSMF, LAS float* uL, int it, int lane) {
    const int g = it & 15, bc = it >> 4, b = bc / 31, c = bc - b * 31;
    const f32x4 c0 = *(const f32x4*)(ssmc + (size_t)(g * 64 + lane) * 8);
    const float ar = c0[0], ai = c0[1];
    bf16x8 bb[4]; ssm_bfrags(a, ssmc, g, lane, bb);
    float hr = 0.f, hi = 0.f;
    bf16x8 ua2[2]; ua2[0] = ssm_loadu(U, b * 2048 + c * 64, 32, g, lane); ua2[1] = ssm_loadu(U, b * 2048 + c * 64 + 32, 32, g, lane);
#pragma unroll
    for (int blk = 0; blk < 2; ++blk) {
        f32x16 xr[2], xi[2]; ssm_xcompute(ua2[blk], bb, xr, xi);
#pragma unroll
        for (int t = 0; t < 32; ++t) { const float nr = fmaf(ar, hr, fmaf(-ai, hi, SSM_XR(t))), ni = fmaf(ar, hi, fmaf(ai, hr, SSM_XI(t))); hr = nr; hi = ni; }
    }
    *(f32x2*)(SSMF + ((size_t)((b * 32 + c) * 16 + g) * 64 + lane) * 2) = (f32x2){hr, hi};
    (void)uL;
}
constexpr int SAB = 4;
struct SaBatch { f32x4 k[SAB], v[SAB]; };
__device__ __forceinline__ void sa_load(SaBatch& B, const float* cb, unsigned loff, int t, int dil, int nvalid, int i0) {
#pragma unroll
    for (int j = 0; j < SAB; ++j) { const int i = i0 + j, idx = i < nvalid ? t + i * dil : t; const char* rp = (const char*)(cb + (size_t)idx * 512);
        B.k[j] = __builtin_nontemporal_load((const f32x4*)(rp + loff)); B.v[j] = __builtin_nontemporal_load((const f32x4*)(rp + 1024 + loff)); }
}
__device__ __forceinline__ void sa_compute(const SaBatch& B, f32x4 q, int nvalid, int i0, float& m, float& l, f32x4& o) {
    float s[SAB]; float mb = m;
#pragma unroll
    for (int j = 0; j < SAB; ++j) { float d = (q[0] * B.k[j][0] + q[1] * B.k[j][1]) + (q[2] * B.k[j][2] + q[3] * B.k[j][3]);
        d += __shfl_xor(d, 1); d += __shfl_xor(d, 2); d += __shfl_xor(d, 4); d += __shfl_xor(d, 8);
        s[j] = (i0 + j) < nvalid ? d : -1e30f; mb = fmaxf(mb, s[j]); }
    const float sc = fexp2(m - mb); l *= sc; o = o * sc; m = mb;
#pragma unroll
    for (int j = 0; j < SAB; ++j) { const float p = fexp2(s[j] - mb); l += p; o = o + B.v[j] * p; }
}
__device__ __forceinline__ void sattn_item(const Args& a, const bf16* Q, bf16* AO, float* LSE, int it, int lane) {
    const int g = it >> 9, rem = it & 511, b = rem >> 2, t = rem & 3;
    const int dil = 1 << (2 * g), nbuf = 128 << (2 * g);
    const int R = MP + 4 * b + t, hh = lane >> 4, dq = (lane & 15) * 4;
    const u32x2 qw = *(const u32x2*)(Q + (size_t)R * AW + g * 256 + hh * 64 + dq);
    const f32x4 q = {bf2f(qw.x & 0xffffu), bf2f(qw.x >> 16), bf2f(qw.y & 0xffffu), bf2f(qw.y >> 16)};
    const float* cb = a.in[I_C1 + g] + (size_t)b * nbuf * 512; const unsigned loff = 4u * (unsigned)(hh * 64 + dq);
    const float* nb = a.out + (g == 0 ? O_KV1S : (g == 1 ? O_KV4S : O_KV16S)) + (size_t)(4 * b) * 512 + hh * 64 + dq;
    const int nvalid = g == 0 ? 128 - t : 128;
    float m = -1e30f, l = 0.f; f32x4 o = {0.f, 0.f, 0.f, 0.f};
    SaBatch A, B; sa_load(A, cb, loff, t, dil, nvalid, 0);
#pragma unroll 1
    for (int i0 = 0; i0 < 128; i0 += 2 * SAB) {
        sa_load(B, cb, loff, t, dil, nvalid, i0 + SAB);
        sa_compute(A, q, nvalid, i0, m, l, o);
        if (i0 + 2 * SAB < 128) sa_load(A, cb, loff, t, dil, nvalid, i0 + 2 * SAB);
        sa_compute(B, q, nvalid, i0 + SAB, m, l, o);
    }
    {
        f32x4 kk[4], vv[4]; float s[4]; float mb = m;
#pragma unroll
        for (int j = 0; j < 4; ++j) { const float* rp = nb + (size_t)j * 512; kk[j] = *(const f32x4*)rp; vv[j] = *(const f32x4*)(rp + 256); }
#pragma unroll
        for (int j = 0; j < 4; ++j) { float d = (q[0] * kk[j][0] + q[1] * kk[j][1]) + (q[2] * kk[j][2] + q[3] * kk[j][3]);
            d += __shfl_xor(d, 1); d += __shfl_xor(d, 2); d += __shfl_xor(d, 4); d += __shfl_xor(d, 8);
            const bool ok = g == 0 ? (j <= t) : (j == t); s[j] = ok ? d : -1e30f; mb = fmaxf(mb, s[j]); }
        const float sc = fexp2(m - mb); l *= sc; o = o * sc; m = mb;
#pragma unroll
        for (int j = 0; j < 4; ++j) { const float p = fexp2(s[j] - mb); l += p; o = o + vv[j] * p; }
    }
    const float il = frcp(l); o = o * il;
    u32x2 w; w.x = cvt_pk_bf16(o[0], o[1]); w.y = cvt_pk_bf16(o[2], o[3]); *(u32x2*)(AO + (size_t)R * AW + g * 256 + hh * 64 + dq) = w;
    if ((lane & 15) == 0) LSE[(size_t)R * 12 + g * 4 + hh] = (m + flog2(l)) * LN2;
}
__device__ __forceinline__ void pattn_item(const bf16* Q, const bf16* Kb, const bf16* VT, bf16* AO, float* LSE, int it, int lane) {
    const int g = it >> 11; int rem = it & 2047;
    const int sh = 2 * g, dil = 1 << sh, S = 2048 >> sh, nql = 6 - sh;
    const int qt = rem & ((1 << nql) - 1); rem >>= nql; const int res = rem & (dil - 1); rem >>= sh; const int hh = rem & 3, b = rem >> 2;
    const int n = lane & 31, hi = lane >> 5;
    const int s_q = 32 * qt + n, qrow = b * 2048 + s_q * dil + res;
    const int coff = g * 256 + hh * 64 + 32 * hi;
    bf16x8 qf[4];
    { const bf16* qp = Q + (size_t)qrow * AW + coff;
#pragma unroll
      for (int d0 = 0; d0 < 4; ++d0) qf[d0] = *(const bf16x8*)(qp + 8 * d0); }
    f32x16 sc[5];
    const int pm = pi23(n);
#pragma unroll
    for (int kt = 0; kt < 5; ++kt) {
        const int sb = 32 * qt - 128 + 32 * kt; int sk = sb + pm; sk = sk < 0 ? 0 : sk;
        const bf16* kp = Kb + (size_t)(b * 2048 + sk * dil + res) * AW + coff;
        bf16x8 kf[4];
#pragma unroll
        for (int d0 = 0; d0 < 4; ++d0) kf[d0] = *(const bf16x8*)(kp + 8 * d0);
        f32x16 acc = {0.f, 0.f, 0.f, 0.f, 0.f, 0.f, 0.f, 0.f, 0.f, 0.f, 0.f, 0.f, 0.f, 0.f, 0.f, 0.f};
#pragma unroll
        for (int d0 = 0; d0 < 4; ++d0) acc = __builtin_amdgcn_mfma_f32_32x32x16_bf16(kf[d0], qf[d0], acc, 0, 0, 0);
        sc[kt] = acc;
    }
    float mx = -1e30f;
#pragma unroll
    for (int kt = 0; kt < 5; ++kt) { const int sb = 32 * qt - 128 + 32 * kt;
#pragma unroll
        for (int r = 0; r < 16; ++r) { const int sk = sb + 16 * (r >> 3) + 8 * hi + (r & 7); const int dl = s_q - sk; const bool ok = (sk >= 0) && (dl >= 0) && (dl <= 128);
            const float v = ok ? sc[kt][r] : -1e30f; sc[kt][r] = v; mx = fmaxf(mx, v); } }
    mx = fmaxf(mx, __shfl_xor(mx, 32));
    float l = 0.f;
#pragma unroll
    for (int kt = 0; kt < 5; ++kt)
#pragma unroll
        for (int r = 0; r < 16; ++r) { const float p = fexp2(sc[kt][r] - mx); sc[kt][r] = p; l += p; }
    l += __shfl_xor(l, 32);
    f32x16 o[2];
#pragma unroll
    for (int dt = 0; dt < 2; ++dt) o[dt] = (f32x16){0.f, 0.f, 0.f, 0.f, 0.f, 0.f, 0.f, 0.f, 0.f, 0.f, 0.f, 0.f, 0.f, 0.f, 0.f, 0.f};
    const bf16* vbase = VT + (size_t)((g * 4 + hh) * 8 + b) * 64 * 2048;
#pragma unroll
    for (int kt = 0; kt < 5; ++kt) {
        int sb = 32 * qt - 128 + 32 * kt; sb = sb < 0 ? 0 : sb;
        const bf16* vp = vbase + (size_t)((res * S + sb) >> 5) * 2048 + n * 32 + 8 * hi;
#pragma unroll
        for (int jj = 0; jj < 2; ++jj) {
            const bf16x8 pb = pack8(sc[kt][8 * jj + 0], sc[kt][8 * jj + 1], sc[kt][8 * jj + 2], sc[kt][8 * jj + 3], sc[kt][8 * jj + 4], sc[kt][8 * jj + 5], sc[kt][8 * jj + 6], sc[kt][8 * jj + 7]);
#pragma unroll
            for (int dt = 0; dt < 2; ++dt) { const bf16x8 vf = *(const bf16x8*)(vp + dt * 1024 + 16 * jj); o[dt] = __builtin_amdgcn_mfma_f32_32x32x16_bf16(vf, pb, o[dt], 0, 0, 0); }
        }
    }
    const float il = frcp(l);
    bf16* op = AO + (size_t)qrow * AW + g * 256 + hh * 64 + 4 * hi;
#pragma unroll
    for (int dt = 0; dt < 2; ++dt)
#pragma unroll
        for (int r4 = 0; r4 < 4; ++r4) { u32x2 w; w.x = cvt_pk_bf16(o[dt][4 * r4] * il, o[dt][4 * r4 + 1] * il); w.y = cvt_pk_bf16(o[dt][4 * r4 + 2] * il, o[dt][4 * r4 + 3] * il);
            *(u32x2*)(op + 32 * dt + 8 * r4) = w; }
    if (hi == 0) LSE[(size_t)qrow * 12 + g * 4 + hh] = (mx + flog2(l)) * LN2;
}

constexpr int PK_ROW = 144, PK_SLOT = 32 * PK_ROW, PV_OFF = 12 * PK_SLOT;
__device__ __forceinline__ void pattn_wg_item(const bf16* Q, const bf16* Kb, const bf16* VT, bf16* AO, float* LSE, LAS unsigned char* lds, int item, int wave, int lane, int tid) {
    const int g = item >> 8, r = item & 255, hh = (r >> 3) & 3, b = r >> 5;
    const int sh = 2 * g, dil = 1 << sh, S = 2048 >> sh;
    const int qblk = g == 0 ? (r & 7) : (r & 1), resb = g == 0 ? 0 : (g == 1 ? ((r >> 1) & 3) : 2 * (r & 7));
    const int pc = tid & 255;
    u32x4 kreg[6], vreg[6];
#pragma unroll
    for (int i = 0; i < 6; ++i) { const int T = (tid >> 8) + 2 * i;
        int sb, rs; bool ok;
        if (g < 2) { sb = 256 * qblk - 128 + 32 * T; rs = resb; ok = sb >= 0; } else { sb = 32 * (T & 3); rs = resb + (T >> 2); ok = T < 8; }
        if (ok) { const int t = (sb + (pc >> 3)) * dil + rs;
            kreg[i] = *(const u32x4*)(Kb + (size_t)(b * 2048 + t) * AW + g * 256 + hh * 64 + 8 * (pc & 7));
            vreg[i] = *(const u32x4*)(VT + (size_t)(b * 2048 + t) * AW + g * 256 + hh * 64 + 8 * (pc & 7)); }
        else { kreg[i] = (u32x4){0u, 0u, 0u, 0u}; vreg[i] = kreg[i]; } }
    const int n = lane & 31, hi = lane >> 5;
    const int qt = g < 2 ? 8 * qblk + wave : (wave & 3), resw = g < 2 ? resb : resb + (wave >> 2);
    const int slot_base = g < 2 ? wave : 4 * (wave >> 2) + (wave & 3) - 4;
    const int s_q = 32 * qt + n, qrow = b * 2048 + s_q * dil + resw;
    bf16x8 qf[4];
    { const bf16* qp = Q + (size_t)qrow * AW + g * 256 + hh * 64 + 32 * hi;
#pragma unroll
      for (int d0 = 0; d0 < 4; ++d0) qf[d0] = *(const bf16x8*)(qp + 8 * d0); }
#pragma unroll
    for (int i = 0; i < 6; ++i) { const int T = (tid >> 8) + 2 * i;
        *(LAS u32x4*)(lds + T * PK_SLOT + (pc >> 3) * PK_ROW + (pc & 7) * 16) = kreg[i];
        *(LAS u32x4*)(lds + PV_OFF + T * PK_SLOT + (pc >> 3) * PK_ROW + (pc & 7) * 16) = vreg[i]; }
    __syncthreads();
    f32x16 sc[5];
    const int pm = pi23(n);
#pragma unroll
    for (int kt = 0; kt < 5; ++kt) {
        const int slot = slot_base + kt, sb = 32 * qt - 128 + 32 * kt;
        f32x16 acc = {0.f, 0.f, 0.f, 0.f, 0.f, 0.f, 0.f, 0.f, 0.f, 0.f, 0.f, 0.f, 0.f, 0.f, 0.f, 0.f};
        if (sb >= 0) {
            const LAS unsigned char* kp = lds + slot * PK_SLOT + pm * PK_ROW + 64 * hi;
            bf16x8 kf[4];
#pragma unroll
            for (int d0 = 0; d0 < 4; ++d0) kf[d0] = *(const LAS bf16x8*)(kp + 16 * d0);
#pragma unroll
            for (int d0 = 0; d0 < 4; ++d0) acc = __builtin_amdgcn_mfma_f32_32x32x16_bf16(kf[d0], qf[d0], acc, 0, 0, 0);
        }
        sc[kt] = acc;
    }
    float mx = -1e30f;
#pragma unroll
    for (int kt = 0; kt < 5; ++kt) { const int sb = 32 * qt - 128 + 32 * kt;
#pragma unroll
        for (int rr = 0; rr < 16; ++rr) { const int sk = sb + 16 * (rr >> 3) + 8 * hi + (rr & 7); const int dl = s_q - sk; const bool ok = (sk >= 0) && (dl >= 0) && (dl <= 128);
            const float v = ok ? sc[kt][rr] : -1e30f; sc[kt][rr] = v; mx = fmaxf(mx, v); } }
    mx = fmaxf(mx, __shfl_xor(mx, 32));
    float l = 0.f;
#pragma unroll
    for (int kt = 0; kt < 5; ++kt)
#pragma unroll
        for (int rr = 0; rr < 16; ++rr) { const float p = fexp2(sc[kt][rr] - mx); sc[kt][rr] = p; l += p; }
    l += __shfl_xor(l, 32);
    f32x16 o[2];
#pragma unroll
    for (int dt = 0; dt < 2; ++dt) o[dt] = (f32x16){0.f, 0.f, 0.f, 0.f, 0.f, 0.f, 0.f, 0.f, 0.f, 0.f, 0.f, 0.f, 0.f, 0.f, 0.f, 0.f};
#pragma unroll
    for (int kt = 0; kt < 5; ++kt) {
        const int slot = slot_base + kt, sb = 32 * qt - 128 + 32 * kt;
        if (sb >= 0) {
            LAS unsigned char* vp = lds + PV_OFF + slot * PK_SLOT + (8 * hi + ((lane >> 2) & 3)) * PK_ROW + (16 * ((lane >> 4) & 1) + 4 * (lane & 3)) * 2;
            bf16x8 vf[2][2];
#pragma unroll
            for (int jj = 0; jj < 2; ++jj)
#pragma unroll
                for (int dt = 0; dt < 2; ++dt) vf[jj][dt] = cat44(lds_tr4(vp + (16 * jj) * PK_ROW + 64 * dt), lds_tr4(vp + (16 * jj + 4) * PK_ROW + 64 * dt));
#pragma unroll
            for (int jj = 0; jj < 2; ++jj) {
                const bf16x8 pb = pack8(sc[kt][8 * jj + 0], sc[kt][8 * jj + 1], sc[kt][8 * jj + 2], sc[kt][8 * jj + 3], sc[kt][8 * jj + 4], sc[kt][8 * jj + 5], sc[kt][8 * jj + 6], sc[kt][8 * jj + 7]);
#pragma unroll
                for (int dt = 0; dt < 2; ++dt) o[dt] = __builtin_amdgcn_mfma_f32_32x32x16_bf16(vf[jj][dt], pb, o[dt], 0, 0, 0);
            }
        }
    }
    const float il = frcp(l);
    bf16* op = AO + (size_t)qrow * AW + g * 256 + hh * 64 + 4 * hi;
#pragma unroll
    for (int dt = 0; dt < 2; ++dt)
#pragma unroll
        for (int r4 = 0; r4 < 4; ++r4) { u32x2 w; w.x = cvt_pk_bf16(o[dt][4 * r4] * il, o[dt][4 * r4 + 1] * il); w.y = cvt_pk_bf16(o[dt][4 * r4 + 2] * il, o[dt][4 * r4 + 3] * il);
            *(u32x2*)(op + 32 * dt + 8 * r4) = w; }
    if (hi == 0) LSE[(size_t)qrow * 12 + g * 4 + hh] = (mx + flog2(l)) * LN2;
    __syncthreads();
}

template <int NB> __device__ __forceinline__ void combine_rows(const bf16* AO, const float* LSE, const float* aon, bf16* MIXED, int R0, int lane) {
    const int hh = lane >> 4; float ls[NB][3]; u32x2 ow[NB][3];
#pragma unroll
    for (int i = 0; i < NB; ++i)
#pragma unroll
        for (int g = 0; g < 3; ++g) { ow[i][g] = *(const u32x2*)(AO + (size_t)(R0 + i) * AW + g * 256 + 4 * lane); ls[i][g] = LSE[(size_t)(R0 + i) * 12 + g * 4 + hh]; }
    f32x4 gn[3];
#pragma unroll
    for (int g = 0; g < 3; ++g) gn[g] = *(const f32x4*)(aon + g * 256 + 4 * lane);
#pragma unroll
    for (int i = 0; i < NB; ++i) {
        const float mx = fmaxf(fmaxf(ls[i][0], ls[i][1]), ls[i][2]);
        float e[3]; e[0] = fexp2((ls[i][0] - mx) * LOG2E); e[1] = fexp2((ls[i][1] - mx) * LOG2E); e[2] = fexp2((ls[i][2] - mx) * LOG2E);
        const float inv = frcp(e[0] + e[1] + e[2]);
        f32x4 v[3]; float ss = 0.f;
#pragma unroll
        for (int g = 0; g < 3; ++g) { const float al = e[g] * inv; v[g] = (f32x4){bf2f(ow[i][g].x & 0xffffu), bf2f(ow[i][g].x >> 16), bf2f(ow[i][g].y & 0xffffu), bf2f(ow[i][g].y >> 16)} * al; ss += dot4(v[g]); }
        const float rs = frsq(wave_sum(ss) * (1.0f / 768.0f) + EPS);
#pragma unroll
        for (int g = 0; g < 3; ++g) { const f32x4 y = v[g] * rs * gn[g];
            u32x2 w; w.x = cvt_pk_bf16(y[0], y[1]); w.y = cvt_pk_bf16(y[2], y[3]); *(u32x2*)(MIXED + (size_t)(R0 + i) * D + g * 256 + 4 * lane) = w; }
    }
}
__device__ __forceinline__ float gelu_tanh(float x) { const float u2 = 1.5957691216057308f * (x + 0.044715f * x * x * x); return x * frcp(1.0f + fexp2(-u2 * LOG2E)); }
__device__ __forceinline__ float sigmoidf_(float z) { return frcp(1.0f + fexp2(-z * LOG2E)); }
__device__ __forceinline__ void ssm_c_item(const Args& a, const float* U, const float* ssmc, const float* SSMF, const bf16* WGLU, bf16* MIXED, LAS unsigned char* lds, int item, int wave, int lane) {
    const bool hs = item < 32;
    const int b = item >> 5, c = item & 31;
    const int R0 = item * 64, RS0 = MP + item * 16;
    LAS unsigned* HL = (LAS unsigned*)(lds + wave * 4352);
    LAS float* ZS = (LAS float*)(lds + 34816);
    const int t16 = lane & 15, q4 = lane >> 4;
    for (int gi = 0; gi < 2; ++gi) {
        const int g = 2 * wave + gi;
        const f32x4* cp = (const f32x4*)(ssmc + (size_t)(g * 64 + lane) * 8); const f32x4 c0 = cp[0], c1 = cp[1];
        const float ar = c0[0], ai = c0[1], a64r = c1[0], a64i = c1[1];
        bf16x8 bb[4]; ssm_bfrags(a, ssmc, g, lane, bb);
        bf16x8 cf[4];
#pragma unroll
        for (int s4 = 0; s4 < 4; ++s4) { const int p0 = 16 * s4 + 4 * q4; const f32x4 x = *(const f32x4*)(a.in[I_CRE] + (size_t)(g * 16 + t16) * 64 + p0), y = *(const f32x4*)(a.in[I_CIM] + (size_t)(g * 16 + t16) * 64 + p0);
            cf[s4] = pack8(x[0], -y[0], x[1], -y[1], x[2], -y[2], x[3], -y[3]); }
        const f32x4 dv = *(const f32x4*)(a.in[I_SD] + g * 16 + 4 * q4);
        float hr = 0.f, hi = 0.f;
        {
            const int nb16 = (c + 15) >> 4; int cc0 = c - 16 * nb16;
            for (int i16 = 0; i16 < nb16; ++i16, cc0 += 16) { f32x2 f[16];
#pragma unroll
                for (int j = 0; j < 16; ++j) { const int cc = cc0 + j; f[j] = cc >= 0 ? *(const f32x2*)(SSMF + ((size_t)((b * 32 + cc) * 16 + g) * 64 + lane) * 2) : (f32x2){0.f, 0.f}; }
#pragma unroll
                for (int j = 0; j < 16; ++j) { const float nr = fmaf(a64r, hr, fmaf(-a64i, hi, f[j][0])), ni = fmaf(a64r, hi, fmaf(a64i, hr, f[j][1])); hr = nr; hi = ni; } }
        }
#if defined(PROBE_DUMP)
        { float* dmp = (float*)((unsigned char*)MIXED - WS_MIXED + 741 * MiB) + ((size_t)(item * 16 + g) * 64 + lane) * 2; dmp[0] = hr; dmp[1] = hi; }
#endif
        bf16x8 ua2[2]; f32x4 uv4[4];
        ua2[0] = ssm_loadu(U, R0, 32, g, lane); ua2[1] = ssm_loadu(U, R0 + 32, 32, g, lane);
#pragma unroll
        for (int j = 0; j < 4; ++j) uv4[j] = *(const f32x4*)(U + (size_t)(R0 + 16 * j + t16) * 256 + g * 16 + 4 * q4);
#if defined(PROBE_DUMP)
        { u32x4* dmp = (u32x4*)((unsigned char*)MIXED - WS_MIXED + 724 * MiB) + ((size_t)(item * 16 + g) * 2) * 64 + lane; dmp[0] = __builtin_bit_cast(u32x4, ua2[0]); dmp[64] = __builtin_bit_cast(u32x4, ua2[1]); }
#endif
#pragma unroll
        for (int blk = 0; blk < 2; ++blk) {
            f32x16 xr[2], xi[2]; ssm_xcompute(ua2[blk], bb, xr, xi);
#pragma unroll
            for (int s2 = 0; s2 < 2; ++s2) {
                const int trow = 32 * blk + 16 * s2 + t16;
                const f32x4 uv = uv4[2 * blk + s2];
#pragma unroll
                for (int tt = 0; tt < 16; ++tt) { const int t = 16 * s2 + tt;
                    const float nr = fmaf(ar, hr, fmaf(-ai, hi, SSM_XR(t))), ni = fmaf(ar, hi, fmaf(ai, hr, SSM_XI(t))); hr = nr; hi = ni;
                    HL[tt * 68 + lane] = cvt_pk_bf16(hr, hi);
                }
                LDS_WAIT(); asm volatile("" ::: "memory");
                f32x4 y = {0.f, 0.f, 0.f, 0.f};
#pragma unroll
                for (int s4 = 0; s4 < 4; ++s4) { const bf16x8 hf = *(const LAS bf16x8*)((LAS unsigned short*)HL + t16 * 136 + 32 * s4 + 8 * q4); y = __builtin_amdgcn_mfma_f32_16x16x32_bf16(cf[s4], hf, y, 0, 0, 0); }
                f32x4 z;
#pragma unroll
                for (int e = 0; e < 4; ++e) z[e] = gelu_tanh(y[e] + dv[e] * uv[e]);
                *(LAS f32x4*)(ZS + trow * 260 + g * 16 + 4 * q4) = z;
                LDS_WAIT(); asm volatile("" ::: "memory");
            }
        }
        if (c == 31) { a.out[O_SREP + (size_t)(b * 16 + g) * 64 + lane] = hr; a.out[O_SIMP + (size_t)(b * 16 + g) * 64 + lane] = hi; }
        if (hs) {
            float sre[4], sim[4];
#pragma unroll
            for (int j = 0; j < 4; ++j) { const size_t o = (size_t)((4 * item + j) * 16 + g) * 64 + lane; sre[j] = a.in[I_SRE][o]; sim[j] = a.in[I_SIM][o]; }
            const bf16x8 ua = ssm_loadu(U, RS0, 16, g, lane);
            const f32x4 uv = *(const f32x4*)(U + (size_t)(RS0 + t16) * 256 + g * 16 + 4 * q4);
            f32x16 xr[2], xi[2]; ssm_xcompute(ua, bb, xr, xi);
#pragma unroll
            for (int tt = 0; tt < 16; ++tt) {
                if ((tt & 3) == 0) { hr = sre[tt >> 2]; hi = sim[tt >> 2]; }
                const float nr = fmaf(ar, hr, fmaf(-ai, hi, SSM_XR(tt))), ni = fmaf(ar, hi, fmaf(ai, hr, SSM_XI(tt))); hr = nr; hi = ni;
                HL[tt * 68 + lane] = cvt_pk_bf16(hr, hi);
                if ((tt & 3) == 3) { const size_t o = (size_t)((4 * item + (tt >> 2)) * 16 + g) * 64 + lane; a.out[O_SRES + o] = hr; a.out[O_SIMS + o] = hi; }
            }
            LDS_WAIT(); asm volatile("" ::: "memory");
            f32x4 y = {0.f, 0.f, 0.f, 0.f};
#pragma unroll
            for (int s4 = 0; s4 < 4; ++s4) { const bf16x8 hf = *(const LAS bf16x8*)((LAS unsigned short*)HL + t16 * 136 + 32 * s4 + 8 * q4); y = __builtin_amdgcn_mfma_f32_16x16x32_bf16(cf[s4], hf, y, 0, 0, 0); }
            f32x4 z;
#pragma unroll
            for (int e = 0; e < 4; ++e) z[e] = gelu_tanh(y[e] + dv[e] * uv[e]);
            *(LAS f32x4*)(ZS + (64 + t16) * 260 + g * 16 + 4 * q4) = z;
            LDS_WAIT(); asm volatile("" ::: "memory");
        }
    }
    const int n = lane & 31, hi5 = lane >> 5, n0 = 32 * wave, nmt = hs ? 3 : 2;
    bf16x8 bfr[16];
#pragma unroll
    for (int st = 0; st < 16; ++st) bfr[st] = *(const bf16x8*)(WGLU + (size_t)(n0 + n) * 256 + 16 * st + 8 * hi5);
    const float bias = a.in[I_BGLU][n0 + n];
    const f32x4 gn = *(const f32x4*)(a.in[I_SON] + 4 * lane);
    __syncthreads();
    f32x16 acc[3];
#pragma unroll
    for (int mt = 0; mt < 3; ++mt) acc[mt] = (f32x16){0.f, 0.f, 0.f, 0.f, 0.f, 0.f, 0.f, 0.f, 0.f, 0.f, 0.f, 0.f, 0.f, 0.f, 0.f, 0.f};
#pragma unroll
    for (int st = 0; st < 16; ++st) {
        const bf16x8 bf = bfr[st];
#pragma unroll
        for (int mt = 0; mt < 3; ++mt) { if (mt < nmt) { const LAS float* zp = ZS + (32 * mt + n) * 260 + 16 * st + 8 * hi5; const f32x4 x = *(const LAS f32x4*)zp, y = *(const LAS f32x4*)(zp + 4);
            acc[mt] = __builtin_amdgcn_mfma_f32_32x32x16_bf16(pack8(x[0], x[1], x[2], x[3], y[0], y[1], y[2], y[3]), bf, acc[mt], 0, 0, 0); } }
    }
    float so[3][16];
#pragma unroll
    for (int mt = 0; mt < 3; ++mt) { if (mt < nmt) {
#pragma unroll
        for (int r = 0; r < 16; ++r) { const int t = 32 * mt + (r & 3) + 8 * (r >> 2) + 4 * hi5; so[mt][r] = ZS[t * 260 + n0 + n] * sigmoidf_(acc[mt][r] + bias); } } }
    __syncthreads();
#pragma unroll
    for (int mt = 0; mt < 3; ++mt) { if (mt < nmt) {
#pragma unroll
        for (int r = 0; r < 16; ++r) { const int t = 32 * mt + (r & 3) + 8 * (r >> 2) + 4 * hi5; ZS[t * 260 + n0 + n] = so[mt][r]; } } }
    __syncthreads();
#pragma unroll
    for (int i = 0; i < 10; ++i) { if (i >= 8 && !hs) break;
        const int row = i < 8 ? 8 * wave + i : 64 + 2 * wave + (i - 8); const f32x4 v = *(const LAS f32x4*)(ZS + row * 260 + 4 * lane);
        const float rs = frsq(wave_sum(dot4(v)) * (1.0f / 256.0f) + EPS); const f32x4 y = v * rs * gn;
        const size_t orow = i < 8 ? (size_t)(R0 + row) : (size_t)(RS0 + row - 64);
        u32x2 w; w.x = cvt_pk_bf16(y[0], y[1]); w.y = cvt_pk_bf16(y[2], y[3]); *(u32x2*)(MIXED + orow * D + 768 + 4 * lane) = w; }
    __syncthreads();
}

__device__ __forceinline__ float xq_sigma(const float* RS1, const float* QS, int R, int h) {
    const float rstd = frsq(RS1[R] * (1.0f / 1024.0f) + EPS), msq = QS[(size_t)R * 4 + h] * (1.0f / 256.0f);
    return rstd / sqrtf(rstd * rstd * msq + EPS) * (0.0625f * LOG2E);
}
template <int MODE, bool BASE_BF16 = false> __device__ __forceinline__ void sample_gemm_tile(const bf16* A, const bf16* Bt, int K, const void* base, float* outp, bf16* hb, float* ssq, LAS unsigned char* lds, int tile, int wave, int lane, int tid) {
    const int tm = tile >> 5, tn = tile & 31, n = lane & 31, hi = lane >> 5, kw = K >> 3;
    const bf16* ap = A + (size_t)(64 * tm + n) * K + wave * kw + 8 * hi;
    const bf16* bp = Bt + (size_t)(32 * tn + n) * K + wave * kw + 8 * hi;
    f32x16 acc0 = {0.f, 0.f, 0.f, 0.f, 0.f, 0.f, 0.f, 0.f, 0.f, 0.f, 0.f, 0.f, 0.f, 0.f, 0.f, 0.f}, acc1 = acc0;
    const int row = tid >> 3, c4 = (tid & 7) * 4, rs = 64 * tm + row, col = 32 * tn + c4;
    f32x4 bs = {0.f, 0.f, 0.f, 0.f};
    if (MODE == 0) {
        if (BASE_BF16) { const u32x2 w = *(const u32x2*)((const bf16*)base + (size_t)rs * D + col); bs = (f32x4){bf2f(w.x & 0xffffu), bf2f(w.x >> 16), bf2f(w.y & 0xffffu), bf2f(w.y >> 16)}; }
        else bs = *(const f32x4*)((const float*)base + (size_t)rs * D + col); }
#pragma unroll 8
    for (int s = 0; s < kw; s += 16) { const bf16x8 a0 = *(const bf16x8*)(ap + s), a1 = *(const bf16x8*)(ap + (size_t)32 * K + s), bb = *(const bf16x8*)(bp + s);
        acc0 = __builtin_amdgcn_mfma_f32_32x32x16_bf16(a0, bb, acc0, 0, 0, 0); acc1 = __builtin_amdgcn_mfma_f32_32x32x16_bf16(a1, bb, acc1, 0, 0, 0); }
    LAS float* P = (LAS float*)lds;
#pragma unroll
    for (int r = 0; r < 16; ++r) { const int row = (r & 3) + 8 * (r >> 2) + 4 * hi; P[(wave * 64 + row) * 32 + n] = acc0[r]; P[(wave * 64 + 32 + row) * 32 + n] = acc1[r]; }
    __syncthreads();
    f32x4 v = {0.f, 0.f, 0.f, 0.f};
#pragma unroll
    for (int w = 0; w < 8; ++w) v = v + *(const LAS f32x4*)(P + (w * 64 + row) * 32 + c4);
    float s;
    if (MODE == 0) {
        const f32x4 o = bs + v; if (outp) *(f32x4*)(outp + (size_t)rs * D + col) = o;
        if (hb) { u32x2 w; w.x = cvt_pk_bf16(o[0], o[1]); w.y = cvt_pk_bf16(o[2], o[3]); *(u32x2*)(hb + (size_t)rs * D + col) = w; }
        s = dot4(o); }
    else { u32x2 w; w.x = cvt_pk_bf16(v[0], v[1]); w.y = cvt_pk_bf16(v[2], v[3]); *(u32x2*)(hb + (size_t)rs * D + col) = w; s = dot4(v); }
    if (ssq) { s += __shfl_xor(s, 1); s += __shfl_xor(s, 2); s += __shfl_xor(s, 4); if ((tid & 7) == 0) atomic_addf(MODE == 0 ? ssq + rs : ssq + (size_t)rs * 4 + (tn >> 3), s); }
    __syncthreads();
}
constexpr int XK_ROW = 272, XK_BUF = 32 * XK_ROW, XV_BUF = XK_BUF, XV_OFF = 2 * XK_BUF;
__device__ __forceinline__ void xattn_wg_item(const bf16* QX, const float* SS1, const float* QSS, const bf16* MEMK, const bf16* MVT, bf16* OX, LAS unsigned char* lds, int it, int wave, int lane, int tid) {
    const int qb = it & 7, h = (it >> 3) & 3, b = it >> 5;
    const int n = lane & 31, hi = lane >> 5, R = b * 2048 + 256 * qb + 32 * wave + n;
    const float sigma = xq_sigma(SS1, QSS, R, h);
    const bf16* kg = MEMK + (size_t)(b * 256 + (tid >> 4)) * 1024 + h * 256 + 128 * ((tid >> 3) & 1) + 8 * (tid & 7);
    const bf16* vg = MVT + (size_t)(b * 256 + (tid >> 4)) * 1024 + h * 256 + 8 * (tid & 15);
    LAS unsigned char* kl = lds + (tid >> 4) * XK_ROW + (tid & 15) * 16;
    LAS unsigned char* vl = lds + XV_OFF + (tid >> 4) * XK_ROW + (tid & 15) * 16;
#define XSRC(t) ((t) < 16 ? (const u32x4*)(kg + (size_t)((t) & 7) * 32 * 1024 + ((t) >> 3) * 64) : (const u32x4*)(vg + (size_t)(((t) - 16) & 7) * 32 * 1024 + (((t) - 16) >> 3) * 128))
#define XPUT(t, w_) do { if ((t) < 16) *(LAS u32x4*)(kl + ((t) & 1) * XK_BUF) = (w_); else *(LAS u32x4*)(vl + ((t) & 1) * XV_BUF) = (w_); } while (0)
    u32x4 ring[3]; ring[0] = *XSRC(0); ring[1] = *XSRC(1); ring[2] = *XSRC(2);
    f32x16 sc[8];
#pragma unroll
    for (int kt = 0; kt < 8; ++kt) sc[kt] = (f32x16){0.f, 0.f, 0.f, 0.f, 0.f, 0.f, 0.f, 0.f, 0.f, 0.f, 0.f, 0.f, 0.f, 0.f, 0.f, 0.f};
    XPUT(0, ring[0]);
    __syncthreads();
    const LAS unsigned char* kr = lds + pi23(n) * XK_ROW + 128 * hi;
#pragma unroll
    for (int dh = 0; dh < 2; ++dh) {
        bf16x8 qf[8];
        { const bf16* qp = QX + (size_t)R * D + h * 256 + 128 * hi + 64 * dh;
#pragma unroll
          for (int st = 0; st < 8; ++st) qf[st] = *(const bf16x8*)(qp + 8 * st); }
#pragma unroll
        for (int kt = 0; kt < 8; ++kt) {
            const int s = dh * 8 + kt;
            ring[s % 3] = *XSRC(s + 3);
            const LAS unsigned char* kp = kr + (s & 1) * XK_BUF;
            bf16x8 kf[8];
#pragma unroll
            for (int st = 0; st < 8; ++st) kf[st] = *(const LAS bf16x8*)(kp + 16 * st);
            __builtin_amdgcn_sched_barrier(0);
#pragma unroll
            for (int st = 0; st < 8; ++st) sc[kt] = __builtin_amdgcn_mfma_f32_32x32x16_bf16(kf[st], qf[st], sc[kt], 0, 0, 0);
            XPUT(s + 1, ring[(s + 1) % 3]);
            asm volatile("s_waitcnt lgkmcnt(0)\n\ts_barrier" ::: "memory");
        }
    }
    float mx = -1e30f;
#pragma unroll
    for (int kt = 0; kt < 8; ++kt)
#pragma unroll
        for (int r = 0; r < 16; ++r) { sc[kt][r] *= sigma; mx = fmaxf(mx, sc[kt][r]); }
    mx = fmaxf(mx, __shfl_xor(mx, 32));
    float l = 0.f;
#pragma unroll
    for (int kt = 0; kt < 8; ++kt)
#pragma unroll
        for (int r = 0; r < 16; ++r) { const float p = fexp2(sc[kt][r] - mx); sc[kt][r] = p; l += p; }
    l += __shfl_xor(l, 32);
    const float il = frcp(l);
    bf16x8 pb[8][2];
#pragma unroll
    for (int kt = 0; kt < 8; ++kt)
#pragma unroll
        for (int jj = 0; jj < 2; ++jj) pb[kt][jj] = pack8(sc[kt][8 * jj + 0], sc[kt][8 * jj + 1], sc[kt][8 * jj + 2], sc[kt][8 * jj + 3], sc[kt][8 * jj + 4], sc[kt][8 * jj + 5], sc[kt][8 * jj + 6], sc[kt][8 * jj + 7]);
    LAS unsigned char* vr = lds + XV_OFF + (8 * hi + ((lane >> 2) & 3)) * XK_ROW + (16 * ((lane >> 4) & 1) + 4 * (lane & 3)) * 2;
    bf16* op = OX + (size_t)R * D + h * 256 + 4 * hi;
#pragma unroll
    for (int dh = 0; dh < 2; ++dh) {
        f32x16 o[4];
#pragma unroll
        for (int dt = 0; dt < 4; ++dt) o[dt] = (f32x16){0.f, 0.f, 0.f, 0.f, 0.f, 0.f, 0.f, 0.f, 0.f, 0.f, 0.f, 0.f, 0.f, 0.f, 0.f, 0.f};
#pragma unroll
        for (int kt = 0; kt < 8; ++kt) {
            const int s = 16 + dh * 8 + kt;
            if (s + 3 < 32) ring[s % 3] = *XSRC(s + 3);
            LAS unsigned char* vp = vr + (s & 1) * XV_BUF;
            bf16x8 vf[4][2];
#pragma unroll
            for (int dt = 0; dt < 4; ++dt)
#pragma unroll
                for (int jj = 0; jj < 2; ++jj) vf[dt][jj] = cat44(lds_tr4(vp + (16 * jj) * XK_ROW + 64 * dt), lds_tr4(vp + (16 * jj + 4) * XK_ROW + 64 * dt));
            __builtin_amdgcn_sched_barrier(0);
#pragma unroll
            for (int jj = 0; jj < 2; ++jj)
#pragma unroll
                for (int dt = 0; dt < 4; ++dt) o[dt] = __builtin_amdgcn_mfma_f32_32x32x16_bf16(vf[dt][jj], pb[kt][jj], o[dt], 0, 0, 0);
            if (s + 1 < 32) XPUT(s + 1, ring[(s + 1) % 3]);
            asm volatile("s_waitcnt lgkmcnt(0)\n\ts_barrier" ::: "memory");
        }
#pragma unroll
        for (int dt = 0; dt < 4; ++dt)
#pragma unroll
            for (int r4 = 0; r4 < 4; ++r4) { u32x2 w; w.x = cvt_pk_bf16(o[dt][4 * r4] * il, o[dt][4 * r4 + 1] * il); w.y = cvt_pk_bf16(o[dt][4 * r4 + 2] * il, o[dt][4 * r4 + 3] * il);
                *(u32x2*)(op + 128 * dh + 32 * dt + 8 * r4) = w; }
    }
}
#undef XSRC
#undef XPUT
constexpr int SXB = 4;
struct SxBatch { f32x4 k[SXB], v[SXB]; };
__device__ __forceinline__ void sx_load(SxBatch& B, const float* kb, unsigned loff, int j0) {
#pragma unroll
    for (int j = 0; j < SXB; ++j) { const char* p = (const char*)(kb + (size_t)(j0 + j) * 2048); B.k[j] = __builtin_nontemporal_load((const f32x4*)(p + loff)); B.v[j] = __builtin_nontemporal_load((const f32x4*)(p + 4096 + loff)); }
}
__device__ __forceinline__ float rdl(float v, int l) { return __builtin_bit_cast(float, __builtin_amdgcn_readlane(__builtin_bit_cast(int, v), l)); }
__device__ __forceinline__ void sx_compute(const SxBatch& B, const f32x4 (&q)[4], bool b5, bool b4, float& m, float& l, f32x4 (&o)[4]) {
    float s[SXB]; float mb = m;
#pragma unroll
    for (int j = 0; j < SXB; ++j) {
        float d[4];
#pragma unroll
        for (int t = 0; t < 4; ++t) d[t] = (q[t][0] * B.k[j][0] + q[t][1] * B.k[j][1]) + (q[t][2] * B.k[j][2] + q[t][3] * B.k[j][3]);
        const float x0 = b5 ? d[0] : d[2], x1 = b5 ? d[1] : d[3], k0 = b5 ? d[2] : d[0], k1 = b5 ? d[3] : d[1];
        const float r0 = k0 + __shfl_xor(x0, 32), r1 = k1 + __shfl_xor(x1, 32);
        const float xs = b4 ? r0 : r1, ks = b4 ? r1 : r0;
        float r = ks + __shfl_xor(xs, 16);
        r += __shfl_xor(r, 8); r += __shfl_xor(r, 4); r += __shfl_xor(r, 2); r += __shfl_xor(r, 1);
        s[j] = r; mb = fmaxf(mb, r);
    }
    const float sc = fexp2(m - mb); m = mb; l *= sc;
#pragma unroll
    for (int t = 0; t < 4; ++t) o[t] = o[t] * rdl(sc, 16 * t);
#pragma unroll
    for (int j = 0; j < SXB; ++j) { const float p = fexp2(s[j] - mb); l += p;
#pragma unroll
        for (int t = 0; t < 4; ++t) o[t] = o[t] + B.v[j] * rdl(p, 16 * t); }
}
template <int NSW> __device__ __forceinline__ void sxattn_stream(const Args& a, const bf16* QX, const float* SS1S, const float* QSSS, bf16* OX, LAS unsigned char* lds, LAS unsigned* cnt, int pair, int slot, int sw, int lane) {
    const int b = pair >> 2, h = pair & 3;
    LAS float* OL = (LAS float*)lds + (size_t)slot * (NSW * 1024); LAS float* ML = (LAS float*)(lds + 65536) + slot * 32; LAS float* LL = (LAS float*)(lds + 65536 + 256) + slot * 32;
    const f32x4 gq = *(const f32x4*)(a.in[I_XQN] + 4 * lane);
    f32x4 q[4];
    const float sgc = xq_sigma(SS1S, QSSS, MP + 4 * b + (lane >> 4), h);
#pragma unroll
    for (int t = 0; t < 4; ++t) { const int R = MP + 4 * b + t; const float sg = rdl(sgc, 16 * t); const u32x2 w = *(const u32x2*)(QX + (size_t)R * D + h * 256 + 4 * lane);
        q[t] = (f32x4){bf2f(w.x & 0xffffu), bf2f(w.x >> 16), bf2f(w.y & 0xffffu), bf2f(w.y >> 16)} * gq * sg; }
    constexpr int NK = 256 / NSW;
    const float* kb = a.in[I_CMEM] + ((size_t)(b * 256 + NK * sw) * 2) * 1024 + h * 256; const unsigned loff = 16u * (unsigned)lane;
    const bool b5 = (lane & 32) != 0, b4 = (lane & 16) != 0;
    float m = -1e30f, l = 0.f;
    f32x4 o[4];
#pragma unroll
    for (int t = 0; t < 4; ++t) o[t] = (f32x4){0.f, 0.f, 0.f, 0.f};
    SxBatch A, B; sx_load(A, kb, loff, 0);
#pragma unroll 1
    for (int j0 = 0; j0 < NK; j0 += 2 * SXB) {
        sx_load(B, kb, loff, j0 + SXB);
        sx_compute(A, q, b5, b4, m, l, o);
        if (j0 + 2 * SXB < NK) sx_load(A, kb, loff, j0 + 2 * SXB);
        sx_compute(B, q, b5, b4, m, l, o);
    }
#pragma unroll
    for (int t = 0; t < 4; ++t) *(LAS f32x4*)(OL + (sw * 4 + t) * 256 + 4 * lane) = o[t];
    if ((lane & 15) == 0) { ML[sw * 4 + (lane >> 4)] = m; LL[sw * 4 + (lane >> 4)] = l; }
    asm volatile("s_waitcnt lgkmcnt(0)" ::: "memory");
    unsigned old = 0u; if (lane == 0) old = __hip_atomic_fetch_add(cnt, 1u, __ATOMIC_ACQ_REL, __HIP_MEMORY_SCOPE_WORKGROUP);
    old = __builtin_amdgcn_readfirstlane(old);
    if (old == (unsigned)(NSW - 1)) {
        asm volatile("s_waitcnt lgkmcnt(0)" ::: "memory");
#pragma unroll
        for (int t = 0; t < 4; ++t) {
            float M = -1e30f;
#pragma unroll
            for (int w = 0; w < NSW; ++w) M = fmaxf(M, ML[w * 4 + t]);
            float L = 0.f; f32x4 acc = {0.f, 0.f, 0.f, 0.f};
#pragma unroll
            for (int w = 0; w < NSW; ++w) { const float f = fexp2(ML[w * 4 + t] - M); L += LL[w * 4 + t] * f; acc = acc + *(const LAS f32x4*)(OL + (w * 4 + t) * 256 + 4 * lane) * f; }
            const float il = frcp(L); u32x2 wv; wv.x = cvt_pk_bf16(acc[0] * il, acc[1] * il); wv.y = cvt_pk_bf16(acc[2] * il, acc[3] * il);
            *(u32x2*)(OX + (size_t)(MP + 4 * b + t) * D + h * 256 + 4 * lane) = wv;
        }
    }
}

__device__ __forceinline__ void up8(const bf16* p, float (&v)[8]) { const u32x4 w = *(const u32x4*)p;
    v[0] = bf2f(w.x & 0xffffu); v[1] = bf2f(w.x >> 16); v[2] = bf2f(w.y & 0xffffu); v[3] = bf2f(w.y >> 16); v[4] = bf2f(w.z & 0xffffu); v[5] = bf2f(w.z >> 16); v[6] = bf2f(w.w & 0xffffu); v[7] = bf2f(w.w >> 16); }
__device__ __forceinline__ void ld8(const float* p, float (&v)[8]) { const f32x4 a = *(const f32x4*)p, b = *(const f32x4*)(p + 4); v[0] = a[0]; v[1] = a[1]; v[2] = a[2]; v[3] = a[3]; v[4] = b[0]; v[5] = b[1]; v[6] = b[2]; v[7] = b[3]; }
__device__ __forceinline__ void conv_item(const Args& a, const bf16* UP, bf16* ACT, int it) {
    const int cgp = it % 352, rc = it / 352, j0 = cgp * 8, R0 = rc * 32;
    const float* cw = a.in[I_CONVW]; const float* cbp = a.in[I_CONVB];
    float wg[3][8], wv[3][8], bg[8], bv[8];
#pragma unroll
    for (int i = 0; i < 3; ++i) { ld8(cw + (size_t)i * FF2 + j0, wg[i]); ld8(cw + (size_t)i * FF2 + FF + j0, wv[i]); }
    ld8(cbp + j0, bg); ld8(cbp + FF + j0, bv);
    float g2[8], g1[8], v2[8], v1[8];
    const bool sample = R0 >= MP;
    if (!sample && (R0 & 2047) != 0) { up8(UP + (size_t)(R0 - 2) * FF2 + j0, g2); up8(UP + (size_t)(R0 - 1) * FF2 + j0, g1); up8(UP + (size_t)(R0 - 2) * FF2 + FF + j0, v2); up8(UP + (size_t)(R0 - 1) * FF2 + FF + j0, v1); }
    else {
#pragma unroll
        for (int e = 0; e < 8; ++e) { g2[e] = 0.f; g1[e] = 0.f; v2[e] = 0.f; v1[e] = 0.f; } }
    for (int r = 0; r < 32; ++r) { const int R = R0 + r;
        if (sample && (r & 3) == 0) { const float* sb = a.in[I_SCONV] + (size_t)((R - MP) >> 2) * 2 * FF2; ld8(sb + j0, g2); ld8(sb + FF2 + j0, g1); ld8(sb + FF + j0, v2); ld8(sb + FF2 + FF + j0, v1); }
        float gc[8], vc[8]; up8(UP + (size_t)R * FF2 + j0, gc); up8(UP + (size_t)R * FF2 + FF + j0, vc);
        float o[8];
#pragma unroll
        for (int e = 0; e < 8; ++e) { const float cgv = bg[e] + wg[0][e] * g2[e] + wg[1][e] * g1[e] + wg[2][e] * gc[e]; const float cvv = bv[e] + wv[0][e] * v2[e] + wv[1][e] * v1[e] + wv[2][e] * vc[e];
            o[e] = cgv * sigmoidf_(cgv) * cvv; g2[e] = g1[e]; g1[e] = gc[e]; v2[e] = v1[e]; v1[e] = vc[e]; }
        u32x4 w; w.x = cvt_pk_bf16(o[0], o[1]); w.y = cvt_pk_bf16(o[2], o[3]); w.z = cvt_pk_bf16(o[4], o[5]); w.w = cvt_pk_bf16(o[6], o[7]);
        *(u32x4*)(ACT + (size_t)R * FF + j0) = w;
    }
}

__device__ __forceinline__ void conv_fix_item(const Args& a, const float* EDGE, bf16* ACT, int it) {
    const int cgp = it % 352, rr = it / 352, r = rr & 1, ti = rr >> 1;
    const int pm = 8 * (ti / 7) + 1 + ti % 7, j0 = cgp * 8;
    const float* cw = a.in[I_CONVW]; const float* cbp = a.in[I_CONVB];
    const float* e_prev = EDGE + (size_t)(pm - 1) * 4 * FF2; const float* e_cur = EDGE + (size_t)pm * 4 * FF2;
    const float* r2 = r == 0 ? e_prev + 2 * FF2 : e_prev + 3 * FF2; const float* r1 = r == 0 ? e_prev + 3 * FF2 : e_cur; const float* r0 = r == 0 ? e_cur : e_cur + FF2;
    float o[8];
#pragma unroll
    for (int hf = 0; hf < 2; ++hf) { const int j4 = j0 + 4 * hf;
        const f32x4 cg = *(const f32x4*)(cbp + j4) + *(const f32x4*)(cw + j4) * *(const f32x4*)(r2 + j4) + *(const f32x4*)(cw + FF2 + j4) * *(const f32x4*)(r1 + j4) + *(const f32x4*)(cw + 2 * FF2 + j4) * *(const f32x4*)(r0 + j4);
        const f32x4 cv = *(const f32x4*)(cbp + FF + j4) + *(const f32x4*)(cw + FF + j4) * *(const f32x4*)(r2 + FF + j4) + *(const f32x4*)(cw + FF2 + FF + j4) * *(const f32x4*)(r1 + FF + j4) + *(const f32x4*)(cw + 2 * FF2 + FF + j4) * *(const f32x4*)(r0 + FF + j4);
#pragma unroll
        for (int e = 0; e < 4; ++e) o[4 * hf + e] = cg[e] * sigmoidf_(cg[e]) * cv[e]; }
    u32x4 w; w.x = cvt_pk_bf16(o[0], o[1]); w.y = cvt_pk_bf16(o[2], o[3]); w.z = cvt_pk_bf16(o[4], o[5]); w.w = cvt_pk_bf16(o[6], o[7]);
    *(u32x4*)(ACT + (size_t)(pm * 256 + r) * FF + j0) = w;
}

__device__ __forceinline__ void conv_fix_tile(const Args& a, const float* EDGE, bf16* ACT, int pm, int tid) {
    const float* cw = a.in[I_CONVW]; const float* cbp = a.in[I_CONVB];
    const float* e_prev = EDGE + (size_t)(pm - 1) * 4 * FF2; const float* e_cur = EDGE + (size_t)pm * 4 * FF2;
    for (int it = tid; it < 2 * 352; it += NWAVES * 64) { const int r = it / 352, j0 = (it - r * 352) * 8;
        const float* r2 = r == 0 ? e_prev + 2 * FF2 : e_prev + 3 * FF2; const float* r1 = r == 0 ? e_prev + 3 * FF2 : e_cur; const float* r0 = r == 0 ? e_cur : e_cur + FF2;
        float o[8];
#pragma unroll
        for (int hf = 0; hf < 2; ++hf) { const int j4 = j0 + 4 * hf;
            const f32x4 cg = *(const f32x4*)(cbp + j4) + *(const f32x4*)(cw + j4) * *(const f32x4*)(r2 + j4) + *(const f32x4*)(cw + FF2 + j4) * *(const f32x4*)(r1 + j4) + *(const f32x4*)(cw + 2 * FF2 + j4) * *(const f32x4*)(r0 + j4);
            const f32x4 cv = *(const f32x4*)(cbp + FF + j4) + *(const f32x4*)(cw + FF + j4) * *(const f32x4*)(r2 + FF + j4) + *(const f32x4*)(cw + FF2 + FF + j4) * *(const f32x4*)(r1 + FF + j4) + *(const f32x4*)(cw + 2 * FF2 + FF + j4) * *(const f32x4*)(r0 + FF + j4);
#pragma unroll
            for (int e = 0; e < 4; ++e) o[4 * hf + e] = cg[e] * sigmoidf_(cg[e]) * cv[e]; }
        u32x4 w; w.x = cvt_pk_bf16(o[0], o[1]); w.y = cvt_pk_bf16(o[2], o[3]); w.z = cvt_pk_bf16(o[4], o[5]); w.w = cvt_pk_bf16(o[6], o[7]);
        *(u32x4*)(ACT + (size_t)(pm * 256 + r) * FF + j0) = w; }
}

#ifndef MK_N_LAUNCHES
#define MK_N_LAUNCHES 1
#endif
constexpr int N_PHASES = 11;
#ifndef DUP_PHASE
#define DUP_PHASE -1
#endif
#define NREP(k) ((DUP_PHASE) == (k) ? 2 : 1)
constexpr int N_LAUNCHES = MK_N_LAUNCHES;
static_assert(N_LAUNCHES == 1 || N_LAUNCHES == N_PHASES, "MK_N_LAUNCHES is 1 or 11");

__global__ void __launch_bounds__(NWAVES * 64, 2) fwd_kernel(Args args) {
    extern __shared__ __attribute__((aligned(16))) unsigned char lds_raw[];
    LAS unsigned char* lds = (LAS unsigned char*)lds_raw;
    volatile LAS unsigned* MISC = (volatile LAS unsigned*)(lds + MISC_OFF);
    const int tid0 = threadIdx.x, wave0 = __builtin_amdgcn_readfirstlane(tid0 >> 6);
    const int G = gridDim.x; const int bx = blockIdx.x; const int vcu = (G % 8 == 0) ? (bx % 8) * (G / 8) + bx / 8 : bx;
    const int NGW = G * NWAVES;
    unsigned char* ws = args.ws;
    gu32* ctl = (gu32*)(ws + WS_CTL);
    for (int u = tid0; u < 128; u += NWAVES * 64) ((LAS unsigned*)(lds + MISC_OFF))[u] = 0u;
    __syncthreads();
    XcdBarrier bar; bar.bar = (unsigned*)(ctl + CW_BAR); bar.x = 0; bar.st = nullptr;
    if (N_LAUNCHES == 1) bar = xcd_barrier_post((unsigned*)(ctl + CW_BAR) + args.li * XCD_BAR_WORDS, MISC + 8);
#ifdef DOUBLE_BAR
#define GRID_BAR() do { if (N_LAUNCHES == 1) { xcd_barrier(bar); xcd_barrier(bar); } } while (0)
#else
#define GRID_BAR() do { if (N_LAUNCHES == 1) xcd_barrier(bar); } while (0)
#endif
    const int lo = args.ph_lo, hi = args.ph_hi;
#define IN(k) (lo <= (k) && (k) < hi)
#define WSBASE() GAS unsigned char* wsl = (GAS unsigned char*)ws; asm volatile("" : "+s"(wsl));     int tid = threadIdx.x; asm volatile("" : "+v"(tid)); const int lane = tid & 63, wave = __builtin_amdgcn_readfirstlane(tid >> 6), gw = vcu * NWAVES + wave; (void)lane; (void)gw
#define ROPE_ ((float*)(wsl + WS_ROPE))
#define SSMC_ ((float*)(wsl + WS_SSMC))
#define WIN ((bf16*)(wsl + WS_WIN))
#define WOUT ((bf16*)(wsl + WS_WOUT))
#define WXQ ((bf16*)(wsl + WS_WXQ))
#define WXKV ((bf16*)(wsl + WS_WXKV))
#define WXO ((bf16*)(wsl + WS_WXO))
#define WUP ((bf16*)(wsl + WS_WUP))
#define WDOWN ((bf16*)(wsl + WS_WDOWN))
#define WGLU ((bf16*)(wsl + WS_WGLU))
#define XN ((bf16*)(wsl + WS_XN))
#define MEMN ((bf16*)(wsl + WS_MEMN))
#define Qb ((bf16*)(wsl + WS_Q))
#define Kb ((bf16*)(wsl + WS_K))
#define VT ((bf16*)(wsl + WS_VT))
#define U_ ((float*)(wsl + WS_U))
#define AO ((bf16*)(wsl + WS_AO))
#define LSE ((float*)(wsl + WS_LSE))
#define SSMF ((float*)(wsl + WS_SSMF))
#define MIXED ((bf16*)(wsl + WS_MIXED))
#define H1B ((bf16*)(wsl + WS_H1B))
#define SS1 ((float*)(wsl + WS_CTL + CTL_RS1))
#define QX ((bf16*)(wsl + WS_QX))
#define QSS ((float*)(wsl + WS_CTL + CTL_QS))
#define MSS ((float*)(wsl + WS_MSS))
#define MEMK ((bf16*)(wsl + WS_MEMK))
#define MVT ((bf16*)(wsl + WS_MVT))
#define OX ((bf16*)(wsl + WS_OX))
#define H2B ((bf16*)(wsl + WS_H2B))
#define SS2 ((float*)(wsl + WS_CTL + CTL_RS2))
#define UP ((bf16*)(wsl + WS_UP))
#define ACT ((bf16*)(wsl + WS_ACT))
#define SS1S (SS1 + MP)
#define QSSS (QSS + (size_t)MP * 4)
#define SS2S (SS2 + MP)
    float* out = args.out;

    if (IN(0)) for (int rep_ = 0; rep_ < NREP(0); ++rep_) { WSBASE();
        LAS float* scr = (LAS float*)(lds + wave * 16384);
        constexpr int I_IN = 16 * (INW / 32), I_SQ = 16 * (D / 32), I_KV = 16 * (2048 / 32), I_UP = 16 * (FF2 / 32), I_DN = (FF / 64) * (D / 32), I_GL = 4 * 8;
        constexpr int NIT = I_IN + 3 * I_SQ + I_KV + I_GL; (void)I_UP; (void)I_DN;
        for (int it = gw; it < NIT; it += NGW) {
            int r = it;
            if (r < I_IN) { p0_transpose_item<1>(args.in[I_WIN], D, INW, WIN, nullptr, scr, r, lane); continue; } r -= I_IN;
            if (r < I_SQ) { p0_transpose_item<0>(args.in[I_WOUT], D, D, WOUT, nullptr, scr, r, lane); continue; } r -= I_SQ;
            if (r < I_SQ) { p0_transpose_item<0>(args.in[I_WXQ], D, D, WXQ, args.in[I_NX], scr, r, lane); continue; } r -= I_SQ;
            if (r < I_SQ) { p0_transpose_item<0>(args.in[I_WXO], D, D, WXO, nullptr, scr, r, lane); continue; } r -= I_SQ;
            if (r < I_KV) { p0_transpose_item<0>(args.in[I_WXKV], D, 2048, WXKV, nullptr, scr, r, lane); continue; } r -= I_KV;
            p0_transpose_item<0>(args.in[I_WGLU], 256, 256, WGLU, nullptr, scr, r, lane);
        }
        { f32x4 gg[4];
#pragma unroll
          for (int j = 0; j < 4; ++j) gg[j] = ((const f32x4*)args.in[I_NMIX])[lane + 64 * j];
          for (int m = 2 * gw; m < MT; m += 2 * NGW) { const float* x0 = m < MP ? args.in[I_XP] + (size_t)m * D : args.in[I_XS] + (size_t)(m - MP) * D;
              rms_rows2_to_bf16(x0, x0 + D, gg, XN + (size_t)m * D, XN + (size_t)(m + 1) * D, lane); }
#pragma unroll
          for (int j = 0; j < 4; ++j) gg[j] = ((const f32x4*)args.in[I_NMEM])[lane + 64 * j];
          for (int m = 2 * gw; m < MM; m += 2 * NGW) rms_rows2_to_bf16(args.in[I_MEM] + (size_t)m * D, args.in[I_MEM] + (size_t)(m + 1) * D, gg, MEMN + (size_t)m * D, MEMN + (size_t)(m + 1) * D, lane); }
        {
            const int gt = vcu * (NWAVES * 64) + tid;
            if (gt < 2052 * 8) { const int pos = gt >> 3, i = gt & 7; const float iv = i == 0 ? 1.0f : i == 1 ? 0.1939227432012558f : i == 2 ? 0.03760603070259094f : i == 3 ? 0.007292664609849453f : i == 4 ? 0.0014142135623842478f : i == 5 ? 0.00027424818836152554f : i == 6 ? 5.3182957344688475e-05f : 1.0313385246263351e-05f;
                const float ang = (float)pos * iv; double s, c; sincos_d((double)ang, s, c); ROPE_[pos * 16 + i] = (float)c; ROPE_[pos * 16 + 8 + i] = (float)s; }
            {
                constexpr int NZ = (int)((CTL_QS + (size_t)MT * 16 - CTL_RS1) / 16);
                u32x4* z = (u32x4*)(wsl + WS_CTL + CTL_RS1);
                for (int i = gt; i < NZ; i += G * NWAVES * 64) z[i] = (u32x4){0u, 0u, 0u, 0u}; }
            const int st = gt - 2052 * 8;
            if (st >= 0 && st < 1024) {
                const int g = st >> 6; const double dt = exp_d((double)args.in[I_LDT][g]); const double lr = (double)args.in[I_LRE][st], li = (double)args.in[I_LIM][st];
                const double mag = exp_d(lr * dt); double s, c; sincos_d(li * dt, s, c); const double are = mag * c, aim = mag * s;
                const double den = lr * lr + li * li, nr = are - 1.0, ni = aim; const double cre = (nr * lr + ni * li) / den, cim = (ni * lr - nr * li) / den;
                const double mag64 = exp_d(64.0 * lr * dt); double s64, c64; sincos_d(64.0 * li * dt, s64, c64);
                float* o = SSMC_ + (size_t)st * 8; o[0] = (float)are; o[1] = (float)aim; o[2] = (float)cre; o[3] = (float)cim; o[4] = (float)(mag64 * c64); o[5] = (float)(mag64 * s64); o[6] = 0.f; o[7] = 0.f; }
        }
        GRID_BAR();
    }

    if (IN(1)) for (int rep_ = 0; rep_ < NREP(1); ++rep_) { WSBASE();
        int base = 0;
        { pg8::Gemm g{XN, WIN, MT, INW, D}; pg8::RotOrder S; S.init(MT, INW, G, bx, base); base += S.nwg;
          pg8::EpiZ E{Qb, Kb, VT, U_, ROPE_, args.in[I_QN], args.in[I_KN], out};
          pg8::gemm_phase<pg8::EpiZ, pg8::RotOrder, true, true>(lds, g, S, E); }
        { pg8::Gemm g{MEMN, WXKV, MM, 2048, D}; pg8::RotOrder S; S.init(MM, 2048, G, bx, base); base += S.nwg;
          pg8::EpiMem E{out + O_MEMKV, MSS, MVT}; pg8::gemm_phase<pg8::EpiMem, pg8::RotOrder, true, true>(lds, g, S, E); }
        {
            constexpr int I_UP = 16 * (FF2 / 32);
            const int first = base % G, nidle = G - first;
            if (bx >= first) {
                __syncthreads();
                LAS float* scr = (LAS float*)(lds + wave * 16384);
                p0_transpose_stream<2>(args.in[I_WUP], D, FF2, WUP, args.in[I_NFFN], scr, (bx - first) * NWAVES + wave, I_UP, nidle * NWAVES, lane);
            }
        }
        GRID_BAR();
    }

    if (IN(2)) for (int rep_ = 0; rep_ < NREP(2); ++rep_) { WSBASE();
        LAS float* uL = (LAS float*)(lds + wave * 4096);
        const int swapo = (bx >> 3) & 1;
#pragma unroll 1
        for (int pass = 0; pass < 2; ++pass) {
            if (pass == swapo) {
                for (int it = vcu; it < 3 * 256; it += G) pattn_wg_item(Qb, Kb, VT, AO, LSE, lds, it, wave, lane, tid);
            } else {
                if (wave < 6) { for (int it = vcu * 6 + wave; it < 3 * 512; it += G * 6) sattn_item(args, Qb, AO, LSE, it, lane); }
                else { if (rep_ == 0) for (int it = vcu * 2 + (wave - 6); it < MM; it += G * 2) memk_fix_item(out + O_MEMKV, MSS, args.in[I_XKN], args.in[I_XQN], MEMK, it, lane);
                       for (int it = vcu * 2 + (wave - 6); it < 8 * 31 * 16; it += G * 2) ssm_a_item(args, U_, SSMC_, SSMF, uL, it, lane); }
            }
            __syncthreads();
        }
        GRID_BAR();
    }

    if (IN(3)) for (int rep_ = 0; rep_ < NREP(3); ++rep_) { WSBASE();
#if defined(PROBE_LDS_FILL)
        for (int u_ = tid; u_ < 134656 / 4; u_ += NWAVES * 64) ((LAS unsigned*)lds)[u_] = PROBE_LDS_FILL;
        __syncthreads();
#endif
#if defined(PROBE_DELAY_P3)
        for (int i_ = 0; i_ < 10; ++i_) __builtin_amdgcn_s_sleep(127);
        __builtin_amdgcn_fence(__ATOMIC_ACQUIRE, "agent"); asm volatile("s_waitcnt vmcnt(0)" ::: "memory"); __syncthreads();
#endif
        const int swapo = (bx >> 3) & 1;
#pragma unroll 1
        for (int pass = 0; pass < 2; ++pass) {
            int tid3 = threadIdx.x; asm volatile("" : "+v"(tid3)); const int lane3 = tid3 & 63, wave3 = __builtin_amdgcn_readfirstlane(tid3 >> 6);
            if (pass == swapo) {
                if (G > 64) {
                    if (vcu >= 32) { const int ncw = (G - 32) * NWAVES; for (int R = ((vcu - 32) * NWAVES + wave3) * 8; R < MT; R += ncw * 8) combine_rows<8>(AO, LSE, args.in[I_AON], MIXED, R, lane3); }
                } else { for (int R = (vcu * NWAVES + wave3) * 4; R < MT; R += NGW * 4) combine_rows<4>(AO, LSE, args.in[I_AON], MIXED, R, lane3); }
            } else {
                for (int it = vcu; it < 256; it += G) ssm_c_item(args, U_, SSMC_, SSMF, WGLU, MIXED, lds, it, wave3, lane3);
            }
        }
        GRID_BAR();
    }

    if (IN(4)) for (int rep_ = 0; rep_ < NREP(4); ++rep_) { WSBASE();
        pg8::Gemm g{MIXED, WOUT, MP, D, D}; pg8::RotOrder S; S.init(MP, D, G, bx, 0);
        const bool tile_first = ((bx >> 3) & 1) != 0;
        if (tile_first) for (int tile = bx; tile < 256; tile += G)
            sample_gemm_tile<0, false>(MIXED + (size_t)MP * D, WOUT, D, args.in[I_XS], nullptr, H1B + (size_t)MP * D, SS1S, lds, tile, wave, lane, tid);
        pg8::EpiRes<false, false> E{args.in[I_XP], nullptr, H1B, SS1}; pg8::gemm_phase<pg8::EpiRes<false, false>, pg8::RotOrder, true, true>(lds, g, S, E);
        if (!tile_first) for (int tile = bx; tile < 256; tile += G)
            sample_gemm_tile<0, false>(MIXED + (size_t)MP * D, WOUT, D, args.in[I_XS], nullptr, H1B + (size_t)MP * D, SS1S, lds, tile, wave, lane, tid);
        GRID_BAR();
    }
    if (IN(5)) for (int rep_ = 0; rep_ < NREP(5); ++rep_) { WSBASE();
        pg8::Gemm g{H1B, WXQ, MP, D, D}; pg8::RotOrder S; S.init(MP, D, G, bx, 0);
        const bool tile_first = ((bx >> 3) & 1) != 0;
        if (tile_first) for (int tile = bx; tile < 256; tile += G)
            sample_gemm_tile<1>(H1B + (size_t)MP * D, WXQ, D, nullptr, nullptr, QX + (size_t)MP * D, QSSS, lds, tile, wave, lane, tid);
        pg8::EpiQx E{QX, QSS}; pg8::gemm_phase<pg8::EpiQx, pg8::RotOrder, true, true>(lds, g, S, E);
        if (!tile_first) for (int tile = bx; tile < 256; tile += G)
            sample_gemm_tile<1>(H1B + (size_t)MP * D, WXQ, D, nullptr, nullptr, QX + (size_t)MP * D, QSSS, lds, tile, wave, lane, tid);
        GRID_BAR();
    }
    if (IN(6)) for (int rep_ = 0; rep_ < NREP(6); ++rep_) { WSBASE();
        if (tid < 8) ((LAS unsigned*)(lds + MISC_OFF))[16 + tid] = 0u;
        __syncthreads();
        int swapo = (bx >> 3) & 1; asm volatile("" : "+s"(swapo));
#pragma unroll 1
        for (int pass = 0; pass < 2; ++pass) {
            if (pass == swapo) {
                int tid3 = threadIdx.x; asm volatile("" : "+v"(tid3)); const int lane3 = tid3 & 63, wave3 = __builtin_amdgcn_readfirstlane(tid3 >> 6);
                GAS unsigned char* wsl3 = (GAS unsigned char*)ws; asm volatile("" : "+s"(wsl3));
                int slot = 0;
                for (int pair = vcu; pair < BS * 4; pair += G, ++slot) sxattn_stream<8>(args, (bf16*)(wsl3 + WS_QX), (float*)(wsl3 + WS_CTL + CTL_RS1), (float*)(wsl3 + WS_CTL + CTL_QS), (bf16*)(wsl3 + WS_OX), lds, (LAS unsigned*)(lds + MISC_OFF) + 16 + (slot & 7), pair, slot & 1, wave3, lane3);
            } else {
                int tid2 = threadIdx.x; asm volatile("" : "+v"(tid2)); const int lane2 = tid2 & 63, wave2 = __builtin_amdgcn_readfirstlane(tid2 >> 6);
                GAS unsigned char* wsl2 = (GAS unsigned char*)ws; asm volatile("" : "+s"(wsl2));
                for (int it = vcu; it < 8 * 4 * 8; it += G) xattn_wg_item((bf16*)(wsl2 + WS_QX), (float*)(wsl2 + WS_CTL + CTL_RS1), (float*)(wsl2 + WS_CTL + CTL_QS), (bf16*)(wsl2 + WS_MEMK), (bf16*)(wsl2 + WS_MVT), (bf16*)(wsl2 + WS_OX), lds, it, wave2, lane2, tid2);
            }
            __syncthreads();
        }
        GRID_BAR();
    }
    if (IN(7)) for (int rep_ = 0; rep_ < NREP(7); ++rep_) { WSBASE();
        pg8::Gemm g{OX, WXO, MP, D, D}; pg8::RotOrder S; S.init(MP, D, G, bx, 0);
        const bool tile_first = ((bx >> 3) & 1) != 0;
        if (tile_first) for (int tile = bx; tile < 256; tile += G)
            sample_gemm_tile<0, true>(OX + (size_t)MP * D, WXO, D, H1B + (size_t)MP * D, nullptr, H2B + (size_t)MP * D, SS2S, lds, tile, wave, lane, tid);
        pg8::EpiRes<true, false> E{H1B, nullptr, H2B, SS2}; pg8::gemm_phase<pg8::EpiRes<true, false>, pg8::RotOrder, true, true>(lds, g, S, E);
        if (!tile_first) for (int tile = bx; tile < 256; tile += G)
            sample_gemm_tile<0, true>(OX + (size_t)MP * D, WXO, D, H1B + (size_t)MP * D, nullptr, H2B + (size_t)MP * D, SS2S, lds, tile, wave, lane, tid);
        GRID_BAR();
    }
    if (IN(8)) for (int rep_ = 0; rep_ < NREP(8); ++rep_) { WSBASE();
        pg8::Gemm g{H2B, WUP, MT, FF2, D}; pg8::RotOrder S; S.init(MT, FF2, G, bx, 0);
        pg8::EpiUpConv E{ACT, (float*)(wsl + WS_EDGE), SS2, args.in[I_CONVW], args.in[I_CONVB], args.in[I_SCONV], out + O_CONVP, out + O_CONVS, lds}; pg8::gemm_phase<pg8::EpiUpConv, pg8::RotOrder, true, true>(lds, g, S, E);
        {
            constexpr int I_DN = (FF / 64) * (D / 32);
            const int first = S.nwg % G, nidle = G - first;
            if (bx >= first) {
                __syncthreads();
                p0_transpose_stream<0>(args.in[I_WDOWN], FF, D, WDOWN, nullptr, (LAS float*)(lds + wave * 16384), (bx - first) * NWAVES + wave, I_DN, nidle * NWAVES, lane);
            }
        }
        GRID_BAR();
    }
    if (IN(10)) for (int rep_ = 0; rep_ < NREP(10); ++rep_) { WSBASE();
        pg8::Gemm g{ACT, WDOWN, MP, D, FF}; pg8::RotOrder S; S.init(MP, D, G, bx, 0);
        const bool tile_first = ((bx >> 3) & 1) != 0;
        if (tile_first) for (int tile = bx; tile < 256; tile += G)
            sample_gemm_tile<0, true>(ACT + (size_t)MP * FF, WDOWN, FF, H2B + (size_t)MP * D, out + (size_t)MP * D, nullptr, nullptr, lds, tile, wave, lane, tid);
        { pg8::Unit uu; for (int i = 0; S.next(i, uu); ++i) if ((uu.pm & 7) != 0) conv_fix_tile(args, (const float*)(wsl + WS_EDGE), ACT, uu.pm, tid);
          VM_WAIT(); __syncthreads(); }
        pg8::EpiRes<true, true> E{H2B, out, nullptr, nullptr}; pg8::gemm_phase<pg8::EpiRes<true, true>, pg8::RotOrder, true, true>(lds, g, S, E);
        if (!tile_first) for (int tile = bx; tile < 256; tile += G)
            sample_gemm_tile<0, true>(ACT + (size_t)MP * FF, WDOWN, FF, H2B + (size_t)MP * D, out + (size_t)MP * D, nullptr, nullptr, lds, tile, wave, lane, tid);
    }
#if defined(DBG_SCALE_MASK)
    if (hi == N_PHASES) { GRID_BAR();
        const size_t offs[16] = {O_YP, O_YS, O_KV1P, O_KV4P, O_KV16P, O_SREP, O_SIMP, O_CONVP, O_MEMKV, O_KV1S, O_KV4S, O_KV16S, O_SRES, O_SIMS, O_CONVS, O_END};
        const size_t gt = (size_t)vcu * (NWAVES * 64) + tid, NT = (size_t)G * NWAVES * 64;
#pragma unroll
        for (int o = 0; o < 15; ++o) if ((DBG_SCALE_MASK >> o) & 1) { for (size_t i = offs[o] + gt; i < offs[o + 1]; i += NT) out[i] *= 3.0f; }
    }
#endif
#undef IN
#undef GRID_BAR
}


#if defined(PROBE_DET) || defined(PROBE_P3_TWICE)
__global__ void det_cmp_kernel(const unsigned* a, const unsigned* b, size_t nwords, unsigned* counter, int tol, int rw, int lo, int hi) {
    unsigned c = 0;
    for (size_t i = (size_t)blockIdx.x * blockDim.x + threadIdx.x; i < nwords; i += (size_t)gridDim.x * blockDim.x) {
        if (rw > 0) { const int cw = (int)(i % (size_t)rw); if (cw < lo || cw >= hi) continue; }
        const unsigned x = a[i], y = b[i];
        if (tol) { const float fx = __uint_as_float(x), fy = __uint_as_float(y); if (!(fabsf(fx - fy) <= 0.02f)) ++c; } else if (x != y) { ++c; atomicMin(counter + 32, (unsigned)i); atomicMax(counter + 48, (unsigned)i); } }
    if (c) atomicAdd(counter, c);
}
__global__ void det_mark_kernel(const unsigned* counters, int nreg, float* y, size_t n, int forced) {
    int r = -1; for (int i = nreg - 1; i >= 0; --i) if (counters[i] != 0u) r = i;
#if defined(PROBE_DET_COUNT)
    { const unsigned c = counters[PROBE_DET_COUNT], fw = counters[32 + PROBE_DET_COUNT], lw = counters[48 + PROBE_DET_COUNT]; const int fitem = (int)(fw / 512u) / 64, litem = (int)(lw / 512u) / 64;
      r = -1;
      if (c) { switch (PROBE_DET_MODE) { case 1: r = (int)(c >> 10); break; case 2: r = fitem >> 4; break; case 3: r = fitem & 15; break; case 4: r = litem - fitem; break; case 5: r = (int)((fw / 512u) & 63) >> 2; break; case 6: r = (int)(fw & 511u) >> 5; break; default: r = 0; } if (r > 21) r = 21; } }
#endif
    if (forced >= 0) r = forced;
#if defined(PROBE_CAL)
    r = (int)((wall_clock64() >> 12) & 1) ? 19 : -1;
#endif
    if (r < 0) return;
    const float f = 1.0f + 0.1f * (float)(r + 1);
    for (size_t i = (size_t)blockIdx.x * blockDim.x + threadIdx.x; i < n; i += (size_t)gridDim.x * blockDim.x) y[i] *= f;
}
#endif

extern "C" void kernel_launch(void* const* d_in, const int* in_sizes, int n_in, void* d_out, int out_size, void* d_ws, size_t ws_size, hipStream_t stream) {
    static int grid = 0;
    if (grid == 0) {
        if (n_in != 39 || (size_t)out_size != O_END || ws_size < WS_END) { fprintf(stderr, "kernel_launch: unexpected problem shape (n_in %d, out %d, ws %zu); nothing launched\n", n_in, out_size, ws_size); grid = -1; return; }
        int dev = 0, cus = 0, per_cu = 0;
        if (hipGetDevice(&dev) != hipSuccess || hipDeviceGetAttribute(&cus, hipDeviceAttributeMultiprocessorCount, dev) != hipSuccess) { grid = -1; return; }
        if (hipFuncSetAttribute((const void*)fwd_kernel, hipFuncAttributeMaxDynamicSharedMemorySize, LDS_BYTES) != hipSuccess) { fprintf(stderr, "kernel_launch: hipFuncSetAttribute failed\n"); grid = -1; return; }
        if (hipOccupancyMaxActiveBlocksPerMultiprocessor(&per_cu, (const void*)fwd_kernel, NWAVES * 64, LDS_BYTES) != hipSuccess || per_cu < 1) { fprintf(stderr, "kernel_launch: occupancy query says %d workgroups per CU\n", per_cu); (void)hipGetLastError(); grid = -1; return; }
        grid = cus;
    }
    if (grid < 0) return;
    (void)hipMemsetAsync((char*)d_ws + WS_CTL, 0, 64 * 1024, stream);
    Args a{};
    for (int i = 0; i < 39; ++i) a.in[i] = (const float*)d_in[i];
    a.out = (float*)d_out; a.ws = (unsigned char*)d_ws;
#if defined(PROBE_PRE_HI)
    a.ph_lo = 0; a.ph_hi = PROBE_PRE_HI; a.li = 1; a.pad = 0;
    hipLaunchKernelGGL(fwd_kernel, dim3(grid), dim3(NWAVES * 64), LDS_BYTES, stream, a);
    (void)hipMemsetAsync((char*)d_ws + WS_CTL, 0, CTL_ZERO_BYTES, stream);
#endif
#if defined(PROBE_DET)
    {
        const size_t SP = 644 * MiB, need = 1005 * MiB;
        char* w = (char*)d_ws; float* o = (float*)d_out;
        if (ws_size >= need) {
            a.ph_lo = 0; a.ph_hi = N_PHASES; a.li = 0; a.pad = 0;
            hipLaunchKernelGGL(fwd_kernel, dim3(grid), dim3(NWAVES * 64), LDS_BYTES, stream, a);
#if defined(PROBE_DUMP)
            (void)hipMemcpyAsync(w + SP + 190 * MiB, w + 191 * MiB, 33 * MiB, hipMemcpyDeviceToDevice, stream);
            (void)hipMemcpyAsync(w + 760 * MiB, w + 724 * MiB, 34 * MiB, hipMemcpyDeviceToDevice, stream);
#else
            (void)hipMemcpyAsync(w + SP, w + 1 * MiB, 223 * MiB, hipMemcpyDeviceToDevice, stream);
            (void)hipMemcpyAsync(w + SP + 223 * MiB, w + 295 * MiB, 4 * MiB, hipMemcpyDeviceToDevice, stream);
            (void)hipMemcpyAsync(w + SP + 227 * MiB, d_out, O_END * 4, hipMemcpyDeviceToDevice, stream);
#endif
#if defined(PROBE_DET_POISON)
            (void)hipMemsetAsync(w + PROBE_DET_POISON_LO * MiB, 0xAA, (size_t)(PROBE_DET_POISON_HI - PROBE_DET_POISON_LO) * MiB, stream);
#endif
            (void)hipMemsetAsync(w + WS_CTL, 0, CTL_ZERO_BYTES, stream);
        }
    }
#endif
    for (int li = 0; li < N_LAUNCHES; ++li) {
        a.li = 0; a.pad = 0;
        a.ph_lo = (N_LAUNCHES == 1) ? 0 : li; a.ph_hi = (N_LAUNCHES == 1) ? N_PHASES : li + 1;
        hipLaunchKernelGGL(fwd_kernel, dim3(grid), dim3(NWAVES * 64), LDS_BYTES, stream, a);
        const hipError_t le = hipPeekAtLastError();
        if (le != hipSuccess) { fprintf(stderr, "kernel_launch: launch %d failed: %s\n", li, hipGetErrorName(le)); break; }
    }
#if defined(PROBE_P3_TWICE)
    {   char* w = (char*)d_ws; float* o = (float*)d_out; unsigned* cnt = (unsigned*)(w + 643 * MiB + 900 * 1024);
        (void)hipMemsetAsync(cnt, 0, 256, stream); (void)hipMemsetAsync(cnt + 32, 0xFF, 64, stream);
        hipLaunchKernelGGL(det_cmp_kernel, dim3(2048), dim3(256), 0, stream, (const unsigned*)(w + WS_MIXED), (const unsigned*)(w + 644 * MiB), (size_t)MP * D * 2 / 4, cnt + PROBE_DET_COUNT, 0, 512, 384, 512);
        hipLaunchKernelGGL(det_mark_kernel, dim3(32), dim3(256), 0, stream, cnt, 1, o + O_SREP, (size_t)BP * 1024, -1);
    }
#endif
#if defined(PROBE_DET)
    {
        const size_t SP = 644 * MiB, need = 1005 * MiB;
        char* w = (char*)d_ws; float* o = (float*)d_out; unsigned* cnt = (unsigned*)(w + 640 * MiB);
        cnt = (unsigned*)(w + 643 * MiB + 900 * 1024);
        if (ws_size < need) { hipLaunchKernelGGL(det_mark_kernel, dim3(1024), dim3(256), 0, stream, cnt, 0, o, (size_t)MP * D, 19); }
        else {
            (void)hipMemsetAsync(cnt, 0, 256, stream); (void)hipMemsetAsync(cnt + 32, 0xFF, 64, stream);
            const char* c0 = w + SP - 1 * MiB;
            const float* oc = (const float*)(w + SP + 227 * MiB);
            struct Reg { const void* a; const void* b; size_t bytes; int tol; };
            struct Reg2 { const void* a; const void* b; size_t bytes; int rw, lo, hi; };
#if defined(PROBE_DUMP)
            const Reg2 regs[5] = {
                {w + 724 * MiB, w + 760 * MiB, (size_t)8 * MiB, 0, 0, 0}, {w + 741 * MiB, w + 777 * MiB, (size_t)2 * MiB, 0, 0, 0},
                {w + WS_MIXED, c0 + WS_MIXED, (size_t)MP * D * 2, 512, 384, 512}, {w + WS_MIXED, c0 + WS_MIXED, (size_t)MP * D * 2, 512, 384, 512}, {w + WS_MIXED, c0 + WS_MIXED, (size_t)MP * D * 2, 512, 384, 512} };
#else
            const Reg2 regs[14] = {
                {w + WS_U, c0 + WS_U, (size_t)MT * 256 * 4, 0, 0, 0}, {w + WS_Q, c0 + WS_Q, (size_t)MT * 768 * 2, 0, 0, 0}, {w + WS_K, c0 + WS_K, (size_t)MT * 768 * 2, 0, 0, 0}, {w + WS_VT, c0 + WS_VT, (size_t)MP * 768 * 2, 0, 0, 0},
                {o + O_KV1P, oc + O_KV1P, (O_SREP - O_KV1P) * 4, 0, 0, 0}, {o + O_MEMKV, oc + O_MEMKV, (O_KV1S - O_MEMKV) * 4, 0, 0, 0}, {o + O_KV1S, oc + O_KV1S, (O_SRES - O_KV1S) * 4, 0, 0, 0},
                {w + WS_SSMF, c0 + WS_SSMF, 2 * MiB, 0, 0, 0}, {w + WS_AO, c0 + WS_AO, (size_t)MT * 768 * 2, 0, 0, 0}, {w + WS_LSE, c0 + WS_LSE, (size_t)MT * 12 * 4, 0, 0, 0}, {w + WS_MEMK, w + SP + 223 * MiB, 4 * MiB, 0, 0, 0},
                {o + O_SREP, oc + O_SREP, (O_CONVP - O_SREP) * 4, 0, 0, 0}, {o + O_SRES, oc + O_SRES, (O_CONVS - O_SRES) * 4, 0, 0, 0}, {w + WS_MIXED, c0 + WS_MIXED, (size_t)MT * D * 2, 0, 0, 0} };
#endif
            for (int r = 0; r < (int)(sizeof(regs) / sizeof(regs[0])); ++r) hipLaunchKernelGGL(det_cmp_kernel, dim3(2048), dim3(256), 0, stream, (const unsigned*)regs[r].a, (const unsigned*)regs[r].b, regs[r].bytes / 4, cnt + r, 0, regs[r].rw, regs[r].lo, regs[r].hi);
            hipLaunchKernelGGL(det_mark_kernel, dim3(32), dim3(256), 0, stream, cnt, 14, o + O_SREP, (size_t)BP * 1024, -1);
        }
    }
#endif
}
```
